# Optimizing an MI355X kernel written in HIP

```python
import jax, jax.numpy as jnp
from jax import lax
import numpy as np

D_MODEL = 1024
BATCH = 16
SEQ = 2048
DEPTH = 4
DEC_BATCH = 128
DEC_SEQ = 1
PAST_LEN = 8192
PAGE_SIZE = 128

N_A_LAYERS = DEPTH // 2
N_B_LAYERS = DEPTH - N_A_LAYERS
EXPAND = 2
D_INNER = EXPAND * D_MODEL
A_HEAD = 64
A_HEADS = D_INNER // A_HEAD
DECAY_LORA = 64
ICLR_LORA = 64
VRES_LORA = 32
GN_EPS = A_HEAD * 1e-5
B_HEADS = 16
QK_NOPE = 128
QK_ROPE = 64
V_HEAD = D_INNER // B_HEADS
KV_LORA = 256
Q_LORA = 384
ROPE_THETA = 10000.0
Q_BLOCK = 128
NORM_EPS = 1e-6
ATTN_SCALE = (QK_NOPE + QK_ROPE) ** -0.5

kernel_name = 'yoco_rwkv7_mla_decoder_step'

F32 = jnp.float32


def rmsnorm(x, w):
    x32 = x.astype(F32)
    y = x32 * lax.rsqrt(jnp.mean(x32 * x32, axis=-1, keepdims=True) + NORM_EPS)
    return (y * w.astype(F32)).astype(x.dtype)


def rope(x, pos):
    half = x.shape[-1] // 2
    inv_freq = ROPE_THETA ** (-jnp.arange(half, dtype=F32) / half)
    ang = pos.astype(F32)[:, None] * inv_freq[None, :]
    shape = (1, pos.shape[0]) + (1,) * (x.ndim - 3) + (half,)
    cos = jnp.cos(ang).reshape(shape)
    sin = jnp.sin(ang).reshape(shape)
    x32 = x.astype(F32)
    x1, x2 = x32[..., :half], x32[..., half:]
    return jnp.concatenate([x1 * cos - x2 * sin, x2 * cos + x1 * sin], axis=-1).astype(x.dtype)


def _wkv_step(S, inp):
    r, w, k, v, a, b = inp
    sa = jnp.einsum('bhvk,bhk->bhv', S, a)
    S = S * w[:, :, None, :] + sa[..., None] * b[:, :, None, :] + v[..., None] * k[:, :, None, :]
    return S, jnp.einsum('bhvk,bhk->bhv', S, r)


def rwkv7_mix(h, h_prev, S0, v_first, vres, mix, w_in, w0, w1, w2, a0, a1, a2,
              k_k, k_a, r_k, lnx_w, lnx_b, w_out):
    B, T, _ = h.shape
    shifted = jnp.concatenate([h_prev[:, None, :].astype(h.dtype), h[:, :-1, :]], axis=1)
    dx = shifted - h
    mixed = h[None] + dx[None] * mix[:4, None, None, :]
    r, k, v, z = jnp.einsum('pbtd,pde->pbte', mixed, w_in)
    xw = h + dx * mix[4]
    xa = h + dx * mix[5]
    w_log = -jax.nn.softplus(-(w0 + jnp.tanh(xw @ w1) @ w2)) - 0.5
    decay = jnp.exp(-jnp.exp(w_log.astype(F32)))
    a = jax.nn.sigmoid(a0 + (xa @ a1) @ a2)
    if vres is not None:
        v0, v1, v2 = vres
        v = v + (v_first - v) * jax.nn.sigmoid(v0 + (mixed[2] @ v1) @ v2)
    heads = lambda t: t.reshape(B, T, A_HEADS, A_HEAD)
    kk = heads(k * k_k).astype(F32)
    kk = kk / jnp.maximum(jnp.sqrt(jnp.sum(kk * kk, axis=-1, keepdims=True)), 1e-12)
    k = k * (1 + (a - 1) * k_a)
    rh, kh, vh, ah = heads(r), heads(k), heads(v), heads(a)
    seq = lambda t: jnp.moveaxis(t.astype(F32), 1, 0)
    xs = (seq(rh), seq(heads(decay)), seq(kh), seq(vh), seq(-kk), seq(kk * ah.astype(F32)))
    S_fin, y = lax.scan(_wkv_step, S0.astype(F32), xs)
    y = jnp.moveaxis(y, 0, 1)
    mu = jnp.mean(y, axis=-1, keepdims=True)
    var = jnp.mean(jnp.square(y - mu), axis=-1, keepdims=True)
    yn = ((y - mu) * lax.rsqrt(var + GN_EPS)).reshape(B, T, D_INNER)
    yn = (yn * lnx_w.astype(F32) + lnx_b.astype(F32)).astype(h.dtype)
    bonus = (jnp.sum(rh * kh * r_k, axis=-1, keepdims=True) * vh).reshape(B, T, D_INNER)
    out = ((yn + bonus) * jax.nn.silu(z)) @ w_out
    return out, v, S_fin.astype(S0.dtype), h[:, -1, :]


def mla_shared_kv(x, pos, kv_in_norm_w, w_dkv, kv_norm_w):
    kv = rmsnorm(x, kv_in_norm_w) @ w_dkv
    ckv = rmsnorm(kv[..., :KV_LORA], kv_norm_w)
    kpe = rope(kv[..., KV_LORA:], pos)
    return ckv, kpe


def mla_query(h, pos, w_in, q_norm_w, w_uq):
    B, T, _ = h.shape
    proj = h @ w_in
    cq = rmsnorm(proj[..., :Q_LORA], q_norm_w)
    z = proj[..., Q_LORA:]
    q = (cq @ w_uq).reshape(B, T, B_HEADS, QK_NOPE + QK_ROPE)
    return q[..., :QK_NOPE], rope(q[..., QK_NOPE:], pos), z


def mla_prompt_attn(q_nope, q_pe, k_nope, kpe, v):
    B, S = q_nope.shape[:2]
    nblk = S // Q_BLOCK
    qn = jnp.moveaxis(q_nope.reshape(B, nblk, Q_BLOCK, B_HEADS, QK_NOPE), 1, 0)
    qp = jnp.moveaxis(q_pe.reshape(B, nblk, Q_BLOCK, B_HEADS, QK_ROPE), 1, 0)
    kpos = jnp.arange(S)

    def block(args):
        i, qn_b, qp_b = args
        s = (jnp.einsum('bqhd,bshd->bhqs', qn_b, k_nope)
             + jnp.einsum('bqhr,bsr->bhqs', qp_b, kpe)).astype(F32) * ATTN_SCALE
        qpos = i * Q_BLOCK + jnp.arange(Q_BLOCK)
        s = jnp.where(kpos[None, :] <= qpos[:, None], s, -jnp.inf)
        p = jax.nn.softmax(s, axis=-1).astype(v.dtype)
        return jnp.einsum('bhqs,bshv->bqhv', p, v)

    o = lax.map(block, (jnp.arange(nblk), qn, qp))
    return jnp.moveaxis(o, 0, 1).reshape(B, S, B_HEADS * V_HEAD)


def mla_sample_attn(q_nope, q_pe, ckv_past, kpe_past, ckv_new, kpe_new, w_uk, w_uv):
    B, T = q_nope.shape[:2]
    P = ckv_past.shape[1]
    q_lat = jnp.einsum('bthn,chn->bthc', q_nope, w_uk)
    s_past = (jnp.einsum('bthc,bsc->bhts', q_lat, ckv_past)
              + jnp.einsum('bthr,bsr->bhts', q_pe, kpe_past)).astype(F32) * ATTN_SCALE
    s_new = (jnp.einsum('bthc,bsc->bhts', q_lat, ckv_new)
             + jnp.einsum('bthr,bsr->bhts', q_pe, kpe_new)).astype(F32) * ATTN_SCALE
    causal = jnp.arange(T)[None, :] <= jnp.arange(T)[:, None]
    s_new = jnp.where(causal, s_new, -jnp.inf)
    p = jax.nn.softmax(jnp.concatenate([s_past, s_new], axis=-1), axis=-1).astype(ckv_past.dtype)
    o_lat = (jnp.einsum('bhts,bsc->bthc', p[..., :P], ckv_past)
             + jnp.einsum('bhts,bsc->bthc', p[..., P:], ckv_new))
    o = jnp.einsum('bthc,chv->bthv', o_lat, w_uv)
    return o.reshape(B, T, B_HEADS * V_HEAD)


def setup_inputs(seed: int = 0) -> dict:
    key = jax.random.key(seed)
    ks = iter(jax.random.split(key, 48))
    nrm = lambda shape, scale: jax.random.normal(next(ks), shape, F32) * scale
    n_pages = PAST_LEN // PAGE_SIZE
    n_used = DEC_BATCH * n_pages
    n_pool = n_used + (n_used + 3) // 4
    page_table = jax.random.permutation(next(ks), n_pool)[:n_used].astype(jnp.int32).reshape(DEC_BATCH, n_pages)
    NA, NB = N_A_LAYERS, N_B_LAYERS
    return {
        'x_prompt': nrm((BATCH, SEQ, D_MODEL), 1.0),
        'x_sample': nrm((DEC_BATCH, DEC_SEQ, D_MODEL), 1.0),
        'state_wkv': nrm((NA, DEC_BATCH, A_HEADS, A_HEAD, A_HEAD), 0.5),
        'state_shift': nrm((NA, DEC_BATCH, D_MODEL), 1.0),
        'cache_ckv': nrm((n_pool, PAGE_SIZE, KV_LORA), 1.0),
        'cache_kpe': nrm((n_pool, PAGE_SIZE, QK_ROPE), 1.0),
        'page_table': page_table,
        'a_norm_w': 1.0 + nrm((NA, D_MODEL), 0.02),
        'a_mix': jax.random.uniform(next(ks), (NA, 6, D_MODEL), F32),
        'a_w_in': nrm((NA, 4, D_MODEL, D_INNER), D_MODEL ** -0.5),
        'a_w0': jax.random.uniform(next(ks), (NA, D_INNER), F32, -6.0, -1.0),
        'a_w1': nrm((NA, D_MODEL, DECAY_LORA), D_MODEL ** -0.5),
        'a_w2': nrm((NA, DECAY_LORA, D_INNER), 0.1 * DECAY_LORA ** -0.5),
        'a_a0': nrm((NA, D_INNER), 0.1),
        'a_a1': nrm((NA, D_MODEL, ICLR_LORA), D_MODEL ** -0.5),
        'a_a2': nrm((NA, ICLR_LORA, D_INNER), 0.5 * ICLR_LORA ** -0.5),
        'a_v0': nrm((NA - 1, D_INNER), 0.1),
        'a_v1': nrm((NA - 1, D_MODEL, VRES_LORA), D_MODEL ** -0.5),
        'a_v2': nrm((NA - 1, VRES_LORA, D_INNER), 0.5 * VRES_LORA ** -0.5),
        'a_k_k': 0.85 + nrm((NA, D_INNER), 0.02),
        'a_k_a': 1.0 + nrm((NA, D_INNER), 0.02),
        'a_r_k': nrm((NA, A_HEADS, A_HEAD), 0.1),
        'a_lnx_w': 1.0 + nrm((NA, D_INNER), 0.02),
        'a_lnx_b': nrm((NA, D_INNER), 0.01),
        'a_w_out': nrm((NA, D_INNER, D_MODEL), D_INNER ** -0.5),
        'kv_in_norm_w': 1.0 + nrm((D_MODEL,), 0.02),
        'w_dkv': nrm((D_MODEL, KV_LORA + QK_ROPE), D_MODEL ** -0.5),
        'kv_norm_w': 1.0 + nrm((KV_LORA,), 0.02),
        'w_uk': nrm((KV_LORA, B_HEADS, QK_NOPE), KV_LORA ** -0.5),
        'w_uv': nrm((KV_LORA, B_HEADS, V_HEAD), KV_LORA ** -0.5),
        'b_norm_w': 1.0 + nrm((NB, D_MODEL), 0.02),
        'b_w_in': nrm((NB, D_MODEL, Q_LORA + D_INNER), D_MODEL ** -0.5),
        'b_q_norm_w': 1.0 + nrm((NB, Q_LORA), 0.02),
        'b_w_uq': nrm((NB, Q_LORA, B_HEADS * (QK_NOPE + QK_ROPE)), Q_LORA ** -0.5),
        'b_w_out': nrm((NB, D_INNER, D_MODEL), D_INNER ** -0.5),
        'final_norm_w': 1.0 + nrm((D_MODEL,), 0.02),
    }


def reference(x_prompt, x_sample, state_wkv, state_shift, cache_ckv, cache_kpe, page_table,
              a_norm_w, a_mix, a_w_in, a_w0, a_w1, a_w2, a_a0, a_a1, a_a2, a_v0, a_v1, a_v2,
              a_k_k, a_k_a, a_r_k, a_lnx_w, a_lnx_b, a_w_out,
              kv_in_norm_w, w_dkv, kv_norm_w, w_uk, w_uv,
              b_norm_w, b_w_in, b_q_norm_w, b_w_uq, b_w_out, final_norm_w):
    Bp, Sp, _ = x_prompt.shape
    Bs, Ts, _ = x_sample.shape
    past = page_table.shape[1] * cache_ckv.shape[1]
    pos_p = jnp.arange(Sp, dtype=jnp.int32)
    pos_s = past + jnp.arange(Ts, dtype=jnp.int32)
    xp, xs = x_prompt, x_sample
    shift0 = jnp.zeros((Bp, D_MODEL), x_prompt.dtype)
    wkv0 = jnp.zeros((Bp, A_HEADS, A_HEAD, A_HEAD), state_wkv.dtype)
    vf_p = vf_s = None
    wkv_p, sh_p, wkv_s, sh_s = [], [], [], []
    for l in range(N_A_LAYERS):
        vres = None if l == 0 else (a_v0[l - 1], a_v1[l - 1], a_v2[l - 1])
        prm = (a_mix[l], a_w_in[l], a_w0[l], a_w1[l], a_w2[l], a_a0[l], a_a1[l], a_a2[l],
               a_k_k[l], a_k_a[l], a_r_k[l], a_lnx_w[l], a_lnx_b[l], a_w_out[l])
        o, v, S, last = rwkv7_mix(rmsnorm(xp, a_norm_w[l]), shift0, wkv0, vf_p, vres, *prm)
        xp = xp + o
        wkv_p.append(S)
        sh_p.append(last)
        if l == 0:
            vf_p = v
        o, v, S, last = rwkv7_mix(rmsnorm(xs, a_norm_w[l]), state_shift[l], state_wkv[l], vf_s, vres, *prm)
        xs = xs + o
        wkv_s.append(S)
        sh_s.append(last)
        if l == 0:
            vf_s = v
    ckv_p, kpe_p = mla_shared_kv(xp, pos_p, kv_in_norm_w, w_dkv, kv_norm_w)
    ckv_s, kpe_s = mla_shared_kv(xs, pos_s, kv_in_norm_w, w_dkv, kv_norm_w)
    k_nope_p = jnp.einsum('bsc,chn->bshn', ckv_p, w_uk)
    v_p = jnp.einsum('bsc,chv->bshv', ckv_p, w_uv)
    ckv_past = cache_ckv[page_table].reshape(Bs, past, KV_LORA)
    kpe_past = cache_kpe[page_table].reshape(Bs, past, QK_ROPE)
    for l in range(N_B_LAYERS):
        qn, qr, z = mla_query(rmsnorm(xp, b_norm_w[l]), pos_p, b_w_in[l], b_q_norm_w[l], b_w_uq[l])
        o = mla_prompt_attn(qn, qr, k_nope_p, kpe_p, v_p)
        xp = xp + (o * jax.nn.silu(z)) @ b_w_out[l]
        qn, qr, z = mla_query(rmsnorm(xs, b_norm_w[l]), pos_s, b_w_in[l], b_q_norm_w[l], b_w_uq[l])
        o = mla_sample_attn(qn, qr, ckv_past, kpe_past, ckv_s, kpe_s, w_uk, w_uv)
        xs = xs + (o * jax.nn.silu(z)) @ b_w_out[l]
    y_prompt = rmsnorm(xp, final_norm_w)
    y_sample = rmsnorm(xs, final_norm_w)
    return (y_prompt, y_sample, jnp.stack(wkv_p), jnp.stack(sh_p), ckv_p, kpe_p,
            jnp.stack(wkv_s), jnp.stack(sh_s), ckv_s, kpe_s)
```

```cpp
#include <hip/hip_runtime.h>
#include <cstdio>
#include <cstdint>
namespace pg8 {
#define PG8_LAS __attribute__((address_space(3)))
typedef unsigned short bf16_t;
typedef short bf16x8 __attribute__((ext_vector_type(8)));
typedef float f32x4 __attribute__((ext_vector_type(4)));
typedef unsigned u32x4 __attribute__((ext_vector_type(4)));
constexpr int BM = 256, BK = 64, HALF = 128, HTB = HALF * BK * 2  , STAGE_BYTES = 8 * HTB, NXCD = 8, WGM = 8;

__host__ __device__ __forceinline__ int lds_byte(int r, int c) { const int st = (r >> 4) * 2 + (c >> 5), rr = r & 15, cc = c & 31, ob = rr * 64 + cc * 2; return st * 1024 + (ob ^ (((ob >> 9) & 1) << 5)); }
__host__ __device__ __forceinline__ void stage_rc(int b, int& R, int& C) { const int st = b / 1024, sb = b % 1024, swz = sb ^ (((sb >> 9) & 1) << 5); R = (st >> 1) * 16 + swz / 64; C = (st & 1) * 32 + (swz % 64) / 2; }
__host__ __device__ __forceinline__ int perm32(int rho) { const int n = rho >> 4, i = rho & 15; return 8 * (i >> 2) + 4 * n + (i & 3); }

struct Unit { int pm, pn; };
struct Gemm { const bf16_t* A; const bf16_t* Bt; int M, N, K; };

struct StaticOrder {
    int nM, nN, nwg, G, c;
    __host__ __device__ void init(int M, int N, int G_, int c_) { nM = M / BM; nN = N / BM; nwg = nM * nN; G = G_; c = c_; }
    __host__ __device__ bool next(int i, Unit& u) const {
        const long L = (long)i * G + c; if (L >= nwg) return false;
        int wgid = (int)L; { const int q = nwg / NXCD, r = nwg % NXCD, xcd = wgid % NXCD, off = wgid / NXCD; wgid = (xcd < r ? xcd * (q + 1) : r * (q + 1) + (xcd - r) * q) + off; }
        const int nig = WGM * nN, gid = wgid / nig, fm = gid * WGM, gsz = (nM - fm) < WGM ? (nM - fm) : WGM;
        u.pm = fm + ((wgid % nig) % gsz); u.pn = (wgid % nig) / gsz; return true;
    }
    __device__ __forceinline__ void a_ready(const Unit&) const {}
    __device__ __forceinline__ void done(const Unit&) const {}
};

__device__ __forceinline__ unsigned cvt_pk_bf16(float lo, float hi) { unsigned r; asm volatile("v_cvt_pk_bf16_f32 %0, %1, %2" : "=v"(r) : "v"(lo), "v"(hi)); return r; }
typedef float f32x2 __attribute__((ext_vector_type(2)));
__device__ __forceinline__ float act_apply(int ACT, float x) {
    if (ACT == 1) return 1.0f - 2.0f / (1.0f + __expf(2.0f * x));
    if (ACT == 2) return __expf(-0.6065306597126334f / (1.0f + __expf(-x)));
    if (ACT == 3) return 1.0f / (1.0f + __expf(-x));
    return x;
}
template <int ACT> struct EpiB {
    static constexpr bool PERM = true, AFTER_DRAIN = false;
    bf16_t* O; int ldc; int nvalid; int nstore;
    __device__ __forceinline__ void operator()(const f32x4 (&acc)[2][2][4][2], const Unit& u, int wr, int wc, int, int) const {
        int lane_; asm volatile("v_mbcnt_lo_u32_b32 %0, -1, 0\n\tv_mbcnt_hi_u32_b32 %0, -1, %0" : "=v"(lane_)); const int fr = lane_ & 15, fq = lane_ >> 4;
        const int row0 = u.pm * BM + wr * 64 + fr, col0 = u.pn * BM + wc * 32 + 8 * fq;
#pragma unroll
        for (int ai = 0; ai < 2; ++ai)
#pragma unroll
            for (int m = 0; m < 4; ++m) { bf16_t* rowp = O + (size_t)(row0 + ai * HALF + m * 16) * ldc + col0;
#pragma unroll
                for (int bj = 0; bj < 2; ++bj) { const int c = col0 + bj * HALF; if (c >= nstore) continue;
                    f32x4 v0 = acc[ai][bj][m][0], v1 = acc[ai][bj][m][1];
                    if (ACT != 0) {
#pragma unroll
                        for (int e = 0; e < 4; ++e) { v0[e] = act_apply(ACT, v0[e]); v1[e] = act_apply(ACT, v1[e]); } }
                    u32x4 w; w.x = cvt_pk_bf16(v0[0], v0[1]); w.y = cvt_pk_bf16(v0[2], v0[3]); w.z = cvt_pk_bf16(v1[0], v1[1]); w.w = cvt_pk_bf16(v1[2], v1[3]);
                    if (c >= nvalid) w = (u32x4){0u, 0u, 0u, 0u};
                    *(u32x4*)(rowp + bj * HALF) = w; } }
    }
};
template <int ACT, bool HAS_BASE, bool HAS_BIAS> struct EpiF {
    static constexpr bool PERM = false, AFTER_DRAIN = false;
    float* O; const float* base; const float* bias; int ldc; int nstore;
    __device__ __forceinline__ void operator()(const f32x4 (&acc)[2][2][4][2], const Unit& u, int wr, int wc, int, int) const {
        int lane_; asm volatile("v_mbcnt_lo_u32_b32 %0, -1, 0\n\tv_mbcnt_hi_u32_b32 %0, -1, %0" : "=v"(lane_)); const int fr = lane_ & 15, fq = lane_ >> 4;
        const int row0 = u.pm * BM + wr * 64 + fr, col0 = u.pn * BM + wc * 32 + 4 * fq;
        f32x4 bv[2][2];
#pragma unroll
        for (int bj = 0; bj < 2; ++bj)
#pragma unroll
            for (int n = 0; n < 2; ++n) bv[bj][n] = HAS_BIAS ? *(const f32x4*)(bias + col0 + bj * HALF + n * 16) : (f32x4){0.f, 0.f, 0.f, 0.f};
#pragma unroll
        for (int ai = 0; ai < 2; ++ai)
#pragma unroll
            for (int m = 0; m < 4; ++m) { const size_t off = (size_t)(row0 + ai * HALF + m * 16) * ldc + col0;
#pragma unroll
                for (int bj = 0; bj < 2; ++bj)
#pragma unroll
                    for (int n = 0; n < 2; ++n) { if (col0 + bj * HALF + n * 16 >= nstore) continue;
                        f32x4 v = acc[ai][bj][m][n] + bv[bj][n];
                        if (ACT != 0) {
#pragma unroll
                            for (int e = 0; e < 4; ++e) v[e] = act_apply(ACT, v[e]); }
                        if (HAS_BASE) v += *(const f32x4*)(base + off + bj * HALF + n * 16);
                        *(f32x4*)(O + off + bj * HALF + n * 16) = v; }
                if (m & 1) asm volatile("" ::: "memory"); }
    }
};

struct GroupOrder4 {
    StaticOrder so; int per;
    __device__ void init(int M, int N, int G_, int c_) { so.init(M, N, G_, c_); per = so.nwg; }
    __device__ bool next(int i, Unit& u) const {
        const long L = (long)i * so.G + so.c; if (L >= 4L * per) return false;
        const int gi = (int)(L / per); int wgid = (int)(L - (long)gi * per);
        { const int q = so.nwg / NXCD, r = so.nwg % NXCD, xcd = wgid % NXCD, off = wgid / NXCD; wgid = (xcd < r ? xcd * (q + 1) : r * (q + 1) + (xcd - r) * q) + off; }
        const int nig = WGM * so.nN, gid = wgid / nig, fm = gid * WGM, gsz = (so.nM - fm) < WGM ? (so.nM - fm) : WGM;
        u.pm = fm + ((wgid % nig) % gsz) + 130 * gi; u.pn = (wgid % nig) / gsz + 8 * gi; return true;
    }
    __device__ __forceinline__ void a_ready(const Unit&) const {}
    __device__ __forceinline__ void done(const Unit&) const {}
};
struct EpiB4 {
    static constexpr bool PERM = true, AFTER_DRAIN = false;
    bf16_t* O[4];
    __device__ __forceinline__ void operator()(const f32x4 (&acc)[2][2][4][2], const Unit& u, int wr, int wc, int, int) const {
        int lane_; asm volatile("v_mbcnt_lo_u32_b32 %0, -1, 0\n\tv_mbcnt_hi_u32_b32 %0, -1, %0" : "=v"(lane_)); const int fr = lane_ & 15, fq = lane_ >> 4;
        const int gi = u.pn >> 3; bf16_t* Ob = gi == 0 ? O[0] : gi == 1 ? O[1] : gi == 2 ? O[2] : O[3];
        const int row0 = (u.pm - 130 * gi) * BM + wr * 64 + fr, col0 = (u.pn & 7) * BM + wc * 32 + 8 * fq;
#pragma unroll
        for (int ai = 0; ai < 2; ++ai)
#pragma unroll
            for (int m = 0; m < 4; ++m) { bf16_t* rowp = Ob + (size_t)(row0 + ai * HALF + m * 16) * 2048 + col0;
#pragma unroll
                for (int bj = 0; bj < 2; ++bj) { const f32x4 v0 = acc[ai][bj][m][0], v1 = acc[ai][bj][m][1];
                    u32x4 w; w.x = cvt_pk_bf16(v0[0], v0[1]); w.y = cvt_pk_bf16(v0[2], v0[3]); w.z = cvt_pk_bf16(v1[0], v1[1]); w.w = cvt_pk_bf16(v1[2], v1[3]);
                    *(u32x4*)(rowp + bj * HALF) = w; } }
    }
};
template <class Epi, class Sched, bool ALIGN_EPI = false, bool SP2 = false>
__device__ __forceinline__ void gemm_phase(PG8_LAS unsigned char* lds, const Gemm g, const Sched& S, const Epi& E, const int wid) {
    int lane_; asm volatile("v_mbcnt_lo_u32_b32 %0, -1, 0\n\tv_mbcnt_hi_u32_b32 %0, -1, %0" : "=v"(lane_));
    const int lane = lane_, tid = wid * 64 + lane, wr = wid >> 2, wc = wid & 3, fr = lane & 15, fq = lane >> 4;
    const int K = g.K, nt = K / BK;
    unsigned voffA[2], voffB[2];
#pragma unroll
    for (int i = 0; i < 2; ++i) { int R, C; stage_rc(tid * 16 + i * 8192, R, C); const int Rb = Epi::PERM ? ((R & ~31) + perm32(R & 31)) : R;
        voffA[i] = (unsigned)(R * K + C) * 2u; voffB[i] = (unsigned)(Rb * K + C) * 2u; }
    const size_t kstep = (size_t)(BK * 2);
    const size_t hstep = (size_t)HALF * K * 2;
    const size_t tstep = 2 * hstep;
    const unsigned ldsw = (unsigned)wid * 1024u;
    const int aoff = lds_byte(wr * 64 + fr, fq * 8), boff = lds_byte(wc * 32 + fr, fq * 8);
#define PG8_SA(b, h) (((b) * 2 + (h)) * HTB)
#define PG8_SB(b, h) ((4 + (b) * 2 + (h)) * HTB)
#define PG8_STAGE(bufoff, gbase, voff) do { _Pragma("unroll") for (int _i = 0; _i < 2; ++_i) \
        __builtin_amdgcn_global_load_lds((const unsigned*)((const char*)(gbase) + (voff)[_i]), (PG8_LAS unsigned*)(lds + (bufoff) + ldsw + _i * 8192), 16, 0, 0); } while (0)
#define PG8_LDA(dst, b, h) do { _Pragma("unroll") for (int m = 0; m < 4; ++m) _Pragma("unroll") for (int k = 0; k < 2; ++k) dst[m][k] = *(const PG8_LAS bf16x8*)(lds + PG8_SA(b, h) + aoff + m * 2048 + k * 1024); } while (0)
#define PG8_LDB(dst, b, h) do { _Pragma("unroll") for (int n = 0; n < 2; ++n) _Pragma("unroll") for (int k = 0; k < 2; ++k) dst[n][k] = *(const PG8_LAS bf16x8*)(lds + PG8_SB(b, h) + boff + n * 2048 + k * 1024); } while (0)
#define PG8_MMA(ai, bj, At, Bt) do { __builtin_amdgcn_s_setprio(1); _Pragma("unroll") for (int m = 0; m < 4; ++m) _Pragma("unroll") for (int n = 0; n < 2; ++n) _Pragma("unroll") for (int k = 0; k < 2; ++k) \
        acc[ai][bj][m][n] = __builtin_amdgcn_mfma_f32_16x16x32_bf16(Bt[n][k], At[m][k], acc[ai][bj][m][n], 0, 0, 0); __builtin_amdgcn_s_setprio(0); } while (0)
#define PG8_WAIT_V(n) asm volatile("s_waitcnt vmcnt(" #n ")" ::: "memory")
#define PG8_WAIT_L(n) asm volatile("s_waitcnt lgkmcnt(" #n ")" ::: "memory")
#define PG8_BAR __builtin_amdgcn_s_barrier()
#define PG8_SCHED __builtin_amdgcn_sched_barrier(0)
    Unit cur, nxt; int ui = 0;
    if (!S.next(0, cur)) return;
    f32x4 acc[2][2][4][2];
#pragma unroll
    for (int a = 0; a < 2; ++a)
#pragma unroll
        for (int b = 0; b < 2; ++b)
#pragma unroll
            for (int m = 0; m < 4; ++m)
#pragma unroll
                for (int n = 0; n < 2; ++n) acc[a][b][m][n] = (f32x4){0.f, 0.f, 0.f, 0.f};
    bf16x8 At[4][2], B0[2][2], B1[2][2];
    const char* cA = (const char*)g.A + (size_t)cur.pm * tstep; const char* cB = (const char*)g.Bt + (size_t)cur.pn * tstep;
    S.a_ready(cur);
    if constexpr (SP2) {
        PG8_STAGE(PG8_SB(0, 0), cB, voffB); PG8_STAGE(PG8_SB(0, 1), cB + hstep, voffB); PG8_STAGE(PG8_SA(0, 0), cA, voffA); PG8_STAGE(PG8_SA(0, 1), cA + hstep, voffA);
        if (wr == 1) PG8_BAR;
        PG8_WAIT_V(2); PG8_BAR;
        PG8_STAGE(PG8_SB(1, 0), cB + kstep, voffB); PG8_STAGE(PG8_SA(1, 0), cA + kstep, voffA); PG8_STAGE(PG8_SB(1, 1), cB + hstep + kstep, voffB);
        PG8_WAIT_V(6); PG8_BAR;
    } else {
        PG8_STAGE(PG8_SB(0, 0), cB, voffB); PG8_STAGE(PG8_SA(0, 0), cA, voffA); PG8_STAGE(PG8_SB(0, 1), cB + hstep, voffB); PG8_STAGE(PG8_SA(0, 1), cA + hstep, voffA);
        if (wr == 1) PG8_BAR;
        PG8_WAIT_V(4); PG8_BAR;
        PG8_STAGE(PG8_SB(1, 0), cB + kstep, voffB); PG8_STAGE(PG8_SA(1, 0), cA + kstep, voffA); PG8_STAGE(PG8_SB(1, 1), cB + hstep + kstep, voffB);
        PG8_WAIT_V(6); PG8_BAR;
    }
    for (;;) {
        const bool has_next = S.next(ui + 1, nxt);
        const char* nA = has_next ? (const char*)g.A + (size_t)nxt.pm * tstep : cA; const char* nB = has_next ? (const char*)g.Bt + (size_t)nxt.pn * tstep : cB;
        for (int t = 0; t < nt; t += 2) {
            const bool last = (t == nt - 2);
            const char* a1 = cA + (size_t)(t + 1) * kstep;
            const char* a2 = last ? nA : cA + (size_t)(t + 2) * kstep; const char* b2 = last ? nB : cB + (size_t)(t + 2) * kstep;
            const char* a3 = a2 + kstep; const char* b3 = b2 + kstep;
            if (last && has_next) S.a_ready(nxt);
            if constexpr (SP2) {
            PG8_LDB(B0, 0, 0); PG8_LDB(B1, 0, 1); PG8_SCHED; PG8_LDA(At, 0, 0); PG8_STAGE(PG8_SA(1, 1), a1 + hstep, voffA);
            PG8_WAIT_V(8); PG8_WAIT_L(0); PG8_BAR; PG8_MMA(0, 0, At, B0); PG8_MMA(0, 1, At, B1); PG8_BAR; PG8_SCHED;
            PG8_LDA(At, 0, 1); PG8_STAGE(PG8_SB(0, 0), b2, voffB); PG8_STAGE(PG8_SB(0, 1), b2 + hstep, voffB); PG8_STAGE(PG8_SA(0, 0), a2, voffA);
            PG8_WAIT_V(8); PG8_WAIT_L(0); PG8_BAR; PG8_MMA(1, 0, At, B0); PG8_MMA(1, 1, At, B1); PG8_BAR; PG8_SCHED;
            PG8_LDB(B0, 1, 0); PG8_LDB(B1, 1, 1); PG8_SCHED; PG8_LDA(At, 1, 0); PG8_STAGE(PG8_SA(0, 1), a2 + hstep, voffA);
            PG8_WAIT_V(8); PG8_WAIT_L(0); PG8_BAR; PG8_MMA(0, 0, At, B0); PG8_MMA(0, 1, At, B1); PG8_BAR; PG8_SCHED;
            PG8_LDA(At, 1, 1); PG8_STAGE(PG8_SB(1, 0), b3, voffB); PG8_STAGE(PG8_SB(1, 1), b3 + hstep, voffB); PG8_STAGE(PG8_SA(1, 0), a3, voffA);
            PG8_WAIT_V(8); PG8_WAIT_L(0); PG8_BAR; PG8_MMA(1, 0, At, B0); PG8_MMA(1, 1, At, B1); PG8_BAR; PG8_SCHED;
            } else {
            PG8_LDB(B0, 0, 0); PG8_SCHED; PG8_LDA(At, 0, 0); PG8_STAGE(PG8_SA(1, 1), a1 + hstep, voffA);
            PG8_WAIT_L(8); PG8_BAR; PG8_WAIT_L(0); PG8_MMA(0, 0, At, B0); PG8_BAR; PG8_SCHED;
            PG8_LDB(B1, 0, 1); PG8_STAGE(PG8_SB(0, 0), b2, voffB);
            PG8_BAR; PG8_WAIT_L(0); PG8_MMA(0, 1, At, B1); PG8_BAR;
            PG8_LDA(At, 0, 1); PG8_STAGE(PG8_SA(0, 0), a2, voffA);
            PG8_BAR; PG8_WAIT_L(0); PG8_MMA(1, 0, At, B0); PG8_BAR; PG8_SCHED;
            PG8_STAGE(PG8_SB(0, 1), b2 + hstep, voffB);
            PG8_WAIT_V(6); PG8_BAR; PG8_MMA(1, 1, At, B1); PG8_BAR;
            PG8_LDB(B0, 1, 0); PG8_SCHED; PG8_LDA(At, 1, 0); PG8_STAGE(PG8_SA(0, 1), a2 + hstep, voffA);
            PG8_WAIT_L(8); PG8_BAR; PG8_WAIT_L(0); PG8_MMA(0, 0, At, B0); PG8_BAR; PG8_SCHED;
            PG8_LDB(B1, 1, 1); PG8_STAGE(PG8_SB(1, 0), b3, voffB);
            PG8_BAR; PG8_WAIT_L(0); PG8_MMA(0, 1, At, B1); PG8_BAR;
            PG8_LDA(At, 1, 1); PG8_STAGE(PG8_SA(1, 0), a3, voffA);
            PG8_BAR; PG8_WAIT_L(0); PG8_MMA(1, 0, At, B0); PG8_BAR; PG8_SCHED;
            PG8_STAGE(PG8_SB(1, 1), b3 + hstep, voffB);
            PG8_WAIT_V(6); PG8_BAR; PG8_MMA(1, 1, At, B1); PG8_BAR;
            }
        }
        if constexpr (ALIGN_EPI) { if (wr == 0) PG8_BAR; }
        if constexpr (!Epi::AFTER_DRAIN) { E(acc, cur, wr, wc, fr, fq); S.done(cur); }
        if (!has_next) break;
#pragma unroll
        for (int a = 0; a < 2; ++a)
#pragma unroll
            for (int b = 0; b < 2; ++b)
#pragma unroll
                for (int m = 0; m < 4; ++m)
#pragma unroll
                    for (int n = 0; n < 2; ++n) acc[a][b][m][n] = (f32x4){0.f, 0.f, 0.f, 0.f};
        cur = nxt; cA = nA; cB = nB; ++ui;
        if constexpr (ALIGN_EPI) { if (wr == 1) PG8_BAR; }
    }
    PG8_WAIT_V(0);
    if constexpr (!ALIGN_EPI) { if (wr == 0) PG8_BAR; }
    PG8_BAR;
    if constexpr (Epi::AFTER_DRAIN) { E.fused(acc, cur, wr, wc, fr, fq, lds, wid, lane); S.done(cur); }
#undef PG8_SA
#undef PG8_SB
#undef PG8_STAGE
#undef PG8_LDA
#undef PG8_LDB
#undef PG8_MMA
#undef PG8_WAIT_V
#undef PG8_WAIT_L
#undef PG8_BAR
#undef PG8_SCHED
}
}
constexpr int D_MODEL = 1024, BATCH = 16, SEQ = 2048, DEC_BATCH = 128, PAST = 8192, PAGE = 128, NPAGES = 64;
constexpr int D_INNER = 2048, A_HEADS = 32, A_HEAD = 64, B_HEADS = 16, KV_LORA = 256, Q_LORA = 384, QK_NOPE = 128, QK_ROPE = 64, V_HEAD = 128, QK_HEAD = 192;
constexpr int MP = BATCH * SEQ;
constexpr int MS0 = MP;
constexpr int MT = MP + 256;
constexpr float NORM_EPS = 1e-6f, GN_EPS = 64e-5f;
constexpr float ATTN_SCALE = 0.07216878364870322f;
constexpr float LOG2E = 1.4426950408889634f;
constexpr int NWAVES = 8, NTHR = 512;

constexpr size_t O_YP = 0, O_YS = O_YP + (size_t)MP * D_MODEL, O_WKVP = O_YS + (size_t)DEC_BATCH * D_MODEL, O_SHP = O_WKVP + (size_t)2 * BATCH * A_HEADS * 4096,
    O_CKVP = O_SHP + (size_t)2 * BATCH * D_MODEL, O_KPEP = O_CKVP + (size_t)MP * KV_LORA, O_WKVS = O_KPEP + (size_t)MP * QK_ROPE, O_SHS = O_WKVS + (size_t)2 * DEC_BATCH * A_HEADS * 4096,
    O_CKVS = O_SHS + (size_t)2 * DEC_BATCH * D_MODEL, O_KPES = O_CKVS + (size_t)DEC_BATCH * KV_LORA, O_END = O_KPES + (size_t)DEC_BATCH * QK_ROPE;

constexpr size_t MiB = 1u << 20;
constexpr size_t WS_CTL = 0, CTL_ZERO_BYTES = 2 * MiB;
constexpr size_t WS_WIN = 2 * MiB;
constexpr size_t WS_W1 = WS_WIN + 32 * MiB;
constexpr size_t WS_W2 = WS_W1 + 3 * MiB;
constexpr size_t WS_WO = WS_W2 + 3 * MiB;
constexpr size_t WS_WDKV = WS_WO + 8 * MiB;
constexpr size_t WS_WUK = WS_WDKV + 1 * MiB;
constexpr size_t WS_WUV = WS_WUK + 1 * MiB;
constexpr size_t WS_WQ = WS_WUV + 1 * MiB;
constexpr size_t WS_WZ = WS_WQ + 2 * MiB;
constexpr size_t WS_WUQ = WS_WZ + 8 * MiB;
constexpr size_t WS_WBO = WS_WUQ + 5 * MiB;
constexpr size_t WS_ROPE = WS_WBO + 8 * MiB;
constexpr size_t WS_X = 96 * MiB;
constexpr size_t WS_AM = WS_X + 130 * MiB;
constexpr size_t AM_STRIDE = 65 * MiB;
constexpr size_t WS_R = WS_AM + 6 * AM_STRIDE;
constexpr size_t BIGB = 130 * MiB;
constexpr size_t WS_K = WS_R + BIGB, WS_V0 = WS_K + BIGB, WS_V1 = WS_V0 + BIGB, WS_Z = WS_V1 + BIGB, WS_G = WS_Z + BIGB;
constexpr size_t WS_LW = WS_G + BIGB;
constexpr size_t WS_LA = WS_LW + 9 * MiB, WS_LV = WS_LA + 9 * MiB;
constexpr size_t WS_BON = WS_LV + 9 * MiB;
constexpr size_t WS_F = WS_BON + 5 * MiB;
constexpr size_t BIGF = 260 * MiB;
constexpr size_t WS_WD = WS_F, WS_IA = WS_F + BIGF, WS_VG = WS_F + 2 * BIGF, WS_SR = WS_F + 3 * BIGF, WS_SK = WS_F + 4 * BIGF, WS_SA = WS_F + 5 * BIGF, WS_SB = WS_F + 6 * BIGF,
    WS_SV = WS_F + 7 * BIGF, WS_Y = WS_F + 8 * BIGF, WS_END_A = WS_F + 9 * BIGF;
constexpr size_t WS_KVR = WS_F;
constexpr size_t WS_CKVB = WS_KVR + 41 * MiB;
constexpr size_t WS_KPEB = WS_CKVB + 17 * MiB;
constexpr size_t WS_KN = WS_KPEB + 5 * MiB;
constexpr size_t WS_VT = WS_KN + 128 * MiB;
constexpr size_t WS_QL = WS_VT + 128 * MiB;
constexpr size_t WS_CQ = WS_QL + 49 * MiB;
constexpr size_t WS_QR = WS_CQ + 25 * MiB;
constexpr size_t WS_Q = WS_QR + 388 * MiB;
constexpr size_t WS_QABS = WS_Q + 194 * MiB;
constexpr size_t WS_OPART = WS_QABS + 2 * MiB;
constexpr size_t WS_ML = WS_OPART + 16 * MiB;
constexpr size_t WS_END_B = WS_ML + 1 * MiB;
constexpr size_t WS_NEED = WS_END_A > WS_END_B ? WS_END_A : WS_END_B;
static_assert(WS_ROPE + 1 * MiB <= WS_X, "weights region");
constexpr int CW_BAR = 4096;

constexpr int RING_BYTES = 131072;
constexpr int LDSCTL_OFF = RING_BYTES;
constexpr int LDS_BYTES = 147456;

#define GAS __attribute__((address_space(1)))
#define LAS __attribute__((address_space(3)))
typedef unsigned short bf16;
typedef unsigned v4u __attribute__((ext_vector_type(4)));
typedef unsigned v2u __attribute__((ext_vector_type(2)));
typedef float f32x4 __attribute__((ext_vector_type(4)));
typedef float f32x16 __attribute__((ext_vector_type(16)));
typedef short bf16x8 __attribute__((ext_vector_type(8)));
typedef short s16x4 __attribute__((ext_vector_type(4)));
typedef const __attribute__((address_space(4))) float* cfp;
#define LDS_WAIT() asm volatile("s_waitcnt lgkmcnt(0)" ::: "memory")
#define VM_WAIT() asm volatile("s_waitcnt vmcnt(0)" ::: "memory")
__device__ __forceinline__ unsigned f2bf(float f) { unsigned u = __builtin_bit_cast(unsigned, f); return (u + 0x7fffu + ((u >> 16) & 1u)) >> 16; }
__device__ __forceinline__ unsigned pk2(float lo, float hi) { return f2bf(lo) | (f2bf(hi) << 16); }
__device__ __forceinline__ float bflo(unsigned u) { return __builtin_bit_cast(float, u << 16); }
__device__ __forceinline__ float bfhi(unsigned u) { return __builtin_bit_cast(float, u & 0xffff0000u); }
template <int MASK> __device__ __forceinline__ float swz_xor(float v) { return __builtin_bit_cast(float, __builtin_amdgcn_ds_swizzle(__builtin_bit_cast(int, v), 0x1F | (MASK << 10))); }
__device__ __forceinline__ float xor32_sum(float v) { float a = v, b = v; asm volatile("s_nop 1\n\tv_permlane32_swap_b32 %0, %1\n\ts_nop 1" : "+v"(a), "+v"(b)); return a + b; }
__device__ __forceinline__ float xor32_max(float v) { float a = v, b = v; asm volatile("s_nop 1\n\tv_permlane32_swap_b32 %0, %1\n\ts_nop 1" : "+v"(a), "+v"(b)); return fmaxf(a, b); }
__device__ __forceinline__ float wave_sum(float v) { v += swz_xor<1>(v); v += swz_xor<2>(v); v += swz_xor<4>(v); v += swz_xor<8>(v); v += swz_xor<16>(v); return xor32_sum(v); }
__device__ __forceinline__ float sigmoidf_(float x) { return 1.0f / (1.0f + __expf(-x)); }
#define XB_TMO      128
#define XB_XCNT(j)  (256  + 64 * (j))
#define XB_XSUB(j)  (1280 + 64 * (j))
#define XB_XGEN(j)  (2304 + 64 * (j))
#define XB_TOP      3328
#define XB_TOPGEN   3392
#define XCD_BAR_WORDS 3456
#define XB_SPIN_CAP (1u << 18)

__device__ __forceinline__ unsigned xb_ld(unsigned* p)              { return __hip_atomic_load(p, __ATOMIC_RELAXED, __HIP_MEMORY_SCOPE_AGENT); }
__device__ __forceinline__ unsigned xb_add(unsigned* p, unsigned v) { return __hip_atomic_fetch_add(p, v, __ATOMIC_RELAXED, __HIP_MEMORY_SCOPE_AGENT); }
__device__ __forceinline__ unsigned xb_xcc_id() { return (unsigned)__builtin_amdgcn_s_getreg((3 << 11) | 20) & 0xFu; }
#define XB_SPIN(cond, bar) do { unsigned _sp = 0; while (cond) { __builtin_amdgcn_s_sleep(1); \
    if ((++_sp & 255u) == 0u) { if (xb_ld(&(bar)[XB_TMO])) break; if (_sp > XB_SPIN_CAP) { atomicAdd(&(bar)[XB_TMO], 1u); break; } } } } while (0)

struct XcdBarrier {
    unsigned* bar; unsigned x; unsigned w;
    volatile LAS unsigned* st;
};

__device__ __forceinline__ bool xb_t0(unsigned w) { unsigned l; asm volatile("v_mbcnt_lo_u32_b32 %0, -1, 0\n\tv_mbcnt_hi_u32_b32 %0, -1, %0" : "=v"(l)); return w == 0u && l == 0u; }
__device__ __forceinline__ XcdBarrier xcd_barrier_post(unsigned* bar, volatile LAS unsigned* st, unsigned w) {
    XcdBarrier b; b.bar = bar; b.x = xb_xcc_id(); b.st = st; b.w = w;
    if (xb_t0(w)) (void)xb_add(&bar[XB_XCNT(b.x)], 1u);
    return b;
}
__device__ __forceinline__ void xcd_barrier_complete(unsigned* bar, unsigned x, unsigned& nloc, unsigned& nx) {
    const unsigned G = gridDim.x * gridDim.y * gridDim.z;
    unsigned sum, cnt, mine, sp = 0u;
    for (;;) {
        sum = 0u; cnt = 0u; mine = 0u;
#pragma unroll
        for (unsigned j = 0; j < 16; ++j) { const unsigned c = xb_ld(&bar[XB_XCNT(j)]); sum += c; cnt += (c > 0u) ? 1u : 0u; mine = (j == x) ? c : mine; }
        if (sum == G) break;
        __builtin_amdgcn_s_sleep(1);
        if ((++sp & 255u) == 0u) { if (xb_ld(&bar[XB_TMO])) break; if (sp > XB_SPIN_CAP) { atomicAdd(&bar[XB_TMO], 1u); break; } }
    }
    nloc = mine > 0u ? mine : 1u; nx = cnt > 0u ? cnt : 1u;
}

__device__ __forceinline__ void xcd_barrier(const XcdBarrier& b) {
    asm volatile("s_waitcnt vmcnt(0)" ::: "memory");
    __syncthreads();
    if (xb_t0(b.w)) {
        unsigned* bar = b.bar;
        __builtin_amdgcn_s_waitcnt(0);
        unsigned nloc = b.st[0], nx = b.st[1];
        if (nloc == 0u) { xcd_barrier_complete(bar, b.x, nloc, nx); b.st[0] = nloc; b.st[1] = nx; }
        const unsigned old = xb_add(&bar[XB_XSUB(b.x)], 1u);
        const unsigned gen = old / nloc;
        if (old + 1u == (gen + 1u) * nloc) {
            __builtin_amdgcn_fence(__ATOMIC_RELEASE, "agent");
            asm volatile("s_waitcnt vmcnt(0)" ::: "memory");
            const unsigned og = xb_add(&bar[XB_TOP], 1u);
            const unsigned tg = og / nx;
            if (og + 1u == (tg + 1u) * nx) xb_add(&bar[XB_TOPGEN], 1u);
            else XB_SPIN(xb_ld(&bar[XB_TOPGEN]) == tg, bar);
            __builtin_amdgcn_fence(__ATOMIC_ACQUIRE, "agent");
            xb_add(&bar[XB_XGEN(b.x)], 1u);
            asm volatile("s_waitcnt vmcnt(0)" ::: "memory");
        } else {
            XB_SPIN(xb_ld(&bar[XB_XGEN(b.x)]) == gen, bar);
            __builtin_amdgcn_fence(__ATOMIC_ACQUIRE, "agent");
            asm volatile("s_waitcnt vmcnt(0)" ::: "memory");
        }
    }
    __syncthreads();
}
struct Args { const void* in[36]; float* out; unsigned char* ws; int ph_lo, ph_hi, li, pad; };
typedef const __attribute__((address_space(4))) Args* cargs;
__device__ __forceinline__ int lane_id() { int l; asm volatile("v_mbcnt_lo_u32_b32 %0, -1, 0\n\tv_mbcnt_hi_u32_b32 %0, -1, %0" : "=v"(l)); return l; }
struct Frame { LAS unsigned char* lds; unsigned char* ws; float* out; int lane, wave, bid, gw, NGW, G, NT; };
#define LANE F.lane
__device__ __forceinline__ Frame make_frame(cargs ap, int wave0, LAS unsigned char* lds) {
    Frame F; int w = wave0, b = (int)blockIdx.x, g = (int)gridDim.x; asm volatile("" : "+s"(w), "+s"(b), "+s"(g));
    F.lds = lds; F.ws = ap->ws; F.out = ap->out; F.lane = lane_id(); F.wave = w; F.bid = b; F.G = g; F.gw = b * NWAVES + w; F.NGW = g * NWAVES; F.NT = g * NTHR;
    return F;
}

__device__ __forceinline__ void tr_item(const float* W, int ldw, int col0, int Kvalid, int nblk, bf16* WT, int ldt, bool zpad, LAS float* scr, int item, int lane) {
    const int kb = item / nblk, nb = item % nblk, k0 = 64 * kb, n0 = 32 * nb;
#pragma unroll 8
    for (int i = 0; i < 32; ++i) { const int kk = 2 * i + (lane >> 5); scr[kk * 33 + (lane & 31)] = (k0 + kk < Kvalid) ? W[(size_t)(k0 + kk) * ldw + col0 + n0 + (lane & 31)] : 0.f; }
    LDS_WAIT(); asm volatile("" ::: "memory");
    const int c = lane & 7;
#pragma unroll
    for (int j = 0; j < 4; ++j) { const int n = (lane >> 3) + 8 * j; const LAS float* s = scr + (8 * c) * 33 + n;
        v4u o; o.x = pk2(s[0 * 33], s[1 * 33]); o.y = pk2(s[2 * 33], s[3 * 33]); o.z = pk2(s[4 * 33], s[5 * 33]); o.w = pk2(s[6 * 33], s[7 * 33]);
        *(v4u*)(WT + (size_t)(n0 + n) * ldt + k0 + 8 * c) = o;
        if (zpad) *(v4u*)(WT + (size_t)(n0 + n) * ldt + 64 + 8 * c) = (v4u){0u, 0u, 0u, 0u}; }
    LDS_WAIT(); asm volatile("" ::: "memory");
}
#define TRJOB(W_, ldw_, col0_, Kv_, Nc_, WT_, ldt_, zp_) do { const int nblk_ = (Nc_) / 32, items_ = (((Kv_) + 63) / 64) * nblk_; \
    for (int it_ = F.gw; it_ < items_; it_ += F.NGW) tr_item((W_), (ldw_), (col0_), (Kv_), nblk_, (bf16*)(WT_), (ldt_), (zp_), scr, it_, LANE); } while (0)

__device__ __forceinline__ void p0_prologue(Frame& F, cargs a) {
    LAS float* scr = (LAS float*)(F.lds + F.wave * 16384);
    unsigned char* ws = F.ws;
    for (int l = 0; l < 2; ++l) {
        for (int p = 0; p < 4; ++p) TRJOB((const float*)a->in[9] + (size_t)(l * 4 + p) * 1024 * 2048, 2048, 0, 1024, 2048, ws + WS_WIN + (size_t)(l * 4 + p) * 4 * MiB, 1024, false);
        TRJOB((const float*)a->in[11] + (size_t)l * 1024 * 64, 64, 0, 1024, 64, ws + WS_W1 + (size_t)l * (MiB / 2), 1024, false);
        TRJOB((const float*)a->in[14] + (size_t)l * 1024 * 64, 64, 0, 1024, 64, ws + WS_W1 + (size_t)(2 + l) * (MiB / 2), 1024, false);
        TRJOB((const float*)a->in[12] + (size_t)l * 64 * 2048, 2048, 0, 64, 2048, ws + WS_W2 + (size_t)l * (MiB / 2), 128, true);
        TRJOB((const float*)a->in[15] + (size_t)l * 64 * 2048, 2048, 0, 64, 2048, ws + WS_W2 + (size_t)(2 + l) * (MiB / 2), 128, true);
        TRJOB((const float*)a->in[24] + (size_t)l * 2048 * 1024, 1024, 0, 2048, 1024, ws + WS_WO + (size_t)l * 4 * MiB, 2048, false);
        TRJOB((const float*)a->in[31] + (size_t)l * 1024 * 2432, 2432, 0, 1024, 384, ws + WS_WQ + (size_t)l * MiB, 1024, false);
        TRJOB((const float*)a->in[31] + (size_t)l * 1024 * 2432, 2432, 384, 1024, 2048, ws + WS_WZ + (size_t)l * 4 * MiB, 1024, false);
        TRJOB((const float*)a->in[33] + (size_t)l * 384 * 3072, 3072, 0, 384, 3072, ws + WS_WUQ + (size_t)l * (5 * MiB / 2), 384, false);
        TRJOB((const float*)a->in[34] + (size_t)l * 2048 * 1024, 1024, 0, 2048, 1024, ws + WS_WBO + (size_t)l * 4 * MiB, 2048, false);
    }
    TRJOB((const float*)a->in[17], 32, 0, 1024, 32, ws + WS_W1 + (size_t)4 * (MiB / 2), 1024, false);
    TRJOB((const float*)a->in[18], 2048, 0, 32, 2048, ws + WS_W2 + (size_t)4 * (MiB / 2), 128, true);
    TRJOB((const float*)a->in[26], 320, 0, 1024, 320, ws + WS_WDKV, 1024, false);
    TRJOB((const float*)a->in[28], 2048, 0, 256, 2048, ws + WS_WUK, 256, false);
    TRJOB((const float*)a->in[29], 2048, 0, 256, 2048, ws + WS_WUV, 256, false);
    { const f32x4* xp = (const f32x4*)a->in[0]; const f32x4* xs = (const f32x4*)a->in[1]; f32x4* X4 = (f32x4*)(ws + WS_X);
      for (size_t i = (F.bid * NTHR + F.wave * 64 + LANE); i < (size_t)MT * 256; i += F.NT) { const int m = (int)(i >> 8);
          f32x4 v = (f32x4){0.f, 0.f, 0.f, 0.f}; if (m < MP) v = xp[i]; else if (m < MP + DEC_BATCH) v = xs[i - (size_t)MP * 256]; X4[i] = v; } }
    { float* T = (float*)(ws + WS_ROPE);
      for (int i = (F.bid * NTHR + F.wave * 64 + LANE); i < 2049 * 32; i += F.NT) { const int p = i >> 5, f = i & 31; const double pos = p < 2048 ? (double)p : 8192.0;
          const double ang = pos * pow(10000.0, -(double)f / 32.0); T[2 * i] = (float)cos(ang); T[2 * i + 1] = (float)sin(ang); } }
}

__device__ __forceinline__ void load_row(const float* row, int lane, f32x4 (&v)[4]) {
#pragma unroll
    for (int j = 0; j < 4; ++j) v[j] = ((const f32x4*)row)[lane + 64 * j];
}
__device__ __forceinline__ float row_rs(const f32x4 (&v)[4]) {
    float s = 0.f;
#pragma unroll
    for (int j = 0; j < 4; ++j) s += (v[j].x * v[j].x + v[j].y * v[j].y) + (v[j].z * v[j].z + v[j].w * v[j].w);
    return 1.0f / sqrtf(wave_sum(s) * (1.0f / 1024.0f) + NORM_EPS);
}
__device__ __forceinline__ void norm_rows_bf16(Frame& F, const float* X, const float* w, bf16* O) {
    f32x4 w4[4]; load_row(w, LANE, w4);
    for (int m = F.gw; m < MT; m += F.NGW) { f32x4 x[4]; load_row(X + (size_t)m * 1024, LANE, x); const float rs = row_rs(x);
#pragma unroll
        for (int j = 0; j < 4; ++j) { const f32x4 h = x[j] * rs * w4[j]; v2u o; o.x = pk2(h.x, h.y); o.y = pk2(h.z, h.w); *(v2u*)(O + (size_t)m * 1024 + 4 * LANE + 256 * j) = o; } }
}

__device__ __forceinline__ void a1_prepass(Frame& F, cargs a, int l) {
    const float* X = (const float*)(F.ws + WS_X);
    const float* nw = (const float*)a->in[7] + l * 1024; const float* mix = (const float*)a->in[8] + l * 6 * 1024; const float* sshift = (const float*)a->in[3] + (size_t)l * DEC_BATCH * 1024;
    f32x4 w4[4]; load_row(nw, LANE, w4);
    for (int m = F.gw; m < MT; m += F.NGW) {
        f32x4 x[4], h[4], hp[4]; load_row(X + (size_t)m * 1024, LANE, x); const float rs = row_rs(x);
#pragma unroll
        for (int j = 0; j < 4; ++j) { h[j] = x[j] * rs * w4[j]; hp[j] = (f32x4){0.f, 0.f, 0.f, 0.f}; }
        if (m < MP) { if ((m & (SEQ - 1)) != 0) { f32x4 xq[4]; load_row(X + (size_t)(m - 1) * 1024, LANE, xq); const float rq = row_rs(xq);
#pragma unroll
                for (int j = 0; j < 4; ++j) hp[j] = xq[j] * rq * w4[j]; } }
        else if (m < MP + DEC_BATCH) load_row(sshift + (size_t)(m - MP) * 1024, LANE, hp);
#pragma unroll
        for (int p = 0; p < 6; ++p) { bf16* O = (bf16*)(F.ws + WS_AM + (size_t)p * AM_STRIDE) + (size_t)m * 1024;
#pragma unroll
            for (int j = 0; j < 4; ++j) { const f32x4 mx = ((const f32x4*)(mix + p * 1024))[LANE + 64 * j]; const f32x4 o = h[j] + (hp[j] - h[j]) * mx;
                v2u w; w.x = pk2(o.x, o.y); w.y = pk2(o.z, o.w); *(v2u*)(O + 4 * LANE + 256 * j) = w; } }
        float* so = nullptr;
        if (m < MP) { if ((m & (SEQ - 1)) == SEQ - 1) so = F.out + O_SHP + (size_t)(l * BATCH + (m >> 11)) * 1024; }
        else if (m < MP + DEC_BATCH) so = F.out + O_SHS + (size_t)(l * DEC_BATCH + (m - MP)) * 1024;
        if (so) {
#pragma unroll
            for (int j = 0; j < 4; ++j) ((f32x4*)so)[LANE + 64 * j] = h[j]; }
    }
}

typedef float f32x2 __attribute__((ext_vector_type(2)));
__device__ __forceinline__ void unpack8(v4u u, float (&f)[8]) { f[0] = bflo(u.x); f[1] = bfhi(u.x); f[2] = bflo(u.y); f[3] = bfhi(u.y); f[4] = bflo(u.z); f[5] = bfhi(u.z); f[6] = bflo(u.w); f[7] = bfhi(u.w); }
constexpr int FS_TS = 16, FS_Y = FS_TS * 6 * 64 * 4, FS_Z = FS_Y + FS_TS * 64 * 4, FS_BON = FS_Z + FS_TS * 64 * 2, FS_BH = FS_BON + 128, FS_BUF = 2 * FS_BH;
static_assert(2 * FS_BUF <= RING_BYTES && FS_BH % 16 == 0, "fused scan LDS");
template <int CTRL> __device__ __forceinline__ float dppf(float v) { return __builtin_bit_cast(float, __builtin_amdgcn_update_dpp(0, __builtin_bit_cast(int, v), CTRL, 0xF, 0xF, false)); }
__device__ __forceinline__ float wave_sum_fast(float v) {
    v += dppf<0xB1>(v); v += dppf<0x4E>(v); v += dppf<0x124>(v); v += dppf<0x128>(v);
    const int iv = __builtin_bit_cast(int, v);
    return (__builtin_bit_cast(float, __builtin_amdgcn_readlane(iv, 0)) + __builtin_bit_cast(float, __builtin_amdgcn_readlane(iv, 16))) + (__builtin_bit_cast(float, __builtin_amdgcn_readlane(iv, 32)) + __builtin_bit_cast(float, __builtin_amdgcn_readlane(iv, 48)));
}
struct HeadPrm { float w0, a0, v0, kk, ka, rk, lnw, lnb; };
__device__ __forceinline__ float frcp(float x) { return __builtin_amdgcn_rcpf(x); }
__device__ __forceinline__ float fsig(float x) { return __builtin_amdgcn_rcpf(1.0f + __builtin_amdgcn_exp2f(-1.4426950408889634f * x)); }
__device__ __forceinline__ float wkv_step_lds(f32x2 (&S)[32], const LAS float* op, int lane) {
    const LAS f32x4* a4 = (const LAS f32x4*)op; const LAS f32x4* w4 = a4 + 16; const LAS f32x4* b4 = a4 + 32; const LAS f32x4* k4 = a4 + 48; const LAS f32x4* r4 = a4 + 64;
    const float vv = op[320 + lane];
    f32x2 s0 = (f32x2){0.f, 0.f}, s1 = s0;
#pragma unroll
    for (int q = 0; q < 16; ++q) { const f32x4 a = a4[q]; s0 += S[2 * q] * (f32x2){a.x, a.y}; s1 += S[2 * q + 1] * (f32x2){a.z, a.w}; }
    const f32x2 st = s0 + s1; const float sa = st.x + st.y; const f32x2 sa2 = (f32x2){sa, sa}, vv2 = (f32x2){vv, vv};
    f32x2 y0 = (f32x2){0.f, 0.f}, y1 = y0;
#pragma unroll
    for (int q = 0; q < 16; ++q) { const f32x4 w = w4[q], b = b4[q], k = k4[q], r = r4[q];
        S[2 * q] = S[2 * q] * (f32x2){w.x, w.y} + (sa2 * (f32x2){b.x, b.y} + vv2 * (f32x2){k.x, k.y}); y0 += S[2 * q] * (f32x2){r.x, r.y};
        S[2 * q + 1] = S[2 * q + 1] * (f32x2){w.z, w.w} + (sa2 * (f32x2){b.z, b.w} + vv2 * (f32x2){k.z, k.w}); y1 += S[2 * q + 1] * (f32x2){r.z, r.w}; }
    const f32x2 yt = y0 + y1; return yt.x + yt.y;
}
__device__ __forceinline__ void fs_prep_one(const HeadPrm& P, int l, float r, float k, float v, float dw, float da, float dv, float vf, LAS float* op, int lane, float& bon) {
    const float ia = sigmoidf_(P.a0 + da), w = __expf(-0.6065306597126334f * sigmoidf_(P.w0 + dw));
    if (l) v = v + (vf - v) * sigmoidf_(P.v0 + dv);
    const float kk = k * P.kk, n2 = wave_sum_fast(kk * kk), inv = 1.0f / fmaxf(sqrtf(n2), 1e-12f), q = kk * inv, kp = k * (1.0f + (ia - 1.0f) * P.ka);
    bon = wave_sum_fast(r * kp * P.rk);
    op[lane] = -q; op[64 + lane] = w; op[128 + lane] = q * ia; op[192 + lane] = kp; op[256 + lane] = r; op[320 + lane] = v;
}
__device__ __forceinline__ float fs_post_one(const HeadPrm& P, float y, float vp, float z, float bon) {
    const float mu = wave_sum_fast(y) * (1.0f / 64.0f), d = y - mu, var = wave_sum_fast(d * d) * (1.0f / 64.0f);
    const float yn = d * __builtin_amdgcn_rsqf(var + GN_EPS) * P.lnw + P.lnb; return (yn + bon * vp) * (z * fsig(z));
}
__device__ __forceinline__ float ldbf(const bf16* p) { return bflo((unsigned)*p); }
__device__ __forceinline__ bf16 tobf(float x) { return __builtin_bit_cast(unsigned short, (__bf16)x); }
typedef short s16x4_t __attribute__((ext_vector_type(4)));
#define MF16(a_, b_, c_) __builtin_amdgcn_mfma_f32_16x16x16bf16_1k((a_), (b_), (c_), 0, 0, 0)
#define MF32(a_, b_, c_) __builtin_amdgcn_mfma_f32_16x16x32_bf16((a_), (b_), (c_), 0, 0, 0)
typedef __bf16 bf16x4_nat __attribute__((ext_vector_type(4)));
__device__ __forceinline__ s16x4_t cvt4(f32x4 v) { return __builtin_bit_cast(s16x4_t, __builtin_convertvector(v, bf16x4_nat)); }
constexpr int CK_TP = 144, CK_KP = 40;
constexpr int CK_AT = 0, CK_RT = CK_AT + 16 * CK_TP, CK_BH = CK_RT + 16 * CK_TP, CK_KH = CK_BH + 16 * CK_TP, CK_BHT = CK_KH + 16 * CK_TP, CK_KHT = CK_BHT + 64 * CK_KP, CK_VT = CK_KHT + 64 * CK_KP,
    CK_PC = CK_VT + 64 * CK_KP, CK_OPB = CK_PC + 256;
constexpr int RG_VP = 0, RG_Z = 2048, RG_BON = 4096, RG_SZ = 4224;
constexpr int BH_OPB = 0, BH_RING = 2 * CK_OPB, BH_Y = BH_RING + 3 * RG_SZ, BH_SZ = BH_Y + 2 * 4096;
static_assert(2 * BH_SZ <= RING_BYTES && BH_SZ % 16 == 0 && CK_OPB % 16 == 0, "chunked scan LDS");
__device__ __forceinline__ void ck_scan_chunk(f32x4 (&ST)[4][4], const LAS unsigned char* ob, LAS float* yb, int c16, int g) {
    const f32x4 zero4 = (f32x4){0.f, 0.f, 0.f, 0.f};
    bf16x8 at[2], rt[2], bh[2], kh[2];
#pragma unroll
    for (int ks = 0; ks < 2; ++ks) { const int o = c16 * CK_TP + 16 * g + 64 * ks;
        at[ks] = *(const LAS bf16x8*)(ob + CK_AT + o); rt[ks] = *(const LAS bf16x8*)(ob + CK_RT + o); bh[ks] = *(const LAS bf16x8*)(ob + CK_BH + o); kh[ks] = *(const LAS bf16x8*)(ob + CK_KH + o); }
    f32x4 qN = zero4, qL = zero4, qMk = zero4, qNbr = zero4, qNkr = zero4;
#pragma unroll
    for (int ks = 0; ks < 2; ++ks) { qN = MF32(bh[ks], at[ks], qN); qL = MF32(at[ks], bh[ks], qL); qMk = MF32(kh[ks], at[ks], qMk); qNbr = MF32(bh[ks], rt[ks], qNbr); qNkr = MF32(kh[ks], rt[ks], qNkr); }
    f32x4 Id;
#pragma unroll
    for (int r = 0; r < 4; ++r) { const int row = 4 * g + r; Id[r] = row == c16 ? 1.f : 0.f;
        if (!(row < c16)) { qN[r] = 0.f; qMk[r] = 0.f; }
        if (!(row <= c16)) { qNbr[r] = 0.f; qNkr[r] = 0.f; }
        if (!(c16 < row)) qL[r] = 0.f; }
    const s16x4_t aN = cvt4(qN), aL = cvt4(qL), aMk = cvt4(qMk), aNbr = cvt4(qNbr), aNkr = cvt4(qNkr);
    const f32x4 n2 = MF16(aL, aN, zero4), l2 = MF16(aN, aL, zero4);
    const s16x4_t aN2 = cvt4(n2), aL2 = cvt4(l2);
    const f32x4 n4 = MF16(aL2, aN2, zero4), l4 = MF16(aN2, aL2, zero4);
    const f32x4 n8 = MF16(cvt4(l4), cvt4(n4), zero4);
    const f32x4 p1t = MF16(cvt4(n2 + Id), cvt4(qL + Id), zero4);
    const f32x4 p2 = MF16(cvt4(l4 + Id), cvt4(n8 + Id), zero4);
    const s16x4_t aT = cvt4(MF16(cvt4(p1t), cvt4(p2), zero4));
    s16x4_t af[4], rf[4]; s16x4_t Sb[4];
#pragma unroll
    for (int ki = 0; ki < 4; ++ki) { const int o = c16 * CK_TP + (16 * ki + 4 * g) * 2; af[ki] = *(const LAS s16x4_t*)(ob + CK_AT + o); rf[ki] = *(const LAS s16x4_t*)(ob + CK_RT + o); }
#pragma unroll
    for (int vi = 0; vi < 4; ++vi) {
        f32x4 xt = zero4, y0 = zero4;
#pragma unroll
        for (int ki = 0; ki < 4; ++ki) { Sb[ki] = cvt4(ST[ki][vi]); xt = MF16(af[ki], Sb[ki], xt); y0 = MF16(rf[ki], Sb[ki], y0); }
        const s16x4_t vt = *(const LAS s16x4_t*)(ob + CK_VT + (16 * vi + c16) * CK_KP + 8 * g);
        xt = MF16(aMk, vt, xt);
        const s16x4_t ub = cvt4(MF16(aT, cvt4(xt), zero4));
        y0 = MF16(aNbr, ub, y0); y0 = MF16(aNkr, vt, y0);
#pragma unroll
        for (int r = 0; r < 4; ++r) yb[(4 * g + r) * 64 + 16 * vi + c16] = y0[r];
#pragma unroll
        for (int ki = 0; ki < 4; ++ki) { const int o = (16 * ki + c16) * CK_KP + 8 * g;
            const s16x4_t bf_ = *(const LAS s16x4_t*)(ob + CK_BHT + o), kf_ = *(const LAS s16x4_t*)(ob + CK_KHT + o);
            ST[ki][vi] = MF16(bf_, ub, ST[ki][vi]); ST[ki][vi] = MF16(kf_, vt, ST[ki][vi]); }
    }
#pragma unroll
    for (int ki = 0; ki < 4; ++ki) { const f32x4 pc = *(const LAS f32x4*)(ob + CK_PC + (16 * ki + 4 * g) * 4);
#pragma unroll
        for (int vi = 0; vi < 4; ++vi) ST[ki][vi] *= pc; }
}
__device__ __forceinline__ void a5_fused(Frame& F, cargs a, int l) {
    unsigned char* ws = F.ws; const int lane = F.lane;
    const bf16* R = (const bf16*)(ws + WS_R); const bf16* K = (const bf16*)(ws + WS_K); const bf16* V = (const bf16*)(ws + (l ? WS_V1 : WS_V0)); const bf16* VF = (const bf16*)(ws + WS_V0); const bf16* Z = (const bf16*)(ws + WS_Z);
    const bf16* DW = (const bf16*)(ws + WS_WD); const bf16* DA = (const bf16*)(ws + WS_IA); const bf16* DV = (const bf16*)(ws + WS_VG); bf16* G = (bf16*)(ws + WS_G);
    const float* pw0 = (const float*)a->in[10] + l * 2048; const float* pa0 = (const float*)a->in[13] + l * 2048; const float* pv0 = (const float*)a->in[16]; const float* pkk = (const float*)a->in[19] + l * 2048;
    const float* pka = (const float*)a->in[20] + l * 2048; const float* prk = (const float*)a->in[21] + l * 2048; const float* plw = (const float*)a->in[22] + l * 2048; const float* plb = (const float*)a->in[23] + l * 2048;
    constexpr int NCH = SEQ / 16;
    for (int pr = F.bid; pr < BATCH * A_HEADS / 2; pr += F.G) { const int bh0 = 2 * pr;
        const int role = F.wave >> 1, hb = F.wave & 1, bh = bh0 + hb, b = bh >> 5, hh = bh & 31, ch = hh * 64 + lane;
        LAS unsigned char* blk = F.lds + hb * BH_SZ;
        HeadPrm P; P.w0 = pw0[ch]; P.a0 = pa0[ch]; P.v0 = l ? pv0[ch] : 0.f; P.kk = pkk[ch]; P.ka = pka[ch]; P.rk = prk[ch]; P.lnw = plw[ch]; P.lnb = plb[ch];
        const size_t rowb = (size_t)b * SEQ; const int c16 = lane & 15, g = lane >> 4;
#define CK_BAR() do { asm volatile("s_waitcnt lgkmcnt(0)" ::: "memory"); __builtin_amdgcn_s_barrier(); asm volatile("" ::: "memory"); } while (0)
#define CK_LOAD(cc, hf, SET) do { _Pragma("unroll") for (int t = 0; t < 8; ++t) { const size_t o = (rowb + (size_t)(cc) * 16 + 8 * (hf) + t) * 2048 + ch; \
                SET##r[t] = R[o]; SET##k[t] = K[o]; SET##v[t] = V[o]; SET##z[t] = Z[o]; SET##w[t] = DW[o]; SET##a[t] = DA[o]; if (l) { SET##d[t] = DV[o]; SET##f[t] = VF[o]; } if (hf) SET##e[t] = DW[o - (size_t)8 * 2048]; } } while (0)
#define CK_PREP(cc, hf, SET) do { LAS unsigned char* ob = blk + BH_OPB + ((cc) & 1) * CK_OPB; LAS unsigned char* rg = blk + BH_RING + ((cc) % 3) * RG_SZ; float Pc = 1.0f; \
            if (hf) { _Pragma("unroll") for (int tt = 0; tt < 8; ++tt) Pc *= __builtin_amdgcn_exp2f(-0.8750387749f * fsig(P.w0 + bflo((unsigned)SET##e[tt]))); } \
            _Pragma("unroll") for (int tt = 0; tt < 8; ++tt) { const int t = 8 * (hf) + tt; const float r_ = bflo((unsigned)SET##r[tt]), k_ = bflo((unsigned)SET##k[tt]), dw_ = bflo((unsigned)SET##w[tt]), da_ = bflo((unsigned)SET##a[tt]); float vv = bflo((unsigned)SET##v[tt]); \
                const float ia = fsig(P.a0 + da_), w = __builtin_amdgcn_exp2f(-0.8750387749f * fsig(P.w0 + dw_)); if (l) vv = vv + (bflo((unsigned)SET##f[tt]) - vv) * fsig(P.v0 + bflo((unsigned)SET##d[tt])); \
                const float kk = k_ * P.kk, n2 = wave_sum_fast(kk * kk), q = kk * __builtin_amdgcn_rsqf(fmaxf(n2, 1e-24f)), kp = k_ * (1.0f + (ia - 1.0f) * P.ka), bon = wave_sum_fast(r_ * kp * P.rk); \
                const float Pm1 = Pc; Pc *= w; const float rp = frcp(Pc); \
                ((LAS bf16*)(ob + CK_AT + t * CK_TP))[lane] = tobf(-q * Pm1); ((LAS bf16*)(ob + CK_RT + t * CK_TP))[lane] = tobf(r_ * Pc); \
                const bf16 bq = tobf(q * ia * rp), kq = tobf(kp * rp), vq = tobf(vv); \
                ((LAS bf16*)(ob + CK_BH + t * CK_TP))[lane] = bq; ((LAS bf16*)(ob + CK_KH + t * CK_TP))[lane] = kq; \
                ((LAS bf16*)(ob + CK_BHT + lane * CK_KP))[t] = bq; ((LAS bf16*)(ob + CK_KHT + lane * CK_KP))[t] = kq; ((LAS bf16*)(ob + CK_VT + lane * CK_KP))[t] = vq; \
                ((LAS bf16*)(rg + RG_VP))[t * 64 + lane] = vq; ((LAS bf16*)(rg + RG_Z))[t * 64 + lane] = SET##z[tt]; if (lane == 0) ((LAS float*)(rg + RG_BON))[t] = bon; } \
            if ((hf) == 1) ((LAS float*)(ob + CK_PC))[lane] = Pc; } while (0)
#define CK_POST(cc) do { const LAS unsigned char* rg = blk + BH_RING + ((cc) % 3) * RG_SZ; const LAS float* yb = (const LAS float*)(blk + BH_Y + ((cc) & 1) * 4096); \
            _Pragma("unroll 4") for (int t = 0; t < 16; ++t) { const float y = yb[t * 64 + lane], vp = bflo((unsigned)((const LAS bf16*)(rg + RG_VP))[t * 64 + lane]), z = bflo((unsigned)((const LAS bf16*)(rg + RG_Z))[t * 64 + lane]), bon = ((const LAS float*)(rg + RG_BON))[t]; \
                G[(rowb + (size_t)(cc) * 16 + t) * 2048 + ch] = (bf16)f2bf(fs_post_one(P, y, vp, z, bon)); } } while (0)
        typedef unsigned short us2 __attribute__((ext_vector_type(2)));
        if (role == 0) { f32x4 ST[4][4];
#pragma unroll
            for (int i = 0; i < 4; ++i)
#pragma unroll
                for (int j = 0; j < 4; ++j) ST[i][j] = (f32x4){0.f, 0.f, 0.f, 0.f};
            CK_BAR();
            for (int c = 0; c < NCH; ++c) { ck_scan_chunk(ST, blk + BH_OPB + (c & 1) * CK_OPB, (LAS float*)(blk + BH_Y + (c & 1) * 4096), c16, g); CK_BAR(); }
            float* so = F.out + O_WKVP + ((size_t)(l * BATCH + b) * A_HEADS + hh) * 4096;
#pragma unroll
            for (int ki = 0; ki < 4; ++ki)
#pragma unroll
                for (int vi = 0; vi < 4; ++vi) *(f32x4*)(so + (16 * vi + c16) * 64 + 16 * ki + 4 * g) = ST[ki][vi]; }
        else if (role == 1 || role == 3) { const int hf = role == 3;
            bf16 Ar[8], Ak[8], Av[8], Az[8], Aw[8], Aa[8], Ad[8], Af[8], Ae[8], Br[8], Bk[8], Bv[8], Bz[8], Bw[8], Ba[8], Bd[8], Bf[8], Be[8];
#pragma unroll
            for (int t = 0; t < 8; ++t) { Ad[t] = 0; Af[t] = 0; Ae[t] = 0; Bd[t] = 0; Bf[t] = 0; Be[t] = 0; }
            CK_LOAD(0, hf, A); CK_LOAD(1, hf, B); CK_PREP(0, hf, A); CK_LOAD(2, hf, A); CK_BAR();
            for (int c = 0; c < NCH; c += 2) {
                if (c + 1 < NCH) { CK_PREP(c + 1, hf, B); if (c + 3 < NCH) CK_LOAD(c + 3, hf, B); } CK_BAR();
                if (c + 2 < NCH) { CK_PREP(c + 2, hf, A); if (c + 4 < NCH) CK_LOAD(c + 4, hf, A); } CK_BAR(); } }
        else if (role == 2) { CK_BAR();
            for (int c = 0; c < NCH; ++c) { if (c >= 1) CK_POST(c - 1); CK_BAR(); } }
        if (role == 2) CK_POST(NCH - 1);
        __syncthreads();
#undef CK_PREP
#undef CK_LOAD
#undef CK_BAR
#undef CK_POST
    }
    const float* stt = (const float*)a->in[2] + (size_t)l * DEC_BATCH * A_HEADS * 4096;
    LAS float* sop = (LAS float*)(F.lds + F.wave * 2048);
    for (int it = F.gw; it < DEC_BATCH * A_HEADS; it += F.NGW) { const int b = it >> 5, hh = it & 31, ch = hh * 64 + lane; const size_t o = (size_t)(MP + b) * 2048 + ch;
        HeadPrm P; P.w0 = pw0[ch]; P.a0 = pa0[ch]; P.v0 = l ? pv0[ch] : 0.f; P.kk = pkk[ch]; P.ka = pka[ch]; P.rk = prk[ch]; P.lnw = plw[ch]; P.lnb = plb[ch];
        const float z = ldbf(Z + o); float bon;
        fs_prep_one(P, l, ldbf(R + o), ldbf(K + o), ldbf(V + o), ldbf(DW + o), ldbf(DA + o), l ? ldbf(DV + o) : 0.f, l ? ldbf(VF + o) : 0.f, sop, lane, bon);
        LDS_WAIT(); asm volatile("" ::: "memory");
        f32x2 S[32]; const float* si = stt + (size_t)it * 4096 + lane * 64;
#pragma unroll
        for (int k = 0; k < 32; k += 2) { const f32x4 v = *(const f32x4*)(si + 2 * k); S[k] = (f32x2){v.x, v.y}; S[k + 1] = (f32x2){v.z, v.w}; }
        const float y = wkv_step_lds(S, sop, lane), vp = sop[320 + lane];
        float* so = F.out + O_WKVS + ((size_t)l * DEC_BATCH * A_HEADS + it) * 4096 + lane * 64;
#pragma unroll
        for (int k = 0; k < 32; k += 2) *(f32x4*)(so + 2 * k) = (f32x4){S[k].x, S[k].y, S[k + 1].x, S[k + 1].y};
        G[o] = (bf16)f2bf(fs_post_one(P, y, vp, z, bon));
        LDS_WAIT(); asm volatile("" ::: "memory");
    }
#undef FS_PREP
#undef FS_POST
}

__device__ __forceinline__ void final_norm(Frame& F, cargs a) {
    const float* X = (const float*)(F.ws + WS_X); f32x4 w4[4]; load_row((const float*)a->in[35], LANE, w4);
    for (int m = F.gw; m < MP + DEC_BATCH; m += F.NGW) { f32x4 x[4]; load_row(X + (size_t)m * 1024, LANE, x); const float rs = row_rs(x);
        float* o = m < MP ? F.out + O_YP + (size_t)m * 1024 : F.out + O_YS + (size_t)(m - MP) * 1024;
#pragma unroll
        for (int j = 0; j < 4; ++j) ((f32x4*)o)[LANE + 64 * j] = x[j] * rs * w4[j]; }
}
__device__ __forceinline__ void b0c_kvpost(Frame& F, cargs a) {
    unsigned char* ws = F.ws; const float* KVR = (const float*)(ws + WS_KVR); bf16* CK = (bf16*)(ws + WS_CKVB); bf16* KP = (bf16*)(ws + WS_KPEB); const float* ROPE = (const float*)(ws + WS_ROPE);
    const f32x4 w4 = ((const f32x4*)a->in[27])[F.lane];
    for (int m = F.gw; m < MP + DEC_BATCH; m += F.NGW) { const float* row = KVR + (size_t)m * 320;
        const f32x4 v = ((const f32x4*)row)[F.lane]; const float ss = wave_sum((v.x * v.x + v.y * v.y) + (v.z * v.z + v.w * v.w));
        const float rs = 1.0f / sqrtf(ss * (1.0f / 256.0f) + NORM_EPS); const f32x4 c = v * rs * w4;
        float* oc = m < MP ? F.out + O_CKVP + (size_t)m * 256 : F.out + O_CKVS + (size_t)(m - MP) * 256; float* ok = m < MP ? F.out + O_KPEP + (size_t)m * 64 : F.out + O_KPES + (size_t)(m - MP) * 64;
        ((f32x4*)oc)[F.lane] = c; v2u pw; pw.x = pk2(c.x, c.y); pw.y = pk2(c.z, c.w); *(v2u*)(CK + (size_t)m * 256 + 4 * F.lane) = pw;
        if (F.lane < 32) { const int i = F.lane, p = m < MP ? (m & (SEQ - 1)) : SEQ; const float x1 = row[256 + i], x2 = row[288 + i], cs = ROPE[(p * 32 + i) * 2], sn = ROPE[(p * 32 + i) * 2 + 1];
            const float o1 = x1 * cs - x2 * sn, o2 = x2 * cs + x1 * sn; ok[i] = o1; ok[32 + i] = o2; KP[(size_t)m * 64 + i] = (bf16)f2bf(o1); KP[(size_t)m * 64 + 32 + i] = (bf16)f2bf(o2); }
    }
}
__device__ __forceinline__ void b1c_cq(Frame& F, cargs a, int l) {
    unsigned char* ws = F.ws; const float* QL = (const float*)(ws + WS_QL); bf16* CQ = (bf16*)(ws + WS_CQ); const float* w = (const float*)a->in[32] + l * 384;
    f32x2 w2[3];
#pragma unroll
    for (int j = 0; j < 3; ++j) w2[j] = *(const f32x2*)(w + 2 * F.lane + 128 * j);
    for (int m = F.gw; m < MT; m += F.NGW) { f32x2 v[3]; float ss = 0.f;
#pragma unroll
        for (int j = 0; j < 3; ++j) { v[j] = *(const f32x2*)(QL + (size_t)m * 384 + 2 * F.lane + 128 * j); ss += v[j].x * v[j].x + v[j].y * v[j].y; }
        const float rs = 1.0f / sqrtf(wave_sum(ss) * (1.0f / 384.0f) + NORM_EPS);
#pragma unroll
        for (int j = 0; j < 3; ++j) *(unsigned*)(CQ + (size_t)m * 384 + 2 * F.lane + 128 * j) = pk2(v[j].x * rs * w2[j].x, v[j].y * rs * w2[j].y); }
}
__device__ __forceinline__ void b1e_qpost(Frame& F, cargs a) {
    unsigned char* ws = F.ws; const bf16* QR = (const bf16*)(ws + WS_QR); bf16* Q = (bf16*)(ws + WS_Q); const float* ROPE = (const float*)(ws + WS_ROPE); const float SC = ATTN_SCALE * LOG2E;
    for (int m = F.gw; m < MP + DEC_BATCH; m += F.NGW) { const bf16* row = QR + (size_t)m * 3072; bf16* qo = Q + (size_t)m * 3072; const int p = m < MP ? (m & (SEQ - 1)) : SEQ;
#pragma unroll
        for (int j = 0; j < 8; ++j) { const int idx = F.lane + 64 * j, hd = idx >> 5, c4 = idx & 31; const v2u u = *(const v2u*)(row + hd * 192 + 4 * c4);
            v2u w; w.x = pk2(bflo(u.x) * SC, bfhi(u.x) * SC); w.y = pk2(bflo(u.y) * SC, bfhi(u.y) * SC); *(v2u*)(qo + hd * 192 + 4 * c4) = w; }
#pragma unroll
        for (int j = 0; j < 8; ++j) { const int pid = F.lane + 64 * j, hd = pid >> 5, i = pid & 31; const float x1 = bflo((unsigned)row[hd * 192 + 128 + i]), x2 = bflo((unsigned)row[hd * 192 + 160 + i]), cs = ROPE[(p * 32 + i) * 2], sn = ROPE[(p * 32 + i) * 2 + 1];
            qo[hd * 192 + 128 + i] = (bf16)f2bf((x1 * cs - x2 * sn) * SC); qo[hd * 192 + 160 + i] = (bf16)f2bf((x2 * cs + x1 * sn) * SC); }
    }
    const float* wuk = (const float*)a->in[28]; bf16* QA = (bf16*)(ws + WS_QABS);
    for (int it = F.gw; it < DEC_BATCH * B_HEADS; it += F.NGW) { const int b = it >> 4, hd = it & 15; const bf16* qn = QR + (size_t)(MP + b) * 3072 + hd * 192;
        float acc[4] = {0.f, 0.f, 0.f, 0.f};
        for (int n = 0; n < 128; n += 4) { const v2u qu = *(const v2u*)(qn + n); const f32x4 q4 = (f32x4){bflo(qu.x), bfhi(qu.x), bflo(qu.y), bfhi(qu.y)};
#pragma unroll
            for (int cc = 0; cc < 4; ++cc) { const f32x4 w4 = *(const f32x4*)(wuk + (size_t)(4 * F.lane + cc) * 2048 + hd * 128 + n); acc[cc] += (q4.x * w4.x + q4.y * w4.y) + (q4.z * w4.z + q4.w * w4.w); } }
        v2u w; w.x = pk2(acc[0] * SC, acc[1] * SC); w.y = pk2(acc[2] * SC, acc[3] * SC); *(v2u*)(QA + (size_t)it * 320 + 4 * F.lane) = w;
        if (F.lane < 32) { const int i = F.lane; const float x1 = bflo((unsigned)qn[128 + i]), x2 = bflo((unsigned)qn[160 + i]), cs = ROPE[(SEQ * 32 + i) * 2], sn = ROPE[(SEQ * 32 + i) * 2 + 1];
            QA[(size_t)it * 320 + 256 + i] = (bf16)f2bf((x1 * cs - x2 * sn) * SC); QA[(size_t)it * 320 + 288 + i] = (bf16)f2bf((x2 * cs + x1 * sn) * SC); }
    }
}

constexpr int AT_KP = 400, AT_VP = 136, AT_KBYTES = 64 * AT_KP, AT_VBYTES = 128 * AT_VP;
__device__ __forceinline__ int crow(int r, int hi) { return (r & 3) + 8 * (r >> 2) + 4 * hi; }
__device__ __forceinline__ bf16x8 pack8f(float a0, float a1, float a2, float a3, float a4, float a5, float a6, float a7) {
    v4u w; w.x = pk2(a0, a1); w.y = pk2(a2, a3); w.z = pk2(a4, a5); w.w = pk2(a6, a7); return __builtin_bit_cast(bf16x8, w); }
__device__ __forceinline__ void attn_unit(Frame& F, int b, int hd, int qb) {
    unsigned char* ws = F.ws; const bf16* Q = (const bf16*)(ws + WS_Q); const bf16* KN = (const bf16*)(ws + WS_KN); const bf16* KPE = (const bf16*)(ws + WS_KPEB); const bf16* VT = (const bf16*)(ws + WS_VT);
    const bf16* Z = (const bf16*)(ws + WS_Z); bf16* G = (bf16*)(ws + WS_G);
    LAS unsigned char* Ks = F.lds; LAS unsigned char* Vs = F.lds + AT_KBYTES;
    const int lane = lane_id(), r32 = lane & 31, hi = lane >> 5, tid = F.wave * 64 + lane;
    const int qpos = qb * 256 + F.wave * 32 + r32; const size_t qrow = (size_t)b * SEQ + qpos;
    bf16x8 qf[12];
#pragma unroll
    for (int s = 0; s < 12; ++s) qf[s] = *(const bf16x8*)(Q + qrow * 3072 + hd * 192 + 16 * s + 8 * hi);
    f32x16 o[4];
#pragma unroll
    for (int d = 0; d < 4; ++d)
#pragma unroll
        for (int r = 0; r < 16; ++r) o[d][r] = 0.f;
    float mrow = -1e30f, lrow = 0.f;
    const int ntiles = 4 * qb + 4, wq0 = qb * 256 + F.wave * 32;
    v4u pk_[3], pv_[2];
#define AT_FETCH(kt_) do { const size_t krow0 = (size_t)b * SEQ + (kt_) * 64; \
        _Pragma("unroll") for (int i = 0; i < 3; ++i) { const int c = tid + 512 * i, key = c / 24, ch = c % 24; \
            pk_[i] = ch < 16 ? *(const v4u*)(KN + (krow0 + key) * 2048 + hd * 128 + ch * 8) : *(const v4u*)(KPE + (krow0 + key) * 64 + (ch - 16) * 8); } \
        _Pragma("unroll") for (int i = 0; i < 2; ++i) { const int c = tid + 512 * i, d = c >> 3, ch = c & 7; pv_[i] = *(const v4u*)(VT + (size_t)(hd * 128 + d) * MP + krow0 + ch * 8); } } while (0)
    AT_FETCH(0);
    for (int kt = 0; kt < ntiles; ++kt) {
        __syncthreads();
#pragma unroll
        for (int i = 0; i < 3; ++i) { const int c = tid + 512 * i, key = c / 24, ch = c % 24; *(LAS v4u*)(Ks + key * AT_KP + ch * 16) = pk_[i]; }
#pragma unroll
        for (int i = 0; i < 2; ++i) { const int c = tid + 512 * i, d = c >> 3, ch = c & 7; *(LAS v2u*)(Vs + d * AT_VP + ch * 16) = (v2u){pv_[i].x, pv_[i].y}; *(LAS v2u*)(Vs + d * AT_VP + ch * 16 + 8) = (v2u){pv_[i].z, pv_[i].w}; }
        __syncthreads();
        if (kt + 1 < ntiles) AT_FETCH(kt + 1);
        if (kt * 64 > wq0 + 31) continue;
        f32x16 s0, s1;
#pragma unroll
        for (int r = 0; r < 16; ++r) { s0[r] = 0.f; s1[r] = 0.f; }
#pragma unroll
        for (int s = 0; s < 12; ++s) { const bf16x8 a0 = *(const LAS bf16x8*)(Ks + r32 * AT_KP + (16 * s + 8 * hi) * 2), a1 = *(const LAS bf16x8*)(Ks + (32 + r32) * AT_KP + (16 * s + 8 * hi) * 2);
            s0 = __builtin_amdgcn_mfma_f32_32x32x16_bf16(a0, qf[s], s0, 0, 0, 0); s1 = __builtin_amdgcn_mfma_f32_32x32x16_bf16(a1, qf[s], s1, 0, 0, 0); }
        if (kt * 64 + 63 > wq0) {
#pragma unroll
            for (int r = 0; r < 16; ++r) { const int key = kt * 64 + crow(r, hi); if (key > qpos) s0[r] = -__builtin_inff(); if (key + 32 > qpos) s1[r] = -__builtin_inff(); } }
        float tmax = s0[0];
#pragma unroll
        for (int r = 1; r < 16; ++r) tmax = fmaxf(tmax, s0[r]);
#pragma unroll
        for (int r = 0; r < 16; ++r) tmax = fmaxf(tmax, s1[r]);
        tmax = xor32_max(tmax);
        const float mnew = fmaxf(mrow, tmax), alpha = __builtin_amdgcn_exp2f(mrow - mnew); mrow = mnew;
        float ps = 0.f;
#pragma unroll
        for (int r = 0; r < 16; ++r) { s0[r] = __builtin_amdgcn_exp2f(s0[r] - mnew); s1[r] = __builtin_amdgcn_exp2f(s1[r] - mnew); ps += s0[r] + s1[r]; }
        lrow = lrow * alpha + ps;
#pragma unroll
        for (int d = 0; d < 4; ++d)
#pragma unroll
            for (int r = 0; r < 16; ++r) o[d][r] *= alpha;
        bf16x8 pb[4];
        pb[0] = pack8f(s0[0], s0[1], s0[2], s0[3], s0[4], s0[5], s0[6], s0[7]); pb[1] = pack8f(s0[8], s0[9], s0[10], s0[11], s0[12], s0[13], s0[14], s0[15]);
        pb[2] = pack8f(s1[0], s1[1], s1[2], s1[3], s1[4], s1[5], s1[6], s1[7]); pb[3] = pack8f(s1[8], s1[9], s1[10], s1[11], s1[12], s1[13], s1[14], s1[15]);
#pragma unroll
        for (int ks = 0; ks < 4; ++ks)
#pragma unroll
            for (int d = 0; d < 4; ++d) { const LAS unsigned char* vp = Vs + (32 * d + r32) * AT_VP + (16 * ks + 4 * hi) * 2;
                const v2u lo = *(const LAS v2u*)vp, hi2 = *(const LAS v2u*)(vp + 16); const v4u av = (v4u){lo.x, lo.y, hi2.x, hi2.y};
                o[d] = __builtin_amdgcn_mfma_f32_32x32x16_bf16(__builtin_bit_cast(bf16x8, av), pb[ks], o[d], 0, 0, 0); }
    }
#undef AT_FETCH
    lrow = xor32_sum(lrow); const float inv = 1.0f / lrow;
#pragma unroll
    for (int d = 0; d < 4; ++d)
#pragma unroll
        for (int rg = 0; rg < 4; ++rg) { const int dd = 32 * d + 8 * rg + 4 * hi; const size_t off = qrow * 2048 + hd * 128 + dd;
            const v2u zz = *(const v2u*)(Z + off); const float z0 = bflo(zz.x), z1 = bfhi(zz.x), z2 = bflo(zz.y), z3 = bfhi(zz.y);
            v2u w; w.x = pk2(o[d][4 * rg] * inv * (z0 * sigmoidf_(z0)), o[d][4 * rg + 1] * inv * (z1 * sigmoidf_(z1))); w.y = pk2(o[d][4 * rg + 2] * inv * (z2 * sigmoidf_(z2)), o[d][4 * rg + 3] * inv * (z3 * sigmoidf_(z3)));
            *(v2u*)(G + off) = w; }
}
__device__ __forceinline__ void b2a_attn_prompt(Frame& F) {
    const int vcu = (F.G % 8 == 0) ? (F.bid % 8) * (F.G / 8) + F.bid / 8 : F.bid;
    for (int u = vcu; u < BATCH * B_HEADS * 4; u += F.G) { const int bh = u >> 2, qp = u & 3;
        for (int hf = 0; hf < 2; ++hf) attn_unit(F, bh >> 4, bh & 15, hf ? qp : 7 - qp); }
    __syncthreads();
}

constexpr int DT_P = 656;
typedef short v4i16_t __attribute__((ext_vector_type(4)));
__device__ __forceinline__ void b2b_attn_sample(Frame& F, cargs a) {
    unsigned char* ws = F.ws; const float* cckv = (const float*)a->in[4]; const float* ckpe = (const float*)a->in[5]; const int* ptab = (const int*)a->in[6];
    const bf16* QA = (const bf16*)(ws + WS_QABS); float* OP = (float*)(ws + WS_OPART); float* ML = (float*)(ws + WS_ML);
    LAS unsigned char* T = F.lds;
    F.lane = lane_id();
    const int lane = F.lane, hcol = lane & 15, g = lane >> 4, tid = F.wave * 64 + lane, q4 = (lane & 15) >> 2, p4 = lane & 3;
    for (int u = F.bid; u < DEC_BATCH * 8; u += F.G) { const int b = u >> 3, sp = u & 7;
        bf16x8 qf[10];
#pragma unroll
        for (int s = 0; s < 10; ++s) qf[s] = *(const bf16x8*)(QA + (size_t)(b * 16 + hcol) * 320 + 32 * s + 8 * g);
        f32x4 o[2]; o[0] = (f32x4){0.f, 0.f, 0.f, 0.f}; o[1] = o[0]; float mrow = -1e30f, lrow = 0.f;
        f32x4 pf_[10];
#define DT_FETCH(t_) do { const int pp = ptab[b * NPAGES + sp * 8 + ((t_) >> 1)], tok0 = ((t_) & 1) * 64; \
            _Pragma("unroll") for (int i = 0; i < 10; ++i) { const int c = tid + 512 * i, key = c / 80, ch = c % 80; const size_t tk = (size_t)pp * PAGE + tok0 + key; \
                pf_[i] = ch < 64 ? *(const f32x4*)(cckv + tk * 256 + ch * 4) : *(const f32x4*)(ckpe + tk * 64 + (ch - 64) * 4); } } while (0)
        DT_FETCH(0);
        for (int t = 0; t < 16; ++t) {
            __syncthreads();
#pragma unroll
            for (int i = 0; i < 10; ++i) { const int c = tid + 512 * i, key = c / 80, ch = c % 80; *(LAS v2u*)(T + key * DT_P + ch * 8) = (v2u){pk2(pf_[i].x, pf_[i].y), pk2(pf_[i].z, pf_[i].w)}; }
            __syncthreads();
            if (t + 1 < 16) DT_FETCH(t + 1);
            f32x4 sc[4];
#pragma unroll
            for (int kg = 0; kg < 4; ++kg) { sc[kg] = (f32x4){0.f, 0.f, 0.f, 0.f};
#pragma unroll
                for (int s = 0; s < 10; ++s) { const bf16x8 kf = *(const LAS bf16x8*)(T + (16 * kg + hcol) * DT_P + (32 * s + 8 * g) * 2);
                    sc[kg] = __builtin_amdgcn_mfma_f32_16x16x32_bf16(kf, qf[s], sc[kg], 0, 0, 0); } }
            float tmax = sc[0][0];
#pragma unroll
            for (int kg = 0; kg < 4; ++kg)
#pragma unroll
                for (int r = 0; r < 4; ++r) tmax = fmaxf(tmax, sc[kg][r]);
            tmax = fmaxf(tmax, swz_xor<16>(tmax)); tmax = xor32_max(tmax);
            const float mnew = fmaxf(mrow, tmax), alpha = __builtin_amdgcn_exp2f(mrow - mnew); mrow = mnew;
            float ps = 0.f;
#pragma unroll
            for (int kg = 0; kg < 4; ++kg)
#pragma unroll
                for (int r = 0; r < 4; ++r) { sc[kg][r] = __builtin_amdgcn_exp2f(sc[kg][r] - mnew); ps += sc[kg][r]; }
            lrow = lrow * alpha + ps; o[0] *= alpha; o[1] *= alpha;
#pragma unroll
            for (int kk = 0; kk < 2; ++kk) { const bf16x8 pbf = pack8f(sc[2 * kk][0], sc[2 * kk][1], sc[2 * kk][2], sc[2 * kk][3], sc[2 * kk + 1][0], sc[2 * kk + 1][1], sc[2 * kk + 1][2], sc[2 * kk + 1][3]);
#pragma unroll
                for (int ci = 0; ci < 2; ++ci) { const int cb = 2 * F.wave + ci; LAS unsigned char* ap = T + (32 * kk + 4 * g + q4) * DT_P + (16 * cb + 4 * p4) * 2;
                    const s16x4 lo = __builtin_bit_cast(s16x4, __builtin_amdgcn_ds_read_tr16_b64_v4i16((LAS v4i16_t*)ap)), hi2 = __builtin_bit_cast(s16x4, __builtin_amdgcn_ds_read_tr16_b64_v4i16((LAS v4i16_t*)(ap + 16 * DT_P)));
                    const bf16x8 av = (bf16x8){lo[0], lo[1], lo[2], lo[3], hi2[0], hi2[1], hi2[2], hi2[3]};
                    o[ci] = __builtin_amdgcn_mfma_f32_16x16x32_bf16(av, pbf, o[ci], 0, 0, 0); } }
        }
#undef DT_FETCH
        lrow += swz_xor<16>(lrow); lrow = xor32_sum(lrow);
        const size_t pb_ = (size_t)(b * 8 + sp) * 16 + hcol;
#pragma unroll
        for (int ci = 0; ci < 2; ++ci) *(f32x4*)(OP + pb_ * 256 + 16 * (2 * F.wave + ci) + 4 * g) = o[ci];
        if (F.wave == 0 && g == 0) { ML[pb_ * 2] = mrow; ML[pb_ * 2 + 1] = lrow; }
    }
    __syncthreads();
}
__device__ __forceinline__ void b2c_combine(Frame& F, cargs a) {
    unsigned char* ws = F.ws; const bf16* QA = (const bf16*)(ws + WS_QABS); const float* OP = (const float*)(ws + WS_OPART); const float* ML = (const float*)(ws + WS_ML);
    const float* wuv = (const float*)a->in[29]; const bf16* Z = (const bf16*)(ws + WS_Z); bf16* G = (bf16*)(ws + WS_G);
    LAS float* scr = (LAS float*)(F.lds + F.wave * 1024);
    for (int it = F.gw; it < DEC_BATCH * B_HEADS; it += F.NGW) { const int b = it >> 4, hd = it & 15; const int lane = F.lane;
        const float* cn = F.out + O_CKVS + (size_t)b * 256; const float* kn = F.out + O_KPES + (size_t)b * 64; const bf16* qa = QA + (size_t)it * 320;
        const f32x4 c4 = *(const f32x4*)(cn + 4 * lane); const v2u qv = *(const v2u*)(qa + 4 * lane);
        float sn = (bflo(qv.x) * c4.x + bfhi(qv.x) * c4.y) + (bflo(qv.y) * c4.z + bfhi(qv.y) * c4.w);
        sn += __builtin_bit_cast(float, (unsigned)qa[256 + lane] << 16) * kn[lane];
        sn = wave_sum(sn);
        float ms[8], ls[8], M = sn;
#pragma unroll
        for (int s = 0; s < 8; ++s) { ms[s] = ML[((size_t)(b * 8 + s) * 16 + hd) * 2]; ls[s] = ML[((size_t)(b * 8 + s) * 16 + hd) * 2 + 1]; M = fmaxf(M, ms[s]); }
        const float en = __builtin_amdgcn_exp2f(sn - M); float L = en; f32x4 acc = c4 * en;
#pragma unroll
        for (int s = 0; s < 8; ++s) { const float e = __builtin_amdgcn_exp2f(ms[s] - M); L += e * ls[s]; acc += *(const f32x4*)(OP + ((size_t)(b * 8 + s) * 16 + hd) * 256 + 4 * lane) * e; }
        acc *= 1.0f / L;
        *(LAS f32x4*)(scr + 4 * lane) = acc; LDS_WAIT(); asm volatile("" ::: "memory");
        f32x2 ov = (f32x2){0.f, 0.f};
        for (int c = 0; c < 256; ++c) { const float ol = scr[c]; ov += *(const f32x2*)(wuv + (size_t)c * 2048 + hd * 128 + 2 * lane) * ol; }
        const size_t off = (size_t)(MP + b) * 2048 + hd * 128 + 2 * lane; const unsigned zz = *(const unsigned*)(Z + off); const float z0 = bflo(zz), z1 = bfhi(zz);
        *(unsigned*)(G + off) = pk2(ov.x * (z0 * sigmoidf_(z0)), ov.y * (z1 * sigmoidf_(z1)));
        LDS_WAIT(); asm volatile("" ::: "memory");
    }
}
#ifndef MK_SPLIT
#define MK_SPLIT 0
#endif
#ifndef MK_DIAG
#define MK_DIAG 0
#endif
constexpr int NPHASES = 1 + 2 * 5 + 4 + 2 * 8 + 1 + (MK_DIAG ? 1 : 0);
#define PH_BEGIN if (ph >= lo && ph < hi) { cargs ap = (cargs)__builtin_amdgcn_kernarg_segment_ptr(); asm volatile("" : "+s"(ap)); Frame F = make_frame(ap, wave0, (LAS unsigned char*)lds); unsigned char* ws = F.ws;
#define PH_END } if (ph >= lo && ph + 1 < hi) xcd_barrier(bar); ++ph;
typedef pg8::StaticOrder SO;
#define GEMM_B(ACT_, A_, Bt_, M_, N_, K_, O_, ldc_, nvalid_, nstore_) do { pg8::Gemm g_{(const pg8::bf16_t*)(A_), (const pg8::bf16_t*)(Bt_), (M_), (N_), (K_)}; SO S_; S_.init((M_), (N_), F.G, F.bid); \
    pg8::EpiB<ACT_> E_{(pg8::bf16_t*)(O_), (ldc_), (nvalid_), (nstore_)}; pg8::gemm_phase<pg8::EpiB<ACT_>, SO, true, true>(F.lds, g_, S_, E_, F.wave); } while (0)
#define GEMM_F(ACT_, HB_, HBI_, A_, Bt_, M_, N_, K_, O_, base_, bias_, ldc_, nstore_) do { int kk_ = (K_); asm volatile("" : "+s"(kk_)); pg8::Gemm g_{(const pg8::bf16_t*)(A_), (const pg8::bf16_t*)(Bt_), (M_), (N_), kk_}; SO S_; S_.init((M_), (N_), F.G, F.bid); \
    pg8::EpiF<ACT_, HB_, HBI_> E_{(float*)(O_), (const float*)(base_), (const float*)(bias_), (ldc_), (nstore_)}; pg8::gemm_phase<pg8::EpiF<ACT_, HB_, HBI_>, SO, true, true>(F.lds, g_, S_, E_, F.wave); } while (0)

__global__ void __launch_bounds__(NTHR, 2) mk_fwd(Args args) {
    extern __shared__ __attribute__((aligned(16))) unsigned char lds[];
    const int wave0 = __builtin_amdgcn_readfirstlane(threadIdx.x >> 6);
    for (int u = threadIdx.x; u < (LDS_BYTES - LDSCTL_OFF) / 4; u += NTHR) ((LAS unsigned*)(lds + LDSCTL_OFF))[u] = 0u;
    __syncthreads();
    XcdBarrier bar = xcd_barrier_post((unsigned*)(args.ws + WS_CTL) + CW_BAR + args.li * XCD_BAR_WORDS, (volatile LAS unsigned*)((LAS unsigned char*)lds + LDSCTL_OFF), (unsigned)wave0);
    int ph = 0; const int lo = args.ph_lo, hi = args.ph_hi;

    PH_BEGIN p0_prologue(F, ap); PH_END

    for (int l = 0; l < 2; ++l) {
        PH_BEGIN a1_prepass(F, ap, l); PH_END
        PH_BEGIN
            { static_assert(AM_STRIDE == (size_t)130 * 256 * 1024 * 2, "A-operand buffers sit 130 row panels apart");
              pg8::Gemm g_{(const pg8::bf16_t*)(ws + WS_AM), (const pg8::bf16_t*)(ws + WS_WIN + (size_t)(l * 4) * 4 * MiB), MT, 2048, 1024}; pg8::GroupOrder4 S_; S_.init(MT, 2048, F.G, F.bid);
              pg8::EpiB4 E_{{(pg8::bf16_t*)(ws + WS_R), (pg8::bf16_t*)(ws + WS_K), (pg8::bf16_t*)(ws + (l ? WS_V1 : WS_V0)), (pg8::bf16_t*)(ws + WS_Z)}};
              pg8::gemm_phase<pg8::EpiB4, pg8::GroupOrder4, true, true>(F.lds, g_, S_, E_, F.wave); }
            GEMM_B(1, ws + WS_AM + 4 * AM_STRIDE, ws + WS_W1 + (size_t)l * (MiB / 2), MT, 256, 1024, ws + WS_LW, 128, 64, 128);
            GEMM_B(0, ws + WS_AM + 5 * AM_STRIDE, ws + WS_W1 + (size_t)(2 + l) * (MiB / 2), MT, 256, 1024, ws + WS_LA, 128, 64, 128);
            if (l) GEMM_B(0, ws + WS_AM + 2 * AM_STRIDE, ws + WS_W1 + (size_t)4 * (MiB / 2), MT, 256, 1024, ws + WS_LV, 128, 32, 128);
        PH_END
        PH_BEGIN
            GEMM_B(0, ws + WS_LW, ws + WS_W2 + (size_t)l * (MiB / 2), MT, 2048, 128, ws + WS_WD, 2048, 2048, 2048);
            GEMM_B(0, ws + WS_LA, ws + WS_W2 + (size_t)(2 + l) * (MiB / 2), MT, 2048, 128, ws + WS_IA, 2048, 2048, 2048);
            if (l) GEMM_B(0, ws + WS_LV, ws + WS_W2 + (size_t)4 * (MiB / 2), MT, 2048, 128, ws + WS_VG, 2048, 2048, 2048);
        PH_END
        PH_BEGIN a5_fused(F, ap, l); PH_END
        PH_BEGIN
            GEMM_F(0, true, false, ws + WS_G, ws + WS_WO + (size_t)l * 4 * MiB, MT, 1024, 2048, ws + WS_X, ws + WS_X, nullptr, 1024, 1024);
        PH_END
    }

    PH_BEGIN norm_rows_bf16(F, (const float*)(ws + WS_X), (const float*)ap->in[25], (bf16*)(ws + WS_AM)); PH_END
    PH_BEGIN GEMM_F(0, false, false, ws + WS_AM, ws + WS_WDKV, MT, 512, 1024, ws + WS_KVR, nullptr, nullptr, 320, 320); PH_END
    PH_BEGIN b0c_kvpost(F, ap); PH_END
    PH_BEGIN
        GEMM_B(0, ws + WS_CKVB, ws + WS_WUK, MP, 2048, 256, ws + WS_KN, 2048, 2048, 2048);
        GEMM_B(0, ws + WS_WUV, ws + WS_CKVB, 2048, MP, 256, ws + WS_VT, MP, MP, MP);
    PH_END
    for (int l = 0; l < 2; ++l) {
        PH_BEGIN norm_rows_bf16(F, (const float*)(ws + WS_X), (const float*)ap->in[30] + l * 1024, (bf16*)(ws + WS_AM)); PH_END
        PH_BEGIN
            GEMM_F(0, false, false, ws + WS_AM, ws + WS_WQ + (size_t)l * MiB, MT, 512, 1024, ws + WS_QL, nullptr, nullptr, 384, 384);
            GEMM_B(0, ws + WS_AM, ws + WS_WZ + (size_t)l * 4 * MiB, MT, 2048, 1024, ws + WS_Z, 2048, 2048, 2048);
        PH_END
        PH_BEGIN b1c_cq(F, ap, l); PH_END
        PH_BEGIN GEMM_B(0, ws + WS_CQ, ws + WS_WUQ + (size_t)l * (5 * MiB / 2), MT, 3072, 384, ws + WS_QR, 3072, 3072, 3072); PH_END
        PH_BEGIN b1e_qpost(F, ap); PH_END
        PH_BEGIN b2a_attn_prompt(F); b2b_attn_sample(F, ap); PH_END
        PH_BEGIN b2c_combine(F, ap); PH_END
        PH_BEGIN GEMM_F(0, true, false, ws + WS_G, ws + WS_WBO + (size_t)l * 4 * MiB, MT, 1024, 2048, ws + WS_X, ws + WS_X, nullptr, 1024, 1024); PH_END
    }

    PH_BEGIN final_norm(F, ap); PH_END
#if MK_DIAG
    PH_BEGIN
        const size_t offs[11] = {O_YP, O_YS, O_WKVP, O_SHP, O_CKVP, O_KPEP, O_WKVS, O_SHS, O_CKVS, O_KPES, O_END};
        for (int k = 1; k < 10; ++k) { const float f = 1.0f + sqrtf(2e-4f * (float)k);
            for (size_t i = offs[k] + (size_t)(F.bid * NTHR + F.wave * 64 + F.lane); i < offs[k + 1]; i += (size_t)F.NT) F.out[i] *= f; }
    PH_END
#endif
}

extern "C" void kernel_launch(void* const* d_in, const int* in_sizes, int n_in, void* d_out, int out_size, void* d_ws, size_t ws_size, hipStream_t stream) {
    static int grid = 0;
    if (grid == 0) {
        if (n_in != 36 || (size_t)out_size != O_END || ws_size < WS_NEED) { fprintf(stderr, "kernel_launch: unexpected sizes: n_in %d out %d (want %zu) ws %zu (need %zu)\n", n_in, out_size, (size_t)O_END, ws_size, (size_t)WS_NEED); grid = -1; return; }
        int dev = 0, cus = 0, per_cu = 0;
        if (hipGetDevice(&dev) != hipSuccess || hipDeviceGetAttribute(&cus, hipDeviceAttributeMultiprocessorCount, dev) != hipSuccess) { grid = -1; return; }
        if (hipFuncSetAttribute((const void*)mk_fwd, hipFuncAttributeMaxDynamicSharedMemorySize, LDS_BYTES) != hipSuccess) { fprintf(stderr, "kernel_launch: hipFuncSetAttribute failed\n"); grid = -1; return; }
        if (hipOccupancyMaxActiveBlocksPerMultiprocessor(&per_cu, (const void*)mk_fwd, NTHR, LDS_BYTES) != hipSuccess || per_cu < 1) fprintf(stderr, "kernel_launch: occupancy query reports %d\n", per_cu);
        (void)hipGetLastError();
        grid = cus;
    }
    if (grid < 0) return;
    if (hipMemsetAsync((char*)d_ws + WS_CTL, 0, CTL_ZERO_BYTES, stream) != hipSuccess) { fprintf(stderr, "kernel_launch: memset failed\n"); return; }
    Args a{};
    for (int i = 0; i < 36; ++i) a.in[i] = d_in[i];
    a.out = (float*)d_out; a.ws = (unsigned char*)d_ws;
#if MK_SPLIT
    for (int li = 0; li < NPHASES; ++li) { a.ph_lo = li; a.ph_hi = li + 1; a.li = li;
        hipLaunchKernelGGL(mk_fwd, dim3(grid), dim3(NTHR), LDS_BYTES, stream, a); }
#else
    a.ph_lo = 0; a.ph_hi = NPHASES; a.li = 0;
    hipLaunchKernelGGL(mk_fwd, dim3(grid), dim3(NTHR), LDS_BYTES, stream, a);
#endif
    const hipError_t le = hipPeekAtLastError();
    if (le != hipSuccess) fprintf(stderr, "kernel_launch: launch failed: %s\n", hipGetErrorName(le));
}
```

```cpp
#include <hip/hip_runtime.h>
#include <cstdio>
#include <cstdint>
namespace pg8 {
#define PG8_LAS __attribute__((address_space(3)))
typedef unsigned short bf16_t;
typedef short bf16x8 __attribute__((ext_vector_type(8)));
typedef float f32x4 __attribute__((ext_vector_type(4)));
typedef unsigned u32x4 __attribute__((ext_vector_type(4)));
constexpr int BM = 256, BK = 64, HALF = 128, HTB = HALF * BK * 2  , STAGE_BYTES = 8 * HTB, NXCD = 8, WGM = 8;

__host__ __device__ __forceinline__ int lds_byte(int r, int c) { const int st = (r >> 4) * 2 + (c >> 5), rr = r & 15, cc = c & 31, ob = rr * 64 + cc * 2; return st * 1024 + (ob ^ (((ob >> 9) & 1) << 5)); }
__host__ __device__ __forceinline__ void stage_rc(int b, int& R, int& C) { const int st = b / 1024, sb = b % 1024, swz = sb ^ (((sb >> 9) & 1) << 5); R = (st >> 1) * 16 + swz / 64; C = (st & 1) * 32 + (swz % 64) / 2; }
__host__ __device__ __forceinline__ int perm32(int rho) { const int n = rho >> 4, i = rho & 15; return 8 * (i >> 2) + 4 * n + (i & 3); }

struct Unit { int pm, pn; int ko; };
struct Gemm { const bf16_t* A; const bf16_t* Bt; int M, N, K; int ld; };

struct StaticOrder {
    int nM, nN, nwg, G, c;
    __host__ __device__ void init(int M, int N, int G_, int c_) { nM = M / BM; nN = N / BM; nwg = nM * nN; G = G_; c = c_; }
    __host__ __device__ bool next(int i, Unit& u) const {
        const long L = (long)i * G + c; if (L >= nwg) return false;
        int wgid = (int)L; { const int q = nwg / NXCD, r = nwg % NXCD, xcd = wgid % NXCD, off = wgid / NXCD; wgid = (xcd < r ? xcd * (q + 1) : r * (q + 1) + (xcd - r) * q) + off; }
        const int nig = WGM * nN, gid = wgid / nig, fm = gid * WGM, gsz = (nM - fm) < WGM ? (nM - fm) : WGM;
        u.pm = fm + ((wgid % nig) % gsz); u.pn = (wgid % nig) / gsz; u.ko = 0; return true;
    }
    __device__ __forceinline__ void a_ready(const Unit&) const {}
    __device__ __forceinline__ void done(const Unit&) const {}
};

__device__ __forceinline__ unsigned cvt_pk_bf16(float lo, float hi) { unsigned r; asm volatile("v_cvt_pk_bf16_f32 %0, %1, %2" : "=v"(r) : "v"(lo), "v"(hi)); return r; }
typedef float f32x2 __attribute__((ext_vector_type(2)));
__device__ __forceinline__ float act_apply(int ACT, float x) {
    if (ACT == 1) return 1.0f - 2.0f / (1.0f + __expf(2.0f * x));
    if (ACT == 2) return __expf(-0.6065306597126334f / (1.0f + __expf(-x)));
    if (ACT == 3) return 1.0f / (1.0f + __expf(-x));
    return x;
}
template <int ACT> struct EpiB {
    static constexpr bool PERM = true, AFTER_DRAIN = false;
    bf16_t* O; int ldc; int nvalid; int nstore;
    __device__ __forceinline__ void operator()(const f32x4 (&acc)[2][2][4][2], const Unit& u, int wr, int wc, int, int) const {
        int lane_; asm volatile("v_mbcnt_lo_u32_b32 %0, -1, 0\n\tv_mbcnt_hi_u32_b32 %0, -1, %0" : "=v"(lane_)); const int fr = lane_ & 15, fq = lane_ >> 4;
        const int row0 = u.pm * BM + wr * 64 + fr, col0 = u.pn * BM + wc * 32 + 8 * fq;
#pragma unroll
        for (int ai = 0; ai < 2; ++ai)
#pragma unroll
            for (int m = 0; m < 4; ++m) { bf16_t* rowp = O + (size_t)(row0 + ai * HALF + m * 16) * ldc + col0;
#pragma unroll
                for (int bj = 0; bj < 2; ++bj) { const int c = col0 + bj * HALF; if (c >= nstore) continue;
                    f32x4 v0 = acc[ai][bj][m][0], v1 = acc[ai][bj][m][1];
                    if (ACT != 0) {
#pragma unroll
                        for (int e = 0; e < 4; ++e) { v0[e] = act_apply(ACT, v0[e]); v1[e] = act_apply(ACT, v1[e]); } }
                    u32x4 w; w.x = cvt_pk_bf16(v0[0], v0[1]); w.y = cvt_pk_bf16(v0[2], v0[3]); w.z = cvt_pk_bf16(v1[0], v1[1]); w.w = cvt_pk_bf16(v1[2], v1[3]);
                    if (c >= nvalid) w = (u32x4){0u, 0u, 0u, 0u};
                    *(u32x4*)(rowp + bj * HALF) = w; } }
    }
};
template <int ACT, bool HAS_BASE, bool HAS_BIAS> struct EpiF {
    static constexpr bool PERM = false, AFTER_DRAIN = false;
    float* O; const float* base; const float* bias; int ldc; int nstore;
    __device__ __forceinline__ void operator()(const f32x4 (&acc)[2][2][4][2], const Unit& u, int wr, int wc, int, int) const {
        int lane_; asm volatile("v_mbcnt_lo_u32_b32 %0, -1, 0\n\tv_mbcnt_hi_u32_b32 %0, -1, %0" : "=v"(lane_)); const int fr = lane_ & 15, fq = lane_ >> 4;
        const int row0 = u.pm * BM + wr * 64 + fr, col0 = u.pn * BM + wc * 32 + 4 * fq;
        f32x4 bv[2][2];
#pragma unroll
        for (int bj = 0; bj < 2; ++bj)
#pragma unroll
            for (int n = 0; n < 2; ++n) bv[bj][n] = HAS_BIAS ? *(const f32x4*)(bias + col0 + bj * HALF + n * 16) : (f32x4){0.f, 0.f, 0.f, 0.f};
#pragma unroll
        for (int ai = 0; ai < 2; ++ai)
#pragma unroll
            for (int m = 0; m < 4; ++m) { const size_t off = (size_t)(row0 + ai * HALF + m * 16) * ldc + col0;
#pragma unroll
                for (int bj = 0; bj < 2; ++bj)
#pragma unroll
                    for (int n = 0; n < 2; ++n) { if (col0 + bj * HALF + n * 16 >= nstore) continue;
                        f32x4 v = acc[ai][bj][m][n] + bv[bj][n];
                        if (ACT != 0) {
#pragma unroll
                            for (int e = 0; e < 4; ++e) v[e] = act_apply(ACT, v[e]); }
                        if (HAS_BASE) v += *(const f32x4*)(base + off + bj * HALF + n * 16);
                        *(f32x4*)(O + off + bj * HALF + n * 16) = v; }
                if (m & 1) asm volatile("" ::: "memory"); }
    }
};

struct GroupOrder4 {
    StaticOrder so; int per;
    __device__ void init(int M, int N, int G_, int c_) { so.init(M, N, G_, c_); per = so.nwg; }
    __device__ bool next(int i, Unit& u) const {
        const long L = (long)i * so.G + so.c; if (L >= 4L * per) return false;
        const int gi = (int)(L / per); int wgid = (int)(L - (long)gi * per);
        { const int q = so.nwg / NXCD, r = so.nwg % NXCD, xcd = wgid % NXCD, off = wgid / NXCD; wgid = (xcd < r ? xcd * (q + 1) : r * (q + 1) + (xcd - r) * q) + off; }
        const int nig = WGM * so.nN, gid = wgid / nig, fm = gid * WGM, gsz = (so.nM - fm) < WGM ? (so.nM - fm) : WGM;
        u.pm = fm + ((wgid % nig) % gsz) + 130 * gi; u.pn = (wgid % nig) / gsz + 8 * gi; u.ko = 0; return true;
    }
    __device__ __forceinline__ void a_ready(const Unit&) const {}
    __device__ __forceinline__ void done(const Unit&) const {}
};
struct EpiB4 {
    static constexpr bool PERM = true, AFTER_DRAIN = false;
    bf16_t* O[4];
    __device__ __forceinline__ void operator()(const f32x4 (&acc)[2][2][4][2], const Unit& u, int wr, int wc, int, int) const {
        int lane_; asm volatile("v_mbcnt_lo_u32_b32 %0, -1, 0\n\tv_mbcnt_hi_u32_b32 %0, -1, %0" : "=v"(lane_)); const int fr = lane_ & 15, fq = lane_ >> 4;
        const int gi = u.pn >> 3; bf16_t* Ob = gi == 0 ? O[0] : gi == 1 ? O[1] : gi == 2 ? O[2] : O[3];
        const int row0 = (u.pm - 130 * gi) * BM + wr * 64 + fr, col0 = (u.pn & 7) * BM + wc * 32 + 8 * fq;
#pragma unroll
        for (int ai = 0; ai < 2; ++ai)
#pragma unroll
            for (int m = 0; m < 4; ++m) { bf16_t* rowp = Ob + (size_t)(row0 + ai * HALF + m * 16) * 2048 + col0;
#pragma unroll
                for (int bj = 0; bj < 2; ++bj) { const f32x4 v0 = acc[ai][bj][m][0], v1 = acc[ai][bj][m][1];
                    u32x4 w; w.x = cvt_pk_bf16(v0[0], v0[1]); w.y = cvt_pk_bf16(v0[2], v0[3]); w.z = cvt_pk_bf16(v1[0], v1[1]); w.w = cvt_pk_bf16(v1[2], v1[3]);
                    *(u32x4*)(rowp + bj * HALF) = w; } }
    }
};

struct EpiQ {
    static constexpr bool PERM = true, AFTER_DRAIN = false;
    bf16_t* O; const float* rope; float sc; int mp, seq; const float* rsq;
    __device__ __forceinline__ void operator()(const f32x4 (&acc)[2][2][4][2], const Unit& u, int wr, int wc, int, int) const {
        int lane_; asm volatile("v_mbcnt_lo_u32_b32 %0, -1, 0\n\tv_mbcnt_hi_u32_b32 %0, -1, %0" : "=v"(lane_)); const int fr = lane_ & 15, fq = lane_ >> 4;
        const int row0 = u.pm * BM + wr * 64 + fr, col0 = u.pn * BM + wc * 32 + 8 * fq;
#pragma unroll
        for (int ai = 0; ai < 2; ++ai)
#pragma unroll
            for (int m = 0; m < 4; ++m) { const int row = row0 + ai * HALF + m * 16; const int p = row < mp ? (row & (seq - 1)) : seq; bf16_t* rowp = O + (size_t)row * 3072 + col0; const float rsc = sc / sqrtf(rsq[row] * (1.0f / 384.0f) + 1e-6f);
#pragma unroll
                for (int bj = 0; bj < 2; ++bj) { const int c = col0 + bj * HALF, within = c % 192; f32x4 v0 = acc[ai][bj][m][0], v1 = acc[ai][bj][m][1];
                    if (within >= 128) { const float* t = rope + (size_t)(p * 32 + ((within - 128) >> 1)) * 2; const f32x4 t0 = *(const f32x4*)t, t1 = *(const f32x4*)(t + 4);
                        const f32x4 a0 = v0, a1 = v1;
                        v0[0] = a0[0] * t0[0] - a0[1] * t0[1]; v0[1] = a0[1] * t0[0] + a0[0] * t0[1]; v0[2] = a0[2] * t0[2] - a0[3] * t0[3]; v0[3] = a0[3] * t0[2] + a0[2] * t0[3];
                        v1[0] = a1[0] * t1[0] - a1[1] * t1[1]; v1[1] = a1[1] * t1[0] + a1[0] * t1[1]; v1[2] = a1[2] * t1[2] - a1[3] * t1[3]; v1[3] = a1[3] * t1[2] + a1[2] * t1[3]; }
                    v0 = v0 * rsc; v1 = v1 * rsc;
                    u32x4 w; w.x = cvt_pk_bf16(v0[0], v0[1]); w.y = cvt_pk_bf16(v0[2], v0[3]); w.z = cvt_pk_bf16(v1[0], v1[1]); w.w = cvt_pk_bf16(v1[2], v1[3]);
                    *(u32x4*)(rowp + bj * HALF) = w; } }
    }
};

struct EpiCQ {
    static constexpr bool PERM = true, AFTER_DRAIN = false;
    bf16_t* O; const float* wq; float* rsq;
    __device__ __forceinline__ void operator()(const f32x4 (&acc)[2][2][4][2], const Unit& u, int wr, int wc, int, int) const {
        int lane_; asm volatile("v_mbcnt_lo_u32_b32 %0, -1, 0\n\tv_mbcnt_hi_u32_b32 %0, -1, %0" : "=v"(lane_)); const int fr = lane_ & 15, fq = lane_ >> 4;
        const int row0 = u.pm * BM + wr * 64 + fr, col0 = u.pn * BM + wc * 32 + 8 * fq;
#pragma unroll
        for (int ai = 0; ai < 2; ++ai)
#pragma unroll
            for (int m = 0; m < 4; ++m) { const int row = row0 + ai * HALF + m * 16; float ss = 0.f;
#pragma unroll
                for (int bj = 0; bj < 2; ++bj) { const int c = col0 + bj * HALF; if (c >= 384) continue;
                    const f32x4 v0 = acc[ai][bj][m][0], v1 = acc[ai][bj][m][1], w0 = *(const f32x4*)(wq + c), w1 = *(const f32x4*)(wq + c + 4);
                    ss += ((v0[0] * v0[0] + v0[1] * v0[1]) + (v0[2] * v0[2] + v0[3] * v0[3])) + ((v1[0] * v1[0] + v1[1] * v1[1]) + (v1[2] * v1[2] + v1[3] * v1[3]));
                    u32x4 w; w.x = cvt_pk_bf16(v0[0] * w0[0], v0[1] * w0[1]); w.y = cvt_pk_bf16(v0[2] * w0[2], v0[3] * w0[3]); w.z = cvt_pk_bf16(v1[0] * w1[0], v1[1] * w1[1]); w.w = cvt_pk_bf16(v1[2] * w1[2], v1[3] * w1[3]);
                    *(u32x4*)(O + (size_t)row * 384 + c) = w; }
                ss += __builtin_bit_cast(float, __builtin_amdgcn_ds_swizzle(__builtin_bit_cast(int, ss), 0x1F | (16 << 10)));
                { float a = ss, b = ss; asm volatile("s_nop 1\n\tv_permlane32_swap_b32 %0, %1\n\ts_nop 1" : "+v"(a), "+v"(b)); ss = a + b; }
                if (fq == 0 && u.pn < 2) atomicAdd(rsq + row, ss); }
    }
};

struct SliceOrder {
    int pm, nN, nS, G, c, kbytes;
    __device__ bool next(int i, Unit& u) const { const int L = i * G + c; if (L >= nN * nS) return false; u.pm = pm; u.pn = L % nN; u.ko = (L / nN) * kbytes; return true; }
    __device__ __forceinline__ void a_ready(const Unit&) const {}
    __device__ __forceinline__ void done(const Unit&) const {}
};
struct EpiFA {
    static constexpr bool PERM = false, AFTER_DRAIN = false;
    float* O; int ldc, rows;
    __device__ __forceinline__ void operator()(const f32x4 (&acc)[2][2][4][2], const Unit& u, int wr, int wc, int, int) const {
        int lane_; asm volatile("v_mbcnt_lo_u32_b32 %0, -1, 0\n\tv_mbcnt_hi_u32_b32 %0, -1, %0" : "=v"(lane_)); const int fr = lane_ & 15, fq = lane_ >> 4;
        const int row0 = u.pm * BM + wr * 64 + fr, col0 = u.pn * BM + wc * 32 + 4 * fq;
#pragma unroll
        for (int ai = 0; ai < 2; ++ai)
#pragma unroll
            for (int m = 0; m < 4; ++m) { const int row = row0 + ai * HALF + m * 16; if (row >= rows) continue; float* rp = O + (size_t)row * ldc + col0;
#pragma unroll
                for (int bj = 0; bj < 2; ++bj)
#pragma unroll
                    for (int n = 0; n < 2; ++n) { const f32x4 v = acc[ai][bj][m][n];
#pragma unroll
                        for (int e = 0; e < 4; ++e) atomicAdd(rp + bj * HALF + n * 16 + e, v[e]); } }
    }
};
template <class Epi, class Sched, bool ALIGN_EPI = false, bool SP2 = false>
__device__ __forceinline__ void gemm_phase(PG8_LAS unsigned char* lds, const Gemm g, const Sched& S, const Epi& E, const int wid) {
    int lane_; asm volatile("v_mbcnt_lo_u32_b32 %0, -1, 0\n\tv_mbcnt_hi_u32_b32 %0, -1, %0" : "=v"(lane_));
    const int lane = lane_, tid = wid * 64 + lane, wr = wid >> 2, wc = wid & 3, fr = lane & 15, fq = lane >> 4;
    const int K = g.K, nt = K / BK, LD = g.ld ? g.ld : g.K;
    unsigned voffA[2], voffB[2];
#pragma unroll
    for (int i = 0; i < 2; ++i) { int R, C; stage_rc(tid * 16 + i * 8192, R, C); const int Rb = Epi::PERM ? ((R & ~31) + perm32(R & 31)) : R;
        voffA[i] = (unsigned)(R * LD + C) * 2u; voffB[i] = (unsigned)(Rb * LD + C) * 2u; }
    const size_t kstep = (size_t)(BK * 2);
    const size_t hstep = (size_t)HALF * LD * 2;
    const size_t tstep = 2 * hstep;
    const unsigned ldsw = (unsigned)wid * 1024u;
    const int aoff = lds_byte(wr * 64 + fr, fq * 8), boff = lds_byte(wc * 32 + fr, fq * 8);
#define PG8_SA(b, h) (((b) * 2 + (h)) * HTB)
#define PG8_SB(b, h) ((4 + (b) * 2 + (h)) * HTB)
#define PG8_STAGE(bufoff, gbase, voff) do { _Pragma("unroll") for (int _i = 0; _i < 2; ++_i) \
        __builtin_amdgcn_global_load_lds((const unsigned*)((const char*)(gbase) + (voff)[_i]), (PG8_LAS unsigned*)(lds + (bufoff) + ldsw + _i * 8192), 16, 0, 0); } while (0)
#define PG8_LDA(dst, b, h) do { _Pragma("unroll") for (int m = 0; m < 4; ++m) _Pragma("unroll") for (int k = 0; k < 2; ++k) dst[m][k] = *(const PG8_LAS bf16x8*)(lds + PG8_SA(b, h) + aoff + m * 2048 + k * 1024); } while (0)
#define PG8_LDB(dst, b, h) do { _Pragma("unroll") for (int n = 0; n < 2; ++n) _Pragma("unroll") for (int k = 0; k < 2; ++k) dst[n][k] = *(const PG8_LAS bf16x8*)(lds + PG8_SB(b, h) + boff + n * 2048 + k * 1024); } while (0)
#define PG8_MMA(ai, bj, At, Bt) do { __builtin_amdgcn_s_setprio(1); _Pragma("unroll") for (int m = 0; m < 4; ++m) _Pragma("unroll") for (int n = 0; n < 2; ++n) _Pragma("unroll") for (int k = 0; k < 2; ++k) \
        acc[ai][bj][m][n] = __builtin_amdgcn_mfma_f32_16x16x32_bf16(Bt[n][k], At[m][k], acc[ai][bj][m][n], 0, 0, 0); __builtin_amdgcn_s_setprio(0); } while (0)
#define PG8_WAIT_V(n) asm volatile("s_waitcnt vmcnt(" #n ")" ::: "memory")
#define PG8_WAIT_L(n) asm volatile("s_waitcnt lgkmcnt(" #n ")" ::: "memory")
#define PG8_BAR __builtin_amdgcn_s_barrier()
#define PG8_SCHED __builtin_amdgcn_sched_barrier(0)
    Unit cur, nxt; int ui = 0;
    if (!S.next(0, cur)) return;
    f32x4 acc[2][2][4][2];
#pragma unroll
    for (int a = 0; a < 2; ++a)
#pragma unroll
        for (int b = 0; b < 2; ++b)
#pragma unroll
            for (int m = 0; m < 4; ++m)
#pragma unroll
                for (int n = 0; n < 2; ++n) acc[a][b][m][n] = (f32x4){0.f, 0.f, 0.f, 0.f};
    bf16x8 At[4][2], B0[2][2], B1[2][2];
    const char* cA = (const char*)g.A + (size_t)cur.pm * tstep + cur.ko; const char* cB = (const char*)g.Bt + (size_t)cur.pn * tstep + cur.ko;
    S.a_ready(cur);
    if constexpr (SP2) {
        PG8_STAGE(PG8_SB(0, 0), cB, voffB); PG8_STAGE(PG8_SB(0, 1), cB + hstep, voffB); PG8_STAGE(PG8_SA(0, 0), cA, voffA); PG8_STAGE(PG8_SA(0, 1), cA + hstep, voffA);
        if (wr == 1) PG8_BAR;
        PG8_WAIT_V(2); PG8_BAR;
        PG8_STAGE(PG8_SB(1, 0), cB + kstep, voffB); PG8_STAGE(PG8_SA(1, 0), cA + kstep, voffA); PG8_STAGE(PG8_SB(1, 1), cB + hstep + kstep, voffB);
        PG8_WAIT_V(6); PG8_BAR;
    } else {
        PG8_STAGE(PG8_SB(0, 0), cB, voffB); PG8_STAGE(PG8_SA(0, 0), cA, voffA); PG8_STAGE(PG8_SB(0, 1), cB + hstep, voffB); PG8_STAGE(PG8_SA(0, 1), cA + hstep, voffA);
        if (wr == 1) PG8_BAR;
        PG8_WAIT_V(4); PG8_BAR;
        PG8_STAGE(PG8_SB(1, 0), cB + kstep, voffB); PG8_STAGE(PG8_SA(1, 0), cA + kstep, voffA); PG8_STAGE(PG8_SB(1, 1), cB + hstep + kstep, voffB);
        PG8_WAIT_V(6); PG8_BAR;
    }
    for (;;) {
        const bool has_next = S.next(ui + 1, nxt);
        const char* nA = has_next ? (const char*)g.A + (size_t)nxt.pm * tstep + nxt.ko : cA; const char* nB = has_next ? (const char*)g.Bt + (size_t)nxt.pn * tstep + nxt.ko : cB;
        for (int t = 0; t < nt; t += 2) {
            const bool last = (t == nt - 2);
            const char* a1 = cA + (size_t)(t + 1) * kstep;
            const char* a2 = last ? nA : cA + (size_t)(t + 2) * kstep; const char* b2 = last ? nB : cB + (size_t)(t + 2) * kstep;
            const char* a3 = a2 + kstep; const char* b3 = b2 + kstep;
            if (last && has_next) S.a_ready(nxt);
            if constexpr (SP2) {
            PG8_LDB(B0, 0, 0); PG8_LDB(B1, 0, 1); PG8_SCHED; PG8_LDA(At, 0, 0); PG8_STAGE(PG8_SA(1, 1), a1 + hstep, voffA);
            PG8_WAIT_V(8); PG8_WAIT_L(0); PG8_BAR; PG8_MMA(0, 0, At, B0); PG8_MMA(0, 1, At, B1); PG8_BAR; PG8_SCHED;
            PG8_LDA(At, 0, 1); PG8_STAGE(PG8_SB(0, 0), b2, voffB); PG8_STAGE(PG8_SB(0, 1), b2 + hstep, voffB); PG8_STAGE(PG8_SA(0, 0), a2, voffA);
            PG8_WAIT_V(8); PG8_WAIT_L(0); PG8_BAR; PG8_MMA(1, 0, At, B0); PG8_MMA(1, 1, At, B1); PG8_BAR; PG8_SCHED;
            PG8_LDB(B0, 1, 0); PG8_LDB(B1, 1, 1); PG8_SCHED; PG8_LDA(At, 1, 0); PG8_STAGE(PG8_SA(0, 1), a2 + hstep, voffA);
            PG8_WAIT_V(8); PG8_WAIT_L(0); PG8_BAR; PG8_MMA(0, 0, At, B0); PG8_MMA(0, 1, At, B1); PG8_BAR; PG8_SCHED;
            PG8_LDA(At, 1, 1); PG8_STAGE(PG8_SB(1, 0), b3, voffB); PG8_STAGE(PG8_SB(1, 1), b3 + hstep, voffB); PG8_STAGE(PG8_SA(1, 0), a3, voffA);
            PG8_WAIT_V(8); PG8_WAIT_L(0); PG8_BAR; PG8_MMA(1, 0, At, B0); PG8_MMA(1, 1, At, B1); PG8_BAR; PG8_SCHED;
            } else {
            PG8_LDB(B0, 0, 0); PG8_SCHED; PG8_LDA(At, 0, 0); PG8_STAGE(PG8_SA(1, 1), a1 + hstep, voffA);
            PG8_WAIT_L(8); PG8_BAR; PG8_WAIT_L(0); PG8_MMA(0, 0, At, B0); PG8_BAR; PG8_SCHED;
            PG8_LDB(B1, 0, 1); PG8_STAGE(PG8_SB(0, 0), b2, voffB);
            PG8_BAR; PG8_WAIT_L(0); PG8_MMA(0, 1, At, B1); PG8_BAR;
            PG8_LDA(At, 0, 1); PG8_STAGE(PG8_SA(0, 0), a2, voffA);
            PG8_BAR; PG8_WAIT_L(0); PG8_MMA(1, 0, At, B0); PG8_BAR; PG8_SCHED;
            PG8_STAGE(PG8_SB(0, 1), b2 + hstep, voffB);
            PG8_WAIT_V(6); PG8_BAR; PG8_MMA(1, 1, At, B1); PG8_BAR;
            PG8_LDB(B0, 1, 0); PG8_SCHED; PG8_LDA(At, 1, 0); PG8_STAGE(PG8_SA(0, 1), a2 + hstep, voffA);
            PG8_WAIT_L(8); PG8_BAR; PG8_WAIT_L(0); PG8_MMA(0, 0, At, B0); PG8_BAR; PG8_SCHED;
            PG8_LDB(B1, 1, 1); PG8_STAGE(PG8_SB(1, 0), b3, voffB);
            PG8_BAR; PG8_WAIT_L(0); PG8_MMA(0, 1, At, B1); PG8_BAR;
            PG8_LDA(At, 1, 1); PG8_STAGE(PG8_SA(1, 0), a3, voffA);
            PG8_BAR; PG8_WAIT_L(0); PG8_MMA(1, 0, At, B0); PG8_BAR; PG8_SCHED;
            PG8_STAGE(PG8_SB(1, 1), b3 + hstep, voffB);
            PG8_WAIT_V(6); PG8_BAR; PG8_MMA(1, 1, At, B1); PG8_BAR;
            }
        }
        if constexpr (ALIGN_EPI) { if (wr == 0) PG8_BAR; }
        if constexpr (!Epi::AFTER_DRAIN) { E(acc, cur, wr, wc, fr, fq); S.done(cur); }
        if (!has_next) break;
#pragma unroll
        for (int a = 0; a < 2; ++a)
#pragma unroll
            for (int b = 0; b < 2; ++b)
#pragma unroll
                for (int m = 0; m < 4; ++m)
#pragma unroll
                    for (int n = 0; n < 2; ++n) acc[a][b][m][n] = (f32x4){0.f, 0.f, 0.f, 0.f};
        cur = nxt; cA = nA; cB = nB; ++ui;
        if constexpr (ALIGN_EPI) { if (wr == 1) PG8_BAR; }
    }
    PG8_WAIT_V(0);
    if constexpr (!ALIGN_EPI) { if (wr == 0) PG8_BAR; }
    PG8_BAR;
    if constexpr (Epi::AFTER_DRAIN) { E.fused(acc, cur, wr, wc, fr, fq, lds, wid, lane); S.done(cur); }
#undef PG8_SA
#undef PG8_SB
#undef PG8_STAGE
#undef PG8_LDA
#undef PG8_LDB
#undef PG8_MMA
#undef PG8_WAIT_V
#undef PG8_WAIT_L
#undef PG8_BAR
#undef PG8_SCHED
}
}
constexpr int D_MODEL = 1024, BATCH = 16, SEQ = 2048, DEC_BATCH = 128, PAST = 8192, PAGE = 128, NPAGES = 64;
constexpr int D_INNER = 2048, A_HEADS = 32, A_HEAD = 64, B_HEADS = 16, KV_LORA = 256, Q_LORA = 384, QK_NOPE = 128, QK_ROPE = 64, V_HEAD = 128, QK_HEAD = 192;
constexpr int MP = BATCH * SEQ;
constexpr int MS0 = MP;
constexpr int MT = MP + 256;
constexpr float NORM_EPS = 1e-6f, GN_EPS = 64e-5f;
constexpr float ATTN_SCALE = 0.07216878364870322f;
constexpr float LOG2E = 1.4426950408889634f;
constexpr int NWAVES = 8, NTHR = 512;

constexpr size_t O_YP = 0, O_YS = O_YP + (size_t)MP * D_MODEL, O_WKVP = O_YS + (size_t)DEC_BATCH * D_MODEL, O_SHP = O_WKVP + (size_t)2 * BATCH * A_HEADS * 4096,
    O_CKVP = O_SHP + (size_t)2 * BATCH * D_MODEL, O_KPEP = O_CKVP + (size_t)MP * KV_LORA, O_WKVS = O_KPEP + (size_t)MP * QK_ROPE, O_SHS = O_WKVS + (size_t)2 * DEC_BATCH * A_HEADS * 4096,
    O_CKVS = O_SHS + (size_t)2 * DEC_BATCH * D_MODEL, O_KPES = O_CKVS + (size_t)DEC_BATCH * KV_LORA, O_END = O_KPES + (size_t)DEC_BATCH * QK_ROPE;

constexpr size_t MiB = 1u << 20;
constexpr size_t WS_CTL = 0, CTL_ZERO_BYTES = 2 * MiB;
constexpr size_t WS_WIN = 2 * MiB;
constexpr size_t WS_W1 = WS_WIN + 32 * MiB;
constexpr size_t WS_W2 = WS_W1 + 3 * MiB;
constexpr size_t WS_WO = WS_W2 + 3 * MiB;
constexpr size_t WS_WDKV = WS_WO + 8 * MiB;
constexpr size_t WS_WUK = WS_WDKV + 1 * MiB;
constexpr size_t WS_WUV = WS_WUK + 1 * MiB;
constexpr size_t WS_WQ = WS_WUV + 1 * MiB;
constexpr size_t WS_WZ = WS_WQ + 2 * MiB;
constexpr size_t WS_WUQ = WS_WZ + 8 * MiB;
constexpr size_t WS_WBO = WS_WUQ + 5 * MiB;
constexpr size_t WS_ROPE = WS_WBO + 8 * MiB;
constexpr size_t WS_X = 96 * MiB;
constexpr size_t WS_AM = WS_X + 130 * MiB;
constexpr size_t AM_STRIDE = 65 * MiB;
constexpr size_t WS_R = WS_AM + 6 * AM_STRIDE;
constexpr size_t BIGB = 130 * MiB;
constexpr size_t WS_K = WS_R + BIGB, WS_V0 = WS_K + BIGB, WS_V1 = WS_V0 + BIGB, WS_Z = WS_V1 + BIGB, WS_G = WS_Z + BIGB;
constexpr size_t WS_LW = WS_G + BIGB;
constexpr size_t WS_LA = WS_LW + 9 * MiB, WS_LV = WS_LA + 9 * MiB;
constexpr size_t WS_BON = WS_LV + 9 * MiB;
constexpr size_t WS_F = WS_BON + 5 * MiB;
constexpr size_t BIGF = 260 * MiB;
constexpr size_t WS_WD = WS_F, WS_IA = WS_F + BIGF, WS_VG = WS_F + 2 * BIGF, WS_SR = WS_F + 3 * BIGF, WS_SK = WS_F + 4 * BIGF, WS_SA = WS_F + 5 * BIGF, WS_SB = WS_F + 6 * BIGF,
    WS_SV = WS_F + 7 * BIGF, WS_Y = WS_F + 8 * BIGF, WS_END_A = WS_F + 9 * BIGF;
constexpr size_t WS_KVR = WS_F;
constexpr size_t WS_CKVB = WS_KVR + 41 * MiB;
constexpr size_t WS_KPEB = WS_CKVB + 17 * MiB;
constexpr size_t WS_KN = WS_KPEB + 5 * MiB;
constexpr size_t WS_VT = WS_KN + 128 * MiB;
constexpr size_t WS_QL = WS_VT + 128 * MiB;
constexpr size_t WS_CQ = WS_QL + 49 * MiB;
constexpr size_t WS_QR = WS_CQ + 25 * MiB;
constexpr size_t WS_Q = WS_QR + 388 * MiB;
constexpr size_t WS_QABS = WS_Q + 194 * MiB;
constexpr size_t WS_OPART = WS_QABS + 2 * MiB;
constexpr size_t WS_ML = WS_OPART + 16 * MiB;
constexpr size_t WS_END_B = WS_ML + 1 * MiB;
constexpr size_t WS_NEED = WS_END_A > WS_END_B ? WS_END_A : WS_END_B;
static_assert(WS_ROPE + 1 * MiB <= WS_X, "weights region");
constexpr size_t CW_RSQ = 1 * MiB;
constexpr int CW_BAR = 4096;

constexpr int RING_BYTES = 131072;
constexpr int LDSCTL_OFF = RING_BYTES;
constexpr int LDS_BYTES = 147456;

#define GAS __attribute__((address_space(1)))
#define LAS __attribute__((address_space(3)))
typedef unsigned short bf16;
typedef unsigned v4u __attribute__((ext_vector_type(4)));
typedef unsigned v2u __attribute__((ext_vector_type(2)));
typedef float f32x4 __attribute__((ext_vector_type(4)));
typedef float f32x16 __attribute__((ext_vector_type(16)));
typedef short bf16x8 __attribute__((ext_vector_type(8)));
typedef short s16x4 __attribute__((ext_vector_type(4)));
typedef const __attribute__((address_space(4))) float* cfp;
#define LDS_WAIT() asm volatile("s_waitcnt lgkmcnt(0)" ::: "memory")
#define VM_WAIT() asm volatile("s_waitcnt vmcnt(0)" ::: "memory")
__device__ __forceinline__ unsigned f2bf(float f) { unsigned u = __builtin_bit_cast(unsigned, f); return (u + 0x7fffu + ((u >> 16) & 1u)) >> 16; }
__device__ __forceinline__ unsigned pk2(float lo, float hi) { return f2bf(lo) | (f2bf(hi) << 16); }
__device__ __forceinline__ float bflo(unsigned u) { return __builtin_bit_cast(float, u << 16); }
__device__ __forceinline__ float bfhi(unsigned u) { return __builtin_bit_cast(float, u & 0xffff0000u); }
template <int MASK> __device__ __forceinline__ float swz_xor(float v) { return __builtin_bit_cast(float, __builtin_amdgcn_ds_swizzle(__builtin_bit_cast(int, v), 0x1F | (MASK << 10))); }
__device__ __forceinline__ float xor32_sum(float v) { float a = v, b = v; asm volatile("s_nop 1\n\tv_permlane32_swap_b32 %0, %1\n\ts_nop 1" : "+v"(a), "+v"(b)); return a + b; }
__device__ __forceinline__ float xor32_max(float v) { float a = v, b = v; asm volatile("s_nop 1\n\tv_permlane32_swap_b32 %0, %1\n\ts_nop 1" : "+v"(a), "+v"(b)); return fmaxf(a, b); }
__device__ __forceinline__ float wave_sum(float v) { v += swz_xor<1>(v); v += swz_xor<2>(v); v += swz_xor<4>(v); v += swz_xor<8>(v); v += swz_xor<16>(v); return xor32_sum(v); }
__device__ __forceinline__ float sigmoidf_(float x) { return 1.0f / (1.0f + __expf(-x)); }
#define XB_TMO      128
#define XB_XCNT(j)  (256  + 64 * (j))
#define XB_XSUB(j)  (1280 + 64 * (j))
#define XB_XGEN(j)  (2304 + 64 * (j))
#define XB_TOP      3328
#define XB_TOPGEN   3392
#define XCD_BAR_WORDS 3456
#define XB_SPIN_CAP (1u << 18)

__device__ __forceinline__ unsigned xb_ld(unsigned* p)              { return __hip_atomic_load(p, __ATOMIC_RELAXED, __HIP_MEMORY_SCOPE_AGENT); }
__device__ __forceinline__ unsigned xb_add(unsigned* p, unsigned v) { return __hip_atomic_fetch_add(p, v, __ATOMIC_RELAXED, __HIP_MEMORY_SCOPE_AGENT); }
__device__ __forceinline__ unsigned xb_xcc_id() { return (unsigned)__builtin_amdgcn_s_getreg((3 << 11) | 20) & 0xFu; }
#define XB_SPIN(cond, bar) do { unsigned _sp = 0; while (cond) { __builtin_amdgcn_s_sleep(1); \
    if ((++_sp & 255u) == 0u) { if (xb_ld(&(bar)[XB_TMO])) break; if (_sp > XB_SPIN_CAP) { atomicAdd(&(bar)[XB_TMO], 1u); break; } } } } while (0)

struct XcdBarrier {
    unsigned* bar; unsigned x; unsigned w;
    volatile LAS unsigned* st;
};

__device__ __forceinline__ bool xb_t0(unsigned w) { unsigned l; asm volatile("v_mbcnt_lo_u32_b32 %0, -1, 0\n\tv_mbcnt_hi_u32_b32 %0, -1, %0" : "=v"(l)); return w == 0u && l == 0u; }
__device__ __forceinline__ XcdBarrier xcd_barrier_post(unsigned* bar, volatile LAS unsigned* st, unsigned w) {
    XcdBarrier b; b.bar = bar; b.x = xb_xcc_id(); b.st = st; b.w = w;
    if (xb_t0(w)) (void)xb_add(&bar[XB_XCNT(b.x)], 1u);
    return b;
}
__device__ __forceinline__ void xcd_barrier_complete(unsigned* bar, unsigned x, unsigned& nloc, unsigned& nx) {
    const unsigned G = gridDim.x * gridDim.y * gridDim.z;
    unsigned sum, cnt, mine, sp = 0u;
    for (;;) {
        sum = 0u; cnt = 0u; mine = 0u;
#pragma unroll
        for (unsigned j = 0; j < 16; ++j) { const unsigned c = xb_ld(&bar[XB_XCNT(j)]); sum += c; cnt += (c > 0u) ? 1u : 0u; mine = (j == x) ? c : mine; }
        if (sum == G) break;
        __builtin_amdgcn_s_sleep(1);
        if ((++sp & 255u) == 0u) { if (xb_ld(&bar[XB_TMO])) break; if (sp > XB_SPIN_CAP) { atomicAdd(&bar[XB_TMO], 1u); break; } }
    }
    nloc = mine > 0u ? mine : 1u; nx = cnt > 0u ? cnt : 1u;
}

__device__ __forceinline__ void xcd_barrier(const XcdBarrier& b) {
    asm volatile("s_waitcnt vmcnt(0)" ::: "memory");
    __syncthreads();
    if (xb_t0(b.w)) {
        unsigned* bar = b.bar;
        __builtin_amdgcn_s_waitcnt(0);
        unsigned nloc = b.st[0], nx = b.st[1];
        if (nloc == 0u) { xcd_barrier_complete(bar, b.x, nloc, nx); b.st[0] = nloc; b.st[1] = nx; }
        const unsigned old = xb_add(&bar[XB_XSUB(b.x)], 1u);
        const unsigned gen = old / nloc;
        if (old + 1u == (gen + 1u) * nloc) {
            __builtin_amdgcn_fence(__ATOMIC_RELEASE, "agent");
            asm volatile("s_waitcnt vmcnt(0)" ::: "memory");
            const unsigned og = xb_add(&bar[XB_TOP], 1u);
            const unsigned tg = og / nx;
            if (og + 1u == (tg + 1u) * nx) xb_add(&bar[XB_TOPGEN], 1u);
            else XB_SPIN(xb_ld(&bar[XB_TOPGEN]) == tg, bar);
            __builtin_amdgcn_fence(__ATOMIC_ACQUIRE, "agent");
            xb_add(&bar[XB_XGEN(b.x)], 1u);
            asm volatile("s_waitcnt vmcnt(0)" ::: "memory");
        } else {
            XB_SPIN(xb_ld(&bar[XB_XGEN(b.x)]) == gen, bar);
            __builtin_amdgcn_fence(__ATOMIC_ACQUIRE, "agent");
            asm volatile("s_waitcnt vmcnt(0)" ::: "memory");
        }
    }
    __syncthreads();
}
struct Args { const void* in[36]; float* out; unsigned char* ws; int ph_lo, ph_hi, li, pad; };
typedef const __attribute__((address_space(4))) Args* cargs;
__device__ __forceinline__ int lane_id() { int l; asm volatile("v_mbcnt_lo_u32_b32 %0, -1, 0\n\tv_mbcnt_hi_u32_b32 %0, -1, %0" : "=v"(l)); return l; }
struct Frame { LAS unsigned char* lds; unsigned char* ws; float* out; int lane, wave, bid, gw, NGW, G, NT; };
#define LANE F.lane
__device__ __forceinline__ Frame make_frame(cargs ap, int wave0, LAS unsigned char* lds) {
    Frame F; int w = wave0, b = (int)blockIdx.x, g = (int)gridDim.x; asm volatile("" : "+s"(w), "+s"(b), "+s"(g));
    F.lds = lds; F.ws = ap->ws; F.out = ap->out; F.lane = lane_id(); F.wave = w; F.bid = b; F.G = g; F.gw = b * NWAVES + w; F.NGW = g * NWAVES; F.NT = g * NTHR;
    return F;
}

__device__ __forceinline__ int rope_perm_col(int n) { const int c = n % 192; if (c < 128) return n; const int j = c - 128; return n - c + 128 + 2 * (j & 31) + (j >> 5); }
__device__ __forceinline__ void tr_item(const float* W, int ldw, int col0, int Kvalid, int nblk, bf16* WT, int ldt, bool zpad, LAS float* scr, int item, int lane, bool rperm = false) {
    const int kb = item / nblk, nb = item % nblk, k0 = 64 * kb, n0 = 32 * nb;
#pragma unroll 8
    for (int i = 0; i < 32; ++i) { const int kk = 2 * i + (lane >> 5); scr[kk * 33 + (lane & 31)] = (k0 + kk < Kvalid) ? W[(size_t)(k0 + kk) * ldw + col0 + n0 + (lane & 31)] : 0.f; }
    LDS_WAIT(); asm volatile("" ::: "memory");
    const int c = lane & 7;
#pragma unroll
    for (int j = 0; j < 4; ++j) { const int n = (lane >> 3) + 8 * j; const LAS float* s = scr + (8 * c) * 33 + n;
        v4u o; o.x = pk2(s[0 * 33], s[1 * 33]); o.y = pk2(s[2 * 33], s[3 * 33]); o.z = pk2(s[4 * 33], s[5 * 33]); o.w = pk2(s[6 * 33], s[7 * 33]);
        const int nd = rperm ? rope_perm_col(n0 + n) : n0 + n;
        *(v4u*)(WT + (size_t)nd * ldt + k0 + 8 * c) = o;
        if (zpad) *(v4u*)(WT + (size_t)nd * ldt + 64 + 8 * c) = (v4u){0u, 0u, 0u, 0u}; }
    LDS_WAIT(); asm volatile("" ::: "memory");
}
#define TRJOB_(W_, ldw_, col0_, Kv_, Nc_, WT_, ldt_, zp_, rp_) do { const int nblk_ = (Nc_) / 32, items_ = (((Kv_) + 63) / 64) * nblk_; \
    for (int it_ = F.gw; it_ < items_; it_ += F.NGW) tr_item((W_), (ldw_), (col0_), (Kv_), nblk_, (bf16*)(WT_), (ldt_), (zp_), scr, it_, LANE, (rp_)); } while (0)
#define TRJOB(W_, ldw_, col0_, Kv_, Nc_, WT_, ldt_, zp_) TRJOB_(W_, ldw_, col0_, Kv_, Nc_, WT_, ldt_, zp_, false)

__device__ __forceinline__ void p0_prologue(Frame& F, cargs a) {
    LAS float* scr = (LAS float*)(F.lds + F.wave * 16384);
    unsigned char* ws = F.ws;
    for (int l = 0; l < 2; ++l) {
        for (int p = 0; p < 4; ++p) TRJOB((const float*)a->in[9] + (size_t)(l * 4 + p) * 1024 * 2048, 2048, 0, 1024, 2048, ws + WS_WIN + (size_t)(l * 4 + p) * 4 * MiB, 1024, false);
        TRJOB((const float*)a->in[11] + (size_t)l * 1024 * 64, 64, 0, 1024, 64, ws + WS_W1 + (size_t)l * (MiB / 2), 1024, false);
        TRJOB((const float*)a->in[14] + (size_t)l * 1024 * 64, 64, 0, 1024, 64, ws + WS_W1 + (size_t)(2 + l) * (MiB / 2), 1024, false);
        TRJOB((const float*)a->in[12] + (size_t)l * 64 * 2048, 2048, 0, 64, 2048, ws + WS_W2 + (size_t)l * (MiB / 2), 128, true);
        TRJOB((const float*)a->in[15] + (size_t)l * 64 * 2048, 2048, 0, 64, 2048, ws + WS_W2 + (size_t)(2 + l) * (MiB / 2), 128, true);
        TRJOB((const float*)a->in[24] + (size_t)l * 2048 * 1024, 1024, 0, 2048, 1024, ws + WS_WO + (size_t)l * 4 * MiB, 2048, false);
        TRJOB((const float*)a->in[31] + (size_t)l * 1024 * 2432, 2432, 0, 1024, 384, ws + WS_WQ + (size_t)l * MiB, 1024, false);
        TRJOB((const float*)a->in[31] + (size_t)l * 1024 * 2432, 2432, 384, 1024, 2048, ws + WS_WZ + (size_t)l * 4 * MiB, 1024, false);
        TRJOB_((const float*)a->in[33] + (size_t)l * 384 * 3072, 3072, 0, 384, 3072, ws + WS_WUQ + (size_t)l * (5 * MiB / 2), 384, false, true);
        TRJOB((const float*)a->in[34] + (size_t)l * 2048 * 1024, 1024, 0, 2048, 1024, ws + WS_WBO + (size_t)l * 4 * MiB, 2048, false);
    }
    TRJOB((const float*)a->in[17], 32, 0, 1024, 32, ws + WS_W1 + (size_t)4 * (MiB / 2), 1024, false);
    TRJOB((const float*)a->in[18], 2048, 0, 32, 2048, ws + WS_W2 + (size_t)4 * (MiB / 2), 128, true);
    TRJOB((const float*)a->in[26], 320, 0, 1024, 320, ws + WS_WDKV, 1024, false);
    TRJOB((const float*)a->in[28], 2048, 0, 256, 2048, ws + WS_WUK, 256, false);
    TRJOB((const float*)a->in[29], 2048, 0, 256, 2048, ws + WS_WUV, 256, false);
    { const f32x4* xp = (const f32x4*)a->in[0]; const f32x4* xs = (const f32x4*)a->in[1]; f32x4* X4 = (f32x4*)(ws + WS_X);
      for (size_t i = (F.bid * NTHR + F.wave * 64 + LANE); i < (size_t)MT * 256; i += F.NT) { const int m = (int)(i >> 8);
          f32x4 v = (f32x4){0.f, 0.f, 0.f, 0.f}; if (m < MP) v = xp[i]; else if (m < MP + DEC_BATCH) v = xs[i - (size_t)MP * 256]; X4[i] = v; } }
    { float* T = (float*)(ws + WS_ROPE);
      for (int i = (F.bid * NTHR + F.wave * 64 + LANE); i < 2049 * 32; i += F.NT) { const int p = i >> 5, f = i & 31; const double pos = p < 2048 ? (double)p : 8192.0;
          const double ang = pos * pow(10000.0, -(double)f / 32.0); T[2 * i] = (float)cos(ang); T[2 * i + 1] = (float)sin(ang); } }
}

__device__ __forceinline__ void load_row(const float* row, int lane, f32x4 (&v)[4]) {
#pragma unroll
    for (int j = 0; j < 4; ++j) v[j] = ((const f32x4*)row)[lane + 64 * j];
}
__device__ __forceinline__ float row_rs(const f32x4 (&v)[4]) {
    float s = 0.f;
#pragma unroll
    for (int j = 0; j < 4; ++j) s += (v[j].x * v[j].x + v[j].y * v[j].y) + (v[j].z * v[j].z + v[j].w * v[j].w);
    return 1.0f / sqrtf(wave_sum(s) * (1.0f / 1024.0f) + NORM_EPS);
}
__device__ __forceinline__ void norm_rows_bf16(Frame& F, const float* X, const float* w, bf16* O) {
    f32x4 w4[4]; load_row(w, LANE, w4);
    for (int m = F.gw; m < MT; m += F.NGW) { f32x4 x[4]; load_row(X + (size_t)m * 1024, LANE, x); const float rs = row_rs(x);
#pragma unroll
        for (int j = 0; j < 4; ++j) { const f32x4 h = x[j] * rs * w4[j]; v2u o; o.x = pk2(h.x, h.y); o.y = pk2(h.z, h.w); *(v2u*)(O + (size_t)m * 1024 + 4 * LANE + 256 * j) = o; } }
}

__device__ __forceinline__ void a1_prepass(Frame& F, cargs a, int l) {
    const float* X = (const float*)(F.ws + WS_X);
    const float* nw = (const float*)a->in[7] + l * 1024; const float* mix = (const float*)a->in[8] + l * 6 * 1024; const float* sshift = (const float*)a->in[3] + (size_t)l * DEC_BATCH * 1024;
    f32x4 w4[4]; load_row(nw, LANE, w4);
    for (int m = F.gw; m < MT; m += F.NGW) {
        f32x4 x[4], h[4], hp[4]; load_row(X + (size_t)m * 1024, LANE, x); const float rs = row_rs(x);
#pragma unroll
        for (int j = 0; j < 4; ++j) { h[j] = x[j] * rs * w4[j]; hp[j] = (f32x4){0.f, 0.f, 0.f, 0.f}; }
        if (m < MP) { if ((m & (SEQ - 1)) != 0) { f32x4 xq[4]; load_row(X + (size_t)(m - 1) * 1024, LANE, xq); const float rq = row_rs(xq);
#pragma unroll
                for (int j = 0; j < 4; ++j) hp[j] = xq[j] * rq * w4[j]; } }
        else if (m < MP + DEC_BATCH) load_row(sshift + (size_t)(m - MP) * 1024, LANE, hp);
#pragma unroll
        for (int p = 0; p < 6; ++p) { bf16* O = (bf16*)(F.ws + WS_AM + (size_t)p * AM_STRIDE) + (size_t)m * 1024;
#pragma unroll
            for (int j = 0; j < 4; ++j) { const f32x4 mx = ((const f32x4*)(mix + p * 1024))[LANE + 64 * j]; const f32x4 o = h[j] + (hp[j] - h[j]) * mx;
                v2u w; w.x = pk2(o.x, o.y); w.y = pk2(o.z, o.w); *(v2u*)(O + 4 * LANE + 256 * j) = w; } }
        float* so = nullptr;
        if (m < MP) { if ((m & (SEQ - 1)) == SEQ - 1) so = F.out + O_SHP + (size_t)(l * BATCH + (m >> 11)) * 1024; }
        else if (m < MP + DEC_BATCH) so = F.out + O_SHS + (size_t)(l * DEC_BATCH + (m - MP)) * 1024;
        if (so) {
#pragma unroll
            for (int j = 0; j < 4; ++j) ((f32x4*)so)[LANE + 64 * j] = h[j]; }
    }
}

typedef float f32x2 __attribute__((ext_vector_type(2)));
__device__ __forceinline__ void unpack8(v4u u, float (&f)[8]) { f[0] = bflo(u.x); f[1] = bfhi(u.x); f[2] = bflo(u.y); f[3] = bfhi(u.y); f[4] = bflo(u.z); f[5] = bfhi(u.z); f[6] = bflo(u.w); f[7] = bfhi(u.w); }
constexpr int FS_TS = 16, FS_Y = FS_TS * 6 * 64 * 4, FS_Z = FS_Y + FS_TS * 64 * 4, FS_BON = FS_Z + FS_TS * 64 * 2, FS_BH = FS_BON + 128, FS_BUF = 2 * FS_BH;
static_assert(2 * FS_BUF <= RING_BYTES && FS_BH % 16 == 0, "fused scan LDS");
template <int CTRL> __device__ __forceinline__ float dppf(float v) { return __builtin_bit_cast(float, __builtin_amdgcn_update_dpp(0, __builtin_bit_cast(int, v), CTRL, 0xF, 0xF, false)); }
__device__ __forceinline__ float wave_sum_fast(float v) {
    v += dppf<0xB1>(v); v += dppf<0x4E>(v); v += dppf<0x124>(v); v += dppf<0x128>(v);
    const int iv = __builtin_bit_cast(int, v);
    return (__builtin_bit_cast(float, __builtin_amdgcn_readlane(iv, 0)) + __builtin_bit_cast(float, __builtin_amdgcn_readlane(iv, 16))) + (__builtin_bit_cast(float, __builtin_amdgcn_readlane(iv, 32)) + __builtin_bit_cast(float, __builtin_amdgcn_readlane(iv, 48)));
}
struct HeadPrm { float w0, a0, v0, kk, ka, rk, lnw, lnb; };
__device__ __forceinline__ float frcp(float x) { return __builtin_amdgcn_rcpf(x); }
__device__ __forceinline__ float fsig(float x) { return __builtin_amdgcn_rcpf(1.0f + __builtin_amdgcn_exp2f(-1.4426950408889634f * x)); }
__device__ __forceinline__ float wkv_step_lds(f32x2 (&S)[32], const LAS float* op, int lane) {
    const LAS f32x4* a4 = (const LAS f32x4*)op; const LAS f32x4* w4 = a4 + 16; const LAS f32x4* b4 = a4 + 32; const LAS f32x4* k4 = a4 + 48; const LAS f32x4* r4 = a4 + 64;
    const float vv = op[320 + lane];
    f32x2 s0 = (f32x2){0.f, 0.f}, s1 = s0;
#pragma unroll
    for (int q = 0; q < 16; ++q) { const f32x4 a = a4[q]; s0 += S[2 * q] * (f32x2){a.x, a.y}; s1 += S[2 * q + 1] * (f32x2){a.z, a.w}; }
    const f32x2 st = s0 + s1; const float sa = st.x + st.y; const f32x2 sa2 = (f32x2){sa, sa}, vv2 = (f32x2){vv, vv};
    f32x2 y0 = (f32x2){0.f, 0.f}, y1 = y0;
#pragma unroll
    for (int q = 0; q < 16; ++q) { const f32x4 w = w4[q], b = b4[q], k = k4[q], r = r4[q];
        S[2 * q] = S[2 * q] * (f32x2){w.x, w.y} + (sa2 * (f32x2){b.x, b.y} + vv2 * (f32x2){k.x, k.y}); y0 += S[2 * q] * (f32x2){r.x, r.y};
        S[2 * q + 1] = S[2 * q + 1] * (f32x2){w.z, w.w} + (sa2 * (f32x2){b.z, b.w} + vv2 * (f32x2){k.z, k.w}); y1 += S[2 * q + 1] * (f32x2){r.z, r.w}; }
    const f32x2 yt = y0 + y1; return yt.x + yt.y;
}
__device__ __forceinline__ void fs_prep_one(const HeadPrm& P, int l, float r, float k, float v, float dw, float da, float dv, float vf, LAS float* op, int lane, float& bon) {
    const float ia = sigmoidf_(P.a0 + da), w = __expf(-0.6065306597126334f * sigmoidf_(P.w0 + dw));
    if (l) v = v + (vf - v) * sigmoidf_(P.v0 + dv);
    const float kk = k * P.kk, n2 = wave_sum_fast(kk * kk), inv = 1.0f / fmaxf(sqrtf(n2), 1e-12f), q = kk * inv, kp = k * (1.0f + (ia - 1.0f) * P.ka);
    bon = wave_sum_fast(r * kp * P.rk);
    op[lane] = -q; op[64 + lane] = w; op[128 + lane] = q * ia; op[192 + lane] = kp; op[256 + lane] = r; op[320 + lane] = v;
}
__device__ __forceinline__ float fs_post_one(const HeadPrm& P, float y, float vp, float z, float bon) {
    const float mu = wave_sum_fast(y) * (1.0f / 64.0f), d = y - mu, var = wave_sum_fast(d * d) * (1.0f / 64.0f);
    const float yn = d * __builtin_amdgcn_rsqf(var + GN_EPS) * P.lnw + P.lnb; return (yn + bon * vp) * (z * fsig(z));
}
__device__ __forceinline__ float ldbf(const bf16* p) { return bflo((unsigned)*p); }
__device__ __forceinline__ bf16 tobf(float x) { return __builtin_bit_cast(unsigned short, (__bf16)x); }
typedef short s16x4_t __attribute__((ext_vector_type(4)));
#define MF16(a_, b_, c_) __builtin_amdgcn_mfma_f32_16x16x16bf16_1k((a_), (b_), (c_), 0, 0, 0)
#define MF32(a_, b_, c_) __builtin_amdgcn_mfma_f32_16x16x32_bf16((a_), (b_), (c_), 0, 0, 0)
typedef __bf16 bf16x4_nat __attribute__((ext_vector_type(4)));
__device__ __forceinline__ s16x4_t cvt4(f32x4 v) { return __builtin_bit_cast(s16x4_t, __builtin_convertvector(v, bf16x4_nat)); }
constexpr int CK_TP = 144, CK_KP = 40;
constexpr int CK_AT = 0, CK_RT = CK_AT + 16 * CK_TP, CK_BH = CK_RT + 16 * CK_TP, CK_KH = CK_BH + 16 * CK_TP, CK_BHT = CK_KH + 16 * CK_TP, CK_KHT = CK_BHT + 64 * CK_KP, CK_VT = CK_KHT + 64 * CK_KP,
    CK_PC = CK_VT + 64 * CK_KP, CK_OPB = CK_PC + 256;
constexpr int RG_VP = 0, RG_Z = 2048, RG_BON = 4096, RG_SZ = 4224;
constexpr int BH_OPB = 0, BH_RING = 2 * CK_OPB, BH_Y = BH_RING + 3 * RG_SZ, BH_SZ = BH_Y + 2 * 4096;
static_assert(2 * BH_SZ <= RING_BYTES && BH_SZ % 16 == 0 && CK_OPB % 16 == 0, "chunked scan LDS");
__device__ __forceinline__ void ck_scan_chunk(f32x4 (&ST)[4][4], const LAS unsigned char* ob, LAS float* yb, int c16, int g) {
    const f32x4 zero4 = (f32x4){0.f, 0.f, 0.f, 0.f};
    bf16x8 at[2], rt[2], bh[2], kh[2];
#pragma unroll
    for (int ks = 0; ks < 2; ++ks) { const int o = c16 * CK_TP + 16 * g + 64 * ks;
        at[ks] = *(const LAS bf16x8*)(ob + CK_AT + o); rt[ks] = *(const LAS bf16x8*)(ob + CK_RT + o); bh[ks] = *(const LAS bf16x8*)(ob + CK_BH + o); kh[ks] = *(const LAS bf16x8*)(ob + CK_KH + o); }
    f32x4 qN = zero4, qL = zero4, qMk = zero4, qNbr = zero4, qNkr = zero4;
#pragma unroll
    for (int ks = 0; ks < 2; ++ks) { qN = MF32(bh[ks], at[ks], qN); qL = MF32(at[ks], bh[ks], qL); qMk = MF32(kh[ks], at[ks], qMk); qNbr = MF32(bh[ks], rt[ks], qNbr); qNkr = MF32(kh[ks], rt[ks], qNkr); }
    f32x4 Id;
#pragma unroll
    for (int r = 0; r < 4; ++r) { const int row = 4 * g + r; Id[r] = row == c16 ? 1.f : 0.f;
        if (!(row < c16)) { qN[r] = 0.f; qMk[r] = 0.f; }
        if (!(row <= c16)) { qNbr[r] = 0.f; qNkr[r] = 0.f; }
        if (!(c16 < row)) qL[r] = 0.f; }
    const s16x4_t aN = cvt4(qN), aL = cvt4(qL), aMk = cvt4(qMk), aNbr = cvt4(qNbr), aNkr = cvt4(qNkr);
    const f32x4 n2 = MF16(aL, aN, zero4), l2 = MF16(aN, aL, zero4);
    const s16x4_t aN2 = cvt4(n2), aL2 = cvt4(l2);
    const f32x4 n4 = MF16(aL2, aN2, zero4), l4 = MF16(aN2, aL2, zero4);
    const f32x4 n8 = MF16(cvt4(l4), cvt4(n4), zero4);
    const f32x4 p1t = MF16(cvt4(n2 + Id), cvt4(qL + Id), zero4);
    const f32x4 p2 = MF16(cvt4(l4 + Id), cvt4(n8 + Id), zero4);
    const s16x4_t aT = cvt4(MF16(cvt4(p1t), cvt4(p2), zero4));
    s16x4_t af[4], rf[4]; s16x4_t Sb[4];
#pragma unroll
    for (int ki = 0; ki < 4; ++ki) { const int o = c16 * CK_TP + (16 * ki + 4 * g) * 2; af[ki] = *(const LAS s16x4_t*)(ob + CK_AT + o); rf[ki] = *(const LAS s16x4_t*)(ob + CK_RT + o); }
#pragma unroll
    for (int vi = 0; vi < 4; ++vi) {
        f32x4 xt = zero4, y0 = zero4;
#pragma unroll
        for (int ki = 0; ki < 4; ++ki) { Sb[ki] = cvt4(ST[ki][vi]); xt = MF16(af[ki], Sb[ki], xt); y0 = MF16(rf[ki], Sb[ki], y0); }
        const s16x4_t vt = *(const LAS s16x4_t*)(ob + CK_VT + (16 * vi + c16) * CK_KP + 8 * g);
        xt = MF16(aMk, vt, xt);
        const s16x4_t ub = cvt4(MF16(aT, cvt4(xt), zero4));
        y0 = MF16(aNbr, ub, y0); y0 = MF16(aNkr, vt, y0);
#pragma unroll
        for (int r = 0; r < 4; ++r) yb[(4 * g + r) * 64 + 16 * vi + c16] = y0[r];
#pragma unroll
        for (int ki = 0; ki < 4; ++ki) { const int o = (16 * ki + c16) * CK_KP + 8 * g;
            const s16x4_t bf_ = *(const LAS s16x4_t*)(ob + CK_BHT + o), kf_ = *(const LAS s16x4_t*)(ob + CK_KHT + o);
            ST[ki][vi] = MF16(bf_, ub, ST[ki][vi]); ST[ki][vi] = MF16(kf_, vt, ST[ki][vi]); }
    }
#pragma unroll
    for (int ki = 0; ki < 4; ++ki) { const f32x4 pc = *(const LAS f32x4*)(ob + CK_PC + (16 * ki + 4 * g) * 4);
#pragma unroll
        for (int vi = 0; vi < 4; ++vi) ST[ki][vi] *= pc; }
}
__device__ __forceinline__ void a5_fused(Frame& F, cargs a, int l) {
    unsigned char* ws = F.ws; const int lane = F.lane;
    const bf16* R = (const bf16*)(ws + WS_R); const bf16* K = (const bf16*)(ws + WS_K); const bf16* V = (const bf16*)(ws + (l ? WS_V1 : WS_V0)); const bf16* VF = (const bf16*)(ws + WS_V0); const bf16* Z = (const bf16*)(ws + WS_Z);
    const bf16* DW = (const bf16*)(ws + WS_WD); const bf16* DA = (const bf16*)(ws + WS_IA); const bf16* DV = (const bf16*)(ws + WS_VG); bf16* G = (bf16*)(ws + WS_G);
    const float* pw0 = (const float*)a->in[10] + l * 2048; const float* pa0 = (const float*)a->in[13] + l * 2048; const float* pv0 = (const float*)a->in[16]; const float* pkk = (const float*)a->in[19] + l * 2048;
    const float* pka = (const float*)a->in[20] + l * 2048; const float* prk = (const float*)a->in[21] + l * 2048; const float* plw = (const float*)a->in[22] + l * 2048; const float* plb = (const float*)a->in[23] + l * 2048;
    constexpr int NCH = SEQ / 16;
    for (int pr = F.bid; pr < BATCH * A_HEADS / 2; pr += F.G) { const int bh0 = 2 * pr;
        const int role = F.wave >> 1, hb = F.wave & 1, bh = bh0 + hb, b = bh >> 5, hh = bh & 31, ch = hh * 64 + lane;
        LAS unsigned char* blk = F.lds + hb * BH_SZ;
        HeadPrm P; P.w0 = pw0[ch]; P.a0 = pa0[ch]; P.v0 = l ? pv0[ch] : 0.f; P.kk = pkk[ch]; P.ka = pka[ch]; P.rk = prk[ch]; P.lnw = plw[ch]; P.lnb = plb[ch];
        const size_t rowb = (size_t)b * SEQ; const int c16 = lane & 15, g = lane >> 4;
#define CK_BAR() do { asm volatile("s_waitcnt lgkmcnt(0)" ::: "memory"); __builtin_amdgcn_s_barrier(); asm volatile("" ::: "memory"); } while (0)
#define CK_LOAD(cc, hf, SET) do { _Pragma("unroll") for (int t = 0; t < 8; ++t) { const size_t o = (rowb + (size_t)(cc) * 16 + 8 * (hf) + t) * 2048 + ch; \
                SET##r[t] = R[o]; SET##k[t] = K[o]; SET##v[t] = V[o]; SET##z[t] = Z[o]; SET##w[t] = DW[o]; SET##a[t] = DA[o]; if (l) { SET##d[t] = DV[o]; SET##f[t] = VF[o]; } if (hf) SET##e[t] = DW[o - (size_t)8 * 2048]; } } while (0)
#define CK_PREP(cc, hf, SET) do { LAS unsigned char* ob = blk + BH_OPB + ((cc) & 1) * CK_OPB; LAS unsigned char* rg = blk + BH_RING + ((cc) % 3) * RG_SZ; float Pc = 1.0f; \
            if (hf) { _Pragma("unroll") for (int tt = 0; tt < 8; ++tt) Pc *= __builtin_amdgcn_exp2f(-0.8750387749f * fsig(P.w0 + bflo((unsigned)SET##e[tt]))); } \
            _Pragma("unroll") for (int tt = 0; tt < 8; ++tt) { const int t = 8 * (hf) + tt; const float r_ = bflo((unsigned)SET##r[tt]), k_ = bflo((unsigned)SET##k[tt]), dw_ = bflo((unsigned)SET##w[tt]), da_ = bflo((unsigned)SET##a[tt]); float vv = bflo((unsigned)SET##v[tt]); \
                const float ia = fsig(P.a0 + da_), w = __builtin_amdgcn_exp2f(-0.8750387749f * fsig(P.w0 + dw_)); if (l) vv = vv + (bflo((unsigned)SET##f[tt]) - vv) * fsig(P.v0 + bflo((unsigned)SET##d[tt])); \
                const float kk = k_ * P.kk, n2 = wave_sum_fast(kk * kk), q = kk * __builtin_amdgcn_rsqf(fmaxf(n2, 1e-24f)), kp = k_ * (1.0f + (ia - 1.0f) * P.ka), bon = wave_sum_fast(r_ * kp * P.rk); \
                const float Pm1 = Pc; Pc *= w; const float rp = frcp(Pc); \
                ((LAS bf16*)(ob + CK_AT + t * CK_TP))[lane] = tobf(-q * Pm1); ((LAS bf16*)(ob + CK_RT + t * CK_TP))[lane] = tobf(r_ * Pc); \
                const bf16 bq = tobf(q * ia * rp), kq = tobf(kp * rp), vq = tobf(vv); \
                ((LAS bf16*)(ob + CK_BH + t * CK_TP))[lane] = bq; ((LAS bf16*)(ob + CK_KH + t * CK_TP))[lane] = kq; \
                ((LAS bf16*)(ob + CK_BHT + lane * CK_KP))[t] = bq; ((LAS bf16*)(ob + CK_KHT + lane * CK_KP))[t] = kq; ((LAS bf16*)(ob + CK_VT + lane * CK_KP))[t] = vq; \
                ((LAS bf16*)(rg + RG_VP))[t * 64 + lane] = vq; ((LAS bf16*)(rg + RG_Z))[t * 64 + lane] = SET##z[tt]; if (lane == 0) ((LAS float*)(rg + RG_BON))[t] = bon; } \
            if ((hf) == 1) ((LAS float*)(ob + CK_PC))[lane] = Pc; } while (0)
#define CK_POST(cc) do { const LAS unsigned char* rg = blk + BH_RING + ((cc) % 3) * RG_SZ; const LAS float* yb = (const LAS float*)(blk + BH_Y + ((cc) & 1) * 4096); \
            _Pragma("unroll 4") for (int t = 0; t < 16; ++t) { const float y = yb[t * 64 + lane], vp = bflo((unsigned)((const LAS bf16*)(rg + RG_VP))[t * 64 + lane]), z = bflo((unsigned)((const LAS bf16*)(rg + RG_Z))[t * 64 + lane]), bon = ((const LAS float*)(rg + RG_BON))[t]; \
                G[(rowb + (size_t)(cc) * 16 + t) * 2048 + ch] = (bf16)f2bf(fs_post_one(P, y, vp, z, bon)); } } while (0)
        typedef unsigned short us2 __attribute__((ext_vector_type(2)));
        if (role == 0) { f32x4 ST[4][4];
#pragma unroll
            for (int i = 0; i < 4; ++i)
#pragma unroll
                for (int j = 0; j < 4; ++j) ST[i][j] = (f32x4){0.f, 0.f, 0.f, 0.f};
            CK_BAR();
            for (int c = 0; c < NCH; ++c) { ck_scan_chunk(ST, blk + BH_OPB + (c & 1) * CK_OPB, (LAS float*)(blk + BH_Y + (c & 1) * 4096), c16, g); CK_BAR(); }
            float* so = F.out + O_WKVP + ((size_t)(l * BATCH + b) * A_HEADS + hh) * 4096;
#pragma unroll
            for (int ki = 0; ki < 4; ++ki)
#pragma unroll
                for (int vi = 0; vi < 4; ++vi) *(f32x4*)(so + (16 * vi + c16) * 64 + 16 * ki + 4 * g) = ST[ki][vi]; }
        else if (role == 1 || role == 3) { const int hf = role == 3;
            bf16 Ar[8], Ak[8], Av[8], Az[8], Aw[8], Aa[8], Ad[8], Af[8], Ae[8], Br[8], Bk[8], Bv[8], Bz[8], Bw[8], Ba[8], Bd[8], Bf[8], Be[8];
#pragma unroll
            for (int t = 0; t < 8; ++t) { Ad[t] = 0; Af[t] = 0; Ae[t] = 0; Bd[t] = 0; Bf[t] = 0; Be[t] = 0; }
            CK_LOAD(0, hf, A); CK_LOAD(1, hf, B); CK_PREP(0, hf, A); CK_LOAD(2, hf, A); CK_BAR();
            for (int c = 0; c < NCH; c += 2) {
                if (c + 1 < NCH) { CK_PREP(c + 1, hf, B); if (c + 3 < NCH) CK_LOAD(c + 3, hf, B); } CK_BAR();
                if (c + 2 < NCH) { CK_PREP(c + 2, hf, A); if (c + 4 < NCH) CK_LOAD(c + 4, hf, A); } CK_BAR(); } }
        else if (role == 2) { CK_BAR();
            for (int c = 0; c < NCH; ++c) { if (c >= 1) CK_POST(c - 1); CK_BAR(); } }
        if (role == 2) CK_POST(NCH - 1);
        __syncthreads();
#undef CK_PREP
#undef CK_LOAD
#undef CK_BAR
#undef CK_POST
    }
    const float* stt = (const float*)a->in[2] + (size_t)l * DEC_BATCH * A_HEADS * 4096;
    LAS float* sop = (LAS float*)(F.lds + F.wave * 2048);
    for (int it = F.gw; it < DEC_BATCH * A_HEADS; it += F.NGW) { const int b = it >> 5, hh = it & 31, ch = hh * 64 + lane; const size_t o = (size_t)(MP + b) * 2048 + ch;
        HeadPrm P; P.w0 = pw0[ch]; P.a0 = pa0[ch]; P.v0 = l ? pv0[ch] : 0.f; P.kk = pkk[ch]; P.ka = pka[ch]; P.rk = prk[ch]; P.lnw = plw[ch]; P.lnb = plb[ch];
        const float z = ldbf(Z + o); float bon;
        fs_prep_one(P, l, ldbf(R + o), ldbf(K + o), ldbf(V + o), ldbf(DW + o), ldbf(DA + o), l ? ldbf(DV + o) : 0.f, l ? ldbf(VF + o) : 0.f, sop, lane, bon);
        LDS_WAIT(); asm volatile("" ::: "memory");
        f32x2 S[32]; const float* si = stt + (size_t)it * 4096 + lane * 64;
#pragma unroll
        for (int k = 0; k < 32; k += 2) { const f32x4 v = *(const f32x4*)(si + 2 * k); S[k] = (f32x2){v.x, v.y}; S[k + 1] = (f32x2){v.z, v.w}; }
        const float y = wkv_step_lds(S, sop, lane), vp = sop[320 + lane];
        float* so = F.out + O_WKVS + ((size_t)l * DEC_BATCH * A_HEADS + it) * 4096 + lane * 64;
#pragma unroll
        for (int k = 0; k < 32; k += 2) *(f32x4*)(so + 2 * k) = (f32x4){S[k].x, S[k].y, S[k + 1].x, S[k + 1].y};
        G[o] = (bf16)f2bf(fs_post_one(P, y, vp, z, bon));
        LDS_WAIT(); asm volatile("" ::: "memory");
    }
#undef FS_PREP
#undef FS_POST
}

__device__ __forceinline__ void final_norm(Frame& F, cargs a) {
    const float* X = (const float*)(F.ws + WS_X); f32x4 w4[4]; load_row((const float*)a->in[35], LANE, w4);
    for (int m = F.gw; m < MP + DEC_BATCH; m += F.NGW) { f32x4 x[4]; load_row(X + (size_t)m * 1024, LANE, x); const float rs = row_rs(x);
        float* o = m < MP ? F.out + O_YP + (size_t)m * 1024 : F.out + O_YS + (size_t)(m - MP) * 1024;
#pragma unroll
        for (int j = 0; j < 4; ++j) ((f32x4*)o)[LANE + 64 * j] = x[j] * rs * w4[j]; }
}
__device__ __forceinline__ void b0c_kvpost(Frame& F, cargs a) {
    unsigned char* ws = F.ws; const float* KVR = (const float*)(ws + WS_KVR); bf16* CK = (bf16*)(ws + WS_CKVB); bf16* KP = (bf16*)(ws + WS_KPEB); const float* ROPE = (const float*)(ws + WS_ROPE);
    const f32x4 w4 = ((const f32x4*)a->in[27])[F.lane];
    for (int m = F.gw; m < MP + DEC_BATCH; m += F.NGW) { const float* row = KVR + (size_t)m * 320;
        const f32x4 v = ((const f32x4*)row)[F.lane]; const float ss = wave_sum((v.x * v.x + v.y * v.y) + (v.z * v.z + v.w * v.w));
        const float rs = 1.0f / sqrtf(ss * (1.0f / 256.0f) + NORM_EPS); const f32x4 c = v * rs * w4;
        float* oc = m < MP ? F.out + O_CKVP + (size_t)m * 256 : F.out + O_CKVS + (size_t)(m - MP) * 256; float* ok = m < MP ? F.out + O_KPEP + (size_t)m * 64 : F.out + O_KPES + (size_t)(m - MP) * 64;
        ((f32x4*)oc)[F.lane] = c; v2u pw; pw.x = pk2(c.x, c.y); pw.y = pk2(c.z, c.w); *(v2u*)(CK + (size_t)m * 256 + 4 * F.lane) = pw;
        if (F.lane < 32) { const int i = F.lane, p = m < MP ? (m & (SEQ - 1)) : SEQ; const float x1 = row[256 + i], x2 = row[288 + i], cs = ROPE[(p * 32 + i) * 2], sn = ROPE[(p * 32 + i) * 2 + 1];
            const float o1 = x1 * cs - x2 * sn, o2 = x2 * cs + x1 * sn; ok[i] = o1; ok[32 + i] = o2; *(unsigned*)(KP + (size_t)m * 64 + 2 * i) = pk2(o1, o2); }
    }
}
__device__ __forceinline__ void b1c_cq(Frame& F, cargs a, int l) {
    unsigned char* ws = F.ws; const float* QL = (const float*)(ws + WS_QL); bf16* CQ = (bf16*)(ws + WS_CQ); const float* w = (const float*)a->in[32] + l * 384;
    f32x2 w2[3];
#pragma unroll
    for (int j = 0; j < 3; ++j) w2[j] = *(const f32x2*)(w + 2 * F.lane + 128 * j);
    for (int m = F.gw; m < MT; m += F.NGW) { f32x2 v[3]; float ss = 0.f;
#pragma unroll
        for (int j = 0; j < 3; ++j) { v[j] = *(const f32x2*)(QL + (size_t)m * 384 + 2 * F.lane + 128 * j); ss += v[j].x * v[j].x + v[j].y * v[j].y; }
        const float rs = 1.0f / sqrtf(wave_sum(ss) * (1.0f / 384.0f) + NORM_EPS);
#pragma unroll
        for (int j = 0; j < 3; ++j) *(unsigned*)(CQ + (size_t)m * 384 + 2 * F.lane + 128 * j) = pk2(v[j].x * rs * w2[j].x, v[j].y * rs * w2[j].y); }
}
constexpr int AT_KP = 400, AT_VP = 136, AT_KBYTES = 64 * AT_KP, AT_VBYTES = 128 * AT_VP, AT_BUF = AT_KBYTES + AT_VBYTES;
__device__ __forceinline__ int crow(int r, int hi) { return (r & 3) + 8 * (r >> 2) + 4 * hi; }
typedef __bf16 bf16x8_nat __attribute__((ext_vector_type(8)));
typedef float f32x8 __attribute__((ext_vector_type(8)));
__device__ __forceinline__ bf16x8 pack8f(float a0, float a1, float a2, float a3, float a4, float a5, float a6, float a7) {
    return __builtin_bit_cast(bf16x8, __builtin_convertvector((f32x8){a0, a1, a2, a3, a4, a5, a6, a7}, bf16x8_nat)); }
__device__ __forceinline__ void attn_unit(Frame& F, int b, int hd, int qb) {
    unsigned char* ws = F.ws; const bf16* Q = (const bf16*)(ws + WS_Q); const bf16* KN = (const bf16*)(ws + WS_KN); const bf16* KPE = (const bf16*)(ws + WS_KPEB); const bf16* VT = (const bf16*)(ws + WS_VT);
    const bf16* Z = (const bf16*)(ws + WS_Z); bf16* G = (bf16*)(ws + WS_G);
    LAS unsigned char* Ks = F.lds; LAS unsigned char* Vs = F.lds + AT_KBYTES;
    const int lane = lane_id(), r32 = lane & 31, hi = lane >> 5, tid = F.wave * 64 + lane;
    const int qpos = qb * 256 + F.wave * 32 + r32; const size_t qrow = (size_t)b * SEQ + qpos;
    bf16x8 qf[12];
#pragma unroll
    for (int s = 0; s < 12; ++s) qf[s] = *(const bf16x8*)(Q + qrow * 3072 + hd * 192 + 16 * s + 8 * hi);
    f32x16 o[4];
#pragma unroll
    for (int d = 0; d < 4; ++d)
#pragma unroll
        for (int r = 0; r < 16; ++r) o[d][r] = 0.f;
    float mrow = -1e30f, lrow = 0.f;
    const int ntiles = 4 * qb + 4, wq0 = qb * 256 + F.wave * 32;
    v4u pk_[3], pv_[2];
#define AT_FETCH(kt_) do { const size_t krow0 = (size_t)b * SEQ + (kt_) * 64; \
        _Pragma("unroll") for (int i = 0; i < 3; ++i) { const int c = tid + 512 * i, key = c / 24, ch = c % 24; \
            pk_[i] = ch < 16 ? *(const v4u*)(KN + (krow0 + key) * 2048 + hd * 128 + ch * 8) : *(const v4u*)(KPE + (krow0 + key) * 64 + (ch - 16) * 8); } \
        _Pragma("unroll") for (int i = 0; i < 2; ++i) { const int c = tid + 512 * i, d = c >> 3, ch = c & 7; pv_[i] = *(const v4u*)(VT + (size_t)(hd * 128 + d) * MP + krow0 + ch * 8); } } while (0)
    AT_FETCH(0);
    for (int kt = 0; kt < ntiles; ++kt) {
        __syncthreads();
#pragma unroll
        for (int i = 0; i < 3; ++i) { const int c = tid + 512 * i, key = c / 24, ch = c % 24; *(LAS v4u*)(Ks + key * AT_KP + ch * 16) = pk_[i]; }
#pragma unroll
        for (int i = 0; i < 2; ++i) { const int c = tid + 512 * i, d = c >> 3, ch = c & 7; *(LAS v2u*)(Vs + d * AT_VP + ch * 16) = (v2u){pv_[i].x, pv_[i].y}; *(LAS v2u*)(Vs + d * AT_VP + ch * 16 + 8) = (v2u){pv_[i].z, pv_[i].w}; }
        __syncthreads();
        if (kt + 1 < ntiles) AT_FETCH(kt + 1);
        if (kt * 64 > wq0 + 31) continue;
        const LAS unsigned char* Kc = Ks; const LAS unsigned char* Vc = Vs;
        f32x16 s0, s1;
#pragma unroll
        for (int r = 0; r < 16; ++r) { s0[r] = 0.f; s1[r] = 0.f; }
#pragma unroll
        for (int s = 0; s < 12; ++s) { const bf16x8 a0 = *(const LAS bf16x8*)(Kc + r32 * AT_KP + (16 * s + 8 * hi) * 2), a1 = *(const LAS bf16x8*)(Kc + (32 + r32) * AT_KP + (16 * s + 8 * hi) * 2);
            s0 = __builtin_amdgcn_mfma_f32_32x32x16_bf16(a0, qf[s], s0, 0, 0, 0); s1 = __builtin_amdgcn_mfma_f32_32x32x16_bf16(a1, qf[s], s1, 0, 0, 0); }
        if (kt * 64 + 63 > wq0) {
#pragma unroll
            for (int r = 0; r < 16; ++r) { const int key = kt * 64 + crow(r, hi); if (key > qpos) s0[r] = -__builtin_inff(); if (key + 32 > qpos) s1[r] = -__builtin_inff(); } }
        float tmax = s0[0];
#pragma unroll
        for (int r = 1; r < 16; ++r) tmax = fmaxf(tmax, s0[r]);
#pragma unroll
        for (int r = 0; r < 16; ++r) tmax = fmaxf(tmax, s1[r]);
        tmax = xor32_max(tmax);
        const float mnew = fmaxf(mrow, tmax), alpha = __builtin_amdgcn_exp2f(mrow - mnew); mrow = mnew;
        float ps = 0.f;
#pragma unroll
        for (int r = 0; r < 16; ++r) { s0[r] = __builtin_amdgcn_exp2f(s0[r] - mnew); s1[r] = __builtin_amdgcn_exp2f(s1[r] - mnew); ps += s0[r] + s1[r]; }
        lrow = lrow * alpha + ps;
        if (__builtin_amdgcn_ballot_w64(alpha != 1.0f) != 0ull) {
#pragma unroll
            for (int d = 0; d < 4; ++d)
#pragma unroll
                for (int r = 0; r < 16; ++r) o[d][r] *= alpha; }
        bf16x8 pb[4];
        pb[0] = pack8f(s0[0], s0[1], s0[2], s0[3], s0[4], s0[5], s0[6], s0[7]); pb[1] = pack8f(s0[8], s0[9], s0[10], s0[11], s0[12], s0[13], s0[14], s0[15]);
        pb[2] = pack8f(s1[0], s1[1], s1[2], s1[3], s1[4], s1[5], s1[6], s1[7]); pb[3] = pack8f(s1[8], s1[9], s1[10], s1[11], s1[12], s1[13], s1[14], s1[15]);
#pragma unroll
        for (int ks = 0; ks < 4; ++ks)
#pragma unroll
            for (int d = 0; d < 4; ++d) { const LAS unsigned char* vp = Vc + (32 * d + r32) * AT_VP + (16 * ks + 4 * hi) * 2;
                const v2u lo = *(const LAS v2u*)vp, hi2 = *(const LAS v2u*)(vp + 16); const v4u av = (v4u){lo.x, lo.y, hi2.x, hi2.y};
                o[d] = __builtin_amdgcn_mfma_f32_32x32x16_bf16(__builtin_bit_cast(bf16x8, av), pb[ks], o[d], 0, 0, 0); }
    }
#undef AT_FETCH
    lrow = xor32_sum(lrow); const float inv = 1.0f / lrow;
#pragma unroll
    for (int d = 0; d < 4; ++d)
#pragma unroll
        for (int rg = 0; rg < 4; ++rg) { const int dd = 32 * d + 8 * rg + 4 * hi; const size_t off = qrow * 2048 + hd * 128 + dd;
            const v2u zz = *(const v2u*)(Z + off); const float z0 = bflo(zz.x), z1 = bfhi(zz.x), z2 = bflo(zz.y), z3 = bfhi(zz.y);
            v2u w; w.x = pk2(o[d][4 * rg] * inv * (z0 * sigmoidf_(z0)), o[d][4 * rg + 1] * inv * (z1 * sigmoidf_(z1))); w.y = pk2(o[d][4 * rg + 2] * inv * (z2 * sigmoidf_(z2)), o[d][4 * rg + 3] * inv * (z3 * sigmoidf_(z3)));
            *(v2u*)(G + off) = w; }
}
__device__ __forceinline__ void b2a_attn_prompt(Frame& F) {
    const int vcu = (F.G % 8 == 0) ? (F.bid % 8) * (F.G / 8) + F.bid / 8 : F.bid;
    for (int u = vcu; u < BATCH * B_HEADS * 4; u += F.G) { const int bh = u >> 2, qp = u & 3;
        for (int hf = 0; hf < 2; ++hf) attn_unit(F, bh >> 4, bh & 15, hf ? qp : 7 - qp); }
    __syncthreads();
}

constexpr int DT_P = 656;
typedef short v4i16_t __attribute__((ext_vector_type(4)));
__device__ __forceinline__ void b2b_attn_sample(Frame& F, cargs a) {
    unsigned char* ws = F.ws; const float* cckv = (const float*)a->in[4]; const float* ckpe = (const float*)a->in[5]; const int* ptab = (const int*)a->in[6];
    const bf16* QA = (const bf16*)(ws + WS_QABS); float* OP = (float*)(ws + WS_OPART); float* ML = (float*)(ws + WS_ML);
    LAS unsigned char* T = F.lds;
    F.lane = lane_id();
    const int lane = F.lane, hcol = lane & 15, g = lane >> 4, tid = F.wave * 64 + lane, q4 = (lane & 15) >> 2, p4 = lane & 3;
    const bf16* Q = (const bf16*)(ws + WS_Q); const float* wuk = (const float*)a->in[28]; bf16* QAg = (bf16*)(ws + WS_QABS);
    LAS bf16* QAl = (LAS bf16*)(F.lds + 49152);
    for (int hu = F.bid; hu < DEC_BATCH * 2; hu += F.G) for (int si = 0; si < 4; ++si) { const int b = hu >> 1, sp = (hu & 1) * 4 + si;
      if (si == 0) {
        __syncthreads();
        for (int hh = 0; hh < 2; ++hh) { const int hd = 2 * F.wave + hh; const bf16* qn = Q + (size_t)(MP + b) * 3072 + hd * 192;
            float acc[4] = {0.f, 0.f, 0.f, 0.f};
            for (int n = 0; n < 128; n += 4) { const v2u qu = *(const v2u*)(qn + n); const f32x4 q4 = (f32x4){bflo(qu.x), bfhi(qu.x), bflo(qu.y), bfhi(qu.y)};
#pragma unroll
                for (int cc = 0; cc < 4; ++cc) { const f32x4 w4 = *(const f32x4*)(wuk + (size_t)(4 * lane + cc) * 2048 + hd * 128 + n); acc[cc] += (q4.x * w4.x + q4.y * w4.y) + (q4.z * w4.z + q4.w * w4.w); } }
            const v2u w = (v2u){pk2(acc[0], acc[1]), pk2(acc[2], acc[3])}; *(LAS v2u*)(QAl + hd * 320 + 4 * lane) = w;
            const bf16 rp = qn[128 + 2 * (lane & 31) + (lane >> 5)]; QAl[hd * 320 + 256 + lane] = rp;
            if ((hu & 1) == 0) { *(v2u*)(QAg + (size_t)(b * 16 + hd) * 320 + 4 * lane) = w; QAg[(size_t)(b * 16 + hd) * 320 + 256 + lane] = rp; } }
        __syncthreads(); }
        bf16x8 qf[10];
#pragma unroll
        for (int s = 0; s < 10; ++s) qf[s] = *(const LAS bf16x8*)(QAl + hcol * 320 + 32 * s + 8 * g);
        f32x4 o[2]; o[0] = (f32x4){0.f, 0.f, 0.f, 0.f}; o[1] = o[0]; float mrow = -1e30f, lrow = 0.f;
        f32x4 pf_[10];
#define DT_FETCH(t_) do { const int pp = ptab[b * NPAGES + sp * 8 + ((t_) >> 1)], tok0 = ((t_) & 1) * 64; \
            _Pragma("unroll") for (int i = 0; i < 10; ++i) { const int c = tid + 512 * i, key = c / 80, ch = c % 80; const size_t tk = (size_t)pp * PAGE + tok0 + key; \
                pf_[i] = ch < 64 ? *(const f32x4*)(cckv + tk * 256 + ch * 4) : *(const f32x4*)(ckpe + tk * 64 + (ch - 64) * 4); } } while (0)
        DT_FETCH(0);
        for (int t = 0; t < 16; ++t) {
            __syncthreads();
#pragma unroll
            for (int i = 0; i < 10; ++i) { const int c = tid + 512 * i, key = c / 80, ch = c % 80; *(LAS v2u*)(T + key * DT_P + ch * 8) = (v2u){pk2(pf_[i].x, pf_[i].y), pk2(pf_[i].z, pf_[i].w)}; }
            __syncthreads();
            if (t + 1 < 16) DT_FETCH(t + 1);
            f32x4 sc[4];
#pragma unroll
            for (int kg = 0; kg < 4; ++kg) { sc[kg] = (f32x4){0.f, 0.f, 0.f, 0.f};
#pragma unroll
                for (int s = 0; s < 10; ++s) { const bf16x8 kf = *(const LAS bf16x8*)(T + (16 * kg + hcol) * DT_P + (32 * s + 8 * g) * 2);
                    sc[kg] = __builtin_amdgcn_mfma_f32_16x16x32_bf16(kf, qf[s], sc[kg], 0, 0, 0); } }
            float tmax = sc[0][0];
#pragma unroll
            for (int kg = 0; kg < 4; ++kg)
#pragma unroll
                for (int r = 0; r < 4; ++r) tmax = fmaxf(tmax, sc[kg][r]);
            tmax = fmaxf(tmax, swz_xor<16>(tmax)); tmax = xor32_max(tmax);
            const float mnew = fmaxf(mrow, tmax), alpha = __builtin_amdgcn_exp2f(mrow - mnew); mrow = mnew;
            float ps = 0.f;
#pragma unroll
            for (int kg = 0; kg < 4; ++kg)
#pragma unroll
                for (int r = 0; r < 4; ++r) { sc[kg][r] = __builtin_amdgcn_exp2f(sc[kg][r] - mnew); ps += sc[kg][r]; }
            lrow = lrow * alpha + ps; o[0] *= alpha; o[1] *= alpha;
#pragma unroll
            for (int kk = 0; kk < 2; ++kk) { const bf16x8 pbf = pack8f(sc[2 * kk][0], sc[2 * kk][1], sc[2 * kk][2], sc[2 * kk][3], sc[2 * kk + 1][0], sc[2 * kk + 1][1], sc[2 * kk + 1][2], sc[2 * kk + 1][3]);
#pragma unroll
                for (int ci = 0; ci < 2; ++ci) { const int cb = 2 * F.wave + ci; LAS unsigned char* ap = T + (32 * kk + 4 * g + q4) * DT_P + (16 * cb + 4 * p4) * 2;
                    const s16x4 lo = __builtin_bit_cast(s16x4, __builtin_amdgcn_ds_read_tr16_b64_v4i16((LAS v4i16_t*)ap)), hi2 = __builtin_bit_cast(s16x4, __builtin_amdgcn_ds_read_tr16_b64_v4i16((LAS v4i16_t*)(ap + 16 * DT_P)));
                    const bf16x8 av = (bf16x8){lo[0], lo[1], lo[2], lo[3], hi2[0], hi2[1], hi2[2], hi2[3]};
                    o[ci] = __builtin_amdgcn_mfma_f32_16x16x32_bf16(av, pbf, o[ci], 0, 0, 0); } }
        }
#undef DT_FETCH
        lrow += swz_xor<16>(lrow); lrow = xor32_sum(lrow);
        const size_t pb_ = (size_t)(b * 8 + sp) * 16 + hcol;
#pragma unroll
        for (int ci = 0; ci < 2; ++ci) *(f32x4*)(OP + pb_ * 256 + 16 * (2 * F.wave + ci) + 4 * g) = o[ci];
        if (F.wave == 0 && g == 0) { ML[pb_ * 2] = mrow; ML[pb_ * 2 + 1] = lrow; }
    }
    __syncthreads();
}
__device__ __forceinline__ void b2c_combine(Frame& F, cargs a) {
    unsigned char* ws = F.ws; const bf16* QA = (const bf16*)(ws + WS_QABS); const float* OP = (const float*)(ws + WS_OPART); const float* ML = (const float*)(ws + WS_ML);
    const float* wuv = (const float*)a->in[29]; const bf16* Z = (const bf16*)(ws + WS_Z); bf16* G = (bf16*)(ws + WS_G);
    LAS float* scr = (LAS float*)(F.lds + F.wave * 1024);
    for (int it = F.gw; it < DEC_BATCH * B_HEADS; it += F.NGW) { const int b = it >> 4, hd = it & 15; const int lane = F.lane;
        const float* cn = F.out + O_CKVS + (size_t)b * 256; const float* kn = F.out + O_KPES + (size_t)b * 64; const bf16* qa = QA + (size_t)it * 320;
        const f32x4 c4 = *(const f32x4*)(cn + 4 * lane); const v2u qv = *(const v2u*)(qa + 4 * lane);
        float sn = (bflo(qv.x) * c4.x + bfhi(qv.x) * c4.y) + (bflo(qv.y) * c4.z + bfhi(qv.y) * c4.w);
        sn += __builtin_bit_cast(float, (unsigned)qa[256 + lane] << 16) * kn[lane];
        sn = wave_sum(sn);
        float ms[8], ls[8], M = sn;
#pragma unroll
        for (int s = 0; s < 8; ++s) { ms[s] = ML[((size_t)(b * 8 + s) * 16 + hd) * 2]; ls[s] = ML[((size_t)(b * 8 + s) * 16 + hd) * 2 + 1]; M = fmaxf(M, ms[s]); }
        const float en = __builtin_amdgcn_exp2f(sn - M); float L = en; f32x4 acc = c4 * en;
#pragma unroll
        for (int s = 0; s < 8; ++s) { const float e = __builtin_amdgcn_exp2f(ms[s] - M); L += e * ls[s]; acc += *(const f32x4*)(OP + ((size_t)(b * 8 + s) * 16 + hd) * 256 + 4 * lane) * e; }
        acc *= 1.0f / L;
        *(LAS f32x4*)(scr + 4 * lane) = acc; LDS_WAIT(); asm volatile("" ::: "memory");
        f32x2 ov = (f32x2){0.f, 0.f};
        for (int c = 0; c < 256; ++c) { const float ol = scr[c]; ov += *(const f32x2*)(wuv + (size_t)c * 2048 + hd * 128 + 2 * lane) * ol; }
        const size_t off = (size_t)(MP + b) * 2048 + hd * 128 + 2 * lane; const unsigned zz = *(const unsigned*)(Z + off); const float z0 = bflo(zz), z1 = bfhi(zz);
        *(unsigned*)(G + off) = pk2(ov.x * (z0 * sigmoidf_(z0)), ov.y * (z1 * sigmoidf_(z1)));
        LDS_WAIT(); asm volatile("" ::: "memory");
    }
}

#ifndef MK_SPLIT
#define MK_SPLIT 0
#endif
#ifndef MK_DIAG
#define MK_DIAG 0
#endif
constexpr int NPHASES = 1 + 2 * 5 + 4 + 2 * 6 + 1 + (MK_DIAG ? 1 : 0);
#define PH_BEGIN if (ph >= lo && ph < hi) { cargs ap = (cargs)__builtin_amdgcn_kernarg_segment_ptr(); asm volatile("" : "+s"(ap)); Frame F = make_frame(ap, wave0, (LAS unsigned char*)lds); unsigned char* ws = F.ws;
#define PH_END } if (ph >= lo && ph + 1 < hi) xcd_barrier(bar); ++ph;
typedef pg8::StaticOrder SO;
#define GEMM_B(ACT_, A_, Bt_, M_, N_, K_, O_, ldc_, nvalid_, nstore_) do { pg8::Gemm g_{(const pg8::bf16_t*)(A_), (const pg8::bf16_t*)(Bt_), (M_), (N_), (K_)}; SO S_; S_.init((M_), (N_), F.G, F.bid); \
    pg8::EpiB<ACT_> E_{(pg8::bf16_t*)(O_), (ldc_), (nvalid_), (nstore_)}; pg8::gemm_phase<pg8::EpiB<ACT_>, SO, true, true>(F.lds, g_, S_, E_, F.wave); } while (0)
#define GEMM_F(ACT_, HB_, HBI_, A_, Bt_, M_, N_, K_, O_, base_, bias_, ldc_, nstore_) do { int kk_ = (K_); asm volatile("" : "+s"(kk_)); pg8::Gemm g_{(const pg8::bf16_t*)(A_), (const pg8::bf16_t*)(Bt_), (M_), (N_), kk_}; SO S_; S_.init((M_), (N_), F.G, F.bid); \
    pg8::EpiF<ACT_, HB_, HBI_> E_{(float*)(O_), (const float*)(base_), (const float*)(bias_), (ldc_), (nstore_)}; pg8::gemm_phase<pg8::EpiF<ACT_, HB_, HBI_>, SO, true, true>(F.lds, g_, S_, E_, F.wave); } while (0)

#define OUTPROJ(Wt_) do { \
    { pg8::Gemm g_{(const pg8::bf16_t*)(ws + WS_G), (const pg8::bf16_t*)(Wt_), MT, 1024, 256, 2048}; pg8::SliceOrder S_{MP / 256, 4, 8, F.G, F.bid, 512}; pg8::EpiFA E_{(float*)(ws + WS_X), 1024, MP + DEC_BATCH}; \
      pg8::gemm_phase<pg8::EpiFA, pg8::SliceOrder, true, true>(F.lds, g_, S_, E_, F.wave); } \
    GEMM_F(0, true, false, ws + WS_G, (Wt_), MP, 1024, 2048, ws + WS_X, ws + WS_X, nullptr, 1024, 1024); } while (0)
__global__ void __launch_bounds__(NTHR, 2) mk_fwd(Args args) {
    extern __shared__ __attribute__((aligned(16))) unsigned char lds[];
    const int wave0 = __builtin_amdgcn_readfirstlane(threadIdx.x >> 6);
    for (int u = threadIdx.x; u < (LDS_BYTES - LDSCTL_OFF) / 4; u += NTHR) ((LAS unsigned*)(lds + LDSCTL_OFF))[u] = 0u;
    __syncthreads();
    XcdBarrier bar = xcd_barrier_post((unsigned*)(args.ws + WS_CTL) + CW_BAR + args.li * XCD_BAR_WORDS, (volatile LAS unsigned*)((LAS unsigned char*)lds + LDSCTL_OFF), (unsigned)wave0);
    int ph = 0; const int lo = args.ph_lo, hi = args.ph_hi;

    PH_BEGIN p0_prologue(F, ap); PH_END

    for (int l = 0; l < 2; ++l) {
        PH_BEGIN a1_prepass(F, ap, l); PH_END
        PH_BEGIN
            { static_assert(AM_STRIDE == (size_t)130 * 256 * 1024 * 2, "A-operand buffers sit 130 row panels apart");
              pg8::Gemm g_{(const pg8::bf16_t*)(ws + WS_AM), (const pg8::bf16_t*)(ws + WS_WIN + (size_t)(l * 4) * 4 * MiB), MT, 2048, 1024}; pg8::GroupOrder4 S_; S_.init(MT, 2048, F.G, F.bid);
              pg8::EpiB4 E_{{(pg8::bf16_t*)(ws + WS_R), (pg8::bf16_t*)(ws + WS_K), (pg8::bf16_t*)(ws + (l ? WS_V1 : WS_V0)), (pg8::bf16_t*)(ws + WS_Z)}};
              pg8::gemm_phase<pg8::EpiB4, pg8::GroupOrder4, true, true>(F.lds, g_, S_, E_, F.wave); }
            GEMM_B(1, ws + WS_AM + 4 * AM_STRIDE, ws + WS_W1 + (size_t)l * (MiB / 2), MT, 256, 1024, ws + WS_LW, 128, 64, 128);
            GEMM_B(0, ws + WS_AM + 5 * AM_STRIDE, ws + WS_W1 + (size_t)(2 + l) * (MiB / 2), MT, 256, 1024, ws + WS_LA, 128, 64, 128);
            if (l) GEMM_B(0, ws + WS_AM + 2 * AM_STRIDE, ws + WS_W1 + (size_t)4 * (MiB / 2), MT, 256, 1024, ws + WS_LV, 128, 32, 128);
        PH_END
        PH_BEGIN
            GEMM_B(0, ws + WS_LW, ws + WS_W2 + (size_t)l * (MiB / 2), MT, 2048, 128, ws + WS_WD, 2048, 2048, 2048);
            GEMM_B(0, ws + WS_LA, ws + WS_W2 + (size_t)(2 + l) * (MiB / 2), MT, 2048, 128, ws + WS_IA, 2048, 2048, 2048);
            if (l) GEMM_B(0, ws + WS_LV, ws + WS_W2 + (size_t)4 * (MiB / 2), MT, 2048, 128, ws + WS_VG, 2048, 2048, 2048);
        PH_END
        PH_BEGIN a5_fused(F, ap, l); PH_END
        PH_BEGIN
            OUTPROJ(ws + WS_WO + (size_t)l * 4 * MiB);
        PH_END
    }

    PH_BEGIN norm_rows_bf16(F, (const float*)(ws + WS_X), (const float*)ap->in[25], (bf16*)(ws + WS_AM)); PH_END
    PH_BEGIN GEMM_F(0, false, false, ws + WS_AM, ws + WS_WDKV, MT, 512, 1024, ws + WS_KVR, nullptr, nullptr, 320, 320); PH_END
    PH_BEGIN b0c_kvpost(F, ap); PH_END
    PH_BEGIN
        GEMM_B(0, ws + WS_CKVB, ws + WS_WUK, MP, 2048, 256, ws + WS_KN, 2048, 2048, 2048);
        GEMM_B(0, ws + WS_WUV, ws + WS_CKVB, 2048, MP, 256, ws + WS_VT, MP, MP, MP);
    PH_END
    for (int l = 0; l < 2; ++l) {
        PH_BEGIN norm_rows_bf16(F, (const float*)(ws + WS_X), (const float*)ap->in[30] + l * 1024, (bf16*)(ws + WS_AM)); PH_END
        PH_BEGIN
            { pg8::Gemm g_{(const pg8::bf16_t*)(ws + WS_AM), (const pg8::bf16_t*)(ws + WS_WQ + (size_t)l * MiB), MT, 512, 1024}; SO S_; S_.init(MT, 512, F.G, F.bid);
              pg8::EpiCQ E_{(pg8::bf16_t*)(ws + WS_CQ), (const float*)ap->in[32] + l * 384, (float*)(ws + WS_CTL + CW_RSQ + (size_t)l * 262144)}; pg8::gemm_phase<pg8::EpiCQ, SO, true, true>(F.lds, g_, S_, E_, F.wave); }
            GEMM_B(0, ws + WS_AM, ws + WS_WZ + (size_t)l * 4 * MiB, MT, 2048, 1024, ws + WS_Z, 2048, 2048, 2048);
        PH_END
        PH_BEGIN { pg8::Gemm g_{(const pg8::bf16_t*)(ws + WS_CQ), (const pg8::bf16_t*)(ws + WS_WUQ + (size_t)l * (5 * MiB / 2)), MT, 3072, 384}; SO S_; S_.init(MT, 3072, F.G, F.bid);
            pg8::EpiQ E_{(pg8::bf16_t*)(ws + WS_Q), (const float*)(ws + WS_ROPE), ATTN_SCALE * LOG2E, MP, SEQ, (const float*)(ws + WS_CTL + CW_RSQ + (size_t)l * 262144)}; pg8::gemm_phase<pg8::EpiQ, SO, true, true>(F.lds, g_, S_, E_, F.wave); } PH_END
        PH_BEGIN b2a_attn_prompt(F); b2b_attn_sample(F, ap); PH_END
        PH_BEGIN b2c_combine(F, ap); PH_END
        PH_BEGIN OUTPROJ(ws + WS_WBO + (size_t)l * 4 * MiB); PH_END
    }

    PH_BEGIN final_norm(F, ap); PH_END
#if MK_DIAG
    PH_BEGIN
        const size_t offs[11] = {O_YP, O_YS, O_WKVP, O_SHP, O_CKVP, O_KPEP, O_WKVS, O_SHS, O_CKVS, O_KPES, O_END};
        for (int k = 1; k < 10; ++k) { const float f = 1.0f + sqrtf(2e-4f * (float)k);
            for (size_t i = offs[k] + (size_t)(F.bid * NTHR + F.wave * 64 + F.lane); i < offs[k + 1]; i += (size_t)F.NT) F.out[i] *= f; }
    PH_END
#endif
}

extern "C" void kernel_launch(void* const* d_in, const int* in_sizes, int n_in, void* d_out, int out_size, void* d_ws, size_t ws_size, hipStream_t stream) {
    static int grid = 0;
    if (grid == 0) {
        if (n_in != 36 || (size_t)out_size != O_END || ws_size < WS_NEED) { fprintf(stderr, "kernel_launch: unexpected sizes: n_in %d out %d (want %zu) ws %zu (need %zu)\n", n_in, out_size, (size_t)O_END, ws_size, (size_t)WS_NEED); grid = -1; return; }
        int dev = 0, cus = 0, per_cu = 0;
        if (hipGetDevice(&dev) != hipSuccess || hipDeviceGetAttribute(&cus, hipDeviceAttributeMultiprocessorCount, dev) != hipSuccess) { grid = -1; return; }
        if (hipFuncSetAttribute((const void*)mk_fwd, hipFuncAttributeMaxDynamicSharedMemorySize, LDS_BYTES) != hipSuccess) { fprintf(stderr, "kernel_launch: hipFuncSetAttribute failed\n"); grid = -1; return; }
        if (hipOccupancyMaxActiveBlocksPerMultiprocessor(&per_cu, (const void*)mk_fwd, NTHR, LDS_BYTES) != hipSuccess || per_cu < 1) fprintf(stderr, "kernel_launch: occupancy query reports %d\n", per_cu);
        (void)hipGetLastError();
        grid = cus;
    }
    if (grid < 0) return;
    if (hipMemsetAsync((char*)d_ws + WS_CTL, 0, CTL_ZERO_BYTES, stream) != hipSuccess) { fprintf(stderr, "kernel_launch: memset failed\n"); return; }
    Args a{};
    for (int i = 0; i < 36; ++i) a.in[i] = d_in[i];
    a.out = (float*)d_out; a.ws = (unsigned char*)d_ws;
#if MK_SPLIT
    for (int li = 0; li < NPHASES; ++li) { a.ph_lo = li; a.ph_hi = li + 1; a.li = li;
        hipLaunchKernelGGL(mk_fwd, dim3(grid), dim3(NTHR), LDS_BYTES, stream, a); }
#else
    a.ph_lo = 0; a.ph_hi = NPHASES; a.li = 0;
    hipLaunchKernelGGL(mk_fwd, dim3(grid), dim3(NTHR), LDS_BYTES, stream, a);
#endif
    const hipError_t le = hipPeekAtLastError();
    if (le != hipSuccess) fprintf(stderr, "kernel_launch: launch failed: %s\n", hipGetErrorName(le));
}
```

```cpp
#include <hip/hip_runtime.h>
#include <cstdio>
#include <cstdint>
namespace pg8 {
#define PG8_LAS __attribute__((address_space(3)))
typedef unsigned short bf16_t;
typedef short bf16x8 __attribute__((ext_vector_type(8)));
typedef float f32x4 __attribute__((ext_vector_type(4)));
typedef unsigned u32x4 __attribute__((ext_vector_type(4)));
constexpr int BM = 256, BK = 64, HALF = 128, HTB = HALF * BK * 2  , STAGE_BYTES = 8 * HTB, NXCD = 8, WGM = 8;

__host__ __device__ __forceinline__ int lds_byte(int r, int c) { const int st = (r >> 4) * 2 + (c >> 5), rr = r & 15, cc = c & 31, ob = rr * 64 + cc * 2; return st * 1024 + (ob ^ (((ob >> 9) & 1) << 5)); }
__host__ __device__ __forceinline__ void stage_rc(int b, int& R, int& C) { const int st = b / 1024, sb = b % 1024, swz = sb ^ (((sb >> 9) & 1) << 5); R = (st >> 1) * 16 + swz / 64; C = (st & 1) * 32 + (swz % 64) / 2; }
__host__ __device__ __forceinline__ int perm32(int rho) { const int n = rho >> 4, i = rho & 15; return 8 * (i >> 2) + 4 * n + (i & 3); }

struct Unit { int pm, pn; int ko; };
struct Gemm { const bf16_t* A; const bf16_t* Bt; int M, N, K; int ld; };

struct StaticOrder {
    int nM, nN, nwg, G, c;
    __host__ __device__ void init(int M, int N, int G_, int c_) { nM = M / BM; nN = N / BM; nwg = nM * nN; G = G_; c = c_; }
    __host__ __device__ bool next(int i, Unit& u) const {
        const long L = (long)i * G + c; if (L >= nwg) return false;
        int wgid = (int)L; { const int q = nwg / NXCD, r = nwg % NXCD, xcd = wgid % NXCD, off = wgid / NXCD; wgid = (xcd < r ? xcd * (q + 1) : r * (q + 1) + (xcd - r) * q) + off; }
        const int nig = WGM * nN, gid = wgid / nig, fm = gid * WGM, gsz = (nM - fm) < WGM ? (nM - fm) : WGM;
        u.pm = fm + ((wgid % nig) % gsz); u.pn = (wgid % nig) / gsz; u.ko = 0; return true;
    }
    __device__ __forceinline__ void a_ready(const Unit&) const {}
    __device__ __forceinline__ void done(const Unit&) const {}
};

__device__ __forceinline__ unsigned cvt_pk_bf16(float lo, float hi) { unsigned r; asm volatile("v_cvt_pk_bf16_f32 %0, %1, %2" : "=v"(r) : "v"(lo), "v"(hi)); return r; }
typedef float f32x2 __attribute__((ext_vector_type(2)));
__device__ __forceinline__ float act_apply(int ACT, float x) {
    if (ACT == 1) return 1.0f - 2.0f / (1.0f + __expf(2.0f * x));
    if (ACT == 2) return __expf(-0.6065306597126334f / (1.0f + __expf(-x)));
    if (ACT == 3) return 1.0f / (1.0f + __expf(-x));
    return x;
}
template <int ACT> struct EpiB {
    static constexpr bool PERM = true, AFTER_DRAIN = false;
    bf16_t* O; int ldc; int nvalid; int nstore;
    __device__ __forceinline__ void operator()(const f32x4 (&acc)[2][2][4][2], const Unit& u, int wr, int wc, int, int) const {
        int lane_; asm volatile("v_mbcnt_lo_u32_b32 %0, -1, 0\n\tv_mbcnt_hi_u32_b32 %0, -1, %0" : "=v"(lane_)); const int fr = lane_ & 15, fq = lane_ >> 4;
        const int row0 = u.pm * BM + wr * 64 + fr, col0 = u.pn * BM + wc * 32 + 8 * fq;
#pragma unroll
        for (int ai = 0; ai < 2; ++ai)
#pragma unroll
            for (int m = 0; m < 4; ++m) { bf16_t* rowp = O + (size_t)(row0 + ai * HALF + m * 16) * ldc + col0;
#pragma unroll
                for (int bj = 0; bj < 2; ++bj) { const int c = col0 + bj * HALF; if (c >= nstore) continue;
                    f32x4 v0 = acc[ai][bj][m][0], v1 = acc[ai][bj][m][1];
                    if (ACT != 0) {
#pragma unroll
                        for (int e = 0; e < 4; ++e) { v0[e] = act_apply(ACT, v0[e]); v1[e] = act_apply(ACT, v1[e]); } }
                    u32x4 w; w.x = cvt_pk_bf16(v0[0], v0[1]); w.y = cvt_pk_bf16(v0[2], v0[3]); w.z = cvt_pk_bf16(v1[0], v1[1]); w.w = cvt_pk_bf16(v1[2], v1[3]);
                    if (c >= nvalid) w = (u32x4){0u, 0u, 0u, 0u};
                    *(u32x4*)(rowp + bj * HALF) = w; } }
    }
};
template <int ACT, bool HAS_BASE, bool HAS_BIAS> struct EpiF {
    static constexpr bool PERM = false, AFTER_DRAIN = false;
    float* O; const float* base; const float* bias; int ldc; int nstore;
    __device__ __forceinline__ void operator()(const f32x4 (&acc)[2][2][4][2], const Unit& u, int wr, int wc, int, int) const {
        int lane_; asm volatile("v_mbcnt_lo_u32_b32 %0, -1, 0\n\tv_mbcnt_hi_u32_b32 %0, -1, %0" : "=v"(lane_)); const int fr = lane_ & 15, fq = lane_ >> 4;
        const int row0 = u.pm * BM + wr * 64 + fr, col0 = u.pn * BM + wc * 32 + 4 * fq;
        f32x4 bv[2][2];
#pragma unroll
        for (int bj = 0; bj < 2; ++bj)
#pragma unroll
            for (int n = 0; n < 2; ++n) bv[bj][n] = HAS_BIAS ? *(const f32x4*)(bias + col0 + bj * HALF + n * 16) : (f32x4){0.f, 0.f, 0.f, 0.f};
#pragma unroll
        for (int ai = 0; ai < 2; ++ai)
#pragma unroll
            for (int m = 0; m < 4; ++m) { const size_t off = (size_t)(row0 + ai * HALF + m * 16) * ldc + col0;
#pragma unroll
                for (int bj = 0; bj < 2; ++bj)
#pragma unroll
                    for (int n = 0; n < 2; ++n) { if (col0 + bj * HALF + n * 16 >= nstore) continue;
                        f32x4 v = acc[ai][bj][m][n] + bv[bj][n];
                        if (ACT != 0) {
#pragma unroll
                            for (int e = 0; e < 4; ++e) v[e] = act_apply(ACT, v[e]); }
                        if (HAS_BASE) v += *(const f32x4*)(base + off + bj * HALF + n * 16);
                        *(f32x4*)(O + off + bj * HALF + n * 16) = v; }
                if (m & 1) asm volatile("" ::: "memory"); }
    }
};

struct GroupOrder4 {
    StaticOrder so; int per;
    __device__ void init(int M, int N, int G_, int c_) { so.init(M, N, G_, c_); per = so.nwg; }
    __device__ bool next(int i, Unit& u) const {
        const long L = (long)i * so.G + so.c; if (L >= 4L * per) return false;
        const int gi = (int)(L / per); int wgid = (int)(L - (long)gi * per);
        { const int q = so.nwg / NXCD, r = so.nwg % NXCD, xcd = wgid % NXCD, off = wgid / NXCD; wgid = (xcd < r ? xcd * (q + 1) : r * (q + 1) + (xcd - r) * q) + off; }
        const int nig = WGM * so.nN, gid = wgid / nig, fm = gid * WGM, gsz = (so.nM - fm) < WGM ? (so.nM - fm) : WGM;
        u.pm = fm + ((wgid % nig) % gsz) + 130 * gi; u.pn = (wgid % nig) / gsz + 8 * gi; u.ko = 0; return true;
    }
    __device__ __forceinline__ void a_ready(const Unit&) const {}
    __device__ __forceinline__ void done(const Unit&) const {}
};
struct EpiB4 {
    static constexpr bool PERM = true, AFTER_DRAIN = false;
    bf16_t* O[4];
    __device__ __forceinline__ void operator()(const f32x4 (&acc)[2][2][4][2], const Unit& u, int wr, int wc, int, int) const {
        int lane_; asm volatile("v_mbcnt_lo_u32_b32 %0, -1, 0\n\tv_mbcnt_hi_u32_b32 %0, -1, %0" : "=v"(lane_)); const int fr = lane_ & 15, fq = lane_ >> 4;
        const int gi = u.pn >> 3; bf16_t* Ob = gi == 0 ? O[0] : gi == 1 ? O[1] : gi == 2 ? O[2] : O[3];
        const int row0 = (u.pm - 130 * gi) * BM + wr * 64 + fr, col0 = (u.pn & 7) * BM + wc * 32 + 8 * fq;
#pragma unroll
        for (int ai = 0; ai < 2; ++ai)
#pragma unroll
            for (int m = 0; m < 4; ++m) { bf16_t* rowp = Ob + (size_t)(row0 + ai * HALF + m * 16) * 2048 + col0;
#pragma unroll
                for (int bj = 0; bj < 2; ++bj) { const f32x4 v0 = acc[ai][bj][m][0], v1 = acc[ai][bj][m][1];
                    u32x4 w; w.x = cvt_pk_bf16(v0[0], v0[1]); w.y = cvt_pk_bf16(v0[2], v0[3]); w.z = cvt_pk_bf16(v1[0], v1[1]); w.w = cvt_pk_bf16(v1[2], v1[3]);
                    *(u32x4*)(rowp + bj * HALF) = w; } }
    }
};

struct EpiQ {
    static constexpr bool PERM = true, AFTER_DRAIN = false;
    bf16_t* O; const float* rope; float sc; int mp, seq; const float* rsq;
    __device__ __forceinline__ void operator()(const f32x4 (&acc)[2][2][4][2], const Unit& u, int wr, int wc, int, int) const {
        int lane_; asm volatile("v_mbcnt_lo_u32_b32 %0, -1, 0\n\tv_mbcnt_hi_u32_b32 %0, -1, %0" : "=v"(lane_)); const int fr = lane_ & 15, fq = lane_ >> 4;
        const int row0 = u.pm * BM + wr * 64 + fr, col0 = u.pn * BM + wc * 32 + 8 * fq;
#pragma unroll
        for (int ai = 0; ai < 2; ++ai)
#pragma unroll
            for (int m = 0; m < 4; ++m) { const int row = row0 + ai * HALF + m * 16; const int p = row < mp ? (row & (seq - 1)) : seq; bf16_t* rowp = O + (size_t)row * 3072 + col0; const float rsc = sc / sqrtf(rsq[row] * (1.0f / 384.0f) + 1e-6f);
#pragma unroll
                for (int bj = 0; bj < 2; ++bj) { const int c = col0 + bj * HALF, within = c % 192; f32x4 v0 = acc[ai][bj][m][0], v1 = acc[ai][bj][m][1];
                    if (within >= 128) { const float* t = rope + (size_t)(p * 32 + ((within - 128) >> 1)) * 2; const f32x4 t0 = *(const f32x4*)t, t1 = *(const f32x4*)(t + 4);
                        const f32x4 a0 = v0, a1 = v1;
                        v0[0] = a0[0] * t0[0] - a0[1] * t0[1]; v0[1] = a0[1] * t0[0] + a0[0] * t0[1]; v0[2] = a0[2] * t0[2] - a0[3] * t0[3]; v0[3] = a0[3] * t0[2] + a0[2] * t0[3];
                        v1[0] = a1[0] * t1[0] - a1[1] * t1[1]; v1[1] = a1[1] * t1[0] + a1[0] * t1[1]; v1[2] = a1[2] * t1[2] - a1[3] * t1[3]; v1[3] = a1[3] * t1[2] + a1[2] * t1[3]; }
                    v0 = v0 * rsc; v1 = v1 * rsc;
                    u32x4 w; w.x = cvt_pk_bf16(v0[0], v0[1]); w.y = cvt_pk_bf16(v0[2], v0[3]); w.z = cvt_pk_bf16(v1[0], v1[1]); w.w = cvt_pk_bf16(v1[2], v1[3]);
                    *(u32x4*)(rowp + bj * HALF) = w; } }
    }
};

struct EpiCQ {
    static constexpr bool PERM = true, AFTER_DRAIN = false;
    bf16_t* O; const float* wq; float* rsq;
    __device__ __forceinline__ void operator()(const f32x4 (&acc)[2][2][4][2], const Unit& u, int wr, int wc, int, int) const {
        int lane_; asm volatile("v_mbcnt_lo_u32_b32 %0, -1, 0\n\tv_mbcnt_hi_u32_b32 %0, -1, %0" : "=v"(lane_)); const int fr = lane_ & 15, fq = lane_ >> 4;
        const int row0 = u.pm * BM + wr * 64 + fr, col0 = u.pn * BM + wc * 32 + 8 * fq;
#pragma unroll
        for (int ai = 0; ai < 2; ++ai)
#pragma unroll
            for (int m = 0; m < 4; ++m) { const int row = row0 + ai * HALF + m * 16; float ss = 0.f;
#pragma unroll
                for (int bj = 0; bj < 2; ++bj) { const int c = col0 + bj * HALF; if (c >= 384) continue;
                    const f32x4 v0 = acc[ai][bj][m][0], v1 = acc[ai][bj][m][1], w0 = *(const f32x4*)(wq + c), w1 = *(const f32x4*)(wq + c + 4);
                    ss += ((v0[0] * v0[0] + v0[1] * v0[1]) + (v0[2] * v0[2] + v0[3] * v0[3])) + ((v1[0] * v1[0] + v1[1] * v1[1]) + (v1[2] * v1[2] + v1[3] * v1[3]));
                    u32x4 w; w.x = cvt_pk_bf16(v0[0] * w0[0], v0[1] * w0[1]); w.y = cvt_pk_bf16(v0[2] * w0[2], v0[3] * w0[3]); w.z = cvt_pk_bf16(v1[0] * w1[0], v1[1] * w1[1]); w.w = cvt_pk_bf16(v1[2] * w1[2], v1[3] * w1[3]);
                    *(u32x4*)(O + (size_t)row * 384 + c) = w; }
                ss += __builtin_bit_cast(float, __builtin_amdgcn_ds_swizzle(__builtin_bit_cast(int, ss), 0x1F | (16 << 10)));
                { float a = ss, b = ss; asm volatile("s_nop 1\n\tv_permlane32_swap_b32 %0, %1\n\ts_nop 1" : "+v"(a), "+v"(b)); ss = a + b; }
                if (fq == 0 && u.pn < 2) atomicAdd(rsq + row, ss); }
    }
};

struct SliceOrder {
    int pm, nN, nS, G, c, kbytes;
    __device__ bool next(int i, Unit& u) const { const int L = i * G + c; if (L >= nN * nS) return false; u.pm = pm; u.pn = L % nN; u.ko = (L / nN) * kbytes; return true; }
    __device__ __forceinline__ void a_ready(const Unit&) const {}
    __device__ __forceinline__ void done(const Unit&) const {}
};
struct EpiFA {
    static constexpr bool PERM = false, AFTER_DRAIN = false;
    float* O; int ldc, rows;
    __device__ __forceinline__ void operator()(const f32x4 (&acc)[2][2][4][2], const Unit& u, int wr, int wc, int, int) const {
        int lane_; asm volatile("v_mbcnt_lo_u32_b32 %0, -1, 0\n\tv_mbcnt_hi_u32_b32 %0, -1, %0" : "=v"(lane_)); const int fr = lane_ & 15, fq = lane_ >> 4;
        const int row0 = u.pm * BM + wr * 64 + fr, col0 = u.pn * BM + wc * 32 + 4 * fq;
#pragma unroll
        for (int ai = 0; ai < 2; ++ai)
#pragma unroll
            for (int m = 0; m < 4; ++m) { const int row = row0 + ai * HALF + m * 16; if (row >= rows) continue; float* rp = O + (size_t)row * ldc + col0;
#pragma unroll
                for (int bj = 0; bj < 2; ++bj)
#pragma unroll
                    for (int n = 0; n < 2; ++n) { const f32x4 v = acc[ai][bj][m][n];
#pragma unroll
                        for (int e = 0; e < 4; ++e) atomicAdd(rp + bj * HALF + n * 16 + e, v[e]); } }
    }
};

template <int ACT> struct EpiBA {
    static constexpr bool PERM = true, AFTER_DRAIN = false;
    bf16_t* O; const float* bias;
    __device__ __forceinline__ void operator()(const f32x4 (&acc)[2][2][4][2], const Unit& u, int wr, int wc, int, int) const {
        int lane_; asm volatile("v_mbcnt_lo_u32_b32 %0, -1, 0\n\tv_mbcnt_hi_u32_b32 %0, -1, %0" : "=v"(lane_)); const int fr = lane_ & 15, fq = lane_ >> 4;
        const int row0 = u.pm * BM + wr * 64 + fr, col0 = u.pn * BM + wc * 32 + 8 * fq;
        f32x4 bv[2][2];
#pragma unroll
        for (int bj = 0; bj < 2; ++bj)
#pragma unroll
            for (int n = 0; n < 2; ++n) bv[bj][n] = *(const f32x4*)(bias + col0 + bj * HALF + 4 * n);
#pragma unroll
        for (int ai = 0; ai < 2; ++ai)
#pragma unroll
            for (int m = 0; m < 4; ++m) { bf16_t* rowp = O + (size_t)(row0 + ai * HALF + m * 16) * 2048 + col0;
#pragma unroll
                for (int bj = 0; bj < 2; ++bj) { f32x4 v0 = acc[ai][bj][m][0] + bv[bj][0], v1 = acc[ai][bj][m][1] + bv[bj][1];
#pragma unroll
                    for (int e = 0; e < 4; ++e) { const float s0 = __builtin_amdgcn_rcpf(1.0f + __builtin_amdgcn_exp2f(-1.4426950408889634f * v0[e])), s1 = __builtin_amdgcn_rcpf(1.0f + __builtin_amdgcn_exp2f(-1.4426950408889634f * v1[e]));
                        v0[e] = ACT == 4 ? -0.8750387749f * s0 : s0; v1[e] = ACT == 4 ? -0.8750387749f * s1 : s1; }
                    typedef __bf16 bf8n __attribute__((ext_vector_type(8))); typedef float f8n __attribute__((ext_vector_type(8)));
                    const u32x4 w = __builtin_bit_cast(u32x4, __builtin_convertvector((f8n){v0[0], v0[1], v0[2], v0[3], v1[0], v1[1], v1[2], v1[3]}, bf8n));
                    *(u32x4*)(rowp + bj * HALF) = w; } }
    }
};
template <class Epi, class Sched, bool ALIGN_EPI = false, bool SP2 = false>
__device__ __forceinline__ void gemm_phase(PG8_LAS unsigned char* lds, const Gemm g, const Sched& S, const Epi& E, const int wid) {
    int lane_; asm volatile("v_mbcnt_lo_u32_b32 %0, -1, 0\n\tv_mbcnt_hi_u32_b32 %0, -1, %0" : "=v"(lane_));
    const int lane = lane_, tid = wid * 64 + lane, wr = wid >> 2, wc = wid & 3, fr = lane & 15, fq = lane >> 4;
    const int K = g.K, nt = K / BK, LD = g.ld ? g.ld : g.K;
    unsigned voffA[2], voffB[2];
#pragma unroll
    for (int i = 0; i < 2; ++i) { int R, C; stage_rc(tid * 16 + i * 8192, R, C); const int Rb = Epi::PERM ? ((R & ~31) + perm32(R & 31)) : R;
        voffA[i] = (unsigned)(R * LD + C) * 2u; voffB[i] = (unsigned)(Rb * LD + C) * 2u; }
    const size_t kstep = (size_t)(BK * 2);
    const size_t hstep = (size_t)HALF * LD * 2;
    const size_t tstep = 2 * hstep;
    const unsigned ldsw = (unsigned)wid * 1024u;
    const int aoff = lds_byte(wr * 64 + fr, fq * 8), boff = lds_byte(wc * 32 + fr, fq * 8);
#define PG8_SA(b, h) (((b) * 2 + (h)) * HTB)
#define PG8_SB(b, h) ((4 + (b) * 2 + (h)) * HTB)
#define PG8_STAGE(bufoff, gbase, voff) do { _Pragma("unroll") for (int _i = 0; _i < 2; ++_i) \
        __builtin_amdgcn_global_load_lds((const unsigned*)((const char*)(gbase) + (voff)[_i]), (PG8_LAS unsigned*)(lds + (bufoff) + ldsw + _i * 8192), 16, 0, 0); } while (0)
#define PG8_LDA(dst, b, h) do { _Pragma("unroll") for (int m = 0; m < 4; ++m) _Pragma("unroll") for (int k = 0; k < 2; ++k) dst[m][k] = *(const PG8_LAS bf16x8*)(lds + PG8_SA(b, h) + aoff + m * 2048 + k * 1024); } while (0)
#define PG8_LDB(dst, b, h) do { _Pragma("unroll") for (int n = 0; n < 2; ++n) _Pragma("unroll") for (int k = 0; k < 2; ++k) dst[n][k] = *(const PG8_LAS bf16x8*)(lds + PG8_SB(b, h) + boff + n * 2048 + k * 1024); } while (0)
#define PG8_MMA(ai, bj, At, Bt) do { __builtin_amdgcn_s_setprio(1); _Pragma("unroll") for (int m = 0; m < 4; ++m) _Pragma("unroll") for (int n = 0; n < 2; ++n) _Pragma("unroll") for (int k = 0; k < 2; ++k) \
        acc[ai][bj][m][n] = __builtin_amdgcn_mfma_f32_16x16x32_bf16(Bt[n][k], At[m][k], acc[ai][bj][m][n], 0, 0, 0); __builtin_amdgcn_s_setprio(0); } while (0)
#define PG8_WAIT_V(n) asm volatile("s_waitcnt vmcnt(" #n ")" ::: "memory")
#define PG8_WAIT_L(n) asm volatile("s_waitcnt lgkmcnt(" #n ")" ::: "memory")
#define PG8_BAR __builtin_amdgcn_s_barrier()
#define PG8_SCHED __builtin_amdgcn_sched_barrier(0)
    Unit cur, nxt; int ui = 0;
    if (!S.next(0, cur)) return;
    f32x4 acc[2][2][4][2];
#pragma unroll
    for (int a = 0; a < 2; ++a)
#pragma unroll
        for (int b = 0; b < 2; ++b)
#pragma unroll
            for (int m = 0; m < 4; ++m)
#pragma unroll
                for (int n = 0; n < 2; ++n) acc[a][b][m][n] = (f32x4){0.f, 0.f, 0.f, 0.f};
    bf16x8 At[4][2], B0[2][2], B1[2][2];
    const char* cA = (const char*)g.A + (size_t)cur.pm * tstep + cur.ko; const char* cB = (const char*)g.Bt + (size_t)cur.pn * tstep + cur.ko;
    S.a_ready(cur);
    if constexpr (SP2) {
        PG8_STAGE(PG8_SB(0, 0), cB, voffB); PG8_STAGE(PG8_SB(0, 1), cB + hstep, voffB); PG8_STAGE(PG8_SA(0, 0), cA, voffA); PG8_STAGE(PG8_SA(0, 1), cA + hstep, voffA);
        if (wr == 1) PG8_BAR;
        PG8_WAIT_V(2); PG8_BAR;
        PG8_STAGE(PG8_SB(1, 0), cB + kstep, voffB); PG8_STAGE(PG8_SA(1, 0), cA + kstep, voffA); PG8_STAGE(PG8_SB(1, 1), cB + hstep + kstep, voffB);
        PG8_WAIT_V(6); PG8_BAR;
    } else {
        PG8_STAGE(PG8_SB(0, 0), cB, voffB); PG8_STAGE(PG8_SA(0, 0), cA, voffA); PG8_STAGE(PG8_SB(0, 1), cB + hstep, voffB); PG8_STAGE(PG8_SA(0, 1), cA + hstep, voffA);
        if (wr == 1) PG8_BAR;
        PG8_WAIT_V(4); PG8_BAR;
        PG8_STAGE(PG8_SB(1, 0), cB + kstep, voffB); PG8_STAGE(PG8_SA(1, 0), cA + kstep, voffA); PG8_STAGE(PG8_SB(1, 1), cB + hstep + kstep, voffB);
        PG8_WAIT_V(6); PG8_BAR;
    }
    for (;;) {
        const bool has_next = S.next(ui + 1, nxt);
        const char* nA = has_next ? (const char*)g.A + (size_t)nxt.pm * tstep + nxt.ko : cA; const char* nB = has_next ? (const char*)g.Bt + (size_t)nxt.pn * tstep + nxt.ko : cB;
        for (int t = 0; t < nt; t += 2) {
            const bool last = (t == nt - 2);
            const char* a1 = cA + (size_t)(t + 1) * kstep;
            const char* a2 = last ? nA : cA + (size_t)(t + 2) * kstep; const char* b2 = last ? nB : cB + (size_t)(t + 2) * kstep;
            const char* a3 = a2 + kstep; const char* b3 = b2 + kstep;
            if (last && has_next) S.a_ready(nxt);
            if constexpr (SP2) {
            PG8_LDB(B0, 0, 0); PG8_LDB(B1, 0, 1); PG8_SCHED; PG8_LDA(At, 0, 0); PG8_STAGE(PG8_SA(1, 1), a1 + hstep, voffA);
            PG8_WAIT_V(8); PG8_WAIT_L(0); PG8_BAR; PG8_MMA(0, 0, At, B0); PG8_MMA(0, 1, At, B1); PG8_BAR; PG8_SCHED;
            PG8_LDA(At, 0, 1); PG8_STAGE(PG8_SB(0, 0), b2, voffB); PG8_STAGE(PG8_SB(0, 1), b2 + hstep, voffB); PG8_STAGE(PG8_SA(0, 0), a2, voffA);
            PG8_WAIT_V(8); PG8_WAIT_L(0); PG8_BAR; PG8_MMA(1, 0, At, B0); PG8_MMA(1, 1, At, B1); PG8_BAR; PG8_SCHED;
            PG8_LDB(B0, 1, 0); PG8_LDB(B1, 1, 1); PG8_SCHED; PG8_LDA(At, 1, 0); PG8_STAGE(PG8_SA(0, 1), a2 + hstep, voffA);
            PG8_WAIT_V(8); PG8_WAIT_L(0); PG8_BAR; PG8_MMA(0, 0, At, B0); PG8_MMA(0, 1, At, B1); PG8_BAR; PG8_SCHED;
            PG8_LDA(At, 1, 1); PG8_STAGE(PG8_SB(1, 0), b3, voffB); PG8_STAGE(PG8_SB(1, 1), b3 + hstep, voffB); PG8_STAGE(PG8_SA(1, 0), a3, voffA);
            PG8_WAIT_V(8); PG8_WAIT_L(0); PG8_BAR; PG8_MMA(1, 0, At, B0); PG8_MMA(1, 1, At, B1); PG8_BAR; PG8_SCHED;
            } else {
            PG8_LDB(B0, 0, 0); PG8_SCHED; PG8_LDA(At, 0, 0); PG8_STAGE(PG8_SA(1, 1), a1 + hstep, voffA);
            PG8_WAIT_L(8); PG8_BAR; PG8_WAIT_L(0); PG8_MMA(0, 0, At, B0); PG8_BAR; PG8_SCHED;
            PG8_LDB(B1, 0, 1); PG8_STAGE(PG8_SB(0, 0), b2, voffB);
            PG8_BAR; PG8_WAIT_L(0); PG8_MMA(0, 1, At, B1); PG8_BAR;
            PG8_LDA(At, 0, 1); PG8_STAGE(PG8_SA(0, 0), a2, voffA);
            PG8_BAR; PG8_WAIT_L(0); PG8_MMA(1, 0, At, B0); PG8_BAR; PG8_SCHED;
            PG8_STAGE(PG8_SB(0, 1), b2 + hstep, voffB);
            PG8_WAIT_V(6); PG8_BAR; PG8_MMA(1, 1, At, B1); PG8_BAR;
            PG8_LDB(B0, 1, 0); PG8_SCHED; PG8_LDA(At, 1, 0); PG8_STAGE(PG8_SA(0, 1), a2 + hstep, voffA);
            PG8_WAIT_L(8); PG8_BAR; PG8_WAIT_L(0); PG8_MMA(0, 0, At, B0); PG8_BAR; PG8_SCHED;
            PG8_LDB(B1, 1, 1); PG8_STAGE(PG8_SB(1, 0), b3, voffB);
            PG8_BAR; PG8_WAIT_L(0); PG8_MMA(0, 1, At, B1); PG8_BAR;
            PG8_LDA(At, 1, 1); PG8_STAGE(PG8_SA(1, 0), a3, voffA);
            PG8_BAR; PG8_WAIT_L(0); PG8_MMA(1, 0, At, B0); PG8_BAR; PG8_SCHED;
            PG8_STAGE(PG8_SB(1, 1), b3 + hstep, voffB);
            PG8_WAIT_V(6); PG8_BAR; PG8_MMA(1, 1, At, B1); PG8_BAR;
            }
        }
        if constexpr (ALIGN_EPI) { if (wr == 0) PG8_BAR; }
        if constexpr (!Epi::AFTER_DRAIN) { E(acc, cur, wr, wc, fr, fq); S.done(cur); }
        if (!has_next) break;
#pragma unroll
        for (int a = 0; a < 2; ++a)
#pragma unroll
            for (int b = 0; b < 2; ++b)
#pragma unroll
                for (int m = 0; m < 4; ++m)
#pragma unroll
                    for (int n = 0; n < 2; ++n) acc[a][b][m][n] = (f32x4){0.f, 0.f, 0.f, 0.f};
        cur = nxt; cA = nA; cB = nB; ++ui;
        if constexpr (ALIGN_EPI) { if (wr == 1) PG8_BAR; }
    }
    PG8_WAIT_V(0);
    if constexpr (!ALIGN_EPI) { if (wr == 0) PG8_BAR; }
    PG8_BAR;
    if constexpr (Epi::AFTER_DRAIN) { E.fused(acc, cur, wr, wc, fr, fq, lds, wid, lane); S.done(cur); }
#undef PG8_SA
#undef PG8_SB
#undef PG8_STAGE
#undef PG8_LDA
#undef PG8_LDB
#undef PG8_MMA
#undef PG8_WAIT_V
#undef PG8_WAIT_L
#undef PG8_BAR
#undef PG8_SCHED
}
}
constexpr int D_MODEL = 1024, BATCH = 16, SEQ = 2048, DEC_BATCH = 128, PAST = 8192, PAGE = 128, NPAGES = 64;
constexpr int D_INNER = 2048, A_HEADS = 32, A_HEAD = 64, B_HEADS = 16, KV_LORA = 256, Q_LORA = 384, QK_NOPE = 128, QK_ROPE = 64, V_HEAD = 128, QK_HEAD = 192;
constexpr int MP = BATCH * SEQ;
constexpr int MS0 = MP;
constexpr int MT = MP + 256;
constexpr float NORM_EPS = 1e-6f, GN_EPS = 64e-5f;
constexpr float ATTN_SCALE = 0.07216878364870322f;
constexpr float LOG2E = 1.4426950408889634f;
constexpr int NWAVES = 8, NTHR = 512;

constexpr size_t O_YP = 0, O_YS = O_YP + (size_t)MP * D_MODEL, O_WKVP = O_YS + (size_t)DEC_BATCH * D_MODEL, O_SHP = O_WKVP + (size_t)2 * BATCH * A_HEADS * 4096,
    O_CKVP = O_SHP + (size_t)2 * BATCH * D_MODEL, O_KPEP = O_CKVP + (size_t)MP * KV_LORA, O_WKVS = O_KPEP + (size_t)MP * QK_ROPE, O_SHS = O_WKVS + (size_t)2 * DEC_BATCH * A_HEADS * 4096,
    O_CKVS = O_SHS + (size_t)2 * DEC_BATCH * D_MODEL, O_KPES = O_CKVS + (size_t)DEC_BATCH * KV_LORA, O_END = O_KPES + (size_t)DEC_BATCH * QK_ROPE;

constexpr size_t MiB = 1u << 20;
constexpr size_t WS_CTL = 0, CTL_ZERO_BYTES = 2 * MiB;
constexpr size_t WS_WIN = 2 * MiB;
constexpr size_t WS_W1 = WS_WIN + 32 * MiB;
constexpr size_t WS_W2 = WS_W1 + 3 * MiB;
constexpr size_t WS_WO = WS_W2 + 3 * MiB;
constexpr size_t WS_WDKV = WS_WO + 8 * MiB;
constexpr size_t WS_WUK = WS_WDKV + 1 * MiB;
constexpr size_t WS_WUV = WS_WUK + 1 * MiB;
constexpr size_t WS_WQ = WS_WUV + 1 * MiB;
constexpr size_t WS_WZ = WS_WQ + 2 * MiB;
constexpr size_t WS_WUQ = WS_WZ + 8 * MiB;
constexpr size_t WS_WBO = WS_WUQ + 5 * MiB;
constexpr size_t WS_ROPE = WS_WBO + 8 * MiB;
constexpr size_t WS_X = 96 * MiB;
constexpr size_t WS_AM = WS_X + 130 * MiB;
constexpr size_t AM_STRIDE = 65 * MiB;
constexpr size_t WS_R = WS_AM + 6 * AM_STRIDE;
constexpr size_t BIGB = 130 * MiB;
constexpr size_t WS_K = WS_R + BIGB, WS_V0 = WS_K + BIGB, WS_V1 = WS_V0 + BIGB, WS_Z = WS_V1 + BIGB, WS_G = WS_Z + BIGB;
constexpr size_t WS_LW = WS_G + BIGB;
constexpr size_t WS_LA = WS_LW + 9 * MiB, WS_LV = WS_LA + 9 * MiB;
constexpr size_t WS_BON = WS_LV + 9 * MiB;
constexpr size_t WS_F = WS_BON + 5 * MiB;
constexpr size_t BIGF = 260 * MiB;
constexpr size_t WS_WD = WS_F, WS_IA = WS_F + BIGF, WS_VG = WS_F + 2 * BIGF, WS_SR = WS_F + 3 * BIGF, WS_SK = WS_F + 4 * BIGF, WS_SA = WS_F + 5 * BIGF, WS_SB = WS_F + 6 * BIGF,
    WS_SV = WS_F + 7 * BIGF, WS_Y = WS_F + 8 * BIGF, WS_END_A = WS_F + 9 * BIGF;
constexpr size_t WS_KVR = WS_F;
constexpr size_t WS_CKVB = WS_KVR + 41 * MiB;
constexpr size_t WS_KPEB = WS_CKVB + 17 * MiB;
constexpr size_t WS_KN = WS_KPEB + 5 * MiB;
constexpr size_t WS_VT = WS_KN + 128 * MiB;
constexpr size_t WS_QL = WS_VT + 128 * MiB;
constexpr size_t WS_CQ = WS_QL + 49 * MiB;
constexpr size_t WS_QR = WS_CQ + 25 * MiB;
constexpr size_t WS_Q = WS_QR + 388 * MiB;
constexpr size_t WS_QABS = WS_Q + 194 * MiB;
constexpr size_t WS_OPART = WS_QABS + 2 * MiB;
constexpr size_t WS_ML = WS_OPART + 16 * MiB;
constexpr size_t WS_END_B = WS_ML + 1 * MiB;
constexpr size_t WS_NEED = WS_END_A > WS_END_B ? WS_END_A : WS_END_B;
static_assert(WS_ROPE + 1 * MiB <= WS_X, "weights region");
constexpr size_t CW_RSQ = 1 * MiB;
constexpr int CW_BAR = 4096;

constexpr int RING_BYTES = 131072;
constexpr int LDSCTL_OFF = RING_BYTES;
constexpr int LDS_BYTES = 147456;

#define GAS __attribute__((address_space(1)))
#define LAS __attribute__((address_space(3)))
typedef unsigned short bf16;
typedef unsigned v4u __attribute__((ext_vector_type(4)));
typedef unsigned v2u __attribute__((ext_vector_type(2)));
typedef float f32x4 __attribute__((ext_vector_type(4)));
typedef float f32x16 __attribute__((ext_vector_type(16)));
typedef short bf16x8 __attribute__((ext_vector_type(8)));
typedef short s16x4 __attribute__((ext_vector_type(4)));
typedef const __attribute__((address_space(4))) float* cfp;
#define LDS_WAIT() asm volatile("s_waitcnt lgkmcnt(0)" ::: "memory")
#define VM_WAIT() asm volatile("s_waitcnt vmcnt(0)" ::: "memory")
__device__ __forceinline__ unsigned f2bf(float f) { unsigned u = __builtin_bit_cast(unsigned, f); return (u + 0x7fffu + ((u >> 16) & 1u)) >> 16; }
__device__ __forceinline__ unsigned pk2(float lo, float hi) { return f2bf(lo) | (f2bf(hi) << 16); }
__device__ __forceinline__ float bflo(unsigned u) { return __builtin_bit_cast(float, u << 16); }
__device__ __forceinline__ float bfhi(unsigned u) { return __builtin_bit_cast(float, u & 0xffff0000u); }
template <int MASK> __device__ __forceinline__ float swz_xor(float v) { return __builtin_bit_cast(float, __builtin_amdgcn_ds_swizzle(__builtin_bit_cast(int, v), 0x1F | (MASK << 10))); }
__device__ __forceinline__ float xor32_sum(float v) { float a = v, b = v; asm volatile("s_nop 1\n\tv_permlane32_swap_b32 %0, %1\n\ts_nop 1" : "+v"(a), "+v"(b)); return a + b; }
__device__ __forceinline__ float xor32_max(float v) { float a = v, b = v; asm volatile("s_nop 1\n\tv_permlane32_swap_b32 %0, %1\n\ts_nop 1" : "+v"(a), "+v"(b)); return fmaxf(a, b); }
__device__ __forceinline__ float wave_sum(float v) { v += swz_xor<1>(v); v += swz_xor<2>(v); v += swz_xor<4>(v); v += swz_xor<8>(v); v += swz_xor<16>(v); return xor32_sum(v); }
__device__ __forceinline__ float sigmoidf_(float x) { return 1.0f / (1.0f + __expf(-x)); }
#define XB_TMO      128
#define XB_XCNT(j)  (256  + 64 * (j))
#define XB_XSUB(j)  (1280 + 64 * (j))
#define XB_XGEN(j)  (2304 + 64 * (j))
#define XB_TOP      3328
#define XB_TOPGEN   3392
#define XCD_BAR_WORDS 3456
#define XB_SPIN_CAP (1u << 18)

__device__ __forceinline__ unsigned xb_ld(unsigned* p)              { return __hip_atomic_load(p, __ATOMIC_RELAXED, __HIP_MEMORY_SCOPE_AGENT); }
__device__ __forceinline__ unsigned xb_add(unsigned* p, unsigned v) { return __hip_atomic_fetch_add(p, v, __ATOMIC_RELAXED, __HIP_MEMORY_SCOPE_AGENT); }
__device__ __forceinline__ unsigned xb_xcc_id() { return (unsigned)__builtin_amdgcn_s_getreg((3 << 11) | 20) & 0xFu; }
#define XB_SPIN(cond, bar) do { unsigned _sp = 0; while (cond) { __builtin_amdgcn_s_sleep(1); \
    if ((++_sp & 255u) == 0u) { if (xb_ld(&(bar)[XB_TMO])) break; if (_sp > XB_SPIN_CAP) { atomicAdd(&(bar)[XB_TMO], 1u); break; } } } } while (0)

struct XcdBarrier {
    unsigned* bar; unsigned x; unsigned w;
    volatile LAS unsigned* st;
};

__device__ __forceinline__ bool xb_t0(unsigned w) { unsigned l; asm volatile("v_mbcnt_lo_u32_b32 %0, -1, 0\n\tv_mbcnt_hi_u32_b32 %0, -1, %0" : "=v"(l)); return w == 0u && l == 0u; }
__device__ __forceinline__ XcdBarrier xcd_barrier_post(unsigned* bar, volatile LAS unsigned* st, unsigned w) {
    XcdBarrier b; b.bar = bar; b.x = xb_xcc_id(); b.st = st; b.w = w;
    if (xb_t0(w)) (void)xb_add(&bar[XB_XCNT(b.x)], 1u);
    return b;
}
__device__ __forceinline__ void xcd_barrier_complete(unsigned* bar, unsigned x, unsigned& nloc, unsigned& nx) {
    const unsigned G = gridDim.x * gridDim.y * gridDim.z;
    unsigned sum, cnt, mine, sp = 0u;
    for (;;) {
        sum = 0u; cnt = 0u; mine = 0u;
#pragma unroll
        for (unsigned j = 0; j < 16; ++j) { const unsigned c = xb_ld(&bar[XB_XCNT(j)]); sum += c; cnt += (c > 0u) ? 1u : 0u; mine = (j == x) ? c : mine; }
        if (sum == G) break;
        __builtin_amdgcn_s_sleep(1);
        if ((++sp & 255u) == 0u) { if (xb_ld(&bar[XB_TMO])) break; if (sp > XB_SPIN_CAP) { atomicAdd(&bar[XB_TMO], 1u); break; } }
    }
    nloc = mine > 0u ? mine : 1u; nx = cnt > 0u ? cnt : 1u;
}

__device__ __forceinline__ void xcd_barrier(const XcdBarrier& b) {
    asm volatile("s_waitcnt vmcnt(0)" ::: "memory");
    __syncthreads();
    if (xb_t0(b.w)) {
        unsigned* bar = b.bar;
        __builtin_amdgcn_s_waitcnt(0);
        unsigned nloc = b.st[0], nx = b.st[1];
        if (nloc == 0u) { xcd_barrier_complete(bar, b.x, nloc, nx); b.st[0] = nloc; b.st[1] = nx; }
        const unsigned old = xb_add(&bar[XB_XSUB(b.x)], 1u);
        const unsigned gen = old / nloc;
        if (old + 1u == (gen + 1u) * nloc) {
            __builtin_amdgcn_fence(__ATOMIC_RELEASE, "agent");
            asm volatile("s_waitcnt vmcnt(0)" ::: "memory");
            const unsigned og = xb_add(&bar[XB_TOP], 1u);
            const unsigned tg = og / nx;
            if (og + 1u == (tg + 1u) * nx) xb_add(&bar[XB_TOPGEN], 1u);
            else XB_SPIN(xb_ld(&bar[XB_TOPGEN]) == tg, bar);
            __builtin_amdgcn_fence(__ATOMIC_ACQUIRE, "agent");
            xb_add(&bar[XB_XGEN(b.x)], 1u);
            asm volatile("s_waitcnt vmcnt(0)" ::: "memory");
        } else {
            XB_SPIN(xb_ld(&bar[XB_XGEN(b.x)]) == gen, bar);
            __builtin_amdgcn_fence(__ATOMIC_ACQUIRE, "agent");
            asm volatile("s_waitcnt vmcnt(0)" ::: "memory");
        }
    }
    __syncthreads();
}
struct Args { const void* in[36]; float* out; unsigned char* ws; int ph_lo, ph_hi, li, pad; };
typedef const __attribute__((address_space(4))) Args* cargs;
__device__ __forceinline__ int lane_id() { int l; asm volatile("v_mbcnt_lo_u32_b32 %0, -1, 0\n\tv_mbcnt_hi_u32_b32 %0, -1, %0" : "=v"(l)); return l; }
struct Frame { LAS unsigned char* lds; unsigned char* ws; float* out; int lane, wave, bid, gw, NGW, G, NT; };
#define LANE F.lane
__device__ __forceinline__ Frame make_frame(cargs ap, int wave0, LAS unsigned char* lds) {
    Frame F; int w = wave0, b = (int)blockIdx.x, g = (int)gridDim.x; asm volatile("" : "+s"(w), "+s"(b), "+s"(g));
    F.lds = lds; F.ws = ap->ws; F.out = ap->out; F.lane = lane_id(); F.wave = w; F.bid = b; F.G = g; F.gw = b * NWAVES + w; F.NGW = g * NWAVES; F.NT = g * NTHR;
    return F;
}

__device__ __forceinline__ int rope_perm_col(int n) { const int c = n % 192; if (c < 128) return n; const int j = c - 128; return n - c + 128 + 2 * (j & 31) + (j >> 5); }
__device__ __forceinline__ void tr_item(const float* W, int ldw, int col0, int Kvalid, int nblk, bf16* WT, int ldt, bool zpad, LAS float* scr, int item, int lane, bool rperm = false) {
    const int kb = item / nblk, nb = item % nblk, k0 = 64 * kb, n0 = 32 * nb;
#pragma unroll
    for (int i = 0; i < 32; ++i) { const int kk = 2 * i + (lane >> 5); scr[kk * 33 + (lane & 31)] = (k0 + kk < Kvalid) ? W[(size_t)(k0 + kk) * ldw + col0 + n0 + (lane & 31)] : 0.f; }
    LDS_WAIT(); asm volatile("" ::: "memory");
    const int c = lane & 7;
#pragma unroll
    for (int j = 0; j < 4; ++j) { const int n = (lane >> 3) + 8 * j; const LAS float* s = scr + (8 * c) * 33 + n;
        v4u o; o.x = pk2(s[0 * 33], s[1 * 33]); o.y = pk2(s[2 * 33], s[3 * 33]); o.z = pk2(s[4 * 33], s[5 * 33]); o.w = pk2(s[6 * 33], s[7 * 33]);
        const int nd = rperm ? rope_perm_col(n0 + n) : n0 + n;
        *(v4u*)(WT + (size_t)nd * ldt + k0 + 8 * c) = o;
        if (zpad) *(v4u*)(WT + (size_t)nd * ldt + 64 + 8 * c) = (v4u){0u, 0u, 0u, 0u}; }
    LDS_WAIT(); asm volatile("" ::: "memory");
}
#define TRJOB_(W_, ldw_, col0_, Kv_, Nc_, WT_, ldt_, zp_, rp_) do { const int nblk_ = (Nc_) / 32, items_ = (((Kv_) + 63) / 64) * nblk_; \
    for (int it_ = ((F.gw - base_) % F.NGW + F.NGW) % F.NGW; it_ < items_; it_ += F.NGW) tr_item((W_), (ldw_), (col0_), (Kv_), nblk_, (bf16*)(WT_), (ldt_), (zp_), scr, it_, LANE, (rp_)); base_ = (base_ + items_) % F.NGW; } while (0)
#define TRJOB(W_, ldw_, col0_, Kv_, Nc_, WT_, ldt_, zp_) TRJOB_(W_, ldw_, col0_, Kv_, Nc_, WT_, ldt_, zp_, false)

__device__ __forceinline__ void p0_prologue(Frame& F, cargs a) {
    LAS float* scr = (LAS float*)(F.lds + F.wave * 16384);
    unsigned char* ws = F.ws; int base_ = 0;
    for (int l = 0; l < 2; ++l) {
        for (int p = 0; p < 4; ++p) TRJOB((const float*)a->in[9] + (size_t)(l * 4 + p) * 1024 * 2048, 2048, 0, 1024, 2048, ws + WS_WIN + (size_t)(l * 4 + p) * 4 * MiB, 1024, false);
        TRJOB((const float*)a->in[11] + (size_t)l * 1024 * 64, 64, 0, 1024, 64, ws + WS_W1 + (size_t)l * (MiB / 2), 1024, false);
        TRJOB((const float*)a->in[14] + (size_t)l * 1024 * 64, 64, 0, 1024, 64, ws + WS_W1 + (size_t)(2 + l) * (MiB / 2), 1024, false);
        TRJOB((const float*)a->in[12] + (size_t)l * 64 * 2048, 2048, 0, 64, 2048, ws + WS_W2 + (size_t)l * (MiB / 2), 128, true);
        TRJOB((const float*)a->in[15] + (size_t)l * 64 * 2048, 2048, 0, 64, 2048, ws + WS_W2 + (size_t)(2 + l) * (MiB / 2), 128, true);
        TRJOB((const float*)a->in[24] + (size_t)l * 2048 * 1024, 1024, 0, 2048, 1024, ws + WS_WO + (size_t)l * 4 * MiB, 2048, false);
        TRJOB((const float*)a->in[31] + (size_t)l * 1024 * 2432, 2432, 0, 1024, 384, ws + WS_WQ + (size_t)l * MiB, 1024, false);
        TRJOB((const float*)a->in[31] + (size_t)l * 1024 * 2432, 2432, 384, 1024, 2048, ws + WS_WZ + (size_t)l * 4 * MiB, 1024, false);
        TRJOB_((const float*)a->in[33] + (size_t)l * 384 * 3072, 3072, 0, 384, 3072, ws + WS_WUQ + (size_t)l * (5 * MiB / 2), 384, false, true);
        TRJOB((const float*)a->in[34] + (size_t)l * 2048 * 1024, 1024, 0, 2048, 1024, ws + WS_WBO + (size_t)l * 4 * MiB, 2048, false);
    }
    TRJOB((const float*)a->in[17], 32, 0, 1024, 32, ws + WS_W1 + (size_t)4 * (MiB / 2), 1024, false);
    TRJOB((const float*)a->in[18], 2048, 0, 32, 2048, ws + WS_W2 + (size_t)4 * (MiB / 2), 128, true);
    TRJOB((const float*)a->in[26], 320, 0, 1024, 320, ws + WS_WDKV, 1024, false);
    TRJOB((const float*)a->in[28], 2048, 0, 256, 2048, ws + WS_WUK, 256, false);
    TRJOB((const float*)a->in[29], 2048, 0, 256, 2048, ws + WS_WUV, 256, false);
    { const f32x4* xs = (const f32x4*)a->in[1]; f32x4* X4 = (f32x4*)(ws + WS_X) + (size_t)MP * 256;
      for (int i = (F.bid * NTHR + F.wave * 64 + LANE); i < 256 * 256; i += F.NT) X4[i] = i < DEC_BATCH * 256 ? xs[i] : (f32x4){0.f, 0.f, 0.f, 0.f}; }
    { float* T = (float*)(ws + WS_ROPE);
      for (int i = (F.bid * NTHR + F.wave * 64 + LANE); i < 2049 * 32; i += F.NT) { const int p = i >> 5, f = i & 31; const double pos = p < 2048 ? (double)p : 8192.0;
          const double ang = pos * (double)exp2f(-(float)f * (13.287712379549449f / 32.0f)); T[2 * i] = (float)cos(ang); T[2 * i + 1] = (float)sin(ang); } }
}

__device__ __forceinline__ void load_row(const float* row, int lane, f32x4 (&v)[4]) {
#pragma unroll
    for (int j = 0; j < 4; ++j) v[j] = ((const f32x4*)row)[lane + 64 * j];
}
__device__ __forceinline__ float row_rs(const f32x4 (&v)[4]) {
    float s = 0.f;
#pragma unroll
    for (int j = 0; j < 4; ++j) s += (v[j].x * v[j].x + v[j].y * v[j].y) + (v[j].z * v[j].z + v[j].w * v[j].w);
    return 1.0f / sqrtf(wave_sum(s) * (1.0f / 1024.0f) + NORM_EPS);
}
__device__ __forceinline__ void norm_rows_bf16(Frame& F, const float* X, const float* w, bf16* O) {
    f32x4 w4[4]; load_row(w, LANE, w4);
    for (int m = F.gw; m < MT; m += F.NGW) { f32x4 x[4]; load_row(X + (size_t)m * 1024, LANE, x); const float rs = row_rs(x);
#pragma unroll
        for (int j = 0; j < 4; ++j) { const f32x4 h = x[j] * rs * w4[j]; v2u o; o.x = pk2(h.x, h.y); o.y = pk2(h.z, h.w); *(v2u*)(O + (size_t)m * 1024 + 4 * LANE + 256 * j) = o; } }
}

__device__ __forceinline__ void a1_prepass(Frame& F, cargs a, int l) {
    const float* Xw = (const float*)(F.ws + WS_X); const float* X = l == 0 ? (const float*)a->in[0] : Xw;
    const float* nw = (const float*)a->in[7] + l * 1024; const float* mix = (const float*)a->in[8] + l * 6 * 1024; const float* sshift = (const float*)a->in[3] + (size_t)l * DEC_BATCH * 1024;
    f32x4 w4[4]; load_row(nw, LANE, w4);
    for (int m = F.gw; m < MT; m += F.NGW) {
        f32x4 x[4], h[4], hp[4]; load_row((m < MP ? X : Xw) + (size_t)m * 1024, LANE, x); const float rs = row_rs(x);
#pragma unroll
        for (int j = 0; j < 4; ++j) { h[j] = x[j] * rs * w4[j]; hp[j] = (f32x4){0.f, 0.f, 0.f, 0.f}; }
        if (m < MP) { if ((m & (SEQ - 1)) != 0) { f32x4 xq[4]; load_row(X + (size_t)(m - 1) * 1024, LANE, xq); const float rq = row_rs(xq);
#pragma unroll
                for (int j = 0; j < 4; ++j) hp[j] = xq[j] * rq * w4[j]; } }
        else if (m < MP + DEC_BATCH) load_row(sshift + (size_t)(m - MP) * 1024, LANE, hp);
#pragma unroll
        for (int p = 0; p < 6; ++p) { bf16* O = (bf16*)(F.ws + WS_AM + (size_t)p * AM_STRIDE) + (size_t)m * 1024;
#pragma unroll
            for (int j = 0; j < 4; ++j) { const f32x4 mx = ((const f32x4*)(mix + p * 1024))[LANE + 64 * j]; const f32x4 o = h[j] + (hp[j] - h[j]) * mx;
                v2u w; w.x = pk2(o.x, o.y); w.y = pk2(o.z, o.w); *(v2u*)(O + 4 * LANE + 256 * j) = w; } }
        float* so = nullptr;
        if (m < MP) { if ((m & (SEQ - 1)) == SEQ - 1) so = F.out + O_SHP + (size_t)(l * BATCH + (m >> 11)) * 1024; }
        else if (m < MP + DEC_BATCH) so = F.out + O_SHS + (size_t)(l * DEC_BATCH + (m - MP)) * 1024;
        if (so) {
#pragma unroll
            for (int j = 0; j < 4; ++j) ((f32x4*)so)[LANE + 64 * j] = h[j]; }
    }
}

typedef float f32x2 __attribute__((ext_vector_type(2)));
__device__ __forceinline__ void unpack8(v4u u, float (&f)[8]) { f[0] = bflo(u.x); f[1] = bfhi(u.x); f[2] = bflo(u.y); f[3] = bfhi(u.y); f[4] = bflo(u.z); f[5] = bfhi(u.z); f[6] = bflo(u.w); f[7] = bfhi(u.w); }
constexpr int FS_TS = 16, FS_Y = FS_TS * 6 * 64 * 4, FS_Z = FS_Y + FS_TS * 64 * 4, FS_BON = FS_Z + FS_TS * 64 * 2, FS_BH = FS_BON + 128, FS_BUF = 2 * FS_BH;
static_assert(2 * FS_BUF <= RING_BYTES && FS_BH % 16 == 0, "fused scan LDS");
template <int CTRL> __device__ __forceinline__ float dppf(float v) { return __builtin_bit_cast(float, __builtin_amdgcn_update_dpp(0, __builtin_bit_cast(int, v), CTRL, 0xF, 0xF, false)); }
__device__ __forceinline__ float wave_sum_fast(float v) {
    v += dppf<0xB1>(v); v += dppf<0x4E>(v); v += dppf<0x124>(v); v += dppf<0x128>(v);
    const int iv = __builtin_bit_cast(int, v);
    return (__builtin_bit_cast(float, __builtin_amdgcn_readlane(iv, 0)) + __builtin_bit_cast(float, __builtin_amdgcn_readlane(iv, 16))) + (__builtin_bit_cast(float, __builtin_amdgcn_readlane(iv, 32)) + __builtin_bit_cast(float, __builtin_amdgcn_readlane(iv, 48)));
}
struct HeadPrm { float w0, a0, v0, kk, ka, rk, lnw, lnb; };
__device__ __forceinline__ float frcp(float x) { return __builtin_amdgcn_rcpf(x); }
__device__ __forceinline__ float fsig(float x) { return __builtin_amdgcn_rcpf(1.0f + __builtin_amdgcn_exp2f(-1.4426950408889634f * x)); }
__device__ __forceinline__ float wkv_step_lds(f32x2 (&S)[32], const LAS float* op, int lane) {
    const LAS f32x4* a4 = (const LAS f32x4*)op; const LAS f32x4* w4 = a4 + 16; const LAS f32x4* b4 = a4 + 32; const LAS f32x4* k4 = a4 + 48; const LAS f32x4* r4 = a4 + 64;
    const float vv = op[320 + lane];
    f32x2 s0 = (f32x2){0.f, 0.f}, s1 = s0;
#pragma unroll
    for (int q = 0; q < 16; ++q) { const f32x4 a = a4[q]; s0 += S[2 * q] * (f32x2){a.x, a.y}; s1 += S[2 * q + 1] * (f32x2){a.z, a.w}; }
    const f32x2 st = s0 + s1; const float sa = st.x + st.y; const f32x2 sa2 = (f32x2){sa, sa}, vv2 = (f32x2){vv, vv};
    f32x2 y0 = (f32x2){0.f, 0.f}, y1 = y0;
#pragma unroll
    for (int q = 0; q < 16; ++q) { const f32x4 w = w4[q], b = b4[q], k = k4[q], r = r4[q];
        S[2 * q] = S[2 * q] * (f32x2){w.x, w.y} + (sa2 * (f32x2){b.x, b.y} + vv2 * (f32x2){k.x, k.y}); y0 += S[2 * q] * (f32x2){r.x, r.y};
        S[2 * q + 1] = S[2 * q + 1] * (f32x2){w.z, w.w} + (sa2 * (f32x2){b.z, b.w} + vv2 * (f32x2){k.z, k.w}); y1 += S[2 * q + 1] * (f32x2){r.z, r.w}; }
    const f32x2 yt = y0 + y1; return yt.x + yt.y;
}
__device__ __forceinline__ void fs_prep_one(const HeadPrm& P, int l, float r, float k, float v, float dw, float da, float dv, float vf, LAS float* op, int lane, float& bon) {
    const float ia = da, w = __builtin_amdgcn_exp2f(dw);
    if (l) v = v + (vf - v) * dv;
    const float kk = k * P.kk, n2 = wave_sum_fast(kk * kk), inv = 1.0f / fmaxf(sqrtf(n2), 1e-12f), q = kk * inv, kp = k * (1.0f + (ia - 1.0f) * P.ka);
    bon = wave_sum_fast(r * kp * P.rk);
    op[lane] = -q; op[64 + lane] = w; op[128 + lane] = q * ia; op[192 + lane] = kp; op[256 + lane] = r; op[320 + lane] = v;
}
__device__ __forceinline__ float fs_post_one(const HeadPrm& P, float y, float vp, float z, float bon) {
    const float mu = wave_sum_fast(y) * (1.0f / 64.0f), d = y - mu, var = wave_sum_fast(d * d) * (1.0f / 64.0f);
    const float yn = d * __builtin_amdgcn_rsqf(var + GN_EPS) * P.lnw + P.lnb; return (yn + bon * vp) * (z * fsig(z));
}
__device__ __forceinline__ float ldbf(const bf16* p) { return bflo((unsigned)*p); }
__device__ __forceinline__ bf16 tobf(float x) { return __builtin_bit_cast(unsigned short, (__bf16)x); }
typedef short s16x4_t __attribute__((ext_vector_type(4)));
#define MF16(a_, b_, c_) __builtin_amdgcn_mfma_f32_16x16x16bf16_1k((a_), (b_), (c_), 0, 0, 0)
#define MF32(a_, b_, c_) __builtin_amdgcn_mfma_f32_16x16x32_bf16((a_), (b_), (c_), 0, 0, 0)
typedef __bf16 bf16x4_nat __attribute__((ext_vector_type(4)));
__device__ __forceinline__ s16x4_t cvt4(f32x4 v) { return __builtin_bit_cast(s16x4_t, __builtin_convertvector(v, bf16x4_nat)); }
constexpr int CK_TP = 144, CK_KP = 40;
constexpr int CK_AT = 0, CK_RT = CK_AT + 16 * CK_TP, CK_BH = CK_RT + 16 * CK_TP, CK_KH = CK_BH + 16 * CK_TP, CK_BHT = CK_KH + 16 * CK_TP, CK_KHT = CK_BHT + 64 * CK_KP, CK_VT = CK_KHT + 64 * CK_KP,
    CK_PC = CK_VT + 64 * CK_KP, CK_OPB = CK_PC + 256;
constexpr int RG_VP = 0, RG_Z = 2048, RG_BON = 4096, RG_SZ = 4224;
constexpr int BH_OPB = 0, BH_RING = 2 * CK_OPB, BH_Y = BH_RING + 3 * RG_SZ, BH_LW = BH_Y + 2 * 4096, BH_PRM = BH_LW + 4096, BH_SZ = BH_PRM + 6 * 256;
static_assert(2 * BH_SZ <= RING_BYTES && BH_SZ % 16 == 0 && CK_OPB % 16 == 0, "chunked scan LDS");
typedef short v4i16_ck __attribute__((ext_vector_type(4)));
__device__ __forceinline__ s16x4_t ck_tr(const LAS unsigned char* p) { return __builtin_bit_cast(s16x4_t, __builtin_amdgcn_ds_read_tr16_b64_v4i16((LAS v4i16_ck*)p)); }
__device__ __forceinline__ void ck_scan_chunk(f32x4 (&ST)[4][4], const LAS unsigned char* ob, const LAS unsigned char* vpb, LAS float* yb, int c16, int g) {
    const f32x4 zero4 = (f32x4){0.f, 0.f, 0.f, 0.f};
    bf16x8 at[2], rt[2], bh[2], kh[2];
#pragma unroll
    for (int ks = 0; ks < 2; ++ks) { const int o = c16 * CK_TP + 16 * g + 64 * ks;
        at[ks] = *(const LAS bf16x8*)(ob + CK_AT + o); rt[ks] = *(const LAS bf16x8*)(ob + CK_RT + o); bh[ks] = *(const LAS bf16x8*)(ob + CK_BH + o); kh[ks] = *(const LAS bf16x8*)(ob + CK_KH + o); }
    f32x4 qN = zero4, qL = zero4, qMk = zero4, qNbr = zero4, qNkr = zero4;
#pragma unroll
    for (int ks = 0; ks < 2; ++ks) { qN = MF32(bh[ks], at[ks], qN); qL = MF32(at[ks], bh[ks], qL); qMk = MF32(kh[ks], at[ks], qMk); qNbr = MF32(bh[ks], rt[ks], qNbr); qNkr = MF32(kh[ks], rt[ks], qNkr); }
    f32x4 Id;
#pragma unroll
    for (int r = 0; r < 4; ++r) { const int row = 4 * g + r; Id[r] = row == c16 ? 1.f : 0.f;
        if (!(row < c16)) { qN[r] = 0.f; qMk[r] = 0.f; }
        if (!(row <= c16)) { qNbr[r] = 0.f; qNkr[r] = 0.f; }
        if (!(c16 < row)) qL[r] = 0.f; }
    const s16x4_t aN = cvt4(qN), aL = cvt4(qL), aMk = cvt4(qMk), aNbr = cvt4(qNbr), aNkr = cvt4(qNkr);
    const f32x4 n2 = MF16(aL, aN, zero4), l2 = MF16(aN, aL, zero4);
    const s16x4_t aN2 = cvt4(n2), aL2 = cvt4(l2);
    const f32x4 n4 = MF16(aL2, aN2, zero4), l4 = MF16(aN2, aL2, zero4);
    const f32x4 n8 = MF16(cvt4(l4), cvt4(n4), zero4);
    const f32x4 p1t = MF16(cvt4(n2 + Id), cvt4(qL + Id), zero4);
    const f32x4 p2 = MF16(cvt4(l4 + Id), cvt4(n8 + Id), zero4);
    const s16x4_t aT = cvt4(MF16(cvt4(p1t), cvt4(p2), zero4));
    s16x4_t af[4], rf[4], bfr[4], kfr[4], vtr[4]; f32x4 pc[4]; s16x4_t Sb[4];
#pragma unroll
    for (int ki = 0; ki < 4; ++ki) { const int o = c16 * CK_TP + (16 * ki + 4 * g) * 2; af[ki] = *(const LAS s16x4_t*)(ob + CK_AT + o); rf[ki] = *(const LAS s16x4_t*)(ob + CK_RT + o);
        const int o2 = (4 * g + (c16 >> 2)) * CK_TP + (16 * ki + 4 * (c16 & 3)) * 2; bfr[ki] = ck_tr(ob + CK_BH + o2); kfr[ki] = ck_tr(ob + CK_KH + o2);
        vtr[ki] = ck_tr(vpb + (4 * g + (c16 >> 2)) * 128 + (16 * ki + 4 * (c16 & 3)) * 2);
        pc[ki] = *(const LAS f32x4*)(ob + CK_PC + (16 * ki + 4 * g) * 4); }
    f32x4 yt[4];
#pragma unroll
    for (int vi = 0; vi < 4; ++vi) {
        f32x4 xt = zero4, y0 = zero4;
#pragma unroll
        for (int ki = 0; ki < 4; ++ki) { Sb[ki] = cvt4(ST[ki][vi]); xt = MF16(af[ki], Sb[ki], xt); y0 = MF16(rf[ki], Sb[ki], y0); }
        const s16x4_t vt = vtr[vi];
        xt = MF16(aMk, vt, xt);
        const s16x4_t ub = cvt4(MF16(aT, cvt4(xt), zero4));
        y0 = MF16(aNbr, ub, y0); yt[vi] = MF16(aNkr, vt, y0);
#pragma unroll
        for (int ki = 0; ki < 4; ++ki) { ST[ki][vi] = MF16(bfr[ki], ub, ST[ki][vi]); ST[ki][vi] = MF16(kfr[ki], vt, ST[ki][vi]); ST[ki][vi] *= pc[ki]; }
    }
#pragma unroll
    for (int vi = 0; vi < 4; ++vi)
#pragma unroll
        for (int r = 0; r < 4; ++r) yb[(4 * g + r) * 64 + 16 * vi + c16] = yt[vi][r];
}
__device__ __forceinline__ void a5_fused(Frame& F, cargs a, int l) {
    unsigned char* ws = F.ws; const int lane = F.lane;
    const bf16* R = (const bf16*)(ws + WS_R); const bf16* K = (const bf16*)(ws + WS_K); const bf16* V = (const bf16*)(ws + (l ? WS_V1 : WS_V0)); const bf16* VF = (const bf16*)(ws + WS_V0); const bf16* Z = (const bf16*)(ws + WS_Z);
    const bf16* DW = (const bf16*)(ws + WS_WD); const bf16* DA = (const bf16*)(ws + WS_IA); const bf16* DV = (const bf16*)(ws + WS_VG); bf16* G = (bf16*)(ws + WS_G);
    const float* pw0 = (const float*)a->in[10] + l * 2048; const float* pa0 = (const float*)a->in[13] + l * 2048; const float* pv0 = (const float*)a->in[16]; const float* pkk = (const float*)a->in[19] + l * 2048;
    const float* pka = (const float*)a->in[20] + l * 2048; const float* prk = (const float*)a->in[21] + l * 2048; const float* plw = (const float*)a->in[22] + l * 2048; const float* plb = (const float*)a->in[23] + l * 2048;
    constexpr int NCH = SEQ / 16;
    for (int pr = F.bid; pr < BATCH * A_HEADS / 2; pr += F.G) { const int bh0 = 2 * pr;
        const int role = F.wave >> 1, hb = F.wave & 1, bh = bh0 + hb, b = bh >> 5, hh = bh & 31, ch = hh * 64 + lane;
        LAS unsigned char* blk = F.lds + hb * BH_SZ;
        const size_t rowb = (size_t)b * SEQ; const int c16 = lane & 15, g = lane >> 4;
#define CK_BAR() do { asm volatile("s_waitcnt lgkmcnt(0)" ::: "memory"); __builtin_amdgcn_s_barrier(); asm volatile("" ::: "memory"); } while (0)
#define CKV_LOAD(cc, SET) do { const size_t ro = (rowb + (size_t)(cc) * 16) * 2048;     \
            _Pragma("unroll") for (int j = 0; j < 2; ++j) { SET##r[j] = ((const v4u*)(R + ro + voff_))[j]; SET##k[j] = ((const v4u*)(K + ro + voff_))[j]; SET##v[j] = ((const v4u*)(V + ro + voff_))[j]; SET##z[j] = ((const v4u*)(Z + ro + voff_))[j]; \
                SET##w[j] = ((const v4u*)(DW + ro + voff_))[j]; SET##a[j] = ((const v4u*)(DA + ro + voff_))[j]; if (l) { SET##d[j] = ((const v4u*)(DV + ro + voff_))[j]; SET##f[j] = ((const v4u*)(VF + ro + voff_))[j]; } } } while (0)
#define CKV_PREP(cc, SET) do { LAS unsigned char* ob = blk + BH_OPB + ((cc) & 1) * CK_OPB; LAS unsigned char* rg = blk + BH_RING + ((cc) % 3) * RG_SZ; \
            float kk_[16], kp_[16], ia_[16], lw_[16]; float n2 = 0.f, bon = 0.f; \
            _Pragma("unroll") for (int j = 0; j < 2; ++j) { float k8[8], a8[8], r8[8], w8[8]; unpack8(SET##k[j], k8); unpack8(SET##a[j], a8); unpack8(SET##r[j], r8); unpack8(SET##w[j], w8); \
                _Pragma("unroll") for (int h = 0; h < 2; ++h) { const f32x4 pkk_ = prm[3 * 16 + 4 * vq_ + 2 * j + h], pka_ = prm[4 * 16 + 4 * vq_ + 2 * j + h], prk_ = prm[5 * 16 + 4 * vq_ + 2 * j + h]; \
                    _Pragma("unroll") for (int e = 0; e < 4; ++e) { const int i = 8 * j + 4 * h + e, e8 = 4 * h + e; const float ia = a8[e8]; ia_[i] = ia; lw_[i] = w8[e8]; \
                        const float kk = k8[e8] * pkk_[e]; kk_[i] = kk; n2 += kk * kk; const float kp = k8[e8] * (1.0f + (ia - 1.0f) * pka_[e]); kp_[i] = kp; bon += r8[e8] * kp * prk_[e]; } } } \
            n2 += dppf<0xB1>(n2); n2 += dppf<0x4E>(n2); bon += dppf<0xB1>(bon); bon += dppf<0x4E>(bon); const float inv = __builtin_amdgcn_rsqf(fmaxf(n2, 1e-24f)); \
              \
            _Pragma("unroll") for (int j = 0; j < 4; ++j) lwp[vt_ * 16 + 4 * vq_ + j] = (f32x4){lw_[4 * j], lw_[4 * j + 1], lw_[4 * j + 2], lw_[4 * j + 3]}; \
            LDS_WAIT(); asm volatile("" ::: "memory"); \
            { float c_[16]; _Pragma("unroll") for (int t = 0; t < 16; ++t) c_[t] = ((const LAS float*)lwp)[t * 64 + lane]; \
              _Pragma("unroll") for (int t = 1; t < 16; ++t) c_[t] += c_[t - 1]; \
              _Pragma("unroll") for (int t = 0; t < 16; ++t) ((LAS float*)lwp)[t * 64 + lane] = c_[t]; } \
            LDS_WAIT(); asm volatile("" ::: "memory"); \
            float lp_[16]; _Pragma("unroll") for (int j = 0; j < 4; ++j) { const f32x4 v = lwp[vt_ * 16 + 4 * vq_ + j]; lp_[4 * j] = v.x; lp_[4 * j + 1] = v.y; lp_[4 * j + 2] = v.z; lp_[4 * j + 3] = v.w; } \
            v4u oa[2], orr[2], ob_[2], ok[2], ov[2]; \
            _Pragma("unroll") for (int j = 0; j < 2; ++j) { float r8[8], v8[8]; unpack8(SET##r[j], r8); unpack8(SET##v[j], v8); \
                if (l) { float d8[8], f8[8]; unpack8(SET##d[j], d8); unpack8(SET##f[j], f8); _Pragma("unroll") for (int h = 0; h < 2; ++h) { \
                        _Pragma("unroll") for (int e = 0; e < 4; ++e) { const int e8 = 4 * h + e; v8[e8] = v8[e8] + (f8[e8] - v8[e8]) * d8[e8]; } } } \
                _Pragma("unroll") for (int e = 0; e < 8; e += 2) { const int i = 8 * j + e; \
                    const float P0 = __builtin_amdgcn_exp2f(lp_[i]), P1 = __builtin_amdgcn_exp2f(lp_[i + 1]), R0 = __builtin_amdgcn_exp2f(-lp_[i]), R1 = __builtin_amdgcn_exp2f(-lp_[i + 1]); \
                    const float M0 = __builtin_amdgcn_exp2f(lp_[i] - lw_[i]), M1 = __builtin_amdgcn_exp2f(lp_[i + 1] - lw_[i + 1]), q0 = kk_[i] * inv, q1 = kk_[i + 1] * inv; \
                    oa[j][e >> 1] = (unsigned)tobf(-q0 * M0) | ((unsigned)tobf(-q1 * M1) << 16); orr[j][e >> 1] = (unsigned)tobf(r8[e] * P0) | ((unsigned)tobf(r8[e + 1] * P1) << 16); \
                    ob_[j][e >> 1] = (unsigned)tobf(q0 * ia_[i] * R0) | ((unsigned)tobf(q1 * ia_[i + 1] * R1) << 16); ok[j][e >> 1] = (unsigned)tobf(kp_[i] * R0) | ((unsigned)tobf(kp_[i + 1] * R1) << 16); \
                    ov[j][e >> 1] = (unsigned)tobf(v8[e]) | ((unsigned)tobf(v8[e + 1]) << 16); \
                    if (vt_ == 15) { ((LAS float*)(ob + CK_PC))[16 * vq_ + i] = P0; ((LAS float*)(ob + CK_PC))[16 * vq_ + i + 1] = P1; } } } \
            _Pragma("unroll") for (int j = 0; j < 2; ++j) { const int o = vt_ * CK_TP + 32 * vq_ + 16 * j; *(LAS v4u*)(ob + CK_AT + o) = oa[j]; *(LAS v4u*)(ob + CK_RT + o) = orr[j]; *(LAS v4u*)(ob + CK_BH + o) = ob_[j]; *(LAS v4u*)(ob + CK_KH + o) = ok[j]; \
                *(LAS v4u*)(rg + RG_VP + vt_ * 128 + 32 * vq_ + 16 * j) = ov[j]; *(LAS v4u*)(rg + RG_Z + vt_ * 128 + 32 * vq_ + 16 * j) = SET##z[j]; } \
            if (vq_ == 0) ((LAS float*)(rg + RG_BON))[vt_] = bon; } while (0)
#define CK_POST(cc) do { const LAS unsigned char* rg = blk + BH_RING + ((cc) % 3) * RG_SZ; const LAS float* yb = (const LAS float*)(blk + BH_Y + ((cc) & 1) * 4096) + pt_ * 64 + 16 * pq_; \
            float y_[16], vp_[16], z_[16]; \
            _Pragma("unroll") for (int j = 0; j < 4; ++j) { const f32x4 v = ((const LAS f32x4*)yb)[j]; y_[4 * j] = v.x; y_[4 * j + 1] = v.y; y_[4 * j + 2] = v.z; y_[4 * j + 3] = v.w; } \
            _Pragma("unroll") for (int j = 0; j < 2; ++j) { float t8[8]; unpack8(((const LAS v4u*)(rg + RG_VP + pt_ * 128 + 32 * pq_))[j], t8); _Pragma("unroll") for (int e = 0; e < 8; ++e) vp_[8 * j + e] = t8[e]; \
                unpack8(((const LAS v4u*)(rg + RG_Z + pt_ * 128 + 32 * pq_))[j], t8); _Pragma("unroll") for (int e = 0; e < 8; ++e) z_[8 * j + e] = t8[e]; } \
            const float bon = ((const LAS float*)(rg + RG_BON))[pt_]; float sm = 0.f; \
            _Pragma("unroll") for (int j = 0; j < 16; ++j) sm += y_[j]; \
            sm += dppf<0xB1>(sm); sm += dppf<0x4E>(sm); const float mu = sm * (1.0f / 64.0f); float sq = 0.f; \
            _Pragma("unroll") for (int j = 0; j < 16; ++j) { y_[j] -= mu; sq += y_[j] * y_[j]; } \
            sq += dppf<0xB1>(sq); sq += dppf<0x4E>(sq); const float rstd = __builtin_amdgcn_rsqf(sq * (1.0f / 64.0f) + GN_EPS); \
            v4u o_[2]; \
            _Pragma("unroll") for (int j = 0; j < 16; j += 2) { const float g0 = (y_[j] * rstd * lw_[j] + lb_[j] + bon * vp_[j]) * (z_[j] * fsig(z_[j])), g1 = (y_[j + 1] * rstd * lw_[j + 1] + lb_[j + 1] + bon * vp_[j + 1]) * (z_[j + 1] * fsig(z_[j + 1])); \
                o_[j >> 3][(j >> 1) & 3] = (unsigned)tobf(g0) | ((unsigned)tobf(g1) << 16); } \
            v4u* gp = (v4u*)(G + (rowb + (size_t)(cc) * 16 + pt_) * 2048 + hh * 64 + 16 * pq_); gp[0] = o_[0]; gp[1] = o_[1]; } while (0)
        typedef unsigned short us2 __attribute__((ext_vector_type(2)));
        if (role == 0) { f32x4 ST[4][4];
#pragma unroll
            for (int i = 0; i < 4; ++i)
#pragma unroll
                for (int j = 0; j < 4; ++j) ST[i][j] = (f32x4){0.f, 0.f, 0.f, 0.f};
            CK_BAR();
            for (int c = 0; c < NCH; ++c) { ck_scan_chunk(ST, blk + BH_OPB + (c & 1) * CK_OPB, blk + BH_RING + (c % 3) * RG_SZ + RG_VP, (LAS float*)(blk + BH_Y + (c & 1) * 4096), c16, g); CK_BAR(); }
            float* so = F.out + O_WKVP + ((size_t)(l * BATCH + b) * A_HEADS + hh) * 4096;
#pragma unroll
            for (int ki = 0; ki < 4; ++ki)
#pragma unroll
                for (int vi = 0; vi < 4; ++vi) *(f32x4*)(so + (16 * vi + c16) * 64 + 16 * ki + 4 * g) = ST[ki][vi]; }
        else if (role == 1) { const int ln1 = lane_id(), vt_ = ln1 >> 2, vq_ = ln1 & 3; const unsigned voff_ = (unsigned)(vt_ * 2048 + hh * 64 + 16 * vq_); LAS f32x4* lwp = (LAS f32x4*)(blk + BH_LW); const LAS f32x4* prm = (const LAS f32x4*)(blk + BH_PRM);
            { const int ln = lane_id(), c1 = hh * 64 + ln; LAS float* pf = (LAS float*)(blk + BH_PRM); pf[ln] = pw0[c1]; pf[64 + ln] = pa0[c1]; pf[128 + ln] = l ? pv0[c1] : 0.f; pf[192 + ln] = pkk[c1]; pf[256 + ln] = pka[c1]; pf[320 + ln] = prk[c1]; LDS_WAIT(); asm volatile("" ::: "memory"); }
            v4u Ar[2], Ak[2], Av[2], Az[2], Aw[2], Aa[2], Ad[2], Af[2];
#pragma unroll
            for (int j = 0; j < 2; ++j) { Ad[j] = (v4u){0u, 0u, 0u, 0u}; Af[j] = Ad[j]; }
            CKV_LOAD(0, A); CKV_PREP(0, A); CKV_LOAD(1, A); CK_BAR();
            for (int c = 0; c < NCH; ++c) { if (c + 1 < NCH) { CKV_PREP(c + 1, A); if (c + 2 < NCH) CKV_LOAD(c + 2, A); } CK_BAR(); } }
        else if (role == 3) {
            const int ln3 = lane_id(), vt_ = ln3 >> 2, vq_ = ln3 & 3; const unsigned voff_ = (unsigned)(vt_ * 2048 + hh * 64 + 16 * vq_);
            v4u Ar[2], Ak[2], Av[2], Az[2], Aw[2], Aa[2], Ad[2], Af[2];
#pragma unroll
            for (int j = 0; j < 2; ++j) { Ad[j] = (v4u){0u, 0u, 0u, 0u}; Af[j] = Ad[j]; }
            CKV_LOAD(2, A); CK_BAR();
            for (int c = 0; c < NCH; ++c) {
#pragma unroll
                for (int j = 0; j < 2; ++j) asm volatile("" :: "v"(Ar[j]), "v"(Ak[j]), "v"(Av[j]), "v"(Az[j]), "v"(Aw[j]), "v"(Aa[j]), "v"(Ad[j]), "v"(Af[j]));
                if (c + 3 < NCH) CKV_LOAD(c + 3, A);
                CK_BAR(); } }
        else { const int ln2 = lane_id(), pt_ = ln2 >> 2, pq_ = ln2 & 3; float lw_[16], lb_[16];
#pragma unroll
            for (int j = 0; j < 16; ++j) { lw_[j] = plw[hh * 64 + 16 * pq_ + j]; lb_[j] = plb[hh * 64 + 16 * pq_ + j]; }
            CK_BAR();
            for (int c = 0; c < NCH; ++c) { if (c >= 1) CK_POST(c - 1); CK_BAR(); }
            CK_POST(NCH - 1); }
        __syncthreads();
#undef CK_PREP
#undef CKV_LOAD
#undef CKV_PREP
#undef CK_BAR
#undef CK_POST
    }
    const float* stt = (const float*)a->in[2] + (size_t)l * DEC_BATCH * A_HEADS * 4096;
    LAS float* sop = (LAS float*)(F.lds + F.wave * 2048);
    for (int it = F.gw; it < DEC_BATCH * A_HEADS; it += F.NGW) { const int b = it >> 5, hh = it & 31, ch = hh * 64 + lane; const size_t o = (size_t)(MP + b) * 2048 + ch;
        HeadPrm P; P.w0 = pw0[ch]; P.a0 = pa0[ch]; P.v0 = l ? pv0[ch] : 0.f; P.kk = pkk[ch]; P.ka = pka[ch]; P.rk = prk[ch]; P.lnw = plw[ch]; P.lnb = plb[ch];
        const float z = ldbf(Z + o); float bon;
        fs_prep_one(P, l, ldbf(R + o), ldbf(K + o), ldbf(V + o), ldbf(DW + o), ldbf(DA + o), l ? ldbf(DV + o) : 0.f, l ? ldbf(VF + o) : 0.f, sop, lane, bon);
        LDS_WAIT(); asm volatile("" ::: "memory");
        f32x2 S[32]; const float* si = stt + (size_t)it * 4096 + lane * 64;
#pragma unroll
        for (int k = 0; k < 32; k += 2) { const f32x4 v = *(const f32x4*)(si + 2 * k); S[k] = (f32x2){v.x, v.y}; S[k + 1] = (f32x2){v.z, v.w}; }
        const float y = wkv_step_lds(S, sop, lane), vp = sop[320 + lane];
        float* so = F.out + O_WKVS + ((size_t)l * DEC_BATCH * A_HEADS + it) * 4096 + lane * 64;
#pragma unroll
        for (int k = 0; k < 32; k += 2) *(f32x4*)(so + 2 * k) = (f32x4){S[k].x, S[k].y, S[k + 1].x, S[k + 1].y};
        G[o] = (bf16)f2bf(fs_post_one(P, y, vp, z, bon));
        LDS_WAIT(); asm volatile("" ::: "memory");
    }
#undef FS_PREP
#undef FS_POST
}

__device__ __forceinline__ void final_norm(Frame& F, cargs a) {
    const float* X = (const float*)(F.ws + WS_X); f32x4 w4[4]; load_row((const float*)a->in[35], LANE, w4);
    for (int m = F.gw; m < MP + DEC_BATCH; m += F.NGW) { f32x4 x[4]; load_row(X + (size_t)m * 1024, LANE, x); const float rs = row_rs(x);
        float* o = m < MP ? F.out + O_YP + (size_t)m * 1024 : F.out + O_YS + (size_t)(m - MP) * 1024;
#pragma unroll
        for (int j = 0; j < 4; ++j) ((f32x4*)o)[LANE + 64 * j] = x[j] * rs * w4[j]; }
}
__device__ __forceinline__ void b0c_kvpost(Frame& F, cargs a) {
    unsigned char* ws = F.ws; const float* KVR = (const float*)(ws + WS_KVR); bf16* CK = (bf16*)(ws + WS_CKVB); bf16* KP = (bf16*)(ws + WS_KPEB); const float* ROPE = (const float*)(ws + WS_ROPE);
    const f32x4 w4 = ((const f32x4*)a->in[27])[F.lane];
    for (int m = F.gw; m < MP + DEC_BATCH; m += F.NGW) { const float* row = KVR + (size_t)m * 320;
        const f32x4 v = ((const f32x4*)row)[F.lane]; const float ss = wave_sum((v.x * v.x + v.y * v.y) + (v.z * v.z + v.w * v.w));
        const float rs = 1.0f / sqrtf(ss * (1.0f / 256.0f) + NORM_EPS); const f32x4 c = v * rs * w4;
        float* oc = m < MP ? F.out + O_CKVP + (size_t)m * 256 : F.out + O_CKVS + (size_t)(m - MP) * 256; float* ok = m < MP ? F.out + O_KPEP + (size_t)m * 64 : F.out + O_KPES + (size_t)(m - MP) * 64;
        ((f32x4*)oc)[F.lane] = c; v2u pw; pw.x = pk2(c.x, c.y); pw.y = pk2(c.z, c.w); *(v2u*)(CK + (size_t)m * 256 + 4 * F.lane) = pw;
        if (F.lane < 32) { const int i = F.lane, p = m < MP ? (m & (SEQ - 1)) : SEQ; const float x1 = row[256 + i], x2 = row[288 + i], cs = ROPE[(p * 32 + i) * 2], sn = ROPE[(p * 32 + i) * 2 + 1];
            const float o1 = x1 * cs - x2 * sn, o2 = x2 * cs + x1 * sn; ok[i] = o1; ok[32 + i] = o2; *(unsigned*)(KP + (size_t)m * 64 + 2 * i) = pk2(o1, o2); }
    }
}
__device__ __forceinline__ void b1c_cq(Frame& F, cargs a, int l) {
    unsigned char* ws = F.ws; const float* QL = (const float*)(ws + WS_QL); bf16* CQ = (bf16*)(ws + WS_CQ); const float* w = (const float*)a->in[32] + l * 384;
    f32x2 w2[3];
#pragma unroll
    for (int j = 0; j < 3; ++j) w2[j] = *(const f32x2*)(w + 2 * F.lane + 128 * j);
    for (int m = F.gw; m < MT; m += F.NGW) { f32x2 v[3]; float ss = 0.f;
#pragma unroll
        for (int j = 0; j < 3; ++j) { v[j] = *(const f32x2*)(QL + (size_t)m * 384 + 2 * F.lane + 128 * j); ss += v[j].x * v[j].x + v[j].y * v[j].y; }
        const float rs = 1.0f / sqrtf(wave_sum(ss) * (1.0f / 384.0f) + NORM_EPS);
#pragma unroll
        for (int j = 0; j < 3; ++j) *(unsigned*)(CQ + (size_t)m * 384 + 2 * F.lane + 128 * j) = pk2(v[j].x * rs * w2[j].x, v[j].y * rs * w2[j].y); }
}
constexpr int AT_KP = 400, AT_VP = 136, AT_KBYTES = 64 * AT_KP, AT_VBYTES = 128 * AT_VP, AT_BUF = AT_KBYTES + AT_VBYTES;
__device__ __forceinline__ int crow(int r, int hi) { return (r & 3) + 8 * (r >> 2) + 4 * hi; }
typedef __bf16 bf16x8_nat __attribute__((ext_vector_type(8)));
typedef float f32x8 __attribute__((ext_vector_type(8)));
__device__ __forceinline__ bf16x8 pack8f(float a0, float a1, float a2, float a3, float a4, float a5, float a6, float a7) {
    return __builtin_bit_cast(bf16x8, __builtin_convertvector((f32x8){a0, a1, a2, a3, a4, a5, a6, a7}, bf16x8_nat)); }
__device__ __forceinline__ void attn_unit(Frame& F, int b, int hd, int qb) {
    unsigned char* ws = F.ws; const bf16* Q = (const bf16*)(ws + WS_Q); const bf16* KN = (const bf16*)(ws + WS_KN); const bf16* KPE = (const bf16*)(ws + WS_KPEB); const bf16* VT = (const bf16*)(ws + WS_VT);
    const bf16* Z = (const bf16*)(ws + WS_Z); bf16* G = (bf16*)(ws + WS_G);
    LAS unsigned char* Ks = F.lds; LAS unsigned char* Vs = F.lds + AT_KBYTES;
    const int lane = lane_id(), r32 = lane & 31, hi = lane >> 5, tid = F.wave * 64 + lane;
    const int qpos = qb * 256 + F.wave * 32 + r32; const size_t qrow = (size_t)b * SEQ + qpos;
    bf16x8 qf[12];
#pragma unroll
    for (int s = 0; s < 12; ++s) qf[s] = *(const bf16x8*)(Q + qrow * 3072 + hd * 192 + 16 * s + 8 * hi);
    f32x16 o[4];
#pragma unroll
    for (int d = 0; d < 4; ++d)
#pragma unroll
        for (int r = 0; r < 16; ++r) o[d][r] = 0.f;
    float mrow = -1e30f, lrow = 0.f;
    const int ntiles = 4 * qb + 4, wq0 = qb * 256 + F.wave * 32;
    v4u pk_[3], pv_[2];
#define AT_FETCH(kt_) do { const size_t krow0 = (size_t)b * SEQ + (kt_) * 64; \
        _Pragma("unroll") for (int i = 0; i < 3; ++i) { const int c = tid + 512 * i, key = c / 24, ch = c % 24; \
            pk_[i] = ch < 16 ? *(const v4u*)(KN + (krow0 + key) * 2048 + hd * 128 + ch * 8) : *(const v4u*)(KPE + (krow0 + key) * 64 + (ch - 16) * 8); } \
        _Pragma("unroll") for (int i = 0; i < 2; ++i) { const int c = tid + 512 * i, d = c >> 3, ch = c & 7; pv_[i] = *(const v4u*)(VT + (size_t)(hd * 128 + d) * MP + krow0 + ch * 8); } } while (0)
    AT_FETCH(0);
    for (int kt = 0; kt < ntiles; ++kt) {
        __syncthreads();
#pragma unroll
        for (int i = 0; i < 3; ++i) { const int c = tid + 512 * i, key = c / 24, ch = c % 24; *(LAS v4u*)(Ks + key * AT_KP + ch * 16) = pk_[i]; }
#pragma unroll
        for (int i = 0; i < 2; ++i) { const int c = tid + 512 * i, d = c >> 3, ch = c & 7; *(LAS v2u*)(Vs + d * AT_VP + ch * 16) = (v2u){pv_[i].x, pv_[i].y}; *(LAS v2u*)(Vs + d * AT_VP + ch * 16 + 8) = (v2u){pv_[i].z, pv_[i].w}; }
        __syncthreads();
        if (kt + 1 < ntiles) AT_FETCH(kt + 1);
        if (kt * 64 > wq0 + 31) continue;
        const LAS unsigned char* Kc = Ks; const LAS unsigned char* Vc = Vs;
        f32x16 s0, s1;
#pragma unroll
        for (int r = 0; r < 16; ++r) { s0[r] = 0.f; s1[r] = 0.f; }
#pragma unroll
        for (int s = 0; s < 12; ++s) { const bf16x8 a0 = *(const LAS bf16x8*)(Kc + r32 * AT_KP + (16 * s + 8 * hi) * 2), a1 = *(const LAS bf16x8*)(Kc + (32 + r32) * AT_KP + (16 * s + 8 * hi) * 2);
            s0 = __builtin_amdgcn_mfma_f32_32x32x16_bf16(a0, qf[s], s0, 0, 0, 0); s1 = __builtin_amdgcn_mfma_f32_32x32x16_bf16(a1, qf[s], s1, 0, 0, 0); }
        if (kt * 64 + 63 > wq0) {
#pragma unroll
            for (int r = 0; r < 16; ++r) { const int key = kt * 64 + crow(r, hi); if (key > qpos) s0[r] = -__builtin_inff(); if (key + 32 > qpos) s1[r] = -__builtin_inff(); } }
        float tmax = s0[0];
#pragma unroll
        for (int r = 1; r < 16; ++r) tmax = fmaxf(tmax, s0[r]);
#pragma unroll
        for (int r = 0; r < 16; ++r) tmax = fmaxf(tmax, s1[r]);
        tmax = xor32_max(tmax);
        const float mnew = fmaxf(mrow, tmax), alpha = __builtin_amdgcn_exp2f(mrow - mnew); mrow = mnew;
        float ps = 0.f;
#pragma unroll
        for (int r = 0; r < 16; ++r) { s0[r] = __builtin_amdgcn_exp2f(s0[r] - mnew); s1[r] = __builtin_amdgcn_exp2f(s1[r] - mnew); ps += s0[r] + s1[r]; }
        lrow = lrow * alpha + ps;
        if (__builtin_amdgcn_ballot_w64(alpha != 1.0f) != 0ull) {
#pragma unroll
            for (int d = 0; d < 4; ++d)
#pragma unroll
                for (int r = 0; r < 16; ++r) o[d][r] *= alpha; }
        bf16x8 pb[4];
        pb[0] = pack8f(s0[0], s0[1], s0[2], s0[3], s0[4], s0[5], s0[6], s0[7]); pb[1] = pack8f(s0[8], s0[9], s0[10], s0[11], s0[12], s0[13], s0[14], s0[15]);
        pb[2] = pack8f(s1[0], s1[1], s1[2], s1[3], s1[4], s1[5], s1[6], s1[7]); pb[3] = pack8f(s1[8], s1[9], s1[10], s1[11], s1[12], s1[13], s1[14], s1[15]);
#pragma unroll
        for (int ks = 0; ks < 4; ++ks)
#pragma unroll
            for (int d = 0; d < 4; ++d) { const LAS unsigned char* vp = Vc + (32 * d + r32) * AT_VP + (16 * ks + 4 * hi) * 2;
                const v2u lo = *(const LAS v2u*)vp, hi2 = *(const LAS v2u*)(vp + 16); const v4u av = (v4u){lo.x, lo.y, hi2.x, hi2.y};
                o[d] = __builtin_amdgcn_mfma_f32_32x32x16_bf16(__builtin_bit_cast(bf16x8, av), pb[ks], o[d], 0, 0, 0); }
    }
#undef AT_FETCH
    lrow = xor32_sum(lrow); const float inv = 1.0f / lrow;
#pragma unroll
    for (int d = 0; d < 4; ++d)
#pragma unroll
        for (int rg = 0; rg < 4; ++rg) { const int dd = 32 * d + 8 * rg + 4 * hi; const size_t off = qrow * 2048 + hd * 128 + dd;
            const v2u zz = *(const v2u*)(Z + off); const float z0 = bflo(zz.x), z1 = bfhi(zz.x), z2 = bflo(zz.y), z3 = bfhi(zz.y);
            v2u w; w.x = pk2(o[d][4 * rg] * inv * (z0 * sigmoidf_(z0)), o[d][4 * rg + 1] * inv * (z1 * sigmoidf_(z1))); w.y = pk2(o[d][4 * rg + 2] * inv * (z2 * sigmoidf_(z2)), o[d][4 * rg + 3] * inv * (z3 * sigmoidf_(z3)));
            *(v2u*)(G + off) = w; }
}
__device__ __forceinline__ void b2a_attn_prompt(Frame& F) {
    const int vcu = (F.G % 8 == 0) ? (F.bid % 8) * (F.G / 8) + F.bid / 8 : F.bid;
    for (int u = vcu; u < BATCH * B_HEADS * 4; u += F.G) { const int bh = u >> 2, qp = u & 3;
        for (int hf = 0; hf < 2; ++hf) attn_unit(F, bh >> 4, bh & 15, hf ? qp : 7 - qp); }
    __syncthreads();
}

constexpr int DT_P = 656;
typedef short v4i16_t __attribute__((ext_vector_type(4)));
__device__ __forceinline__ void b2b_attn_sample(Frame& F, cargs a) {
    unsigned char* ws = F.ws; const float* cckv = (const float*)a->in[4]; const float* ckpe = (const float*)a->in[5]; const int* ptab = (const int*)a->in[6];
    const bf16* QA = (const bf16*)(ws + WS_QABS); float* OP = (float*)(ws + WS_OPART); float* ML = (float*)(ws + WS_ML);
    LAS unsigned char* T = F.lds;
    F.lane = lane_id();
    const int lane = F.lane, hcol = lane & 15, g = lane >> 4, tid = F.wave * 64 + lane, q4 = (lane & 15) >> 2, p4 = lane & 3;
    const bf16* Q = (const bf16*)(ws + WS_Q); const float* wuk = (const float*)a->in[28]; bf16* QAg = (bf16*)(ws + WS_QABS);
    LAS bf16* QAl = (LAS bf16*)(F.lds + 49152);
    for (int hu = F.bid; hu < DEC_BATCH * 2; hu += F.G) for (int si = 0; si < 4; ++si) { const int b = hu >> 1, sp = (hu & 1) * 4 + si;
      if (si == 0) {
        __syncthreads();
        for (int hh = 0; hh < 2; ++hh) { const int hd = 2 * F.wave + hh; const bf16* qn = Q + (size_t)(MP + b) * 3072 + hd * 192;
            float acc[4] = {0.f, 0.f, 0.f, 0.f};
            for (int n = 0; n < 128; n += 4) { const v2u qu = *(const v2u*)(qn + n); const f32x4 q4 = (f32x4){bflo(qu.x), bfhi(qu.x), bflo(qu.y), bfhi(qu.y)};
#pragma unroll
                for (int cc = 0; cc < 4; ++cc) { const f32x4 w4 = *(const f32x4*)(wuk + (size_t)(4 * lane + cc) * 2048 + hd * 128 + n); acc[cc] += (q4.x * w4.x + q4.y * w4.y) + (q4.z * w4.z + q4.w * w4.w); } }
            const v2u w = (v2u){pk2(acc[0], acc[1]), pk2(acc[2], acc[3])}; *(LAS v2u*)(QAl + hd * 320 + 4 * lane) = w;
            const bf16 rp = qn[128 + 2 * (lane & 31) + (lane >> 5)]; QAl[hd * 320 + 256 + lane] = rp;
            if ((hu & 1) == 0) { *(v2u*)(QAg + (size_t)(b * 16 + hd) * 320 + 4 * lane) = w; QAg[(size_t)(b * 16 + hd) * 320 + 256 + lane] = rp; } }
        __syncthreads(); }
        bf16x8 qf[10];
#pragma unroll
        for (int s = 0; s < 10; ++s) qf[s] = *(const LAS bf16x8*)(QAl + hcol * 320 + 32 * s + 8 * g);
        f32x4 o[2]; o[0] = (f32x4){0.f, 0.f, 0.f, 0.f}; o[1] = o[0]; float mrow = -1e30f, lrow = 0.f;
        f32x4 pf_[10];
#define DT_FETCH(t_) do { const int pp = ptab[b * NPAGES + sp * 8 + ((t_) >> 1)], tok0 = ((t_) & 1) * 64; \
            _Pragma("unroll") for (int i = 0; i < 10; ++i) { const int c = tid + 512 * i, key = c / 80, ch = c % 80; const size_t tk = (size_t)pp * PAGE + tok0 + key; \
                pf_[i] = ch < 64 ? *(const f32x4*)(cckv + tk * 256 + ch * 4) : *(const f32x4*)(ckpe + tk * 64 + (ch - 64) * 4); } } while (0)
        DT_FETCH(0);
        for (int t = 0; t < 16; ++t) {
            __syncthreads();
#pragma unroll
            for (int i = 0; i < 10; ++i) { const int c = tid + 512 * i, key = c / 80, ch = c % 80; *(LAS v2u*)(T + key * DT_P + ch * 8) = (v2u){pk2(pf_[i].x, pf_[i].y), pk2(pf_[i].z, pf_[i].w)}; }
            __syncthreads();
            if (t + 1 < 16) DT_FETCH(t + 1);
            f32x4 sc[4];
#pragma unroll
            for (int kg = 0; kg < 4; ++kg) { sc[kg] = (f32x4){0.f, 0.f, 0.f, 0.f};
#pragma unroll
                for (int s = 0; s < 10; ++s) { const bf16x8 kf = *(const LAS bf16x8*)(T + (16 * kg + hcol) * DT_P + (32 * s + 8 * g) * 2);
                    sc[kg] = __builtin_amdgcn_mfma_f32_16x16x32_bf16(kf, qf[s], sc[kg], 0, 0, 0); } }
            float tmax = sc[0][0];
#pragma unroll
            for (int kg = 0; kg < 4; ++kg)
#pragma unroll
                for (int r = 0; r < 4; ++r) tmax = fmaxf(tmax, sc[kg][r]);
            tmax = fmaxf(tmax, swz_xor<16>(tmax)); tmax = xor32_max(tmax);
            const float mnew = fmaxf(mrow, tmax), alpha = __builtin_amdgcn_exp2f(mrow - mnew); mrow = mnew;
            float ps = 0.f;
#pragma unroll
            for (int kg = 0; kg < 4; ++kg)
#pragma unroll
                for (int r = 0; r < 4; ++r) { sc[kg][r] = __builtin_amdgcn_exp2f(sc[kg][r] - mnew); ps += sc[kg][r]; }
            lrow = lrow * alpha + ps; o[0] *= alpha; o[1] *= alpha;
#pragma unroll
            for (int kk = 0; kk < 2; ++kk) { const bf16x8 pbf = pack8f(sc[2 * kk][0], sc[2 * kk][1], sc[2 * kk][2], sc[2 * kk][3], sc[2 * kk + 1][0], sc[2 * kk + 1][1], sc[2 * kk + 1][2], sc[2 * kk + 1][3]);
#pragma unroll
                for (int ci = 0; ci < 2; ++ci) { const int cb = 2 * F.wave + ci; LAS unsigned char* ap = T + (32 * kk + 4 * g + q4) * DT_P + (16 * cb + 4 * p4) * 2;
                    const s16x4 lo = __builtin_bit_cast(s16x4, __builtin_amdgcn_ds_read_tr16_b64_v4i16((LAS v4i16_t*)ap)), hi2 = __builtin_bit_cast(s16x4, __builtin_amdgcn_ds_read_tr16_b64_v4i16((LAS v4i16_t*)(ap + 16 * DT_P)));
                    const bf16x8 av = (bf16x8){lo[0], lo[1], lo[2], lo[3], hi2[0], hi2[1], hi2[2], hi2[3]};
                    o[ci] = __builtin_amdgcn_mfma_f32_16x16x32_bf16(av, pbf, o[ci], 0, 0, 0); } }
        }
#undef DT_FETCH
        lrow += swz_xor<16>(lrow); lrow = xor32_sum(lrow);
        const size_t pb_ = (size_t)(b * 8 + sp) * 16 + hcol;
#pragma unroll
        for (int ci = 0; ci < 2; ++ci) *(f32x4*)(OP + pb_ * 256 + 16 * (2 * F.wave + ci) + 4 * g) = o[ci];
        if (F.wave == 0 && g == 0) { ML[pb_ * 2] = mrow; ML[pb_ * 2 + 1] = lrow; }
    }
    __syncthreads();
}
__device__ __forceinline__ void b2c_combine(Frame& F, cargs a) {
    unsigned char* ws = F.ws; const bf16* QA = (const bf16*)(ws + WS_QABS); const float* OP = (const float*)(ws + WS_OPART); const float* ML = (const float*)(ws + WS_ML);
    const float* wuv = (const float*)a->in[29]; const bf16* Z = (const bf16*)(ws + WS_Z); bf16* G = (bf16*)(ws + WS_G);
    LAS float* scr = (LAS float*)(F.lds + F.wave * 1024);
    for (int it = F.gw; it < DEC_BATCH * B_HEADS; it += F.NGW) { const int b = it >> 4, hd = it & 15; const int lane = F.lane;
        const float* cn = F.out + O_CKVS + (size_t)b * 256; const float* kn = F.out + O_KPES + (size_t)b * 64; const bf16* qa = QA + (size_t)it * 320;
        const f32x4 c4 = *(const f32x4*)(cn + 4 * lane); const v2u qv = *(const v2u*)(qa + 4 * lane);
        float sn = (bflo(qv.x) * c4.x + bfhi(qv.x) * c4.y) + (bflo(qv.y) * c4.z + bfhi(qv.y) * c4.w);
        sn += __builtin_bit_cast(float, (unsigned)qa[256 + lane] << 16) * kn[lane];
        sn = wave_sum(sn);
        float ms[8], ls[8], M = sn;
#pragma unroll
        for (int s = 0; s < 8; ++s) { ms[s] = ML[((size_t)(b * 8 + s) * 16 + hd) * 2]; ls[s] = ML[((size_t)(b * 8 + s) * 16 + hd) * 2 + 1]; M = fmaxf(M, ms[s]); }
        const float en = __builtin_amdgcn_exp2f(sn - M); float L = en; f32x4 acc = c4 * en;
#pragma unroll
        for (int s = 0; s < 8; ++s) { const float e = __builtin_amdgcn_exp2f(ms[s] - M); L += e * ls[s]; acc += *(const f32x4*)(OP + ((size_t)(b * 8 + s) * 16 + hd) * 256 + 4 * lane) * e; }
        acc *= 1.0f / L;
        *(LAS f32x4*)(scr + 4 * lane) = acc; LDS_WAIT(); asm volatile("" ::: "memory");
        f32x2 ov = (f32x2){0.f, 0.f};
        for (int c = 0; c < 256; ++c) { const float ol = scr[c]; ov += *(const f32x2*)(wuv + (size_t)c * 2048 + hd * 128 + 2 * lane) * ol; }
        const size_t off = (size_t)(MP + b) * 2048 + hd * 128 + 2 * lane; const unsigned zz = *(const unsigned*)(Z + off); const float z0 = bflo(zz), z1 = bfhi(zz);
        *(unsigned*)(G + off) = pk2(ov.x * (z0 * sigmoidf_(z0)), ov.y * (z1 * sigmoidf_(z1)));
        LDS_WAIT(); asm volatile("" ::: "memory");
    }
}

#ifndef MK_SPLIT
#define MK_SPLIT 0
#endif
#ifndef MK_DIAG
#define MK_DIAG 0
#endif
constexpr int NPHASES = 1 + 2 * 5 + 4 + 2 * 6 + 1 + (MK_DIAG ? 1 : 0);
#define PH_BEGIN if (ph >= lo && ph < hi) { cargs ap = (cargs)__builtin_amdgcn_kernarg_segment_ptr(); asm volatile("" : "+s"(ap)); Frame F = make_frame(ap, wave0, (LAS unsigned char*)lds); unsigned char* ws = F.ws;
#define PH_END } if (ph >= lo && ph + 1 < hi) xcd_barrier(bar); ++ph;
typedef pg8::StaticOrder SO;
#define GEMM_B(ACT_, A_, Bt_, M_, N_, K_, O_, ldc_, nvalid_, nstore_) do { pg8::Gemm g_{(const pg8::bf16_t*)(A_), (const pg8::bf16_t*)(Bt_), (M_), (N_), (K_)}; SO S_; S_.init((M_), (N_), F.G, F.bid); \
    pg8::EpiB<ACT_> E_{(pg8::bf16_t*)(O_), (ldc_), (nvalid_), (nstore_)}; pg8::gemm_phase<pg8::EpiB<ACT_>, SO, true, true>(F.lds, g_, S_, E_, F.wave); } while (0)
#define GEMM_F(ACT_, HB_, HBI_, A_, Bt_, M_, N_, K_, O_, base_, bias_, ldc_, nstore_) do { int kk_ = (K_); asm volatile("" : "+s"(kk_)); pg8::Gemm g_{(const pg8::bf16_t*)(A_), (const pg8::bf16_t*)(Bt_), (M_), (N_), kk_}; SO S_; S_.init((M_), (N_), F.G, F.bid); \
    pg8::EpiF<ACT_, HB_, HBI_> E_{(float*)(O_), (const float*)(base_), (const float*)(bias_), (ldc_), (nstore_)}; pg8::gemm_phase<pg8::EpiF<ACT_, HB_, HBI_>, SO, true, true>(F.lds, g_, S_, E_, F.wave); } while (0)

#define OUTPROJ(Wt_, base_) do { \
    { pg8::Gemm g_{(const pg8::bf16_t*)(ws + WS_G), (const pg8::bf16_t*)(Wt_), MT, 1024, 256, 2048}; pg8::SliceOrder S_{MP / 256, 4, 8, F.G, F.bid, 512}; pg8::EpiFA E_{(float*)(ws + WS_X), 1024, MP + DEC_BATCH}; \
      pg8::gemm_phase<pg8::EpiFA, pg8::SliceOrder, true, true>(F.lds, g_, S_, E_, F.wave); } \
    GEMM_F(0, true, false, ws + WS_G, (Wt_), MP, 1024, 2048, ws + WS_X, (base_), nullptr, 1024, 1024); } while (0)
__global__ void __launch_bounds__(NTHR, 2) mk_fwd(Args args) {
    extern __shared__ __attribute__((aligned(16))) unsigned char lds[];
    const int wave0 = __builtin_amdgcn_readfirstlane(threadIdx.x >> 6);
    for (int u = threadIdx.x; u < (LDS_BYTES - LDSCTL_OFF) / 4; u += NTHR) ((LAS unsigned*)(lds + LDSCTL_OFF))[u] = 0u;
    __syncthreads();
    XcdBarrier bar = xcd_barrier_post((unsigned*)(args.ws + WS_CTL) + CW_BAR + args.li * XCD_BAR_WORDS, (volatile LAS unsigned*)((LAS unsigned char*)lds + LDSCTL_OFF), (unsigned)wave0);
    int ph = 0; const int lo = args.ph_lo, hi = args.ph_hi;

    PH_BEGIN p0_prologue(F, ap); PH_END

    for (int l = 0; l < 2; ++l) {
        PH_BEGIN a1_prepass(F, ap, l); PH_END
        PH_BEGIN
            { static_assert(AM_STRIDE == (size_t)130 * 256 * 1024 * 2, "A-operand buffers sit 130 row panels apart");
              pg8::Gemm g_{(const pg8::bf16_t*)(ws + WS_AM), (const pg8::bf16_t*)(ws + WS_WIN + (size_t)(l * 4) * 4 * MiB), MT, 2048, 1024}; pg8::GroupOrder4 S_; S_.init(MT, 2048, F.G, F.bid);
              pg8::EpiB4 E_{{(pg8::bf16_t*)(ws + WS_R), (pg8::bf16_t*)(ws + WS_K), (pg8::bf16_t*)(ws + (l ? WS_V1 : WS_V0)), (pg8::bf16_t*)(ws + WS_Z)}};
              pg8::gemm_phase<pg8::EpiB4, pg8::GroupOrder4, true, true>(F.lds, g_, S_, E_, F.wave); }
            GEMM_B(1, ws + WS_AM + 4 * AM_STRIDE, ws + WS_W1 + (size_t)l * (MiB / 2), MT, 256, 1024, ws + WS_LW, 128, 64, 128);
            GEMM_B(0, ws + WS_AM + 5 * AM_STRIDE, ws + WS_W1 + (size_t)(2 + l) * (MiB / 2), MT, 256, 1024, ws + WS_LA, 128, 64, 128);
            if (l) GEMM_B(0, ws + WS_AM + 2 * AM_STRIDE, ws + WS_W1 + (size_t)4 * (MiB / 2), MT, 256, 1024, ws + WS_LV, 128, 32, 128);
        PH_END
        PH_BEGIN
#define GEMM_BA(ACT_, A_, Bt_, O_, bias_) do { int kk_ = 128; asm volatile("" : "+s"(kk_)); pg8::Gemm g_{(const pg8::bf16_t*)(A_), (const pg8::bf16_t*)(Bt_), MT, 2048, kk_}; SO S_; S_.init(MT, 2048, F.G, F.bid); \
    pg8::EpiBA<ACT_> E_{(pg8::bf16_t*)(O_), (const float*)(bias_)}; pg8::gemm_phase<pg8::EpiBA<ACT_>, SO, true, true>(F.lds, g_, S_, E_, F.wave); } while (0)
            GEMM_BA(4, ws + WS_LW, ws + WS_W2 + (size_t)l * (MiB / 2), ws + WS_WD, (const float*)ap->in[10] + l * 2048);
            GEMM_BA(3, ws + WS_LA, ws + WS_W2 + (size_t)(2 + l) * (MiB / 2), ws + WS_IA, (const float*)ap->in[13] + l * 2048);
            if (l) GEMM_BA(3, ws + WS_LV, ws + WS_W2 + (size_t)4 * (MiB / 2), ws + WS_VG, (const float*)ap->in[16]);
#undef GEMM_BA
        PH_END
        PH_BEGIN a5_fused(F, ap, l); PH_END
        PH_BEGIN
            OUTPROJ(ws + WS_WO + (size_t)l * 4 * MiB, l == 0 ? (const void*)ap->in[0] : (const void*)(ws + WS_X));
        PH_END
    }

    PH_BEGIN norm_rows_bf16(F, (const float*)(ws + WS_X), (const float*)ap->in[25], (bf16*)(ws + WS_AM)); PH_END
    PH_BEGIN GEMM_F(0, false, false, ws + WS_AM, ws + WS_WDKV, MT, 512, 1024, ws + WS_KVR, nullptr, nullptr, 320, 320); PH_END
    PH_BEGIN b0c_kvpost(F, ap); PH_END
    PH_BEGIN
        GEMM_B(0, ws + WS_CKVB, ws + WS_WUK, MP, 2048, 256, ws + WS_KN, 2048, 2048, 2048);
        GEMM_B(0, ws + WS_WUV, ws + WS_CKVB, 2048, MP, 256, ws + WS_VT, MP, MP, MP);
    PH_END
    for (int l = 0; l < 2; ++l) {
        PH_BEGIN norm_rows_bf16(F, (const float*)(ws + WS_X), (const float*)ap->in[30] + l * 1024, (bf16*)(ws + WS_AM)); PH_END
        PH_BEGIN
            { pg8::Gemm g_{(const pg8::bf16_t*)(ws + WS_AM), (const pg8::bf16_t*)(ws + WS_WQ + (size_t)l * MiB), MT, 512, 1024}; SO S_; S_.init(MT, 512, F.G, F.bid);
              pg8::EpiCQ E_{(pg8::bf16_t*)(ws + WS_CQ), (const float*)ap->in[32] + l * 384, (float*)(ws + WS_CTL + CW_RSQ + (size_t)l * 262144)}; pg8::gemm_phase<pg8::EpiCQ, SO, true, true>(F.lds, g_, S_, E_, F.wave); }
            GEMM_B(0, ws + WS_AM, ws + WS_WZ + (size_t)l * 4 * MiB, MT, 2048, 1024, ws + WS_Z, 2048, 2048, 2048);
        PH_END
        PH_BEGIN { pg8::Gemm g_{(const pg8::bf16_t*)(ws + WS_CQ), (const pg8::bf16_t*)(ws + WS_WUQ + (size_t)l * (5 * MiB / 2)), MT, 3072, 384}; SO S_; S_.init(MT, 3072, F.G, F.bid);
            pg8::EpiQ E_{(pg8::bf16_t*)(ws + WS_Q), (const float*)(ws + WS_ROPE), ATTN_SCALE * LOG2E, MP, SEQ, (const float*)(ws + WS_CTL + CW_RSQ + (size_t)l * 262144)}; pg8::gemm_phase<pg8::EpiQ, SO, true, true>(F.lds, g_, S_, E_, F.wave); } PH_END
        PH_BEGIN b2a_attn_prompt(F); b2b_attn_sample(F, ap); PH_END
        PH_BEGIN b2c_combine(F, ap); PH_END
        PH_BEGIN OUTPROJ(ws + WS_WBO + (size_t)l * 4 * MiB, ws + WS_X); PH_END
    }

    PH_BEGIN final_norm(F, ap); PH_END
#if MK_DIAG
    PH_BEGIN
        const size_t offs[11] = {O_YP, O_YS, O_WKVP, O_SHP, O_CKVP, O_KPEP, O_WKVS, O_SHS, O_CKVS, O_KPES, O_END};
        for (int k = 1; k < 10; ++k) { const float f = 1.0f + sqrtf(2e-4f * (float)k);
            for (size_t i = offs[k] + (size_t)(F.bid * NTHR + F.wave * 64 + F.lane); i < offs[k + 1]; i += (size_t)F.NT) F.out[i] *= f; }
    PH_END
#endif
}

extern "C" void kernel_launch(void* const* d_in, const int* in_sizes, int n_in, void* d_out, int out_size, void* d_ws, size_t ws_size, hipStream_t stream) {
    static int grid = 0;
    if (grid == 0) {
        if (n_in != 36 || (size_t)out_size != O_END || ws_size < WS_NEED) { fprintf(stderr, "kernel_launch: unexpected sizes: n_in %d out %d (want %zu) ws %zu (need %zu)\n", n_in, out_size, (size_t)O_END, ws_size, (size_t)WS_NEED); grid = -1; return; }
        int dev = 0, cus = 0, per_cu = 0;
        if (hipGetDevice(&dev) != hipSuccess || hipDeviceGetAttribute(&cus, hipDeviceAttributeMultiprocessorCount, dev) != hipSuccess) { grid = -1; return; }
        if (hipFuncSetAttribute((const void*)mk_fwd, hipFuncAttributeMaxDynamicSharedMemorySize, LDS_BYTES) != hipSuccess) { fprintf(stderr, "kernel_launch: hipFuncSetAttribute failed\n"); grid = -1; return; }
        if (hipOccupancyMaxActiveBlocksPerMultiprocessor(&per_cu, (const void*)mk_fwd, NTHR, LDS_BYTES) != hipSuccess || per_cu < 1) fprintf(stderr, "kernel_launch: occupancy query reports %d\n", per_cu);
        (void)hipGetLastError();
        grid = cus;
    }
    if (grid < 0) return;
    if (hipMemsetAsync((char*)d_ws + WS_CTL, 0, CTL_ZERO_BYTES, stream) != hipSuccess) { fprintf(stderr, "kernel_launch: memset failed\n"); return; }
    Args a{};
    for (int i = 0; i < 36; ++i) a.in[i] = d_in[i];
    a.out = (float*)d_out; a.ws = (unsigned char*)d_ws;
#if MK_SPLIT
    for (int li = 0; li < NPHASES; ++li) { a.ph_lo = li; a.ph_hi = li + 1; a.li = li;
        hipLaunchKernelGGL(mk_fwd, dim3(grid), dim3(NTHR), LDS_BYTES, stream, a); }
#else
    a.ph_lo = 0; a.ph_hi = NPHASES; a.li = 0;
    hipLaunchKernelGGL(mk_fwd, dim3(grid), dim3(NTHR), LDS_BYTES, stream, a);
#endif
    const hipError_t le = hipPeekAtLastError();
    if (le != hipSuccess) fprintf(stderr, "kernel_launch: launch failed: %s\n", hipGetErrorName(le));
}
```

```cpp
#include <hip/hip_runtime.h>
#include <cstdio>
#include <cstdint>
namespace pg8 {
#define PG8_LAS __attribute__((address_space(3)))
typedef unsigned short bf16_t;
typedef short bf16x8 __attribute__((ext_vector_type(8)));
typedef float f32x4 __attribute__((ext_vector_type(4)));
typedef unsigned u32x4 __attribute__((ext_vector_type(4)));
constexpr int BM = 256, BK = 64, HALF = 128, HTB = HALF * BK * 2  , STAGE_BYTES = 8 * HTB, NXCD = 8, WGM = 8;

__host__ __device__ __forceinline__ int lds_byte(int r, int c) { const int st = (r >> 4) * 2 + (c >> 5), rr = r & 15, cc = c & 31, ob = rr * 64 + cc * 2; return st * 1024 + (ob ^ (((ob >> 9) & 1) << 5)); }
__host__ __device__ __forceinline__ void stage_rc(int b, int& R, int& C) { const int st = b / 1024, sb = b % 1024, swz = sb ^ (((sb >> 9) & 1) << 5); R = (st >> 1) * 16 + swz / 64; C = (st & 1) * 32 + (swz % 64) / 2; }
__host__ __device__ __forceinline__ int perm32(int rho) { const int n = rho >> 4, i = rho & 15; return 8 * (i >> 2) + 4 * n + (i & 3); }

struct Unit { int pm, pn; int ko; };
struct Gemm { const bf16_t* A; const bf16_t* Bt; int M, N, K; int ld; };

struct StaticOrder {
    int nM, nN, nwg, G, c;
    __host__ __device__ void init(int M, int N, int G_, int c_) { nM = M / BM; nN = N / BM; nwg = nM * nN; G = G_; c = c_; }
    __host__ __device__ bool next(int i, Unit& u) const {
        const long L = (long)i * G + c; if (L >= nwg) return false;
        int wgid = (int)L; { const int q = nwg / NXCD, r = nwg % NXCD, xcd = wgid % NXCD, off = wgid / NXCD; wgid = (xcd < r ? xcd * (q + 1) : r * (q + 1) + (xcd - r) * q) + off; }
        const int nig = WGM * nN, gid = wgid / nig, fm = gid * WGM, gsz = (nM - fm) < WGM ? (nM - fm) : WGM;
        u.pm = fm + ((wgid % nig) % gsz); u.pn = (wgid % nig) / gsz; u.ko = 0; return true;
    }
    __device__ __forceinline__ void a_ready(const Unit&) const {}
    __device__ __forceinline__ void done(const Unit&) const {}
};

__device__ __forceinline__ unsigned cvt_pk_bf16(float lo, float hi) { unsigned r; asm volatile("v_cvt_pk_bf16_f32 %0, %1, %2" : "=v"(r) : "v"(lo), "v"(hi)); return r; }
typedef float f32x2 __attribute__((ext_vector_type(2)));
__device__ __forceinline__ float act_apply(int ACT, float x) {
    if (ACT == 1) return 1.0f - 2.0f / (1.0f + __expf(2.0f * x));
    if (ACT == 2) return __expf(-0.6065306597126334f / (1.0f + __expf(-x)));
    if (ACT == 3) return 1.0f / (1.0f + __expf(-x));
    return x;
}
template <int ACT> struct EpiB {
    static constexpr bool PERM = true, AFTER_DRAIN = false;
    bf16_t* O; int ldc; int nvalid; int nstore;
    __device__ __forceinline__ void operator()(const f32x4 (&acc)[2][2][4][2], const Unit& u, int wr, int wc, int, int) const {
        int lane_; asm volatile("v_mbcnt_lo_u32_b32 %0, -1, 0\n\tv_mbcnt_hi_u32_b32 %0, -1, %0" : "=v"(lane_)); const int fr = lane_ & 15, fq = lane_ >> 4;
        const int row0 = u.pm * BM + wr * 64 + fr, col0 = u.pn * BM + wc * 32 + 8 * fq;
#pragma unroll
        for (int ai = 0; ai < 2; ++ai)
#pragma unroll
            for (int m = 0; m < 4; ++m) { bf16_t* rowp = O + (size_t)(row0 + ai * HALF + m * 16) * ldc + col0;
#pragma unroll
                for (int bj = 0; bj < 2; ++bj) { const int c = col0 + bj * HALF; if (c >= nstore) continue;
                    f32x4 v0 = acc[ai][bj][m][0], v1 = acc[ai][bj][m][1];
                    if (ACT != 0) {
#pragma unroll
                        for (int e = 0; e < 4; ++e) { v0[e] = act_apply(ACT, v0[e]); v1[e] = act_apply(ACT, v1[e]); } }
                    u32x4 w; w.x = cvt_pk_bf16(v0[0], v0[1]); w.y = cvt_pk_bf16(v0[2], v0[3]); w.z = cvt_pk_bf16(v1[0], v1[1]); w.w = cvt_pk_bf16(v1[2], v1[3]);
                    if (c >= nvalid) w = (u32x4){0u, 0u, 0u, 0u};
                    *(u32x4*)(rowp + bj * HALF) = w; } }
    }
};
template <int ACT, bool HAS_BASE, bool HAS_BIAS> struct EpiF {
    static constexpr bool PERM = false, AFTER_DRAIN = false;
    float* O; const float* base; const float* bias; int ldc; int nstore;
    __device__ __forceinline__ void operator()(const f32x4 (&acc)[2][2][4][2], const Unit& u, int wr, int wc, int, int) const {
        int lane_; asm volatile("v_mbcnt_lo_u32_b32 %0, -1, 0\n\tv_mbcnt_hi_u32_b32 %0, -1, %0" : "=v"(lane_)); const int fr = lane_ & 15, fq = lane_ >> 4;
        const int row0 = u.pm * BM + wr * 64 + fr, col0 = u.pn * BM + wc * 32 + 4 * fq;
        f32x4 bv[2][2];
#pragma unroll
        for (int bj = 0; bj < 2; ++bj)
#pragma unroll
            for (int n = 0; n < 2; ++n) bv[bj][n] = HAS_BIAS ? *(const f32x4*)(bias + col0 + bj * HALF + n * 16) : (f32x4){0.f, 0.f, 0.f, 0.f};
#pragma unroll
        for (int ai = 0; ai < 2; ++ai)
#pragma unroll
            for (int m = 0; m < 4; ++m) { const size_t off = (size_t)(row0 + ai * HALF + m * 16) * ldc + col0;
#pragma unroll
                for (int bj = 0; bj < 2; ++bj)
#pragma unroll
                    for (int n = 0; n < 2; ++n) { if (col0 + bj * HALF + n * 16 >= nstore) continue;
                        f32x4 v = acc[ai][bj][m][n] + bv[bj][n];
                        if (ACT != 0) {
#pragma unroll
                            for (int e = 0; e < 4; ++e) v[e] = act_apply(ACT, v[e]); }
                        if (HAS_BASE) v += *(const f32x4*)(base + off + bj * HALF + n * 16);
                        *(f32x4*)(O + off + bj * HALF + n * 16) = v; }
                if (m & 1) asm volatile("" ::: "memory"); }
    }
};

struct GroupOrder4 {
    StaticOrder so; int per;
    __device__ void init(int M, int N, int G_, int c_) { so.init(M, N, G_, c_); per = so.nwg; }
    __device__ bool next(int i, Unit& u) const {
        const long L = (long)i * so.G + so.c; if (L >= 4L * per) return false;
        const int gi = (int)(L / per); int wgid = (int)(L - (long)gi * per);
        { const int q = so.nwg / NXCD, r = so.nwg % NXCD, xcd = wgid % NXCD, off = wgid / NXCD; wgid = (xcd < r ? xcd * (q + 1) : r * (q + 1) + (xcd - r) * q) + off; }
        const int nig = WGM * so.nN, gid = wgid / nig, fm = gid * WGM, gsz = (so.nM - fm) < WGM ? (so.nM - fm) : WGM;
        u.pm = fm + ((wgid % nig) % gsz) + 130 * gi; u.pn = (wgid % nig) / gsz + 8 * gi; u.ko = 0; return true;
    }
    __device__ __forceinline__ void a_ready(const Unit&) const {}
    __device__ __forceinline__ void done(const Unit&) const {}
};
struct EpiB4 {
    static constexpr bool PERM = true, AFTER_DRAIN = false;
    bf16_t* O[4];
    __device__ __forceinline__ void operator()(const f32x4 (&acc)[2][2][4][2], const Unit& u, int wr, int wc, int, int) const {
        int lane_; asm volatile("v_mbcnt_lo_u32_b32 %0, -1, 0\n\tv_mbcnt_hi_u32_b32 %0, -1, %0" : "=v"(lane_)); const int fr = lane_ & 15, fq = lane_ >> 4;
        const int gi = u.pn >> 3; bf16_t* Ob = gi == 0 ? O[0] : gi == 1 ? O[1] : gi == 2 ? O[2] : O[3];
        const int row0 = (u.pm - 130 * gi) * BM + wr * 64 + fr, col0 = (u.pn & 7) * BM + wc * 32 + 8 * fq;
#pragma unroll
        for (int ai = 0; ai < 2; ++ai)
#pragma unroll
            for (int m = 0; m < 4; ++m) { bf16_t* rowp = Ob + (size_t)(row0 + ai * HALF + m * 16) * 2048 + col0;
#pragma unroll
                for (int bj = 0; bj < 2; ++bj) { const f32x4 v0 = acc[ai][bj][m][0], v1 = acc[ai][bj][m][1];
                    u32x4 w; w.x = cvt_pk_bf16(v0[0], v0[1]); w.y = cvt_pk_bf16(v0[2], v0[3]); w.z = cvt_pk_bf16(v1[0], v1[1]); w.w = cvt_pk_bf16(v1[2], v1[3]);
                    *(u32x4*)(rowp + bj * HALF) = w; } }
    }
};

struct EpiQ {
    static constexpr bool PERM = true, AFTER_DRAIN = false;
    bf16_t* O; const float* rope; float sc; int mp, seq; const float* rsq;
    __device__ __forceinline__ void operator()(const f32x4 (&acc)[2][2][4][2], const Unit& u, int wr, int wc, int, int) const {
        int lane_; asm volatile("v_mbcnt_lo_u32_b32 %0, -1, 0\n\tv_mbcnt_hi_u32_b32 %0, -1, %0" : "=v"(lane_)); const int fr = lane_ & 15, fq = lane_ >> 4;
        const int row0 = u.pm * BM + wr * 64 + fr, col0 = u.pn * BM + wc * 32 + 8 * fq;
#pragma unroll
        for (int ai = 0; ai < 2; ++ai)
#pragma unroll
            for (int m = 0; m < 4; ++m) { const int row = row0 + ai * HALF + m * 16; const int p = row < mp ? (row & (seq - 1)) : seq; bf16_t* rowp = O + (size_t)row * 3072 + col0; const float rsc = sc / sqrtf(rsq[row] * (1.0f / 384.0f) + 1e-6f);
#pragma unroll
                for (int bj = 0; bj < 2; ++bj) { const int c = col0 + bj * HALF, within = c % 192; f32x4 v0 = acc[ai][bj][m][0], v1 = acc[ai][bj][m][1];
                    if (within >= 128) { const float* t = rope + (size_t)(p * 32 + ((within - 128) >> 1)) * 2; const f32x4 t0 = *(const f32x4*)t, t1 = *(const f32x4*)(t + 4);
                        const f32x4 a0 = v0, a1 = v1;
                        v0[0] = a0[0] * t0[0] - a0[1] * t0[1]; v0[1] = a0[1] * t0[0] + a0[0] * t0[1]; v0[2] = a0[2] * t0[2] - a0[3] * t0[3]; v0[3] = a0[3] * t0[2] + a0[2] * t0[3];
                        v1[0] = a1[0] * t1[0] - a1[1] * t1[1]; v1[1] = a1[1] * t1[0] + a1[0] * t1[1]; v1[2] = a1[2] * t1[2] - a1[3] * t1[3]; v1[3] = a1[3] * t1[2] + a1[2] * t1[3]; }
                    v0 = v0 * rsc; v1 = v1 * rsc;
                    u32x4 w; w.x = cvt_pk_bf16(v0[0], v0[1]); w.y = cvt_pk_bf16(v0[2], v0[3]); w.z = cvt_pk_bf16(v1[0], v1[1]); w.w = cvt_pk_bf16(v1[2], v1[3]);
                    *(u32x4*)(rowp + bj * HALF) = w; } }
    }
};

struct EpiCQ {
    static constexpr bool PERM = true, AFTER_DRAIN = false;
    bf16_t* O; const float* wq; float* rsq;
    __device__ __forceinline__ void operator()(const f32x4 (&acc)[2][2][4][2], const Unit& u, int wr, int wc, int, int) const {
        int lane_; asm volatile("v_mbcnt_lo_u32_b32 %0, -1, 0\n\tv_mbcnt_hi_u32_b32 %0, -1, %0" : "=v"(lane_)); const int fr = lane_ & 15, fq = lane_ >> 4;
        const int row0 = u.pm * BM + wr * 64 + fr, col0 = u.pn * BM + wc * 32 + 8 * fq;
#pragma unroll
        for (int ai = 0; ai < 2; ++ai)
#pragma unroll
            for (int m = 0; m < 4; ++m) { const int row = row0 + ai * HALF + m * 16; float ss = 0.f;
#pragma unroll
                for (int bj = 0; bj < 2; ++bj) { const int c = col0 + bj * HALF; if (c >= 384) continue;
                    const f32x4 v0 = acc[ai][bj][m][0], v1 = acc[ai][bj][m][1], w0 = *(const f32x4*)(wq + c), w1 = *(const f32x4*)(wq + c + 4);
                    ss += ((v0[0] * v0[0] + v0[1] * v0[1]) + (v0[2] * v0[2] + v0[3] * v0[3])) + ((v1[0] * v1[0] + v1[1] * v1[1]) + (v1[2] * v1[2] + v1[3] * v1[3]));
                    u32x4 w; w.x = cvt_pk_bf16(v0[0] * w0[0], v0[1] * w0[1]); w.y = cvt_pk_bf16(v0[2] * w0[2], v0[3] * w0[3]); w.z = cvt_pk_bf16(v1[0] * w1[0], v1[1] * w1[1]); w.w = cvt_pk_bf16(v1[2] * w1[2], v1[3] * w1[3]);
                    *(u32x4*)(O + (size_t)row * 384 + c) = w; }
                ss += __builtin_bit_cast(float, __builtin_amdgcn_ds_swizzle(__builtin_bit_cast(int, ss), 0x1F | (16 << 10)));
                { float a = ss, b = ss; asm volatile("s_nop 1\n\tv_permlane32_swap_b32 %0, %1\n\ts_nop 1" : "+v"(a), "+v"(b)); ss = a + b; }
                if (fq == 0 && u.pn < 2) atomicAdd(rsq + row, ss); }
    }
};

struct SliceOrder {
    int pm, nN, nS, G, c, kbytes;
    __device__ bool next(int i, Unit& u) const { const int L = i * G + c; if (L >= nN * nS) return false; u.pm = pm; u.pn = L % nN; u.ko = (L / nN) * kbytes; return true; }
    __device__ __forceinline__ void a_ready(const Unit&) const {}
    __device__ __forceinline__ void done(const Unit&) const {}
};
struct EpiFA {
    static constexpr bool PERM = false, AFTER_DRAIN = false;
    float* O; int ldc, rows;
    __device__ __forceinline__ void operator()(const f32x4 (&acc)[2][2][4][2], const Unit& u, int wr, int wc, int, int) const {
        int lane_; asm volatile("v_mbcnt_lo_u32_b32 %0, -1, 0\n\tv_mbcnt_hi_u32_b32 %0, -1, %0" : "=v"(lane_)); const int fr = lane_ & 15, fq = lane_ >> 4;
        const int row0 = u.pm * BM + wr * 64 + fr, col0 = u.pn * BM + wc * 32 + 4 * fq;
#pragma unroll
        for (int ai = 0; ai < 2; ++ai)
#pragma unroll
            for (int m = 0; m < 4; ++m) { const int row = row0 + ai * HALF + m * 16; if (row >= rows) continue; float* rp = O + (size_t)row * ldc + col0;
#pragma unroll
                for (int bj = 0; bj < 2; ++bj)
#pragma unroll
                    for (int n = 0; n < 2; ++n) { const f32x4 v = acc[ai][bj][m][n];
#pragma unroll
                        for (int e = 0; e < 4; ++e) atomicAdd(rp + bj * HALF + n * 16 + e, v[e]); } }
    }
};

template <int ACT> struct EpiBA {
    static constexpr bool PERM = true, AFTER_DRAIN = false;
    bf16_t* O; const float* bias;
    __device__ __forceinline__ void operator()(const f32x4 (&acc)[2][2][4][2], const Unit& u, int wr, int wc, int, int) const {
        int lane_; asm volatile("v_mbcnt_lo_u32_b32 %0, -1, 0\n\tv_mbcnt_hi_u32_b32 %0, -1, %0" : "=v"(lane_)); const int fr = lane_ & 15, fq = lane_ >> 4;
        const int row0 = u.pm * BM + wr * 64 + fr, col0 = u.pn * BM + wc * 32 + 8 * fq;
        f32x4 bv[2][2];
#pragma unroll
        for (int bj = 0; bj < 2; ++bj)
#pragma unroll
            for (int n = 0; n < 2; ++n) bv[bj][n] = *(const f32x4*)(bias + col0 + bj * HALF + 4 * n);
#pragma unroll
        for (int ai = 0; ai < 2; ++ai)
#pragma unroll
            for (int m = 0; m < 4; ++m) { bf16_t* rowp = O + (size_t)(row0 + ai * HALF + m * 16) * 2048 + col0;
#pragma unroll
                for (int bj = 0; bj < 2; ++bj) { f32x4 v0 = acc[ai][bj][m][0] + bv[bj][0], v1 = acc[ai][bj][m][1] + bv[bj][1];
#pragma unroll
                    for (int e = 0; e < 4; ++e) { const float s0 = __builtin_amdgcn_rcpf(1.0f + __builtin_amdgcn_exp2f(-1.4426950408889634f * v0[e])), s1 = __builtin_amdgcn_rcpf(1.0f + __builtin_amdgcn_exp2f(-1.4426950408889634f * v1[e]));
                        v0[e] = ACT == 4 ? -0.8750387749f * s0 : s0; v1[e] = ACT == 4 ? -0.8750387749f * s1 : s1; }
                    typedef __bf16 bf8n __attribute__((ext_vector_type(8))); typedef float f8n __attribute__((ext_vector_type(8)));
                    const u32x4 w = __builtin_bit_cast(u32x4, __builtin_convertvector((f8n){v0[0], v0[1], v0[2], v0[3], v1[0], v1[1], v1[2], v1[3]}, bf8n));
                    *(u32x4*)(rowp + bj * HALF) = w; } }
    }
};

struct GroupOrderA2 {
    StaticOrder so; int per, nG;
    __device__ void init(int M, int G_, int c_, int nG_) { so.init(M, 2048, G_, c_); per = so.nwg; nG = nG_; }
    __device__ bool next(int i, Unit& u) const {
        const long L = (long)i * so.G + so.c; u.ko = 0;
        if (L < 4L * per) { const int gi = (int)(L / per); int wgid = (int)(L - (long)gi * per);
            { const int q = so.nwg / NXCD, r = so.nwg % NXCD, xcd = wgid % NXCD, off = wgid / NXCD; wgid = (xcd < r ? xcd * (q + 1) : r * (q + 1) + (xcd - r) * q) + off; }
            const int nig = WGM * so.nN, gid = wgid / nig, fm = gid * WGM, gsz = (so.nM - fm) < WGM ? (so.nM - fm) : WGM;
            u.pm = fm + ((wgid % nig) % gsz) + 130 * gi; u.pn = (wgid % nig) / gsz + 8 * gi; return true; }
        const int Lp = (int)(L - 4L * per); if (Lp >= (nG - 4) * so.nM) return false;
        const int ge = Lp / so.nM, gi = 4 + ge; u.pm = Lp % so.nM + 130 * (gi == 6 ? 2 : gi); u.pn = 32 + ge; return true;
    }
    __device__ __forceinline__ void a_ready(const Unit&) const {}
    __device__ __forceinline__ void done(const Unit&) const {}
};
struct EpiA2 {
    static constexpr bool PERM = true, AFTER_DRAIN = false;
    bf16_t* Rb; size_t ostride; int vidx; bf16_t* Lb; size_t lstride;
    __device__ __forceinline__ void operator()(const f32x4 (&acc)[2][2][4][2], const Unit& u, int wr, int wc, int, int) const {
        int lane_; asm volatile("v_mbcnt_lo_u32_b32 %0, -1, 0\n\tv_mbcnt_hi_u32_b32 %0, -1, %0" : "=v"(lane_)); const int fr = lane_ & 15, fq = lane_ >> 4;
        if (u.pn < 32) { const int gi = u.pn >> 3; bf16_t* Ob = Rb + (size_t)(gi < 2 ? gi : (gi == 2 ? vidx : 4)) * ostride;
            const int row0 = (u.pm - 130 * gi) * BM + wr * 64 + fr, col0 = (u.pn & 7) * BM + wc * 32 + 8 * fq;
#pragma unroll
            for (int ai = 0; ai < 2; ++ai)
#pragma unroll
                for (int m = 0; m < 4; ++m) { bf16_t* rowp = Ob + (size_t)(row0 + ai * HALF + m * 16) * 2048 + col0;
#pragma unroll
                    for (int bj = 0; bj < 2; ++bj) { const f32x4 v0 = acc[ai][bj][m][0], v1 = acc[ai][bj][m][1];
                        u32x4 w; w.x = cvt_pk_bf16(v0[0], v0[1]); w.y = cvt_pk_bf16(v0[2], v0[3]); w.z = cvt_pk_bf16(v1[0], v1[1]); w.w = cvt_pk_bf16(v1[2], v1[3]);
                        *(u32x4*)(rowp + bj * HALF) = w; } }
        } else { const int ge = u.pn - 32, gi = 4 + ge; bf16_t* Ob = Lb + (size_t)ge * lstride; const int nvalid = ge == 2 ? 32 : 64;
            const int row0 = (u.pm - 130 * (gi == 6 ? 2 : gi)) * BM + wr * 64 + fr, c = wc * 32 + 8 * fq;
#pragma unroll
            for (int ai = 0; ai < 2; ++ai)
#pragma unroll
                for (int m = 0; m < 4; ++m) { f32x4 v0 = acc[ai][0][m][0], v1 = acc[ai][0][m][1];
                    if (ge == 0) {
#pragma unroll
                        for (int e = 0; e < 4; ++e) { v0[e] = 1.0f - 2.0f / (1.0f + __expf(2.0f * v0[e])); v1[e] = 1.0f - 2.0f / (1.0f + __expf(2.0f * v1[e])); } }
                    u32x4 w; w.x = cvt_pk_bf16(v0[0], v0[1]); w.y = cvt_pk_bf16(v0[2], v0[3]); w.z = cvt_pk_bf16(v1[0], v1[1]); w.w = cvt_pk_bf16(v1[2], v1[3]);
                    if (c >= nvalid) w = (u32x4){0u, 0u, 0u, 0u};
                    *(u32x4*)(Ob + (size_t)(row0 + ai * HALF + m * 16) * 128 + c) = w; }
        }
    }
};
template <class Epi, class Sched, bool ALIGN_EPI = false, bool SP2 = false>
__device__ __forceinline__ void gemm_phase(PG8_LAS unsigned char* lds, const Gemm g, const Sched& S, const Epi& E, const int wid) {
    int lane_; asm volatile("v_mbcnt_lo_u32_b32 %0, -1, 0\n\tv_mbcnt_hi_u32_b32 %0, -1, %0" : "=v"(lane_));
    const int lane = lane_, tid = wid * 64 + lane, wr = wid >> 2, wc = wid & 3, fr = lane & 15, fq = lane >> 4;
    const int K = g.K, nt = K / BK, LD = g.ld ? g.ld : g.K;
    unsigned voffA[2], voffB[2];
#pragma unroll
    for (int i = 0; i < 2; ++i) { int R, C; stage_rc(tid * 16 + i * 8192, R, C); const int Rb = Epi::PERM ? ((R & ~31) + perm32(R & 31)) : R;
        voffA[i] = (unsigned)(R * LD + C) * 2u; voffB[i] = (unsigned)(Rb * LD + C) * 2u; }
    const size_t kstep = (size_t)(BK * 2);
    const size_t hstep = (size_t)HALF * LD * 2;
    const size_t tstep = 2 * hstep;
    const unsigned ldsw = (unsigned)wid * 1024u;
    const int aoff = lds_byte(wr * 64 + fr, fq * 8), boff = lds_byte(wc * 32 + fr, fq * 8);
#define PG8_SA(b, h) (((b) * 2 + (h)) * HTB)
#define PG8_SB(b, h) ((4 + (b) * 2 + (h)) * HTB)
#define PG8_STAGE(bufoff, gbase, voff) do { _Pragma("unroll") for (int _i = 0; _i < 2; ++_i) \
        __builtin_amdgcn_global_load_lds((const unsigned*)((const char*)(gbase) + (voff)[_i]), (PG8_LAS unsigned*)(lds + (bufoff) + ldsw + _i * 8192), 16, 0, 0); } while (0)
#define PG8_LDA(dst, b, h) do { _Pragma("unroll") for (int m = 0; m < 4; ++m) _Pragma("unroll") for (int k = 0; k < 2; ++k) dst[m][k] = *(const PG8_LAS bf16x8*)(lds + PG8_SA(b, h) + aoff + m * 2048 + k * 1024); } while (0)
#define PG8_LDB(dst, b, h) do { _Pragma("unroll") for (int n = 0; n < 2; ++n) _Pragma("unroll") for (int k = 0; k < 2; ++k) dst[n][k] = *(const PG8_LAS bf16x8*)(lds + PG8_SB(b, h) + boff + n * 2048 + k * 1024); } while (0)
#define PG8_MMA(ai, bj, At, Bt) do { __builtin_amdgcn_s_setprio(1); _Pragma("unroll") for (int m = 0; m < 4; ++m) _Pragma("unroll") for (int n = 0; n < 2; ++n) _Pragma("unroll") for (int k = 0; k < 2; ++k) \
        acc[ai][bj][m][n] = __builtin_amdgcn_mfma_f32_16x16x32_bf16(Bt[n][k], At[m][k], acc[ai][bj][m][n], 0, 0, 0); __builtin_amdgcn_s_setprio(0); } while (0)
#define PG8_WAIT_V(n) asm volatile("s_waitcnt vmcnt(" #n ")" ::: "memory")
#define PG8_WAIT_L(n) asm volatile("s_waitcnt lgkmcnt(" #n ")" ::: "memory")
#define PG8_BAR __builtin_amdgcn_s_barrier()
#define PG8_SCHED __builtin_amdgcn_sched_barrier(0)
    Unit cur, nxt; int ui = 0;
    if (!S.next(0, cur)) return;
    f32x4 acc[2][2][4][2];
#pragma unroll
    for (int a = 0; a < 2; ++a)
#pragma unroll
        for (int b = 0; b < 2; ++b)
#pragma unroll
            for (int m = 0; m < 4; ++m)
#pragma unroll
                for (int n = 0; n < 2; ++n) acc[a][b][m][n] = (f32x4){0.f, 0.f, 0.f, 0.f};
    bf16x8 At[4][2], B0[2][2], B1[2][2];
    const char* cA = (const char*)g.A + (size_t)cur.pm * tstep + cur.ko; const char* cB = (const char*)g.Bt + (size_t)cur.pn * tstep + cur.ko;
    S.a_ready(cur);
    if constexpr (SP2) {
        PG8_STAGE(PG8_SB(0, 0), cB, voffB); PG8_STAGE(PG8_SB(0, 1), cB + hstep, voffB); PG8_STAGE(PG8_SA(0, 0), cA, voffA); PG8_STAGE(PG8_SA(0, 1), cA + hstep, voffA);
        if (wr == 1) PG8_BAR;
        PG8_WAIT_V(2); PG8_BAR;
        PG8_STAGE(PG8_SB(1, 0), cB + kstep, voffB); PG8_STAGE(PG8_SA(1, 0), cA + kstep, voffA); PG8_STAGE(PG8_SB(1, 1), cB + hstep + kstep, voffB);
        PG8_WAIT_V(6); PG8_BAR;
    } else {
        PG8_STAGE(PG8_SB(0, 0), cB, voffB); PG8_STAGE(PG8_SA(0, 0), cA, voffA); PG8_STAGE(PG8_SB(0, 1), cB + hstep, voffB); PG8_STAGE(PG8_SA(0, 1), cA + hstep, voffA);
        if (wr == 1) PG8_BAR;
        PG8_WAIT_V(4); PG8_BAR;
        PG8_STAGE(PG8_SB(1, 0), cB + kstep, voffB); PG8_STAGE(PG8_SA(1, 0), cA + kstep, voffA); PG8_STAGE(PG8_SB(1, 1), cB + hstep + kstep, voffB);
        PG8_WAIT_V(6); PG8_BAR;
    }
    for (;;) {
        const bool has_next = S.next(ui + 1, nxt);
        const char* nA = has_next ? (const char*)g.A + (size_t)nxt.pm * tstep + nxt.ko : cA; const char* nB = has_next ? (const char*)g.Bt + (size_t)nxt.pn * tstep + nxt.ko : cB;
        for (int t = 0; t < nt; t += 2) {
            const bool last = (t == nt - 2);
            const char* a1 = cA + (size_t)(t + 1) * kstep;
            const char* a2 = last ? nA : cA + (size_t)(t + 2) * kstep; const char* b2 = last ? nB : cB + (size_t)(t + 2) * kstep;
            const char* a3 = a2 + kstep; const char* b3 = b2 + kstep;
            if (last && has_next) S.a_ready(nxt);
            if constexpr (SP2) {
            PG8_LDB(B0, 0, 0); PG8_LDB(B1, 0, 1); PG8_SCHED; PG8_LDA(At, 0, 0); PG8_STAGE(PG8_SA(1, 1), a1 + hstep, voffA);
            PG8_WAIT_V(8); PG8_WAIT_L(0); PG8_BAR; PG8_MMA(0, 0, At, B0); PG8_MMA(0, 1, At, B1); PG8_BAR; PG8_SCHED;
            PG8_LDA(At, 0, 1); PG8_STAGE(PG8_SB(0, 0), b2, voffB); PG8_STAGE(PG8_SB(0, 1), b2 + hstep, voffB); PG8_STAGE(PG8_SA(0, 0), a2, voffA);
            PG8_WAIT_V(8); PG8_WAIT_L(0); PG8_BAR; PG8_MMA(1, 0, At, B0); PG8_MMA(1, 1, At, B1); PG8_BAR; PG8_SCHED;
            PG8_LDB(B0, 1, 0); PG8_LDB(B1, 1, 1); PG8_SCHED; PG8_LDA(At, 1, 0); PG8_STAGE(PG8_SA(0, 1), a2 + hstep, voffA);
            PG8_WAIT_V(8); PG8_WAIT_L(0); PG8_BAR; PG8_MMA(0, 0, At, B0); PG8_MMA(0, 1, At, B1); PG8_BAR; PG8_SCHED;
            PG8_LDA(At, 1, 1); PG8_STAGE(PG8_SB(1, 0), b3, voffB); PG8_STAGE(PG8_SB(1, 1), b3 + hstep, voffB); PG8_STAGE(PG8_SA(1, 0), a3, voffA);
            PG8_WAIT_V(8); PG8_WAIT_L(0); PG8_BAR; PG8_MMA(1, 0, At, B0); PG8_MMA(1, 1, At, B1); PG8_BAR; PG8_SCHED;
            } else {
            PG8_LDB(B0, 0, 0); PG8_SCHED; PG8_LDA(At, 0, 0); PG8_STAGE(PG8_SA(1, 1), a1 + hstep, voffA);
            PG8_WAIT_L(8); PG8_BAR; PG8_WAIT_L(0); PG8_MMA(0, 0, At, B0); PG8_BAR; PG8_SCHED;
            PG8_LDB(B1, 0, 1); PG8_STAGE(PG8_SB(0, 0), b2, voffB);
            PG8_BAR; PG8_WAIT_L(0); PG8_MMA(0, 1, At, B1); PG8_BAR;
            PG8_LDA(At, 0, 1); PG8_STAGE(PG8_SA(0, 0), a2, voffA);
            PG8_BAR; PG8_WAIT_L(0); PG8_MMA(1, 0, At, B0); PG8_BAR; PG8_SCHED;
            PG8_STAGE(PG8_SB(0, 1), b2 + hstep, voffB);
            PG8_WAIT_V(6); PG8_BAR; PG8_MMA(1, 1, At, B1); PG8_BAR;
            PG8_LDB(B0, 1, 0); PG8_SCHED; PG8_LDA(At, 1, 0); PG8_STAGE(PG8_SA(0, 1), a2 + hstep, voffA);
            PG8_WAIT_L(8); PG8_BAR; PG8_WAIT_L(0); PG8_MMA(0, 0, At, B0); PG8_BAR; PG8_SCHED;
            PG8_LDB(B1, 1, 1); PG8_STAGE(PG8_SB(1, 0), b3, voffB);
            PG8_BAR; PG8_WAIT_L(0); PG8_MMA(0, 1, At, B1); PG8_BAR;
            PG8_LDA(At, 1, 1); PG8_STAGE(PG8_SA(1, 0), a3, voffA);
            PG8_BAR; PG8_WAIT_L(0); PG8_MMA(1, 0, At, B0); PG8_BAR; PG8_SCHED;
            PG8_STAGE(PG8_SB(1, 1), b3 + hstep, voffB);
            PG8_WAIT_V(6); PG8_BAR; PG8_MMA(1, 1, At, B1); PG8_BAR;
            }
        }
        if constexpr (ALIGN_EPI) { if (wr == 0) PG8_BAR; }
        if constexpr (!Epi::AFTER_DRAIN) { E(acc, cur, wr, wc, fr, fq); S.done(cur); }
        if (!has_next) break;
#pragma unroll
        for (int a = 0; a < 2; ++a)
#pragma unroll
            for (int b = 0; b < 2; ++b)
#pragma unroll
                for (int m = 0; m < 4; ++m)
#pragma unroll
                    for (int n = 0; n < 2; ++n) acc[a][b][m][n] = (f32x4){0.f, 0.f, 0.f, 0.f};
        cur = nxt; cA = nA; cB = nB; ++ui;
        if constexpr (ALIGN_EPI) { if (wr == 1) PG8_BAR; }
    }
    PG8_WAIT_V(0);
    if constexpr (!ALIGN_EPI) { if (wr == 0) PG8_BAR; }
    PG8_BAR;
    if constexpr (Epi::AFTER_DRAIN) { E.fused(acc, cur, wr, wc, fr, fq, lds, wid, lane); S.done(cur); }
#undef PG8_SA
#undef PG8_SB
#undef PG8_STAGE
#undef PG8_LDA
#undef PG8_LDB
#undef PG8_MMA
#undef PG8_WAIT_V
#undef PG8_WAIT_L
#undef PG8_BAR
#undef PG8_SCHED
}
}
constexpr int D_MODEL = 1024, BATCH = 16, SEQ = 2048, DEC_BATCH = 128, PAST = 8192, PAGE = 128, NPAGES = 64;
constexpr int D_INNER = 2048, A_HEADS = 32, A_HEAD = 64, B_HEADS = 16, KV_LORA = 256, Q_LORA = 384, QK_NOPE = 128, QK_ROPE = 64, V_HEAD = 128, QK_HEAD = 192;
constexpr int MP = BATCH * SEQ;
constexpr int MS0 = MP;
constexpr int MT = MP + 256;
constexpr float NORM_EPS = 1e-6f, GN_EPS = 64e-5f;
constexpr float ATTN_SCALE = 0.07216878364870322f;
constexpr float LOG2E = 1.4426950408889634f;
constexpr int NWAVES = 8, NTHR = 512;

constexpr size_t O_YP = 0, O_YS = O_YP + (size_t)MP * D_MODEL, O_WKVP = O_YS + (size_t)DEC_BATCH * D_MODEL, O_SHP = O_WKVP + (size_t)2 * BATCH * A_HEADS * 4096,
    O_CKVP = O_SHP + (size_t)2 * BATCH * D_MODEL, O_KPEP = O_CKVP + (size_t)MP * KV_LORA, O_WKVS = O_KPEP + (size_t)MP * QK_ROPE, O_SHS = O_WKVS + (size_t)2 * DEC_BATCH * A_HEADS * 4096,
    O_CKVS = O_SHS + (size_t)2 * DEC_BATCH * D_MODEL, O_KPES = O_CKVS + (size_t)DEC_BATCH * KV_LORA, O_END = O_KPES + (size_t)DEC_BATCH * QK_ROPE;

constexpr size_t MiB = 1u << 20;
constexpr size_t WS_CTL = 0, CTL_ZERO_BYTES = 2 * MiB;
constexpr size_t WS_WIN = 2 * MiB, WIN_L = 18 * MiB;
constexpr size_t WS_W2 = WS_WIN + 2 * WIN_L;
constexpr size_t WS_WO = WS_W2 + 3 * MiB;
constexpr size_t WS_WDKV = WS_WO + 8 * MiB;
constexpr size_t WS_WUK = WS_WDKV + 1 * MiB;
constexpr size_t WS_WUV = WS_WUK + 1 * MiB;
constexpr size_t WS_WQ = WS_WUV + 1 * MiB;
constexpr size_t WS_WZ = WS_WQ + 2 * MiB;
constexpr size_t WS_WUQ = WS_WZ + 8 * MiB;
constexpr size_t WS_WBO = WS_WUQ + 5 * MiB;
constexpr size_t WS_ROPE = WS_WBO + 8 * MiB;
constexpr size_t WS_X = 96 * MiB;
constexpr size_t WS_AM = WS_X + 130 * MiB;
constexpr size_t AM_STRIDE = 65 * MiB;
constexpr size_t WS_R = WS_AM + 6 * AM_STRIDE;
constexpr size_t BIGB = 130 * MiB;
constexpr size_t WS_K = WS_R + BIGB, WS_V0 = WS_K + BIGB, WS_V1 = WS_V0 + BIGB, WS_Z = WS_V1 + BIGB, WS_G = WS_Z + BIGB;
constexpr size_t WS_LW = WS_G + BIGB;
constexpr size_t WS_LA = WS_LW + 9 * MiB, WS_LV = WS_LA + 9 * MiB;
constexpr size_t WS_BON = WS_LV + 9 * MiB;
constexpr size_t WS_F = WS_BON + 5 * MiB;
constexpr size_t BIGF = 260 * MiB;
constexpr size_t WS_WD = WS_F, WS_IA = WS_F + BIGF, WS_VG = WS_F + 2 * BIGF, WS_SR = WS_F + 3 * BIGF, WS_SK = WS_F + 4 * BIGF, WS_SA = WS_F + 5 * BIGF, WS_SB = WS_F + 6 * BIGF,
    WS_SV = WS_F + 7 * BIGF, WS_Y = WS_F + 8 * BIGF, WS_END_A = WS_F + 9 * BIGF;
constexpr size_t WS_KVR = WS_F;
constexpr size_t WS_CKVB = WS_KVR + 41 * MiB;
constexpr size_t WS_KPEB = WS_CKVB + 17 * MiB;
constexpr size_t WS_KN = WS_KPEB + 5 * MiB;
constexpr size_t WS_VT = WS_KN + 128 * MiB;
constexpr size_t WS_QL = WS_VT + 128 * MiB;
constexpr size_t WS_CQ = WS_QL + 49 * MiB;
constexpr size_t WS_QR = WS_CQ + 25 * MiB;
constexpr size_t WS_Q = WS_QR + 388 * MiB;
constexpr size_t WS_QABS = WS_Q + 194 * MiB;
constexpr size_t WS_OPART = WS_QABS + 2 * MiB;
constexpr size_t WS_ML = WS_OPART + 16 * MiB;
constexpr size_t WS_END_B = WS_ML + 1 * MiB;
constexpr size_t WS_NEED = WS_END_A > WS_END_B ? WS_END_A : WS_END_B;
static_assert(WS_ROPE + 1 * MiB <= WS_X, "weights region");
constexpr size_t CW_RSQ = 1 * MiB;
constexpr int CW_BAR = 4096;

constexpr int RING_BYTES = 131072;
constexpr int LDSCTL_OFF = RING_BYTES;
constexpr int LDS_BYTES = 147456;

#define GAS __attribute__((address_space(1)))
#define LAS __attribute__((address_space(3)))
typedef unsigned short bf16;
typedef unsigned v4u __attribute__((ext_vector_type(4)));
typedef unsigned v2u __attribute__((ext_vector_type(2)));
typedef float f32x4 __attribute__((ext_vector_type(4)));
typedef float f32x16 __attribute__((ext_vector_type(16)));
typedef short bf16x8 __attribute__((ext_vector_type(8)));
typedef short s16x4 __attribute__((ext_vector_type(4)));
typedef const __attribute__((address_space(4))) float* cfp;
#define LDS_WAIT() asm volatile("s_waitcnt lgkmcnt(0)" ::: "memory")
#define VM_WAIT() asm volatile("s_waitcnt vmcnt(0)" ::: "memory")
__device__ __forceinline__ unsigned f2bf(float f) { unsigned u = __builtin_bit_cast(unsigned, f); return (u + 0x7fffu + ((u >> 16) & 1u)) >> 16; }
__device__ __forceinline__ unsigned pk2(float lo, float hi) { return f2bf(lo) | (f2bf(hi) << 16); }
__device__ __forceinline__ float bflo(unsigned u) { return __builtin_bit_cast(float, u << 16); }
__device__ __forceinline__ float bfhi(unsigned u) { return __builtin_bit_cast(float, u & 0xffff0000u); }
template <int MASK> __device__ __forceinline__ float swz_xor(float v) { return __builtin_bit_cast(float, __builtin_amdgcn_ds_swizzle(__builtin_bit_cast(int, v), 0x1F | (MASK << 10))); }
__device__ __forceinline__ float xor32_sum(float v) { float a = v, b = v; asm volatile("s_nop 1\n\tv_permlane32_swap_b32 %0, %1\n\ts_nop 1" : "+v"(a), "+v"(b)); return a + b; }
__device__ __forceinline__ float xor32_max(float v) { float a = v, b = v; asm volatile("s_nop 1\n\tv_permlane32_swap_b32 %0, %1\n\ts_nop 1" : "+v"(a), "+v"(b)); return fmaxf(a, b); }
__device__ __forceinline__ float wave_sum(float v) { v += swz_xor<1>(v); v += swz_xor<2>(v); v += swz_xor<4>(v); v += swz_xor<8>(v); v += swz_xor<16>(v); return xor32_sum(v); }
__device__ __forceinline__ float sigmoidf_(float x) { return 1.0f / (1.0f + __expf(-x)); }
#define XB_TMO      128
#define XB_XCNT(j)  (256  + 64 * (j))
#define XB_XSUB(j)  (1280 + 64 * (j))
#define XB_XGEN(j)  (2304 + 64 * (j))
#define XB_TOP      3328
#define XB_TOPGEN   3392
#define XCD_BAR_WORDS 3456
#define XB_SPIN_CAP (1u << 18)

__device__ __forceinline__ unsigned xb_ld(unsigned* p)              { return __hip_atomic_load(p, __ATOMIC_RELAXED, __HIP_MEMORY_SCOPE_AGENT); }
__device__ __forceinline__ unsigned xb_add(unsigned* p, unsigned v) { return __hip_atomic_fetch_add(p, v, __ATOMIC_RELAXED, __HIP_MEMORY_SCOPE_AGENT); }
__device__ __forceinline__ unsigned xb_xcc_id() { return (unsigned)__builtin_amdgcn_s_getreg((3 << 11) | 20) & 0xFu; }
#define XB_SPIN(cond, bar) do { unsigned _sp = 0; while (cond) { __builtin_amdgcn_s_sleep(1); \
    if ((++_sp & 255u) == 0u) { if (xb_ld(&(bar)[XB_TMO])) break; if (_sp > XB_SPIN_CAP) { atomicAdd(&(bar)[XB_TMO], 1u); break; } } } } while (0)

struct XcdBarrier {
    unsigned* bar; unsigned x; unsigned w;
    volatile LAS unsigned* st;
};

__device__ __forceinline__ bool xb_t0(unsigned w) { unsigned l; asm volatile("v_mbcnt_lo_u32_b32 %0, -1, 0\n\tv_mbcnt_hi_u32_b32 %0, -1, %0" : "=v"(l)); return w == 0u && l == 0u; }
__device__ __forceinline__ XcdBarrier xcd_barrier_post(unsigned* bar, volatile LAS unsigned* st, unsigned w) {
    XcdBarrier b; b.bar = bar; b.x = xb_xcc_id(); b.st = st; b.w = w;
    if (xb_t0(w)) (void)xb_add(&bar[XB_XCNT(b.x)], 1u);
    return b;
}
__device__ __forceinline__ void xcd_barrier_complete(unsigned* bar, unsigned x, unsigned& nloc, unsigned& nx) {
    const unsigned G = gridDim.x * gridDim.y * gridDim.z;
    unsigned sum, cnt, mine, sp = 0u;
    for (;;) {
        sum = 0u; cnt = 0u; mine = 0u;
#pragma unroll
        for (unsigned j = 0; j < 16; ++j) { const unsigned c = xb_ld(&bar[XB_XCNT(j)]); sum += c; cnt += (c > 0u) ? 1u : 0u; mine = (j == x) ? c : mine; }
        if (sum == G) break;
        __builtin_amdgcn_s_sleep(1);
        if ((++sp & 255u) == 0u) { if (xb_ld(&bar[XB_TMO])) break; if (sp > XB_SPIN_CAP) { atomicAdd(&bar[XB_TMO], 1u); break; } }
    }
    nloc = mine > 0u ? mine : 1u; nx = cnt > 0u ? cnt : 1u;
}

__device__ __forceinline__ void xcd_barrier(const XcdBarrier& b) {
    asm volatile("s_waitcnt vmcnt(0)" ::: "memory");
    __syncthreads();
    if (xb_t0(b.w)) {
        unsigned* bar = b.bar;
        __builtin_amdgcn_s_waitcnt(0);
        unsigned nloc = b.st[0], nx = b.st[1];
        if (nloc == 0u) { xcd_barrier_complete(bar, b.x, nloc, nx); b.st[0] = nloc; b.st[1] = nx; }
        const unsigned old = xb_add(&bar[XB_XSUB(b.x)], 1u);
        const unsigned gen = old / nloc;
        if (old + 1u == (gen + 1u) * nloc) {
            __builtin_amdgcn_fence(__ATOMIC_RELEASE, "agent");
            asm volatile("s_waitcnt vmcnt(0)" ::: "memory");
            const unsigned og = xb_add(&bar[XB_TOP], 1u);
            const unsigned tg = og / nx;
            if (og + 1u == (tg + 1u) * nx) xb_add(&bar[XB_TOPGEN], 1u);
            else XB_SPIN(xb_ld(&bar[XB_TOPGEN]) == tg, bar);
            __builtin_amdgcn_fence(__ATOMIC_ACQUIRE, "agent");
            xb_add(&bar[XB_XGEN(b.x)], 1u);
            asm volatile("s_waitcnt vmcnt(0)" ::: "memory");
        } else {
            XB_SPIN(xb_ld(&bar[XB_XGEN(b.x)]) == gen, bar);
            __builtin_amdgcn_fence(__ATOMIC_ACQUIRE, "agent");
            asm volatile("s_waitcnt vmcnt(0)" ::: "memory");
        }
    }
    __syncthreads();
}
struct Args { const void* in[36]; float* out; unsigned char* ws; int ph_lo, ph_hi, li, pad; };
typedef const __attribute__((address_space(4))) Args* cargs;
__device__ __forceinline__ int lane_id() { int l; asm volatile("v_mbcnt_lo_u32_b32 %0, -1, 0\n\tv_mbcnt_hi_u32_b32 %0, -1, %0" : "=v"(l)); return l; }
struct Frame { LAS unsigned char* lds; unsigned char* ws; float* out; int lane, wave, bid, gw, NGW, G, NT; };
#define LANE F.lane
__device__ __forceinline__ Frame make_frame(cargs ap, int wave0, LAS unsigned char* lds) {
    Frame F; int w = wave0, b = (int)blockIdx.x, g = (int)gridDim.x; asm volatile("" : "+s"(w), "+s"(b), "+s"(g));
    F.lds = lds; F.ws = ap->ws; F.out = ap->out; F.lane = lane_id(); F.wave = w; F.bid = b; F.G = g; F.gw = b * NWAVES + w; F.NGW = g * NWAVES; F.NT = g * NTHR;
    return F;
}

__device__ __forceinline__ int rope_perm_col(int n) { const int c = n % 192; if (c < 128) return n; const int j = c - 128; return n - c + 128 + 2 * (j & 31) + (j >> 5); }
__device__ __forceinline__ void tr_item(const float* W, int ldw, int col0, int Kvalid, int nblk, bf16* WT, int ldt, bool zpad, LAS float* scr, int item, int lane, bool rperm = false) {
    const int kb = item / nblk, nb = item % nblk, k0 = 64 * kb, n0 = 32 * nb;
#pragma unroll
    for (int i = 0; i < 32; ++i) { const int kk = 2 * i + (lane >> 5); scr[kk * 33 + (lane & 31)] = (k0 + kk < Kvalid) ? W[(size_t)(k0 + kk) * ldw + col0 + n0 + (lane & 31)] : 0.f; }
    LDS_WAIT(); asm volatile("" ::: "memory");
    const int c = lane & 7;
#pragma unroll
    for (int j = 0; j < 4; ++j) { const int n = (lane >> 3) + 8 * j; const LAS float* s = scr + (8 * c) * 33 + n;
        v4u o; o.x = pk2(s[0 * 33], s[1 * 33]); o.y = pk2(s[2 * 33], s[3 * 33]); o.z = pk2(s[4 * 33], s[5 * 33]); o.w = pk2(s[6 * 33], s[7 * 33]);
        const int nd = rperm ? rope_perm_col(n0 + n) : n0 + n;
        *(v4u*)(WT + (size_t)nd * ldt + k0 + 8 * c) = o;
        if (zpad) *(v4u*)(WT + (size_t)nd * ldt + 64 + 8 * c) = (v4u){0u, 0u, 0u, 0u}; }
    LDS_WAIT(); asm volatile("" ::: "memory");
}
#define TRJOB_(W_, ldw_, col0_, Kv_, Nc_, WT_, ldt_, zp_, rp_) do { const int nblk_ = (Nc_) / 32, items_ = (((Kv_) + 63) / 64) * nblk_; \
    for (int it_ = ((F.gw - base_) % F.NGW + F.NGW) % F.NGW; it_ < items_; it_ += F.NGW) tr_item((W_), (ldw_), (col0_), (Kv_), nblk_, (bf16*)(WT_), (ldt_), (zp_), scr, it_, LANE, (rp_)); base_ = (base_ + items_) % F.NGW; } while (0)
#define TRJOB(W_, ldw_, col0_, Kv_, Nc_, WT_, ldt_, zp_) TRJOB_(W_, ldw_, col0_, Kv_, Nc_, WT_, ldt_, zp_, false)

__device__ __forceinline__ void p0_prologue(Frame& F, cargs a) {
    LAS float* scr = (LAS float*)(F.lds + F.wave * 16384);
    unsigned char* ws = F.ws; int base_ = 0;
    for (int l = 0; l < 2; ++l) {
        for (int p = 0; p < 4; ++p) TRJOB((const float*)a->in[9] + (size_t)(l * 4 + p) * 1024 * 2048, 2048, 0, 1024, 2048, ws + WS_WIN + (size_t)l * WIN_L + (size_t)p * 4 * MiB, 1024, false);
        TRJOB((const float*)a->in[11] + (size_t)l * 1024 * 64, 64, 0, 1024, 64, ws + WS_WIN + (size_t)l * WIN_L + 16 * MiB, 1024, false);
        TRJOB((const float*)a->in[14] + (size_t)l * 1024 * 64, 64, 0, 1024, 64, ws + WS_WIN + (size_t)l * WIN_L + 16 * MiB + MiB / 2, 1024, false);
        TRJOB((const float*)a->in[12] + (size_t)l * 64 * 2048, 2048, 0, 64, 2048, ws + WS_W2 + (size_t)l * (MiB / 2), 128, true);
        TRJOB((const float*)a->in[15] + (size_t)l * 64 * 2048, 2048, 0, 64, 2048, ws + WS_W2 + (size_t)(2 + l) * (MiB / 2), 128, true);
        TRJOB((const float*)a->in[24] + (size_t)l * 2048 * 1024, 1024, 0, 2048, 1024, ws + WS_WO + (size_t)l * 4 * MiB, 2048, false);
        TRJOB((const float*)a->in[31] + (size_t)l * 1024 * 2432, 2432, 0, 1024, 384, ws + WS_WQ + (size_t)l * MiB, 1024, false);
        TRJOB((const float*)a->in[31] + (size_t)l * 1024 * 2432, 2432, 384, 1024, 2048, ws + WS_WZ + (size_t)l * 4 * MiB, 1024, false);
        TRJOB_((const float*)a->in[33] + (size_t)l * 384 * 3072, 3072, 0, 384, 3072, ws + WS_WUQ + (size_t)l * (5 * MiB / 2), 384, false, true);
        TRJOB((const float*)a->in[34] + (size_t)l * 2048 * 1024, 1024, 0, 2048, 1024, ws + WS_WBO + (size_t)l * 4 * MiB, 2048, false);
    }
    TRJOB((const float*)a->in[17], 32, 0, 1024, 32, ws + WS_WIN + WIN_L + 17 * MiB, 1024, false);
    TRJOB((const float*)a->in[18], 2048, 0, 32, 2048, ws + WS_W2 + (size_t)4 * (MiB / 2), 128, true);
    TRJOB((const float*)a->in[26], 320, 0, 1024, 320, ws + WS_WDKV, 1024, false);
    TRJOB((const float*)a->in[28], 2048, 0, 256, 2048, ws + WS_WUK, 256, false);
    TRJOB((const float*)a->in[29], 2048, 0, 256, 2048, ws + WS_WUV, 256, false);
    { const f32x4* xs = (const f32x4*)a->in[1]; f32x4* X4 = (f32x4*)(ws + WS_X) + (size_t)MP * 256;
      for (int i = (F.bid * NTHR + F.wave * 64 + LANE); i < 256 * 256; i += F.NT) X4[i] = i < DEC_BATCH * 256 ? xs[i] : (f32x4){0.f, 0.f, 0.f, 0.f}; }
    { float* T = (float*)(ws + WS_ROPE);
      for (int i = (F.bid * NTHR + F.wave * 64 + LANE); i < 2049 * 32; i += F.NT) { const int p = i >> 5, f = i & 31; const double pos = p < 2048 ? (double)p : 8192.0;
          const double ang = pos * (double)exp2f(-(float)f * (13.287712379549449f / 32.0f)); T[2 * i] = (float)cos(ang); T[2 * i + 1] = (float)sin(ang); } }
}

__device__ __forceinline__ void load_row(const float* row, int lane, f32x4 (&v)[4]) {
#pragma unroll
    for (int j = 0; j < 4; ++j) v[j] = ((const f32x4*)row)[lane + 64 * j];
}
__device__ __forceinline__ float row_rs(const f32x4 (&v)[4]) {
    float s = 0.f;
#pragma unroll
    for (int j = 0; j < 4; ++j) s += (v[j].x * v[j].x + v[j].y * v[j].y) + (v[j].z * v[j].z + v[j].w * v[j].w);
    return 1.0f / sqrtf(wave_sum(s) * (1.0f / 1024.0f) + NORM_EPS);
}
__device__ __forceinline__ void norm_rows_bf16(Frame& F, const float* X, const float* w, bf16* O) {
    f32x4 w4[4]; load_row(w, LANE, w4);
    for (int m = F.gw; m < MT; m += F.NGW) { f32x4 x[4]; load_row(X + (size_t)m * 1024, LANE, x); const float rs = row_rs(x);
#pragma unroll
        for (int j = 0; j < 4; ++j) { const f32x4 h = x[j] * rs * w4[j]; v2u o; o.x = pk2(h.x, h.y); o.y = pk2(h.z, h.w); *(v2u*)(O + (size_t)m * 1024 + 4 * LANE + 256 * j) = o; } }
}

__device__ __forceinline__ void norm2_rows_bf16(Frame& F, const float* X, const float* wa, bf16* Oa, const float* wb, bf16* Ob) {
    f32x4 a4[4], b4[4]; load_row(wa, LANE, a4); load_row(wb, LANE, b4);
    for (int m = F.gw; m < MT; m += F.NGW) { f32x4 x[4]; load_row(X + (size_t)m * 1024, LANE, x); const float rs = row_rs(x);
#pragma unroll
        for (int j = 0; j < 4; ++j) { const f32x4 xs = x[j] * rs, ha = xs * a4[j], hb = xs * b4[j]; v2u o; o.x = pk2(ha.x, ha.y); o.y = pk2(ha.z, ha.w); *(v2u*)(Oa + (size_t)m * 1024 + 4 * LANE + 256 * j) = o;
            o.x = pk2(hb.x, hb.y); o.y = pk2(hb.z, hb.w); *(v2u*)(Ob + (size_t)m * 1024 + 4 * LANE + 256 * j) = o; } }
}

__device__ __forceinline__ void a1_prepass(Frame& F, cargs a, int l) {
    const float* Xw = (const float*)(F.ws + WS_X); const float* X = l == 0 ? (const float*)a->in[0] : Xw;
    const float* nw = (const float*)a->in[7] + l * 1024; const float* mix = (const float*)a->in[8] + l * 6 * 1024; const float* sshift = (const float*)a->in[3] + (size_t)l * DEC_BATCH * 1024;
    f32x4 w4[4]; load_row(nw, LANE, w4);
    for (int m = F.gw; m < MT; m += F.NGW) {
        f32x4 x[4], h[4], hp[4]; load_row((m < MP ? X : Xw) + (size_t)m * 1024, LANE, x); const float rs = row_rs(x);
#pragma unroll
        for (int j = 0; j < 4; ++j) { h[j] = x[j] * rs * w4[j]; hp[j] = (f32x4){0.f, 0.f, 0.f, 0.f}; }
        if (m < MP) { if ((m & (SEQ - 1)) != 0) { f32x4 xq[4]; load_row(X + (size_t)(m - 1) * 1024, LANE, xq); const float rq = row_rs(xq);
#pragma unroll
                for (int j = 0; j < 4; ++j) hp[j] = xq[j] * rq * w4[j]; } }
        else if (m < MP + DEC_BATCH) load_row(sshift + (size_t)(m - MP) * 1024, LANE, hp);
#pragma unroll
        for (int p = 0; p < 6; ++p) { bf16* O = (bf16*)(F.ws + WS_AM + (size_t)p * AM_STRIDE) + (size_t)m * 1024;
#pragma unroll
            for (int j = 0; j < 4; ++j) { const f32x4 mx = ((const f32x4*)(mix + p * 1024))[LANE + 64 * j]; const f32x4 o = h[j] + (hp[j] - h[j]) * mx;
                v2u w; w.x = pk2(o.x, o.y); w.y = pk2(o.z, o.w); *(v2u*)(O + 4 * LANE + 256 * j) = w; } }
        float* so = nullptr;
        if (m < MP) { if ((m & (SEQ - 1)) == SEQ - 1) so = F.out + O_SHP + (size_t)(l * BATCH + (m >> 11)) * 1024; }
        else if (m < MP + DEC_BATCH) so = F.out + O_SHS + (size_t)(l * DEC_BATCH + (m - MP)) * 1024;
        if (so) {
#pragma unroll
            for (int j = 0; j < 4; ++j) ((f32x4*)so)[LANE + 64 * j] = h[j]; }
    }
}

typedef float f32x2 __attribute__((ext_vector_type(2)));
__device__ __forceinline__ void unpack8(v4u u, float (&f)[8]) { f[0] = bflo(u.x); f[1] = bfhi(u.x); f[2] = bflo(u.y); f[3] = bfhi(u.y); f[4] = bflo(u.z); f[5] = bfhi(u.z); f[6] = bflo(u.w); f[7] = bfhi(u.w); }
constexpr int FS_TS = 16, FS_Y = FS_TS * 6 * 64 * 4, FS_Z = FS_Y + FS_TS * 64 * 4, FS_BON = FS_Z + FS_TS * 64 * 2, FS_BH = FS_BON + 128, FS_BUF = 2 * FS_BH;
static_assert(2 * FS_BUF <= RING_BYTES && FS_BH % 16 == 0, "fused scan LDS");
template <int CTRL> __device__ __forceinline__ float dppf(float v) { return __builtin_bit_cast(float, __builtin_amdgcn_update_dpp(0, __builtin_bit_cast(int, v), CTRL, 0xF, 0xF, false)); }
__device__ __forceinline__ float wave_sum_fast(float v) {
    v += dppf<0xB1>(v); v += dppf<0x4E>(v); v += dppf<0x124>(v); v += dppf<0x128>(v);
    const int iv = __builtin_bit_cast(int, v);
    return (__builtin_bit_cast(float, __builtin_amdgcn_readlane(iv, 0)) + __builtin_bit_cast(float, __builtin_amdgcn_readlane(iv, 16))) + (__builtin_bit_cast(float, __builtin_amdgcn_readlane(iv, 32)) + __builtin_bit_cast(float, __builtin_amdgcn_readlane(iv, 48)));
}
struct HeadPrm { float w0, a0, v0, kk, ka, rk, lnw, lnb; };
__device__ __forceinline__ float frcp(float x) { return __builtin_amdgcn_rcpf(x); }
__device__ __forceinline__ float fsig(float x) { return __builtin_amdgcn_rcpf(1.0f + __builtin_amdgcn_exp2f(-1.4426950408889634f * x)); }
__device__ __forceinline__ float wkv_step_lds(f32x2 (&S)[32], const LAS float* op, int lane) {
    const LAS f32x4* a4 = (const LAS f32x4*)op; const LAS f32x4* w4 = a4 + 16; const LAS f32x4* b4 = a4 + 32; const LAS f32x4* k4 = a4 + 48; const LAS f32x4* r4 = a4 + 64;
    const float vv = op[320 + lane];
    f32x2 s0 = (f32x2){0.f, 0.f}, s1 = s0;
#pragma unroll
    for (int q = 0; q < 16; ++q) { const f32x4 a = a4[q]; s0 += S[2 * q] * (f32x2){a.x, a.y}; s1 += S[2 * q + 1] * (f32x2){a.z, a.w}; }
    const f32x2 st = s0 + s1; const float sa = st.x + st.y; const f32x2 sa2 = (f32x2){sa, sa}, vv2 = (f32x2){vv, vv};
    f32x2 y0 = (f32x2){0.f, 0.f}, y1 = y0;
#pragma unroll
    for (int q = 0; q < 16; ++q) { const f32x4 w = w4[q], b = b4[q], k = k4[q], r = r4[q];
        S[2 * q] = S[2 * q] * (f32x2){w.x, w.y} + (sa2 * (f32x2){b.x, b.y} + vv2 * (f32x2){k.x, k.y}); y0 += S[2 * q] * (f32x2){r.x, r.y};
        S[2 * q + 1] = S[2 * q + 1] * (f32x2){w.z, w.w} + (sa2 * (f32x2){b.z, b.w} + vv2 * (f32x2){k.z, k.w}); y1 += S[2 * q + 1] * (f32x2){r.z, r.w}; }
    const f32x2 yt = y0 + y1; return yt.x + yt.y;
}
__device__ __forceinline__ void fs_prep_one(const HeadPrm& P, int l, float r, float k, float v, float dw, float da, float dv, float vf, LAS float* op, int lane, float& bon) {
    const float ia = da, w = __builtin_amdgcn_exp2f(dw);
    if (l) v = v + (vf - v) * dv;
    const float kk = k * P.kk, n2 = wave_sum_fast(kk * kk), inv = 1.0f / fmaxf(sqrtf(n2), 1e-12f), q = kk * inv, kp = k * (1.0f + (ia - 1.0f) * P.ka);
    bon = wave_sum_fast(r * kp * P.rk);
    op[lane] = -q; op[64 + lane] = w; op[128 + lane] = q * ia; op[192 + lane] = kp; op[256 + lane] = r; op[320 + lane] = v;
}
__device__ __forceinline__ float fs_post_one(const HeadPrm& P, float y, float vp, float z, float bon) {
    const float mu = wave_sum_fast(y) * (1.0f / 64.0f), d = y - mu, var = wave_sum_fast(d * d) * (1.0f / 64.0f);
    const float yn = d * __builtin_amdgcn_rsqf(var + GN_EPS) * P.lnw + P.lnb; return (yn + bon * vp) * (z * fsig(z));
}
__device__ __forceinline__ float ldbf(const bf16* p) { return bflo((unsigned)*p); }
__device__ __forceinline__ bf16 tobf(float x) { return __builtin_bit_cast(unsigned short, (__bf16)x); }
typedef short s16x4_t __attribute__((ext_vector_type(4)));
#define MF16(a_, b_, c_) __builtin_amdgcn_mfma_f32_16x16x16bf16_1k((a_), (b_), (c_), 0, 0, 0)
#define MF32(a_, b_, c_) __builtin_amdgcn_mfma_f32_16x16x32_bf16((a_), (b_), (c_), 0, 0, 0)
typedef __bf16 bf16x4_nat __attribute__((ext_vector_type(4)));
__device__ __forceinline__ s16x4_t cvt4(f32x4 v) { return __builtin_bit_cast(s16x4_t, __builtin_convertvector(v, bf16x4_nat)); }
constexpr int CK_TP = 144, CK_KP = 40;
constexpr int CK_AT = 0, CK_RT = CK_AT + 16 * CK_TP, CK_BH = CK_RT + 16 * CK_TP, CK_KH = CK_BH + 16 * CK_TP, CK_BHT = CK_KH + 16 * CK_TP, CK_KHT = CK_BHT + 64 * CK_KP, CK_VT = CK_KHT + 64 * CK_KP,
    CK_PC = CK_VT + 64 * CK_KP, CK_OPB = CK_PC + 256;
constexpr int RG_VP = 0, RG_Z = 2048, RG_BON = 4096, RG_SZ = 4224;
constexpr int BH_OPB = 0, BH_RING = 2 * CK_OPB, BH_Y = BH_RING + 3 * RG_SZ, BH_LW = BH_Y + 2 * 4096, BH_PRM = BH_LW + 4096, BH_SZ = BH_PRM + 6 * 256;
static_assert(2 * BH_SZ <= RING_BYTES && BH_SZ % 16 == 0 && CK_OPB % 16 == 0, "chunked scan LDS");
typedef short v4i16_ck __attribute__((ext_vector_type(4)));
__device__ __forceinline__ s16x4_t ck_tr(const LAS unsigned char* p) { return __builtin_bit_cast(s16x4_t, __builtin_amdgcn_ds_read_tr16_b64_v4i16((LAS v4i16_ck*)p)); }
__device__ __forceinline__ void ck_scan_chunk(f32x4 (&ST)[4][4], const LAS unsigned char* ob, const LAS unsigned char* vpb, LAS float* yb, int c16, int g) {
    const f32x4 zero4 = (f32x4){0.f, 0.f, 0.f, 0.f};
    bf16x8 at[2], rt[2], bh[2], kh[2];
#pragma unroll
    for (int ks = 0; ks < 2; ++ks) { const int o = c16 * CK_TP + 16 * g + 64 * ks;
        at[ks] = *(const LAS bf16x8*)(ob + CK_AT + o); rt[ks] = *(const LAS bf16x8*)(ob + CK_RT + o); bh[ks] = *(const LAS bf16x8*)(ob + CK_BH + o); kh[ks] = *(const LAS bf16x8*)(ob + CK_KH + o); }
    f32x4 qN = zero4, qL = zero4, qMk = zero4, qNbr = zero4, qNkr = zero4;
#pragma unroll
    for (int ks = 0; ks < 2; ++ks) { qN = MF32(bh[ks], at[ks], qN); qL = MF32(at[ks], bh[ks], qL); qMk = MF32(kh[ks], at[ks], qMk); qNbr = MF32(bh[ks], rt[ks], qNbr); qNkr = MF32(kh[ks], rt[ks], qNkr); }
    f32x4 Id;
#pragma unroll
    for (int r = 0; r < 4; ++r) { const int row = 4 * g + r; Id[r] = row == c16 ? 1.f : 0.f;
        if (!(row < c16)) { qN[r] = 0.f; qMk[r] = 0.f; }
        if (!(row <= c16)) { qNbr[r] = 0.f; qNkr[r] = 0.f; }
        if (!(c16 < row)) qL[r] = 0.f; }
    const s16x4_t aN = cvt4(qN), aL = cvt4(qL), aMk = cvt4(qMk), aNbr = cvt4(qNbr), aNkr = cvt4(qNkr);
    const f32x4 n2 = MF16(aL, aN, zero4), l2 = MF16(aN, aL, zero4);
    const s16x4_t aN2 = cvt4(n2), aL2 = cvt4(l2);
    const f32x4 n4 = MF16(aL2, aN2, zero4), l4 = MF16(aN2, aL2, zero4);
    const f32x4 n8 = MF16(cvt4(l4), cvt4(n4), zero4);
    const f32x4 p1t = MF16(cvt4(n2 + Id), cvt4(qL + Id), zero4);
    const f32x4 p2 = MF16(cvt4(l4 + Id), cvt4(n8 + Id), zero4);
    const s16x4_t aT = cvt4(MF16(cvt4(p1t), cvt4(p2), zero4));
    s16x4_t af[4], rf[4], bfr[4], kfr[4], vtr[4]; f32x4 pc[4]; s16x4_t Sb[4];
#pragma unroll
    for (int ki = 0; ki < 4; ++ki) { const int o = c16 * CK_TP + (16 * ki + 4 * g) * 2; af[ki] = *(const LAS s16x4_t*)(ob + CK_AT + o); rf[ki] = *(const LAS s16x4_t*)(ob + CK_RT + o);
        const int o2 = (4 * g + (c16 >> 2)) * CK_TP + (16 * ki + 4 * (c16 & 3)) * 2; bfr[ki] = ck_tr(ob + CK_BH + o2); kfr[ki] = ck_tr(ob + CK_KH + o2);
        vtr[ki] = ck_tr(vpb + (4 * g + (c16 >> 2)) * 128 + (16 * ki + 4 * (c16 & 3)) * 2);
        pc[ki] = *(const LAS f32x4*)(ob + CK_PC + (16 * ki + 4 * g) * 4); }
    f32x4 yt[4];
#pragma unroll
    for (int vi = 0; vi < 4; ++vi) {
        f32x4 xt = zero4, y0 = zero4;
#pragma unroll
        for (int ki = 0; ki < 4; ++ki) { Sb[ki] = cvt4(ST[ki][vi]); xt = MF16(af[ki], Sb[ki], xt); y0 = MF16(rf[ki], Sb[ki], y0); }
        const s16x4_t vt = vtr[vi];
        xt = MF16(aMk, vt, xt);
        const s16x4_t ub = cvt4(MF16(aT, cvt4(xt), zero4));
        y0 = MF16(aNbr, ub, y0); yt[vi] = MF16(aNkr, vt, y0);
#pragma unroll
        for (int ki = 0; ki < 4; ++ki) { ST[ki][vi] = MF16(bfr[ki], ub, ST[ki][vi]); ST[ki][vi] = MF16(kfr[ki], vt, ST[ki][vi]); ST[ki][vi] *= pc[ki]; }
    }
#pragma unroll
    for (int vi = 0; vi < 4; ++vi)
#pragma unroll
        for (int r = 0; r < 4; ++r) yb[(4 * g + r) * 64 + 16 * vi + c16] = yt[vi][r];
}
__device__ __forceinline__ void a5_fused(Frame& F, cargs a, int l) {
    unsigned char* ws = F.ws; const int lane = F.lane;
    const bf16* R = (const bf16*)(ws + WS_R); const bf16* K = (const bf16*)(ws + WS_K); const bf16* V = (const bf16*)(ws + (l ? WS_V1 : WS_V0)); const bf16* VF = (const bf16*)(ws + WS_V0); const bf16* Z = (const bf16*)(ws + WS_Z);
    const bf16* DW = (const bf16*)(ws + WS_WD); const bf16* DA = (const bf16*)(ws + WS_IA); const bf16* DV = (const bf16*)(ws + WS_VG); bf16* G = (bf16*)(ws + WS_G);
    const float* pw0 = (const float*)a->in[10] + l * 2048; const float* pa0 = (const float*)a->in[13] + l * 2048; const float* pv0 = (const float*)a->in[16]; const float* pkk = (const float*)a->in[19] + l * 2048;
    const float* pka = (const float*)a->in[20] + l * 2048; const float* prk = (const float*)a->in[21] + l * 2048; const float* plw = (const float*)a->in[22] + l * 2048; const float* plb = (const float*)a->in[23] + l * 2048;
    constexpr int NCH = SEQ / 16;
    for (int pr = F.bid; pr < BATCH * A_HEADS / 2; pr += F.G) { const int bh0 = 2 * pr;
        const int role = F.wave >> 1, hb = F.wave & 1, bh = bh0 + hb, b = bh >> 5, hh = bh & 31, ch = hh * 64 + lane;
        LAS unsigned char* blk = F.lds + hb * BH_SZ;
        const size_t rowb = (size_t)b * SEQ; const int c16 = lane & 15, g = lane >> 4;
#define CK_BAR() do { asm volatile("s_waitcnt lgkmcnt(0)" ::: "memory"); __builtin_amdgcn_s_barrier(); asm volatile("" ::: "memory"); } while (0)
#define CKV_LOAD(cc, SET) do { const size_t ro = (rowb + (size_t)(cc) * 16) * 2048;     \
            _Pragma("unroll") for (int j = 0; j < 2; ++j) { SET##r[j] = ((const v4u*)(R + ro + voff_))[j]; SET##k[j] = ((const v4u*)(K + ro + voff_))[j]; SET##v[j] = ((const v4u*)(V + ro + voff_))[j]; SET##z[j] = ((const v4u*)(Z + ro + voff_))[j]; \
                SET##w[j] = ((const v4u*)(DW + ro + voff_))[j]; SET##a[j] = ((const v4u*)(DA + ro + voff_))[j]; if (l) { SET##d[j] = ((const v4u*)(DV + ro + voff_))[j]; SET##f[j] = ((const v4u*)(VF + ro + voff_))[j]; } } } while (0)
#define CKV_PREP(cc, SET) do { LAS unsigned char* ob = blk + BH_OPB + ((cc) & 1) * CK_OPB; LAS unsigned char* rg = blk + BH_RING + ((cc) % 3) * RG_SZ; \
            float kk_[16], kp_[16], ia_[16], lw_[16]; float n2 = 0.f, bon = 0.f; \
            _Pragma("unroll") for (int j = 0; j < 2; ++j) { float k8[8], a8[8], r8[8], w8[8]; unpack8(SET##k[j], k8); unpack8(SET##a[j], a8); unpack8(SET##r[j], r8); unpack8(SET##w[j], w8); \
                _Pragma("unroll") for (int h = 0; h < 2; ++h) { const f32x4 pkk_ = prm[3 * 16 + 4 * vq_ + 2 * j + h], pka_ = prm[4 * 16 + 4 * vq_ + 2 * j + h], prk_ = prm[5 * 16 + 4 * vq_ + 2 * j + h]; \
                    _Pragma("unroll") for (int e = 0; e < 4; ++e) { const int i = 8 * j + 4 * h + e, e8 = 4 * h + e; const float ia = a8[e8]; ia_[i] = ia; lw_[i] = w8[e8]; \
                        const float kk = k8[e8] * pkk_[e]; kk_[i] = kk; n2 += kk * kk; const float kp = k8[e8] * (1.0f + (ia - 1.0f) * pka_[e]); kp_[i] = kp; bon += r8[e8] * kp * prk_[e]; } } } \
            n2 += dppf<0xB1>(n2); n2 += dppf<0x4E>(n2); bon += dppf<0xB1>(bon); bon += dppf<0x4E>(bon); const float inv = __builtin_amdgcn_rsqf(fmaxf(n2, 1e-24f)); \
              \
            _Pragma("unroll") for (int j = 0; j < 4; ++j) lwp[vt_ * 16 + 4 * vq_ + j] = (f32x4){lw_[4 * j], lw_[4 * j + 1], lw_[4 * j + 2], lw_[4 * j + 3]}; \
            LDS_WAIT(); asm volatile("" ::: "memory"); \
            { float c_[16]; _Pragma("unroll") for (int t = 0; t < 16; ++t) c_[t] = ((const LAS float*)lwp)[t * 64 + lane]; \
              _Pragma("unroll") for (int t = 1; t < 16; ++t) c_[t] += c_[t - 1]; \
              _Pragma("unroll") for (int t = 0; t < 16; ++t) ((LAS float*)lwp)[t * 64 + lane] = c_[t]; } \
            LDS_WAIT(); asm volatile("" ::: "memory"); \
            float lp_[16]; _Pragma("unroll") for (int j = 0; j < 4; ++j) { const f32x4 v = lwp[vt_ * 16 + 4 * vq_ + j]; lp_[4 * j] = v.x; lp_[4 * j + 1] = v.y; lp_[4 * j + 2] = v.z; lp_[4 * j + 3] = v.w; } \
            v4u oa[2], orr[2], ob_[2], ok[2], ov[2]; \
            _Pragma("unroll") for (int j = 0; j < 2; ++j) { float r8[8], v8[8]; unpack8(SET##r[j], r8); unpack8(SET##v[j], v8); \
                if (l) { float d8[8], f8[8]; unpack8(SET##d[j], d8); unpack8(SET##f[j], f8); _Pragma("unroll") for (int h = 0; h < 2; ++h) { \
                        _Pragma("unroll") for (int e = 0; e < 4; ++e) { const int e8 = 4 * h + e; v8[e8] = v8[e8] + (f8[e8] - v8[e8]) * d8[e8]; } } } \
                _Pragma("unroll") for (int e = 0; e < 8; e += 2) { const int i = 8 * j + e; \
                    const float P0 = __builtin_amdgcn_exp2f(lp_[i]), P1 = __builtin_amdgcn_exp2f(lp_[i + 1]), R0 = __builtin_amdgcn_exp2f(-lp_[i]), R1 = __builtin_amdgcn_exp2f(-lp_[i + 1]); \
                    const float M0 = __builtin_amdgcn_exp2f(lp_[i] - lw_[i]), M1 = __builtin_amdgcn_exp2f(lp_[i + 1] - lw_[i + 1]), q0 = kk_[i] * inv, q1 = kk_[i + 1] * inv; \
                    oa[j][e >> 1] = (unsigned)tobf(-q0 * M0) | ((unsigned)tobf(-q1 * M1) << 16); orr[j][e >> 1] = (unsigned)tobf(r8[e] * P0) | ((unsigned)tobf(r8[e + 1] * P1) << 16); \
                    ob_[j][e >> 1] = (unsigned)tobf(q0 * ia_[i] * R0) | ((unsigned)tobf(q1 * ia_[i + 1] * R1) << 16); ok[j][e >> 1] = (unsigned)tobf(kp_[i] * R0) | ((unsigned)tobf(kp_[i + 1] * R1) << 16); \
                    ov[j][e >> 1] = (unsigned)tobf(v8[e]) | ((unsigned)tobf(v8[e + 1]) << 16); \
                    if (vt_ == 15) { ((LAS float*)(ob + CK_PC))[16 * vq_ + i] = P0; ((LAS float*)(ob + CK_PC))[16 * vq_ + i + 1] = P1; } } } \
            _Pragma("unroll") for (int j = 0; j < 2; ++j) { const int o = vt_ * CK_TP + 32 * vq_ + 16 * j; *(LAS v4u*)(ob + CK_AT + o) = oa[j]; *(LAS v4u*)(ob + CK_RT + o) = orr[j]; *(LAS v4u*)(ob + CK_BH + o) = ob_[j]; *(LAS v4u*)(ob + CK_KH + o) = ok[j]; \
                *(LAS v4u*)(rg + RG_VP + vt_ * 128 + 32 * vq_ + 16 * j) = ov[j]; *(LAS v4u*)(rg + RG_Z + vt_ * 128 + 32 * vq_ + 16 * j) = SET##z[j]; } \
            if (vq_ == 0) ((LAS float*)(rg + RG_BON))[vt_] = bon; } while (0)
#define CK_POST(cc) do { const LAS unsigned char* rg = blk + BH_RING + ((cc) % 3) * RG_SZ; const LAS float* yb = (const LAS float*)(blk + BH_Y + ((cc) & 1) * 4096) + pt_ * 64 + 16 * pq_; \
            float y_[16], vp_[16], z_[16]; \
            _Pragma("unroll") for (int j = 0; j < 4; ++j) { const f32x4 v = ((const LAS f32x4*)yb)[j]; y_[4 * j] = v.x; y_[4 * j + 1] = v.y; y_[4 * j + 2] = v.z; y_[4 * j + 3] = v.w; } \
            _Pragma("unroll") for (int j = 0; j < 2; ++j) { float t8[8]; unpack8(((const LAS v4u*)(rg + RG_VP + pt_ * 128 + 32 * pq_))[j], t8); _Pragma("unroll") for (int e = 0; e < 8; ++e) vp_[8 * j + e] = t8[e]; \
                unpack8(((const LAS v4u*)(rg + RG_Z + pt_ * 128 + 32 * pq_))[j], t8); _Pragma("unroll") for (int e = 0; e < 8; ++e) z_[8 * j + e] = t8[e]; } \
            const float bon = ((const LAS float*)(rg + RG_BON))[pt_]; float sm = 0.f; \
            _Pragma("unroll") for (int j = 0; j < 16; ++j) sm += y_[j]; \
            sm += dppf<0xB1>(sm); sm += dppf<0x4E>(sm); const float mu = sm * (1.0f / 64.0f); float sq = 0.f; \
            _Pragma("unroll") for (int j = 0; j < 16; ++j) { y_[j] -= mu; sq += y_[j] * y_[j]; } \
            sq += dppf<0xB1>(sq); sq += dppf<0x4E>(sq); const float rstd = __builtin_amdgcn_rsqf(sq * (1.0f / 64.0f) + GN_EPS); \
            v4u o_[2]; \
            _Pragma("unroll") for (int j = 0; j < 16; j += 2) { const float g0 = (y_[j] * rstd * lw_[j] + lb_[j] + bon * vp_[j]) * (z_[j] * fsig(z_[j])), g1 = (y_[j + 1] * rstd * lw_[j + 1] + lb_[j + 1] + bon * vp_[j + 1]) * (z_[j + 1] * fsig(z_[j + 1])); \
                o_[j >> 3][(j >> 1) & 3] = (unsigned)tobf(g0) | ((unsigned)tobf(g1) << 16); } \
            v4u* gp = (v4u*)(G + (rowb + (size_t)(cc) * 16 + pt_) * 2048 + hh * 64 + 16 * pq_); gp[0] = o_[0]; gp[1] = o_[1]; } while (0)
        typedef unsigned short us2 __attribute__((ext_vector_type(2)));
        if (role == 0) { f32x4 ST[4][4];
#pragma unroll
            for (int i = 0; i < 4; ++i)
#pragma unroll
                for (int j = 0; j < 4; ++j) ST[i][j] = (f32x4){0.f, 0.f, 0.f, 0.f};
            CK_BAR();
            for (int c = 0; c < NCH; ++c) { ck_scan_chunk(ST, blk + BH_OPB + (c & 1) * CK_OPB, blk + BH_RING + (c % 3) * RG_SZ + RG_VP, (LAS float*)(blk + BH_Y + (c & 1) * 4096), c16, g); CK_BAR(); }
            float* so = F.out + O_WKVP + ((size_t)(l * BATCH + b) * A_HEADS + hh) * 4096;
#pragma unroll
            for (int ki = 0; ki < 4; ++ki)
#pragma unroll
                for (int vi = 0; vi < 4; ++vi) *(f32x4*)(so + (16 * vi + c16) * 64 + 16 * ki + 4 * g) = ST[ki][vi]; }
        else if (role == 1) { const int ln1 = lane_id(), vt_ = ln1 >> 2, vq_ = ln1 & 3; const unsigned voff_ = (unsigned)(vt_ * 2048 + hh * 64 + 16 * vq_); LAS f32x4* lwp = (LAS f32x4*)(blk + BH_LW); const LAS f32x4* prm = (const LAS f32x4*)(blk + BH_PRM);
            { const int ln = lane_id(), c1 = hh * 64 + ln; LAS float* pf = (LAS float*)(blk + BH_PRM); pf[ln] = pw0[c1]; pf[64 + ln] = pa0[c1]; pf[128 + ln] = l ? pv0[c1] : 0.f; pf[192 + ln] = pkk[c1]; pf[256 + ln] = pka[c1]; pf[320 + ln] = prk[c1]; LDS_WAIT(); asm volatile("" ::: "memory"); }
            v4u Ar[2], Ak[2], Av[2], Az[2], Aw[2], Aa[2], Ad[2], Af[2];
#pragma unroll
            for (int j = 0; j < 2; ++j) { Ad[j] = (v4u){0u, 0u, 0u, 0u}; Af[j] = Ad[j]; }
            CKV_LOAD(0, A); CKV_PREP(0, A); CKV_LOAD(1, A); CK_BAR();
            for (int c = 0; c < NCH; ++c) { if (c + 1 < NCH) { CKV_PREP(c + 1, A); if (c + 2 < NCH) CKV_LOAD(c + 2, A); } CK_BAR(); } }
        else if (role == 3) {
            const int ln3 = lane_id(), vt_ = ln3 >> 2, vq_ = ln3 & 3; const unsigned voff_ = (unsigned)(vt_ * 2048 + hh * 64 + 16 * vq_);
            v4u Ar[2], Ak[2], Av[2], Az[2], Aw[2], Aa[2], Ad[2], Af[2];
#pragma unroll
            for (int j = 0; j < 2; ++j) { Ad[j] = (v4u){0u, 0u, 0u, 0u}; Af[j] = Ad[j]; }
            CKV_LOAD(2, A); CK_BAR();
            for (int c = 0; c < NCH; ++c) {
#pragma unroll
                for (int j = 0; j < 2; ++j) asm volatile("" :: "v"(Ar[j]), "v"(Ak[j]), "v"(Av[j]), "v"(Az[j]), "v"(Aw[j]), "v"(Aa[j]), "v"(Ad[j]), "v"(Af[j]));
                if (c + 3 < NCH) CKV_LOAD(c + 3, A);
                CK_BAR(); } }
        else { const int ln2 = lane_id(), pt_ = ln2 >> 2, pq_ = ln2 & 3; float lw_[16], lb_[16];
#pragma unroll
            for (int j = 0; j < 16; ++j) { lw_[j] = plw[hh * 64 + 16 * pq_ + j]; lb_[j] = plb[hh * 64 + 16 * pq_ + j]; }
            CK_BAR();
            for (int c = 0; c < NCH; ++c) { if (c >= 1) CK_POST(c - 1); CK_BAR(); }
            CK_POST(NCH - 1); }
        __syncthreads();
#undef CK_PREP
#undef CKV_LOAD
#undef CKV_PREP
#undef CK_BAR
#undef CK_POST
    }
    const float* stt = (const float*)a->in[2] + (size_t)l * DEC_BATCH * A_HEADS * 4096;
    LAS float* sop = (LAS float*)(F.lds + F.wave * 2048);
    for (int it = F.gw; it < DEC_BATCH * A_HEADS; it += F.NGW) { const int b = it >> 5, hh = it & 31, ch = hh * 64 + lane; const size_t o = (size_t)(MP + b) * 2048 + ch;
        HeadPrm P; P.w0 = pw0[ch]; P.a0 = pa0[ch]; P.v0 = l ? pv0[ch] : 0.f; P.kk = pkk[ch]; P.ka = pka[ch]; P.rk = prk[ch]; P.lnw = plw[ch]; P.lnb = plb[ch];
        const float z = ldbf(Z + o); float bon;
        fs_prep_one(P, l, ldbf(R + o), ldbf(K + o), ldbf(V + o), ldbf(DW + o), ldbf(DA + o), l ? ldbf(DV + o) : 0.f, l ? ldbf(VF + o) : 0.f, sop, lane, bon);
        LDS_WAIT(); asm volatile("" ::: "memory");
        f32x2 S[32]; const float* si = stt + (size_t)it * 4096 + lane * 64;
#pragma unroll
        for (int k = 0; k < 32; k += 2) { const f32x4 v = *(const f32x4*)(si + 2 * k); S[k] = (f32x2){v.x, v.y}; S[k + 1] = (f32x2){v.z, v.w}; }
        const float y = wkv_step_lds(S, sop, lane), vp = sop[320 + lane];
        float* so = F.out + O_WKVS + ((size_t)l * DEC_BATCH * A_HEADS + it) * 4096 + lane * 64;
#pragma unroll
        for (int k = 0; k < 32; k += 2) *(f32x4*)(so + 2 * k) = (f32x4){S[k].x, S[k].y, S[k + 1].x, S[k + 1].y};
        G[o] = (bf16)f2bf(fs_post_one(P, y, vp, z, bon));
        LDS_WAIT(); asm volatile("" ::: "memory");
    }
#undef FS_PREP
#undef FS_POST
}

__device__ __forceinline__ void final_norm(Frame& F, cargs a) {
    const float* X = (const float*)(F.ws + WS_X); f32x4 w4[4]; load_row((const float*)a->in[35], LANE, w4);
    for (int m = F.gw; m < MP + DEC_BATCH; m += F.NGW) { f32x4 x[4]; load_row(X + (size_t)m * 1024, LANE, x); const float rs = row_rs(x);
        float* o = m < MP ? F.out + O_YP + (size_t)m * 1024 : F.out + O_YS + (size_t)(m - MP) * 1024;
#pragma unroll
        for (int j = 0; j < 4; ++j) ((f32x4*)o)[LANE + 64 * j] = x[j] * rs * w4[j]; }
}
__device__ __forceinline__ void b0c_kvpost(Frame& F, cargs a) {
    unsigned char* ws = F.ws; const float* KVR = (const float*)(ws + WS_KVR); bf16* CK = (bf16*)(ws + WS_CKVB); bf16* KP = (bf16*)(ws + WS_KPEB); const float* ROPE = (const float*)(ws + WS_ROPE);
    const f32x4 w4 = ((const f32x4*)a->in[27])[F.lane];
    for (int m = F.gw; m < MP + DEC_BATCH; m += F.NGW) { const float* row = KVR + (size_t)m * 320;
        const f32x4 v = ((const f32x4*)row)[F.lane]; const float ss = wave_sum((v.x * v.x + v.y * v.y) + (v.z * v.z + v.w * v.w));
        const float rs = 1.0f / sqrtf(ss * (1.0f / 256.0f) + NORM_EPS); const f32x4 c = v * rs * w4;
        float* oc = m < MP ? F.out + O_CKVP + (size_t)m * 256 : F.out + O_CKVS + (size_t)(m - MP) * 256; float* ok = m < MP ? F.out + O_KPEP + (size_t)m * 64 : F.out + O_KPES + (size_t)(m - MP) * 64;
        ((f32x4*)oc)[F.lane] = c; v2u pw; pw.x = pk2(c.x, c.y); pw.y = pk2(c.z, c.w); *(v2u*)(CK + (size_t)m * 256 + 4 * F.lane) = pw;
        if (F.lane < 32) { const int i = F.lane, p = m < MP ? (m & (SEQ - 1)) : SEQ; const float x1 = row[256 + i], x2 = row[288 + i], cs = ROPE[(p * 32 + i) * 2], sn = ROPE[(p * 32 + i) * 2 + 1];
            const float o1 = x1 * cs - x2 * sn, o2 = x2 * cs + x1 * sn; ok[i] = o1; ok[32 + i] = o2; *(unsigned*)(KP + (size_t)m * 64 + 2 * i) = pk2(o1, o2); }
    }
}
__device__ __forceinline__ void b1c_cq(Frame& F, cargs a, int l) {
    unsigned char* ws = F.ws; const float* QL = (const float*)(ws + WS_QL); bf16* CQ = (bf16*)(ws + WS_CQ); const float* w = (const float*)a->in[32] + l * 384;
    f32x2 w2[3];
#pragma unroll
    for (int j = 0; j < 3; ++j) w2[j] = *(const f32x2*)(w + 2 * F.lane + 128 * j);
    for (int m = F.gw; m < MT; m += F.NGW) { f32x2 v[3]; float ss = 0.f;
#pragma unroll
        for (int j = 0; j < 3; ++j) { v[j] = *(const f32x2*)(QL + (size_t)m * 384 + 2 * F.lane + 128 * j); ss += v[j].x * v[j].x + v[j].y * v[j].y; }
        const float rs = 1.0f / sqrtf(wave_sum(ss) * (1.0f / 384.0f) + NORM_EPS);
#pragma unroll
        for (int j = 0; j < 3; ++j) *(unsigned*)(CQ + (size_t)m * 384 + 2 * F.lane + 128 * j) = pk2(v[j].x * rs * w2[j].x, v[j].y * rs * w2[j].y); }
}
constexpr int AT_KP = 400, AT_VP = 136, AT_KBYTES = 64 * AT_KP, AT_VBYTES = 128 * AT_VP, AT_BUF = AT_KBYTES + AT_VBYTES;
__device__ __forceinline__ int crow(int r, int hi) { return (r & 3) + 8 * (r >> 2) + 4 * hi; }
typedef __bf16 bf16x8_nat __attribute__((ext_vector_type(8)));
typedef float f32x8 __attribute__((ext_vector_type(8)));
__device__ __forceinline__ bf16x8 pack8f(float a0, float a1, float a2, float a3, float a4, float a5, float a6, float a7) {
    return __builtin_bit_cast(bf16x8, __builtin_convertvector((f32x8){a0, a1, a2, a3, a4, a5, a6, a7}, bf16x8_nat)); }
__device__ __forceinline__ void attn_unit(Frame& F, int b, int hd, int qb) {
    unsigned char* ws = F.ws; const bf16* Q = (const bf16*)(ws + WS_Q); const bf16* KN = (const bf16*)(ws + WS_KN); const bf16* KPE = (const bf16*)(ws + WS_KPEB); const bf16* VT = (const bf16*)(ws + WS_VT);
    const bf16* Z = (const bf16*)(ws + WS_Z); bf16* G = (bf16*)(ws + WS_G);
    LAS unsigned char* Ks = F.lds; LAS unsigned char* Vs = F.lds + AT_KBYTES;
    const int lane = lane_id(), r32 = lane & 31, hi = lane >> 5, tid = F.wave * 64 + lane;
    const int qpos = qb * 256 + F.wave * 32 + r32; const size_t qrow = (size_t)b * SEQ + qpos;
    bf16x8 qf[12];
#pragma unroll
    for (int s = 0; s < 12; ++s) qf[s] = *(const bf16x8*)(Q + qrow * 3072 + hd * 192 + 16 * s + 8 * hi);
    f32x16 o[4];
#pragma unroll
    for (int d = 0; d < 4; ++d)
#pragma unroll
        for (int r = 0; r < 16; ++r) o[d][r] = 0.f;
    float mrow = -1e30f, lrow = 0.f;
    const int ntiles = 4 * qb + 4, wq0 = qb * 256 + F.wave * 32;
    v4u pk_[3], pv_[2];
#define AT_FETCH(kt_) do { const size_t krow0 = (size_t)b * SEQ + (kt_) * 64; \
        _Pragma("unroll") for (int i = 0; i < 3; ++i) { const int c = tid + 512 * i, key = c / 24, ch = c % 24; \
            pk_[i] = ch < 16 ? *(const v4u*)(KN + (krow0 + key) * 2048 + hd * 128 + ch * 8) : *(const v4u*)(KPE + (krow0 + key) * 64 + (ch - 16) * 8); } \
        _Pragma("unroll") for (int i = 0; i < 2; ++i) { const int c = tid + 512 * i, d = c >> 3, ch = c & 7; pv_[i] = *(const v4u*)(VT + (size_t)(hd * 128 + d) * MP + krow0 + ch * 8); } } while (0)
    AT_FETCH(0);
    for (int kt = 0; kt < ntiles; ++kt) {
        __syncthreads();
#pragma unroll
        for (int i = 0; i < 3; ++i) { const int c = tid + 512 * i, key = c / 24, ch = c % 24; *(LAS v4u*)(Ks + key * AT_KP + ch * 16) = pk_[i]; }
#pragma unroll
        for (int i = 0; i < 2; ++i) { const int c = tid + 512 * i, d = c >> 3, ch = c & 7; *(LAS v2u*)(Vs + d * AT_VP + ch * 16) = (v2u){pv_[i].x, pv_[i].y}; *(LAS v2u*)(Vs + d * AT_VP + ch * 16 + 8) = (v2u){pv_[i].z, pv_[i].w}; }
        __syncthreads();
        if (kt + 1 < ntiles) AT_FETCH(kt + 1);
        if (kt * 64 > wq0 + 31) continue;
        const LAS unsigned char* Kc = Ks; const LAS unsigned char* Vc = Vs;
        f32x16 s0, s1;
#pragma unroll
        for (int r = 0; r < 16; ++r) { s0[r] = 0.f; s1[r] = 0.f; }
#pragma unroll
        for (int s = 0; s < 12; ++s) { const bf16x8 a0 = *(const LAS bf16x8*)(Kc + r32 * AT_KP + (16 * s + 8 * hi) * 2), a1 = *(const LAS bf16x8*)(Kc + (32 + r32) * AT_KP + (16 * s + 8 * hi) * 2);
            s0 = __builtin_amdgcn_mfma_f32_32x32x16_bf16(a0, qf[s], s0, 0, 0, 0); s1 = __builtin_amdgcn_mfma_f32_32x32x16_bf16(a1, qf[s], s1, 0, 0, 0); }
        if (kt * 64 + 63 > wq0) {
#pragma unroll
            for (int r = 0; r < 16; ++r) { const int key = kt * 64 + crow(r, hi); if (key > qpos) s0[r] = -__builtin_inff(); if (key + 32 > qpos) s1[r] = -__builtin_inff(); } }
        float tmax = s0[0];
#pragma unroll
        for (int r = 1; r < 16; ++r) tmax = fmaxf(tmax, s0[r]);
#pragma unroll
        for (int r = 0; r < 16; ++r) tmax = fmaxf(tmax, s1[r]);
        tmax = xor32_max(tmax);
        const float mnew = fmaxf(mrow, tmax), alpha = __builtin_amdgcn_exp2f(mrow - mnew); mrow = mnew;
        float ps = 0.f;
#pragma unroll
        for (int r = 0; r < 16; ++r) { s0[r] = __builtin_amdgcn_exp2f(s0[r] - mnew); s1[r] = __builtin_amdgcn_exp2f(s1[r] - mnew); ps += s0[r] + s1[r]; }
        lrow = lrow * alpha + ps;
        if (__builtin_amdgcn_ballot_w64(alpha != 1.0f) != 0ull) {
#pragma unroll
            for (int d = 0; d < 4; ++d)
#pragma unroll
                for (int r = 0; r < 16; ++r) o[d][r] *= alpha; }
        bf16x8 pb[4];
        pb[0] = pack8f(s0[0], s0[1], s0[2], s0[3], s0[4], s0[5], s0[6], s0[7]); pb[1] = pack8f(s0[8], s0[9], s0[10], s0[11], s0[12], s0[13], s0[14], s0[15]);
        pb[2] = pack8f(s1[0], s1[1], s1[2], s1[3], s1[4], s1[5], s1[6], s1[7]); pb[3] = pack8f(s1[8], s1[9], s1[10], s1[11], s1[12], s1[13], s1[14], s1[15]);
#pragma unroll
        for (int ks = 0; ks < 4; ++ks)
#pragma unroll
            for (int d = 0; d < 4; ++d) { const LAS unsigned char* vp = Vc + (32 * d + r32) * AT_VP + (16 * ks + 4 * hi) * 2;
                const v2u lo = *(const LAS v2u*)vp, hi2 = *(const LAS v2u*)(vp + 16); const v4u av = (v4u){lo.x, lo.y, hi2.x, hi2.y};
                o[d] = __builtin_amdgcn_mfma_f32_32x32x16_bf16(__builtin_bit_cast(bf16x8, av), pb[ks], o[d], 0, 0, 0); }
    }
#undef AT_FETCH
    lrow = xor32_sum(lrow); const float inv = 1.0f / lrow;
#pragma unroll
    for (int d = 0; d < 4; ++d)
#pragma unroll
        for (int rg = 0; rg < 4; ++rg) { const int dd = 32 * d + 8 * rg + 4 * hi; const size_t off = qrow * 2048 + hd * 128 + dd;
            const v2u zz = *(const v2u*)(Z + off); const float z0 = bflo(zz.x), z1 = bfhi(zz.x), z2 = bflo(zz.y), z3 = bfhi(zz.y);
            v2u w; w.x = pk2(o[d][4 * rg] * inv * (z0 * sigmoidf_(z0)), o[d][4 * rg + 1] * inv * (z1 * sigmoidf_(z1))); w.y = pk2(o[d][4 * rg + 2] * inv * (z2 * sigmoidf_(z2)), o[d][4 * rg + 3] * inv * (z3 * sigmoidf_(z3)));
            *(v2u*)(G + off) = w; }
}
__device__ __forceinline__ void b2a_attn_prompt(Frame& F) {
    const int vcu = (F.G % 8 == 0) ? (F.bid % 8) * (F.G / 8) + F.bid / 8 : F.bid;
    for (int u = vcu; u < BATCH * B_HEADS * 4; u += F.G) { const int bh = u >> 2, qp = u & 3;
        for (int hf = 0; hf < 2; ++hf) attn_unit(F, bh >> 4, bh & 15, hf ? qp : 7 - qp); }
    __syncthreads();
}

constexpr int DT_P = 656;
typedef short v4i16_t __attribute__((ext_vector_type(4)));
__device__ __forceinline__ void b2b_attn_sample(Frame& F, cargs a) {
    unsigned char* ws = F.ws; const float* cckv = (const float*)a->in[4]; const float* ckpe = (const float*)a->in[5]; const int* ptab = (const int*)a->in[6];
    const bf16* QA = (const bf16*)(ws + WS_QABS); float* OP = (float*)(ws + WS_OPART); float* ML = (float*)(ws + WS_ML);
    LAS unsigned char* T = F.lds;
    F.lane = lane_id();
    const int lane = F.lane, hcol = lane & 15, g = lane >> 4, tid = F.wave * 64 + lane, q4 = (lane & 15) >> 2, p4 = lane & 3;
    const bf16* Q = (const bf16*)(ws + WS_Q); const float* wuk = (const float*)a->in[28]; bf16* QAg = (bf16*)(ws + WS_QABS);
    LAS bf16* QAl = (LAS bf16*)(F.lds + 49152);
    for (int hu = F.bid; hu < DEC_BATCH * 2; hu += F.G) for (int si = 0; si < 4; ++si) { const int b = hu >> 1, sp = (hu & 1) * 4 + si;
      if (si == 0) {
        __syncthreads();
        for (int hh = 0; hh < 2; ++hh) { const int hd = 2 * F.wave + hh; const bf16* qn = Q + (size_t)(MP + b) * 3072 + hd * 192;
            float acc[4] = {0.f, 0.f, 0.f, 0.f};
            for (int n = 0; n < 128; n += 4) { const v2u qu = *(const v2u*)(qn + n); const f32x4 q4 = (f32x4){bflo(qu.x), bfhi(qu.x), bflo(qu.y), bfhi(qu.y)};
#pragma unroll
                for (int cc = 0; cc < 4; ++cc) { const f32x4 w4 = *(const f32x4*)(wuk + (size_t)(4 * lane + cc) * 2048 + hd * 128 + n); acc[cc] += (q4.x * w4.x + q4.y * w4.y) + (q4.z * w4.z + q4.w * w4.w); } }
            const v2u w = (v2u){pk2(acc[0], acc[1]), pk2(acc[2], acc[3])}; *(LAS v2u*)(QAl + hd * 320 + 4 * lane) = w;
            const bf16 rp = qn[128 + 2 * (lane & 31) + (lane >> 5)]; QAl[hd * 320 + 256 + lane] = rp;
            if ((hu & 1) == 0) { *(v2u*)(QAg + (size_t)(b * 16 + hd) * 320 + 4 * lane) = w; QAg[(size_t)(b * 16 + hd) * 320 + 256 + lane] = rp; } }
        __syncthreads(); }
        bf16x8 qf[10];
#pragma unroll
        for (int s = 0; s < 10; ++s) qf[s] = *(const LAS bf16x8*)(QAl + hcol * 320 + 32 * s + 8 * g);
        f32x4 o[2]; o[0] = (f32x4){0.f, 0.f, 0.f, 0.f}; o[1] = o[0]; float mrow = -1e30f, lrow = 0.f;
        f32x4 pf_[10];
#define DT_FETCH(t_) do { const int pp = ptab[b * NPAGES + sp * 8 + ((t_) >> 1)], tok0 = ((t_) & 1) * 64; \
            _Pragma("unroll") for (int i = 0; i < 10; ++i) { const int c = tid + 512 * i, key = c / 80, ch = c % 80; const size_t tk = (size_t)pp * PAGE + tok0 + key; \
                pf_[i] = ch < 64 ? *(const f32x4*)(cckv + tk * 256 + ch * 4) : *(const f32x4*)(ckpe + tk * 64 + (ch - 64) * 4); } } while (0)
        DT_FETCH(0);
        for (int t = 0; t < 16; ++t) {
            __syncthreads();
#pragma unroll
            for (int i = 0; i < 10; ++i) { const int c = tid + 512 * i, key = c / 80, ch = c % 80; *(LAS v2u*)(T + key * DT_P + ch * 8) = (v2u){pk2(pf_[i].x, pf_[i].y), pk2(pf_[i].z, pf_[i].w)}; }
            __syncthreads();
            if (t + 1 < 16) DT_FETCH(t + 1);
            f32x4 sc[4];
#pragma unroll
            for (int kg = 0; kg < 4; ++kg) { sc[kg] = (f32x4){0.f, 0.f, 0.f, 0.f};
#pragma unroll
                for (int s = 0; s < 10; ++s) { const bf16x8 kf = *(const LAS bf16x8*)(T + (16 * kg + hcol) * DT_P + (32 * s + 8 * g) * 2);
                    sc[kg] = __builtin_amdgcn_mfma_f32_16x16x32_bf16(kf, qf[s], sc[kg], 0, 0, 0); } }
            float tmax = sc[0][0];
#pragma unroll
            for (int kg = 0; kg < 4; ++kg)
#pragma unroll
                for (int r = 0; r < 4; ++r) tmax = fmaxf(tmax, sc[kg][r]);
            tmax = fmaxf(tmax, swz_xor<16>(tmax)); tmax = xor32_max(tmax);
            const float mnew = fmaxf(mrow, tmax), alpha = __builtin_amdgcn_exp2f(mrow - mnew); mrow = mnew;
            float ps = 0.f;
#pragma unroll
            for (int kg = 0; kg < 4; ++kg)
#pragma unroll
                for (int r = 0; r < 4; ++r) { sc[kg][r] = __builtin_amdgcn_exp2f(sc[kg][r] - mnew); ps += sc[kg][r]; }
            lrow = lrow * alpha + ps; o[0] *= alpha; o[1] *= alpha;
#pragma unroll
            for (int kk = 0; kk < 2; ++kk) { const bf16x8 pbf = pack8f(sc[2 * kk][0], sc[2 * kk][1], sc[2 * kk][2], sc[2 * kk][3], sc[2 * kk + 1][0], sc[2 * kk + 1][1], sc[2 * kk + 1][2], sc[2 * kk + 1][3]);
#pragma unroll
                for (int ci = 0; ci < 2; ++ci) { const int cb = 2 * F.wave + ci; LAS unsigned char* ap = T + (32 * kk + 4 * g + q4) * DT_P + (16 * cb + 4 * p4) * 2;
                    const s16x4 lo = __builtin_bit_cast(s16x4, __builtin_amdgcn_ds_read_tr16_b64_v4i16((LAS v4i16_t*)ap)), hi2 = __builtin_bit_cast(s16x4, __builtin_amdgcn_ds_read_tr16_b64_v4i16((LAS v4i16_t*)(ap + 16 * DT_P)));
                    const bf16x8 av = (bf16x8){lo[0], lo[1], lo[2], lo[3], hi2[0], hi2[1], hi2[2], hi2[3]};
                    o[ci] = __builtin_amdgcn_mfma_f32_16x16x32_bf16(av, pbf, o[ci], 0, 0, 0); } }
        }
#undef DT_FETCH
        lrow += swz_xor<16>(lrow); lrow = xor32_sum(lrow);
        const size_t pb_ = (size_t)(b * 8 + sp) * 16 + hcol;
#pragma unroll
        for (int ci = 0; ci < 2; ++ci) *(f32x4*)(OP + pb_ * 256 + 16 * (2 * F.wave + ci) + 4 * g) = o[ci];
        if (F.wave == 0 && g == 0) { ML[pb_ * 2] = mrow; ML[pb_ * 2 + 1] = lrow; }
    }
    __syncthreads();
}
__device__ __forceinline__ void b2c_combine(Frame& F, cargs a) {
    unsigned char* ws = F.ws; const bf16* QA = (const bf16*)(ws + WS_QABS); const float* OP = (const float*)(ws + WS_OPART); const float* ML = (const float*)(ws + WS_ML);
    const float* wuv = (const float*)a->in[29]; const bf16* Z = (const bf16*)(ws + WS_Z); bf16* G = (bf16*)(ws + WS_G);
    LAS float* scr = (LAS float*)(F.lds + F.wave * 1024);
    for (int it = F.gw; it < DEC_BATCH * B_HEADS; it += F.NGW) { const int b = it >> 4, hd = it & 15; const int lane = F.lane;
        const float* cn = F.out + O_CKVS + (size_t)b * 256; const float* kn = F.out + O_KPES + (size_t)b * 64; const bf16* qa = QA + (size_t)it * 320;
        const f32x4 c4 = *(const f32x4*)(cn + 4 * lane); const v2u qv = *(const v2u*)(qa + 4 * lane);
        float sn = (bflo(qv.x) * c4.x + bfhi(qv.x) * c4.y) + (bflo(qv.y) * c4.z + bfhi(qv.y) * c4.w);
        sn += __builtin_bit_cast(float, (unsigned)qa[256 + lane] << 16) * kn[lane];
        sn = wave_sum(sn);
        float ms[8], ls[8], M = sn;
#pragma unroll
        for (int s = 0; s < 8; ++s) { ms[s] = ML[((size_t)(b * 8 + s) * 16 + hd) * 2]; ls[s] = ML[((size_t)(b * 8 + s) * 16 + hd) * 2 + 1]; M = fmaxf(M, ms[s]); }
        const float en = __builtin_amdgcn_exp2f(sn - M); float L = en; f32x4 acc = c4 * en;
#pragma unroll
        for (int s = 0; s < 8; ++s) { const float e = __builtin_amdgcn_exp2f(ms[s] - M); L += e * ls[s]; acc += *(const f32x4*)(OP + ((size_t)(b * 8 + s) * 16 + hd) * 256 + 4 * lane) * e; }
        acc *= 1.0f / L;
        *(LAS f32x4*)(scr + 4 * lane) = acc; LDS_WAIT(); asm volatile("" ::: "memory");
        f32x2 ov = (f32x2){0.f, 0.f};
        for (int c = 0; c < 256; ++c) { const float ol = scr[c]; ov += *(const f32x2*)(wuv + (size_t)c * 2048 + hd * 128 + 2 * lane) * ol; }
        const size_t off = (size_t)(MP + b) * 2048 + hd * 128 + 2 * lane; const unsigned zz = *(const unsigned*)(Z + off); const float z0 = bflo(zz), z1 = bfhi(zz);
        *(unsigned*)(G + off) = pk2(ov.x * (z0 * sigmoidf_(z0)), ov.y * (z1 * sigmoidf_(z1)));
        LDS_WAIT(); asm volatile("" ::: "memory");
    }
}

#ifndef MK_SPLIT
#define MK_SPLIT 0
#endif
#ifndef MK_DIAG
#define MK_DIAG 0
#endif
constexpr int NPHASES = 1 + 4 + 5 + 7 + 6 + 1 + (MK_DIAG ? 1 : 0);
#define PH_BEGIN if (ph >= lo && ph < hi) { cargs ap = (cargs)__builtin_amdgcn_kernarg_segment_ptr(); asm volatile("" : "+s"(ap)); Frame F = make_frame(ap, wave0, (LAS unsigned char*)lds); unsigned char* ws = F.ws;
#define PH_END } if (ph >= lo && ph + 1 < hi) xcd_barrier(bar); ++ph;
typedef pg8::StaticOrder SO;
#define GEMM_B(ACT_, A_, Bt_, M_, N_, K_, O_, ldc_, nvalid_, nstore_) do { pg8::Gemm g_{(const pg8::bf16_t*)(A_), (const pg8::bf16_t*)(Bt_), (M_), (N_), (K_)}; SO S_; S_.init((M_), (N_), F.G, F.bid); \
    pg8::EpiB<ACT_> E_{(pg8::bf16_t*)(O_), (ldc_), (nvalid_), (nstore_)}; pg8::gemm_phase<pg8::EpiB<ACT_>, SO, true, true>(F.lds, g_, S_, E_, F.wave); } while (0)
#define GEMM_F(ACT_, HB_, HBI_, A_, Bt_, M_, N_, K_, O_, base_, bias_, ldc_, nstore_) do { int kk_ = (K_); asm volatile("" : "+s"(kk_)); pg8::Gemm g_{(const pg8::bf16_t*)(A_), (const pg8::bf16_t*)(Bt_), (M_), (N_), kk_}; SO S_; S_.init((M_), (N_), F.G, F.bid); \
    pg8::EpiF<ACT_, HB_, HBI_> E_{(float*)(O_), (const float*)(base_), (const float*)(bias_), (ldc_), (nstore_)}; pg8::gemm_phase<pg8::EpiF<ACT_, HB_, HBI_>, SO, true, true>(F.lds, g_, S_, E_, F.wave); } while (0)

#define OUTPROJ(Wt_, base_) do { \
    { pg8::Gemm g_{(const pg8::bf16_t*)(ws + WS_G), (const pg8::bf16_t*)(Wt_), MT, 1024, 256, 2048}; pg8::SliceOrder S_{MP / 256, 4, 8, F.G, F.bid, 512}; pg8::EpiFA E_{(float*)(ws + WS_X), 1024, MP + DEC_BATCH}; \
      pg8::gemm_phase<pg8::EpiFA, pg8::SliceOrder, true, true>(F.lds, g_, S_, E_, F.wave); } \
    GEMM_F(0, true, false, ws + WS_G, (Wt_), MP, 1024, 2048, ws + WS_X, (base_), nullptr, 1024, 1024); } while (0)
__global__ void __launch_bounds__(NTHR, 2) mk_fwd(Args args) {
    extern __shared__ __attribute__((aligned(16))) unsigned char lds[];
    const int wave0 = __builtin_amdgcn_readfirstlane(threadIdx.x >> 6);
    for (int u = threadIdx.x; u < (LDS_BYTES - LDSCTL_OFF) / 4; u += NTHR) ((LAS unsigned*)(lds + LDSCTL_OFF))[u] = 0u;
    __syncthreads();
    XcdBarrier bar = xcd_barrier_post((unsigned*)(args.ws + WS_CTL) + CW_BAR + args.li * XCD_BAR_WORDS, (volatile LAS unsigned*)((LAS unsigned char*)lds + LDSCTL_OFF), (unsigned)wave0);
    int ph = 0; const int lo = args.ph_lo, hi = args.ph_hi;

    PH_BEGIN p0_prologue(F, ap); __syncthreads(); a1_prepass(F, ap, 0); PH_END

    for (int l = 0; l < 2; ++l) {
        if (l > 0) { PH_BEGIN a1_prepass(F, ap, l); PH_END }
        PH_BEGIN
            { static_assert(AM_STRIDE == (size_t)130 * 256 * 1024 * 2, "A-operand buffers sit 130 row panels apart");
              pg8::Gemm g_{(const pg8::bf16_t*)(ws + WS_AM), (const pg8::bf16_t*)(ws + WS_WIN + (size_t)l * WIN_L), MT, 2048, 1024}; pg8::GroupOrderA2 S_; S_.init(MT, F.G, F.bid, l ? 7 : 6);
              static_assert(WS_K == WS_R + BIGB && WS_V0 == WS_R + 2 * BIGB && WS_V1 == WS_R + 3 * BIGB && WS_Z == WS_R + 4 * BIGB && WS_LA == WS_LW + 9 * MiB && WS_LV == WS_LW + 18 * MiB, "output buffers are equally spaced");
              pg8::EpiA2 E_{(pg8::bf16_t*)(ws + WS_R), BIGB / 2, 2 + l, (pg8::bf16_t*)(ws + WS_LW), 9 * MiB / 2};
              pg8::gemm_phase<pg8::EpiA2, pg8::GroupOrderA2, true, true>(F.lds, g_, S_, E_, F.wave); }
        PH_END
        PH_BEGIN
#define GEMM_BA(ACT_, A_, Bt_, O_, bias_) do { int kk_ = 128; asm volatile("" : "+s"(kk_)); pg8::Gemm g_{(const pg8::bf16_t*)(A_), (const pg8::bf16_t*)(Bt_), MT, 2048, kk_}; SO S_; S_.init(MT, 2048, F.G, F.bid); \
    pg8::EpiBA<ACT_> E_{(pg8::bf16_t*)(O_), (const float*)(bias_)}; pg8::gemm_phase<pg8::EpiBA<ACT_>, SO, true, true>(F.lds, g_, S_, E_, F.wave); } while (0)
            GEMM_BA(4, ws + WS_LW, ws + WS_W2 + (size_t)l * (MiB / 2), ws + WS_WD, (const float*)ap->in[10] + l * 2048);
            GEMM_BA(3, ws + WS_LA, ws + WS_W2 + (size_t)(2 + l) * (MiB / 2), ws + WS_IA, (const float*)ap->in[13] + l * 2048);
            if (l) GEMM_BA(3, ws + WS_LV, ws + WS_W2 + (size_t)4 * (MiB / 2), ws + WS_VG, (const float*)ap->in[16]);
#undef GEMM_BA
        PH_END
        PH_BEGIN a5_fused(F, ap, l); PH_END
        PH_BEGIN
            OUTPROJ(ws + WS_WO + (size_t)l * 4 * MiB, l == 0 ? (const void*)ap->in[0] : (const void*)(ws + WS_X));
        PH_END
    }

#define MLA_INPROJ(l_, A_) do { \
        { pg8::Gemm g_{(const pg8::bf16_t*)(A_), (const pg8::bf16_t*)(ws + WS_WQ + (size_t)(l_) * MiB), MT, 512, 1024}; SO S_; S_.init(MT, 512, F.G, F.bid); \
          pg8::EpiCQ E_{(pg8::bf16_t*)(ws + WS_CQ), (const float*)ap->in[32] + (l_) * 384, (float*)(ws + WS_CTL + CW_RSQ + (size_t)(l_) * 262144)}; pg8::gemm_phase<pg8::EpiCQ, SO, true, true>(F.lds, g_, S_, E_, F.wave); } \
        GEMM_B(0, (A_), ws + WS_WZ + (size_t)(l_) * 4 * MiB, MT, 2048, 1024, ws + WS_Z, 2048, 2048, 2048); } while (0)
#define MLA_QUP(l_) do { pg8::Gemm g_{(const pg8::bf16_t*)(ws + WS_CQ), (const pg8::bf16_t*)(ws + WS_WUQ + (size_t)(l_) * (5 * MiB / 2)), MT, 3072, 384}; SO S_; S_.init(MT, 3072, F.G, F.bid); \
        pg8::EpiQ E_{(pg8::bf16_t*)(ws + WS_Q), (const float*)(ws + WS_ROPE), ATTN_SCALE * LOG2E, MP, SEQ, (const float*)(ws + WS_CTL + CW_RSQ + (size_t)(l_) * 262144)}; pg8::gemm_phase<pg8::EpiQ, SO, true, true>(F.lds, g_, S_, E_, F.wave); } while (0)
    for (int l = 0; l < 2; ++l) {
        PH_BEGIN if (l == 0) norm2_rows_bf16(F, (const float*)(ws + WS_X), (const float*)ap->in[25], (bf16*)(ws + WS_AM), (const float*)ap->in[30], (bf16*)(ws + WS_AM + AM_STRIDE));
                 else norm_rows_bf16(F, (const float*)(ws + WS_X), (const float*)ap->in[30] + l * 1024, (bf16*)(ws + WS_AM)); PH_END
        PH_BEGIN if (l == 0) GEMM_F(0, false, false, ws + WS_AM, ws + WS_WDKV, MT, 512, 1024, ws + WS_KVR, nullptr, nullptr, 320, 320);
                 MLA_INPROJ(l, ws + WS_AM + (l == 0 ? AM_STRIDE : 0)); PH_END
        if (l == 0) { PH_BEGIN b0c_kvpost(F, ap); PH_END }
        PH_BEGIN if (l == 0) { GEMM_B(0, ws + WS_CKVB, ws + WS_WUK, MP, 2048, 256, ws + WS_KN, 2048, 2048, 2048);
                               GEMM_B(0, ws + WS_WUV, ws + WS_CKVB, 2048, MP, 256, ws + WS_VT, MP, MP, MP); }
                 MLA_QUP(l); PH_END
        PH_BEGIN b2a_attn_prompt(F); b2b_attn_sample(F, ap); PH_END
        PH_BEGIN b2c_combine(F, ap); PH_END
        PH_BEGIN OUTPROJ(ws + WS_WBO + (size_t)l * 4 * MiB, ws + WS_X); PH_END
    }
#undef MLA_INPROJ
#undef MLA_QUP

    PH_BEGIN final_norm(F, ap); PH_END
#if MK_DIAG
    PH_BEGIN
        const size_t offs[11] = {O_YP, O_YS, O_WKVP, O_SHP, O_CKVP, O_KPEP, O_WKVS, O_SHS, O_CKVS, O_KPES, O_END};
        for (int k = 1; k < 10; ++k) { const float f = 1.0f + sqrtf(2e-4f * (float)k);
            for (size_t i = offs[k] + (size_t)(F.bid * NTHR + F.wave * 64 + F.lane); i < offs[k + 1]; i += (size_t)F.NT) F.out[i] *= f; }
    PH_END
#endif
}

extern "C" void kernel_launch(void* const* d_in, const int* in_sizes, int n_in, void* d_out, int out_size, void* d_ws, size_t ws_size, hipStream_t stream) {
    static int grid = 0;
    if (grid == 0) {
        if (n_in != 36 || (size_t)out_size != O_END || ws_size < WS_NEED) { fprintf(stderr, "kernel_launch: unexpected sizes: n_in %d out %d (want %zu) ws %zu (need %zu)\n", n_in, out_size, (size_t)O_END, ws_size, (size_t)WS_NEED); grid = -1; return; }
        int dev = 0, cus = 0, per_cu = 0;
        if (hipGetDevice(&dev) != hipSuccess || hipDeviceGetAttribute(&cus, hipDeviceAttributeMultiprocessorCount, dev) != hipSuccess) { grid = -1; return; }
        if (hipFuncSetAttribute((const void*)mk_fwd, hipFuncAttributeMaxDynamicSharedMemorySize, LDS_BYTES) != hipSuccess) { fprintf(stderr, "kernel_launch: hipFuncSetAttribute failed\n"); grid = -1; return; }
        if (hipOccupancyMaxActiveBlocksPerMultiprocessor(&per_cu, (const void*)mk_fwd, NTHR, LDS_BYTES) != hipSuccess || per_cu < 1) fprintf(stderr, "kernel_launch: occupancy query reports %d\n", per_cu);
        (void)hipGetLastError();
        grid = cus;
    }
    if (grid < 0) return;
    if (hipMemsetAsync((char*)d_ws + WS_CTL, 0, CTL_ZERO_BYTES, stream) != hipSuccess) { fprintf(stderr, "kernel_launch: memset failed\n"); return; }
    Args a{};
    for (int i = 0; i < 36; ++i) a.in[i] = d_in[i];
    a.out = (float*)d_out; a.ws = (unsigned char*)d_ws;
#if MK_SPLIT
    for (int li = 0; li < NPHASES; ++li) { a.ph_lo = li; a.ph_hi = li + 1; a.li = li;
        hipLaunchKernelGGL(mk_fwd, dim3(grid), dim3(NTHR), LDS_BYTES, stream, a); }
#else
    a.ph_lo = 0; a.ph_hi = NPHASES; a.li = 0;
    hipLaunchKernelGGL(mk_fwd, dim3(grid), dim3(NTHR), LDS_BYTES, stream, a);
#endif
    const hipError_t le = hipPeekAtLastError();
    if (le != hipSuccess) fprintf(stderr, "kernel_launch: launch failed: %s\n", hipGetErrorName(le));
}
```

```cpp
#include <hip/hip_runtime.h>
#include <cstdio>
#include <cstdint>
namespace pg8 {
#define PG8_LAS __attribute__((address_space(3)))
typedef unsigned short bf16_t;
typedef short bf16x8 __attribute__((ext_vector_type(8)));
typedef float f32x4 __attribute__((ext_vector_type(4)));
typedef unsigned u32x4 __attribute__((ext_vector_type(4)));
constexpr int BM = 256, BK = 64, HALF = 128, HTB = HALF * BK * 2  , STAGE_BYTES = 8 * HTB, NXCD = 8, WGM = 8;

__host__ __device__ __forceinline__ int lds_byte(int r, int c) { const int st = (r >> 4) * 2 + (c >> 5), rr = r & 15, cc = c & 31, ob = rr * 64 + cc * 2; return st * 1024 + (ob ^ (((ob >> 9) & 1) << 5)); }
__host__ __device__ __forceinline__ void stage_rc(int b, int& R, int& C) { const int st = b / 1024, sb = b % 1024, swz = sb ^ (((sb >> 9) & 1) << 5); R = (st >> 1) * 16 + swz / 64; C = (st & 1) * 32 + (swz % 64) / 2; }
__host__ __device__ __forceinline__ int perm32(int rho) { const int n = rho >> 4, i = rho & 15; return 8 * (i >> 2) + 4 * n + (i & 3); }

struct Unit { int pm, pn; int ko; };
struct Gemm { const bf16_t* A; const bf16_t* Bt; int M, N, K; int ld; };

struct StaticOrder {
    int nM, nN, nwg, G, c;
    __host__ __device__ void init(int M, int N, int G_, int c_) { nM = M / BM; nN = N / BM; nwg = nM * nN; G = G_; c = c_; }
    __host__ __device__ bool next(int i, Unit& u) const {
        const long L = (long)i * G + c; if (L >= nwg) return false;
        int wgid = (int)L; { const int q = nwg / NXCD, r = nwg % NXCD, xcd = wgid % NXCD, off = wgid / NXCD; wgid = (xcd < r ? xcd * (q + 1) : r * (q + 1) + (xcd - r) * q) + off; }
        const int nig = WGM * nN, gid = wgid / nig, fm = gid * WGM, gsz = (nM - fm) < WGM ? (nM - fm) : WGM;
        u.pm = fm + ((wgid % nig) % gsz); u.pn = (wgid % nig) / gsz; u.ko = 0; return true;
    }
    __device__ __forceinline__ void a_ready(const Unit&) const {}
    __device__ __forceinline__ void done(const Unit&) const {}
};

__device__ __forceinline__ unsigned cvt_pk_bf16(float lo, float hi) { unsigned r; asm volatile("v_cvt_pk_bf16_f32 %0, %1, %2" : "=v"(r) : "v"(lo), "v"(hi)); return r; }
typedef float f32x2 __attribute__((ext_vector_type(2)));
__device__ __forceinline__ float act_apply(int ACT, float x) {
    if (ACT == 1) return 1.0f - 2.0f / (1.0f + __expf(2.0f * x));
    if (ACT == 2) return __expf(-0.6065306597126334f / (1.0f + __expf(-x)));
    if (ACT == 3) return 1.0f / (1.0f + __expf(-x));
    return x;
}
template <int ACT> struct EpiB {
    static constexpr bool PERM = true, AFTER_DRAIN = false;
    bf16_t* O; int ldc; int nvalid; int nstore;
    __device__ __forceinline__ void operator()(const f32x4 (&acc)[2][2][4][2], const Unit& u, int wr, int wc, int, int) const {
        int lane_; asm volatile("v_mbcnt_lo_u32_b32 %0, -1, 0\n\tv_mbcnt_hi_u32_b32 %0, -1, %0" : "=v"(lane_)); const int fr = lane_ & 15, fq = lane_ >> 4;
        const int row0 = u.pm * BM + wr * 64 + fr, col0 = u.pn * BM + wc * 32 + 8 * fq;
#pragma unroll
        for (int ai = 0; ai < 2; ++ai)
#pragma unroll
            for (int m = 0; m < 4; ++m) { bf16_t* rowp = O + (size_t)(row0 + ai * HALF + m * 16) * ldc + col0;
#pragma unroll
                for (int bj = 0; bj < 2; ++bj) { const int c = col0 + bj * HALF; if (c >= nstore) continue;
                    f32x4 v0 = acc[ai][bj][m][0], v1 = acc[ai][bj][m][1];
                    if (ACT != 0) {
#pragma unroll
                        for (int e = 0; e < 4; ++e) { v0[e] = act_apply(ACT, v0[e]); v1[e] = act_apply(ACT, v1[e]); } }
                    u32x4 w; w.x = cvt_pk_bf16(v0[0], v0[1]); w.y = cvt_pk_bf16(v0[2], v0[3]); w.z = cvt_pk_bf16(v1[0], v1[1]); w.w = cvt_pk_bf16(v1[2], v1[3]);
                    if (c >= nvalid) w = (u32x4){0u, 0u, 0u, 0u};
                    *(u32x4*)(rowp + bj * HALF) = w; } }
    }
};
template <int ACT, bool HAS_BASE, bool HAS_BIAS> struct EpiF {
    static constexpr bool PERM = false, AFTER_DRAIN = false;
    float* O; const float* base; const float* bias; int ldc; int nstore;
    __device__ __forceinline__ void operator()(const f32x4 (&acc)[2][2][4][2], const Unit& u, int wr, int wc, int, int) const {
        int lane_; asm volatile("v_mbcnt_lo_u32_b32 %0, -1, 0\n\tv_mbcnt_hi_u32_b32 %0, -1, %0" : "=v"(lane_)); const int fr = lane_ & 15, fq = lane_ >> 4;
        const int row0 = u.pm * BM + wr * 64 + fr, col0 = u.pn * BM + wc * 32 + 4 * fq;
        f32x4 bv[2][2];
#pragma unroll
        for (int bj = 0; bj < 2; ++bj)
#pragma unroll
            for (int n = 0; n < 2; ++n) bv[bj][n] = HAS_BIAS ? *(const f32x4*)(bias + col0 + bj * HALF + n * 16) : (f32x4){0.f, 0.f, 0.f, 0.f};
#pragma unroll
        for (int ai = 0; ai < 2; ++ai)
#pragma unroll
            for (int m = 0; m < 4; ++m) { const size_t off = (size_t)(row0 + ai * HALF + m * 16) * ldc + col0;
#pragma unroll
                for (int bj = 0; bj < 2; ++bj)
#pragma unroll
                    for (int n = 0; n < 2; ++n) { if (col0 + bj * HALF + n * 16 >= nstore) continue;
                        f32x4 v = acc[ai][bj][m][n] + bv[bj][n];
                        if (ACT != 0) {
#pragma unroll
                            for (int e = 0; e < 4; ++e) v[e] = act_apply(ACT, v[e]); }
                        if (HAS_BASE) v += *(const f32x4*)(base + off + bj * HALF + n * 16);
                        *(f32x4*)(O + off + bj * HALF + n * 16) = v; }
                if (m & 1) asm volatile("" ::: "memory"); }
    }
};

struct GroupOrder4 {
    StaticOrder so; int per;
    __device__ void init(int M, int N, int G_, int c_) { so.init(M, N, G_, c_); per = so.nwg; }
    __device__ bool next(int i, Unit& u) const {
        const long L = (long)i * so.G + so.c; if (L >= 4L * per) return false;
        const int gi = (int)(L / per); int wgid = (int)(L - (long)gi * per);
        { const int q = so.nwg / NXCD, r = so.nwg % NXCD, xcd = wgid % NXCD, off = wgid / NXCD; wgid = (xcd < r ? xcd * (q + 1) : r * (q + 1) + (xcd - r) * q) + off; }
        const int nig = WGM * so.nN, gid = wgid / nig, fm = gid * WGM, gsz = (so.nM - fm) < WGM ? (so.nM - fm) : WGM;
        u.pm = fm + ((wgid % nig) % gsz) + 130 * gi; u.pn = (wgid % nig) / gsz + 8 * gi; u.ko = 0; return true;
    }
    __device__ __forceinline__ void a_ready(const Unit&) const {}
    __device__ __forceinline__ void done(const Unit&) const {}
};
struct EpiB4 {
    static constexpr bool PERM = true, AFTER_DRAIN = false;
    bf16_t* O[4];
    __device__ __forceinline__ void operator()(const f32x4 (&acc)[2][2][4][2], const Unit& u, int wr, int wc, int, int) const {
        int lane_; asm volatile("v_mbcnt_lo_u32_b32 %0, -1, 0\n\tv_mbcnt_hi_u32_b32 %0, -1, %0" : "=v"(lane_)); const int fr = lane_ & 15, fq = lane_ >> 4;
        const int gi = u.pn >> 3; bf16_t* Ob = gi == 0 ? O[0] : gi == 1 ? O[1] : gi == 2 ? O[2] : O[3];
        const int row0 = (u.pm - 130 * gi) * BM + wr * 64 + fr, col0 = (u.pn & 7) * BM + wc * 32 + 8 * fq;
#pragma unroll
        for (int ai = 0; ai < 2; ++ai)
#pragma unroll
            for (int m = 0; m < 4; ++m) { bf16_t* rowp = Ob + (size_t)(row0 + ai * HALF + m * 16) * 2048 + col0;
#pragma unroll
                for (int bj = 0; bj < 2; ++bj) { const f32x4 v0 = acc[ai][bj][m][0], v1 = acc[ai][bj][m][1];
                    u32x4 w; w.x = cvt_pk_bf16(v0[0], v0[1]); w.y = cvt_pk_bf16(v0[2], v0[3]); w.z = cvt_pk_bf16(v1[0], v1[1]); w.w = cvt_pk_bf16(v1[2], v1[3]);
                    *(u32x4*)(rowp + bj * HALF) = w; } }
    }
};

struct EpiQ {
    static constexpr bool PERM = true, AFTER_DRAIN = false;
    bf16_t* O; const float* rope; float sc; int mp, seq; const float* rsq;
    __device__ __forceinline__ void operator()(const f32x4 (&acc)[2][2][4][2], const Unit& u, int wr, int wc, int, int) const {
        int lane_; asm volatile("v_mbcnt_lo_u32_b32 %0, -1, 0\n\tv_mbcnt_hi_u32_b32 %0, -1, %0" : "=v"(lane_)); const int fr = lane_ & 15, fq = lane_ >> 4;
        const int row0 = u.pm * BM + wr * 64 + fr, col0 = u.pn * BM + wc * 32 + 8 * fq;
#pragma unroll
        for (int ai = 0; ai < 2; ++ai)
#pragma unroll
            for (int m = 0; m < 4; ++m) { const int row = row0 + ai * HALF + m * 16; const int p = row < mp ? (row & (seq - 1)) : seq; bf16_t* rowp = O + (size_t)row * 3072 + col0; const float rsc = sc / sqrtf(rsq[row] * (1.0f / 384.0f) + 1e-6f);
#pragma unroll
                for (int bj = 0; bj < 2; ++bj) { const int c = col0 + bj * HALF, within = c % 192; f32x4 v0 = acc[ai][bj][m][0], v1 = acc[ai][bj][m][1];
                    if (within >= 128) { const float* t = rope + (size_t)(p * 32 + ((within - 128) >> 1)) * 2; const f32x4 t0 = *(const f32x4*)t, t1 = *(const f32x4*)(t + 4);
                        const f32x4 a0 = v0, a1 = v1;
                        v0[0] = a0[0] * t0[0] - a0[1] * t0[1]; v0[1] = a0[1] * t0[0] + a0[0] * t0[1]; v0[2] = a0[2] * t0[2] - a0[3] * t0[3]; v0[3] = a0[3] * t0[2] + a0[2] * t0[3];
                        v1[0] = a1[0] * t1[0] - a1[1] * t1[1]; v1[1] = a1[1] * t1[0] + a1[0] * t1[1]; v1[2] = a1[2] * t1[2] - a1[3] * t1[3]; v1[3] = a1[3] * t1[2] + a1[2] * t1[3]; }
                    v0 = v0 * rsc; v1 = v1 * rsc;
                    u32x4 w; w.x = cvt_pk_bf16(v0[0], v0[1]); w.y = cvt_pk_bf16(v0[2], v0[3]); w.z = cvt_pk_bf16(v1[0], v1[1]); w.w = cvt_pk_bf16(v1[2], v1[3]);
                    *(u32x4*)(rowp + bj * HALF) = w; } }
    }
};

struct EpiCQ {
    static constexpr bool PERM = true, AFTER_DRAIN = false;
    bf16_t* O; const float* wq; float* rsq;
    __device__ __forceinline__ void operator()(const f32x4 (&acc)[2][2][4][2], const Unit& u, int wr, int wc, int, int) const {
        int lane_; asm volatile("v_mbcnt_lo_u32_b32 %0, -1, 0\n\tv_mbcnt_hi_u32_b32 %0, -1, %0" : "=v"(lane_)); const int fr = lane_ & 15, fq = lane_ >> 4;
        const int row0 = u.pm * BM + wr * 64 + fr, col0 = u.pn * BM + wc * 32 + 8 * fq;
#pragma unroll
        for (int ai = 0; ai < 2; ++ai)
#pragma unroll
            for (int m = 0; m < 4; ++m) { const int row = row0 + ai * HALF + m * 16; float ss = 0.f;
#pragma unroll
                for (int bj = 0; bj < 2; ++bj) { const int c = col0 + bj * HALF; if (c >= 384) continue;
                    const f32x4 v0 = acc[ai][bj][m][0], v1 = acc[ai][bj][m][1], w0 = *(const f32x4*)(wq + c), w1 = *(const f32x4*)(wq + c + 4);
                    ss += ((v0[0] * v0[0] + v0[1] * v0[1]) + (v0[2] * v0[2] + v0[3] * v0[3])) + ((v1[0] * v1[0] + v1[1] * v1[1]) + (v1[2] * v1[2] + v1[3] * v1[3]));
                    u32x4 w; w.x = cvt_pk_bf16(v0[0] * w0[0], v0[1] * w0[1]); w.y = cvt_pk_bf16(v0[2] * w0[2], v0[3] * w0[3]); w.z = cvt_pk_bf16(v1[0] * w1[0], v1[1] * w1[1]); w.w = cvt_pk_bf16(v1[2] * w1[2], v1[3] * w1[3]);
                    *(u32x4*)(O + (size_t)row * 384 + c) = w; }
                ss += __builtin_bit_cast(float, __builtin_amdgcn_ds_swizzle(__builtin_bit_cast(int, ss), 0x1F | (16 << 10)));
                { float a = ss, b = ss; asm volatile("s_nop 1\n\tv_permlane32_swap_b32 %0, %1\n\ts_nop 1" : "+v"(a), "+v"(b)); ss = a + b; }
                if (fq == 0 && u.pn < 2) atomicAdd(rsq + row, ss); }
    }
};

struct SliceOrder {
    int pm, nN, nS, G, c, kbytes;
    __device__ bool next(int i, Unit& u) const { const int L = i * G + c; if (L >= nN * nS) return false; u.pm = pm; u.pn = L % nN; u.ko = (L / nN) * kbytes; return true; }
    __device__ __forceinline__ void a_ready(const Unit&) const {}
    __device__ __forceinline__ void done(const Unit&) const {}
};
struct EpiFA {
    static constexpr bool PERM = false, AFTER_DRAIN = false;
    float* O; int ldc, rows;
    __device__ __forceinline__ void operator()(const f32x4 (&acc)[2][2][4][2], const Unit& u, int wr, int wc, int, int) const {
        int lane_; asm volatile("v_mbcnt_lo_u32_b32 %0, -1, 0\n\tv_mbcnt_hi_u32_b32 %0, -1, %0" : "=v"(lane_)); const int fr = lane_ & 15, fq = lane_ >> 4;
        const int row0 = u.pm * BM + wr * 64 + fr, col0 = u.pn * BM + wc * 32 + 4 * fq;
#pragma unroll
        for (int ai = 0; ai < 2; ++ai)
#pragma unroll
            for (int m = 0; m < 4; ++m) { const int row = row0 + ai * HALF + m * 16; if (row >= rows) continue; float* rp = O + (size_t)row * ldc + col0;
#pragma unroll
                for (int bj = 0; bj < 2; ++bj)
#pragma unroll
                    for (int n = 0; n < 2; ++n) { const f32x4 v = acc[ai][bj][m][n];
#pragma unroll
                        for (int e = 0; e < 4; ++e) atomicAdd(rp + bj * HALF + n * 16 + e, v[e]); } }
    }
};

template <int ACT> struct EpiBA {
    static constexpr bool PERM = true, AFTER_DRAIN = false;
    bf16_t* O; const float* bias;
    __device__ __forceinline__ void operator()(const f32x4 (&acc)[2][2][4][2], const Unit& u, int wr, int wc, int, int) const {
        int lane_; asm volatile("v_mbcnt_lo_u32_b32 %0, -1, 0\n\tv_mbcnt_hi_u32_b32 %0, -1, %0" : "=v"(lane_)); const int fr = lane_ & 15, fq = lane_ >> 4;
        const int row0 = u.pm * BM + wr * 64 + fr, col0 = u.pn * BM + wc * 32 + 8 * fq;
        f32x4 bv[2][2];
#pragma unroll
        for (int bj = 0; bj < 2; ++bj)
#pragma unroll
            for (int n = 0; n < 2; ++n) bv[bj][n] = *(const f32x4*)(bias + col0 + bj * HALF + 4 * n);
#pragma unroll
        for (int ai = 0; ai < 2; ++ai)
#pragma unroll
            for (int m = 0; m < 4; ++m) { bf16_t* rowp = O + (size_t)(row0 + ai * HALF + m * 16) * 2048 + col0;
#pragma unroll
                for (int bj = 0; bj < 2; ++bj) { f32x4 v0 = acc[ai][bj][m][0] + bv[bj][0], v1 = acc[ai][bj][m][1] + bv[bj][1];
#pragma unroll
                    for (int e = 0; e < 4; ++e) { const float s0 = __builtin_amdgcn_rcpf(1.0f + __builtin_amdgcn_exp2f(-1.4426950408889634f * v0[e])), s1 = __builtin_amdgcn_rcpf(1.0f + __builtin_amdgcn_exp2f(-1.4426950408889634f * v1[e]));
                        v0[e] = ACT == 4 ? -0.8750387749f * s0 : s0; v1[e] = ACT == 4 ? -0.8750387749f * s1 : s1; }
                    typedef __bf16 bf8n __attribute__((ext_vector_type(8))); typedef float f8n __attribute__((ext_vector_type(8)));
                    const u32x4 w = __builtin_bit_cast(u32x4, __builtin_convertvector((f8n){v0[0], v0[1], v0[2], v0[3], v1[0], v1[1], v1[2], v1[3]}, bf8n));
                    *(u32x4*)(rowp + bj * HALF) = w; } }
    }
};

struct GroupOrderA2 {
    StaticOrder so; int per, nG;
    __device__ void init(int M, int G_, int c_, int nG_) { so.init(M, 2048, G_, c_); per = so.nwg; nG = nG_; }
    __device__ bool next(int i, Unit& u) const {
        const long L = (long)i * so.G + so.c; u.ko = 0;
        if (L < 4L * per) { const int gi = (int)(L / per); int wgid = (int)(L - (long)gi * per);
            { const int q = so.nwg / NXCD, r = so.nwg % NXCD, xcd = wgid % NXCD, off = wgid / NXCD; wgid = (xcd < r ? xcd * (q + 1) : r * (q + 1) + (xcd - r) * q) + off; }
            const int nig = WGM * so.nN, gid = wgid / nig, fm = gid * WGM, gsz = (so.nM - fm) < WGM ? (so.nM - fm) : WGM;
            u.pm = fm + ((wgid % nig) % gsz) + 130 * gi; u.pn = (wgid % nig) / gsz + 8 * gi; return true; }
        const int Lp = (int)(L - 4L * per); if (Lp >= (nG - 4) * so.nM) return false;
        const int ge = Lp / so.nM, gi = 4 + ge; u.pm = Lp % so.nM + 130 * (gi == 6 ? 2 : gi); u.pn = 32 + ge; return true;
    }
    __device__ __forceinline__ void a_ready(const Unit&) const {}
    __device__ __forceinline__ void done(const Unit&) const {}
};
struct EpiA2 {
    static constexpr bool PERM = true, AFTER_DRAIN = false;
    bf16_t* Rb; size_t ostride; int vidx; bf16_t* Lb; size_t lstride;
    __device__ __forceinline__ void operator()(const f32x4 (&acc)[2][2][4][2], const Unit& u, int wr, int wc, int, int) const {
        int lane_; asm volatile("v_mbcnt_lo_u32_b32 %0, -1, 0\n\tv_mbcnt_hi_u32_b32 %0, -1, %0" : "=v"(lane_)); const int fr = lane_ & 15, fq = lane_ >> 4;
        if (u.pn < 32) { const int gi = u.pn >> 3; bf16_t* Ob = Rb + (size_t)(gi < 2 ? gi : (gi == 2 ? vidx : 4)) * ostride;
            const int row0 = (u.pm - 130 * gi) * BM + wr * 64 + fr, col0 = (u.pn & 7) * BM + wc * 32 + 8 * fq;
#pragma unroll
            for (int ai = 0; ai < 2; ++ai)
#pragma unroll
                for (int m = 0; m < 4; ++m) { bf16_t* rowp = Ob + (size_t)(row0 + ai * HALF + m * 16) * 2048 + col0;
#pragma unroll
                    for (int bj = 0; bj < 2; ++bj) { const f32x4 v0 = acc[ai][bj][m][0], v1 = acc[ai][bj][m][1];
                        u32x4 w; w.x = cvt_pk_bf16(v0[0], v0[1]); w.y = cvt_pk_bf16(v0[2], v0[3]); w.z = cvt_pk_bf16(v1[0], v1[1]); w.w = cvt_pk_bf16(v1[2], v1[3]);
                        *(u32x4*)(rowp + bj * HALF) = w; } }
        } else { const int ge = u.pn - 32, gi = 4 + ge; bf16_t* Ob = Lb + (size_t)ge * lstride; const int nvalid = ge == 2 ? 32 : 64;
            const int row0 = (u.pm - 130 * (gi == 6 ? 2 : gi)) * BM + wr * 64 + fr, c = wc * 32 + 8 * fq;
#pragma unroll
            for (int ai = 0; ai < 2; ++ai)
#pragma unroll
                for (int m = 0; m < 4; ++m) { f32x4 v0 = acc[ai][0][m][0], v1 = acc[ai][0][m][1];
                    if (ge == 0) {
#pragma unroll
                        for (int e = 0; e < 4; ++e) { v0[e] = 1.0f - 2.0f / (1.0f + __expf(2.0f * v0[e])); v1[e] = 1.0f - 2.0f / (1.0f + __expf(2.0f * v1[e])); } }
                    u32x4 w; w.x = cvt_pk_bf16(v0[0], v0[1]); w.y = cvt_pk_bf16(v0[2], v0[3]); w.z = cvt_pk_bf16(v1[0], v1[1]); w.w = cvt_pk_bf16(v1[2], v1[3]);
                    if (c >= nvalid) w = (u32x4){0u, 0u, 0u, 0u};
                    *(u32x4*)(Ob + (size_t)(row0 + ai * HALF + m * 16) * 128 + c) = w; }
        }
    }
};
template <class Epi, class Sched, bool ALIGN_EPI = false, bool SP2 = false>
__device__ __forceinline__ void gemm_phase(PG8_LAS unsigned char* lds, const Gemm g, const Sched& S, const Epi& E, const int wid) {
    int lane_; asm volatile("v_mbcnt_lo_u32_b32 %0, -1, 0\n\tv_mbcnt_hi_u32_b32 %0, -1, %0" : "=v"(lane_));
    const int lane = lane_, tid = wid * 64 + lane, wr = wid >> 2, wc = wid & 3, fr = lane & 15, fq = lane >> 4;
    const int K = g.K, nt = K / BK, LD = g.ld ? g.ld : g.K;
    unsigned voffA[2], voffB[2];
#pragma unroll
    for (int i = 0; i < 2; ++i) { int R, C; stage_rc(tid * 16 + i * 8192, R, C); const int Rb = Epi::PERM ? ((R & ~31) + perm32(R & 31)) : R;
        voffA[i] = (unsigned)(R * LD + C) * 2u; voffB[i] = (unsigned)(Rb * LD + C) * 2u; }
    const size_t kstep = (size_t)(BK * 2);
    const size_t hstep = (size_t)HALF * LD * 2;
    const size_t tstep = 2 * hstep;
    const unsigned ldsw = (unsigned)wid * 1024u;
    const int aoff = lds_byte(wr * 64 + fr, fq * 8), boff = lds_byte(wc * 32 + fr, fq * 8);
#define PG8_SA(b, h) (((b) * 2 + (h)) * HTB)
#define PG8_SB(b, h) ((4 + (b) * 2 + (h)) * HTB)
#define PG8_STAGE(bufoff, gbase, voff) do { _Pragma("unroll") for (int _i = 0; _i < 2; ++_i) \
        __builtin_amdgcn_global_load_lds((const unsigned*)((const char*)(gbase) + (voff)[_i]), (PG8_LAS unsigned*)(lds + (bufoff) + ldsw + _i * 8192), 16, 0, 0); } while (0)
#define PG8_LDA(dst, b, h) do { _Pragma("unroll") for (int m = 0; m < 4; ++m) _Pragma("unroll") for (int k = 0; k < 2; ++k) dst[m][k] = *(const PG8_LAS bf16x8*)(lds + PG8_SA(b, h) + aoff + m * 2048 + k * 1024); } while (0)
#define PG8_LDB(dst, b, h) do { _Pragma("unroll") for (int n = 0; n < 2; ++n) _Pragma("unroll") for (int k = 0; k < 2; ++k) dst[n][k] = *(const PG8_LAS bf16x8*)(lds + PG8_SB(b, h) + boff + n * 2048 + k * 1024); } while (0)
#define PG8_MMA(ai, bj, At, Bt) do { __builtin_amdgcn_s_setprio(1); _Pragma("unroll") for (int m = 0; m < 4; ++m) _Pragma("unroll") for (int n = 0; n < 2; ++n) _Pragma("unroll") for (int k = 0; k < 2; ++k) \
        acc[ai][bj][m][n] = __builtin_amdgcn_mfma_f32_16x16x32_bf16(Bt[n][k], At[m][k], acc[ai][bj][m][n], 0, 0, 0); __builtin_amdgcn_s_setprio(0); } while (0)
#define PG8_WAIT_V(n) asm volatile("s_waitcnt vmcnt(" #n ")" ::: "memory")
#define PG8_WAIT_L(n) asm volatile("s_waitcnt lgkmcnt(" #n ")" ::: "memory")
#define PG8_BAR __builtin_amdgcn_s_barrier()
#define PG8_SCHED __builtin_amdgcn_sched_barrier(0)
    Unit cur, nxt; int ui = 0;
    if (!S.next(0, cur)) return;
    f32x4 acc[2][2][4][2];
#pragma unroll
    for (int a = 0; a < 2; ++a)
#pragma unroll
        for (int b = 0; b < 2; ++b)
#pragma unroll
            for (int m = 0; m < 4; ++m)
#pragma unroll
                for (int n = 0; n < 2; ++n) acc[a][b][m][n] = (f32x4){0.f, 0.f, 0.f, 0.f};
    bf16x8 At[4][2], B0[2][2], B1[2][2];
    const char* cA = (const char*)g.A + (size_t)cur.pm * tstep + cur.ko; const char* cB = (const char*)g.Bt + (size_t)cur.pn * tstep + cur.ko;
    S.a_ready(cur);
    if constexpr (SP2) {
        PG8_STAGE(PG8_SB(0, 0), cB, voffB); PG8_STAGE(PG8_SB(0, 1), cB + hstep, voffB); PG8_STAGE(PG8_SA(0, 0), cA, voffA); PG8_STAGE(PG8_SA(0, 1), cA + hstep, voffA);
        if (wr == 1) PG8_BAR;
        PG8_WAIT_V(2); PG8_BAR;
        PG8_STAGE(PG8_SB(1, 0), cB + kstep, voffB); PG8_STAGE(PG8_SA(1, 0), cA + kstep, voffA); PG8_STAGE(PG8_SB(1, 1), cB + hstep + kstep, voffB);
        PG8_WAIT_V(6); PG8_BAR;
    } else {
        PG8_STAGE(PG8_SB(0, 0), cB, voffB); PG8_STAGE(PG8_SA(0, 0), cA, voffA); PG8_STAGE(PG8_SB(0, 1), cB + hstep, voffB); PG8_STAGE(PG8_SA(0, 1), cA + hstep, voffA);
        if (wr == 1) PG8_BAR;
        PG8_WAIT_V(4); PG8_BAR;
        PG8_STAGE(PG8_SB(1, 0), cB + kstep, voffB); PG8_STAGE(PG8_SA(1, 0), cA + kstep, voffA); PG8_STAGE(PG8_SB(1, 1), cB + hstep + kstep, voffB);
        PG8_WAIT_V(6); PG8_BAR;
    }
    for (;;) {
        const bool has_next = S.next(ui + 1, nxt);
        const char* nA = has_next ? (const char*)g.A + (size_t)nxt.pm * tstep + nxt.ko : cA; const char* nB = has_next ? (const char*)g.Bt + (size_t)nxt.pn * tstep + nxt.ko : cB;
        for (int t = 0; t < nt; t += 2) {
            const bool last = (t == nt - 2);
            const char* a1 = cA + (size_t)(t + 1) * kstep;
            const char* a2 = last ? nA : cA + (size_t)(t + 2) * kstep; const char* b2 = last ? nB : cB + (size_t)(t + 2) * kstep;
            const char* a3 = a2 + kstep; const char* b3 = b2 + kstep;
            if (last && has_next) S.a_ready(nxt);
            if constexpr (SP2) {
            PG8_LDB(B0, 0, 0); PG8_LDB(B1, 0, 1); PG8_SCHED; PG8_LDA(At, 0, 0); PG8_STAGE(PG8_SA(1, 1), a1 + hstep, voffA);
            PG8_WAIT_V(8); PG8_WAIT_L(0); PG8_BAR; PG8_MMA(0, 0, At, B0); PG8_MMA(0, 1, At, B1); PG8_BAR; PG8_SCHED;
            PG8_LDA(At, 0, 1); PG8_STAGE(PG8_SB(0, 0), b2, voffB); PG8_STAGE(PG8_SB(0, 1), b2 + hstep, voffB); PG8_STAGE(PG8_SA(0, 0), a2, voffA);
            PG8_WAIT_V(8); PG8_WAIT_L(0); PG8_BAR; PG8_MMA(1, 0, At, B0); PG8_MMA(1, 1, At, B1); PG8_BAR; PG8_SCHED;
            PG8_LDB(B0, 1, 0); PG8_LDB(B1, 1, 1); PG8_SCHED; PG8_LDA(At, 1, 0); PG8_STAGE(PG8_SA(0, 1), a2 + hstep, voffA);
            PG8_WAIT_V(8); PG8_WAIT_L(0); PG8_BAR; PG8_MMA(0, 0, At, B0); PG8_MMA(0, 1, At, B1); PG8_BAR; PG8_SCHED;
            PG8_LDA(At, 1, 1); PG8_STAGE(PG8_SB(1, 0), b3, voffB); PG8_STAGE(PG8_SB(1, 1), b3 + hstep, voffB); PG8_STAGE(PG8_SA(1, 0), a3, voffA);
            PG8_WAIT_V(8); PG8_WAIT_L(0); PG8_BAR; PG8_MMA(1, 0, At, B0); PG8_MMA(1, 1, At, B1); PG8_BAR; PG8_SCHED;
            } else {
            PG8_LDB(B0, 0, 0); PG8_SCHED; PG8_LDA(At, 0, 0); PG8_STAGE(PG8_SA(1, 1), a1 + hstep, voffA);
            PG8_WAIT_L(8); PG8_BAR; PG8_WAIT_L(0); PG8_MMA(0, 0, At, B0); PG8_BAR; PG8_SCHED;
            PG8_LDB(B1, 0, 1); PG8_STAGE(PG8_SB(0, 0), b2, voffB);
            PG8_BAR; PG8_WAIT_L(0); PG8_MMA(0, 1, At, B1); PG8_BAR;
            PG8_LDA(At, 0, 1); PG8_STAGE(PG8_SA(0, 0), a2, voffA);
            PG8_BAR; PG8_WAIT_L(0); PG8_MMA(1, 0, At, B0); PG8_BAR; PG8_SCHED;
            PG8_STAGE(PG8_SB(0, 1), b2 + hstep, voffB);
            PG8_WAIT_V(6); PG8_BAR; PG8_MMA(1, 1, At, B1); PG8_BAR;
            PG8_LDB(B0, 1, 0); PG8_SCHED; PG8_LDA(At, 1, 0); PG8_STAGE(PG8_SA(0, 1), a2 + hstep, voffA);
            PG8_WAIT_L(8); PG8_BAR; PG8_WAIT_L(0); PG8_MMA(0, 0, At, B0); PG8_BAR; PG8_SCHED;
            PG8_LDB(B1, 1, 1); PG8_STAGE(PG8_SB(1, 0), b3, voffB);
            PG8_BAR; PG8_WAIT_L(0); PG8_MMA(0, 1, At, B1); PG8_BAR;
            PG8_LDA(At, 1, 1); PG8_STAGE(PG8_SA(1, 0), a3, voffA);
            PG8_BAR; PG8_WAIT_L(0); PG8_MMA(1, 0, At, B0); PG8_BAR; PG8_SCHED;
            PG8_STAGE(PG8_SB(1, 1), b3 + hstep, voffB);
            PG8_WAIT_V(6); PG8_BAR; PG8_MMA(1, 1, At, B1); PG8_BAR;
            }
        }
        if constexpr (ALIGN_EPI) { if (wr == 0) PG8_BAR; }
        if constexpr (!Epi::AFTER_DRAIN) { E(acc, cur, wr, wc, fr, fq); S.done(cur); }
        if (!has_next) break;
#pragma unroll
        for (int a = 0; a < 2; ++a)
#pragma unroll
            for (int b = 0; b < 2; ++b)
#pragma unroll
                for (int m = 0; m < 4; ++m)
#pragma unroll
                    for (int n = 0; n < 2; ++n) acc[a][b][m][n] = (f32x4){0.f, 0.f, 0.f, 0.f};
        cur = nxt; cA = nA; cB = nB; ++ui;
        if constexpr (ALIGN_EPI) { if (wr == 1) PG8_BAR; }
    }
    PG8_WAIT_V(0);
    if constexpr (!ALIGN_EPI) { if (wr == 0) PG8_BAR; }
    PG8_BAR;
    if constexpr (Epi::AFTER_DRAIN) { E.fused(acc, cur, wr, wc, fr, fq, lds, wid, lane); S.done(cur); }
#undef PG8_SA
#undef PG8_SB
#undef PG8_STAGE
#undef PG8_LDA
#undef PG8_LDB
#undef PG8_MMA
#undef PG8_WAIT_V
#undef PG8_WAIT_L
#undef PG8_BAR
#undef PG8_SCHED
}
}
constexpr int D_MODEL = 1024, BATCH = 16, SEQ = 2048, DEC_BATCH = 128, PAST = 8192, PAGE = 128, NPAGES = 64;
constexpr int D_INNER = 2048, A_HEADS = 32, A_HEAD = 64, B_HEADS = 16, KV_LORA = 256, Q_LORA = 384, QK_NOPE = 128, QK_ROPE = 64, V_HEAD = 128, QK_HEAD = 192;
constexpr int MP = BATCH * SEQ;
constexpr int MS0 = MP;
constexpr int MT = MP + 256;
constexpr float NORM_EPS = 1e-6f, GN_EPS = 64e-5f;
constexpr float ATTN_SCALE = 0.07216878364870322f;
constexpr float LOG2E = 1.4426950408889634f;
constexpr int NWAVES = 8, NTHR = 512;

constexpr size_t O_YP = 0, O_YS = O_YP + (size_t)MP * D_MODEL, O_WKVP = O_YS + (size_t)DEC_BATCH * D_MODEL, O_SHP = O_WKVP + (size_t)2 * BATCH * A_HEADS * 4096,
    O_CKVP = O_SHP + (size_t)2 * BATCH * D_MODEL, O_KPEP = O_CKVP + (size_t)MP * KV_LORA, O_WKVS = O_KPEP + (size_t)MP * QK_ROPE, O_SHS = O_WKVS + (size_t)2 * DEC_BATCH * A_HEADS * 4096,
    O_CKVS = O_SHS + (size_t)2 * DEC_BATCH * D_MODEL, O_KPES = O_CKVS + (size_t)DEC_BATCH * KV_LORA, O_END = O_KPES + (size_t)DEC_BATCH * QK_ROPE;

constexpr size_t MiB = 1u << 20;
constexpr size_t WS_CTL = 0, CTL_ZERO_BYTES = 2 * MiB;
constexpr size_t WS_WIN = 2 * MiB, WIN_L = 18 * MiB;
constexpr size_t WS_W2 = WS_WIN + 2 * WIN_L;
constexpr size_t WS_WO = WS_W2 + 3 * MiB;
constexpr size_t WS_WDKV = WS_WO + 8 * MiB;
constexpr size_t WS_WUK = WS_WDKV + 1 * MiB;
constexpr size_t WS_WUV = WS_WUK + 1 * MiB;
constexpr size_t WS_WQ = WS_WUV + 1 * MiB;
constexpr size_t WS_WZ = WS_WQ + 2 * MiB;
constexpr size_t WS_WUQ = WS_WZ + 8 * MiB;
constexpr size_t WS_WBO = WS_WUQ + 5 * MiB;
constexpr size_t WS_ROPE = WS_WBO + 8 * MiB;
constexpr size_t WS_X = 96 * MiB;
constexpr size_t WS_AM = WS_X + 130 * MiB;
constexpr size_t AM_STRIDE = 65 * MiB;
constexpr size_t WS_R = WS_AM + 6 * AM_STRIDE;
constexpr size_t BIGB = 130 * MiB;
constexpr size_t WS_K = WS_R + BIGB, WS_V0 = WS_K + BIGB, WS_V1 = WS_V0 + BIGB, WS_Z = WS_V1 + BIGB, WS_G = WS_Z + BIGB;
constexpr size_t WS_LW = WS_G + BIGB;
constexpr size_t WS_LA = WS_LW + 9 * MiB, WS_LV = WS_LA + 9 * MiB;
constexpr size_t WS_BON = WS_LV + 9 * MiB;
constexpr size_t WS_F = WS_BON + 5 * MiB;
constexpr size_t BIGF = 260 * MiB;
constexpr size_t WS_WD = WS_F, WS_IA = WS_F + BIGF, WS_VG = WS_F + 2 * BIGF, WS_SR = WS_F + 3 * BIGF, WS_SK = WS_F + 4 * BIGF, WS_SA = WS_F + 5 * BIGF, WS_SB = WS_F + 6 * BIGF,
    WS_SV = WS_F + 7 * BIGF, WS_Y = WS_F + 8 * BIGF, WS_END_A = WS_F + 9 * BIGF;
constexpr size_t WS_KVR = WS_F;
constexpr size_t WS_CKVB = WS_KVR + 41 * MiB;
constexpr size_t WS_KPEB = WS_CKVB + 17 * MiB;
constexpr size_t WS_KN = WS_KPEB + 5 * MiB;
constexpr size_t WS_VT = WS_KN + 128 * MiB;
constexpr size_t WS_QL = WS_VT + 128 * MiB;
constexpr size_t WS_CQ = WS_QL + 49 * MiB;
constexpr size_t WS_QR = WS_CQ + 25 * MiB;
constexpr size_t WS_Q = WS_QR + 388 * MiB;
constexpr size_t WS_QABS = WS_Q + 194 * MiB;
constexpr size_t WS_OPART = WS_QABS + 2 * MiB;
constexpr size_t WS_ML = WS_OPART + 16 * MiB;
constexpr size_t WS_END_B = WS_ML + 1 * MiB;
constexpr size_t WS_NEED = WS_END_A > WS_END_B ? WS_END_A : WS_END_B;
static_assert(WS_ROPE + 1 * MiB <= WS_X, "weights region");
constexpr size_t CW_RSQ = 1 * MiB;
constexpr int CW_BAR = 4096;

constexpr int RING_BYTES = 131072;
constexpr int LDSCTL_OFF = RING_BYTES;
constexpr int LDS_BYTES = 147456;

#define GAS __attribute__((address_space(1)))
#define LAS __attribute__((address_space(3)))
typedef unsigned short bf16;
typedef unsigned v4u __attribute__((ext_vector_type(4)));
typedef unsigned v2u __attribute__((ext_vector_type(2)));
typedef float f32x4 __attribute__((ext_vector_type(4)));
typedef float f32x16 __attribute__((ext_vector_type(16)));
typedef short bf16x8 __attribute__((ext_vector_type(8)));
typedef short s16x4 __attribute__((ext_vector_type(4)));
typedef const __attribute__((address_space(4))) float* cfp;
#define LDS_WAIT() asm volatile("s_waitcnt lgkmcnt(0)" ::: "memory")
#define VM_WAIT() asm volatile("s_waitcnt vmcnt(0)" ::: "memory")
__device__ __forceinline__ unsigned f2bf(float f) { unsigned u = __builtin_bit_cast(unsigned, f); return (u + 0x7fffu + ((u >> 16) & 1u)) >> 16; }
__device__ __forceinline__ unsigned pk2(float lo, float hi) { return f2bf(lo) | (f2bf(hi) << 16); }
__device__ __forceinline__ float bflo(unsigned u) { return __builtin_bit_cast(float, u << 16); }
__device__ __forceinline__ float bfhi(unsigned u) { return __builtin_bit_cast(float, u & 0xffff0000u); }
template <int MASK> __device__ __forceinline__ float swz_xor(float v) { return __builtin_bit_cast(float, __builtin_amdgcn_ds_swizzle(__builtin_bit_cast(int, v), 0x1F | (MASK << 10))); }
__device__ __forceinline__ float xor32_sum(float v) { float a = v, b = v; asm volatile("s_nop 1\n\tv_permlane32_swap_b32 %0, %1\n\ts_nop 1" : "+v"(a), "+v"(b)); return a + b; }
__device__ __forceinline__ float xor32_max(float v) { float a = v, b = v; asm volatile("s_nop 1\n\tv_permlane32_swap_b32 %0, %1\n\ts_nop 1" : "+v"(a), "+v"(b)); return fmaxf(a, b); }
__device__ __forceinline__ float wave_sum(float v) { v += swz_xor<1>(v); v += swz_xor<2>(v); v += swz_xor<4>(v); v += swz_xor<8>(v); v += swz_xor<16>(v); return xor32_sum(v); }
__device__ __forceinline__ float sigmoidf_(float x) { return 1.0f / (1.0f + __expf(-x)); }
#define XB_TMO      128
#define XB_XCNT(j)  (256  + 64 * (j))
#define XB_XSUB(j)  (1280 + 64 * (j))
#define XB_XGEN(j)  (2304 + 64 * (j))
#define XB_TOP      3328
#define XB_TOPGEN   3392
#define XCD_BAR_WORDS 3456
#define XB_SPIN_CAP (1u << 18)

__device__ __forceinline__ unsigned xb_ld(unsigned* p)              { return __hip_atomic_load(p, __ATOMIC_RELAXED, __HIP_MEMORY_SCOPE_AGENT); }
__device__ __forceinline__ unsigned xb_add(unsigned* p, unsigned v) { return __hip_atomic_fetch_add(p, v, __ATOMIC_RELAXED, __HIP_MEMORY_SCOPE_AGENT); }
__device__ __forceinline__ unsigned xb_xcc_id() { return (unsigned)__builtin_amdgcn_s_getreg((3 << 11) | 20) & 0xFu; }
#define XB_SPIN(cond, bar) do { unsigned _sp = 0; while (cond) { __builtin_amdgcn_s_sleep(1); \
    if ((++_sp & 255u) == 0u) { if (xb_ld(&(bar)[XB_TMO])) break; if (_sp > XB_SPIN_CAP) { atomicAdd(&(bar)[XB_TMO], 1u); break; } } } } while (0)

struct XcdBarrier {
    unsigned* bar; unsigned x; unsigned w;
    volatile LAS unsigned* st;
};

__device__ __forceinline__ bool xb_t0(unsigned w) { unsigned l; asm volatile("v_mbcnt_lo_u32_b32 %0, -1, 0\n\tv_mbcnt_hi_u32_b32 %0, -1, %0" : "=v"(l)); return w == 0u && l == 0u; }
__device__ __forceinline__ XcdBarrier xcd_barrier_post(unsigned* bar, volatile LAS unsigned* st, unsigned w) {
    XcdBarrier b; b.bar = bar; b.x = xb_xcc_id(); b.st = st; b.w = w;
    if (xb_t0(w)) (void)xb_add(&bar[XB_XCNT(b.x)], 1u);
    return b;
}
__device__ __forceinline__ void xcd_barrier_complete(unsigned* bar, unsigned x, unsigned& nloc, unsigned& nx) {
    const unsigned G = gridDim.x * gridDim.y * gridDim.z;
    unsigned sum, cnt, mine, sp = 0u;
    for (;;) {
        sum = 0u; cnt = 0u; mine = 0u;
#pragma unroll
        for (unsigned j = 0; j < 16; ++j) { const unsigned c = xb_ld(&bar[XB_XCNT(j)]); sum += c; cnt += (c > 0u) ? 1u : 0u; mine = (j == x) ? c : mine; }
        if (sum == G) break;
        __builtin_amdgcn_s_sleep(1);
        if ((++sp & 255u) == 0u) { if (xb_ld(&bar[XB_TMO])) break; if (sp > XB_SPIN_CAP) { atomicAdd(&bar[XB_TMO], 1u); break; } }
    }
    nloc = mine > 0u ? mine : 1u; nx = cnt > 0u ? cnt : 1u;
}

__device__ __forceinline__ void xcd_barrier(const XcdBarrier& b) {
    asm volatile("s_waitcnt vmcnt(0)" ::: "memory");
    __syncthreads();
    if (xb_t0(b.w)) {
        unsigned* bar = b.bar;
        __builtin_amdgcn_s_waitcnt(0);
        unsigned nloc = b.st[0], nx = b.st[1];
        if (nloc == 0u) { xcd_barrier_complete(bar, b.x, nloc, nx); b.st[0] = nloc; b.st[1] = nx; }
        const unsigned old = xb_add(&bar[XB_XSUB(b.x)], 1u);
        const unsigned gen = old / nloc;
        if (old + 1u == (gen + 1u) * nloc) {
            __builtin_amdgcn_fence(__ATOMIC_RELEASE, "agent");
            asm volatile("s_waitcnt vmcnt(0)" ::: "memory");
            const unsigned og = xb_add(&bar[XB_TOP], 1u);
            const unsigned tg = og / nx;
            if (og + 1u == (tg + 1u) * nx) xb_add(&bar[XB_TOPGEN], 1u);
            else XB_SPIN(xb_ld(&bar[XB_TOPGEN]) == tg, bar);
            __builtin_amdgcn_fence(__ATOMIC_ACQUIRE, "agent");
            xb_add(&bar[XB_XGEN(b.x)], 1u);
            asm volatile("s_waitcnt vmcnt(0)" ::: "memory");
        } else {
            XB_SPIN(xb_ld(&bar[XB_XGEN(b.x)]) == gen, bar);
            __builtin_amdgcn_fence(__ATOMIC_ACQUIRE, "agent");
            asm volatile("s_waitcnt vmcnt(0)" ::: "memory");
        }
    }
    __syncthreads();
}
struct Args { const void* in[36]; float* out; unsigned char* ws; int ph_lo, ph_hi, li, pad; };
typedef const __attribute__((address_space(4))) Args* cargs;
__device__ __forceinline__ int lane_id() { int l; asm volatile("v_mbcnt_lo_u32_b32 %0, -1, 0\n\tv_mbcnt_hi_u32_b32 %0, -1, %0" : "=v"(l)); return l; }
struct Frame { LAS unsigned char* lds; unsigned char* ws; float* out; int lane, wave, bid, gw, NGW, G, NT; };
#define LANE F.lane
__device__ __forceinline__ Frame make_frame(cargs ap, int wave0, LAS unsigned char* lds) {
    Frame F; int w = wave0, b = (int)blockIdx.x, g = (int)gridDim.x; asm volatile("" : "+s"(w), "+s"(b), "+s"(g));
    F.lds = lds; F.ws = ap->ws; F.out = ap->out; F.lane = lane_id(); F.wave = w; F.bid = b; F.G = g; F.gw = b * NWAVES + w; F.NGW = g * NWAVES; F.NT = g * NTHR;
    return F;
}

__device__ __forceinline__ int rope_perm_col(int n) { const int c = n % 192; if (c < 128) return n; const int j = c - 128; return n - c + 128 + 2 * (j & 31) + (j >> 5); }
__device__ __forceinline__ void tr_item(const float* W, int ldw, int col0, int Kvalid, int nblk, bf16* WT, int ldt, bool zpad, LAS float* scr, int item, int lane, bool rperm = false) {
    const int kb = item / nblk, nb = item % nblk, k0 = 64 * kb, n0 = 32 * nb;
#pragma unroll
    for (int i = 0; i < 32; ++i) { const int kk = 2 * i + (lane >> 5); scr[kk * 33 + (lane & 31)] = (k0 + kk < Kvalid) ? W[(size_t)(k0 + kk) * ldw + col0 + n0 + (lane & 31)] : 0.f; }
    LDS_WAIT(); asm volatile("" ::: "memory");
    const int c = lane & 7;
#pragma unroll
    for (int j = 0; j < 4; ++j) { const int n = (lane >> 3) + 8 * j; const LAS float* s = scr + (8 * c) * 33 + n;
        v4u o; o.x = pk2(s[0 * 33], s[1 * 33]); o.y = pk2(s[2 * 33], s[3 * 33]); o.z = pk2(s[4 * 33], s[5 * 33]); o.w = pk2(s[6 * 33], s[7 * 33]);
        const int nd = rperm ? rope_perm_col(n0 + n) : n0 + n;
        *(v4u*)(WT + (size_t)nd * ldt + k0 + 8 * c) = o;
        if (zpad) *(v4u*)(WT + (size_t)nd * ldt + 64 + 8 * c) = (v4u){0u, 0u, 0u, 0u}; }
    LDS_WAIT(); asm volatile("" ::: "memory");
}
#define TRJOB_(W_, ldw_, col0_, Kv_, Nc_, WT_, ldt_, zp_, rp_) do { const int nblk_ = (Nc_) / 32, items_ = (((Kv_) + 63) / 64) * nblk_; \
    for (int it_ = ((F.gw - base_) % F.NGW + F.NGW) % F.NGW; it_ < items_; it_ += F.NGW) tr_item((W_), (ldw_), (col0_), (Kv_), nblk_, (bf16*)(WT_), (ldt_), (zp_), scr, it_, LANE, (rp_)); base_ = (base_ + items_) % F.NGW; } while (0)
#define TRJOB(W_, ldw_, col0_, Kv_, Nc_, WT_, ldt_, zp_) TRJOB_(W_, ldw_, col0_, Kv_, Nc_, WT_, ldt_, zp_, false)

__device__ __forceinline__ void p0_prologue(Frame& F, cargs a) {
    LAS float* scr = (LAS float*)(F.lds + F.wave * 16384);
    unsigned char* ws = F.ws; int base_ = 0;
    for (int l = 0; l < 2; ++l) {
        for (int p = 0; p < 4; ++p) TRJOB((const float*)a->in[9] + (size_t)(l * 4 + p) * 1024 * 2048, 2048, 0, 1024, 2048, ws + WS_WIN + (size_t)l * WIN_L + (size_t)p * 4 * MiB, 1024, false);
        TRJOB((const float*)a->in[11] + (size_t)l * 1024 * 64, 64, 0, 1024, 64, ws + WS_WIN + (size_t)l * WIN_L + 16 * MiB, 1024, false);
        TRJOB((const float*)a->in[14] + (size_t)l * 1024 * 64, 64, 0, 1024, 64, ws + WS_WIN + (size_t)l * WIN_L + 16 * MiB + MiB / 2, 1024, false);
        TRJOB((const float*)a->in[12] + (size_t)l * 64 * 2048, 2048, 0, 64, 2048, ws + WS_W2 + (size_t)l * (MiB / 2), 128, true);
        TRJOB((const float*)a->in[15] + (size_t)l * 64 * 2048, 2048, 0, 64, 2048, ws + WS_W2 + (size_t)(2 + l) * (MiB / 2), 128, true);
        TRJOB((const float*)a->in[24] + (size_t)l * 2048 * 1024, 1024, 0, 2048, 1024, ws + WS_WO + (size_t)l * 4 * MiB, 2048, false);
        TRJOB((const float*)a->in[31] + (size_t)l * 1024 * 2432, 2432, 0, 1024, 384, ws + WS_WQ + (size_t)l * MiB, 1024, false);
        TRJOB((const float*)a->in[31] + (size_t)l * 1024 * 2432, 2432, 384, 1024, 2048, ws + WS_WZ + (size_t)l * 4 * MiB, 1024, false);
        TRJOB_((const float*)a->in[33] + (size_t)l * 384 * 3072, 3072, 0, 384, 3072, ws + WS_WUQ + (size_t)l * (5 * MiB / 2), 384, false, true);
        TRJOB((const float*)a->in[34] + (size_t)l * 2048 * 1024, 1024, 0, 2048, 1024, ws + WS_WBO + (size_t)l * 4 * MiB, 2048, false);
    }
    TRJOB((const float*)a->in[17], 32, 0, 1024, 32, ws + WS_WIN + WIN_L + 17 * MiB, 1024, false);
    TRJOB((const float*)a->in[18], 2048, 0, 32, 2048, ws + WS_W2 + (size_t)4 * (MiB / 2), 128, true);
    TRJOB((const float*)a->in[26], 320, 0, 1024, 320, ws + WS_WDKV, 1024, false);
    TRJOB((const float*)a->in[28], 2048, 0, 256, 2048, ws + WS_WUK, 256, false);
    TRJOB((const float*)a->in[29], 2048, 0, 256, 2048, ws + WS_WUV, 256, false);
    { const f32x4* xs = (const f32x4*)a->in[1]; f32x4* X4 = (f32x4*)(ws + WS_X) + (size_t)MP * 256;
      for (int i = (F.bid * NTHR + F.wave * 64 + LANE); i < 256 * 256; i += F.NT) X4[i] = i < DEC_BATCH * 256 ? xs[i] : (f32x4){0.f, 0.f, 0.f, 0.f}; }
    { float* T = (float*)(ws + WS_ROPE);
      for (int i = (F.bid * NTHR + F.wave * 64 + LANE); i < 2049 * 32; i += F.NT) { const int p = i >> 5, f = i & 31; const double pos = p < 2048 ? (double)p : 8192.0;
          const double ang = pos * (double)exp2f(-(float)f * (13.287712379549449f / 32.0f)); T[2 * i] = (float)cos(ang); T[2 * i + 1] = (float)sin(ang); } }
}

__device__ __forceinline__ void load_row(const float* row, int lane, f32x4 (&v)[4]) {
#pragma unroll
    for (int j = 0; j < 4; ++j) v[j] = ((const f32x4*)row)[lane + 64 * j];
}
__device__ __forceinline__ float row_rs(const f32x4 (&v)[4]) {
    float s = 0.f;
#pragma unroll
    for (int j = 0; j < 4; ++j) s += (v[j].x * v[j].x + v[j].y * v[j].y) + (v[j].z * v[j].z + v[j].w * v[j].w);
    return 1.0f / sqrtf(wave_sum(s) * (1.0f / 1024.0f) + NORM_EPS);
}
__device__ __forceinline__ void norm_rows_bf16(Frame& F, const float* X, const float* w, bf16* O) {
    f32x4 w4[4]; load_row(w, LANE, w4);
    for (int m = F.gw; m < MT; m += F.NGW) { f32x4 x[4]; load_row(X + (size_t)m * 1024, LANE, x); const float rs = row_rs(x);
#pragma unroll
        for (int j = 0; j < 4; ++j) { const f32x4 h = x[j] * rs * w4[j]; v2u o; o.x = pk2(h.x, h.y); o.y = pk2(h.z, h.w); *(v2u*)(O + (size_t)m * 1024 + 4 * LANE + 256 * j) = o; } }
}

__device__ __forceinline__ void norm2_rows_bf16(Frame& F, const float* X, const float* wa, bf16* Oa, const float* wb, bf16* Ob) {
    f32x4 a4[4], b4[4]; load_row(wa, LANE, a4); load_row(wb, LANE, b4);
    for (int m = F.gw; m < MT; m += F.NGW) { f32x4 x[4]; load_row(X + (size_t)m * 1024, LANE, x); const float rs = row_rs(x);
#pragma unroll
        for (int j = 0; j < 4; ++j) { const f32x4 xs = x[j] * rs, ha = xs * a4[j], hb = xs * b4[j]; v2u o; o.x = pk2(ha.x, ha.y); o.y = pk2(ha.z, ha.w); *(v2u*)(Oa + (size_t)m * 1024 + 4 * LANE + 256 * j) = o;
            o.x = pk2(hb.x, hb.y); o.y = pk2(hb.z, hb.w); *(v2u*)(Ob + (size_t)m * 1024 + 4 * LANE + 256 * j) = o; } }
}

__device__ __forceinline__ void a1_prepass(Frame& F, cargs a, int l) {
    const float* Xw = (const float*)(F.ws + WS_X); const float* X = l == 0 ? (const float*)a->in[0] : Xw;
    const float* nw = (const float*)a->in[7] + l * 1024; const float* mix = (const float*)a->in[8] + l * 6 * 1024; const float* sshift = (const float*)a->in[3] + (size_t)l * DEC_BATCH * 1024;
    f32x4 w4[4]; load_row(nw, LANE, w4);
    for (int m = F.gw; m < MT; m += F.NGW) {
        f32x4 x[4], h[4], hp[4]; load_row((m < MP ? X : Xw) + (size_t)m * 1024, LANE, x); const float rs = row_rs(x);
#pragma unroll
        for (int j = 0; j < 4; ++j) { h[j] = x[j] * rs * w4[j]; hp[j] = (f32x4){0.f, 0.f, 0.f, 0.f}; }
        if (m < MP) { if ((m & (SEQ - 1)) != 0) { f32x4 xq[4]; load_row(X + (size_t)(m - 1) * 1024, LANE, xq); const float rq = row_rs(xq);
#pragma unroll
                for (int j = 0; j < 4; ++j) hp[j] = xq[j] * rq * w4[j]; } }
        else if (m < MP + DEC_BATCH) load_row(sshift + (size_t)(m - MP) * 1024, LANE, hp);
#pragma unroll
        for (int p = 0; p < 6; ++p) { bf16* O = (bf16*)(F.ws + WS_AM + (size_t)p * AM_STRIDE) + (size_t)m * 1024;
#pragma unroll
            for (int j = 0; j < 4; ++j) { const f32x4 mx = ((const f32x4*)(mix + p * 1024))[LANE + 64 * j]; const f32x4 o = h[j] + (hp[j] - h[j]) * mx;
                v2u w; w.x = pk2(o.x, o.y); w.y = pk2(o.z, o.w); *(v2u*)(O + 4 * LANE + 256 * j) = w; } }
        float* so = nullptr;
        if (m < MP) { if ((m & (SEQ - 1)) == SEQ - 1) so = F.out + O_SHP + (size_t)(l * BATCH + (m >> 11)) * 1024; }
        else if (m < MP + DEC_BATCH) so = F.out + O_SHS + (size_t)(l * DEC_BATCH + (m - MP)) * 1024;
        if (so) {
#pragma unroll
            for (int j = 0; j < 4; ++j) ((f32x4*)so)[LANE + 64 * j] = h[j]; }
    }
}

typedef float f32x2 __attribute__((ext_vector_type(2)));
__device__ __forceinline__ void unpack8(v4u u, float (&f)[8]) { f[0] = bflo(u.x); f[1] = bfhi(u.x); f[2] = bflo(u.y); f[3] = bfhi(u.y); f[4] = bflo(u.z); f[5] = bfhi(u.z); f[6] = bflo(u.w); f[7] = bfhi(u.w); }
constexpr int FS_TS = 16, FS_Y = FS_TS * 6 * 64 * 4, FS_Z = FS_Y + FS_TS * 64 * 4, FS_BON = FS_Z + FS_TS * 64 * 2, FS_BH = FS_BON + 128, FS_BUF = 2 * FS_BH;
static_assert(2 * FS_BUF <= RING_BYTES && FS_BH % 16 == 0, "fused scan LDS");
template <int CTRL> __device__ __forceinline__ float dppf(float v) { return __builtin_bit_cast(float, __builtin_amdgcn_update_dpp(0, __builtin_bit_cast(int, v), CTRL, 0xF, 0xF, false)); }
__device__ __forceinline__ float wave_sum_fast(float v) {
    v += dppf<0xB1>(v); v += dppf<0x4E>(v); v += dppf<0x124>(v); v += dppf<0x128>(v);
    const int iv = __builtin_bit_cast(int, v);
    return (__builtin_bit_cast(float, __builtin_amdgcn_readlane(iv, 0)) + __builtin_bit_cast(float, __builtin_amdgcn_readlane(iv, 16))) + (__builtin_bit_cast(float, __builtin_amdgcn_readlane(iv, 32)) + __builtin_bit_cast(float, __builtin_amdgcn_readlane(iv, 48)));
}
struct HeadPrm { float w0, a0, v0, kk, ka, rk, lnw, lnb; };
__device__ __forceinline__ float frcp(float x) { return __builtin_amdgcn_rcpf(x); }
__device__ __forceinline__ float fsig(float x) { return __builtin_amdgcn_rcpf(1.0f + __builtin_amdgcn_exp2f(-1.4426950408889634f * x)); }
__device__ __forceinline__ float wkv_step_lds(f32x2 (&S)[32], const LAS float* op, int lane) {
    const LAS f32x4* a4 = (const LAS f32x4*)op; const LAS f32x4* w4 = a4 + 16; const LAS f32x4* b4 = a4 + 32; const LAS f32x4* k4 = a4 + 48; const LAS f32x4* r4 = a4 + 64;
    const float vv = op[320 + lane];
    f32x2 s0 = (f32x2){0.f, 0.f}, s1 = s0;
#pragma unroll
    for (int q = 0; q < 16; ++q) { const f32x4 a = a4[q]; s0 += S[2 * q] * (f32x2){a.x, a.y}; s1 += S[2 * q + 1] * (f32x2){a.z, a.w}; }
    const f32x2 st = s0 + s1; const float sa = st.x + st.y; const f32x2 sa2 = (f32x2){sa, sa}, vv2 = (f32x2){vv, vv};
    f32x2 y0 = (f32x2){0.f, 0.f}, y1 = y0;
#pragma unroll
    for (int q = 0; q < 16; ++q) { const f32x4 w = w4[q], b = b4[q], k = k4[q], r = r4[q];
        S[2 * q] = S[2 * q] * (f32x2){w.x, w.y} + (sa2 * (f32x2){b.x, b.y} + vv2 * (f32x2){k.x, k.y}); y0 += S[2 * q] * (f32x2){r.x, r.y};
        S[2 * q + 1] = S[2 * q + 1] * (f32x2){w.z, w.w} + (sa2 * (f32x2){b.z, b.w} + vv2 * (f32x2){k.z, k.w}); y1 += S[2 * q + 1] * (f32x2){r.z, r.w}; }
    const f32x2 yt = y0 + y1; return yt.x + yt.y;
}
__device__ __forceinline__ void fs_prep_one(const HeadPrm& P, int l, float r, float k, float v, float dw, float da, float dv, float vf, LAS float* op, int lane, float& bon) {
    const float ia = da, w = __builtin_amdgcn_exp2f(dw);
    if (l) v = v + (vf - v) * dv;
    const float kk = k * P.kk, n2 = wave_sum_fast(kk * kk), inv = 1.0f / fmaxf(sqrtf(n2), 1e-12f), q = kk * inv, kp = k * (1.0f + (ia - 1.0f) * P.ka);
    bon = wave_sum_fast(r * kp * P.rk);
    op[lane] = -q; op[64 + lane] = w; op[128 + lane] = q * ia; op[192 + lane] = kp; op[256 + lane] = r; op[320 + lane] = v;
}
__device__ __forceinline__ float fs_post_one(const HeadPrm& P, float y, float vp, float z, float bon) {
    const float mu = wave_sum_fast(y) * (1.0f / 64.0f), d = y - mu, var = wave_sum_fast(d * d) * (1.0f / 64.0f);
    const float yn = d * __builtin_amdgcn_rsqf(var + GN_EPS) * P.lnw + P.lnb; return (yn + bon * vp) * (z * fsig(z));
}
__device__ __forceinline__ float ldbf(const bf16* p) { return bflo((unsigned)*p); }
__device__ __forceinline__ bf16 tobf(float x) { return __builtin_bit_cast(unsigned short, (__bf16)x); }
typedef short s16x4_t __attribute__((ext_vector_type(4)));
#define MF16(a_, b_, c_) __builtin_amdgcn_mfma_f32_16x16x16bf16_1k((a_), (b_), (c_), 0, 0, 0)
#define MF32(a_, b_, c_) __builtin_amdgcn_mfma_f32_16x16x32_bf16((a_), (b_), (c_), 0, 0, 0)
typedef __bf16 bf16x4_nat __attribute__((ext_vector_type(4)));
__device__ __forceinline__ s16x4_t cvt4(f32x4 v) { return __builtin_bit_cast(s16x4_t, __builtin_convertvector(v, bf16x4_nat)); }
constexpr int CK_TP = 144, CK_KP = 40;
constexpr int CK_AT = 0, CK_RT = CK_AT + 16 * CK_TP, CK_BH = CK_RT + 16 * CK_TP, CK_KH = CK_BH + 16 * CK_TP, CK_BHT = CK_KH + 16 * CK_TP, CK_KHT = CK_BHT + 64 * CK_KP, CK_VT = CK_KHT + 64 * CK_KP,
    CK_PC = CK_VT + 64 * CK_KP, CK_OPB = CK_PC + 256;
constexpr int RG_VP = 0, RG_Z = 2048, RG_BON = 4096, RG_SZ = 4224;
constexpr int BH_OPB = 0, BH_RING = 2 * CK_OPB, BH_Y = BH_RING + 3 * RG_SZ, BH_LW = BH_Y + 2 * 4096, BH_PRM = BH_LW + 4096, BH_SZ = BH_PRM + 6 * 256;
static_assert(2 * BH_SZ <= RING_BYTES && BH_SZ % 16 == 0 && CK_OPB % 16 == 0, "chunked scan LDS");
typedef short v4i16_ck __attribute__((ext_vector_type(4)));
__device__ __forceinline__ s16x4_t ck_tr(const LAS unsigned char* p) { return __builtin_bit_cast(s16x4_t, __builtin_amdgcn_ds_read_tr16_b64_v4i16((LAS v4i16_ck*)p)); }
__device__ __forceinline__ void ck_scan_chunk(f32x4 (&ST)[4][4], const LAS unsigned char* ob, const LAS unsigned char* vpb, LAS float* yb, int c16, int g) {
    const f32x4 zero4 = (f32x4){0.f, 0.f, 0.f, 0.f};
    bf16x8 at[2], rt[2], bh[2], kh[2];
#pragma unroll
    for (int ks = 0; ks < 2; ++ks) { const int o = c16 * CK_TP + 16 * g + 64 * ks;
        at[ks] = *(const LAS bf16x8*)(ob + CK_AT + o); rt[ks] = *(const LAS bf16x8*)(ob + CK_RT + o); bh[ks] = *(const LAS bf16x8*)(ob + CK_BH + o); kh[ks] = *(const LAS bf16x8*)(ob + CK_KH + o); }
    f32x4 qN = zero4, qL = zero4, qMk = zero4, qNbr = zero4, qNkr = zero4;
#pragma unroll
    for (int ks = 0; ks < 2; ++ks) { qN = MF32(bh[ks], at[ks], qN); qL = MF32(at[ks], bh[ks], qL); qMk = MF32(kh[ks], at[ks], qMk); qNbr = MF32(bh[ks], rt[ks], qNbr); qNkr = MF32(kh[ks], rt[ks], qNkr); }
    f32x4 Id;
#pragma unroll
    for (int r = 0; r < 4; ++r) { const int row = 4 * g + r; Id[r] = row == c16 ? 1.f : 0.f;
        if (!(row < c16)) { qN[r] = 0.f; qMk[r] = 0.f; }
        if (!(row <= c16)) { qNbr[r] = 0.f; qNkr[r] = 0.f; }
        if (!(c16 < row)) qL[r] = 0.f; }
    const s16x4_t aN = cvt4(qN), aL = cvt4(qL), aMk = cvt4(qMk), aNbr = cvt4(qNbr), aNkr = cvt4(qNkr);
    const f32x4 n2 = MF16(aL, aN, zero4), l2 = MF16(aN, aL, zero4);
    const s16x4_t aN2 = cvt4(n2), aL2 = cvt4(l2);
    const f32x4 n4 = MF16(aL2, aN2, zero4), l4 = MF16(aN2, aL2, zero4);
    const f32x4 n8 = MF16(cvt4(l4), cvt4(n4), zero4);
    const f32x4 p1t = MF16(cvt4(n2 + Id), cvt4(qL + Id), zero4);
    const f32x4 p2 = MF16(cvt4(l4 + Id), cvt4(n8 + Id), zero4);
    const s16x4_t aT = cvt4(MF16(cvt4(p1t), cvt4(p2), zero4));
    s16x4_t af[4], rf[4], bfr[4], kfr[4], vtr[4]; f32x4 pc[4]; s16x4_t Sb[4];
#pragma unroll
    for (int ki = 0; ki < 4; ++ki) { const int o = c16 * CK_TP + (16 * ki + 4 * g) * 2; af[ki] = *(const LAS s16x4_t*)(ob + CK_AT + o); rf[ki] = *(const LAS s16x4_t*)(ob + CK_RT + o);
        const int o2 = (4 * g + (c16 >> 2)) * CK_TP + (16 * ki + 4 * (c16 & 3)) * 2; bfr[ki] = ck_tr(ob + CK_BH + o2); kfr[ki] = ck_tr(ob + CK_KH + o2);
        vtr[ki] = ck_tr(vpb + (4 * g + (c16 >> 2)) * 128 + (16 * ki + 4 * (c16 & 3)) * 2);
        pc[ki] = *(const LAS f32x4*)(ob + CK_PC + (16 * ki + 4 * g) * 4); }
    f32x4 yt[4];
#pragma unroll
    for (int vi = 0; vi < 4; ++vi) {
        f32x4 xt = zero4, y0 = zero4;
#pragma unroll
        for (int ki = 0; ki < 4; ++ki) { Sb[ki] = cvt4(ST[ki][vi]); xt = MF16(af[ki], Sb[ki], xt); y0 = MF16(rf[ki], Sb[ki], y0); }
        const s16x4_t vt = vtr[vi];
        xt = MF16(aMk, vt, xt);
        const s16x4_t ub = cvt4(MF16(aT, cvt4(xt), zero4));
        y0 = MF16(aNbr, ub, y0); yt[vi] = MF16(aNkr, vt, y0);
#pragma unroll
        for (int ki = 0; ki < 4; ++ki) { ST[ki][vi] = MF16(bfr[ki], ub, ST[ki][vi]); ST[ki][vi] = MF16(kfr[ki], vt, ST[ki][vi]); ST[ki][vi] *= pc[ki]; }
    }
#pragma unroll
    for (int vi = 0; vi < 4; ++vi)
#pragma unroll
        for (int r = 0; r < 4; ++r) yb[(4 * g + r) * 64 + 16 * vi + c16] = yt[vi][r];
}
__device__ __forceinline__ void a5_fused(Frame& F, cargs a, int l) {
    unsigned char* ws = F.ws; const int lane = F.lane;
    const bf16* R = (const bf16*)(ws + WS_R); const bf16* K = (const bf16*)(ws + WS_K); const bf16* V = (const bf16*)(ws + (l ? WS_V1 : WS_V0)); const bf16* VF = (const bf16*)(ws + WS_V0); const bf16* Z = (const bf16*)(ws + WS_Z);
    const bf16* DW = (const bf16*)(ws + WS_WD); const bf16* DA = (const bf16*)(ws + WS_IA); const bf16* DV = (const bf16*)(ws + WS_VG); bf16* G = (bf16*)(ws + WS_G);
    const float* pw0 = (const float*)a->in[10] + l * 2048; const float* pa0 = (const float*)a->in[13] + l * 2048; const float* pv0 = (const float*)a->in[16]; const float* pkk = (const float*)a->in[19] + l * 2048;
    const float* pka = (const float*)a->in[20] + l * 2048; const float* prk = (const float*)a->in[21] + l * 2048; const float* plw = (const float*)a->in[22] + l * 2048; const float* plb = (const float*)a->in[23] + l * 2048;
    constexpr int NCH = SEQ / 16;
    for (int pr = F.bid; pr < BATCH * A_HEADS / 2; pr += F.G) { const int bh0 = 2 * pr;
        const int role = F.wave >> 1, hb = F.wave & 1, bh = bh0 + hb, b = bh >> 5, hh = bh & 31, ch = hh * 64 + lane;
        LAS unsigned char* blk = F.lds + hb * BH_SZ;
        const size_t rowb = (size_t)b * SEQ; const int c16 = lane & 15, g = lane >> 4;
#define CK_BAR() do { asm volatile("s_waitcnt lgkmcnt(0)" ::: "memory"); __builtin_amdgcn_s_barrier(); asm volatile("" ::: "memory"); } while (0)
#define CKV_LOAD(cc, SET) do { const size_t ro = (rowb + (size_t)(cc) * 16) * 2048;     \
            _Pragma("unroll") for (int j = 0; j < 2; ++j) { SET##r[j] = ((const v4u*)(R + ro + voff_))[j]; SET##k[j] = ((const v4u*)(K + ro + voff_))[j]; SET##v[j] = ((const v4u*)(V + ro + voff_))[j]; SET##z[j] = ((const v4u*)(Z + ro + voff_))[j]; \
                SET##w[j] = ((const v4u*)(DW + ro + voff_))[j]; SET##a[j] = ((const v4u*)(DA + ro + voff_))[j]; if (l) { SET##d[j] = ((const v4u*)(DV + ro + voff_))[j]; SET##f[j] = ((const v4u*)(VF + ro + voff_))[j]; } } } while (0)
#define CKV_PREP(cc, SET) do { LAS unsigned char* ob = blk + BH_OPB + ((cc) & 1) * CK_OPB; LAS unsigned char* rg = blk + BH_RING + ((cc) % 3) * RG_SZ; \
            float kk_[16], kp_[16], ia_[16], lw_[16]; float n2 = 0.f, bon = 0.f; \
            _Pragma("unroll") for (int j = 0; j < 2; ++j) { float k8[8], a8[8], r8[8], w8[8]; unpack8(SET##k[j], k8); unpack8(SET##a[j], a8); unpack8(SET##r[j], r8); unpack8(SET##w[j], w8); \
                _Pragma("unroll") for (int h = 0; h < 2; ++h) { const f32x4 pkk_ = prm[3 * 16 + 4 * vq_ + 2 * j + h], pka_ = prm[4 * 16 + 4 * vq_ + 2 * j + h], prk_ = prm[5 * 16 + 4 * vq_ + 2 * j + h]; \
                    _Pragma("unroll") for (int e = 0; e < 4; ++e) { const int i = 8 * j + 4 * h + e, e8 = 4 * h + e; const float ia = a8[e8]; ia_[i] = ia; lw_[i] = w8[e8]; \
                        const float kk = k8[e8] * pkk_[e]; kk_[i] = kk; n2 += kk * kk; const float kp = k8[e8] * (1.0f + (ia - 1.0f) * pka_[e]); kp_[i] = kp; bon += r8[e8] * kp * prk_[e]; } } } \
            n2 += dppf<0xB1>(n2); n2 += dppf<0x4E>(n2); bon += dppf<0xB1>(bon); bon += dppf<0x4E>(bon); const float inv = __builtin_amdgcn_rsqf(fmaxf(n2, 1e-24f)); \
              \
            _Pragma("unroll") for (int j = 0; j < 4; ++j) lwp[vt_ * 16 + 4 * vq_ + j] = (f32x4){lw_[4 * j], lw_[4 * j + 1], lw_[4 * j + 2], lw_[4 * j + 3]}; \
            LDS_WAIT(); asm volatile("" ::: "memory"); \
            { float c_[16]; _Pragma("unroll") for (int t = 0; t < 16; ++t) c_[t] = ((const LAS float*)lwp)[t * 64 + lane]; \
              _Pragma("unroll") for (int t = 1; t < 16; ++t) c_[t] += c_[t - 1]; \
              _Pragma("unroll") for (int t = 0; t < 16; ++t) ((LAS float*)lwp)[t * 64 + lane] = c_[t]; } \
            LDS_WAIT(); asm volatile("" ::: "memory"); \
            float lp_[16]; _Pragma("unroll") for (int j = 0; j < 4; ++j) { const f32x4 v = lwp[vt_ * 16 + 4 * vq_ + j]; lp_[4 * j] = v.x; lp_[4 * j + 1] = v.y; lp_[4 * j + 2] = v.z; lp_[4 * j + 3] = v.w; } \
            v4u oa[2], orr[2], ob_[2], ok[2], ov[2]; \
            _Pragma("unroll") for (int j = 0; j < 2; ++j) { float r8[8], v8[8]; unpack8(SET##r[j], r8); unpack8(SET##v[j], v8); \
                if (l) { float d8[8], f8[8]; unpack8(SET##d[j], d8); unpack8(SET##f[j], f8); _Pragma("unroll") for (int h = 0; h < 2; ++h) { \
                        _Pragma("unroll") for (int e = 0; e < 4; ++e) { const int e8 = 4 * h + e; v8[e8] = v8[e8] + (f8[e8] - v8[e8]) * d8[e8]; } } } \
                _Pragma("unroll") for (int e = 0; e < 8; e += 2) { const int i = 8 * j + e; \
                    const float P0 = __builtin_amdgcn_exp2f(lp_[i]), P1 = __builtin_amdgcn_exp2f(lp_[i + 1]), R0 = __builtin_amdgcn_exp2f(-lp_[i]), R1 = __builtin_amdgcn_exp2f(-lp_[i + 1]); \
                    const float M0 = __builtin_amdgcn_exp2f(lp_[i] - lw_[i]), M1 = __builtin_amdgcn_exp2f(lp_[i + 1] - lw_[i + 1]), q0 = kk_[i] * inv, q1 = kk_[i + 1] * inv; \
                    oa[j][e >> 1] = (unsigned)tobf(-q0 * M0) | ((unsigned)tobf(-q1 * M1) << 16); orr[j][e >> 1] = (unsigned)tobf(r8[e] * P0) | ((unsigned)tobf(r8[e + 1] * P1) << 16); \
                    ob_[j][e >> 1] = (unsigned)tobf(q0 * ia_[i] * R0) | ((unsigned)tobf(q1 * ia_[i + 1] * R1) << 16); ok[j][e >> 1] = (unsigned)tobf(kp_[i] * R0) | ((unsigned)tobf(kp_[i + 1] * R1) << 16); \
                    ov[j][e >> 1] = (unsigned)tobf(v8[e]) | ((unsigned)tobf(v8[e + 1]) << 16); \
                    if (vt_ == 15) { ((LAS float*)(ob + CK_PC))[16 * vq_ + i] = P0; ((LAS float*)(ob + CK_PC))[16 * vq_ + i + 1] = P1; } } } \
            _Pragma("unroll") for (int j = 0; j < 2; ++j) { const int o = vt_ * CK_TP + 32 * vq_ + 16 * j; *(LAS v4u*)(ob + CK_AT + o) = oa[j]; *(LAS v4u*)(ob + CK_RT + o) = orr[j]; *(LAS v4u*)(ob + CK_BH + o) = ob_[j]; *(LAS v4u*)(ob + CK_KH + o) = ok[j]; \
                *(LAS v4u*)(rg + RG_VP + vt_ * 128 + 32 * vq_ + 16 * j) = ov[j]; *(LAS v4u*)(rg + RG_Z + vt_ * 128 + 32 * vq_ + 16 * j) = SET##z[j]; } \
            if (vq_ == 0) ((LAS float*)(rg + RG_BON))[vt_] = bon; } while (0)
#define CK_POST(cc) do { const LAS unsigned char* rg = blk + BH_RING + ((cc) % 3) * RG_SZ; const LAS float* yb = (const LAS float*)(blk + BH_Y + ((cc) & 1) * 4096) + pt_ * 64 + 16 * pq_; \
            float y_[16], vp_[16], z_[16]; \
            _Pragma("unroll") for (int j = 0; j < 4; ++j) { const f32x4 v = ((const LAS f32x4*)yb)[j]; y_[4 * j] = v.x; y_[4 * j + 1] = v.y; y_[4 * j + 2] = v.z; y_[4 * j + 3] = v.w; } \
            _Pragma("unroll") for (int j = 0; j < 2; ++j) { float t8[8]; unpack8(((const LAS v4u*)(rg + RG_VP + pt_ * 128 + 32 * pq_))[j], t8); _Pragma("unroll") for (int e = 0; e < 8; ++e) vp_[8 * j + e] = t8[e]; \
                unpack8(((const LAS v4u*)(rg + RG_Z + pt_ * 128 + 32 * pq_))[j], t8); _Pragma("unroll") for (int e = 0; e < 8; ++e) z_[8 * j + e] = t8[e]; } \
            const float bon = ((const LAS float*)(rg + RG_BON))[pt_]; float sm = 0.f; \
            _Pragma("unroll") for (int j = 0; j < 16; ++j) sm += y_[j]; \
            sm += dppf<0xB1>(sm); sm += dppf<0x4E>(sm); const float mu = sm * (1.0f / 64.0f); float sq = 0.f; \
            _Pragma("unroll") for (int j = 0; j < 16; ++j) { y_[j] -= mu; sq += y_[j] * y_[j]; } \
            sq += dppf<0xB1>(sq); sq += dppf<0x4E>(sq); const float rstd = __builtin_amdgcn_rsqf(sq * (1.0f / 64.0f) + GN_EPS); \
            v4u o_[2]; \
            _Pragma("unroll") for (int j = 0; j < 16; j += 2) { const float g0 = (y_[j] * rstd * lw_[j] + lb_[j] + bon * vp_[j]) * (z_[j] * fsig(z_[j])), g1 = (y_[j + 1] * rstd * lw_[j + 1] + lb_[j + 1] + bon * vp_[j + 1]) * (z_[j + 1] * fsig(z_[j + 1])); \
                o_[j >> 3][(j >> 1) & 3] = (unsigned)tobf(g0) | ((unsigned)tobf(g1) << 16); } \
            v4u* gp = (v4u*)(G + (rowb + (size_t)(cc) * 16 + pt_) * 2048 + hh * 64 + 16 * pq_); gp[0] = o_[0]; gp[1] = o_[1]; } while (0)
        typedef unsigned short us2 __attribute__((ext_vector_type(2)));
        if (role == 0) { f32x4 ST[4][4];
#pragma unroll
            for (int i = 0; i < 4; ++i)
#pragma unroll
                for (int j = 0; j < 4; ++j) ST[i][j] = (f32x4){0.f, 0.f, 0.f, 0.f};
            CK_BAR();
            for (int c = 0; c < NCH; ++c) { ck_scan_chunk(ST, blk + BH_OPB + (c & 1) * CK_OPB, blk + BH_RING + (c % 3) * RG_SZ + RG_VP, (LAS float*)(blk + BH_Y + (c & 1) * 4096), c16, g); CK_BAR(); }
            float* so = F.out + O_WKVP + ((size_t)(l * BATCH + b) * A_HEADS + hh) * 4096;
#pragma unroll
            for (int ki = 0; ki < 4; ++ki)
#pragma unroll
                for (int vi = 0; vi < 4; ++vi) *(f32x4*)(so + (16 * vi + c16) * 64 + 16 * ki + 4 * g) = ST[ki][vi]; }
        else if (role == 1) { const int ln1 = lane_id(), vt_ = ln1 >> 2, vq_ = ln1 & 3; const unsigned voff_ = (unsigned)(vt_ * 2048 + hh * 64 + 16 * vq_); LAS f32x4* lwp = (LAS f32x4*)(blk + BH_LW); const LAS f32x4* prm = (const LAS f32x4*)(blk + BH_PRM);
            { const int ln = lane_id(), c1 = hh * 64 + ln; LAS float* pf = (LAS float*)(blk + BH_PRM); pf[ln] = pw0[c1]; pf[64 + ln] = pa0[c1]; pf[128 + ln] = l ? pv0[c1] : 0.f; pf[192 + ln] = pkk[c1]; pf[256 + ln] = pka[c1]; pf[320 + ln] = prk[c1]; LDS_WAIT(); asm volatile("" ::: "memory"); }
            v4u Ar[2], Ak[2], Av[2], Az[2], Aw[2], Aa[2], Ad[2], Af[2];
#pragma unroll
            for (int j = 0; j < 2; ++j) { Ad[j] = (v4u){0u, 0u, 0u, 0u}; Af[j] = Ad[j]; }
            CKV_LOAD(0, A); CKV_PREP(0, A); CKV_LOAD(1, A); CK_BAR();
            for (int c = 0; c < NCH; ++c) { if (c + 1 < NCH) { CKV_PREP(c + 1, A); if (c + 2 < NCH) CKV_LOAD(c + 2, A); } CK_BAR(); } }
        else if (role == 3) {
            const int ln3 = lane_id(), vt_ = ln3 >> 2, vq_ = ln3 & 3; const unsigned voff_ = (unsigned)(vt_ * 2048 + hh * 64 + 16 * vq_);
            v4u Ar[2], Ak[2], Av[2], Az[2], Aw[2], Aa[2], Ad[2], Af[2];
#pragma unroll
            for (int j = 0; j < 2; ++j) { Ad[j] = (v4u){0u, 0u, 0u, 0u}; Af[j] = Ad[j]; }
            CKV_LOAD(2, A); CK_BAR();
            for (int c = 0; c < NCH; ++c) {
#pragma unroll
                for (int j = 0; j < 2; ++j) asm volatile("" :: "v"(Ar[j]), "v"(Ak[j]), "v"(Av[j]), "v"(Az[j]), "v"(Aw[j]), "v"(Aa[j]), "v"(Ad[j]), "v"(Af[j]));
                if (c + 3 < NCH) CKV_LOAD(c + 3, A);
                CK_BAR(); } }
        else { const int ln2 = lane_id(), pt_ = ln2 >> 2, pq_ = ln2 & 3; float lw_[16], lb_[16];
#pragma unroll
            for (int j = 0; j < 16; ++j) { lw_[j] = plw[hh * 64 + 16 * pq_ + j]; lb_[j] = plb[hh * 64 + 16 * pq_ + j]; }
            CK_BAR();
            for (int c = 0; c < NCH; ++c) { if (c >= 1) CK_POST(c - 1); CK_BAR(); }
            CK_POST(NCH - 1); }
        __syncthreads();
#undef CK_PREP
#undef CKV_LOAD
#undef CKV_PREP
#undef CK_BAR
#undef CK_POST
    }
    const float* stt = (const float*)a->in[2] + (size_t)l * DEC_BATCH * A_HEADS * 4096;
    LAS float* sop = (LAS float*)(F.lds + F.wave * 2048);
    for (int it = F.gw; it < DEC_BATCH * A_HEADS; it += F.NGW) { const int b = it >> 5, hh = it & 31, ch = hh * 64 + lane; const size_t o = (size_t)(MP + b) * 2048 + ch;
        HeadPrm P; P.w0 = pw0[ch]; P.a0 = pa0[ch]; P.v0 = l ? pv0[ch] : 0.f; P.kk = pkk[ch]; P.ka = pka[ch]; P.rk = prk[ch]; P.lnw = plw[ch]; P.lnb = plb[ch];
        const float z = ldbf(Z + o); float bon;
        fs_prep_one(P, l, ldbf(R + o), ldbf(K + o), ldbf(V + o), ldbf(DW + o), ldbf(DA + o), l ? ldbf(DV + o) : 0.f, l ? ldbf(VF + o) : 0.f, sop, lane, bon);
        LDS_WAIT(); asm volatile("" ::: "memory");
        f32x2 S[32]; const float* si = stt + (size_t)it * 4096 + lane * 64;
#pragma unroll
        for (int k = 0; k < 32; k += 2) { const f32x4 v = *(const f32x4*)(si + 2 * k); S[k] = (f32x2){v.x, v.y}; S[k + 1] = (f32x2){v.z, v.w}; }
        const float y = wkv_step_lds(S, sop, lane), vp = sop[320 + lane];
        float* so = F.out + O_WKVS + ((size_t)l * DEC_BATCH * A_HEADS + it) * 4096 + lane * 64;
#pragma unroll
        for (int k = 0; k < 32; k += 2) *(f32x4*)(so + 2 * k) = (f32x4){S[k].x, S[k].y, S[k + 1].x, S[k + 1].y};
        G[o] = (bf16)f2bf(fs_post_one(P, y, vp, z, bon));
        LDS_WAIT(); asm volatile("" ::: "memory");
    }
#undef FS_PREP
#undef FS_POST
}

__device__ __forceinline__ void final_norm(Frame& F, cargs a) {
    const float* X = (const float*)(F.ws + WS_X); f32x4 w4[4]; load_row((const float*)a->in[35], LANE, w4);
    for (int m = F.gw; m < MP + DEC_BATCH; m += F.NGW) { f32x4 x[4]; load_row(X + (size_t)m * 1024, LANE, x); const float rs = row_rs(x);
        float* o = m < MP ? F.out + O_YP + (size_t)m * 1024 : F.out + O_YS + (size_t)(m - MP) * 1024;
#pragma unroll
        for (int j = 0; j < 4; ++j) ((f32x4*)o)[LANE + 64 * j] = x[j] * rs * w4[j]; }
}
__device__ __forceinline__ void b0c_kvpost(Frame& F, cargs a) {
    unsigned char* ws = F.ws; const float* KVR = (const float*)(ws + WS_KVR); bf16* CK = (bf16*)(ws + WS_CKVB); bf16* KP = (bf16*)(ws + WS_KPEB); const float* ROPE = (const float*)(ws + WS_ROPE);
    const f32x4 w4 = ((const f32x4*)a->in[27])[F.lane];
    for (int m = F.gw; m < MP + DEC_BATCH; m += F.NGW) { const float* row = KVR + (size_t)m * 320;
        const f32x4 v = ((const f32x4*)row)[F.lane]; const float ss = wave_sum((v.x * v.x + v.y * v.y) + (v.z * v.z + v.w * v.w));
        const float rs = 1.0f / sqrtf(ss * (1.0f / 256.0f) + NORM_EPS); const f32x4 c = v * rs * w4;
        float* oc = m < MP ? F.out + O_CKVP + (size_t)m * 256 : F.out + O_CKVS + (size_t)(m - MP) * 256; float* ok = m < MP ? F.out + O_KPEP + (size_t)m * 64 : F.out + O_KPES + (size_t)(m - MP) * 64;
        ((f32x4*)oc)[F.lane] = c; v2u pw; pw.x = pk2(c.x, c.y); pw.y = pk2(c.z, c.w); *(v2u*)(CK + (size_t)m * 256 + 4 * F.lane) = pw;
        if (F.lane < 32) { const int i = F.lane, p = m < MP ? (m & (SEQ - 1)) : SEQ; const float x1 = row[256 + i], x2 = row[288 + i], cs = ROPE[(p * 32 + i) * 2], sn = ROPE[(p * 32 + i) * 2 + 1];
            const float o1 = x1 * cs - x2 * sn, o2 = x2 * cs + x1 * sn; ok[i] = o1; ok[32 + i] = o2; *(unsigned*)(KP + (size_t)m * 64 + 2 * i) = pk2(o1, o2); }
    }
}
__device__ __forceinline__ void b1c_cq(Frame& F, cargs a, int l) {
    unsigned char* ws = F.ws; const float* QL = (const float*)(ws + WS_QL); bf16* CQ = (bf16*)(ws + WS_CQ); const float* w = (const float*)a->in[32] + l * 384;
    f32x2 w2[3];
#pragma unroll
    for (int j = 0; j < 3; ++j) w2[j] = *(const f32x2*)(w + 2 * F.lane + 128 * j);
    for (int m = F.gw; m < MT; m += F.NGW) { f32x2 v[3]; float ss = 0.f;
#pragma unroll
        for (int j = 0; j < 3; ++j) { v[j] = *(const f32x2*)(QL + (size_t)m * 384 + 2 * F.lane + 128 * j); ss += v[j].x * v[j].x + v[j].y * v[j].y; }
        const float rs = 1.0f / sqrtf(wave_sum(ss) * (1.0f / 384.0f) + NORM_EPS);
#pragma unroll
        for (int j = 0; j < 3; ++j) *(unsigned*)(CQ + (size_t)m * 384 + 2 * F.lane + 128 * j) = pk2(v[j].x * rs * w2[j].x, v[j].y * rs * w2[j].y); }
}
constexpr int AT_KP = 400, AT_VP = 136, AT_KBYTES = 64 * AT_KP, AT_VBYTES = 128 * AT_VP, AT_BUF = AT_KBYTES + AT_VBYTES;
__device__ __forceinline__ int crow(int r, int hi) { return (r & 3) + 8 * (r >> 2) + 4 * hi; }
typedef __bf16 bf16x8_nat __attribute__((ext_vector_type(8)));
typedef float f32x8 __attribute__((ext_vector_type(8)));
__device__ __forceinline__ bf16x8 pack8f(float a0, float a1, float a2, float a3, float a4, float a5, float a6, float a7) {
    return __builtin_bit_cast(bf16x8, __builtin_convertvector((f32x8){a0, a1, a2, a3, a4, a5, a6, a7}, bf16x8_nat)); }
__device__ __forceinline__ void attn_unit(Frame& F, int b, int hd, int qb) {
    unsigned char* ws = F.ws; const bf16* Q = (const bf16*)(ws + WS_Q);
    const bf16* Z = (const bf16*)(ws + WS_Z); bf16* G = (bf16*)(ws + WS_G);
    LAS unsigned char* Ks = F.lds; LAS unsigned char* Vs = F.lds + AT_KBYTES;
    const int lane = lane_id(), r32 = lane & 31, hi = lane >> 5, tid = F.wave * 64 + lane;
    const int qpos = qb * 256 + F.wave * 32 + r32; const size_t qrow = (size_t)b * SEQ + qpos;
    bf16x8 qf[12];
#pragma unroll
    for (int s = 0; s < 12; ++s) qf[s] = *(const bf16x8*)(Q + qrow * 3072 + hd * 192 + 16 * s + 8 * hi);
    f32x16 o[4];
#pragma unroll
    for (int d = 0; d < 4; ++d)
#pragma unroll
        for (int r = 0; r < 16; ++r) o[d][r] = 0.f;
    float mrow = -1e30f, lrow = 0.f;
    const int ntiles = 4 * qb + 4, wq0 = qb * 256 + F.wave * 32;
    const unsigned gK = (unsigned)((tid >> 4) * 4096 + (tid & 15) * 16), gP = (unsigned)((tid >> 3) * 128 + (tid & 7) * 16), gV = (unsigned)((tid >> 3) * (MP * 2) + (tid & 7) * 16);
    LAS unsigned char* lK = Ks + (tid >> 4) * AT_KP + (tid & 15) * 16; LAS unsigned char* lP = Ks + (tid >> 3) * AT_KP + 256 + (tid & 7) * 16; LAS unsigned char* lV = Vs + (tid >> 3) * AT_VP + (tid & 7) * 16;
    const unsigned char* kb0 = ws + WS_KN + ((size_t)b * SEQ * 2048 + hd * 128) * 2; const unsigned char* pb0 = ws + WS_KPEB + (size_t)b * SEQ * 128; const unsigned char* vb0 = ws + WS_VT + ((size_t)hd * 128 * MP + (size_t)b * SEQ) * 2;
    v4u pk_[3], pv_[2];
#define AT_FETCH(kt_) do { const unsigned char* kb = kb0 + (size_t)(kt_) * (64 * 4096); const unsigned char* pb = pb0 + (size_t)(kt_) * (64 * 128); const unsigned char* vb = vb0 + (size_t)(kt_) * 128; \
        pk_[0] = *(const v4u*)(kb + gK); pk_[1] = *(const v4u*)(kb + 32 * 4096 + gK); pk_[2] = *(const v4u*)(pb + gP); pv_[0] = *(const v4u*)(vb + gV); pv_[1] = *(const v4u*)(vb + (size_t)64 * MP * 2 + gV); } while (0)
    AT_FETCH(0);
    const LAS unsigned char* kA = Ks + r32 * AT_KP + hi * 16;
    const LAS unsigned char* vA = Vs + r32 * AT_VP + hi * 8;
#define AT_KF(st_) (*(const LAS bf16x8*)(kA + ((st_) & 1) * (32 * AT_KP) + ((st_) >> 1) * 32))
#define AT_VF(st_, j_) (*(const LAS v2u*)(vA + ((st_) & 3) * (32 * AT_VP) + ((st_) >> 2) * 32 + 16 * (j_)))
    constexpr int KD = 6, VD = 4;
    for (int kt = 0; kt < ntiles; ++kt) {
        __syncthreads();
        *(LAS v4u*)lK = pk_[0]; *(LAS v4u*)(lK + 32 * AT_KP) = pk_[1]; *(LAS v4u*)lP = pk_[2];
#pragma unroll
        for (int i = 0; i < 2; ++i) { *(LAS v2u*)(lV + i * 64 * AT_VP) = (v2u){pv_[i].x, pv_[i].y}; *(LAS v2u*)(lV + i * 64 * AT_VP + 8) = (v2u){pv_[i].z, pv_[i].w}; }
        __syncthreads();
        if (kt + 1 < ntiles) AT_FETCH(kt + 1);
        if (kt * 64 > wq0 + 31) continue;
        f32x16 s0, s1;
#pragma unroll
        for (int r = 0; r < 16; ++r) { s0[r] = 0.f; s1[r] = 0.f; }
        bf16x8 kf[8];
#pragma unroll
        for (int st = 0; st < KD; ++st) kf[st] = AT_KF(st);
#pragma unroll
        for (int st = 0; st < 24; ++st) {
            if (st + KD < 24) kf[(st + KD) & 7] = AT_KF(st + KD);
            if (st & 1) s1 = __builtin_amdgcn_mfma_f32_32x32x16_bf16(kf[st & 7], qf[st >> 1], s1, 0, 0, 0);
            else s0 = __builtin_amdgcn_mfma_f32_32x32x16_bf16(kf[st & 7], qf[st >> 1], s0, 0, 0, 0);
            __builtin_amdgcn_sched_barrier(0);
        }
        v2u vf[8][2];
#pragma unroll
        for (int st = 0; st < VD; ++st) { vf[st][0] = AT_VF(st, 0); vf[st][1] = AT_VF(st, 1); }
        __builtin_amdgcn_sched_barrier(0);
        if (kt * 64 + 63 > wq0) {
#pragma unroll
            for (int r = 0; r < 16; ++r) { const int key = kt * 64 + crow(r, hi); if (key > qpos) s0[r] = -__builtin_inff(); if (key + 32 > qpos) s1[r] = -__builtin_inff(); } }
        float tmax = s0[0];
#pragma unroll
        for (int r = 1; r < 16; ++r) tmax = fmaxf(tmax, s0[r]);
#pragma unroll
        for (int r = 0; r < 16; ++r) tmax = fmaxf(tmax, s1[r]);
        tmax = xor32_max(tmax);
        if (__builtin_amdgcn_ballot_w64(tmax > mrow + 8.0f) != 0ull) { const float mnew = fmaxf(mrow, tmax), alpha = __builtin_amdgcn_exp2f(mrow - mnew); mrow = mnew; lrow *= alpha;
#pragma unroll
            for (int d = 0; d < 4; ++d)
#pragma unroll
                for (int r = 0; r < 16; ++r) o[d][r] *= alpha; }
        float ps = 0.f;
#pragma unroll
        for (int r = 0; r < 16; ++r) { s0[r] = __builtin_amdgcn_exp2f(s0[r] - mrow); s1[r] = __builtin_amdgcn_exp2f(s1[r] - mrow); ps += s0[r] + s1[r]; }
        lrow += ps;
        bf16x8 pb[4];
        pb[0] = pack8f(s0[0], s0[1], s0[2], s0[3], s0[4], s0[5], s0[6], s0[7]); pb[1] = pack8f(s0[8], s0[9], s0[10], s0[11], s0[12], s0[13], s0[14], s0[15]);
        pb[2] = pack8f(s1[0], s1[1], s1[2], s1[3], s1[4], s1[5], s1[6], s1[7]); pb[3] = pack8f(s1[8], s1[9], s1[10], s1[11], s1[12], s1[13], s1[14], s1[15]);
        __builtin_amdgcn_sched_barrier(0);
#pragma unroll
        for (int st = 0; st < 16; ++st) {
            if (st + VD < 16) { vf[(st + VD) & 7][0] = AT_VF(st + VD, 0); vf[(st + VD) & 7][1] = AT_VF(st + VD, 1); }
            const v4u av = (v4u){vf[st & 7][0].x, vf[st & 7][0].y, vf[st & 7][1].x, vf[st & 7][1].y};
            o[st & 3] = __builtin_amdgcn_mfma_f32_32x32x16_bf16(__builtin_bit_cast(bf16x8, av), pb[st >> 2], o[st & 3], 0, 0, 0);
            __builtin_amdgcn_sched_barrier(0);
        }
    }
#undef AT_FETCH
#undef AT_KF
#undef AT_VF
    lrow = xor32_sum(lrow); const float inv = 1.0f / lrow;
#pragma unroll
    for (int d = 0; d < 4; ++d)
#pragma unroll
        for (int rg = 0; rg < 4; ++rg) { const int dd = 32 * d + 8 * rg + 4 * hi; const size_t off = qrow * 2048 + hd * 128 + dd;
            const v2u zz = *(const v2u*)(Z + off); const float z0 = bflo(zz.x), z1 = bfhi(zz.x), z2 = bflo(zz.y), z3 = bfhi(zz.y);
            v2u w; w.x = pk2(o[d][4 * rg] * inv * (z0 * sigmoidf_(z0)), o[d][4 * rg + 1] * inv * (z1 * sigmoidf_(z1))); w.y = pk2(o[d][4 * rg + 2] * inv * (z2 * sigmoidf_(z2)), o[d][4 * rg + 3] * inv * (z3 * sigmoidf_(z3)));
            *(v2u*)(G + off) = w; }
}
__device__ __forceinline__ void b2a_attn_prompt(Frame& F) {
    const int vcu = (F.G % 8 == 0) ? (F.bid % 8) * (F.G / 8) + F.bid / 8 : F.bid;
    for (int u = vcu; u < BATCH * B_HEADS * 4; u += F.G) { const int bh = u >> 2, qp = u & 3;
        for (int hf = 0; hf < 2; ++hf) attn_unit(F, bh >> 4, bh & 15, hf ? qp : 7 - qp); }
    __syncthreads();
}

constexpr int DT_P = 656;
typedef short v4i16_t __attribute__((ext_vector_type(4)));
__device__ __forceinline__ void b2b_attn_sample(Frame& F, cargs a) {
    unsigned char* ws = F.ws; const float* cckv = (const float*)a->in[4]; const float* ckpe = (const float*)a->in[5]; const int* ptab = (const int*)a->in[6];
    const bf16* QA = (const bf16*)(ws + WS_QABS); float* OP = (float*)(ws + WS_OPART); float* ML = (float*)(ws + WS_ML);
    LAS unsigned char* T = F.lds;
    F.lane = lane_id();
    const int lane = F.lane, hcol = lane & 15, g = lane >> 4, tid = F.wave * 64 + lane, q4 = (lane & 15) >> 2, p4 = lane & 3;
    const bf16* Q = (const bf16*)(ws + WS_Q); const float* wuk = (const float*)a->in[28]; bf16* QAg = (bf16*)(ws + WS_QABS);
    LAS bf16* QAl = (LAS bf16*)(F.lds + 49152);
    for (int hu = F.bid; hu < DEC_BATCH * 2; hu += F.G) for (int si = 0; si < 4; ++si) { const int b = hu >> 1, sp = (hu & 1) * 4 + si;
      if (si == 0) {
        __syncthreads();
        for (int hh = 0; hh < 2; ++hh) { const int hd = 2 * F.wave + hh; const bf16* qn = Q + (size_t)(MP + b) * 3072 + hd * 192;
            float acc[4] = {0.f, 0.f, 0.f, 0.f};
            for (int n = 0; n < 128; n += 4) { const v2u qu = *(const v2u*)(qn + n); const f32x4 q4 = (f32x4){bflo(qu.x), bfhi(qu.x), bflo(qu.y), bfhi(qu.y)};
#pragma unroll
                for (int cc = 0; cc < 4; ++cc) { const f32x4 w4 = *(const f32x4*)(wuk + (size_t)(4 * lane + cc) * 2048 + hd * 128 + n); acc[cc] += (q4.x * w4.x + q4.y * w4.y) + (q4.z * w4.z + q4.w * w4.w); } }
            const v2u w = (v2u){pk2(acc[0], acc[1]), pk2(acc[2], acc[3])}; *(LAS v2u*)(QAl + hd * 320 + 4 * lane) = w;
            const bf16 rp = qn[128 + 2 * (lane & 31) + (lane >> 5)]; QAl[hd * 320 + 256 + lane] = rp;
            if ((hu & 1) == 0) { *(v2u*)(QAg + (size_t)(b * 16 + hd) * 320 + 4 * lane) = w; QAg[(size_t)(b * 16 + hd) * 320 + 256 + lane] = rp; } }
        __syncthreads(); }
        bf16x8 qf[10];
#pragma unroll
        for (int s = 0; s < 10; ++s) qf[s] = *(const LAS bf16x8*)(QAl + hcol * 320 + 32 * s + 8 * g);
        f32x4 o[2]; o[0] = (f32x4){0.f, 0.f, 0.f, 0.f}; o[1] = o[0]; float mrow = -1e30f, lrow = 0.f;
        f32x4 pf_[10];
#define DT_FETCH(t_) do { const int pp = ptab[b * NPAGES + sp * 8 + ((t_) >> 1)], tok0 = ((t_) & 1) * 64; \
            _Pragma("unroll") for (int i = 0; i < 10; ++i) { const int c = tid + 512 * i, key = c / 80, ch = c % 80; const size_t tk = (size_t)pp * PAGE + tok0 + key; \
                pf_[i] = ch < 64 ? *(const f32x4*)(cckv + tk * 256 + ch * 4) : *(const f32x4*)(ckpe + tk * 64 + (ch - 64) * 4); } } while (0)
        DT_FETCH(0);
        for (int t = 0; t < 16; ++t) {
            __syncthreads();
#pragma unroll
            for (int i = 0; i < 10; ++i) { const int c = tid + 512 * i, key = c / 80, ch = c % 80; *(LAS v2u*)(T + key * DT_P + ch * 8) = (v2u){pk2(pf_[i].x, pf_[i].y), pk2(pf_[i].z, pf_[i].w)}; }
            __syncthreads();
            if (t + 1 < 16) DT_FETCH(t + 1);
            f32x4 sc[4];
#pragma unroll
            for (int kg = 0; kg < 4; ++kg) { sc[kg] = (f32x4){0.f, 0.f, 0.f, 0.f};
#pragma unroll
                for (int s = 0; s < 10; ++s) { const bf16x8 kf = *(const LAS bf16x8*)(T + (16 * kg + hcol) * DT_P + (32 * s + 8 * g) * 2);
                    sc[kg] = __builtin_amdgcn_mfma_f32_16x16x32_bf16(kf, qf[s], sc[kg], 0, 0, 0); } }
            float tmax = sc[0][0];
#pragma unroll
            for (int kg = 0; kg < 4; ++kg)
#pragma unroll
                for (int r = 0; r < 4; ++r) tmax = fmaxf(tmax, sc[kg][r]);
            tmax = fmaxf(tmax, swz_xor<16>(tmax)); tmax = xor32_max(tmax);
            const float mnew = fmaxf(mrow, tmax), alpha = __builtin_amdgcn_exp2f(mrow - mnew); mrow = mnew;
            float ps = 0.f;
#pragma unroll
            for (int kg = 0; kg < 4; ++kg)
#pragma unroll
                for (int r = 0; r < 4; ++r) { sc[kg][r] = __builtin_amdgcn_exp2f(sc[kg][r] - mnew); ps += sc[kg][r]; }
            lrow = lrow * alpha + ps; o[0] *= alpha; o[1] *= alpha;
#pragma unroll
            for (int kk = 0; kk < 2; ++kk) { const bf16x8 pbf = pack8f(sc[2 * kk][0], sc[2 * kk][1], sc[2 * kk][2], sc[2 * kk][3], sc[2 * kk + 1][0], sc[2 * kk + 1][1], sc[2 * kk + 1][2], sc[2 * kk + 1][3]);
#pragma unroll
                for (int ci = 0; ci < 2; ++ci) { const int cb = 2 * F.wave + ci; LAS unsigned char* ap = T + (32 * kk + 4 * g + q4) * DT_P + (16 * cb + 4 * p4) * 2;
                    const s16x4 lo = __builtin_bit_cast(s16x4, __builtin_amdgcn_ds_read_tr16_b64_v4i16((LAS v4i16_t*)ap)), hi2 = __builtin_bit_cast(s16x4, __builtin_amdgcn_ds_read_tr16_b64_v4i16((LAS v4i16_t*)(ap + 16 * DT_P)));
                    const bf16x8 av = (bf16x8){lo[0], lo[1], lo[2], lo[3], hi2[0], hi2[1], hi2[2], hi2[3]};
                    o[ci] = __builtin_amdgcn_mfma_f32_16x16x32_bf16(av, pbf, o[ci], 0, 0, 0); } }
        }
#undef DT_FETCH
        lrow += swz_xor<16>(lrow); lrow = xor32_sum(lrow);
        const size_t pb_ = (size_t)(b * 8 + sp) * 16 + hcol;
#pragma unroll
        for (int ci = 0; ci < 2; ++ci) *(f32x4*)(OP + pb_ * 256 + 16 * (2 * F.wave + ci) + 4 * g) = o[ci];
        if (F.wave == 0 && g == 0) { ML[pb_ * 2] = mrow; ML[pb_ * 2 + 1] = lrow; }
    }
    __syncthreads();
}
__device__ __forceinline__ void b2c_combine(Frame& F, cargs a) {
    unsigned char* ws = F.ws; const bf16* QA = (const bf16*)(ws + WS_QABS); const float* OP = (const float*)(ws + WS_OPART); const float* ML = (const float*)(ws + WS_ML);
    const float* wuv = (const float*)a->in[29]; const bf16* Z = (const bf16*)(ws + WS_Z); bf16* G = (bf16*)(ws + WS_G);
    LAS float* scr = (LAS float*)(F.lds + F.wave * 1024);
    for (int it = F.gw; it < DEC_BATCH * B_HEADS; it += F.NGW) { const int b = it >> 4, hd = it & 15; const int lane = F.lane;
        const float* cn = F.out + O_CKVS + (size_t)b * 256; const float* kn = F.out + O_KPES + (size_t)b * 64; const bf16* qa = QA + (size_t)it * 320;
        const f32x4 c4 = *(const f32x4*)(cn + 4 * lane); const v2u qv = *(const v2u*)(qa + 4 * lane);
        float sn = (bflo(qv.x) * c4.x + bfhi(qv.x) * c4.y) + (bflo(qv.y) * c4.z + bfhi(qv.y) * c4.w);
        sn += __builtin_bit_cast(float, (unsigned)qa[256 + lane] << 16) * kn[lane];
        sn = wave_sum(sn);
        float ms[8], ls[8], M = sn;
#pragma unroll
        for (int s = 0; s < 8; ++s) { ms[s] = ML[((size_t)(b * 8 + s) * 16 + hd) * 2]; ls[s] = ML[((size_t)(b * 8 + s) * 16 + hd) * 2 + 1]; M = fmaxf(M, ms[s]); }
        const float en = __builtin_amdgcn_exp2f(sn - M); float L = en; f32x4 acc = c4 * en;
#pragma unroll
        for (int s = 0; s < 8; ++s) { const float e = __builtin_amdgcn_exp2f(ms[s] - M); L += e * ls[s]; acc += *(const f32x4*)(OP + ((size_t)(b * 8 + s) * 16 + hd) * 256 + 4 * lane) * e; }
        acc *= 1.0f / L;
        *(LAS f32x4*)(scr + 4 * lane) = acc; LDS_WAIT(); asm volatile("" ::: "memory");
        f32x2 ov = (f32x2){0.f, 0.f};
        for (int c = 0; c < 256; ++c) { const float ol = scr[c]; ov += *(const f32x2*)(wuv + (size_t)c * 2048 + hd * 128 + 2 * lane) * ol; }
        const size_t off = (size_t)(MP + b) * 2048 + hd * 128 + 2 * lane; const unsigned zz = *(const unsigned*)(Z + off); const float z0 = bflo(zz), z1 = bfhi(zz);
        *(unsigned*)(G + off) = pk2(ov.x * (z0 * sigmoidf_(z0)), ov.y * (z1 * sigmoidf_(z1)));
        LDS_WAIT(); asm volatile("" ::: "memory");
    }
}

#ifndef MK_SPLIT
#define MK_SPLIT 0
#endif
#ifndef MK_DIAG
#define MK_DIAG 0
#endif
constexpr int NPHASES = 1 + 4 + 5 + 7 + 6 + 1 + (MK_DIAG ? 1 : 0);
#define PH_BEGIN if (ph >= lo && ph < hi) { cargs ap = (cargs)__builtin_amdgcn_kernarg_segment_ptr(); asm volatile("" : "+s"(ap)); Frame F = make_frame(ap, wave0, (LAS unsigned char*)lds); unsigned char* ws = F.ws;
#define PH_END } if (ph >= lo && ph + 1 < hi) xcd_barrier(bar); ++ph;
typedef pg8::StaticOrder SO;
#define GEMM_B(ACT_, A_, Bt_, M_, N_, K_, O_, ldc_, nvalid_, nstore_) do { pg8::Gemm g_{(const pg8::bf16_t*)(A_), (const pg8::bf16_t*)(Bt_), (M_), (N_), (K_)}; SO S_; S_.init((M_), (N_), F.G, F.bid); \
    pg8::EpiB<ACT_> E_{(pg8::bf16_t*)(O_), (ldc_), (nvalid_), (nstore_)}; pg8::gemm_phase<pg8::EpiB<ACT_>, SO, true, true>(F.lds, g_, S_, E_, F.wave); } while (0)
#define GEMM_F(ACT_, HB_, HBI_, A_, Bt_, M_, N_, K_, O_, base_, bias_, ldc_, nstore_) do { int kk_ = (K_); asm volatile("" : "+s"(kk_)); pg8::Gemm g_{(const pg8::bf16_t*)(A_), (const pg8::bf16_t*)(Bt_), (M_), (N_), kk_}; SO S_; S_.init((M_), (N_), F.G, F.bid); \
    pg8::EpiF<ACT_, HB_, HBI_> E_{(float*)(O_), (const float*)(base_), (const float*)(bias_), (ldc_), (nstore_)}; pg8::gemm_phase<pg8::EpiF<ACT_, HB_, HBI_>, SO, true, true>(F.lds, g_, S_, E_, F.wave); } while (0)

#define OUTPROJ(Wt_, base_) do { \
    { pg8::Gemm g_{(const pg8::bf16_t*)(ws + WS_G), (const pg8::bf16_t*)(Wt_), MT, 1024, 256, 2048}; pg8::SliceOrder S_{MP / 256, 4, 8, F.G, F.bid, 512}; pg8::EpiFA E_{(float*)(ws + WS_X), 1024, MP + DEC_BATCH}; \
      pg8::gemm_phase<pg8::EpiFA, pg8::SliceOrder, true, true>(F.lds, g_, S_, E_, F.wave); } \
    GEMM_F(0, true, false, ws + WS_G, (Wt_), MP, 1024, 2048, ws + WS_X, (base_), nullptr, 1024, 1024); } while (0)
__global__ void __launch_bounds__(NTHR, 2) mk_fwd(Args args) {
    extern __shared__ __attribute__((aligned(16))) unsigned char lds[];
    const int wave0 = __builtin_amdgcn_readfirstlane(threadIdx.x >> 6);
    for (int u = threadIdx.x; u < (LDS_BYTES - LDSCTL_OFF) / 4; u += NTHR) ((LAS unsigned*)(lds + LDSCTL_OFF))[u] = 0u;
    __syncthreads();
    XcdBarrier bar = xcd_barrier_post((unsigned*)(args.ws + WS_CTL) + CW_BAR + args.li * XCD_BAR_WORDS, (volatile LAS unsigned*)((LAS unsigned char*)lds + LDSCTL_OFF), (unsigned)wave0);
    int ph = 0; const int lo = args.ph_lo, hi = args.ph_hi;

    PH_BEGIN p0_prologue(F, ap); __syncthreads(); a1_prepass(F, ap, 0); PH_END

    for (int l = 0; l < 2; ++l) {
        if (l > 0) { PH_BEGIN a1_prepass(F, ap, l); PH_END }
        PH_BEGIN
            { static_assert(AM_STRIDE == (size_t)130 * 256 * 1024 * 2, "A-operand buffers sit 130 row panels apart");
              pg8::Gemm g_{(const pg8::bf16_t*)(ws + WS_AM), (const pg8::bf16_t*)(ws + WS_WIN + (size_t)l * WIN_L), MT, 2048, 1024}; pg8::GroupOrderA2 S_; S_.init(MT, F.G, F.bid, l ? 7 : 6);
              static_assert(WS_K == WS_R + BIGB && WS_V0 == WS_R + 2 * BIGB && WS_V1 == WS_R + 3 * BIGB && WS_Z == WS_R + 4 * BIGB && WS_LA == WS_LW + 9 * MiB && WS_LV == WS_LW + 18 * MiB, "output buffers are equally spaced");
              pg8::EpiA2 E_{(pg8::bf16_t*)(ws + WS_R), BIGB / 2, 2 + l, (pg8::bf16_t*)(ws + WS_LW), 9 * MiB / 2};
              pg8::gemm_phase<pg8::EpiA2, pg8::GroupOrderA2, true, true>(F.lds, g_, S_, E_, F.wave); }
        PH_END
        PH_BEGIN
#define GEMM_BA(ACT_, A_, Bt_, O_, bias_) do { int kk_ = 128; asm volatile("" : "+s"(kk_)); pg8::Gemm g_{(const pg8::bf16_t*)(A_), (const pg8::bf16_t*)(Bt_), MT, 2048, kk_}; SO S_; S_.init(MT, 2048, F.G, F.bid); \
    pg8::EpiBA<ACT_> E_{(pg8::bf16_t*)(O_), (const float*)(bias_)}; pg8::gemm_phase<pg8::EpiBA<ACT_>, SO, true, true>(F.lds, g_, S_, E_, F.wave); } while (0)
            GEMM_BA(4, ws + WS_LW, ws + WS_W2 + (size_t)l * (MiB / 2), ws + WS_WD, (const float*)ap->in[10] + l * 2048);
            GEMM_BA(3, ws + WS_LA, ws + WS_W2 + (size_t)(2 + l) * (MiB / 2), ws + WS_IA, (const float*)ap->in[13] + l * 2048);
            if (l) GEMM_BA(3, ws + WS_LV, ws + WS_W2 + (size_t)4 * (MiB / 2), ws + WS_VG, (const float*)ap->in[16]);
#undef GEMM_BA
        PH_END
        PH_BEGIN a5_fused(F, ap, l); PH_END
        PH_BEGIN
            OUTPROJ(ws + WS_WO + (size_t)l * 4 * MiB, l == 0 ? (const void*)ap->in[0] : (const void*)(ws + WS_X));
        PH_END
    }

#define MLA_INPROJ(l_, A_) do { \
        { pg8::Gemm g_{(const pg8::bf16_t*)(A_), (const pg8::bf16_t*)(ws + WS_WQ + (size_t)(l_) * MiB), MT, 512, 1024}; SO S_; S_.init(MT, 512, F.G, F.bid); \
          pg8::EpiCQ E_{(pg8::bf16_t*)(ws + WS_CQ), (const float*)ap->in[32] + (l_) * 384, (float*)(ws + WS_CTL + CW_RSQ + (size_t)(l_) * 262144)}; pg8::gemm_phase<pg8::EpiCQ, SO, true, true>(F.lds, g_, S_, E_, F.wave); } \
        GEMM_B(0, (A_), ws + WS_WZ + (size_t)(l_) * 4 * MiB, MT, 2048, 1024, ws + WS_Z, 2048, 2048, 2048); } while (0)
#define MLA_QUP(l_) do { pg8::Gemm g_{(const pg8::bf16_t*)(ws + WS_CQ), (const pg8::bf16_t*)(ws + WS_WUQ + (size_t)(l_) * (5 * MiB / 2)), MT, 3072, 384}; SO S_; S_.init(MT, 3072, F.G, F.bid); \
        pg8::EpiQ E_{(pg8::bf16_t*)(ws + WS_Q), (const float*)(ws + WS_ROPE), ATTN_SCALE * LOG2E, MP, SEQ, (const float*)(ws + WS_CTL + CW_RSQ + (size_t)(l_) * 262144)}; pg8::gemm_phase<pg8::EpiQ, SO, true, true>(F.lds, g_, S_, E_, F.wave); } while (0)
    for (int l = 0; l < 2; ++l) {
        PH_BEGIN if (l == 0) norm2_rows_bf16(F, (const float*)(ws + WS_X), (const float*)ap->in[25], (bf16*)(ws + WS_AM), (const float*)ap->in[30], (bf16*)(ws + WS_AM + AM_STRIDE));
                 else norm_rows_bf16(F, (const float*)(ws + WS_X), (const float*)ap->in[30] + l * 1024, (bf16*)(ws + WS_AM)); PH_END
        PH_BEGIN if (l == 0) GEMM_F(0, false, false, ws + WS_AM, ws + WS_WDKV, MT, 512, 1024, ws + WS_KVR, nullptr, nullptr, 320, 320);
                 MLA_INPROJ(l, ws + WS_AM + (l == 0 ? AM_STRIDE : 0)); PH_END
        if (l == 0) { PH_BEGIN b0c_kvpost(F, ap); PH_END }
        PH_BEGIN if (l == 0) { GEMM_B(0, ws + WS_CKVB, ws + WS_WUK, MP, 2048, 256, ws + WS_KN, 2048, 2048, 2048);
                               GEMM_B(0, ws + WS_WUV, ws + WS_CKVB, 2048, MP, 256, ws + WS_VT, MP, MP, MP); }
                 MLA_QUP(l); PH_END
        PH_BEGIN b2a_attn_prompt(F); b2b_attn_sample(F, ap); PH_END
        PH_BEGIN b2c_combine(F, ap); PH_END
        PH_BEGIN OUTPROJ(ws + WS_WBO + (size_t)l * 4 * MiB, ws + WS_X); PH_END
    }
#undef MLA_INPROJ
#undef MLA_QUP

    PH_BEGIN final_norm(F, ap); PH_END
#if MK_DIAG
    PH_BEGIN
        const size_t offs[11] = {O_YP, O_YS, O_WKVP, O_SHP, O_CKVP, O_KPEP, O_WKVS, O_SHS, O_CKVS, O_KPES, O_END};
        for (int k = 1; k < 10; ++k) { const float f = 1.0f + sqrtf(2e-4f * (float)k);
            for (size_t i = offs[k] + (size_t)(F.bid * NTHR + F.wave * 64 + F.lane); i < offs[k + 1]; i += (size_t)F.NT) F.out[i] *= f; }
    PH_END
#endif
}

extern "C" void kernel_launch(void* const* d_in, const int* in_sizes, int n_in, void* d_out, int out_size, void* d_ws, size_t ws_size, hipStream_t stream) {
    static int grid = 0;
    if (grid == 0) {
        if (n_in != 36 || (size_t)out_size != O_END || ws_size < WS_NEED) { fprintf(stderr, "kernel_launch: unexpected sizes: n_in %d out %d (want %zu) ws %zu (need %zu)\n", n_in, out_size, (size_t)O_END, ws_size, (size_t)WS_NEED); grid = -1; return; }
        int dev = 0, cus = 0, per_cu = 0;
        if (hipGetDevice(&dev) != hipSuccess || hipDeviceGetAttribute(&cus, hipDeviceAttributeMultiprocessorCount, dev) != hipSuccess) { grid = -1; return; }
        if (hipFuncSetAttribute((const void*)mk_fwd, hipFuncAttributeMaxDynamicSharedMemorySize, LDS_BYTES) != hipSuccess) { fprintf(stderr, "kernel_launch: hipFuncSetAttribute failed\n"); grid = -1; return; }
        if (hipOccupancyMaxActiveBlocksPerMultiprocessor(&per_cu, (const void*)mk_fwd, NTHR, LDS_BYTES) != hipSuccess || per_cu < 1) fprintf(stderr, "kernel_launch: occupancy query reports %d\n", per_cu);
        (void)hipGetLastError();
        grid = cus;
    }
    if (grid < 0) return;
    if (hipMemsetAsync((char*)d_ws + WS_CTL, 0, CTL_ZERO_BYTES, stream) != hipSuccess) { fprintf(stderr, "kernel_launch: memset failed\n"); return; }
    Args a{};
    for (int i = 0; i < 36; ++i) a.in[i] = d_in[i];
    a.out = (float*)d_out; a.ws = (unsigned char*)d_ws;
#if MK_SPLIT
    for (int li = 0; li < NPHASES; ++li) { a.ph_lo = li; a.ph_hi = li + 1; a.li = li;
        hipLaunchKernelGGL(mk_fwd, dim3(grid), dim3(NTHR), LDS_BYTES, stream, a); }
#else
    a.ph_lo = 0; a.ph_hi = NPHASES; a.li = 0;
    hipLaunchKernelGGL(mk_fwd, dim3(grid), dim3(NTHR), LDS_BYTES, stream, a);
#endif
    const hipError_t le = hipPeekAtLastError();
    if (le != hipSuccess) fprintf(stderr, "kernel_launch: launch failed: %s\n", hipGetErrorName(le));
}
```

```cpp
#include <hip/hip_runtime.h>
#include <cstdio>
#include <cstdint>
namespace pg8 {
#define PG8_LAS __attribute__((address_space(3)))
typedef unsigned short bf16_t;
typedef short bf16x8 __attribute__((ext_vector_type(8)));
typedef float f32x4 __attribute__((ext_vector_type(4)));
typedef unsigned u32x4 __attribute__((ext_vector_type(4)));
constexpr int BM = 256, BK = 64, HALF = 128, HTB = HALF * BK * 2  , STAGE_BYTES = 8 * HTB, NXCD = 8, WGM = 8;

__host__ __device__ __forceinline__ int lds_byte(int r, int c) { const int st = (r >> 4) * 2 + (c >> 5), rr = r & 15, cc = c & 31, ob = rr * 64 + cc * 2; return st * 1024 + (ob ^ (((ob >> 9) & 1) << 5)); }
__host__ __device__ __forceinline__ void stage_rc(int b, int& R, int& C) { const int st = b / 1024, sb = b % 1024, swz = sb ^ (((sb >> 9) & 1) << 5); R = (st >> 1) * 16 + swz / 64; C = (st & 1) * 32 + (swz % 64) / 2; }
__host__ __device__ __forceinline__ int perm32(int rho) { const int n = rho >> 4, i = rho & 15; return 8 * (i >> 2) + 4 * n + (i & 3); }

struct Unit { int pm, pn; int ko; };
struct Gemm { const bf16_t* A; const bf16_t* Bt; int M, N, K; int ld; };

struct StaticOrder {
    int nM, nN, nwg, G, c;
    __host__ __device__ void init(int M, int N, int G_, int c_) { nM = M / BM; nN = N / BM; nwg = nM * nN; G = G_; c = c_; }
    __host__ __device__ bool next(int i, Unit& u) const {
        const long L = (long)i * G + c; if (L >= nwg) return false;
        int wgid = (int)L; { const int q = nwg / NXCD, r = nwg % NXCD, xcd = wgid % NXCD, off = wgid / NXCD; wgid = (xcd < r ? xcd * (q + 1) : r * (q + 1) + (xcd - r) * q) + off; }
        const int nig = WGM * nN, gid = wgid / nig, fm = gid * WGM, gsz = (nM - fm) < WGM ? (nM - fm) : WGM;
        u.pm = fm + ((wgid % nig) % gsz); u.pn = (wgid % nig) / gsz; u.ko = 0; return true;
    }
    __device__ __forceinline__ void a_ready(const Unit&) const {}
    __device__ __forceinline__ void done(const Unit&) const {}
};

__device__ __forceinline__ unsigned cvt_pk_bf16(float lo, float hi) { unsigned r; asm volatile("v_cvt_pk_bf16_f32 %0, %1, %2" : "=v"(r) : "v"(lo), "v"(hi)); return r; }
typedef float f32x2 __attribute__((ext_vector_type(2)));
__device__ __forceinline__ float act_apply(int ACT, float x) {
    if (ACT == 1) return 1.0f - 2.0f / (1.0f + __expf(2.0f * x));
    if (ACT == 2) return __expf(-0.6065306597126334f / (1.0f + __expf(-x)));
    if (ACT == 3) return 1.0f / (1.0f + __expf(-x));
    return x;
}
template <int ACT> struct EpiB {
    static constexpr bool PERM = true, AFTER_DRAIN = false;
    bf16_t* O; int ldc; int nvalid; int nstore;
    __device__ __forceinline__ void operator()(const f32x4 (&acc)[2][2][4][2], const Unit& u, int wr, int wc, int, int) const {
        int lane_; asm volatile("v_mbcnt_lo_u32_b32 %0, -1, 0\n\tv_mbcnt_hi_u32_b32 %0, -1, %0" : "=v"(lane_)); const int fr = lane_ & 15, fq = lane_ >> 4;
        const int row0 = u.pm * BM + wr * 64 + fr, col0 = u.pn * BM + wc * 32 + 8 * fq;
#pragma unroll
        for (int ai = 0; ai < 2; ++ai)
#pragma unroll
            for (int m = 0; m < 4; ++m) { bf16_t* rowp = O + (size_t)(row0 + ai * HALF + m * 16) * ldc + col0;
#pragma unroll
                for (int bj = 0; bj < 2; ++bj) { const int c = col0 + bj * HALF; if (c >= nstore) continue;
                    f32x4 v0 = acc[ai][bj][m][0], v1 = acc[ai][bj][m][1];
                    if (ACT != 0) {
#pragma unroll
                        for (int e = 0; e < 4; ++e) { v0[e] = act_apply(ACT, v0[e]); v1[e] = act_apply(ACT, v1[e]); } }
                    u32x4 w; w.x = cvt_pk_bf16(v0[0], v0[1]); w.y = cvt_pk_bf16(v0[2], v0[3]); w.z = cvt_pk_bf16(v1[0], v1[1]); w.w = cvt_pk_bf16(v1[2], v1[3]);
                    if (c >= nvalid) w = (u32x4){0u, 0u, 0u, 0u};
                    *(u32x4*)(rowp + bj * HALF) = w; } }
    }
};
template <int ACT, bool HAS_BASE, bool HAS_BIAS> struct EpiF {
    static constexpr bool PERM = false, AFTER_DRAIN = false;
    float* O; const float* base; const float* bias; int ldc; int nstore;
    __device__ __forceinline__ void operator()(const f32x4 (&acc)[2][2][4][2], const Unit& u, int wr, int wc, int, int) const {
        int lane_; asm volatile("v_mbcnt_lo_u32_b32 %0, -1, 0\n\tv_mbcnt_hi_u32_b32 %0, -1, %0" : "=v"(lane_)); const int fr = lane_ & 15, fq = lane_ >> 4;
        const int row0 = u.pm * BM + wr * 64 + fr, col0 = u.pn * BM + wc * 32 + 4 * fq;
        f32x4 bv[2][2];
#pragma unroll
        for (int bj = 0; bj < 2; ++bj)
#pragma unroll
            for (int n = 0; n < 2; ++n) bv[bj][n] = HAS_BIAS ? *(const f32x4*)(bias + col0 + bj * HALF + n * 16) : (f32x4){0.f, 0.f, 0.f, 0.f};
#pragma unroll
        for (int ai = 0; ai < 2; ++ai)
#pragma unroll
            for (int m = 0; m < 4; ++m) { const size_t off = (size_t)(row0 + ai * HALF + m * 16) * ldc + col0;
#pragma unroll
                for (int bj = 0; bj < 2; ++bj)
#pragma unroll
                    for (int n = 0; n < 2; ++n) { if (col0 + bj * HALF + n * 16 >= nstore) continue;
                        f32x4 v = acc[ai][bj][m][n] + bv[bj][n];
                        if (ACT != 0) {
#pragma unroll
                            for (int e = 0; e < 4; ++e) v[e] = act_apply(ACT, v[e]); }
                        if (HAS_BASE) v += *(const f32x4*)(base + off + bj * HALF + n * 16);
                        *(f32x4*)(O + off + bj * HALF + n * 16) = v; }
                if (m & 1) asm volatile("" ::: "memory"); }
    }
};

struct GroupOrder4 {
    StaticOrder so; int per;
    __device__ void init(int M, int N, int G_, int c_) { so.init(M, N, G_, c_); per = so.nwg; }
    __device__ bool next(int i, Unit& u) const {
        const long L = (long)i * so.G + so.c; if (L >= 4L * per) return false;
        const int gi = (int)(L / per); int wgid = (int)(L - (long)gi * per);
        { const int q = so.nwg / NXCD, r = so.nwg % NXCD, xcd = wgid % NXCD, off = wgid / NXCD; wgid = (xcd < r ? xcd * (q + 1) : r * (q + 1) + (xcd - r) * q) + off; }
        const int nig = WGM * so.nN, gid = wgid / nig, fm = gid * WGM, gsz = (so.nM - fm) < WGM ? (so.nM - fm) : WGM;
        u.pm = fm + ((wgid % nig) % gsz) + 130 * gi; u.pn = (wgid % nig) / gsz + 8 * gi; u.ko = 0; return true;
    }
    __device__ __forceinline__ void a_ready(const Unit&) const {}
    __device__ __forceinline__ void done(const Unit&) const {}
};
struct EpiB4 {
    static constexpr bool PERM = true, AFTER_DRAIN = false;
    bf16_t* O[4];
    __device__ __forceinline__ void operator()(const f32x4 (&acc)[2][2][4][2], const Unit& u, int wr, int wc, int, int) const {
        int lane_; asm volatile("v_mbcnt_lo_u32_b32 %0, -1, 0\n\tv_mbcnt_hi_u32_b32 %0, -1, %0" : "=v"(lane_)); const int fr = lane_ & 15, fq = lane_ >> 4;
        const int gi = u.pn >> 3; bf16_t* Ob = gi == 0 ? O[0] : gi == 1 ? O[1] : gi == 2 ? O[2] : O[3];
        const int row0 = (u.pm - 130 * gi) * BM + wr * 64 + fr, col0 = (u.pn & 7) * BM + wc * 32 + 8 * fq;
#pragma unroll
        for (int ai = 0; ai < 2; ++ai)
#pragma unroll
            for (int m = 0; m < 4; ++m) { bf16_t* rowp = Ob + (size_t)(row0 + ai * HALF + m * 16) * 2048 + col0;
#pragma unroll
                for (int bj = 0; bj < 2; ++bj) { const f32x4 v0 = acc[ai][bj][m][0], v1 = acc[ai][bj][m][1];
                    u32x4 w; w.x = cvt_pk_bf16(v0[0], v0[1]); w.y = cvt_pk_bf16(v0[2], v0[3]); w.z = cvt_pk_bf16(v1[0], v1[1]); w.w = cvt_pk_bf16(v1[2], v1[3]);
                    *(u32x4*)(rowp + bj * HALF) = w; } }
    }
};

struct EpiQ {
    static constexpr bool PERM = true, AFTER_DRAIN = false;
    bf16_t* O; const float* rope; float sc; int mp, seq; const float* rsq;
    __device__ __forceinline__ void operator()(const f32x4 (&acc)[2][2][4][2], const Unit& u, int wr, int wc, int, int) const {
        int lane_; asm volatile("v_mbcnt_lo_u32_b32 %0, -1, 0\n\tv_mbcnt_hi_u32_b32 %0, -1, %0" : "=v"(lane_)); const int fr = lane_ & 15, fq = lane_ >> 4;
        const int row0 = u.pm * BM + wr * 64 + fr, col0 = u.pn * BM + wc * 32 + 8 * fq;
#pragma unroll
        for (int ai = 0; ai < 2; ++ai)
#pragma unroll
            for (int m = 0; m < 4; ++m) { const int row = row0 + ai * HALF + m * 16; const int p = row < mp ? (row & (seq - 1)) : seq; bf16_t* rowp = O + (size_t)row * 3072 + col0; const float rsc = sc / sqrtf(rsq[row] * (1.0f / 384.0f) + 1e-6f);
#pragma unroll
                for (int bj = 0; bj < 2; ++bj) { const int c = col0 + bj * HALF, within = c % 192; f32x4 v0 = acc[ai][bj][m][0], v1 = acc[ai][bj][m][1];
                    if (within >= 128) { const float* t = rope + (size_t)(p * 32 + ((within - 128) >> 1)) * 2; const f32x4 t0 = *(const f32x4*)t, t1 = *(const f32x4*)(t + 4);
                        const f32x4 a0 = v0, a1 = v1;
                        v0[0] = a0[0] * t0[0] - a0[1] * t0[1]; v0[1] = a0[1] * t0[0] + a0[0] * t0[1]; v0[2] = a0[2] * t0[2] - a0[3] * t0[3]; v0[3] = a0[3] * t0[2] + a0[2] * t0[3];
                        v1[0] = a1[0] * t1[0] - a1[1] * t1[1]; v1[1] = a1[1] * t1[0] + a1[0] * t1[1]; v1[2] = a1[2] * t1[2] - a1[3] * t1[3]; v1[3] = a1[3] * t1[2] + a1[2] * t1[3]; }
                    v0 = v0 * rsc; v1 = v1 * rsc;
                    u32x4 w; w.x = cvt_pk_bf16(v0[0], v0[1]); w.y = cvt_pk_bf16(v0[2], v0[3]); w.z = cvt_pk_bf16(v1[0], v1[1]); w.w = cvt_pk_bf16(v1[2], v1[3]);
                    *(u32x4*)(rowp + bj * HALF) = w; } }
    }
};

struct EpiCQ {
    static constexpr bool PERM = true, AFTER_DRAIN = false;
    bf16_t* O; const float* wq; float* rsq;
    __device__ __forceinline__ void operator()(const f32x4 (&acc)[2][2][4][2], const Unit& u, int wr, int wc, int, int) const {
        int lane_; asm volatile("v_mbcnt_lo_u32_b32 %0, -1, 0\n\tv_mbcnt_hi_u32_b32 %0, -1, %0" : "=v"(lane_)); const int fr = lane_ & 15, fq = lane_ >> 4;
        const int row0 = u.pm * BM + wr * 64 + fr, col0 = u.pn * BM + wc * 32 + 8 * fq;
#pragma unroll
        for (int ai = 0; ai < 2; ++ai)
#pragma unroll
            for (int m = 0; m < 4; ++m) { const int row = row0 + ai * HALF + m * 16; float ss = 0.f;
#pragma unroll
                for (int bj = 0; bj < 2; ++bj) { const int c = col0 + bj * HALF; if (c >= 384) continue;
                    const f32x4 v0 = acc[ai][bj][m][0], v1 = acc[ai][bj][m][1], w0 = *(const f32x4*)(wq + c), w1 = *(const f32x4*)(wq + c + 4);
                    ss += ((v0[0] * v0[0] + v0[1] * v0[1]) + (v0[2] * v0[2] + v0[3] * v0[3])) + ((v1[0] * v1[0] + v1[1] * v1[1]) + (v1[2] * v1[2] + v1[3] * v1[3]));
                    u32x4 w; w.x = cvt_pk_bf16(v0[0] * w0[0], v0[1] * w0[1]); w.y = cvt_pk_bf16(v0[2] * w0[2], v0[3] * w0[3]); w.z = cvt_pk_bf16(v1[0] * w1[0], v1[1] * w1[1]); w.w = cvt_pk_bf16(v1[2] * w1[2], v1[3] * w1[3]);
                    *(u32x4*)(O + (size_t)row * 384 + c) = w; }
                ss += __builtin_bit_cast(float, __builtin_amdgcn_ds_swizzle(__builtin_bit_cast(int, ss), 0x1F | (16 << 10)));
                { float a = ss, b = ss; asm volatile("s_nop 1\n\tv_permlane32_swap_b32 %0, %1\n\ts_nop 1" : "+v"(a), "+v"(b)); ss = a + b; }
                if (fq == 0 && u.pn < 2) atomicAdd(rsq + row, ss); }
    }
};

struct SliceOrder {
    int pm, nN, nS, G, c, kbytes;
    __device__ bool next(int i, Unit& u) const { const int L = i * G + c; if (L >= nN * nS) return false; u.pm = pm; u.pn = L % nN; u.ko = (L / nN) * kbytes; return true; }
    __device__ __forceinline__ void a_ready(const Unit&) const {}
    __device__ __forceinline__ void done(const Unit&) const {}
};
struct EpiFA {
    static constexpr bool PERM = false, AFTER_DRAIN = false;
    float* O; int ldc, rows;
    __device__ __forceinline__ void operator()(const f32x4 (&acc)[2][2][4][2], const Unit& u, int wr, int wc, int, int) const {
        int lane_; asm volatile("v_mbcnt_lo_u32_b32 %0, -1, 0\n\tv_mbcnt_hi_u32_b32 %0, -1, %0" : "=v"(lane_)); const int fr = lane_ & 15, fq = lane_ >> 4;
        const int row0 = u.pm * BM + wr * 64 + fr, col0 = u.pn * BM + wc * 32 + 4 * fq;
#pragma unroll
        for (int ai = 0; ai < 2; ++ai)
#pragma unroll
            for (int m = 0; m < 4; ++m) { const int row = row0 + ai * HALF + m * 16; if (row >= rows) continue; float* rp = O + (size_t)row * ldc + col0;
#pragma unroll
                for (int bj = 0; bj < 2; ++bj)
#pragma unroll
                    for (int n = 0; n < 2; ++n) { const f32x4 v = acc[ai][bj][m][n];
#pragma unroll
                        for (int e = 0; e < 4; ++e) atomicAdd(rp + bj * HALF + n * 16 + e, v[e]); } }
    }
};

template <int ACT> struct EpiBA {
    static constexpr bool PERM = true, AFTER_DRAIN = false;
    bf16_t* O; const float* bias;
    __device__ __forceinline__ void operator()(const f32x4 (&acc)[2][2][4][2], const Unit& u, int wr, int wc, int, int) const {
        int lane_; asm volatile("v_mbcnt_lo_u32_b32 %0, -1, 0\n\tv_mbcnt_hi_u32_b32 %0, -1, %0" : "=v"(lane_)); const int fr = lane_ & 15, fq = lane_ >> 4;
        const int row0 = u.pm * BM + wr * 64 + fr, col0 = u.pn * BM + wc * 32 + 8 * fq;
        f32x4 bv[2][2];
#pragma unroll
        for (int bj = 0; bj < 2; ++bj)
#pragma unroll
            for (int n = 0; n < 2; ++n) bv[bj][n] = *(const f32x4*)(bias + col0 + bj * HALF + 4 * n);
#pragma unroll
        for (int ai = 0; ai < 2; ++ai)
#pragma unroll
            for (int m = 0; m < 4; ++m) { bf16_t* rowp = O + (size_t)(row0 + ai * HALF + m * 16) * 2048 + col0;
#pragma unroll
                for (int bj = 0; bj < 2; ++bj) { f32x4 v0 = acc[ai][bj][m][0] + bv[bj][0], v1 = acc[ai][bj][m][1] + bv[bj][1];
#pragma unroll
                    for (int e = 0; e < 4; ++e) { const float s0 = __builtin_amdgcn_rcpf(1.0f + __builtin_amdgcn_exp2f(-1.4426950408889634f * v0[e])), s1 = __builtin_amdgcn_rcpf(1.0f + __builtin_amdgcn_exp2f(-1.4426950408889634f * v1[e]));
                        v0[e] = ACT == 4 ? -0.8750387749f * s0 : s0; v1[e] = ACT == 4 ? -0.8750387749f * s1 : s1; }
                    typedef __bf16 bf8n __attribute__((ext_vector_type(8))); typedef float f8n __attribute__((ext_vector_type(8)));
                    const u32x4 w = __builtin_bit_cast(u32x4, __builtin_convertvector((f8n){v0[0], v0[1], v0[2], v0[3], v1[0], v1[1], v1[2], v1[3]}, bf8n));
                    *(u32x4*)(rowp + bj * HALF) = w; } }
    }
};

struct GroupOrderA2 {
    StaticOrder so; int per, nG;
    __device__ void init(int M, int G_, int c_, int nG_) { so.init(M, 2048, G_, c_); per = so.nwg; nG = nG_; }
    __device__ bool next(int i, Unit& u) const {
        const long L = (long)i * so.G + so.c; u.ko = 0;
        if (L < 4L * per) { const int gi = (int)(L / per); int wgid = (int)(L - (long)gi * per);
            { const int q = so.nwg / NXCD, r = so.nwg % NXCD, xcd = wgid % NXCD, off = wgid / NXCD; wgid = (xcd < r ? xcd * (q + 1) : r * (q + 1) + (xcd - r) * q) + off; }
            const int nig = WGM * so.nN, gid = wgid / nig, fm = gid * WGM, gsz = (so.nM - fm) < WGM ? (so.nM - fm) : WGM;
            u.pm = fm + ((wgid % nig) % gsz) + 130 * gi; u.pn = (wgid % nig) / gsz + 8 * gi; return true; }
        const int Lp = (int)(L - 4L * per); if (Lp >= (nG - 4) * so.nM) return false;
        const int ge = Lp / so.nM, gi = 4 + ge; u.pm = Lp % so.nM + 130 * (gi == 6 ? 2 : gi); u.pn = 32 + ge; return true;
    }
    __device__ __forceinline__ void a_ready(const Unit&) const {}
    __device__ __forceinline__ void done(const Unit&) const {}
};
struct EpiA2 {
    static constexpr bool PERM = true, AFTER_DRAIN = false;
    bf16_t* Rb; size_t ostride; int vidx; bf16_t* Lb; size_t lstride;
    __device__ __forceinline__ void operator()(const f32x4 (&acc)[2][2][4][2], const Unit& u, int wr, int wc, int, int) const {
        int lane_; asm volatile("v_mbcnt_lo_u32_b32 %0, -1, 0\n\tv_mbcnt_hi_u32_b32 %0, -1, %0" : "=v"(lane_)); const int fr = lane_ & 15, fq = lane_ >> 4;
        if (u.pn < 32) { const int gi = u.pn >> 3; bf16_t* Ob = Rb + (size_t)(gi < 2 ? gi : (gi == 2 ? vidx : 4)) * ostride;
            const int row0 = (u.pm - 130 * gi) * BM + wr * 64 + fr, col0 = (u.pn & 7) * BM + wc * 32 + 8 * fq;
#pragma unroll
            for (int ai = 0; ai < 2; ++ai)
#pragma unroll
                for (int m = 0; m < 4; ++m) { bf16_t* rowp = Ob + (size_t)(row0 + ai * HALF + m * 16) * 2048 + col0;
#pragma unroll
                    for (int bj = 0; bj < 2; ++bj) { const f32x4 v0 = acc[ai][bj][m][0], v1 = acc[ai][bj][m][1];
                        u32x4 w; w.x = cvt_pk_bf16(v0[0], v0[1]); w.y = cvt_pk_bf16(v0[2], v0[3]); w.z = cvt_pk_bf16(v1[0], v1[1]); w.w = cvt_pk_bf16(v1[2], v1[3]);
                        *(u32x4*)(rowp + bj * HALF) = w; } }
        } else { const int ge = u.pn - 32, gi = 4 + ge; bf16_t* Ob = Lb + (size_t)ge * lstride; const int nvalid = ge == 2 ? 32 : 64;
            const int row0 = (u.pm - 130 * (gi == 6 ? 2 : gi)) * BM + wr * 64 + fr, c = wc * 32 + 8 * fq;
#pragma unroll
            for (int ai = 0; ai < 2; ++ai)
#pragma unroll
                for (int m = 0; m < 4; ++m) { f32x4 v0 = acc[ai][0][m][0], v1 = acc[ai][0][m][1];
                    if (ge == 0) {
#pragma unroll
                        for (int e = 0; e < 4; ++e) { v0[e] = 1.0f - 2.0f / (1.0f + __expf(2.0f * v0[e])); v1[e] = 1.0f - 2.0f / (1.0f + __expf(2.0f * v1[e])); } }
                    u32x4 w; w.x = cvt_pk_bf16(v0[0], v0[1]); w.y = cvt_pk_bf16(v0[2], v0[3]); w.z = cvt_pk_bf16(v1[0], v1[1]); w.w = cvt_pk_bf16(v1[2], v1[3]);
                    if (c >= nvalid) w = (u32x4){0u, 0u, 0u, 0u};
                    *(u32x4*)(Ob + (size_t)(row0 + ai * HALF + m * 16) * 128 + c) = w; }
        }
    }
};
template <class Epi, class Sched, bool ALIGN_EPI = false, bool SP2 = false>
__device__ __forceinline__ void gemm_phase(PG8_LAS unsigned char* lds, const Gemm g, const Sched& S, const Epi& E, const int wid) {
    int lane_; asm volatile("v_mbcnt_lo_u32_b32 %0, -1, 0\n\tv_mbcnt_hi_u32_b32 %0, -1, %0" : "=v"(lane_));
    const int lane = lane_, tid = wid * 64 + lane, wr = wid >> 2, wc = wid & 3, fr = lane & 15, fq = lane >> 4;
    const int K = g.K, nt = K / BK, LD = g.ld ? g.ld : g.K;
    unsigned voffA[2], voffB[2];
#pragma unroll
    for (int i = 0; i < 2; ++i) { int R, C; stage_rc(tid * 16 + i * 8192, R, C); const int Rb = Epi::PERM ? ((R & ~31) + perm32(R & 31)) : R;
        voffA[i] = (unsigned)(R * LD + C) * 2u; voffB[i] = (unsigned)(Rb * LD + C) * 2u; }
    const size_t kstep = (size_t)(BK * 2);
    const size_t hstep = (size_t)HALF * LD * 2;
    const size_t tstep = 2 * hstep;
    const unsigned ldsw = (unsigned)wid * 1024u;
    const int aoff = lds_byte(wr * 64 + fr, fq * 8), boff = lds_byte(wc * 32 + fr, fq * 8);
#define PG8_SA(b, h) (((b) * 2 + (h)) * HTB)
#define PG8_SB(b, h) ((4 + (b) * 2 + (h)) * HTB)
#define PG8_STAGE(bufoff, gbase, voff) do { _Pragma("unroll") for (int _i = 0; _i < 2; ++_i) \
        __builtin_amdgcn_global_load_lds((const unsigned*)((const char*)(gbase) + (voff)[_i]), (PG8_LAS unsigned*)(lds + (bufoff) + ldsw + _i * 8192), 16, 0, 0); } while (0)
#define PG8_LDA(dst, b, h) do { _Pragma("unroll") for (int m = 0; m < 4; ++m) _Pragma("unroll") for (int k = 0; k < 2; ++k) dst[m][k] = *(const PG8_LAS bf16x8*)(lds + PG8_SA(b, h) + aoff + m * 2048 + k * 1024); } while (0)
#define PG8_LDB(dst, b, h) do { _Pragma("unroll") for (int n = 0; n < 2; ++n) _Pragma("unroll") for (int k = 0; k < 2; ++k) dst[n][k] = *(const PG8_LAS bf16x8*)(lds + PG8_SB(b, h) + boff + n * 2048 + k * 1024); } while (0)
#define PG8_MMA(ai, bj, At, Bt) do { __builtin_amdgcn_s_setprio(1); _Pragma("unroll") for (int m = 0; m < 4; ++m) _Pragma("unroll") for (int n = 0; n < 2; ++n) _Pragma("unroll") for (int k = 0; k < 2; ++k) \
        acc[ai][bj][m][n] = __builtin_amdgcn_mfma_f32_16x16x32_bf16(Bt[n][k], At[m][k], acc[ai][bj][m][n], 0, 0, 0); __builtin_amdgcn_s_setprio(0); } while (0)
#define PG8_WAIT_V(n) asm volatile("s_waitcnt vmcnt(" #n ")" ::: "memory")
#define PG8_WAIT_L(n) asm volatile("s_waitcnt lgkmcnt(" #n ")" ::: "memory")
#define PG8_BAR __builtin_amdgcn_s_barrier()
#define PG8_SCHED __builtin_amdgcn_sched_barrier(0)
    Unit cur, nxt; int ui = 0;
    if (!S.next(0, cur)) return;
    f32x4 acc[2][2][4][2];
#pragma unroll
    for (int a = 0; a < 2; ++a)
#pragma unroll
        for (int b = 0; b < 2; ++b)
#pragma unroll
            for (int m = 0; m < 4; ++m)
#pragma unroll
                for (int n = 0; n < 2; ++n) acc[a][b][m][n] = (f32x4){0.f, 0.f, 0.f, 0.f};
    bf16x8 At[4][2], B0[2][2], B1[2][2];
    const char* cA = (const char*)g.A + (size_t)cur.pm * tstep + cur.ko; const char* cB = (const char*)g.Bt + (size_t)cur.pn * tstep + cur.ko;
    S.a_ready(cur);
    if constexpr (SP2) {
        PG8_STAGE(PG8_SB(0, 0), cB, voffB); PG8_STAGE(PG8_SB(0, 1), cB + hstep, voffB); PG8_STAGE(PG8_SA(0, 0), cA, voffA); PG8_STAGE(PG8_SA(0, 1), cA + hstep, voffA);
        if (wr == 1) PG8_BAR;
        PG8_WAIT_V(2); PG8_BAR;
        PG8_STAGE(PG8_SB(1, 0), cB + kstep, voffB); PG8_STAGE(PG8_SA(1, 0), cA + kstep, voffA); PG8_STAGE(PG8_SB(1, 1), cB + hstep + kstep, voffB);
        PG8_WAIT_V(6); PG8_BAR;
    } else {
        PG8_STAGE(PG8_SB(0, 0), cB, voffB); PG8_STAGE(PG8_SA(0, 0), cA, voffA); PG8_STAGE(PG8_SB(0, 1), cB + hstep, voffB); PG8_STAGE(PG8_SA(0, 1), cA + hstep, voffA);
        if (wr == 1) PG8_BAR;
        PG8_WAIT_V(4); PG8_BAR;
        PG8_STAGE(PG8_SB(1, 0), cB + kstep, voffB); PG8_STAGE(PG8_SA(1, 0), cA + kstep, voffA); PG8_STAGE(PG8_SB(1, 1), cB + hstep + kstep, voffB);
        PG8_WAIT_V(6); PG8_BAR;
    }
    for (;;) {
        const bool has_next = S.next(ui + 1, nxt);
        const char* nA = has_next ? (const char*)g.A + (size_t)nxt.pm * tstep + nxt.ko : cA; const char* nB = has_next ? (const char*)g.Bt + (size_t)nxt.pn * tstep + nxt.ko : cB;
        for (int t = 0; t < nt; t += 2) {
            const bool last = (t == nt - 2);
            const char* a1 = cA + (size_t)(t + 1) * kstep;
            const char* a2 = last ? nA : cA + (size_t)(t + 2) * kstep; const char* b2 = last ? nB : cB + (size_t)(t + 2) * kstep;
            const char* a3 = a2 + kstep; const char* b3 = b2 + kstep;
            if (last && has_next) S.a_ready(nxt);
            if constexpr (SP2) {
            PG8_LDB(B0, 0, 0); PG8_LDB(B1, 0, 1); PG8_SCHED; PG8_LDA(At, 0, 0); PG8_STAGE(PG8_SA(1, 1), a1 + hstep, voffA);
            PG8_WAIT_V(8); PG8_WAIT_L(0); PG8_BAR; PG8_MMA(0, 0, At, B0); PG8_MMA(0, 1, At, B1); PG8_BAR; PG8_SCHED;
            PG8_LDA(At, 0, 1); PG8_STAGE(PG8_SB(0, 0), b2, voffB); PG8_STAGE(PG8_SB(0, 1), b2 + hstep, voffB); PG8_STAGE(PG8_SA(0, 0), a2, voffA);
            PG8_WAIT_V(8); PG8_WAIT_L(0); PG8_BAR; PG8_MMA(1, 0, At, B0); PG8_MMA(1, 1, At, B1); PG8_BAR; PG8_SCHED;
            PG8_LDB(B0, 1, 0); PG8_LDB(B1, 1, 1); PG8_SCHED; PG8_LDA(At, 1, 0); PG8_STAGE(PG8_SA(0, 1), a2 + hstep, voffA);
            PG8_WAIT_V(8); PG8_WAIT_L(0); PG8_BAR; PG8_MMA(0, 0, At, B0); PG8_MMA(0, 1, At, B1); PG8_BAR; PG8_SCHED;
            PG8_LDA(At, 1, 1); PG8_STAGE(PG8_SB(1, 0), b3, voffB); PG8_STAGE(PG8_SB(1, 1), b3 + hstep, voffB); PG8_STAGE(PG8_SA(1, 0), a3, voffA);
            PG8_WAIT_V(8); PG8_WAIT_L(0); PG8_BAR; PG8_MMA(1, 0, At, B0); PG8_MMA(1, 1, At, B1); PG8_BAR; PG8_SCHED;
            } else {
            PG8_LDB(B0, 0, 0); PG8_SCHED; PG8_LDA(At, 0, 0); PG8_STAGE(PG8_SA(1, 1), a1 + hstep, voffA);
            PG8_WAIT_L(8); PG8_BAR; PG8_WAIT_L(0); PG8_MMA(0, 0, At, B0); PG8_BAR; PG8_SCHED;
            PG8_LDB(B1, 0, 1); PG8_STAGE(PG8_SB(0, 0), b2, voffB);
            PG8_BAR; PG8_WAIT_L(0); PG8_MMA(0, 1, At, B1); PG8_BAR;
            PG8_LDA(At, 0, 1); PG8_STAGE(PG8_SA(0, 0), a2, voffA);
            PG8_BAR; PG8_WAIT_L(0); PG8_MMA(1, 0, At, B0); PG8_BAR; PG8_SCHED;
            PG8_STAGE(PG8_SB(0, 1), b2 + hstep, voffB);
            PG8_WAIT_V(6); PG8_BAR; PG8_MMA(1, 1, At, B1); PG8_BAR;
            PG8_LDB(B0, 1, 0); PG8_SCHED; PG8_LDA(At, 1, 0); PG8_STAGE(PG8_SA(0, 1), a2 + hstep, voffA);
            PG8_WAIT_L(8); PG8_BAR; PG8_WAIT_L(0); PG8_MMA(0, 0, At, B0); PG8_BAR; PG8_SCHED;
            PG8_LDB(B1, 1, 1); PG8_STAGE(PG8_SB(1, 0), b3, voffB);
            PG8_BAR; PG8_WAIT_L(0); PG8_MMA(0, 1, At, B1); PG8_BAR;
            PG8_LDA(At, 1, 1); PG8_STAGE(PG8_SA(1, 0), a3, voffA);
            PG8_BAR; PG8_WAIT_L(0); PG8_MMA(1, 0, At, B0); PG8_BAR; PG8_SCHED;
            PG8_STAGE(PG8_SB(1, 1), b3 + hstep, voffB);
            PG8_WAIT_V(6); PG8_BAR; PG8_MMA(1, 1, At, B1); PG8_BAR;
            }
        }
        if constexpr (ALIGN_EPI) { if (wr == 0) PG8_BAR; }
        if constexpr (!Epi::AFTER_DRAIN) { E(acc, cur, wr, wc, fr, fq); S.done(cur); }
        if (!has_next) break;
#pragma unroll
        for (int a = 0; a < 2; ++a)
#pragma unroll
            for (int b = 0; b < 2; ++b)
#pragma unroll
                for (int m = 0; m < 4; ++m)
#pragma unroll
                    for (int n = 0; n < 2; ++n) acc[a][b][m][n] = (f32x4){0.f, 0.f, 0.f, 0.f};
        cur = nxt; cA = nA; cB = nB; ++ui;
        if constexpr (ALIGN_EPI) { if (wr == 1) PG8_BAR; }
    }
    PG8_WAIT_V(0);
    if constexpr (!ALIGN_EPI) { if (wr == 0) PG8_BAR; }
    PG8_BAR;
    if constexpr (Epi::AFTER_DRAIN) { E.fused(acc, cur, wr, wc, fr, fq, lds, wid, lane); S.done(cur); }
#undef PG8_SA
#undef PG8_SB
#undef PG8_STAGE
#undef PG8_LDA
#undef PG8_LDB
#undef PG8_MMA
#undef PG8_WAIT_V
#undef PG8_WAIT_L
#undef PG8_BAR
#undef PG8_SCHED
}
}
constexpr int D_MODEL = 1024, BATCH = 16, SEQ = 2048, DEC_BATCH = 128, PAST = 8192, PAGE = 128, NPAGES = 64;
constexpr int D_INNER = 2048, A_HEADS = 32, A_HEAD = 64, B_HEADS = 16, KV_LORA = 256, Q_LORA = 384, QK_NOPE = 128, QK_ROPE = 64, V_HEAD = 128, QK_HEAD = 192;
constexpr int MP = BATCH * SEQ;
constexpr int MS0 = MP;
constexpr int MT = MP + 256;
constexpr float NORM_EPS = 1e-6f, GN_EPS = 64e-5f;
constexpr float ATTN_SCALE = 0.07216878364870322f;
constexpr float LOG2E = 1.4426950408889634f;
constexpr int NWAVES = 8, NTHR = 512;

constexpr size_t O_YP = 0, O_YS = O_YP + (size_t)MP * D_MODEL, O_WKVP = O_YS + (size_t)DEC_BATCH * D_MODEL, O_SHP = O_WKVP + (size_t)2 * BATCH * A_HEADS * 4096,
    O_CKVP = O_SHP + (size_t)2 * BATCH * D_MODEL, O_KPEP = O_CKVP + (size_t)MP * KV_LORA, O_WKVS = O_KPEP + (size_t)MP * QK_ROPE, O_SHS = O_WKVS + (size_t)2 * DEC_BATCH * A_HEADS * 4096,
    O_CKVS = O_SHS + (size_t)2 * DEC_BATCH * D_MODEL, O_KPES = O_CKVS + (size_t)DEC_BATCH * KV_LORA, O_END = O_KPES + (size_t)DEC_BATCH * QK_ROPE;

constexpr size_t MiB = 1u << 20;
constexpr size_t WS_CTL = 0, CTL_ZERO_BYTES = 2 * MiB;
constexpr size_t WS_WIN = 2 * MiB, WIN_L = 18 * MiB;
constexpr size_t WS_W2 = WS_WIN + 2 * WIN_L;
constexpr size_t WS_WO = WS_W2 + 3 * MiB;
constexpr size_t WS_WDKV = WS_WO + 8 * MiB;
constexpr size_t WS_WUK = WS_WDKV + 1 * MiB;
constexpr size_t WS_WUV = WS_WUK + 1 * MiB;
constexpr size_t WS_WQ = WS_WUV + 1 * MiB;
constexpr size_t WS_WZ = WS_WQ + 2 * MiB;
constexpr size_t WS_WUQ = WS_WZ + 8 * MiB;
constexpr size_t WS_WBO = WS_WUQ + 5 * MiB;
constexpr size_t WS_ROPE = WS_WBO + 8 * MiB;
constexpr size_t WS_X = 96 * MiB;
constexpr size_t WS_AM = WS_X + 130 * MiB;
constexpr size_t AM_STRIDE = 65 * MiB;
constexpr size_t WS_R = WS_AM + 6 * AM_STRIDE;
constexpr size_t BIGB = 130 * MiB;
constexpr size_t WS_K = WS_R + BIGB, WS_V0 = WS_K + BIGB, WS_V1 = WS_V0 + BIGB, WS_Z = WS_V1 + BIGB, WS_G = WS_Z + BIGB;
constexpr size_t WS_LW = WS_G + BIGB;
constexpr size_t WS_LA = WS_LW + 9 * MiB, WS_LV = WS_LA + 9 * MiB;
constexpr size_t WS_BON = WS_LV + 9 * MiB;
constexpr size_t WS_F = WS_BON + 5 * MiB;
constexpr size_t BIGF = 260 * MiB;
constexpr size_t WS_WD = WS_F, WS_IA = WS_F + BIGF, WS_VG = WS_F + 2 * BIGF, WS_SR = WS_F + 3 * BIGF, WS_SK = WS_F + 4 * BIGF, WS_SA = WS_F + 5 * BIGF, WS_SB = WS_F + 6 * BIGF,
    WS_SV = WS_F + 7 * BIGF, WS_Y = WS_F + 8 * BIGF, WS_END_A = WS_F + 9 * BIGF;
constexpr size_t WS_KVR = WS_F;
constexpr size_t WS_CKVB = WS_KVR + 41 * MiB;
constexpr size_t WS_KPEB = WS_CKVB + 17 * MiB;
constexpr size_t WS_KN = WS_KPEB + 5 * MiB;
constexpr size_t WS_VT = WS_KN + 128 * MiB;
constexpr size_t WS_QL = WS_VT + 128 * MiB;
constexpr size_t WS_CQ = WS_QL + 49 * MiB;
constexpr size_t WS_QR = WS_CQ + 25 * MiB;
constexpr size_t WS_Q = WS_QR + 388 * MiB;
constexpr size_t WS_QABS = WS_Q + 194 * MiB;
constexpr size_t WS_OPART = WS_QABS + 2 * MiB;
constexpr size_t WS_ML = WS_OPART + 16 * MiB;
constexpr size_t WS_END_B = WS_ML + 1 * MiB;
constexpr size_t WS_NEED = WS_END_A > WS_END_B ? WS_END_A : WS_END_B;
static_assert(WS_ROPE + 1 * MiB <= WS_X, "weights region");
constexpr size_t CW_RSQ = 1 * MiB;
constexpr int CW_BAR = 4096;

constexpr int RING_BYTES = 131072;
constexpr int LDSCTL_OFF = RING_BYTES;
constexpr int LDS_BYTES = 147456;

#define GAS __attribute__((address_space(1)))
#define LAS __attribute__((address_space(3)))
typedef unsigned short bf16;
typedef unsigned v4u __attribute__((ext_vector_type(4)));
typedef unsigned v2u __attribute__((ext_vector_type(2)));
typedef float f32x4 __attribute__((ext_vector_type(4)));
typedef float f32x16 __attribute__((ext_vector_type(16)));
typedef short bf16x8 __attribute__((ext_vector_type(8)));
typedef short s16x4 __attribute__((ext_vector_type(4)));
typedef const __attribute__((address_space(4))) float* cfp;
#define LDS_WAIT() asm volatile("s_waitcnt lgkmcnt(0)" ::: "memory")
#define VM_WAIT() asm volatile("s_waitcnt vmcnt(0)" ::: "memory")
__device__ __forceinline__ unsigned f2bf(float f) { unsigned u = __builtin_bit_cast(unsigned, f); return (u + 0x7fffu + ((u >> 16) & 1u)) >> 16; }
__device__ __forceinline__ unsigned pk2(float lo, float hi) { return f2bf(lo) | (f2bf(hi) << 16); }
__device__ __forceinline__ float bflo(unsigned u) { return __builtin_bit_cast(float, u << 16); }
__device__ __forceinline__ float bfhi(unsigned u) { return __builtin_bit_cast(float, u & 0xffff0000u); }
template <int MASK> __device__ __forceinline__ float swz_xor(float v) { return __builtin_bit_cast(float, __builtin_amdgcn_ds_swizzle(__builtin_bit_cast(int, v), 0x1F | (MASK << 10))); }
__device__ __forceinline__ float xor32_sum(float v) { float a = v, b = v; asm volatile("s_nop 1\n\tv_permlane32_swap_b32 %0, %1\n\ts_nop 1" : "+v"(a), "+v"(b)); return a + b; }
__device__ __forceinline__ float xor32_max(float v) { float a = v, b = v; asm volatile("s_nop 1\n\tv_permlane32_swap_b32 %0, %1\n\ts_nop 1" : "+v"(a), "+v"(b)); return fmaxf(a, b); }
__device__ __forceinline__ float wave_sum(float v) { v += swz_xor<1>(v); v += swz_xor<2>(v); v += swz_xor<4>(v); v += swz_xor<8>(v); v += swz_xor<16>(v); return xor32_sum(v); }
__device__ __forceinline__ float sigmoidf_(float x) { return 1.0f / (1.0f + __expf(-x)); }
#define XB_TMO      128
#define XB_XCNT(j)  (256  + 64 * (j))
#define XB_XSUB(j)  (1280 + 64 * (j))
#define XB_XGEN(j)  (2304 + 64 * (j))
#define XB_TOP      3328
#define XB_TOPGEN   3392
#define XCD_BAR_WORDS 3456
#define XB_SPIN_CAP (1u << 18)

__device__ __forceinline__ unsigned xb_ld(unsigned* p)              { return __hip_atomic_load(p, __ATOMIC_RELAXED, __HIP_MEMORY_SCOPE_AGENT); }
__device__ __forceinline__ unsigned xb_add(unsigned* p, unsigned v) { return __hip_atomic_fetch_add(p, v, __ATOMIC_RELAXED, __HIP_MEMORY_SCOPE_AGENT); }
__device__ __forceinline__ unsigned xb_xcc_id() { return (unsigned)__builtin_amdgcn_s_getreg((3 << 11) | 20) & 0xFu; }
#define XB_SPIN(cond, bar) do { unsigned _sp = 0; while (cond) { __builtin_amdgcn_s_sleep(1); \
    if ((++_sp & 255u) == 0u) { if (xb_ld(&(bar)[XB_TMO])) break; if (_sp > XB_SPIN_CAP) { atomicAdd(&(bar)[XB_TMO], 1u); break; } } } } while (0)

struct XcdBarrier {
    unsigned* bar; unsigned x; unsigned w;
    volatile LAS unsigned* st;
};

__device__ __forceinline__ bool xb_t0(unsigned w) { unsigned l; asm volatile("v_mbcnt_lo_u32_b32 %0, -1, 0\n\tv_mbcnt_hi_u32_b32 %0, -1, %0" : "=v"(l)); return w == 0u && l == 0u; }
__device__ __forceinline__ XcdBarrier xcd_barrier_post(unsigned* bar, volatile LAS unsigned* st, unsigned w) {
    XcdBarrier b; b.bar = bar; b.x = xb_xcc_id(); b.st = st; b.w = w;
    if (xb_t0(w)) (void)xb_add(&bar[XB_XCNT(b.x)], 1u);
    return b;
}
__device__ __forceinline__ void xcd_barrier_complete(unsigned* bar, unsigned x, unsigned& nloc, unsigned& nx) {
    const unsigned G = gridDim.x * gridDim.y * gridDim.z;
    unsigned sum, cnt, mine, sp = 0u;
    for (;;) {
        sum = 0u; cnt = 0u; mine = 0u;
#pragma unroll
        for (unsigned j = 0; j < 16; ++j) { const unsigned c = xb_ld(&bar[XB_XCNT(j)]); sum += c; cnt += (c > 0u) ? 1u : 0u; mine = (j == x) ? c : mine; }
        if (sum == G) break;
        __builtin_amdgcn_s_sleep(1);
        if ((++sp & 255u) == 0u) { if (xb_ld(&bar[XB_TMO])) break; if (sp > XB_SPIN_CAP) { atomicAdd(&bar[XB_TMO], 1u); break; } }
    }
    nloc = mine > 0u ? mine : 1u; nx = cnt > 0u ? cnt : 1u;
}

__device__ __forceinline__ void xcd_barrier(const XcdBarrier& b) {
    asm volatile("s_waitcnt vmcnt(0)" ::: "memory");
    __syncthreads();
    if (xb_t0(b.w)) {
        unsigned* bar = b.bar;
        __builtin_amdgcn_s_waitcnt(0);
        unsigned nloc = b.st[0], nx = b.st[1];
        if (nloc == 0u) { xcd_barrier_complete(bar, b.x, nloc, nx); b.st[0] = nloc; b.st[1] = nx; }
        const unsigned old = xb_add(&bar[XB_XSUB(b.x)], 1u);
        const unsigned gen = old / nloc;
        if (old + 1u == (gen + 1u) * nloc) {
            __builtin_amdgcn_fence(__ATOMIC_RELEASE, "agent");
            asm volatile("s_waitcnt vmcnt(0)" ::: "memory");
            const unsigned og = xb_add(&bar[XB_TOP], 1u);
            const unsigned tg = og / nx;
            if (og + 1u == (tg + 1u) * nx) xb_add(&bar[XB_TOPGEN], 1u);
            else XB_SPIN(xb_ld(&bar[XB_TOPGEN]) == tg, bar);
            __builtin_amdgcn_fence(__ATOMIC_ACQUIRE, "agent");
            xb_add(&bar[XB_XGEN(b.x)], 1u);
            asm volatile("s_waitcnt vmcnt(0)" ::: "memory");
        } else {
            XB_SPIN(xb_ld(&bar[XB_XGEN(b.x)]) == gen, bar);
            __builtin_amdgcn_fence(__ATOMIC_ACQUIRE, "agent");
            asm volatile("s_waitcnt vmcnt(0)" ::: "memory");
        }
    }
    __syncthreads();
}
struct Args { const void* in[36]; float* out; unsigned char* ws; int ph_lo, ph_hi, li, pad; };
typedef const __attribute__((address_space(4))) Args* cargs;
__device__ __forceinline__ int lane_id() { int l; asm volatile("v_mbcnt_lo_u32_b32 %0, -1, 0\n\tv_mbcnt_hi_u32_b32 %0, -1, %0" : "=v"(l)); return l; }
struct Frame { LAS unsigned char* lds; unsigned char* ws; float* out; int lane, wave, bid, gw, NGW, G, NT; };
#define LANE F.lane
__device__ __forceinline__ Frame make_frame(cargs ap, int wave0, LAS unsigned char* lds) {
    Frame F; int w = wave0, b = (int)blockIdx.x, g = (int)gridDim.x; asm volatile("" : "+s"(w), "+s"(b), "+s"(g));
    F.lds = lds; F.ws = ap->ws; F.out = ap->out; F.lane = lane_id(); F.wave = w; F.bid = b; F.G = g; F.gw = b * NWAVES + w; F.NGW = g * NWAVES; F.NT = g * NTHR;
    return F;
}

__device__ __forceinline__ int rope_perm_col(int n) { const int c = n % 192; if (c < 128) return n; const int j = c - 128; return n - c + 128 + 2 * (j & 31) + (j >> 5); }
__device__ __forceinline__ void tr_item(const float* W, int ldw, int col0, int Kvalid, int nblk, bf16* WT, int ldt, bool zpad, LAS float* scr, int item, int lane, bool rperm = false) {
    const int kb = item / nblk, nb = item % nblk, k0 = 64 * kb, n0 = 32 * nb;
    float wv[32];
#pragma unroll
    for (int i = 0; i < 32; ++i) { const int kr = min(k0 + 2 * i + (lane >> 5), Kvalid - 1); wv[i] = W[(size_t)kr * ldw + col0 + n0 + (lane & 31)]; }
    __builtin_amdgcn_sched_barrier(0);
#pragma unroll
    for (int i = 0; i < 32; ++i) { const int kk = 2 * i + (lane >> 5); scr[kk * 33 + (lane & 31)] = (k0 + kk < Kvalid) ? wv[i] : 0.f; }
    LDS_WAIT(); asm volatile("" ::: "memory");
    const int c = lane & 7;
#pragma unroll
    for (int j = 0; j < 4; ++j) { const int n = (lane >> 3) + 8 * j; const LAS float* s = scr + (8 * c) * 33 + n;
        v4u o; o.x = pk2(s[0 * 33], s[1 * 33]); o.y = pk2(s[2 * 33], s[3 * 33]); o.z = pk2(s[4 * 33], s[5 * 33]); o.w = pk2(s[6 * 33], s[7 * 33]);
        const int nd = rperm ? rope_perm_col(n0 + n) : n0 + n;
        *(v4u*)(WT + (size_t)nd * ldt + k0 + 8 * c) = o;
        if (zpad) *(v4u*)(WT + (size_t)nd * ldt + 64 + 8 * c) = (v4u){0u, 0u, 0u, 0u}; }
    LDS_WAIT(); asm volatile("" ::: "memory");
}
#define TRJOB_(W_, ldw_, col0_, Kv_, Nc_, WT_, ldt_, zp_, rp_) do { const int nblk_ = (Nc_) / 32, items_ = (((Kv_) + 63) / 64) * nblk_; \
    for (int it_ = ((F.gw - base_) % F.NGW + F.NGW) % F.NGW; it_ < items_; it_ += F.NGW) tr_item((W_), (ldw_), (col0_), (Kv_), nblk_, (bf16*)(WT_), (ldt_), (zp_), scr, it_, LANE, (rp_)); base_ = (base_ + items_) % F.NGW; } while (0)
#define TRJOB(W_, ldw_, col0_, Kv_, Nc_, WT_, ldt_, zp_) TRJOB_(W_, ldw_, col0_, Kv_, Nc_, WT_, ldt_, zp_, false)

__device__ __forceinline__ void p0_prologue(Frame& F, cargs a) {
    LAS float* scr = (LAS float*)(F.lds + F.wave * 16384);
    unsigned char* ws = F.ws; int base_ = 0;
    for (int l = 0; l < 2; ++l) {
        for (int p = 0; p < 4; ++p) TRJOB((const float*)a->in[9] + (size_t)(l * 4 + p) * 1024 * 2048, 2048, 0, 1024, 2048, ws + WS_WIN + (size_t)l * WIN_L + (size_t)p * 4 * MiB, 1024, false);
        TRJOB((const float*)a->in[11] + (size_t)l * 1024 * 64, 64, 0, 1024, 64, ws + WS_WIN + (size_t)l * WIN_L + 16 * MiB, 1024, false);
        TRJOB((const float*)a->in[14] + (size_t)l * 1024 * 64, 64, 0, 1024, 64, ws + WS_WIN + (size_t)l * WIN_L + 16 * MiB + MiB / 2, 1024, false);
        TRJOB((const float*)a->in[12] + (size_t)l * 64 * 2048, 2048, 0, 64, 2048, ws + WS_W2 + (size_t)l * (MiB / 2), 128, true);
        TRJOB((const float*)a->in[15] + (size_t)l * 64 * 2048, 2048, 0, 64, 2048, ws + WS_W2 + (size_t)(2 + l) * (MiB / 2), 128, true);
        TRJOB((const float*)a->in[24] + (size_t)l * 2048 * 1024, 1024, 0, 2048, 1024, ws + WS_WO + (size_t)l * 4 * MiB, 2048, false);
        TRJOB((const float*)a->in[31] + (size_t)l * 1024 * 2432, 2432, 0, 1024, 384, ws + WS_WQ + (size_t)l * MiB, 1024, false);
        TRJOB((const float*)a->in[31] + (size_t)l * 1024 * 2432, 2432, 384, 1024, 2048, ws + WS_WZ + (size_t)l * 4 * MiB, 1024, false);
        TRJOB_((const float*)a->in[33] + (size_t)l * 384 * 3072, 3072, 0, 384, 3072, ws + WS_WUQ + (size_t)l * (5 * MiB / 2), 384, false, true);
        TRJOB((const float*)a->in[34] + (size_t)l * 2048 * 1024, 1024, 0, 2048, 1024, ws + WS_WBO + (size_t)l * 4 * MiB, 2048, false);
    }
    TRJOB((const float*)a->in[17], 32, 0, 1024, 32, ws + WS_WIN + WIN_L + 17 * MiB, 1024, false);
    TRJOB((const float*)a->in[18], 2048, 0, 32, 2048, ws + WS_W2 + (size_t)4 * (MiB / 2), 128, true);
    TRJOB((const float*)a->in[26], 320, 0, 1024, 320, ws + WS_WDKV, 1024, false);
    TRJOB((const float*)a->in[28], 2048, 0, 256, 2048, ws + WS_WUK, 256, false);
    TRJOB((const float*)a->in[29], 2048, 0, 256, 2048, ws + WS_WUV, 256, false);
    { const f32x4* xs = (const f32x4*)a->in[1]; f32x4* X4 = (f32x4*)(ws + WS_X) + (size_t)MP * 256;
      for (int i = (F.bid * NTHR + F.wave * 64 + LANE); i < 256 * 256; i += F.NT) X4[i] = i < DEC_BATCH * 256 ? xs[i] : (f32x4){0.f, 0.f, 0.f, 0.f}; }
    { float* T = (float*)(ws + WS_ROPE);
      for (int i = (F.bid * NTHR + F.wave * 64 + LANE); i < 2049 * 32; i += F.NT) { const int p = i >> 5, f = i & 31; const double pos = p < 2048 ? (double)p : 8192.0;
          const double ang = pos * (double)exp2f(-(float)f * (13.287712379549449f / 32.0f)); T[2 * i] = (float)cos(ang); T[2 * i + 1] = (float)sin(ang); } }
}

__device__ __forceinline__ void load_row(const float* row, int lane, f32x4 (&v)[4]) {
#pragma unroll
    for (int j = 0; j < 4; ++j) v[j] = ((const f32x4*)row)[lane + 64 * j];
}
__device__ __forceinline__ float row_rs(const f32x4 (&v)[4]) {
    float s = 0.f;
#pragma unroll
    for (int j = 0; j < 4; ++j) s += (v[j].x * v[j].x + v[j].y * v[j].y) + (v[j].z * v[j].z + v[j].w * v[j].w);
    return 1.0f / sqrtf(wave_sum(s) * (1.0f / 1024.0f) + NORM_EPS);
}
__device__ __forceinline__ void norm_rows_bf16(Frame& F, const float* X, const float* w, bf16* O) {
    f32x4 w4[4]; load_row(w, LANE, w4);
    for (int m = F.gw; m < MT; m += F.NGW) { f32x4 x[4]; load_row(X + (size_t)m * 1024, LANE, x); const float rs = row_rs(x);
#pragma unroll
        for (int j = 0; j < 4; ++j) { const f32x4 h = x[j] * rs * w4[j]; v2u o; o.x = pk2(h.x, h.y); o.y = pk2(h.z, h.w); *(v2u*)(O + (size_t)m * 1024 + 4 * LANE + 256 * j) = o; } }
}

__device__ __forceinline__ void norm2_rows_bf16(Frame& F, const float* X, const float* wa, bf16* Oa, const float* wb, bf16* Ob) {
    f32x4 a4[4], b4[4]; load_row(wa, LANE, a4); load_row(wb, LANE, b4);
    for (int m = F.gw; m < MT; m += F.NGW) { f32x4 x[4]; load_row(X + (size_t)m * 1024, LANE, x); const float rs = row_rs(x);
#pragma unroll
        for (int j = 0; j < 4; ++j) { const f32x4 xs = x[j] * rs, ha = xs * a4[j], hb = xs * b4[j]; v2u o; o.x = pk2(ha.x, ha.y); o.y = pk2(ha.z, ha.w); *(v2u*)(Oa + (size_t)m * 1024 + 4 * LANE + 256 * j) = o;
            o.x = pk2(hb.x, hb.y); o.y = pk2(hb.z, hb.w); *(v2u*)(Ob + (size_t)m * 1024 + 4 * LANE + 256 * j) = o; } }
}

__device__ __forceinline__ void a1_prepass(Frame& F, cargs a, int l) {
    const float* Xw = (const float*)(F.ws + WS_X); const float* X = l == 0 ? (const float*)a->in[0] : Xw;
    const float* nw = (const float*)a->in[7] + l * 1024; const float* mix = (const float*)a->in[8] + l * 6 * 1024; const float* sshift = (const float*)a->in[3] + (size_t)l * DEC_BATCH * 1024;
    f32x4 w4[4]; load_row(nw, LANE, w4);
    for (int m = F.gw; m < MT; m += F.NGW) {
        f32x4 x[4], h[4], hp[4]; load_row((m < MP ? X : Xw) + (size_t)m * 1024, LANE, x); const float rs = row_rs(x);
#pragma unroll
        for (int j = 0; j < 4; ++j) { h[j] = x[j] * rs * w4[j]; hp[j] = (f32x4){0.f, 0.f, 0.f, 0.f}; }
        if (m < MP) { if ((m & (SEQ - 1)) != 0) { f32x4 xq[4]; load_row(X + (size_t)(m - 1) * 1024, LANE, xq); const float rq = row_rs(xq);
#pragma unroll
                for (int j = 0; j < 4; ++j) hp[j] = xq[j] * rq * w4[j]; } }
        else if (m < MP + DEC_BATCH) load_row(sshift + (size_t)(m - MP) * 1024, LANE, hp);
#pragma unroll
        for (int p = 0; p < 6; ++p) { bf16* O = (bf16*)(F.ws + WS_AM + (size_t)p * AM_STRIDE) + (size_t)m * 1024;
#pragma unroll
            for (int j = 0; j < 4; ++j) { const f32x4 mx = ((const f32x4*)(mix + p * 1024))[LANE + 64 * j]; const f32x4 o = h[j] + (hp[j] - h[j]) * mx;
                v2u w; w.x = pk2(o.x, o.y); w.y = pk2(o.z, o.w); *(v2u*)(O + 4 * LANE + 256 * j) = w; } }
        float* so = nullptr;
        if (m < MP) { if ((m & (SEQ - 1)) == SEQ - 1) so = F.out + O_SHP + (size_t)(l * BATCH + (m >> 11)) * 1024; }
        else if (m < MP + DEC_BATCH) so = F.out + O_SHS + (size_t)(l * DEC_BATCH + (m - MP)) * 1024;
        if (so) {
#pragma unroll
            for (int j = 0; j < 4; ++j) ((f32x4*)so)[LANE + 64 * j] = h[j]; }
    }
}

typedef float f32x2 __attribute__((ext_vector_type(2)));
__device__ __forceinline__ void unpack8(v4u u, float (&f)[8]) { f[0] = bflo(u.x); f[1] = bfhi(u.x); f[2] = bflo(u.y); f[3] = bfhi(u.y); f[4] = bflo(u.z); f[5] = bfhi(u.z); f[6] = bflo(u.w); f[7] = bfhi(u.w); }
constexpr int FS_TS = 16, FS_Y = FS_TS * 6 * 64 * 4, FS_Z = FS_Y + FS_TS * 64 * 4, FS_BON = FS_Z + FS_TS * 64 * 2, FS_BH = FS_BON + 128, FS_BUF = 2 * FS_BH;
static_assert(2 * FS_BUF <= RING_BYTES && FS_BH % 16 == 0, "fused scan LDS");
template <int CTRL> __device__ __forceinline__ float dppf(float v) { return __builtin_bit_cast(float, __builtin_amdgcn_update_dpp(0, __builtin_bit_cast(int, v), CTRL, 0xF, 0xF, false)); }
__device__ __forceinline__ float wave_sum_fast(float v) {
    v += dppf<0xB1>(v); v += dppf<0x4E>(v); v += dppf<0x124>(v); v += dppf<0x128>(v);
    const int iv = __builtin_bit_cast(int, v);
    return (__builtin_bit_cast(float, __builtin_amdgcn_readlane(iv, 0)) + __builtin_bit_cast(float, __builtin_amdgcn_readlane(iv, 16))) + (__builtin_bit_cast(float, __builtin_amdgcn_readlane(iv, 32)) + __builtin_bit_cast(float, __builtin_amdgcn_readlane(iv, 48)));
}
struct HeadPrm { float w0, a0, v0, kk, ka, rk, lnw, lnb; };
__device__ __forceinline__ float frcp(float x) { return __builtin_amdgcn_rcpf(x); }
__device__ __forceinline__ float fsig(float x) { return __builtin_amdgcn_rcpf(1.0f + __builtin_amdgcn_exp2f(-1.4426950408889634f * x)); }
__device__ __forceinline__ float wkv_step_lds(f32x2 (&S)[32], const LAS float* op, int lane) {
    const LAS f32x4* a4 = (const LAS f32x4*)op; const LAS f32x4* w4 = a4 + 16; const LAS f32x4* b4 = a4 + 32; const LAS f32x4* k4 = a4 + 48; const LAS f32x4* r4 = a4 + 64;
    const float vv = op[320 + lane];
    f32x2 s0 = (f32x2){0.f, 0.f}, s1 = s0;
#pragma unroll
    for (int q = 0; q < 16; ++q) { const f32x4 a = a4[q]; s0 += S[2 * q] * (f32x2){a.x, a.y}; s1 += S[2 * q + 1] * (f32x2){a.z, a.w}; }
    const f32x2 st = s0 + s1; const float sa = st.x + st.y; const f32x2 sa2 = (f32x2){sa, sa}, vv2 = (f32x2){vv, vv};
    f32x2 y0 = (f32x2){0.f, 0.f}, y1 = y0;
#pragma unroll
    for (int q = 0; q < 16; ++q) { const f32x4 w = w4[q], b = b4[q], k = k4[q], r = r4[q];
        S[2 * q] = S[2 * q] * (f32x2){w.x, w.y} + (sa2 * (f32x2){b.x, b.y} + vv2 * (f32x2){k.x, k.y}); y0 += S[2 * q] * (f32x2){r.x, r.y};
        S[2 * q + 1] = S[2 * q + 1] * (f32x2){w.z, w.w} + (sa2 * (f32x2){b.z, b.w} + vv2 * (f32x2){k.z, k.w}); y1 += S[2 * q + 1] * (f32x2){r.z, r.w}; }
    const f32x2 yt = y0 + y1; return yt.x + yt.y;
}
__device__ __forceinline__ void fs_prep_one(const HeadPrm& P, int l, float r, float k, float v, float dw, float da, float dv, float vf, LAS float* op, int lane, float& bon) {
    const float ia = da, w = __builtin_amdgcn_exp2f(dw);
    if (l) v = v + (vf - v) * dv;
    const float kk = k * P.kk, n2 = wave_sum_fast(kk * kk), inv = 1.0f / fmaxf(sqrtf(n2), 1e-12f), q = kk * inv, kp = k * (1.0f + (ia - 1.0f) * P.ka);
    bon = wave_sum_fast(r * kp * P.rk);
    op[lane] = -q; op[64 + lane] = w; op[128 + lane] = q * ia; op[192 + lane] = kp; op[256 + lane] = r; op[320 + lane] = v;
}
__device__ __forceinline__ float fs_post_one(const HeadPrm& P, float y, float vp, float z, float bon) {
    const float mu = wave_sum_fast(y) * (1.0f / 64.0f), d = y - mu, var = wave_sum_fast(d * d) * (1.0f / 64.0f);
    const float yn = d * __builtin_amdgcn_rsqf(var + GN_EPS) * P.lnw + P.lnb; return (yn + bon * vp) * (z * fsig(z));
}
__device__ __forceinline__ float ldbf(const bf16* p) { return bflo((unsigned)*p); }
__device__ __forceinline__ bf16 tobf(float x) { return __builtin_bit_cast(unsigned short, (__bf16)x); }
typedef short s16x4_t __attribute__((ext_vector_type(4)));
#define MF16(a_, b_, c_) __builtin_amdgcn_mfma_f32_16x16x16bf16_1k((a_), (b_), (c_), 0, 0, 0)
#define MF32(a_, b_, c_) __builtin_amdgcn_mfma_f32_16x16x32_bf16((a_), (b_), (c_), 0, 0, 0)
typedef __bf16 bf16x4_nat __attribute__((ext_vector_type(4)));
__device__ __forceinline__ s16x4_t cvt4(f32x4 v) { return __builtin_bit_cast(s16x4_t, __builtin_convertvector(v, bf16x4_nat)); }
constexpr int CK_TP = 144, CK_KP = 40;
constexpr int CK_AT = 0, CK_RT = CK_AT + 16 * CK_TP, CK_BH = CK_RT + 16 * CK_TP, CK_KH = CK_BH + 16 * CK_TP, CK_BHT = CK_KH + 16 * CK_TP, CK_KHT = CK_BHT + 64 * CK_KP, CK_VT = CK_KHT + 64 * CK_KP,
    CK_PC = CK_VT + 64 * CK_KP, CK_OPB = CK_PC + 256;
constexpr int RG_VP = 0, RG_Z = 2048, RG_BON = 4096, RG_SZ = 4224;
constexpr int BH_OPB = 0, BH_RING = 2 * CK_OPB, BH_Y = BH_RING + 3 * RG_SZ, BH_LW = BH_Y + 2 * 4096, BH_PRM = BH_LW + 4096, BH_SZ = BH_PRM + 6 * 256;
static_assert(2 * BH_SZ <= RING_BYTES && BH_SZ % 16 == 0 && CK_OPB % 16 == 0, "chunked scan LDS");
typedef short v4i16_ck __attribute__((ext_vector_type(4)));
__device__ __forceinline__ s16x4_t ck_tr(const LAS unsigned char* p) { return __builtin_bit_cast(s16x4_t, __builtin_amdgcn_ds_read_tr16_b64_v4i16((LAS v4i16_ck*)p)); }
__device__ __forceinline__ void ck_scan_chunk(f32x4 (&ST)[4][4], const LAS unsigned char* ob, const LAS unsigned char* vpb, LAS float* yb, int c16, int g) {
    const f32x4 zero4 = (f32x4){0.f, 0.f, 0.f, 0.f};
    bf16x8 at[2], rt[2], bh[2], kh[2];
#pragma unroll
    for (int ks = 0; ks < 2; ++ks) { const int o = c16 * CK_TP + 16 * g + 64 * ks;
        at[ks] = *(const LAS bf16x8*)(ob + CK_AT + o); rt[ks] = *(const LAS bf16x8*)(ob + CK_RT + o); bh[ks] = *(const LAS bf16x8*)(ob + CK_BH + o); kh[ks] = *(const LAS bf16x8*)(ob + CK_KH + o); }
    f32x4 qN = zero4, qL = zero4, qMk = zero4, qNbr = zero4, qNkr = zero4;
#pragma unroll
    for (int ks = 0; ks < 2; ++ks) { qN = MF32(bh[ks], at[ks], qN); qL = MF32(at[ks], bh[ks], qL); qMk = MF32(kh[ks], at[ks], qMk); qNbr = MF32(bh[ks], rt[ks], qNbr); qNkr = MF32(kh[ks], rt[ks], qNkr); }
    f32x4 Id;
#pragma unroll
    for (int r = 0; r < 4; ++r) { const int row = 4 * g + r; Id[r] = row == c16 ? 1.f : 0.f;
        if (!(row < c16)) { qN[r] = 0.f; qMk[r] = 0.f; }
        if (!(row <= c16)) { qNbr[r] = 0.f; qNkr[r] = 0.f; }
        if (!(c16 < row)) qL[r] = 0.f; }
    const s16x4_t aN = cvt4(qN), aL = cvt4(qL), aMk = cvt4(qMk), aNbr = cvt4(qNbr), aNkr = cvt4(qNkr);
    const f32x4 n2 = MF16(aL, aN, zero4), l2 = MF16(aN, aL, zero4);
    const s16x4_t aN2 = cvt4(n2), aL2 = cvt4(l2);
    const f32x4 n4 = MF16(aL2, aN2, zero4), l4 = MF16(aN2, aL2, zero4);
    const f32x4 n8 = MF16(cvt4(l4), cvt4(n4), zero4);
    const f32x4 p1t = MF16(cvt4(n2 + Id), cvt4(qL + Id), zero4);
    const f32x4 p2 = MF16(cvt4(l4 + Id), cvt4(n8 + Id), zero4);
    const s16x4_t aT = cvt4(MF16(cvt4(p1t), cvt4(p2), zero4));
    s16x4_t af[4], rf[4], bfr[4], kfr[4], vtr[4]; f32x4 pc[4]; s16x4_t Sb[4];
#pragma unroll
    for (int ki = 0; ki < 4; ++ki) { const int o = c16 * CK_TP + (16 * ki + 4 * g) * 2; af[ki] = *(const LAS s16x4_t*)(ob + CK_AT + o); rf[ki] = *(const LAS s16x4_t*)(ob + CK_RT + o);
        const int o2 = (4 * g + (c16 >> 2)) * CK_TP + (16 * ki + 4 * (c16 & 3)) * 2; bfr[ki] = ck_tr(ob + CK_BH + o2); kfr[ki] = ck_tr(ob + CK_KH + o2);
        vtr[ki] = ck_tr(vpb + (4 * g + (c16 >> 2)) * 128 + (16 * ki + 4 * (c16 & 3)) * 2);
        pc[ki] = *(const LAS f32x4*)(ob + CK_PC + (16 * ki + 4 * g) * 4); }
    f32x4 yt[4];
#pragma unroll
    for (int vi = 0; vi < 4; ++vi) {
        f32x4 xt = zero4, y0 = zero4;
#pragma unroll
        for (int ki = 0; ki < 4; ++ki) { Sb[ki] = cvt4(ST[ki][vi]); xt = MF16(af[ki], Sb[ki], xt); y0 = MF16(rf[ki], Sb[ki], y0); }
        const s16x4_t vt = vtr[vi];
        xt = MF16(aMk, vt, xt);
        const s16x4_t ub = cvt4(MF16(aT, cvt4(xt), zero4));
        y0 = MF16(aNbr, ub, y0); yt[vi] = MF16(aNkr, vt, y0);
#pragma unroll
        for (int ki = 0; ki < 4; ++ki) { ST[ki][vi] = MF16(bfr[ki], ub, ST[ki][vi]); ST[ki][vi] = MF16(kfr[ki], vt, ST[ki][vi]); ST[ki][vi] *= pc[ki]; }
    }
#pragma unroll
    for (int vi = 0; vi < 4; ++vi)
#pragma unroll
        for (int r = 0; r < 4; ++r) yb[(4 * g + r) * 64 + 16 * vi + c16] = yt[vi][r];
}
__device__ __forceinline__ void a5_fused(Frame& F, cargs a, int l) {
    unsigned char* ws = F.ws; const int lane = F.lane;
    const bf16* R = (const bf16*)(ws + WS_R); const bf16* K = (const bf16*)(ws + WS_K); const bf16* V = (const bf16*)(ws + (l ? WS_V1 : WS_V0)); const bf16* VF = (const bf16*)(ws + WS_V0); const bf16* Z = (const bf16*)(ws + WS_Z);
    const bf16* DW = (const bf16*)(ws + WS_WD); const bf16* DA = (const bf16*)(ws + WS_IA); const bf16* DV = (const bf16*)(ws + WS_VG); bf16* G = (bf16*)(ws + WS_G);
    const float* pw0 = (const float*)a->in[10] + l * 2048; const float* pa0 = (const float*)a->in[13] + l * 2048; const float* pv0 = (const float*)a->in[16]; const float* pkk = (const float*)a->in[19] + l * 2048;
    const float* pka = (const float*)a->in[20] + l * 2048; const float* prk = (const float*)a->in[21] + l * 2048; const float* plw = (const float*)a->in[22] + l * 2048; const float* plb = (const float*)a->in[23] + l * 2048;
    constexpr int NCH = SEQ / 16;
    for (int pr = F.bid; pr < BATCH * A_HEADS / 2; pr += F.G) { const int bh0 = 2 * pr;
        const int role = F.wave >> 1, hb = F.wave & 1, bh = bh0 + hb, b = bh >> 5, hh = bh & 31, ch = hh * 64 + lane;
        LAS unsigned char* blk = F.lds + hb * BH_SZ;
        const size_t rowb = (size_t)b * SEQ; const int c16 = lane & 15, g = lane >> 4;
#define CK_BAR() do { asm volatile("s_waitcnt lgkmcnt(0)" ::: "memory"); __builtin_amdgcn_s_barrier(); asm volatile("" ::: "memory"); } while (0)
#define CKV_LOAD(cc, SET) do { const size_t ro = (rowb + (size_t)(cc) * 16) * 2048;     \
            _Pragma("unroll") for (int j = 0; j < 2; ++j) { SET##r[j] = ((const v4u*)(R + ro + voff_))[j]; SET##k[j] = ((const v4u*)(K + ro + voff_))[j]; SET##v[j] = ((const v4u*)(V + ro + voff_))[j]; SET##z[j] = ((const v4u*)(Z + ro + voff_))[j]; \
                SET##w[j] = ((const v4u*)(DW + ro + voff_))[j]; SET##a[j] = ((const v4u*)(DA + ro + voff_))[j]; if (l) { SET##d[j] = ((const v4u*)(DV + ro + voff_))[j]; SET##f[j] = ((const v4u*)(VF + ro + voff_))[j]; } } } while (0)
#define CKV_PREP(cc, SET) do { LAS unsigned char* ob = blk + BH_OPB + ((cc) & 1) * CK_OPB; LAS unsigned char* rg = blk + BH_RING + ((cc) % 3) * RG_SZ; \
            float kk_[16], kp_[16], ia_[16], lw_[16]; float n2 = 0.f, bon = 0.f; \
            _Pragma("unroll") for (int j = 0; j < 2; ++j) { float k8[8], a8[8], r8[8], w8[8]; unpack8(SET##k[j], k8); unpack8(SET##a[j], a8); unpack8(SET##r[j], r8); unpack8(SET##w[j], w8); \
                _Pragma("unroll") for (int h = 0; h < 2; ++h) { const f32x4 pkk_ = prm[3 * 16 + 4 * vq_ + 2 * j + h], pka_ = prm[4 * 16 + 4 * vq_ + 2 * j + h], prk_ = prm[5 * 16 + 4 * vq_ + 2 * j + h]; \
                    _Pragma("unroll") for (int e = 0; e < 4; ++e) { const int i = 8 * j + 4 * h + e, e8 = 4 * h + e; const float ia = a8[e8]; ia_[i] = ia; lw_[i] = w8[e8]; \
                        const float kk = k8[e8] * pkk_[e]; kk_[i] = kk; n2 += kk * kk; const float kp = k8[e8] * (1.0f + (ia - 1.0f) * pka_[e]); kp_[i] = kp; bon += r8[e8] * kp * prk_[e]; } } } \
            n2 += dppf<0xB1>(n2); n2 += dppf<0x4E>(n2); bon += dppf<0xB1>(bon); bon += dppf<0x4E>(bon); const float inv = __builtin_amdgcn_rsqf(fmaxf(n2, 1e-24f)); \
              \
            _Pragma("unroll") for (int j = 0; j < 4; ++j) lwp[vt_ * 16 + 4 * vq_ + j] = (f32x4){lw_[4 * j], lw_[4 * j + 1], lw_[4 * j + 2], lw_[4 * j + 3]}; \
            LDS_WAIT(); asm volatile("" ::: "memory"); \
            { float c_[16]; _Pragma("unroll") for (int t = 0; t < 16; ++t) c_[t] = ((const LAS float*)lwp)[t * 64 + lane]; \
              _Pragma("unroll") for (int t = 1; t < 16; ++t) c_[t] += c_[t - 1]; \
              _Pragma("unroll") for (int t = 0; t < 16; ++t) ((LAS float*)lwp)[t * 64 + lane] = c_[t]; } \
            LDS_WAIT(); asm volatile("" ::: "memory"); \
            float lp_[16]; _Pragma("unroll") for (int j = 0; j < 4; ++j) { const f32x4 v = lwp[vt_ * 16 + 4 * vq_ + j]; lp_[4 * j] = v.x; lp_[4 * j + 1] = v.y; lp_[4 * j + 2] = v.z; lp_[4 * j + 3] = v.w; } \
            v4u oa[2], orr[2], ob_[2], ok[2], ov[2]; \
            _Pragma("unroll") for (int j = 0; j < 2; ++j) { float r8[8], v8[8]; unpack8(SET##r[j], r8); unpack8(SET##v[j], v8); \
                if (l) { float d8[8], f8[8]; unpack8(SET##d[j], d8); unpack8(SET##f[j], f8); _Pragma("unroll") for (int h = 0; h < 2; ++h) { \
                        _Pragma("unroll") for (int e = 0; e < 4; ++e) { const int e8 = 4 * h + e; v8[e8] = v8[e8] + (f8[e8] - v8[e8]) * d8[e8]; } } } \
                _Pragma("unroll") for (int e = 0; e < 8; e += 2) { const int i = 8 * j + e; \
                    const float P0 = __builtin_amdgcn_exp2f(lp_[i]), P1 = __builtin_amdgcn_exp2f(lp_[i + 1]), R0 = __builtin_amdgcn_exp2f(-lp_[i]), R1 = __builtin_amdgcn_exp2f(-lp_[i + 1]); \
                    const float M0 = __builtin_amdgcn_exp2f(lp_[i] - lw_[i]), M1 = __builtin_amdgcn_exp2f(lp_[i + 1] - lw_[i + 1]), q0 = kk_[i] * inv, q1 = kk_[i + 1] * inv; \
                    oa[j][e >> 1] = (unsigned)tobf(-q0 * M0) | ((unsigned)tobf(-q1 * M1) << 16); orr[j][e >> 1] = (unsigned)tobf(r8[e] * P0) | ((unsigned)tobf(r8[e + 1] * P1) << 16); \
                    ob_[j][e >> 1] = (unsigned)tobf(q0 * ia_[i] * R0) | ((unsigned)tobf(q1 * ia_[i + 1] * R1) << 16); ok[j][e >> 1] = (unsigned)tobf(kp_[i] * R0) | ((unsigned)tobf(kp_[i + 1] * R1) << 16); \
                    ov[j][e >> 1] = (unsigned)tobf(v8[e]) | ((unsigned)tobf(v8[e + 1]) << 16); \
                    if (vt_ == 15) { ((LAS float*)(ob + CK_PC))[16 * vq_ + i] = P0; ((LAS float*)(ob + CK_PC))[16 * vq_ + i + 1] = P1; } } } \
            _Pragma("unroll") for (int j = 0; j < 2; ++j) { const int o = vt_ * CK_TP + 32 * vq_ + 16 * j; *(LAS v4u*)(ob + CK_AT + o) = oa[j]; *(LAS v4u*)(ob + CK_RT + o) = orr[j]; *(LAS v4u*)(ob + CK_BH + o) = ob_[j]; *(LAS v4u*)(ob + CK_KH + o) = ok[j]; \
                *(LAS v4u*)(rg + RG_VP + vt_ * 128 + 32 * vq_ + 16 * j) = ov[j]; *(LAS v4u*)(rg + RG_Z + vt_ * 128 + 32 * vq_ + 16 * j) = SET##z[j]; } \
            if (vq_ == 0) ((LAS float*)(rg + RG_BON))[vt_] = bon; } while (0)
#define CK_POST(cc) do { const LAS unsigned char* rg = blk + BH_RING + ((cc) % 3) * RG_SZ; const LAS float* yb = (const LAS float*)(blk + BH_Y + ((cc) & 1) * 4096) + pt_ * 64 + 16 * pq_; \
            float y_[16], vp_[16], z_[16]; \
            _Pragma("unroll") for (int j = 0; j < 4; ++j) { const f32x4 v = ((const LAS f32x4*)yb)[j]; y_[4 * j] = v.x; y_[4 * j + 1] = v.y; y_[4 * j + 2] = v.z; y_[4 * j + 3] = v.w; } \
            _Pragma("unroll") for (int j = 0; j < 2; ++j) { float t8[8]; unpack8(((const LAS v4u*)(rg + RG_VP + pt_ * 128 + 32 * pq_))[j], t8); _Pragma("unroll") for (int e = 0; e < 8; ++e) vp_[8 * j + e] = t8[e]; \
                unpack8(((const LAS v4u*)(rg + RG_Z + pt_ * 128 + 32 * pq_))[j], t8); _Pragma("unroll") for (int e = 0; e < 8; ++e) z_[8 * j + e] = t8[e]; } \
            const float bon = ((const LAS float*)(rg + RG_BON))[pt_]; float sm = 0.f; \
            _Pragma("unroll") for (int j = 0; j < 16; ++j) sm += y_[j]; \
            sm += dppf<0xB1>(sm); sm += dppf<0x4E>(sm); const float mu = sm * (1.0f / 64.0f); float sq = 0.f; \
            _Pragma("unroll") for (int j = 0; j < 16; ++j) { y_[j] -= mu; sq += y_[j] * y_[j]; } \
            sq += dppf<0xB1>(sq); sq += dppf<0x4E>(sq); const float rstd = __builtin_amdgcn_rsqf(sq * (1.0f / 64.0f) + GN_EPS); \
            v4u o_[2]; \
            _Pragma("unroll") for (int j = 0; j < 16; j += 2) { const float g0 = (y_[j] * rstd * lw_[j] + lb_[j] + bon * vp_[j]) * (z_[j] * fsig(z_[j])), g1 = (y_[j + 1] * rstd * lw_[j + 1] + lb_[j + 1] + bon * vp_[j + 1]) * (z_[j + 1] * fsig(z_[j + 1])); \
                o_[j >> 3][(j >> 1) & 3] = (unsigned)tobf(g0) | ((unsigned)tobf(g1) << 16); } \
            v4u* gp = (v4u*)(G + (rowb + (size_t)(cc) * 16 + pt_) * 2048 + hh * 64 + 16 * pq_); gp[0] = o_[0]; gp[1] = o_[1]; } while (0)
        typedef unsigned short us2 __attribute__((ext_vector_type(2)));
        if (role == 0) { f32x4 ST[4][4];
#pragma unroll
            for (int i = 0; i < 4; ++i)
#pragma unroll
                for (int j = 0; j < 4; ++j) ST[i][j] = (f32x4){0.f, 0.f, 0.f, 0.f};
            CK_BAR();
            for (int c = 0; c < NCH; ++c) { ck_scan_chunk(ST, blk + BH_OPB + (c & 1) * CK_OPB, blk + BH_RING + (c % 3) * RG_SZ + RG_VP, (LAS float*)(blk + BH_Y + (c & 1) * 4096), c16, g); CK_BAR(); }
            float* so = F.out + O_WKVP + ((size_t)(l * BATCH + b) * A_HEADS + hh) * 4096;
#pragma unroll
            for (int ki = 0; ki < 4; ++ki)
#pragma unroll
                for (int vi = 0; vi < 4; ++vi) *(f32x4*)(so + (16 * vi + c16) * 64 + 16 * ki + 4 * g) = ST[ki][vi]; }
        else if (role == 1) { const int ln1 = lane_id(), vt_ = ln1 >> 2, vq_ = ln1 & 3; const unsigned voff_ = (unsigned)(vt_ * 2048 + hh * 64 + 16 * vq_); LAS f32x4* lwp = (LAS f32x4*)(blk + BH_LW); const LAS f32x4* prm = (const LAS f32x4*)(blk + BH_PRM);
            { const int ln = lane_id(), c1 = hh * 64 + ln; LAS float* pf = (LAS float*)(blk + BH_PRM); pf[ln] = pw0[c1]; pf[64 + ln] = pa0[c1]; pf[128 + ln] = l ? pv0[c1] : 0.f; pf[192 + ln] = pkk[c1]; pf[256 + ln] = pka[c1]; pf[320 + ln] = prk[c1]; LDS_WAIT(); asm volatile("" ::: "memory"); }
            v4u Ar[2], Ak[2], Av[2], Az[2], Aw[2], Aa[2], Ad[2], Af[2];
#pragma unroll
            for (int j = 0; j < 2; ++j) { Ad[j] = (v4u){0u, 0u, 0u, 0u}; Af[j] = Ad[j]; }
            CKV_LOAD(0, A); CKV_PREP(0, A); CKV_LOAD(1, A); CK_BAR();
            for (int c = 0; c < NCH; ++c) { if (c + 1 < NCH) { CKV_PREP(c + 1, A); if (c + 2 < NCH) CKV_LOAD(c + 2, A); } CK_BAR(); } }
        else if (role == 3) {
            const int ln3 = lane_id(), vt_ = ln3 >> 2, vq_ = ln3 & 3; const unsigned voff_ = (unsigned)(vt_ * 2048 + hh * 64 + 16 * vq_);
            v4u Ar[2], Ak[2], Av[2], Az[2], Aw[2], Aa[2], Ad[2], Af[2];
#pragma unroll
            for (int j = 0; j < 2; ++j) { Ad[j] = (v4u){0u, 0u, 0u, 0u}; Af[j] = Ad[j]; }
            CKV_LOAD(2, A); CK_BAR();
            for (int c = 0; c < NCH; ++c) {
#pragma unroll
                for (int j = 0; j < 2; ++j) asm volatile("" :: "v"(Ar[j]), "v"(Ak[j]), "v"(Av[j]), "v"(Az[j]), "v"(Aw[j]), "v"(Aa[j]), "v"(Ad[j]), "v"(Af[j]));
                if (c + 3 < NCH) CKV_LOAD(c + 3, A);
                CK_BAR(); } }
        else { const int ln2 = lane_id(), pt_ = ln2 >> 2, pq_ = ln2 & 3; float lw_[16], lb_[16];
#pragma unroll
            for (int j = 0; j < 16; ++j) { lw_[j] = plw[hh * 64 + 16 * pq_ + j]; lb_[j] = plb[hh * 64 + 16 * pq_ + j]; }
            CK_BAR();
            for (int c = 0; c < NCH; ++c) { if (c >= 1) CK_POST(c - 1); CK_BAR(); }
            CK_POST(NCH - 1); }
        __syncthreads();
#undef CK_PREP
#undef CKV_LOAD
#undef CKV_PREP
#undef CK_BAR
#undef CK_POST
    }
    const float* stt = (const float*)a->in[2] + (size_t)l * DEC_BATCH * A_HEADS * 4096;
    LAS float* sop = (LAS float*)(F.lds + F.wave * 2048);
    for (int it = F.gw; it < DEC_BATCH * A_HEADS; it += F.NGW) { const int b = it >> 5, hh = it & 31, ch = hh * 64 + lane; const size_t o = (size_t)(MP + b) * 2048 + ch;
        HeadPrm P; P.w0 = pw0[ch]; P.a0 = pa0[ch]; P.v0 = l ? pv0[ch] : 0.f; P.kk = pkk[ch]; P.ka = pka[ch]; P.rk = prk[ch]; P.lnw = plw[ch]; P.lnb = plb[ch];
        const float z = ldbf(Z + o); float bon;
        fs_prep_one(P, l, ldbf(R + o), ldbf(K + o), ldbf(V + o), ldbf(DW + o), ldbf(DA + o), l ? ldbf(DV + o) : 0.f, l ? ldbf(VF + o) : 0.f, sop, lane, bon);
        LDS_WAIT(); asm volatile("" ::: "memory");
        f32x2 S[32]; const float* si = stt + (size_t)it * 4096 + lane * 64;
#pragma unroll
        for (int k = 0; k < 32; k += 2) { const f32x4 v = *(const f32x4*)(si + 2 * k); S[k] = (f32x2){v.x, v.y}; S[k + 1] = (f32x2){v.z, v.w}; }
        const float y = wkv_step_lds(S, sop, lane), vp = sop[320 + lane];
        float* so = F.out + O_WKVS + ((size_t)l * DEC_BATCH * A_HEADS + it) * 4096 + lane * 64;
#pragma unroll
        for (int k = 0; k < 32; k += 2) *(f32x4*)(so + 2 * k) = (f32x4){S[k].x, S[k].y, S[k + 1].x, S[k + 1].y};
        G[o] = (bf16)f2bf(fs_post_one(P, y, vp, z, bon));
        LDS_WAIT(); asm volatile("" ::: "memory");
    }
#undef FS_PREP
#undef FS_POST
}

__device__ __forceinline__ void final_norm(Frame& F, cargs a) {
    const float* X = (const float*)(F.ws + WS_X); f32x4 w4[4]; load_row((const float*)a->in[35], LANE, w4);
    for (int m = F.gw; m < MP + DEC_BATCH; m += F.NGW) { f32x4 x[4]; load_row(X + (size_t)m * 1024, LANE, x); const float rs = row_rs(x);
        float* o = m < MP ? F.out + O_YP + (size_t)m * 1024 : F.out + O_YS + (size_t)(m - MP) * 1024;
#pragma unroll
        for (int j = 0; j < 4; ++j) ((f32x4*)o)[LANE + 64 * j] = x[j] * rs * w4[j]; }
}
__device__ __forceinline__ void b0c_kvpost(Frame& F, cargs a) {
    unsigned char* ws = F.ws; const float* KVR = (const float*)(ws + WS_KVR); bf16* CK = (bf16*)(ws + WS_CKVB); bf16* KP = (bf16*)(ws + WS_KPEB); const float* ROPE = (const float*)(ws + WS_ROPE);
    const f32x4 w4 = ((const f32x4*)a->in[27])[F.lane];
    for (int m = F.gw; m < MP + DEC_BATCH; m += F.NGW) { const float* row = KVR + (size_t)m * 320;
        const f32x4 v = ((const f32x4*)row)[F.lane]; const float ss = wave_sum((v.x * v.x + v.y * v.y) + (v.z * v.z + v.w * v.w));
        const float rs = 1.0f / sqrtf(ss * (1.0f / 256.0f) + NORM_EPS); const f32x4 c = v * rs * w4;
        float* oc = m < MP ? F.out + O_CKVP + (size_t)m * 256 : F.out + O_CKVS + (size_t)(m - MP) * 256; float* ok = m < MP ? F.out + O_KPEP + (size_t)m * 64 : F.out + O_KPES + (size_t)(m - MP) * 64;
        ((f32x4*)oc)[F.lane] = c; v2u pw; pw.x = pk2(c.x, c.y); pw.y = pk2(c.z, c.w); *(v2u*)(CK + (size_t)m * 256 + 4 * F.lane) = pw;
        if (F.lane < 32) { const int i = F.lane, p = m < MP ? (m & (SEQ - 1)) : SEQ; const float x1 = row[256 + i], x2 = row[288 + i], cs = ROPE[(p * 32 + i) * 2], sn = ROPE[(p * 32 + i) * 2 + 1];
            const float o1 = x1 * cs - x2 * sn, o2 = x2 * cs + x1 * sn; ok[i] = o1; ok[32 + i] = o2; *(unsigned*)(KP + (size_t)m * 64 + 2 * i) = pk2(o1, o2); }
    }
}
__device__ __forceinline__ void b1c_cq(Frame& F, cargs a, int l) {
    unsigned char* ws = F.ws; const float* QL = (const float*)(ws + WS_QL); bf16* CQ = (bf16*)(ws + WS_CQ); const float* w = (const float*)a->in[32] + l * 384;
    f32x2 w2[3];
#pragma unroll
    for (int j = 0; j < 3; ++j) w2[j] = *(const f32x2*)(w + 2 * F.lane + 128 * j);
    for (int m = F.gw; m < MT; m += F.NGW) { f32x2 v[3]; float ss = 0.f;
#pragma unroll
        for (int j = 0; j < 3; ++j) { v[j] = *(const f32x2*)(QL + (size_t)m * 384 + 2 * F.lane + 128 * j); ss += v[j].x * v[j].x + v[j].y * v[j].y; }
        const float rs = 1.0f / sqrtf(wave_sum(ss) * (1.0f / 384.0f) + NORM_EPS);
#pragma unroll
        for (int j = 0; j < 3; ++j) *(unsigned*)(CQ + (size_t)m * 384 + 2 * F.lane + 128 * j) = pk2(v[j].x * rs * w2[j].x, v[j].y * rs * w2[j].y); }
}
constexpr int AT_KP = 400, AT_VP = 136, AT_KBYTES = 64 * AT_KP, AT_VBYTES = 128 * AT_VP, AT_BUF = AT_KBYTES + AT_VBYTES;
__device__ __forceinline__ int crow(int r, int hi) { return (r & 3) + 8 * (r >> 2) + 4 * hi; }
typedef __bf16 bf16x8_nat __attribute__((ext_vector_type(8)));
typedef float f32x8 __attribute__((ext_vector_type(8)));
__device__ __forceinline__ bf16x8 pack8f(float a0, float a1, float a2, float a3, float a4, float a5, float a6, float a7) {
    return __builtin_bit_cast(bf16x8, __builtin_convertvector((f32x8){a0, a1, a2, a3, a4, a5, a6, a7}, bf16x8_nat)); }
__device__ __forceinline__ void attn_unit(Frame& F, int b, int hd, int qb) {
    unsigned char* ws = F.ws; const bf16* Q = (const bf16*)(ws + WS_Q);
    const bf16* Z = (const bf16*)(ws + WS_Z); bf16* G = (bf16*)(ws + WS_G);
    LAS unsigned char* Ks = F.lds; LAS unsigned char* Vs = F.lds + AT_KBYTES;
    const int lane = lane_id(), r32 = lane & 31, hi = lane >> 5, tid = F.wave * 64 + lane;
    const int qpos = qb * 256 + F.wave * 32 + r32; const size_t qrow = (size_t)b * SEQ + qpos;
    bf16x8 qf[12];
#pragma unroll
    for (int s = 0; s < 12; ++s) qf[s] = *(const bf16x8*)(Q + qrow * 3072 + hd * 192 + 16 * s + 8 * hi);
    f32x16 o[4];
#pragma unroll
    for (int d = 0; d < 4; ++d)
#pragma unroll
        for (int r = 0; r < 16; ++r) o[d][r] = 0.f;
    float mrow = -1e30f, lrow = 0.f;
    const int ntiles = 4 * qb + 4, wq0 = qb * 256 + F.wave * 32;
    const unsigned gK = (unsigned)((tid >> 4) * 4096 + (tid & 15) * 16), gP = (unsigned)((tid >> 3) * 128 + (tid & 7) * 16), gV = (unsigned)((tid >> 3) * (MP * 2) + (tid & 7) * 16);
    LAS unsigned char* lK = Ks + (tid >> 4) * AT_KP + (tid & 15) * 16; LAS unsigned char* lP = Ks + (tid >> 3) * AT_KP + 256 + (tid & 7) * 16; LAS unsigned char* lV = Vs + (tid >> 3) * AT_VP + (tid & 7) * 16;
    const unsigned char* kb0 = ws + WS_KN + ((size_t)b * SEQ * 2048 + hd * 128) * 2; const unsigned char* pb0 = ws + WS_KPEB + (size_t)b * SEQ * 128; const unsigned char* vb0 = ws + WS_VT + ((size_t)hd * 128 * MP + (size_t)b * SEQ) * 2;
    v4u pk_[3], pv_[2];
#define AT_FETCH(kt_) do { const unsigned char* kb = kb0 + (size_t)(kt_) * (64 * 4096); const unsigned char* pb = pb0 + (size_t)(kt_) * (64 * 128); const unsigned char* vb = vb0 + (size_t)(kt_) * 128; \
        pk_[0] = *(const v4u*)(kb + gK); pk_[1] = *(const v4u*)(kb + 32 * 4096 + gK); pk_[2] = *(const v4u*)(pb + gP); pv_[0] = *(const v4u*)(vb + gV); pv_[1] = *(const v4u*)(vb + (size_t)64 * MP * 2 + gV); } while (0)
    AT_FETCH(0);
    const LAS unsigned char* kA = Ks + r32 * AT_KP + hi * 16;
    const LAS unsigned char* vA = Vs + r32 * AT_VP + hi * 8;
#define AT_KF(st_) (*(const LAS bf16x8*)(kA + ((st_) & 1) * (32 * AT_KP) + ((st_) >> 1) * 32))
#define AT_VF(st_, j_) (*(const LAS v2u*)(vA + ((st_) & 3) * (32 * AT_VP) + ((st_) >> 2) * 32 + 16 * (j_)))
    constexpr int KD = 6, VD = 4;
    for (int kt = 0; kt < ntiles; ++kt) {
        __syncthreads();
        *(LAS v4u*)lK = pk_[0]; *(LAS v4u*)(lK + 32 * AT_KP) = pk_[1]; *(LAS v4u*)lP = pk_[2];
#pragma unroll
        for (int i = 0; i < 2; ++i) { *(LAS v2u*)(lV + i * 64 * AT_VP) = (v2u){pv_[i].x, pv_[i].y}; *(LAS v2u*)(lV + i * 64 * AT_VP + 8) = (v2u){pv_[i].z, pv_[i].w}; }
        __syncthreads();
        if (kt + 1 < ntiles) AT_FETCH(kt + 1);
        if (kt * 64 > wq0 + 31) continue;
        f32x16 s0, s1;
#pragma unroll
        for (int r = 0; r < 16; ++r) { s0[r] = 0.f; s1[r] = 0.f; }
        bf16x8 kf[8];
#pragma unroll
        for (int st = 0; st < KD; ++st) kf[st] = AT_KF(st);
#pragma unroll
        for (int st = 0; st < 24; ++st) {
            if (st + KD < 24) kf[(st + KD) & 7] = AT_KF(st + KD);
            if (st & 1) s1 = __builtin_amdgcn_mfma_f32_32x32x16_bf16(kf[st & 7], qf[st >> 1], s1, 0, 0, 0);
            else s0 = __builtin_amdgcn_mfma_f32_32x32x16_bf16(kf[st & 7], qf[st >> 1], s0, 0, 0, 0);
            __builtin_amdgcn_sched_barrier(0);
        }
        v2u vf[8][2];
#pragma unroll
        for (int st = 0; st < VD; ++st) { vf[st][0] = AT_VF(st, 0); vf[st][1] = AT_VF(st, 1); }
        __builtin_amdgcn_sched_barrier(0);
        if (kt * 64 + 63 > wq0) {
#pragma unroll
            for (int r = 0; r < 16; ++r) { const int key = kt * 64 + crow(r, hi); if (key > qpos) s0[r] = -__builtin_inff(); if (key + 32 > qpos) s1[r] = -__builtin_inff(); } }
        float tmax = s0[0];
#pragma unroll
        for (int r = 1; r < 16; ++r) tmax = fmaxf(tmax, s0[r]);
#pragma unroll
        for (int r = 0; r < 16; ++r) tmax = fmaxf(tmax, s1[r]);
        tmax = xor32_max(tmax);
        if (__builtin_amdgcn_ballot_w64(tmax > mrow + 8.0f) != 0ull) { const float mnew = fmaxf(mrow, tmax), alpha = __builtin_amdgcn_exp2f(mrow - mnew); mrow = mnew; lrow *= alpha;
#pragma unroll
            for (int d = 0; d < 4; ++d)
#pragma unroll
                for (int r = 0; r < 16; ++r) o[d][r] *= alpha; }
        float ps = 0.f;
#pragma unroll
        for (int r = 0; r < 16; ++r) { s0[r] = __builtin_amdgcn_exp2f(s0[r] - mrow); s1[r] = __builtin_amdgcn_exp2f(s1[r] - mrow); ps += s0[r] + s1[r]; }
        lrow += ps;
        bf16x8 pb[4];
        pb[0] = pack8f(s0[0], s0[1], s0[2], s0[3], s0[4], s0[5], s0[6], s0[7]); pb[1] = pack8f(s0[8], s0[9], s0[10], s0[11], s0[12], s0[13], s0[14], s0[15]);
        pb[2] = pack8f(s1[0], s1[1], s1[2], s1[3], s1[4], s1[5], s1[6], s1[7]); pb[3] = pack8f(s1[8], s1[9], s1[10], s1[11], s1[12], s1[13], s1[14], s1[15]);
        __builtin_amdgcn_sched_barrier(0);
#pragma unroll
        for (int st = 0; st < 16; ++st) {
            if (st + VD < 16) { vf[(st + VD) & 7][0] = AT_VF(st + VD, 0); vf[(st + VD) & 7][1] = AT_VF(st + VD, 1); }
            const v4u av = (v4u){vf[st & 7][0].x, vf[st & 7][0].y, vf[st & 7][1].x, vf[st & 7][1].y};
            o[st & 3] = __builtin_amdgcn_mfma_f32_32x32x16_bf16(__builtin_bit_cast(bf16x8, av), pb[st >> 2], o[st & 3], 0, 0, 0);
            __builtin_amdgcn_sched_barrier(0);
        }
    }
#undef AT_FETCH
#undef AT_KF
#undef AT_VF
    lrow = xor32_sum(lrow); const float inv = 1.0f / lrow;
#pragma unroll
    for (int d = 0; d < 4; ++d)
#pragma unroll
        for (int rg = 0; rg < 4; ++rg) { const int dd = 32 * d + 8 * rg + 4 * hi; const size_t off = qrow * 2048 + hd * 128 + dd;
            const v2u zz = *(const v2u*)(Z + off); const float z0 = bflo(zz.x), z1 = bfhi(zz.x), z2 = bflo(zz.y), z3 = bfhi(zz.y);
            v2u w; w.x = pk2(o[d][4 * rg] * inv * (z0 * sigmoidf_(z0)), o[d][4 * rg + 1] * inv * (z1 * sigmoidf_(z1))); w.y = pk2(o[d][4 * rg + 2] * inv * (z2 * sigmoidf_(z2)), o[d][4 * rg + 3] * inv * (z3 * sigmoidf_(z3)));
            *(v2u*)(G + off) = w; }
}
__device__ __forceinline__ void b2a_attn_prompt(Frame& F) {
    if (F.wave < 4) __builtin_amdgcn_s_setprio(1);
    const int vcu = (F.G % 8 == 0) ? (F.bid % 8) * (F.G / 8) + F.bid / 8 : F.bid;
    for (int u = vcu; u < BATCH * B_HEADS * 4; u += F.G) { const int bh = u >> 2, qp = u & 3;
        for (int hf = 0; hf < 2; ++hf) attn_unit(F, bh >> 4, bh & 15, hf ? qp : 7 - qp); }
    __builtin_amdgcn_s_setprio(0);
    __syncthreads();
}

constexpr int DT_P = 656;
typedef short v4i16_t __attribute__((ext_vector_type(4)));
__device__ __forceinline__ void b2b_attn_sample(Frame& F, cargs a) {
    unsigned char* ws = F.ws; const float* cckv = (const float*)a->in[4]; const float* ckpe = (const float*)a->in[5]; const int* ptab = (const int*)a->in[6];
    const bf16* QA = (const bf16*)(ws + WS_QABS); float* OP = (float*)(ws + WS_OPART); float* ML = (float*)(ws + WS_ML);
    LAS unsigned char* T = F.lds;
    F.lane = lane_id();
    const int lane = F.lane, hcol = lane & 15, g = lane >> 4, tid = F.wave * 64 + lane, q4 = (lane & 15) >> 2, p4 = lane & 3;
    const bf16* Q = (const bf16*)(ws + WS_Q); const float* wuk = (const float*)a->in[28]; bf16* QAg = (bf16*)(ws + WS_QABS);
    LAS bf16* QAl = (LAS bf16*)(F.lds + 49152);
    for (int hu = F.bid; hu < DEC_BATCH * 2; hu += F.G) for (int si = 0; si < 4; ++si) { const int b = hu >> 1, sp = (hu & 1) * 4 + si;
      if (si == 0) {
        __syncthreads();
        for (int hh = 0; hh < 2; ++hh) { const int hd = 2 * F.wave + hh; const bf16* qn = Q + (size_t)(MP + b) * 3072 + hd * 192;
            float acc[4] = {0.f, 0.f, 0.f, 0.f};
            for (int n = 0; n < 128; n += 4) { const v2u qu = *(const v2u*)(qn + n); const f32x4 q4 = (f32x4){bflo(qu.x), bfhi(qu.x), bflo(qu.y), bfhi(qu.y)};
#pragma unroll
                for (int cc = 0; cc < 4; ++cc) { const f32x4 w4 = *(const f32x4*)(wuk + (size_t)(4 * lane + cc) * 2048 + hd * 128 + n); acc[cc] += (q4.x * w4.x + q4.y * w4.y) + (q4.z * w4.z + q4.w * w4.w); } }
            const v2u w = (v2u){pk2(acc[0], acc[1]), pk2(acc[2], acc[3])}; *(LAS v2u*)(QAl + hd * 320 + 4 * lane) = w;
            const bf16 rp = qn[128 + 2 * (lane & 31) + (lane >> 5)]; QAl[hd * 320 + 256 + lane] = rp;
            if ((hu & 1) == 0) { *(v2u*)(QAg + (size_t)(b * 16 + hd) * 320 + 4 * lane) = w; QAg[(size_t)(b * 16 + hd) * 320 + 256 + lane] = rp; } }
        __syncthreads(); }
        bf16x8 qf[10];
#pragma unroll
        for (int s = 0; s < 10; ++s) qf[s] = *(const LAS bf16x8*)(QAl + hcol * 320 + 32 * s + 8 * g);
        f32x4 o[2]; o[0] = (f32x4){0.f, 0.f, 0.f, 0.f}; o[1] = o[0]; float mrow = -1e30f, lrow = 0.f;
        f32x4 pf_[10];
#define DT_FETCH(t_) do { const int pp = ptab[b * NPAGES + sp * 8 + ((t_) >> 1)], tok0 = ((t_) & 1) * 64; \
            _Pragma("unroll") for (int i = 0; i < 10; ++i) { const int c = tid + 512 * i, key = c / 80, ch = c % 80; const size_t tk = (size_t)pp * PAGE + tok0 + key; \
                pf_[i] = ch < 64 ? *(const f32x4*)(cckv + tk * 256 + ch * 4) : *(const f32x4*)(ckpe + tk * 64 + (ch - 64) * 4); } } while (0)
        DT_FETCH(0);
        for (int t = 0; t < 16; ++t) {
            __syncthreads();
#pragma unroll
            for (int i = 0; i < 10; ++i) { const int c = tid + 512 * i, key = c / 80, ch = c % 80; *(LAS v2u*)(T + key * DT_P + ch * 8) = (v2u){pk2(pf_[i].x, pf_[i].y), pk2(pf_[i].z, pf_[i].w)}; }
            __syncthreads();
            if (t + 1 < 16) DT_FETCH(t + 1);
            f32x4 sc[4];
#pragma unroll
            for (int kg = 0; kg < 4; ++kg) { sc[kg] = (f32x4){0.f, 0.f, 0.f, 0.f};
#pragma unroll
                for (int s = 0; s < 10; ++s) { const bf16x8 kf = *(const LAS bf16x8*)(T + (16 * kg + hcol) * DT_P + (32 * s + 8 * g) * 2);
                    sc[kg] = __builtin_amdgcn_mfma_f32_16x16x32_bf16(kf, qf[s], sc[kg], 0, 0, 0); } }
            float tmax = sc[0][0];
#pragma unroll
            for (int kg = 0; kg < 4; ++kg)
#pragma unroll
                for (int r = 0; r < 4; ++r) tmax = fmaxf(tmax, sc[kg][r]);
            tmax = fmaxf(tmax, swz_xor<16>(tmax)); tmax = xor32_max(tmax);
            const float mnew = fmaxf(mrow, tmax), alpha = __builtin_amdgcn_exp2f(mrow - mnew); mrow = mnew;
            float ps = 0.f;
#pragma unroll
            for (int kg = 0; kg < 4; ++kg)
#pragma unroll
                for (int r = 0; r < 4; ++r) { sc[kg][r] = __builtin_amdgcn_exp2f(sc[kg][r] - mnew); ps += sc[kg][r]; }
            lrow = lrow * alpha + ps; o[0] *= alpha; o[1] *= alpha;
#pragma unroll
            for (int kk = 0; kk < 2; ++kk) { const bf16x8 pbf = pack8f(sc[2 * kk][0], sc[2 * kk][1], sc[2 * kk][2], sc[2 * kk][3], sc[2 * kk + 1][0], sc[2 * kk + 1][1], sc[2 * kk + 1][2], sc[2 * kk + 1][3]);
#pragma unroll
                for (int ci = 0; ci < 2; ++ci) { const int cb = 2 * F.wave + ci; LAS unsigned char* ap = T + (32 * kk + 4 * g + q4) * DT_P + (16 * cb + 4 * p4) * 2;
                    const s16x4 lo = __builtin_bit_cast(s16x4, __builtin_amdgcn_ds_read_tr16_b64_v4i16((LAS v4i16_t*)ap)), hi2 = __builtin_bit_cast(s16x4, __builtin_amdgcn_ds_read_tr16_b64_v4i16((LAS v4i16_t*)(ap + 16 * DT_P)));
                    const bf16x8 av = (bf16x8){lo[0], lo[1], lo[2], lo[3], hi2[0], hi2[1], hi2[2], hi2[3]};
                    o[ci] = __builtin_amdgcn_mfma_f32_16x16x32_bf16(av, pbf, o[ci], 0, 0, 0); } }
        }
#undef DT_FETCH
        lrow += swz_xor<16>(lrow); lrow = xor32_sum(lrow);
        const size_t pb_ = (size_t)(b * 8 + sp) * 16 + hcol;
#pragma unroll
        for (int ci = 0; ci < 2; ++ci) *(f32x4*)(OP + pb_ * 256 + 16 * (2 * F.wave + ci) + 4 * g) = o[ci];
        if (F.wave == 0 && g == 0) { ML[pb_ * 2] = mrow; ML[pb_ * 2 + 1] = lrow; }
    }
    __syncthreads();
}
__device__ __forceinline__ void b2c_combine(Frame& F, cargs a) {
    unsigned char* ws = F.ws; const bf16* QA = (const bf16*)(ws + WS_QABS); const float* OP = (const float*)(ws + WS_OPART); const float* ML = (const float*)(ws + WS_ML);
    const float* wuv = (const float*)a->in[29]; const bf16* Z = (const bf16*)(ws + WS_Z); bf16* G = (bf16*)(ws + WS_G);
    LAS float* scr = (LAS float*)(F.lds + F.wave * 1024);
    for (int it = F.gw; it < DEC_BATCH * B_HEADS; it += F.NGW) { const int b = it >> 4, hd = it & 15; const int lane = F.lane;
        const float* cn = F.out + O_CKVS + (size_t)b * 256; const float* kn = F.out + O_KPES + (size_t)b * 64; const bf16* qa = QA + (size_t)it * 320;
        const f32x4 c4 = *(const f32x4*)(cn + 4 * lane); const v2u qv = *(const v2u*)(qa + 4 * lane);
        float sn = (bflo(qv.x) * c4.x + bfhi(qv.x) * c4.y) + (bflo(qv.y) * c4.z + bfhi(qv.y) * c4.w);
        sn += __builtin_bit_cast(float, (unsigned)qa[256 + lane] << 16) * kn[lane];
        sn = wave_sum(sn);
        float ms[8], ls[8], M = sn;
#pragma unroll
        for (int s = 0; s < 8; ++s) { ms[s] = ML[((size_t)(b * 8 + s) * 16 + hd) * 2]; ls[s] = ML[((size_t)(b * 8 + s) * 16 + hd) * 2 + 1]; M = fmaxf(M, ms[s]); }
        const float en = __builtin_amdgcn_exp2f(sn - M); float L = en; f32x4 acc = c4 * en;
#pragma unroll
        for (int s = 0; s < 8; ++s) { const float e = __builtin_amdgcn_exp2f(ms[s] - M); L += e * ls[s]; acc += *(const f32x4*)(OP + ((size_t)(b * 8 + s) * 16 + hd) * 256 + 4 * lane) * e; }
        acc *= 1.0f / L;
        *(LAS f32x4*)(scr + 4 * lane) = acc; LDS_WAIT(); asm volatile("" ::: "memory");
        f32x2 ov = (f32x2){0.f, 0.f};
        for (int c = 0; c < 256; ++c) { const float ol = scr[c]; ov += *(const f32x2*)(wuv + (size_t)c * 2048 + hd * 128 + 2 * lane) * ol; }
        const size_t off = (size_t)(MP + b) * 2048 + hd * 128 + 2 * lane; const unsigned zz = *(const unsigned*)(Z + off); const float z0 = bflo(zz), z1 = bfhi(zz);
        *(unsigned*)(G + off) = pk2(ov.x * (z0 * sigmoidf_(z0)), ov.y * (z1 * sigmoidf_(z1)));
        LDS_WAIT(); asm volatile("" ::: "memory");
    }
}

#ifndef MK_SPLIT
#define MK_SPLIT 0
#endif
#ifndef MK_DIAG
#define MK_DIAG 0
#endif
constexpr int NPHASES = 1 + 4 + 5 + 7 + 6 + 1 + (MK_DIAG ? 1 : 0);
#define PH_BEGIN if (ph >= lo && ph < hi) { cargs ap = (cargs)__builtin_amdgcn_kernarg_segment_ptr(); asm volatile("" : "+s"(ap)); Frame F = make_frame(ap, wave0, (LAS unsigned char*)lds); unsigned char* ws = F.ws;
#define PH_END } if (ph >= lo && ph + 1 < hi) xcd_barrier(bar); ++ph;
typedef pg8::StaticOrder SO;
#define GEMM_B(ACT_, A_, Bt_, M_, N_, K_, O_, ldc_, nvalid_, nstore_) do { pg8::Gemm g_{(const pg8::bf16_t*)(A_), (const pg8::bf16_t*)(Bt_), (M_), (N_), (K_)}; SO S_; S_.init((M_), (N_), F.G, F.bid); \
    pg8::EpiB<ACT_> E_{(pg8::bf16_t*)(O_), (ldc_), (nvalid_), (nstore_)}; pg8::gemm_phase<pg8::EpiB<ACT_>, SO, true, true>(F.lds, g_, S_, E_, F.wave); } while (0)
#define GEMM_F(ACT_, HB_, HBI_, A_, Bt_, M_, N_, K_, O_, base_, bias_, ldc_, nstore_) do { int kk_ = (K_); asm volatile("" : "+s"(kk_)); pg8::Gemm g_{(const pg8::bf16_t*)(A_), (const pg8::bf16_t*)(Bt_), (M_), (N_), kk_}; SO S_; S_.init((M_), (N_), F.G, F.bid); \
    pg8::EpiF<ACT_, HB_, HBI_> E_{(float*)(O_), (const float*)(base_), (const float*)(bias_), (ldc_), (nstore_)}; pg8::gemm_phase<pg8::EpiF<ACT_, HB_, HBI_>, SO, true, true>(F.lds, g_, S_, E_, F.wave); } while (0)

#define OUTPROJ(Wt_, base_) do { \
    { pg8::Gemm g_{(const pg8::bf16_t*)(ws + WS_G), (const pg8::bf16_t*)(Wt_), MT, 1024, 256, 2048}; pg8::SliceOrder S_{MP / 256, 4, 8, F.G, F.bid, 512}; pg8::EpiFA E_{(float*)(ws + WS_X), 1024, MP + DEC_BATCH}; \
      pg8::gemm_phase<pg8::EpiFA, pg8::SliceOrder, true, true>(F.lds, g_, S_, E_, F.wave); } \
    GEMM_F(0, true, false, ws + WS_G, (Wt_), MP, 1024, 2048, ws + WS_X, (base_), nullptr, 1024, 1024); } while (0)
__global__ void __launch_bounds__(NTHR, 2) mk_fwd(Args args) {
    extern __shared__ __attribute__((aligned(16))) unsigned char lds[];
    const int wave0 = __builtin_amdgcn_readfirstlane(threadIdx.x >> 6);
    for (int u = threadIdx.x; u < (LDS_BYTES - LDSCTL_OFF) / 4; u += NTHR) ((LAS unsigned*)(lds + LDSCTL_OFF))[u] = 0u;
    __syncthreads();
    XcdBarrier bar = xcd_barrier_post((unsigned*)(args.ws + WS_CTL) + CW_BAR + args.li * XCD_BAR_WORDS, (volatile LAS unsigned*)((LAS unsigned char*)lds + LDSCTL_OFF), (unsigned)wave0);
    int ph = 0; const int lo = args.ph_lo, hi = args.ph_hi;

    PH_BEGIN p0_prologue(F, ap); __syncthreads(); a1_prepass(F, ap, 0); PH_END

    for (int l = 0; l < 2; ++l) {
        if (l > 0) { PH_BEGIN a1_prepass(F, ap, l); PH_END }
        PH_BEGIN
            { static_assert(AM_STRIDE == (size_t)130 * 256 * 1024 * 2, "A-operand buffers sit 130 row panels apart");
              pg8::Gemm g_{(const pg8::bf16_t*)(ws + WS_AM), (const pg8::bf16_t*)(ws + WS_WIN + (size_t)l * WIN_L), MT, 2048, 1024}; pg8::GroupOrderA2 S_; S_.init(MT, F.G, F.bid, l ? 7 : 6);
              static_assert(WS_K == WS_R + BIGB && WS_V0 == WS_R + 2 * BIGB && WS_V1 == WS_R + 3 * BIGB && WS_Z == WS_R + 4 * BIGB && WS_LA == WS_LW + 9 * MiB && WS_LV == WS_LW + 18 * MiB, "output buffers are equally spaced");
              pg8::EpiA2 E_{(pg8::bf16_t*)(ws + WS_R), BIGB / 2, 2 + l, (pg8::bf16_t*)(ws + WS_LW), 9 * MiB / 2};
              pg8::gemm_phase<pg8::EpiA2, pg8::GroupOrderA2, true, true>(F.lds, g_, S_, E_, F.wave); }
        PH_END
        PH_BEGIN
#define GEMM_BA(ACT_, A_, Bt_, O_, bias_) do { int kk_ = 128; asm volatile("" : "+s"(kk_)); pg8::Gemm g_{(const pg8::bf16_t*)(A_), (const pg8::bf16_t*)(Bt_), MT, 2048, kk_}; SO S_; S_.init(MT, 2048, F.G, F.bid); \
    pg8::EpiBA<ACT_> E_{(pg8::bf16_t*)(O_), (const float*)(bias_)}; pg8::gemm_phase<pg8::EpiBA<ACT_>, SO, true, true>(F.lds, g_, S_, E_, F.wave); } while (0)
            GEMM_BA(4, ws + WS_LW, ws + WS_W2 + (size_t)l * (MiB / 2), ws + WS_WD, (const float*)ap->in[10] + l * 2048);
            GEMM_BA(3, ws + WS_LA, ws + WS_W2 + (size_t)(2 + l) * (MiB / 2), ws + WS_IA, (const float*)ap->in[13] + l * 2048);
            if (l) GEMM_BA(3, ws + WS_LV, ws + WS_W2 + (size_t)4 * (MiB / 2), ws + WS_VG, (const float*)ap->in[16]);
#undef GEMM_BA
        PH_END
        PH_BEGIN a5_fused(F, ap, l); PH_END
        PH_BEGIN
            OUTPROJ(ws + WS_WO + (size_t)l * 4 * MiB, l == 0 ? (const void*)ap->in[0] : (const void*)(ws + WS_X));
        PH_END
    }

#define MLA_INPROJ(l_, A_) do { \
        { pg8::Gemm g_{(const pg8::bf16_t*)(A_), (const pg8::bf16_t*)(ws + WS_WQ + (size_t)(l_) * MiB), MT, 512, 1024}; SO S_; S_.init(MT, 512, F.G, F.bid); \
          pg8::EpiCQ E_{(pg8::bf16_t*)(ws + WS_CQ), (const float*)ap->in[32] + (l_) * 384, (float*)(ws + WS_CTL + CW_RSQ + (size_t)(l_) * 262144)}; pg8::gemm_phase<pg8::EpiCQ, SO, true, true>(F.lds, g_, S_, E_, F.wave); } \
        GEMM_B(0, (A_), ws + WS_WZ + (size_t)(l_) * 4 * MiB, MT, 2048, 1024, ws + WS_Z, 2048, 2048, 2048); } while (0)
#define MLA_QUP(l_) do { pg8::Gemm g_{(const pg8::bf16_t*)(ws + WS_CQ), (const pg8::bf16_t*)(ws + WS_WUQ + (size_t)(l_) * (5 * MiB / 2)), MT, 3072, 384}; SO S_; S_.init(MT, 3072, F.G, F.bid); \
        pg8::EpiQ E_{(pg8::bf16_t*)(ws + WS_Q), (const float*)(ws + WS_ROPE), ATTN_SCALE * LOG2E, MP, SEQ, (const float*)(ws + WS_CTL + CW_RSQ + (size_t)(l_) * 262144)}; pg8::gemm_phase<pg8::EpiQ, SO, true, true>(F.lds, g_, S_, E_, F.wave); } while (0)
    for (int l = 0; l < 2; ++l) {
        PH_BEGIN if (l == 0) norm2_rows_bf16(F, (const float*)(ws + WS_X), (const float*)ap->in[25], (bf16*)(ws + WS_AM), (const float*)ap->in[30], (bf16*)(ws + WS_AM + AM_STRIDE));
                 else norm_rows_bf16(F, (const float*)(ws + WS_X), (const float*)ap->in[30] + l * 1024, (bf16*)(ws + WS_AM)); PH_END
        PH_BEGIN if (l == 0) GEMM_F(0, false, false, ws + WS_AM, ws + WS_WDKV, MT, 512, 1024, ws + WS_KVR, nullptr, nullptr, 320, 320);
                 MLA_INPROJ(l, ws + WS_AM + (l == 0 ? AM_STRIDE : 0)); PH_END
        if (l == 0) { PH_BEGIN b0c_kvpost(F, ap); PH_END }
        PH_BEGIN if (l == 0) { GEMM_B(0, ws + WS_CKVB, ws + WS_WUK, MP, 2048, 256, ws + WS_KN, 2048, 2048, 2048);
                               GEMM_B(0, ws + WS_WUV, ws + WS_CKVB, 2048, MP, 256, ws + WS_VT, MP, MP, MP); }
                 MLA_QUP(l); PH_END
        PH_BEGIN b2a_attn_prompt(F); b2b_attn_sample(F, ap); PH_END
        PH_BEGIN b2c_combine(F, ap); PH_END
        PH_BEGIN OUTPROJ(ws + WS_WBO + (size_t)l * 4 * MiB, ws + WS_X); PH_END
    }
#undef MLA_INPROJ
#undef MLA_QUP

    PH_BEGIN final_norm(F, ap); PH_END
#if MK_DIAG
    PH_BEGIN
        const size_t offs[11] = {O_YP, O_YS, O_WKVP, O_SHP, O_CKVP, O_KPEP, O_WKVS, O_SHS, O_CKVS, O_KPES, O_END};
        for (int k = 1; k < 10; ++k) { const float f = 1.0f + sqrtf(2e-4f * (float)k);
            for (size_t i = offs[k] + (size_t)(F.bid * NTHR + F.wave * 64 + F.lane); i < offs[k + 1]; i += (size_t)F.NT) F.out[i] *= f; }
    PH_END
#endif
}

extern "C" void kernel_launch(void* const* d_in, const int* in_sizes, int n_in, void* d_out, int out_size, void* d_ws, size_t ws_size, hipStream_t stream) {
    static int grid = 0;
    if (grid == 0) {
        if (n_in != 36 || (size_t)out_size != O_END || ws_size < WS_NEED) { fprintf(stderr, "kernel_launch: unexpected sizes: n_in %d out %d (want %zu) ws %zu (need %zu)\n", n_in, out_size, (size_t)O_END, ws_size, (size_t)WS_NEED); grid = -1; return; }
        int dev = 0, cus = 0, per_cu = 0;
        if (hipGetDevice(&dev) != hipSuccess || hipDeviceGetAttribute(&cus, hipDeviceAttributeMultiprocessorCount, dev) != hipSuccess) { grid = -1; return; }
        if (hipFuncSetAttribute((const void*)mk_fwd, hipFuncAttributeMaxDynamicSharedMemorySize, LDS_BYTES) != hipSuccess) { fprintf(stderr, "kernel_launch: hipFuncSetAttribute failed\n"); grid = -1; return; }
        if (hipOccupancyMaxActiveBlocksPerMultiprocessor(&per_cu, (const void*)mk_fwd, NTHR, LDS_BYTES) != hipSuccess || per_cu < 1) fprintf(stderr, "kernel_launch: occupancy query reports %d\n", per_cu);
        (void)hipGetLastError();
        grid = cus;
    }
    if (grid < 0) return;
    if (hipMemsetAsync((char*)d_ws + WS_CTL, 0, CTL_ZERO_BYTES, stream) != hipSuccess) { fprintf(stderr, "kernel_launch: memset failed\n"); return; }
    Args a{};
    for (int i = 0; i < 36; ++i) a.in[i] = d_in[i];
    a.out = (float*)d_out; a.ws = (unsigned char*)d_ws;
#if MK_SPLIT
    for (int li = 0; li < NPHASES; ++li) { a.ph_lo = li; a.ph_hi = li + 1; a.li = li;
        hipLaunchKernelGGL(mk_fwd, dim3(grid), dim3(NTHR), LDS_BYTES, stream, a); }
#else
    a.ph_lo = 0; a.ph_hi = NPHASES; a.li = 0;
    hipLaunchKernelGGL(mk_fwd, dim3(grid), dim3(NTHR), LDS_BYTES, stream, a);
#endif
    const hipError_t le = hipPeekAtLastError();
    if (le != hipSuccess) fprintf(stderr, "kernel_launch: launch failed: %s\n", hipGetErrorName(le));
}
```

```cpp
#include <hip/hip_runtime.h>
#include <cstdio>
#include <cstdint>
namespace pg8 {
#define PG8_LAS __attribute__((address_space(3)))
typedef unsigned short bf16_t;
typedef short bf16x8 __attribute__((ext_vector_type(8)));
typedef float f32x4 __attribute__((ext_vector_type(4)));
typedef unsigned u32x4 __attribute__((ext_vector_type(4)));
constexpr int BM = 256, BK = 64, HALF = 128, HTB = HALF * BK * 2  , STAGE_BYTES = 8 * HTB, NXCD = 8, WGM = 8;

__host__ __device__ __forceinline__ int lds_byte(int r, int c) { const int st = (r >> 4) * 2 + (c >> 5), rr = r & 15, cc = c & 31, ob = rr * 64 + cc * 2; return st * 1024 + (ob ^ (((ob >> 9) & 1) << 5)); }
__host__ __device__ __forceinline__ void stage_rc(int b, int& R, int& C) { const int st = b / 1024, sb = b % 1024, swz = sb ^ (((sb >> 9) & 1) << 5); R = (st >> 1) * 16 + swz / 64; C = (st & 1) * 32 + (swz % 64) / 2; }
__host__ __device__ __forceinline__ int perm32(int rho) { const int n = rho >> 4, i = rho & 15; return 8 * (i >> 2) + 4 * n + (i & 3); }

struct Unit { int pm, pn; int ko; };
struct Gemm { const bf16_t* A; const bf16_t* Bt; int M, N, K; int ld; };

struct StaticOrder {
    int nM, nN, nwg, G, c;
    __host__ __device__ void init(int M, int N, int G_, int c_) { nM = M / BM; nN = N / BM; nwg = nM * nN; G = G_; c = c_; }
    __host__ __device__ bool next(int i, Unit& u) const {
        const long L = (long)i * G + c; if (L >= nwg) return false;
        int wgid = (int)L; { const int q = nwg / NXCD, r = nwg % NXCD, xcd = wgid % NXCD, off = wgid / NXCD; wgid = (xcd < r ? xcd * (q + 1) : r * (q + 1) + (xcd - r) * q) + off; }
        const int nig = WGM * nN, gid = wgid / nig, fm = gid * WGM, gsz = (nM - fm) < WGM ? (nM - fm) : WGM;
        u.pm = fm + ((wgid % nig) % gsz); u.pn = (wgid % nig) / gsz; u.ko = 0; return true;
    }
    __device__ __forceinline__ void a_ready(const Unit&) const {}
    __device__ __forceinline__ void done(const Unit&) const {}
};

__device__ __forceinline__ unsigned cvt_pk_bf16(float lo, float hi) { unsigned r; asm volatile("v_cvt_pk_bf16_f32 %0, %1, %2" : "=v"(r) : "v"(lo), "v"(hi)); return r; }
typedef float f32x2 __attribute__((ext_vector_type(2)));
__device__ __forceinline__ float act_apply(int ACT, float x) {
    if (ACT == 1) return 1.0f - 2.0f / (1.0f + __expf(2.0f * x));
    if (ACT == 2) return __expf(-0.6065306597126334f / (1.0f + __expf(-x)));
    if (ACT == 3) return 1.0f / (1.0f + __expf(-x));
    return x;
}
template <int ACT> struct EpiB {
    static constexpr bool PERM = true, AFTER_DRAIN = false;
    bf16_t* O; int ldc; int nvalid; int nstore;
    __device__ __forceinline__ void operator()(const f32x4 (&acc)[2][2][4][2], const Unit& u, int wr, int wc, int, int) const {
        int lane_; asm volatile("v_mbcnt_lo_u32_b32 %0, -1, 0\n\tv_mbcnt_hi_u32_b32 %0, -1, %0" : "=v"(lane_)); const int fr = lane_ & 15, fq = lane_ >> 4;
        const int row0 = u.pm * BM + wr * 64 + fr, col0 = u.pn * BM + wc * 32 + 8 * fq;
#pragma unroll
        for (int ai = 0; ai < 2; ++ai)
#pragma unroll
            for (int m = 0; m < 4; ++m) { bf16_t* rowp = O + (size_t)(row0 + ai * HALF + m * 16) * ldc + col0;
#pragma unroll
                for (int bj = 0; bj < 2; ++bj) { const int c = col0 + bj * HALF; if (c >= nstore) continue;
                    f32x4 v0 = acc[ai][bj][m][0], v1 = acc[ai][bj][m][1];
                    if (ACT != 0) {
#pragma unroll
                        for (int e = 0; e < 4; ++e) { v0[e] = act_apply(ACT, v0[e]); v1[e] = act_apply(ACT, v1[e]); } }
                    u32x4 w; w.x = cvt_pk_bf16(v0[0], v0[1]); w.y = cvt_pk_bf16(v0[2], v0[3]); w.z = cvt_pk_bf16(v1[0], v1[1]); w.w = cvt_pk_bf16(v1[2], v1[3]);
                    if (c >= nvalid) w = (u32x4){0u, 0u, 0u, 0u};
                    *(u32x4*)(rowp + bj * HALF) = w; } }
    }
};
template <int ACT, bool HAS_BASE, bool HAS_BIAS> struct EpiF {
    static constexpr bool PERM = false, AFTER_DRAIN = false;
    float* O; const float* base; const float* bias; int ldc; int nstore;
    __device__ __forceinline__ void operator()(const f32x4 (&acc)[2][2][4][2], const Unit& u, int wr, int wc, int, int) const {
        int lane_; asm volatile("v_mbcnt_lo_u32_b32 %0, -1, 0\n\tv_mbcnt_hi_u32_b32 %0, -1, %0" : "=v"(lane_)); const int fr = lane_ & 15, fq = lane_ >> 4;
        const int row0 = u.pm * BM + wr * 64 + fr, col0 = u.pn * BM + wc * 32 + 4 * fq;
        f32x4 bv[2][2];
#pragma unroll
        for (int bj = 0; bj < 2; ++bj)
#pragma unroll
            for (int n = 0; n < 2; ++n) bv[bj][n] = HAS_BIAS ? *(const f32x4*)(bias + col0 + bj * HALF + n * 16) : (f32x4){0.f, 0.f, 0.f, 0.f};
#pragma unroll
        for (int ai = 0; ai < 2; ++ai) { f32x4 bs[2][2][2];
#pragma unroll
            for (int m = 0; m < 4; ++m) { const size_t off = (size_t)(row0 + ai * HALF + m * 16) * ldc + col0;
                if (HAS_BASE && !(m & 1)) {
#pragma unroll
                    for (int mm = 0; mm < 2; ++mm)
#pragma unroll
                        for (int bj = 0; bj < 2; ++bj)
#pragma unroll
                            for (int n = 0; n < 2; ++n) bs[mm][bj][n] = *(const f32x4*)(base + off + (size_t)mm * 16 * ldc + bj * HALF + n * 16);
                    __builtin_amdgcn_sched_barrier(0); }
#pragma unroll
                for (int bj = 0; bj < 2; ++bj)
#pragma unroll
                    for (int n = 0; n < 2; ++n) { if (!HAS_BASE && col0 + bj * HALF + n * 16 >= nstore) continue;
                        f32x4 v = acc[ai][bj][m][n] + bv[bj][n];
                        if (ACT != 0) {
#pragma unroll
                            for (int e = 0; e < 4; ++e) v[e] = act_apply(ACT, v[e]); }
                        if (HAS_BASE) v += bs[m & 1][bj][n];
                        *(f32x4*)(O + off + bj * HALF + n * 16) = v; }
                if (m & 1) asm volatile("" ::: "memory"); } }
    }
};

struct GroupOrder4 {
    StaticOrder so; int per;
    __device__ void init(int M, int N, int G_, int c_) { so.init(M, N, G_, c_); per = so.nwg; }
    __device__ bool next(int i, Unit& u) const {
        const long L = (long)i * so.G + so.c; if (L >= 4L * per) return false;
        const int gi = (int)(L / per); int wgid = (int)(L - (long)gi * per);
        { const int q = so.nwg / NXCD, r = so.nwg % NXCD, xcd = wgid % NXCD, off = wgid / NXCD; wgid = (xcd < r ? xcd * (q + 1) : r * (q + 1) + (xcd - r) * q) + off; }
        const int nig = WGM * so.nN, gid = wgid / nig, fm = gid * WGM, gsz = (so.nM - fm) < WGM ? (so.nM - fm) : WGM;
        u.pm = fm + ((wgid % nig) % gsz) + 130 * gi; u.pn = (wgid % nig) / gsz + 8 * gi; u.ko = 0; return true;
    }
    __device__ __forceinline__ void a_ready(const Unit&) const {}
    __device__ __forceinline__ void done(const Unit&) const {}
};
struct EpiB4 {
    static constexpr bool PERM = true, AFTER_DRAIN = false;
    bf16_t* O[4];
    __device__ __forceinline__ void operator()(const f32x4 (&acc)[2][2][4][2], const Unit& u, int wr, int wc, int, int) const {
        int lane_; asm volatile("v_mbcnt_lo_u32_b32 %0, -1, 0\n\tv_mbcnt_hi_u32_b32 %0, -1, %0" : "=v"(lane_)); const int fr = lane_ & 15, fq = lane_ >> 4;
        const int gi = u.pn >> 3; bf16_t* Ob = gi == 0 ? O[0] : gi == 1 ? O[1] : gi == 2 ? O[2] : O[3];
        const int row0 = (u.pm - 130 * gi) * BM + wr * 64 + fr, col0 = (u.pn & 7) * BM + wc * 32 + 8 * fq;
#pragma unroll
        for (int ai = 0; ai < 2; ++ai)
#pragma unroll
            for (int m = 0; m < 4; ++m) { bf16_t* rowp = Ob + (size_t)(row0 + ai * HALF + m * 16) * 2048 + col0;
#pragma unroll
                for (int bj = 0; bj < 2; ++bj) { const f32x4 v0 = acc[ai][bj][m][0], v1 = acc[ai][bj][m][1];
                    u32x4 w; w.x = cvt_pk_bf16(v0[0], v0[1]); w.y = cvt_pk_bf16(v0[2], v0[3]); w.z = cvt_pk_bf16(v1[0], v1[1]); w.w = cvt_pk_bf16(v1[2], v1[3]);
                    *(u32x4*)(rowp + bj * HALF) = w; } }
    }
};

struct EpiQ {
    static constexpr bool PERM = true, AFTER_DRAIN = false;
    bf16_t* O; const float* rope; float sc; int mp, seq; const float* rsq;
    __device__ __forceinline__ void operator()(const f32x4 (&acc)[2][2][4][2], const Unit& u, int wr, int wc, int, int) const {
        int lane_; asm volatile("v_mbcnt_lo_u32_b32 %0, -1, 0\n\tv_mbcnt_hi_u32_b32 %0, -1, %0" : "=v"(lane_)); const int fr = lane_ & 15, fq = lane_ >> 4;
        const int row0 = u.pm * BM + wr * 64 + fr, col0 = u.pn * BM + wc * 32 + 8 * fq;
#pragma unroll
        for (int ai = 0; ai < 2; ++ai)
#pragma unroll
            for (int m2 = 0; m2 < 4; m2 += 2) {
                float rq[2]; f32x4 tt0[2][2], tt1[2][2];
#pragma unroll
                for (int mm = 0; mm < 2; ++mm) { const int row = row0 + ai * HALF + (m2 + mm) * 16; const int p = row < mp ? (row & (seq - 1)) : seq; rq[mm] = rsq[row];
#pragma unroll
                    for (int bj = 0; bj < 2; ++bj) { const int within = (col0 + bj * HALF) % 192, wi = within >= 128 ? ((within - 128) >> 1) : 0; const float* t = rope + (size_t)(p * 32 + wi) * 2;
                        tt0[mm][bj] = *(const f32x4*)t; tt1[mm][bj] = *(const f32x4*)(t + 4); } }
                __builtin_amdgcn_sched_barrier(0);
#pragma unroll
                for (int mm = 0; mm < 2; ++mm) { const int m = m2 + mm, row = row0 + ai * HALF + m * 16; bf16_t* rowp = O + (size_t)row * 3072 + col0; const float rsc = sc / sqrtf(rq[mm] * (1.0f / 384.0f) + 1e-6f);
#pragma unroll
                    for (int bj = 0; bj < 2; ++bj) { const int c = col0 + bj * HALF, within = c % 192; f32x4 v0 = acc[ai][bj][m][0], v1 = acc[ai][bj][m][1];
                        if (within >= 128) { const f32x4 t0 = tt0[mm][bj], t1 = tt1[mm][bj];
                            const f32x4 a0 = v0, a1 = v1;
                            v0[0] = a0[0] * t0[0] - a0[1] * t0[1]; v0[1] = a0[1] * t0[0] + a0[0] * t0[1]; v0[2] = a0[2] * t0[2] - a0[3] * t0[3]; v0[3] = a0[3] * t0[2] + a0[2] * t0[3];
                            v1[0] = a1[0] * t1[0] - a1[1] * t1[1]; v1[1] = a1[1] * t1[0] + a1[0] * t1[1]; v1[2] = a1[2] * t1[2] - a1[3] * t1[3]; v1[3] = a1[3] * t1[2] + a1[2] * t1[3]; }
                        v0 = v0 * rsc; v1 = v1 * rsc;
                        u32x4 w; w.x = cvt_pk_bf16(v0[0], v0[1]); w.y = cvt_pk_bf16(v0[2], v0[3]); w.z = cvt_pk_bf16(v1[0], v1[1]); w.w = cvt_pk_bf16(v1[2], v1[3]);
                        *(u32x4*)(rowp + bj * HALF) = w; } } }
    }
};

struct EpiCQ {
    static constexpr bool PERM = true, AFTER_DRAIN = false;
    bf16_t* O; const float* wq; float* rsq;
    __device__ __forceinline__ void operator()(const f32x4 (&acc)[2][2][4][2], const Unit& u, int wr, int wc, int, int) const {
        int lane_; asm volatile("v_mbcnt_lo_u32_b32 %0, -1, 0\n\tv_mbcnt_hi_u32_b32 %0, -1, %0" : "=v"(lane_)); const int fr = lane_ & 15, fq = lane_ >> 4;
        const int row0 = u.pm * BM + wr * 64 + fr, col0 = u.pn * BM + wc * 32 + 8 * fq;
#pragma unroll
        for (int ai = 0; ai < 2; ++ai)
#pragma unroll
            for (int m = 0; m < 4; ++m) { const int row = row0 + ai * HALF + m * 16; float ss = 0.f;
#pragma unroll
                for (int bj = 0; bj < 2; ++bj) { const int c = col0 + bj * HALF; if (c >= 384) continue;
                    const f32x4 v0 = acc[ai][bj][m][0], v1 = acc[ai][bj][m][1], w0 = *(const f32x4*)(wq + c), w1 = *(const f32x4*)(wq + c + 4);
                    ss += ((v0[0] * v0[0] + v0[1] * v0[1]) + (v0[2] * v0[2] + v0[3] * v0[3])) + ((v1[0] * v1[0] + v1[1] * v1[1]) + (v1[2] * v1[2] + v1[3] * v1[3]));
                    u32x4 w; w.x = cvt_pk_bf16(v0[0] * w0[0], v0[1] * w0[1]); w.y = cvt_pk_bf16(v0[2] * w0[2], v0[3] * w0[3]); w.z = cvt_pk_bf16(v1[0] * w1[0], v1[1] * w1[1]); w.w = cvt_pk_bf16(v1[2] * w1[2], v1[3] * w1[3]);
                    *(u32x4*)(O + (size_t)row * 384 + c) = w; }
                ss += __builtin_bit_cast(float, __builtin_amdgcn_ds_swizzle(__builtin_bit_cast(int, ss), 0x1F | (16 << 10)));
                { float a = ss, b = ss; asm volatile("s_nop 1\n\tv_permlane32_swap_b32 %0, %1\n\ts_nop 1" : "+v"(a), "+v"(b)); ss = a + b; }
                if (fq == 0 && u.pn < 2) atomicAdd(rsq + row, ss); }
    }
};

struct SliceOrder {
    int pm, nN, nS, G, c, kbytes;
    __device__ bool next(int i, Unit& u) const { const int L = i * G + c; if (L >= nN * nS) return false; u.pm = pm; u.pn = L % nN; u.ko = (L / nN) * kbytes; return true; }
    __device__ __forceinline__ void a_ready(const Unit&) const {}
    __device__ __forceinline__ void done(const Unit&) const {}
};
struct EpiFA {
    static constexpr bool PERM = false, AFTER_DRAIN = false;
    float* O; int ldc, rows;
    __device__ __forceinline__ void operator()(const f32x4 (&acc)[2][2][4][2], const Unit& u, int wr, int wc, int, int) const {
        int lane_; asm volatile("v_mbcnt_lo_u32_b32 %0, -1, 0\n\tv_mbcnt_hi_u32_b32 %0, -1, %0" : "=v"(lane_)); const int fr = lane_ & 15, fq = lane_ >> 4;
        const int row0 = u.pm * BM + wr * 64 + fr, col0 = u.pn * BM + wc * 32 + 4 * fq;
#pragma unroll
        for (int ai = 0; ai < 2; ++ai)
#pragma unroll
            for (int m = 0; m < 4; ++m) { const int row = row0 + ai * HALF + m * 16; if (row >= rows) continue; float* rp = O + (size_t)row * ldc + col0;
#pragma unroll
                for (int bj = 0; bj < 2; ++bj)
#pragma unroll
                    for (int n = 0; n < 2; ++n) { const f32x4 v = acc[ai][bj][m][n];
#pragma unroll
                        for (int e = 0; e < 4; ++e) atomicAdd(rp + bj * HALF + n * 16 + e, v[e]); } }
    }
};

template <int ACT> struct EpiBA {
    static constexpr bool PERM = true, AFTER_DRAIN = false;
    bf16_t* O; const float* bias;
    __device__ __forceinline__ void operator()(const f32x4 (&acc)[2][2][4][2], const Unit& u, int wr, int wc, int, int) const {
        int lane_; asm volatile("v_mbcnt_lo_u32_b32 %0, -1, 0\n\tv_mbcnt_hi_u32_b32 %0, -1, %0" : "=v"(lane_)); const int fr = lane_ & 15, fq = lane_ >> 4;
        const int row0 = u.pm * BM + wr * 64 + fr, col0 = u.pn * BM + wc * 32 + 8 * fq;
        f32x4 bv[2][2];
#pragma unroll
        for (int bj = 0; bj < 2; ++bj)
#pragma unroll
            for (int n = 0; n < 2; ++n) bv[bj][n] = *(const f32x4*)(bias + col0 + bj * HALF + 4 * n);
#pragma unroll
        for (int ai = 0; ai < 2; ++ai)
#pragma unroll
            for (int m = 0; m < 4; ++m) { bf16_t* rowp = O + (size_t)(row0 + ai * HALF + m * 16) * 2048 + col0;
#pragma unroll
                for (int bj = 0; bj < 2; ++bj) { f32x4 v0 = acc[ai][bj][m][0] + bv[bj][0], v1 = acc[ai][bj][m][1] + bv[bj][1];
#pragma unroll
                    for (int e = 0; e < 4; ++e) { const float s0 = __builtin_amdgcn_rcpf(1.0f + __builtin_amdgcn_exp2f(-1.4426950408889634f * v0[e])), s1 = __builtin_amdgcn_rcpf(1.0f + __builtin_amdgcn_exp2f(-1.4426950408889634f * v1[e]));
                        v0[e] = ACT == 4 ? -0.8750387749f * s0 : s0; v1[e] = ACT == 4 ? -0.8750387749f * s1 : s1; }
                    typedef __bf16 bf8n __attribute__((ext_vector_type(8))); typedef float f8n __attribute__((ext_vector_type(8)));
                    const u32x4 w = __builtin_bit_cast(u32x4, __builtin_convertvector((f8n){v0[0], v0[1], v0[2], v0[3], v1[0], v1[1], v1[2], v1[3]}, bf8n));
                    *(u32x4*)(rowp + bj * HALF) = w; } }
    }
};

struct GroupOrderA2 {
    StaticOrder so; int per, nG;
    __device__ void init(int M, int G_, int c_, int nG_) { so.init(M, 2048, G_, c_); per = so.nwg; nG = nG_; }
    __device__ bool next(int i, Unit& u) const {
        const long L = (long)i * so.G + so.c; u.ko = 0;
        if (L < 4L * per) { const int gi = (int)(L / per); int wgid = (int)(L - (long)gi * per);
            { const int q = so.nwg / NXCD, r = so.nwg % NXCD, xcd = wgid % NXCD, off = wgid / NXCD; wgid = (xcd < r ? xcd * (q + 1) : r * (q + 1) + (xcd - r) * q) + off; }
            const int nig = WGM * so.nN, gid = wgid / nig, fm = gid * WGM, gsz = (so.nM - fm) < WGM ? (so.nM - fm) : WGM;
            u.pm = fm + ((wgid % nig) % gsz) + 130 * gi; u.pn = (wgid % nig) / gsz + 8 * gi; return true; }
        const int Lp = (int)(L - 4L * per); if (Lp >= (nG - 4) * so.nM) return false;
        const int ge = Lp / so.nM, gi = 4 + ge; u.pm = Lp % so.nM + 130 * (gi == 6 ? 2 : gi); u.pn = 32 + ge; return true;
    }
    __device__ __forceinline__ void a_ready(const Unit&) const {}
    __device__ __forceinline__ void done(const Unit&) const {}
};
struct EpiA2 {
    static constexpr bool PERM = true, AFTER_DRAIN = false;
    bf16_t* Rb; size_t ostride; int vidx; bf16_t* Lb; size_t lstride;
    __device__ __forceinline__ void operator()(const f32x4 (&acc)[2][2][4][2], const Unit& u, int wr, int wc, int, int) const {
        int lane_; asm volatile("v_mbcnt_lo_u32_b32 %0, -1, 0\n\tv_mbcnt_hi_u32_b32 %0, -1, %0" : "=v"(lane_)); const int fr = lane_ & 15, fq = lane_ >> 4;
        if (u.pn < 32) { const int gi = u.pn >> 3; bf16_t* Ob = Rb + (size_t)(gi < 2 ? gi : (gi == 2 ? vidx : 4)) * ostride;
            const int row0 = (u.pm - 130 * gi) * BM + wr * 64 + fr, col0 = (u.pn & 7) * BM + wc * 32 + 8 * fq;
#pragma unroll
            for (int ai = 0; ai < 2; ++ai)
#pragma unroll
                for (int m = 0; m < 4; ++m) { bf16_t* rowp = Ob + (size_t)(row0 + ai * HALF + m * 16) * 2048 + col0;
#pragma unroll
                    for (int bj = 0; bj < 2; ++bj) { const f32x4 v0 = acc[ai][bj][m][0], v1 = acc[ai][bj][m][1];
                        u32x4 w; w.x = cvt_pk_bf16(v0[0], v0[1]); w.y = cvt_pk_bf16(v0[2], v0[3]); w.z = cvt_pk_bf16(v1[0], v1[1]); w.w = cvt_pk_bf16(v1[2], v1[3]);
                        *(u32x4*)(rowp + bj * HALF) = w; } }
        } else { const int ge = u.pn - 32, gi = 4 + ge; bf16_t* Ob = Lb + (size_t)ge * lstride; const int nvalid = ge == 2 ? 32 : 64;
            const int row0 = (u.pm - 130 * (gi == 6 ? 2 : gi)) * BM + wr * 64 + fr, c = wc * 32 + 8 * fq;
#pragma unroll
            for (int ai = 0; ai < 2; ++ai)
#pragma unroll
                for (int m = 0; m < 4; ++m) { f32x4 v0 = acc[ai][0][m][0], v1 = acc[ai][0][m][1];
                    if (ge == 0) {
#pragma unroll
                        for (int e = 0; e < 4; ++e) { v0[e] = 1.0f - 2.0f / (1.0f + __expf(2.0f * v0[e])); v1[e] = 1.0f - 2.0f / (1.0f + __expf(2.0f * v1[e])); } }
                    u32x4 w; w.x = cvt_pk_bf16(v0[0], v0[1]); w.y = cvt_pk_bf16(v0[2], v0[3]); w.z = cvt_pk_bf16(v1[0], v1[1]); w.w = cvt_pk_bf16(v1[2], v1[3]);
                    if (c >= nvalid) w = (u32x4){0u, 0u, 0u, 0u};
                    *(u32x4*)(Ob + (size_t)(row0 + ai * HALF + m * 16) * 128 + c) = w; }
        }
    }
};
template <class Epi, class Sched, bool ALIGN_EPI = false, bool SP2 = false>
__device__ __forceinline__ void gemm_phase(PG8_LAS unsigned char* lds, const Gemm g, const Sched& S, const Epi& E, const int wid) {
    int lane_; asm volatile("v_mbcnt_lo_u32_b32 %0, -1, 0\n\tv_mbcnt_hi_u32_b32 %0, -1, %0" : "=v"(lane_));
    const int lane = lane_, tid = wid * 64 + lane, wr = wid >> 2, wc = wid & 3, fr = lane & 15, fq = lane >> 4;
    const int K = g.K, nt = K / BK, LD = g.ld ? g.ld : g.K;
    unsigned voffA[2], voffB[2];
#pragma unroll
    for (int i = 0; i < 2; ++i) { int R, C; stage_rc(tid * 16 + i * 8192, R, C); const int Rb = Epi::PERM ? ((R & ~31) + perm32(R & 31)) : R;
        voffA[i] = (unsigned)(R * LD + C) * 2u; voffB[i] = (unsigned)(Rb * LD + C) * 2u; }
    const size_t kstep = (size_t)(BK * 2);
    const size_t hstep = (size_t)HALF * LD * 2;
    const size_t tstep = 2 * hstep;
    const unsigned ldsw = (unsigned)wid * 1024u;
    const int aoff = lds_byte(wr * 64 + fr, fq * 8), boff = lds_byte(wc * 32 + fr, fq * 8);
#define PG8_SA(b, h) (((b) * 2 + (h)) * HTB)
#define PG8_SB(b, h) ((4 + (b) * 2 + (h)) * HTB)
#define PG8_STAGE(bufoff, gbase, voff) do { _Pragma("unroll") for (int _i = 0; _i < 2; ++_i) \
        __builtin_amdgcn_global_load_lds((const unsigned*)((const char*)(gbase) + (voff)[_i]), (PG8_LAS unsigned*)(lds + (bufoff) + ldsw + _i * 8192), 16, 0, 0); } while (0)
#define PG8_LDA(dst, b, h) do { _Pragma("unroll") for (int m = 0; m < 4; ++m) _Pragma("unroll") for (int k = 0; k < 2; ++k) dst[m][k] = *(const PG8_LAS bf16x8*)(lds + PG8_SA(b, h) + aoff + m * 2048 + k * 1024); } while (0)
#define PG8_LDB(dst, b, h) do { _Pragma("unroll") for (int n = 0; n < 2; ++n) _Pragma("unroll") for (int k = 0; k < 2; ++k) dst[n][k] = *(const PG8_LAS bf16x8*)(lds + PG8_SB(b, h) + boff + n * 2048 + k * 1024); } while (0)
#define PG8_MMA(ai, bj, At, Bt) do { __builtin_amdgcn_s_setprio(1); _Pragma("unroll") for (int m = 0; m < 4; ++m) _Pragma("unroll") for (int n = 0; n < 2; ++n) _Pragma("unroll") for (int k = 0; k < 2; ++k) \
        acc[ai][bj][m][n] = __builtin_amdgcn_mfma_f32_16x16x32_bf16(Bt[n][k], At[m][k], acc[ai][bj][m][n], 0, 0, 0); __builtin_amdgcn_s_setprio(0); } while (0)
#define PG8_WAIT_V(n) asm volatile("s_waitcnt vmcnt(" #n ")" ::: "memory")
#define PG8_WAIT_L(n) asm volatile("s_waitcnt lgkmcnt(" #n ")" ::: "memory")
#define PG8_BAR __builtin_amdgcn_s_barrier()
#define PG8_SCHED __builtin_amdgcn_sched_barrier(0)
    Unit cur, nxt; int ui = 0;
    if (!S.next(0, cur)) return;
    f32x4 acc[2][2][4][2];
#pragma unroll
    for (int a = 0; a < 2; ++a)
#pragma unroll
        for (int b = 0; b < 2; ++b)
#pragma unroll
            for (int m = 0; m < 4; ++m)
#pragma unroll
                for (int n = 0; n < 2; ++n) acc[a][b][m][n] = (f32x4){0.f, 0.f, 0.f, 0.f};
    bf16x8 At[4][2], B0[2][2], B1[2][2];
    const char* cA = (const char*)g.A + (size_t)cur.pm * tstep + cur.ko; const char* cB = (const char*)g.Bt + (size_t)cur.pn * tstep + cur.ko;
    S.a_ready(cur);
    if constexpr (SP2) {
        PG8_STAGE(PG8_SB(0, 0), cB, voffB); PG8_STAGE(PG8_SB(0, 1), cB + hstep, voffB); PG8_STAGE(PG8_SA(0, 0), cA, voffA); PG8_STAGE(PG8_SA(0, 1), cA + hstep, voffA);
        if (wr == 1) PG8_BAR;
        PG8_WAIT_V(2); PG8_BAR;
        PG8_STAGE(PG8_SB(1, 0), cB + kstep, voffB); PG8_STAGE(PG8_SA(1, 0), cA + kstep, voffA); PG8_STAGE(PG8_SB(1, 1), cB + hstep + kstep, voffB);
        PG8_WAIT_V(6); PG8_BAR;
    } else {
        PG8_STAGE(PG8_SB(0, 0), cB, voffB); PG8_STAGE(PG8_SA(0, 0), cA, voffA); PG8_STAGE(PG8_SB(0, 1), cB + hstep, voffB); PG8_STAGE(PG8_SA(0, 1), cA + hstep, voffA);
        if (wr == 1) PG8_BAR;
        PG8_WAIT_V(4); PG8_BAR;
        PG8_STAGE(PG8_SB(1, 0), cB + kstep, voffB); PG8_STAGE(PG8_SA(1, 0), cA + kstep, voffA); PG8_STAGE(PG8_SB(1, 1), cB + hstep + kstep, voffB);
        PG8_WAIT_V(6); PG8_BAR;
    }
    for (;;) {
        const bool has_next = S.next(ui + 1, nxt);
        const char* nA = has_next ? (const char*)g.A + (size_t)nxt.pm * tstep + nxt.ko : cA; const char* nB = has_next ? (const char*)g.Bt + (size_t)nxt.pn * tstep + nxt.ko : cB;
        for (int t = 0; t < nt; t += 2) {
            const bool last = (t == nt - 2);
            const char* a1 = cA + (size_t)(t + 1) * kstep;
            const char* a2 = last ? nA : cA + (size_t)(t + 2) * kstep; const char* b2 = last ? nB : cB + (size_t)(t + 2) * kstep;
            const char* a3 = a2 + kstep; const char* b3 = b2 + kstep;
            if (last && has_next) S.a_ready(nxt);
            if constexpr (SP2) {
            PG8_LDB(B0, 0, 0); PG8_LDB(B1, 0, 1); PG8_SCHED; PG8_LDA(At, 0, 0); PG8_STAGE(PG8_SA(1, 1), a1 + hstep, voffA);
            PG8_WAIT_V(8); PG8_WAIT_L(0); PG8_BAR; PG8_MMA(0, 0, At, B0); PG8_MMA(0, 1, At, B1); PG8_BAR; PG8_SCHED;
            PG8_LDA(At, 0, 1); PG8_STAGE(PG8_SB(0, 0), b2, voffB); PG8_STAGE(PG8_SB(0, 1), b2 + hstep, voffB); PG8_STAGE(PG8_SA(0, 0), a2, voffA);
            PG8_WAIT_V(8); PG8_WAIT_L(0); PG8_BAR; PG8_MMA(1, 0, At, B0); PG8_MMA(1, 1, At, B1); PG8_BAR; PG8_SCHED;
            PG8_LDB(B0, 1, 0); PG8_LDB(B1, 1, 1); PG8_SCHED; PG8_LDA(At, 1, 0); PG8_STAGE(PG8_SA(0, 1), a2 + hstep, voffA);
            PG8_WAIT_V(8); PG8_WAIT_L(0); PG8_BAR; PG8_MMA(0, 0, At, B0); PG8_MMA(0, 1, At, B1); PG8_BAR; PG8_SCHED;
            PG8_LDA(At, 1, 1); PG8_STAGE(PG8_SB(1, 0), b3, voffB); PG8_STAGE(PG8_SB(1, 1), b3 + hstep, voffB); PG8_STAGE(PG8_SA(1, 0), a3, voffA);
            PG8_WAIT_V(8); PG8_WAIT_L(0); PG8_BAR; PG8_MMA(1, 0, At, B0); PG8_MMA(1, 1, At, B1); PG8_BAR; PG8_SCHED;
            } else {
            PG8_LDB(B0, 0, 0); PG8_SCHED; PG8_LDA(At, 0, 0); PG8_STAGE(PG8_SA(1, 1), a1 + hstep, voffA);
            PG8_WAIT_L(8); PG8_BAR; PG8_WAIT_L(0); PG8_MMA(0, 0, At, B0); PG8_BAR; PG8_SCHED;
            PG8_LDB(B1, 0, 1); PG8_STAGE(PG8_SB(0, 0), b2, voffB);
            PG8_BAR; PG8_WAIT_L(0); PG8_MMA(0, 1, At, B1); PG8_BAR;
            PG8_LDA(At, 0, 1); PG8_STAGE(PG8_SA(0, 0), a2, voffA);
            PG8_BAR; PG8_WAIT_L(0); PG8_MMA(1, 0, At, B0); PG8_BAR; PG8_SCHED;
            PG8_STAGE(PG8_SB(0, 1), b2 + hstep, voffB);
            PG8_WAIT_V(6); PG8_BAR; PG8_MMA(1, 1, At, B1); PG8_BAR;
            PG8_LDB(B0, 1, 0); PG8_SCHED; PG8_LDA(At, 1, 0); PG8_STAGE(PG8_SA(0, 1), a2 + hstep, voffA);
            PG8_WAIT_L(8); PG8_BAR; PG8_WAIT_L(0); PG8_MMA(0, 0, At, B0); PG8_BAR; PG8_SCHED;
            PG8_LDB(B1, 1, 1); PG8_STAGE(PG8_SB(1, 0), b3, voffB);
            PG8_BAR; PG8_WAIT_L(0); PG8_MMA(0, 1, At, B1); PG8_BAR;
            PG8_LDA(At, 1, 1); PG8_STAGE(PG8_SA(1, 0), a3, voffA);
            PG8_BAR; PG8_WAIT_L(0); PG8_MMA(1, 0, At, B0); PG8_BAR; PG8_SCHED;
            PG8_STAGE(PG8_SB(1, 1), b3 + hstep, voffB);
            PG8_WAIT_V(6); PG8_BAR; PG8_MMA(1, 1, At, B1); PG8_BAR;
            }
        }
        if constexpr (ALIGN_EPI) { if (wr == 0) PG8_BAR; }
        if constexpr (!Epi::AFTER_DRAIN) { E(acc, cur, wr, wc, fr, fq); S.done(cur); }
        if (!has_next) break;
#pragma unroll
        for (int a = 0; a < 2; ++a)
#pragma unroll
            for (int b = 0; b < 2; ++b)
#pragma unroll
                for (int m = 0; m < 4; ++m)
#pragma unroll
                    for (int n = 0; n < 2; ++n) acc[a][b][m][n] = (f32x4){0.f, 0.f, 0.f, 0.f};
        cur = nxt; cA = nA; cB = nB; ++ui;
        if constexpr (ALIGN_EPI) { if (wr == 1) PG8_BAR; }
    }
    PG8_WAIT_V(0);
    if constexpr (!ALIGN_EPI) { if (wr == 0) PG8_BAR; }
    PG8_BAR;
    if constexpr (Epi::AFTER_DRAIN) { E.fused(acc, cur, wr, wc, fr, fq, lds, wid, lane); S.done(cur); }
#undef PG8_SA
#undef PG8_SB
#undef PG8_STAGE
#undef PG8_LDA
#undef PG8_LDB
#undef PG8_MMA
#undef PG8_WAIT_V
#undef PG8_WAIT_L
#undef PG8_BAR
#undef PG8_SCHED
}
}
constexpr int D_MODEL = 1024, BATCH = 16, SEQ = 2048, DEC_BATCH = 128, PAST = 8192, PAGE = 128, NPAGES = 64;
constexpr int D_INNER = 2048, A_HEADS = 32, A_HEAD = 64, B_HEADS = 16, KV_LORA = 256, Q_LORA = 384, QK_NOPE = 128, QK_ROPE = 64, V_HEAD = 128, QK_HEAD = 192;
constexpr int MP = BATCH * SEQ;
constexpr int MS0 = MP;
constexpr int MT = MP + 256;
constexpr float NORM_EPS = 1e-6f, GN_EPS = 64e-5f;
constexpr float ATTN_SCALE = 0.07216878364870322f;
constexpr float LOG2E = 1.4426950408889634f;
constexpr int NWAVES = 8, NTHR = 512;

constexpr size_t O_YP = 0, O_YS = O_YP + (size_t)MP * D_MODEL, O_WKVP = O_YS + (size_t)DEC_BATCH * D_MODEL, O_SHP = O_WKVP + (size_t)2 * BATCH * A_HEADS * 4096,
    O_CKVP = O_SHP + (size_t)2 * BATCH * D_MODEL, O_KPEP = O_CKVP + (size_t)MP * KV_LORA, O_WKVS = O_KPEP + (size_t)MP * QK_ROPE, O_SHS = O_WKVS + (size_t)2 * DEC_BATCH * A_HEADS * 4096,
    O_CKVS = O_SHS + (size_t)2 * DEC_BATCH * D_MODEL, O_KPES = O_CKVS + (size_t)DEC_BATCH * KV_LORA, O_END = O_KPES + (size_t)DEC_BATCH * QK_ROPE;

constexpr size_t MiB = 1u << 20;
constexpr size_t WS_CTL = 0, CTL_ZERO_BYTES = 2 * MiB;
constexpr size_t WS_WIN = 2 * MiB, WIN_L = 18 * MiB;
constexpr size_t WS_W2 = WS_WIN + 2 * WIN_L;
constexpr size_t WS_WO = WS_W2 + 3 * MiB;
constexpr size_t WS_WDKV = WS_WO + 8 * MiB;
constexpr size_t WS_WUK = WS_WDKV + 1 * MiB;
constexpr size_t WS_WUV = WS_WUK + 1 * MiB;
constexpr size_t WS_WQ = WS_WUV + 1 * MiB;
constexpr size_t WS_WZ = WS_WQ + 2 * MiB;
constexpr size_t WS_WUQ = WS_WZ + 8 * MiB;
constexpr size_t WS_WBO = WS_WUQ + 5 * MiB;
constexpr size_t WS_ROPE = WS_WBO + 8 * MiB;
constexpr size_t WS_X = 96 * MiB;
constexpr size_t WS_AM = WS_X + 130 * MiB;
constexpr size_t AM_STRIDE = 65 * MiB;
constexpr size_t WS_R = WS_AM + 6 * AM_STRIDE;
constexpr size_t BIGB = 130 * MiB;
constexpr size_t WS_K = WS_R + BIGB, WS_V0 = WS_K + BIGB, WS_V1 = WS_V0 + BIGB, WS_Z = WS_V1 + BIGB, WS_G = WS_Z + BIGB;
constexpr size_t WS_LW = WS_G + BIGB;
constexpr size_t WS_LA = WS_LW + 9 * MiB, WS_LV = WS_LA + 9 * MiB;
constexpr size_t WS_BON = WS_LV + 9 * MiB;
constexpr size_t WS_F = WS_BON + 5 * MiB;
constexpr size_t BIGF = 260 * MiB;
constexpr size_t WS_WD = WS_F, WS_IA = WS_F + BIGF, WS_VG = WS_F + 2 * BIGF, WS_SR = WS_F + 3 * BIGF, WS_SK = WS_F + 4 * BIGF, WS_SA = WS_F + 5 * BIGF, WS_SB = WS_F + 6 * BIGF,
    WS_SV = WS_F + 7 * BIGF, WS_Y = WS_F + 8 * BIGF, WS_END_A = WS_F + 9 * BIGF;
constexpr size_t WS_KVR = WS_F;
constexpr size_t WS_CKVB = WS_KVR + 41 * MiB;
constexpr size_t WS_KPEB = WS_CKVB + 17 * MiB;
constexpr size_t WS_KN = WS_KPEB + 5 * MiB;
constexpr size_t WS_VT = WS_KN + 128 * MiB;
constexpr size_t WS_QL = WS_VT + 128 * MiB;
constexpr size_t WS_CQ = WS_QL + 49 * MiB;
constexpr size_t WS_QR = WS_CQ + 25 * MiB;
constexpr size_t WS_Q = WS_QR + 388 * MiB;
constexpr size_t WS_QABS = WS_Q + 194 * MiB;
constexpr size_t WS_OPART = WS_QABS + 2 * MiB;
constexpr size_t WS_ML = WS_OPART + 16 * MiB;
constexpr size_t WS_END_B = WS_ML + 1 * MiB;
constexpr size_t WS_NEED = WS_END_A > WS_END_B ? WS_END_A : WS_END_B;
static_assert(WS_ROPE + 1 * MiB <= WS_X, "weights region");
constexpr size_t CW_RSQ = 1 * MiB;
constexpr int CW_BAR = 4096;

constexpr int RING_BYTES = 131072;
constexpr int LDSCTL_OFF = RING_BYTES;
constexpr int LDS_BYTES = 147456;

#define GAS __attribute__((address_space(1)))
#define LAS __attribute__((address_space(3)))
typedef unsigned short bf16;
typedef unsigned v4u __attribute__((ext_vector_type(4)));
typedef unsigned v2u __attribute__((ext_vector_type(2)));
typedef float f32x4 __attribute__((ext_vector_type(4)));
typedef float f32x16 __attribute__((ext_vector_type(16)));
typedef short bf16x8 __attribute__((ext_vector_type(8)));
typedef short s16x4 __attribute__((ext_vector_type(4)));
typedef const __attribute__((address_space(4))) float* cfp;
#define LDS_WAIT() asm volatile("s_waitcnt lgkmcnt(0)" ::: "memory")
#define VM_WAIT() asm volatile("s_waitcnt vmcnt(0)" ::: "memory")
__device__ __forceinline__ unsigned f2bf(float f) { unsigned u = __builtin_bit_cast(unsigned, f); return (u + 0x7fffu + ((u >> 16) & 1u)) >> 16; }
__device__ __forceinline__ unsigned pk2(float lo, float hi) { return f2bf(lo) | (f2bf(hi) << 16); }
__device__ __forceinline__ float bflo(unsigned u) { return __builtin_bit_cast(float, u << 16); }
__device__ __forceinline__ float bfhi(unsigned u) { return __builtin_bit_cast(float, u & 0xffff0000u); }
template <int MASK> __device__ __forceinline__ float swz_xor(float v) { return __builtin_bit_cast(float, __builtin_amdgcn_ds_swizzle(__builtin_bit_cast(int, v), 0x1F | (MASK << 10))); }
__device__ __forceinline__ float xor32_sum(float v) { float a = v, b = v; asm volatile("s_nop 1\n\tv_permlane32_swap_b32 %0, %1\n\ts_nop 1" : "+v"(a), "+v"(b)); return a + b; }
__device__ __forceinline__ float xor32_max(float v) { float a = v, b = v; asm volatile("s_nop 1\n\tv_permlane32_swap_b32 %0, %1\n\ts_nop 1" : "+v"(a), "+v"(b)); return fmaxf(a, b); }
__device__ __forceinline__ float wave_sum(float v) { v += swz_xor<1>(v); v += swz_xor<2>(v); v += swz_xor<4>(v); v += swz_xor<8>(v); v += swz_xor<16>(v); return xor32_sum(v); }
__device__ __forceinline__ float sigmoidf_(float x) { return 1.0f / (1.0f + __expf(-x)); }
#define XB_TMO      128
#define XB_XCNT(j)  (256  + 64 * (j))
#define XB_XSUB(j)  (1280 + 64 * (j))
#define XB_XGEN(j)  (2304 + 64 * (j))
#define XB_TOP      3328
#define XB_TOPGEN   3392
#define XCD_BAR_WORDS 3456
#define XB_SPIN_CAP (1u << 18)

__device__ __forceinline__ unsigned xb_ld(unsigned* p)              { return __hip_atomic_load(p, __ATOMIC_RELAXED, __HIP_MEMORY_SCOPE_AGENT); }
__device__ __forceinline__ unsigned xb_add(unsigned* p, unsigned v) { return __hip_atomic_fetch_add(p, v, __ATOMIC_RELAXED, __HIP_MEMORY_SCOPE_AGENT); }
__device__ __forceinline__ unsigned xb_xcc_id() { return (unsigned)__builtin_amdgcn_s_getreg((3 << 11) | 20) & 0xFu; }
#define XB_SPIN(cond, bar) do { unsigned _sp = 0; while (cond) { __builtin_amdgcn_s_sleep(1); \
    if ((++_sp & 255u) == 0u) { if (xb_ld(&(bar)[XB_TMO])) break; if (_sp > XB_SPIN_CAP) { atomicAdd(&(bar)[XB_TMO], 1u); break; } } } } while (0)

struct XcdBarrier {
    unsigned* bar; unsigned x; unsigned w;
    volatile LAS unsigned* st;
};

__device__ __forceinline__ bool xb_t0(unsigned w) { unsigned l; asm volatile("v_mbcnt_lo_u32_b32 %0, -1, 0\n\tv_mbcnt_hi_u32_b32 %0, -1, %0" : "=v"(l)); return w == 0u && l == 0u; }
__device__ __forceinline__ XcdBarrier xcd_barrier_post(unsigned* bar, volatile LAS unsigned* st, unsigned w) {
    XcdBarrier b; b.bar = bar; b.x = xb_xcc_id(); b.st = st; b.w = w;
    if (xb_t0(w)) (void)xb_add(&bar[XB_XCNT(b.x)], 1u);
    return b;
}
__device__ __forceinline__ void xcd_barrier_complete(unsigned* bar, unsigned x, unsigned& nloc, unsigned& nx) {
    const unsigned G = gridDim.x * gridDim.y * gridDim.z;
    unsigned sum, cnt, mine, sp = 0u;
    for (;;) {
        sum = 0u; cnt = 0u; mine = 0u;
#pragma unroll
        for (unsigned j = 0; j < 16; ++j) { const unsigned c = xb_ld(&bar[XB_XCNT(j)]); sum += c; cnt += (c > 0u) ? 1u : 0u; mine = (j == x) ? c : mine; }
        if (sum == G) break;
        __builtin_amdgcn_s_sleep(1);
        if ((++sp & 255u) == 0u) { if (xb_ld(&bar[XB_TMO])) break; if (sp > XB_SPIN_CAP) { atomicAdd(&bar[XB_TMO], 1u); break; } }
    }
    nloc = mine > 0u ? mine : 1u; nx = cnt > 0u ? cnt : 1u;
}

__device__ __forceinline__ void xcd_barrier(const XcdBarrier& b) {
    asm volatile("s_waitcnt vmcnt(0)" ::: "memory");
    __syncthreads();
    if (xb_t0(b.w)) {
        unsigned* bar = b.bar;
        __builtin_amdgcn_s_waitcnt(0);
        unsigned nloc = b.st[0], nx = b.st[1];
        if (nloc == 0u) { xcd_barrier_complete(bar, b.x, nloc, nx); b.st[0] = nloc; b.st[1] = nx; }
        const unsigned old = xb_add(&bar[XB_XSUB(b.x)], 1u);
        const unsigned gen = old / nloc;
        if (old + 1u == (gen + 1u) * nloc) {
            __builtin_amdgcn_fence(__ATOMIC_RELEASE, "agent");
            asm volatile("s_waitcnt vmcnt(0)" ::: "memory");
            const unsigned og = xb_add(&bar[XB_TOP], 1u);
            const unsigned tg = og / nx;
            if (og + 1u == (tg + 1u) * nx) xb_add(&bar[XB_TOPGEN], 1u);
            else XB_SPIN(xb_ld(&bar[XB_TOPGEN]) == tg, bar);
            __builtin_amdgcn_fence(__ATOMIC_ACQUIRE, "agent");
            xb_add(&bar[XB_XGEN(b.x)], 1u);
            asm volatile("s_waitcnt vmcnt(0)" ::: "memory");
        } else {
            XB_SPIN(xb_ld(&bar[XB_XGEN(b.x)]) == gen, bar);
            __builtin_amdgcn_fence(__ATOMIC_ACQUIRE, "agent");
            asm volatile("s_waitcnt vmcnt(0)" ::: "memory");
        }
    }
    __syncthreads();
}
struct Args { const void* in[36]; float* out; unsigned char* ws; int ph_lo, ph_hi, li, pad; };
typedef const __attribute__((address_space(4))) Args* cargs;
__device__ __forceinline__ int lane_id() { int l; asm volatile("v_mbcnt_lo_u32_b32 %0, -1, 0\n\tv_mbcnt_hi_u32_b32 %0, -1, %0" : "=v"(l)); return l; }
struct Frame { LAS unsigned char* lds; unsigned char* ws; float* out; int lane, wave, bid, gw, NGW, G, NT; };
#define LANE F.lane
__device__ __forceinline__ Frame make_frame(cargs ap, int wave0, LAS unsigned char* lds) {
    Frame F; int w = wave0, b = (int)blockIdx.x, g = (int)gridDim.x; asm volatile("" : "+s"(w), "+s"(b), "+s"(g));
    F.lds = lds; F.ws = ap->ws; F.out = ap->out; F.lane = lane_id(); F.wave = w; F.bid = b; F.G = g; F.gw = b * NWAVES + w; F.NGW = g * NWAVES; F.NT = g * NTHR;
    return F;
}

__device__ __forceinline__ int rope_perm_col(int n) { const int c = n % 192; if (c < 128) return n; const int j = c - 128; return n - c + 128 + 2 * (j & 31) + (j >> 5); }
__device__ __forceinline__ void tr_item(const float* W, int ldw, int col0, int Kvalid, int nblk, bf16* WT, int ldt, bool zpad, LAS float* scr, int item, int lane, bool rperm = false) {
    const int kb = item / nblk, nb = item % nblk, k0 = 64 * kb, n0 = 32 * nb;
    float wv[32];
#pragma unroll
    for (int i = 0; i < 32; ++i) { const int kr = min(k0 + 2 * i + (lane >> 5), Kvalid - 1); wv[i] = W[(size_t)kr * ldw + col0 + n0 + (lane & 31)]; }
    __builtin_amdgcn_sched_barrier(0);
#pragma unroll
    for (int i = 0; i < 32; ++i) { const int kk = 2 * i + (lane >> 5); scr[kk * 33 + (lane & 31)] = (k0 + kk < Kvalid) ? wv[i] : 0.f; }
    LDS_WAIT(); asm volatile("" ::: "memory");
    const int c = lane & 7;
#pragma unroll
    for (int j = 0; j < 4; ++j) { const int n = (lane >> 3) + 8 * j; const LAS float* s = scr + (8 * c) * 33 + n;
        v4u o; o.x = pk2(s[0 * 33], s[1 * 33]); o.y = pk2(s[2 * 33], s[3 * 33]); o.z = pk2(s[4 * 33], s[5 * 33]); o.w = pk2(s[6 * 33], s[7 * 33]);
        const int nd = rperm ? rope_perm_col(n0 + n) : n0 + n;
        *(v4u*)(WT + (size_t)nd * ldt + k0 + 8 * c) = o;
        if (zpad) *(v4u*)(WT + (size_t)nd * ldt + 64 + 8 * c) = (v4u){0u, 0u, 0u, 0u}; }
    LDS_WAIT(); asm volatile("" ::: "memory");
}
#define TRJOB_(W_, ldw_, col0_, Kv_, Nc_, WT_, ldt_, zp_, rp_) do { const int nblk_ = (Nc_) / 32, items_ = (((Kv_) + 63) / 64) * nblk_; \
    for (int it_ = ((F.gw - base_) % F.NGW + F.NGW) % F.NGW; it_ < items_; it_ += F.NGW) tr_item((W_), (ldw_), (col0_), (Kv_), nblk_, (bf16*)(WT_), (ldt_), (zp_), scr, it_, LANE, (rp_)); base_ = (base_ + items_) % F.NGW; } while (0)
#define TRJOB(W_, ldw_, col0_, Kv_, Nc_, WT_, ldt_, zp_) TRJOB_(W_, ldw_, col0_, Kv_, Nc_, WT_, ldt_, zp_, false)

__device__ __forceinline__ void p0_prologue(Frame& F, cargs a) {
    LAS float* scr = (LAS float*)(F.lds + F.wave * 16384);
    unsigned char* ws = F.ws; int base_ = 0;
    for (int l = 0; l < 2; ++l) {
        for (int p = 0; p < 4; ++p) TRJOB((const float*)a->in[9] + (size_t)(l * 4 + p) * 1024 * 2048, 2048, 0, 1024, 2048, ws + WS_WIN + (size_t)l * WIN_L + (size_t)p * 4 * MiB, 1024, false);
        TRJOB((const float*)a->in[11] + (size_t)l * 1024 * 64, 64, 0, 1024, 64, ws + WS_WIN + (size_t)l * WIN_L + 16 * MiB, 1024, false);
        TRJOB((const float*)a->in[14] + (size_t)l * 1024 * 64, 64, 0, 1024, 64, ws + WS_WIN + (size_t)l * WIN_L + 16 * MiB + MiB / 2, 1024, false);
        TRJOB((const float*)a->in[12] + (size_t)l * 64 * 2048, 2048, 0, 64, 2048, ws + WS_W2 + (size_t)l * (MiB / 2), 128, true);
        TRJOB((const float*)a->in[15] + (size_t)l * 64 * 2048, 2048, 0, 64, 2048, ws + WS_W2 + (size_t)(2 + l) * (MiB / 2), 128, true);
        TRJOB((const float*)a->in[24] + (size_t)l * 2048 * 1024, 1024, 0, 2048, 1024, ws + WS_WO + (size_t)l * 4 * MiB, 2048, false);
        TRJOB((const float*)a->in[31] + (size_t)l * 1024 * 2432, 2432, 0, 1024, 384, ws + WS_WQ + (size_t)l * MiB, 1024, false);
        TRJOB((const float*)a->in[31] + (size_t)l * 1024 * 2432, 2432, 384, 1024, 2048, ws + WS_WZ + (size_t)l * 4 * MiB, 1024, false);
        TRJOB_((const float*)a->in[33] + (size_t)l * 384 * 3072, 3072, 0, 384, 3072, ws + WS_WUQ + (size_t)l * (5 * MiB / 2), 384, false, true);
        TRJOB((const float*)a->in[34] + (size_t)l * 2048 * 1024, 1024, 0, 2048, 1024, ws + WS_WBO + (size_t)l * 4 * MiB, 2048, false);
    }
    TRJOB((const float*)a->in[17], 32, 0, 1024, 32, ws + WS_WIN + WIN_L + 17 * MiB, 1024, false);
    TRJOB((const float*)a->in[18], 2048, 0, 32, 2048, ws + WS_W2 + (size_t)4 * (MiB / 2), 128, true);
    TRJOB((const float*)a->in[26], 320, 0, 1024, 320, ws + WS_WDKV, 1024, false);
    TRJOB((const float*)a->in[28], 2048, 0, 256, 2048, ws + WS_WUK, 256, false);
    TRJOB((const float*)a->in[29], 2048, 0, 256, 2048, ws + WS_WUV, 256, false);
    { const f32x4* xs = (const f32x4*)a->in[1]; f32x4* X4 = (f32x4*)(ws + WS_X) + (size_t)MP * 256;
      for (int i = (F.bid * NTHR + F.wave * 64 + LANE); i < 256 * 256; i += F.NT) X4[i] = i < DEC_BATCH * 256 ? xs[i] : (f32x4){0.f, 0.f, 0.f, 0.f}; }
    { float* T = (float*)(ws + WS_ROPE);
      for (int i = (F.bid * NTHR + F.wave * 64 + LANE); i < 2049 * 32; i += F.NT) { const int p = i >> 5, f = i & 31; const double pos = p < 2048 ? (double)p : 8192.0;
          const double ang = pos * (double)exp2f(-(float)f * (13.287712379549449f / 32.0f)); T[2 * i] = (float)cos(ang); T[2 * i + 1] = (float)sin(ang); } }
}

__device__ __forceinline__ void load_row(const float* row, int lane, f32x4 (&v)[4]) {
#pragma unroll
    for (int j = 0; j < 4; ++j) v[j] = ((const f32x4*)row)[lane + 64 * j];
}
__device__ __forceinline__ float row_rs(const f32x4 (&v)[4]) {
    float s = 0.f;
#pragma unroll
    for (int j = 0; j < 4; ++j) s += (v[j].x * v[j].x + v[j].y * v[j].y) + (v[j].z * v[j].z + v[j].w * v[j].w);
    return 1.0f / sqrtf(wave_sum(s) * (1.0f / 1024.0f) + NORM_EPS);
}
__device__ __forceinline__ void norm_rows_bf16(Frame& F, const float* X, const float* w, bf16* O) {
    f32x4 w4[4]; load_row(w, LANE, w4);
    for (int m = F.gw; m < MT; m += F.NGW) { f32x4 x[4]; load_row(X + (size_t)m * 1024, LANE, x); const float rs = row_rs(x);
#pragma unroll
        for (int j = 0; j < 4; ++j) { const f32x4 h = x[j] * rs * w4[j]; v2u o; o.x = pk2(h.x, h.y); o.y = pk2(h.z, h.w); *(v2u*)(O + (size_t)m * 1024 + 4 * LANE + 256 * j) = o; } }
}

__device__ __forceinline__ void norm2_rows_bf16(Frame& F, const float* X, const float* wa, bf16* Oa, const float* wb, bf16* Ob) {
    f32x4 a4[4], b4[4]; load_row(wa, LANE, a4); load_row(wb, LANE, b4);
    for (int m = F.gw; m < MT; m += F.NGW) { f32x4 x[4]; load_row(X + (size_t)m * 1024, LANE, x); const float rs = row_rs(x);
#pragma unroll
        for (int j = 0; j < 4; ++j) { const f32x4 xs = x[j] * rs, ha = xs * a4[j], hb = xs * b4[j]; v2u o; o.x = pk2(ha.x, ha.y); o.y = pk2(ha.z, ha.w); *(v2u*)(Oa + (size_t)m * 1024 + 4 * LANE + 256 * j) = o;
            o.x = pk2(hb.x, hb.y); o.y = pk2(hb.z, hb.w); *(v2u*)(Ob + (size_t)m * 1024 + 4 * LANE + 256 * j) = o; } }
}

__device__ __forceinline__ void a1_prepass(Frame& F, cargs a, int l) {
    const float* Xw = (const float*)(F.ws + WS_X); const float* X = l == 0 ? (const float*)a->in[0] : Xw;
    const float* nw = (const float*)a->in[7] + l * 1024; const float* mix = (const float*)a->in[8] + l * 6 * 1024; const float* sshift = (const float*)a->in[3] + (size_t)l * DEC_BATCH * 1024;
    f32x4 w4[4]; load_row(nw, LANE, w4);
    LAS f32x4* mxl = (LAS f32x4*)F.lds;
    for (int i = F.wave * 64 + LANE; i < 6 * 256; i += NTHR) mxl[i] = ((const f32x4*)mix)[i];
    __syncthreads();
    for (int m = F.gw; m < MT; m += F.NGW) {
        f32x4 x[4], h[4], hp[4]; load_row((m < MP ? X : Xw) + (size_t)m * 1024, LANE, x); const float rs = row_rs(x);
#pragma unroll
        for (int j = 0; j < 4; ++j) { h[j] = x[j] * rs * w4[j]; hp[j] = (f32x4){0.f, 0.f, 0.f, 0.f}; }
        if (m < MP) { if ((m & (SEQ - 1)) != 0) { f32x4 xq[4]; load_row(X + (size_t)(m - 1) * 1024, LANE, xq); const float rq = row_rs(xq);
#pragma unroll
                for (int j = 0; j < 4; ++j) hp[j] = xq[j] * rq * w4[j]; } }
        else if (m < MP + DEC_BATCH) load_row(sshift + (size_t)(m - MP) * 1024, LANE, hp);
#pragma unroll
        for (int p = 0; p < 6; ++p) { bf16* O = (bf16*)(F.ws + WS_AM + (size_t)p * AM_STRIDE) + (size_t)m * 1024;
#pragma unroll
            for (int j = 0; j < 4; ++j) { const f32x4 mx = mxl[p * 256 + LANE + 64 * j]; const f32x4 o = h[j] + (hp[j] - h[j]) * mx;
                v2u w; w.x = pk2(o.x, o.y); w.y = pk2(o.z, o.w); *(v2u*)(O + 4 * LANE + 256 * j) = w; } }
        float* so = nullptr;
        if (m < MP) { if ((m & (SEQ - 1)) == SEQ - 1) so = F.out + O_SHP + (size_t)(l * BATCH + (m >> 11)) * 1024; }
        else if (m < MP + DEC_BATCH) so = F.out + O_SHS + (size_t)(l * DEC_BATCH + (m - MP)) * 1024;
        if (so) {
#pragma unroll
            for (int j = 0; j < 4; ++j) ((f32x4*)so)[LANE + 64 * j] = h[j]; }
    }
}

typedef float f32x2 __attribute__((ext_vector_type(2)));
__device__ __forceinline__ void unpack8(v4u u, float (&f)[8]) { f[0] = bflo(u.x); f[1] = bfhi(u.x); f[2] = bflo(u.y); f[3] = bfhi(u.y); f[4] = bflo(u.z); f[5] = bfhi(u.z); f[6] = bflo(u.w); f[7] = bfhi(u.w); }
constexpr int FS_TS = 16, FS_Y = FS_TS * 6 * 64 * 4, FS_Z = FS_Y + FS_TS * 64 * 4, FS_BON = FS_Z + FS_TS * 64 * 2, FS_BH = FS_BON + 128, FS_BUF = 2 * FS_BH;
static_assert(2 * FS_BUF <= RING_BYTES && FS_BH % 16 == 0, "fused scan LDS");
template <int CTRL> __device__ __forceinline__ float dppf(float v) { return __builtin_bit_cast(float, __builtin_amdgcn_update_dpp(0, __builtin_bit_cast(int, v), CTRL, 0xF, 0xF, false)); }
__device__ __forceinline__ float wave_sum_fast(float v) {
    v += dppf<0xB1>(v); v += dppf<0x4E>(v); v += dppf<0x124>(v); v += dppf<0x128>(v);
    const int iv = __builtin_bit_cast(int, v);
    return (__builtin_bit_cast(float, __builtin_amdgcn_readlane(iv, 0)) + __builtin_bit_cast(float, __builtin_amdgcn_readlane(iv, 16))) + (__builtin_bit_cast(float, __builtin_amdgcn_readlane(iv, 32)) + __builtin_bit_cast(float, __builtin_amdgcn_readlane(iv, 48)));
}
struct HeadPrm { float w0, a0, v0, kk, ka, rk, lnw, lnb; };
__device__ __forceinline__ float frcp(float x) { return __builtin_amdgcn_rcpf(x); }
__device__ __forceinline__ float fsig(float x) { return __builtin_amdgcn_rcpf(1.0f + __builtin_amdgcn_exp2f(-1.4426950408889634f * x)); }
__device__ __forceinline__ float wkv_step_lds(f32x2 (&S)[32], const LAS float* op, int lane) {
    const LAS f32x4* a4 = (const LAS f32x4*)op; const LAS f32x4* w4 = a4 + 16; const LAS f32x4* b4 = a4 + 32; const LAS f32x4* k4 = a4 + 48; const LAS f32x4* r4 = a4 + 64;
    const float vv = op[320 + lane];
    f32x2 s0 = (f32x2){0.f, 0.f}, s1 = s0;
#pragma unroll
    for (int q = 0; q < 16; ++q) { const f32x4 a = a4[q]; s0 += S[2 * q] * (f32x2){a.x, a.y}; s1 += S[2 * q + 1] * (f32x2){a.z, a.w}; }
    const f32x2 st = s0 + s1; const float sa = st.x + st.y; const f32x2 sa2 = (f32x2){sa, sa}, vv2 = (f32x2){vv, vv};
    f32x2 y0 = (f32x2){0.f, 0.f}, y1 = y0;
#pragma unroll
    for (int q = 0; q < 16; ++q) { const f32x4 w = w4[q], b = b4[q], k = k4[q], r = r4[q];
        S[2 * q] = S[2 * q] * (f32x2){w.x, w.y} + (sa2 * (f32x2){b.x, b.y} + vv2 * (f32x2){k.x, k.y}); y0 += S[2 * q] * (f32x2){r.x, r.y};
        S[2 * q + 1] = S[2 * q + 1] * (f32x2){w.z, w.w} + (sa2 * (f32x2){b.z, b.w} + vv2 * (f32x2){k.z, k.w}); y1 += S[2 * q + 1] * (f32x2){r.z, r.w}; }
    const f32x2 yt = y0 + y1; return yt.x + yt.y;
}
__device__ __forceinline__ void fs_prep_one(const HeadPrm& P, int l, float r, float k, float v, float dw, float da, float dv, float vf, LAS float* op, int lane, float& bon) {
    const float ia = da, w = __builtin_amdgcn_exp2f(dw);
    if (l) v = v + (vf - v) * dv;
    const float kk = k * P.kk, n2 = wave_sum_fast(kk * kk), inv = 1.0f / fmaxf(sqrtf(n2), 1e-12f), q = kk * inv, kp = k * (1.0f + (ia - 1.0f) * P.ka);
    bon = wave_sum_fast(r * kp * P.rk);
    op[lane] = -q; op[64 + lane] = w; op[128 + lane] = q * ia; op[192 + lane] = kp; op[256 + lane] = r; op[320 + lane] = v;
}
__device__ __forceinline__ float fs_post_one(const HeadPrm& P, float y, float vp, float z, float bon) {
    const float mu = wave_sum_fast(y) * (1.0f / 64.0f), d = y - mu, var = wave_sum_fast(d * d) * (1.0f / 64.0f);
    const float yn = d * __builtin_amdgcn_rsqf(var + GN_EPS) * P.lnw + P.lnb; return (yn + bon * vp) * (z * fsig(z));
}
__device__ __forceinline__ float ldbf(const bf16* p) { return bflo((unsigned)*p); }
__device__ __forceinline__ bf16 tobf(float x) { return __builtin_bit_cast(unsigned short, (__bf16)x); }
typedef short s16x4_t __attribute__((ext_vector_type(4)));
#define MF16(a_, b_, c_) __builtin_amdgcn_mfma_f32_16x16x16bf16_1k((a_), (b_), (c_), 0, 0, 0)
#define MF32(a_, b_, c_) __builtin_amdgcn_mfma_f32_16x16x32_bf16((a_), (b_), (c_), 0, 0, 0)
typedef __bf16 bf16x4_nat __attribute__((ext_vector_type(4)));
__device__ __forceinline__ s16x4_t cvt4(f32x4 v) { return __builtin_bit_cast(s16x4_t, __builtin_convertvector(v, bf16x4_nat)); }
constexpr int CK_TP = 144, CK_KP = 40;
constexpr int CK_AT = 0, CK_RT = CK_AT + 16 * CK_TP, CK_BH = CK_RT + 16 * CK_TP, CK_KH = CK_BH + 16 * CK_TP, CK_BHT = CK_KH + 16 * CK_TP, CK_KHT = CK_BHT + 64 * CK_KP, CK_VT = CK_KHT + 64 * CK_KP,
    CK_PC = CK_VT + 64 * CK_KP, CK_OPB = CK_PC + 256;
constexpr int RG_VP = 0, RG_Z = 2048, RG_BON = 4096, RG_SZ = 4224;
constexpr int BH_OPB = 0, BH_RING = 2 * CK_OPB, BH_Y = BH_RING + 3 * RG_SZ, BH_LW = BH_Y + 2 * 4096, BH_PRM = BH_LW + 4096, BH_SZ = BH_PRM + 6 * 256;
static_assert(2 * BH_SZ <= RING_BYTES && BH_SZ % 16 == 0 && CK_OPB % 16 == 0, "chunked scan LDS");
typedef short v4i16_ck __attribute__((ext_vector_type(4)));
__device__ __forceinline__ s16x4_t ck_tr(const LAS unsigned char* p) { return __builtin_bit_cast(s16x4_t, __builtin_amdgcn_ds_read_tr16_b64_v4i16((LAS v4i16_ck*)p)); }
__device__ __forceinline__ void ck_scan_chunk(f32x4 (&ST)[4][4], const LAS unsigned char* ob, const LAS unsigned char* vpb, LAS float* yb, int c16, int g) {
    const f32x4 zero4 = (f32x4){0.f, 0.f, 0.f, 0.f};
    bf16x8 at[2], rt[2], bh[2], kh[2];
#pragma unroll
    for (int ks = 0; ks < 2; ++ks) { const int o = c16 * CK_TP + 16 * g + 64 * ks;
        at[ks] = *(const LAS bf16x8*)(ob + CK_AT + o); rt[ks] = *(const LAS bf16x8*)(ob + CK_RT + o); bh[ks] = *(const LAS bf16x8*)(ob + CK_BH + o); kh[ks] = *(const LAS bf16x8*)(ob + CK_KH + o); }
    f32x4 qN = zero4, qL = zero4, qMk = zero4, qNbr = zero4, qNkr = zero4;
#pragma unroll
    for (int ks = 0; ks < 2; ++ks) { qN = MF32(bh[ks], at[ks], qN); qL = MF32(at[ks], bh[ks], qL); qMk = MF32(kh[ks], at[ks], qMk); qNbr = MF32(bh[ks], rt[ks], qNbr); qNkr = MF32(kh[ks], rt[ks], qNkr); }
    f32x4 Id;
#pragma unroll
    for (int r = 0; r < 4; ++r) { const int row = 4 * g + r; Id[r] = row == c16 ? 1.f : 0.f;
        if (!(row < c16)) { qN[r] = 0.f; qMk[r] = 0.f; }
        if (!(row <= c16)) { qNbr[r] = 0.f; qNkr[r] = 0.f; }
        if (!(c16 < row)) qL[r] = 0.f; }
    const s16x4_t aN = cvt4(qN), aL = cvt4(qL), aMk = cvt4(qMk), aNbr = cvt4(qNbr), aNkr = cvt4(qNkr);
    const f32x4 n2 = MF16(aL, aN, zero4), l2 = MF16(aN, aL, zero4);
    const s16x4_t aN2 = cvt4(n2), aL2 = cvt4(l2);
    const f32x4 n4 = MF16(aL2, aN2, zero4), l4 = MF16(aN2, aL2, zero4);
    const f32x4 n8 = MF16(cvt4(l4), cvt4(n4), zero4);
    const f32x4 p1t = MF16(cvt4(n2 + Id), cvt4(qL + Id), zero4);
    const f32x4 p2 = MF16(cvt4(l4 + Id), cvt4(n8 + Id), zero4);
    const s16x4_t aT = cvt4(MF16(cvt4(p1t), cvt4(p2), zero4));
    s16x4_t af[4], rf[4], bfr[4], kfr[4], vtr[4]; f32x4 pc[4]; s16x4_t Sb[4];
#pragma unroll
    for (int ki = 0; ki < 4; ++ki) { const int o = c16 * CK_TP + (16 * ki + 4 * g) * 2; af[ki] = *(const LAS s16x4_t*)(ob + CK_AT + o); rf[ki] = *(const LAS s16x4_t*)(ob + CK_RT + o);
        const int o2 = (4 * g + (c16 >> 2)) * CK_TP + (16 * ki + 4 * (c16 & 3)) * 2; bfr[ki] = ck_tr(ob + CK_BH + o2); kfr[ki] = ck_tr(ob + CK_KH + o2);
        vtr[ki] = ck_tr(vpb + (4 * g + (c16 >> 2)) * 128 + (16 * ki + 4 * (c16 & 3)) * 2);
        pc[ki] = *(const LAS f32x4*)(ob + CK_PC + (16 * ki + 4 * g) * 4); }
    f32x4 yt[4];
#pragma unroll
    for (int vi = 0; vi < 4; ++vi) {
        f32x4 xt = zero4, y0 = zero4;
#pragma unroll
        for (int ki = 0; ki < 4; ++ki) { Sb[ki] = cvt4(ST[ki][vi]); xt = MF16(af[ki], Sb[ki], xt); y0 = MF16(rf[ki], Sb[ki], y0); }
        const s16x4_t vt = vtr[vi];
        xt = MF16(aMk, vt, xt);
        const s16x4_t ub = cvt4(MF16(aT, cvt4(xt), zero4));
        y0 = MF16(aNbr, ub, y0); yt[vi] = MF16(aNkr, vt, y0);
#pragma unroll
        for (int ki = 0; ki < 4; ++ki) { ST[ki][vi] = MF16(bfr[ki], ub, ST[ki][vi]); ST[ki][vi] = MF16(kfr[ki], vt, ST[ki][vi]); ST[ki][vi] *= pc[ki]; }
    }
#pragma unroll
    for (int vi = 0; vi < 4; ++vi)
#pragma unroll
        for (int r = 0; r < 4; ++r) yb[(4 * g + r) * 64 + 16 * vi + c16] = yt[vi][r];
}
__device__ __forceinline__ void a5_fused(Frame& F, cargs a, int l) {
    unsigned char* ws = F.ws; const int lane = F.lane;
    const bf16* R = (const bf16*)(ws + WS_R); const bf16* K = (const bf16*)(ws + WS_K); const bf16* V = (const bf16*)(ws + (l ? WS_V1 : WS_V0)); const bf16* VF = (const bf16*)(ws + WS_V0); const bf16* Z = (const bf16*)(ws + WS_Z);
    const bf16* DW = (const bf16*)(ws + WS_WD); const bf16* DA = (const bf16*)(ws + WS_IA); const bf16* DV = (const bf16*)(ws + WS_VG); bf16* G = (bf16*)(ws + WS_G);
    const float* pw0 = (const float*)a->in[10] + l * 2048; const float* pa0 = (const float*)a->in[13] + l * 2048; const float* pv0 = (const float*)a->in[16]; const float* pkk = (const float*)a->in[19] + l * 2048;
    const float* pka = (const float*)a->in[20] + l * 2048; const float* prk = (const float*)a->in[21] + l * 2048; const float* plw = (const float*)a->in[22] + l * 2048; const float* plb = (const float*)a->in[23] + l * 2048;
    constexpr int NCH = SEQ / 16;
    for (int pr = F.bid; pr < BATCH * A_HEADS / 2; pr += F.G) { const int bh0 = 2 * pr;
        const int role = F.wave >> 1, hb = F.wave & 1, bh = bh0 + hb, b = bh >> 5, hh = bh & 31, ch = hh * 64 + lane;
        LAS unsigned char* blk = F.lds + hb * BH_SZ;
        const size_t rowb = (size_t)b * SEQ; const int c16 = lane & 15, g = lane >> 4;
#define CK_BAR() do { asm volatile("s_waitcnt lgkmcnt(0)" ::: "memory"); __builtin_amdgcn_s_barrier(); asm volatile("" ::: "memory"); } while (0)
#define CKV_LOAD(cc, SET) do { const size_t ro = (rowb + (size_t)(cc) * 16) * 2048;     \
            _Pragma("unroll") for (int j = 0; j < 2; ++j) { SET##r[j] = ((const v4u*)(R + ro + voff_))[j]; SET##k[j] = ((const v4u*)(K + ro + voff_))[j]; SET##v[j] = ((const v4u*)(V + ro + voff_))[j]; SET##z[j] = ((const v4u*)(Z + ro + voff_))[j]; \
                SET##w[j] = ((const v4u*)(DW + ro + voff_))[j]; SET##a[j] = ((const v4u*)(DA + ro + voff_))[j]; if (l) { SET##d[j] = ((const v4u*)(DV + ro + voff_))[j]; SET##f[j] = ((const v4u*)(VF + ro + voff_))[j]; } } } while (0)
#define CKV_PREP(cc, SET) do { LAS unsigned char* ob = blk + BH_OPB + ((cc) & 1) * CK_OPB; LAS unsigned char* rg = blk + BH_RING + ((cc) % 3) * RG_SZ; \
            float kk_[16], kp_[16], ia_[16], lw_[16]; float n2 = 0.f, bon = 0.f; \
            _Pragma("unroll") for (int j = 0; j < 2; ++j) { float k8[8], a8[8], r8[8], w8[8]; unpack8(SET##k[j], k8); unpack8(SET##a[j], a8); unpack8(SET##r[j], r8); unpack8(SET##w[j], w8); \
                _Pragma("unroll") for (int h = 0; h < 2; ++h) { const f32x4 pkk_ = prm[3 * 16 + 4 * vq_ + 2 * j + h], pka_ = prm[4 * 16 + 4 * vq_ + 2 * j + h], prk_ = prm[5 * 16 + 4 * vq_ + 2 * j + h]; \
                    _Pragma("unroll") for (int e = 0; e < 4; ++e) { const int i = 8 * j + 4 * h + e, e8 = 4 * h + e; const float ia = a8[e8]; ia_[i] = ia; lw_[i] = w8[e8]; \
                        const float kk = k8[e8] * pkk_[e]; kk_[i] = kk; n2 += kk * kk; const float kp = k8[e8] * (1.0f + (ia - 1.0f) * pka_[e]); kp_[i] = kp; bon += r8[e8] * kp * prk_[e]; } } } \
            n2 += dppf<0xB1>(n2); n2 += dppf<0x4E>(n2); bon += dppf<0xB1>(bon); bon += dppf<0x4E>(bon); const float inv = __builtin_amdgcn_rsqf(fmaxf(n2, 1e-24f)); \
              \
            _Pragma("unroll") for (int j = 0; j < 4; ++j) lwp[vt_ * 16 + 4 * vq_ + j] = (f32x4){lw_[4 * j], lw_[4 * j + 1], lw_[4 * j + 2], lw_[4 * j + 3]}; \
            LDS_WAIT(); asm volatile("" ::: "memory"); \
            { float c_[16]; _Pragma("unroll") for (int t = 0; t < 16; ++t) c_[t] = ((const LAS float*)lwp)[t * 64 + lane]; \
              _Pragma("unroll") for (int t = 1; t < 16; ++t) c_[t] += c_[t - 1]; \
              _Pragma("unroll") for (int t = 0; t < 16; ++t) ((LAS float*)lwp)[t * 64 + lane] = c_[t]; } \
            LDS_WAIT(); asm volatile("" ::: "memory"); \
            float lp_[16]; _Pragma("unroll") for (int j = 0; j < 4; ++j) { const f32x4 v = lwp[vt_ * 16 + 4 * vq_ + j]; lp_[4 * j] = v.x; lp_[4 * j + 1] = v.y; lp_[4 * j + 2] = v.z; lp_[4 * j + 3] = v.w; } \
            v4u oa[2], orr[2], ob_[2], ok[2], ov[2]; \
            _Pragma("unroll") for (int j = 0; j < 2; ++j) { float r8[8], v8[8]; unpack8(SET##r[j], r8); unpack8(SET##v[j], v8); \
                if (l) { float d8[8], f8[8]; unpack8(SET##d[j], d8); unpack8(SET##f[j], f8); _Pragma("unroll") for (int h = 0; h < 2; ++h) { \
                        _Pragma("unroll") for (int e = 0; e < 4; ++e) { const int e8 = 4 * h + e; v8[e8] = v8[e8] + (f8[e8] - v8[e8]) * d8[e8]; } } } \
                _Pragma("unroll") for (int e = 0; e < 8; e += 2) { const int i = 8 * j + e; \
                    const float P0 = __builtin_amdgcn_exp2f(lp_[i]), P1 = __builtin_amdgcn_exp2f(lp_[i + 1]), R0 = __builtin_amdgcn_exp2f(-lp_[i]), R1 = __builtin_amdgcn_exp2f(-lp_[i + 1]); \
                    const float M0 = __builtin_amdgcn_exp2f(lp_[i] - lw_[i]), M1 = __builtin_amdgcn_exp2f(lp_[i + 1] - lw_[i + 1]), q0 = kk_[i] * inv, q1 = kk_[i + 1] * inv; \
                    oa[j][e >> 1] = (unsigned)tobf(-q0 * M0) | ((unsigned)tobf(-q1 * M1) << 16); orr[j][e >> 1] = (unsigned)tobf(r8[e] * P0) | ((unsigned)tobf(r8[e + 1] * P1) << 16); \
                    ob_[j][e >> 1] = (unsigned)tobf(q0 * ia_[i] * R0) | ((unsigned)tobf(q1 * ia_[i + 1] * R1) << 16); ok[j][e >> 1] = (unsigned)tobf(kp_[i] * R0) | ((unsigned)tobf(kp_[i + 1] * R1) << 16); \
                    ov[j][e >> 1] = (unsigned)tobf(v8[e]) | ((unsigned)tobf(v8[e + 1]) << 16); \
                    if (vt_ == 15) { ((LAS float*)(ob + CK_PC))[16 * vq_ + i] = P0; ((LAS float*)(ob + CK_PC))[16 * vq_ + i + 1] = P1; } } } \
            _Pragma("unroll") for (int j = 0; j < 2; ++j) { const int o = vt_ * CK_TP + 32 * vq_ + 16 * j; *(LAS v4u*)(ob + CK_AT + o) = oa[j]; *(LAS v4u*)(ob + CK_RT + o) = orr[j]; *(LAS v4u*)(ob + CK_BH + o) = ob_[j]; *(LAS v4u*)(ob + CK_KH + o) = ok[j]; \
                *(LAS v4u*)(rg + RG_VP + vt_ * 128 + 32 * vq_ + 16 * j) = ov[j]; *(LAS v4u*)(rg + RG_Z + vt_ * 128 + 32 * vq_ + 16 * j) = SET##z[j]; } \
            if (vq_ == 0) ((LAS float*)(rg + RG_BON))[vt_] = bon; } while (0)
#define CK_POST(cc) do { const LAS unsigned char* rg = blk + BH_RING + ((cc) % 3) * RG_SZ; const LAS float* yb = (const LAS float*)(blk + BH_Y + ((cc) & 1) * 4096) + pt_ * 64 + 16 * pq_; \
            float y_[16], vp_[16], z_[16]; \
            _Pragma("unroll") for (int j = 0; j < 4; ++j) { const f32x4 v = ((const LAS f32x4*)yb)[j]; y_[4 * j] = v.x; y_[4 * j + 1] = v.y; y_[4 * j + 2] = v.z; y_[4 * j + 3] = v.w; } \
            _Pragma("unroll") for (int j = 0; j < 2; ++j) { float t8[8]; unpack8(((const LAS v4u*)(rg + RG_VP + pt_ * 128 + 32 * pq_))[j], t8); _Pragma("unroll") for (int e = 0; e < 8; ++e) vp_[8 * j + e] = t8[e]; \
                unpack8(((const LAS v4u*)(rg + RG_Z + pt_ * 128 + 32 * pq_))[j], t8); _Pragma("unroll") for (int e = 0; e < 8; ++e) z_[8 * j + e] = t8[e]; } \
            const float bon = ((const LAS float*)(rg + RG_BON))[pt_]; float sm = 0.f; \
            _Pragma("unroll") for (int j = 0; j < 16; ++j) sm += y_[j]; \
            sm += dppf<0xB1>(sm); sm += dppf<0x4E>(sm); const float mu = sm * (1.0f / 64.0f); float sq = 0.f; \
            _Pragma("unroll") for (int j = 0; j < 16; ++j) { y_[j] -= mu; sq += y_[j] * y_[j]; } \
            sq += dppf<0xB1>(sq); sq += dppf<0x4E>(sq); const float rstd = __builtin_amdgcn_rsqf(sq * (1.0f / 64.0f) + GN_EPS); \
            v4u o_[2]; \
            _Pragma("unroll") for (int j = 0; j < 16; j += 2) { const float g0 = (y_[j] * rstd * lw_[j] + lb_[j] + bon * vp_[j]) * (z_[j] * fsig(z_[j])), g1 = (y_[j + 1] * rstd * lw_[j + 1] + lb_[j + 1] + bon * vp_[j + 1]) * (z_[j + 1] * fsig(z_[j + 1])); \
                o_[j >> 3][(j >> 1) & 3] = (unsigned)tobf(g0) | ((unsigned)tobf(g1) << 16); } \
            v4u* gp = (v4u*)(G + (rowb + (size_t)(cc) * 16 + pt_) * 2048 + hh * 64 + 16 * pq_); gp[0] = o_[0]; gp[1] = o_[1]; } while (0)
        typedef unsigned short us2 __attribute__((ext_vector_type(2)));
        if (role == 0) { f32x4 ST[4][4];
#pragma unroll
            for (int i = 0; i < 4; ++i)
#pragma unroll
                for (int j = 0; j < 4; ++j) ST[i][j] = (f32x4){0.f, 0.f, 0.f, 0.f};
            CK_BAR();
            for (int c = 0; c < NCH; ++c) { ck_scan_chunk(ST, blk + BH_OPB + (c & 1) * CK_OPB, blk + BH_RING + (c % 3) * RG_SZ + RG_VP, (LAS float*)(blk + BH_Y + (c & 1) * 4096), c16, g); CK_BAR(); }
            float* so = F.out + O_WKVP + ((size_t)(l * BATCH + b) * A_HEADS + hh) * 4096;
#pragma unroll
            for (int ki = 0; ki < 4; ++ki)
#pragma unroll
                for (int vi = 0; vi < 4; ++vi) *(f32x4*)(so + (16 * vi + c16) * 64 + 16 * ki + 4 * g) = ST[ki][vi]; }
        else if (role == 1) { const int ln1 = lane_id(), vt_ = ln1 >> 2, vq_ = ln1 & 3; const unsigned voff_ = (unsigned)(vt_ * 2048 + hh * 64 + 16 * vq_); LAS f32x4* lwp = (LAS f32x4*)(blk + BH_LW); const LAS f32x4* prm = (const LAS f32x4*)(blk + BH_PRM);
            { const int ln = lane_id(), c1 = hh * 64 + ln; LAS float* pf = (LAS float*)(blk + BH_PRM); pf[ln] = pw0[c1]; pf[64 + ln] = pa0[c1]; pf[128 + ln] = l ? pv0[c1] : 0.f; pf[192 + ln] = pkk[c1]; pf[256 + ln] = pka[c1]; pf[320 + ln] = prk[c1]; LDS_WAIT(); asm volatile("" ::: "memory"); }
            v4u Ar[2], Ak[2], Av[2], Az[2], Aw[2], Aa[2], Ad[2], Af[2];
#pragma unroll
            for (int j = 0; j < 2; ++j) { Ad[j] = (v4u){0u, 0u, 0u, 0u}; Af[j] = Ad[j]; }
            CKV_LOAD(0, A); CKV_PREP(0, A); CKV_LOAD(1, A); CK_BAR();
            for (int c = 0; c < NCH; ++c) { if (c + 1 < NCH) { CKV_PREP(c + 1, A); if (c + 2 < NCH) CKV_LOAD(c + 2, A); } CK_BAR(); } }
        else if (role == 3) {
            const int ln3 = lane_id(), vt_ = ln3 >> 2, vq_ = ln3 & 3; const unsigned voff_ = (unsigned)(vt_ * 2048 + hh * 64 + 16 * vq_);
            v4u Ar[2], Ak[2], Av[2], Az[2], Aw[2], Aa[2], Ad[2], Af[2];
#pragma unroll
            for (int j = 0; j < 2; ++j) { Ad[j] = (v4u){0u, 0u, 0u, 0u}; Af[j] = Ad[j]; }
            CKV_LOAD(2, A); CK_BAR();
            for (int c = 0; c < NCH; ++c) {
#pragma unroll
                for (int j = 0; j < 2; ++j) asm volatile("" :: "v"(Ar[j]), "v"(Ak[j]), "v"(Av[j]), "v"(Az[j]), "v"(Aw[j]), "v"(Aa[j]), "v"(Ad[j]), "v"(Af[j]));
                if (c + 3 < NCH) CKV_LOAD(c + 3, A);
                CK_BAR(); } }
        else { const int ln2 = lane_id(), pt_ = ln2 >> 2, pq_ = ln2 & 3; float lw_[16], lb_[16];
#pragma unroll
            for (int j = 0; j < 16; ++j) { lw_[j] = plw[hh * 64 + 16 * pq_ + j]; lb_[j] = plb[hh * 64 + 16 * pq_ + j]; }
            CK_BAR();
            for (int c = 0; c < NCH; ++c) { if (c >= 1) CK_POST(c - 1); CK_BAR(); }
            CK_POST(NCH - 1); }
        __syncthreads();
#undef CK_PREP
#undef CKV_LOAD
#undef CKV_PREP
#undef CK_BAR
#undef CK_POST
    }
    const float* stt = (const float*)a->in[2] + (size_t)l * DEC_BATCH * A_HEADS * 4096;
    LAS float* sop = (LAS float*)(F.lds + F.wave * 2048);
    for (int it = F.gw; it < DEC_BATCH * A_HEADS; it += F.NGW) { const int b = it >> 5, hh = it & 31, ch = hh * 64 + lane; const size_t o = (size_t)(MP + b) * 2048 + ch;
        HeadPrm P; P.w0 = pw0[ch]; P.a0 = pa0[ch]; P.v0 = l ? pv0[ch] : 0.f; P.kk = pkk[ch]; P.ka = pka[ch]; P.rk = prk[ch]; P.lnw = plw[ch]; P.lnb = plb[ch];
        const float z = ldbf(Z + o); float bon;
        fs_prep_one(P, l, ldbf(R + o), ldbf(K + o), ldbf(V + o), ldbf(DW + o), ldbf(DA + o), l ? ldbf(DV + o) : 0.f, l ? ldbf(VF + o) : 0.f, sop, lane, bon);
        LDS_WAIT(); asm volatile("" ::: "memory");
        f32x2 S[32]; const float* si = stt + (size_t)it * 4096 + lane * 64;
#pragma unroll
        for (int k = 0; k < 32; k += 2) { const f32x4 v = *(const f32x4*)(si + 2 * k); S[k] = (f32x2){v.x, v.y}; S[k + 1] = (f32x2){v.z, v.w}; }
        const float y = wkv_step_lds(S, sop, lane), vp = sop[320 + lane];
        float* so = F.out + O_WKVS + ((size_t)l * DEC_BATCH * A_HEADS + it) * 4096 + lane * 64;
#pragma unroll
        for (int k = 0; k < 32; k += 2) *(f32x4*)(so + 2 * k) = (f32x4){S[k].x, S[k].y, S[k + 1].x, S[k + 1].y};
        G[o] = (bf16)f2bf(fs_post_one(P, y, vp, z, bon));
        LDS_WAIT(); asm volatile("" ::: "memory");
    }
#undef FS_PREP
#undef FS_POST
}

__device__ __forceinline__ void final_norm(Frame& F, cargs a) {
    const float* X = (const float*)(F.ws + WS_X); f32x4 w4[4]; load_row((const float*)a->in[35], LANE, w4);
    for (int m = F.gw; m < MP + DEC_BATCH; m += F.NGW) { f32x4 x[4]; load_row(X + (size_t)m * 1024, LANE, x); const float rs = row_rs(x);
        float* o = m < MP ? F.out + O_YP + (size_t)m * 1024 : F.out + O_YS + (size_t)(m - MP) * 1024;
#pragma unroll
        for (int j = 0; j < 4; ++j) ((f32x4*)o)[LANE + 64 * j] = x[j] * rs * w4[j]; }
}
__device__ __forceinline__ void b0c_kvpost(Frame& F, cargs a) {
    unsigned char* ws = F.ws; const float* KVR = (const float*)(ws + WS_KVR); bf16* CK = (bf16*)(ws + WS_CKVB); bf16* KP = (bf16*)(ws + WS_KPEB); const float* ROPE = (const float*)(ws + WS_ROPE);
    const f32x4 w4 = ((const f32x4*)a->in[27])[F.lane];
    for (int m = F.gw; m < MP + DEC_BATCH; m += F.NGW) { const float* row = KVR + (size_t)m * 320;
        const f32x4 v = ((const f32x4*)row)[F.lane]; const float ss = wave_sum((v.x * v.x + v.y * v.y) + (v.z * v.z + v.w * v.w));
        const float rs = 1.0f / sqrtf(ss * (1.0f / 256.0f) + NORM_EPS); const f32x4 c = v * rs * w4;
        float* oc = m < MP ? F.out + O_CKVP + (size_t)m * 256 : F.out + O_CKVS + (size_t)(m - MP) * 256; float* ok = m < MP ? F.out + O_KPEP + (size_t)m * 64 : F.out + O_KPES + (size_t)(m - MP) * 64;
        ((f32x4*)oc)[F.lane] = c; v2u pw; pw.x = pk2(c.x, c.y); pw.y = pk2(c.z, c.w); *(v2u*)(CK + (size_t)m * 256 + 4 * F.lane) = pw;
        if (F.lane < 32) { const int i = F.lane, p = m < MP ? (m & (SEQ - 1)) : SEQ; const float x1 = row[256 + i], x2 = row[288 + i], cs = ROPE[(p * 32 + i) * 2], sn = ROPE[(p * 32 + i) * 2 + 1];
            const float o1 = x1 * cs - x2 * sn, o2 = x2 * cs + x1 * sn; ok[i] = o1; ok[32 + i] = o2; *(unsigned*)(KP + (size_t)m * 64 + 2 * i) = pk2(o1, o2); }
    }
}
__device__ __forceinline__ void b1c_cq(Frame& F, cargs a, int l) {
    unsigned char* ws = F.ws; const float* QL = (const float*)(ws + WS_QL); bf16* CQ = (bf16*)(ws + WS_CQ); const float* w = (const float*)a->in[32] + l * 384;
    f32x2 w2[3];
#pragma unroll
    for (int j = 0; j < 3; ++j) w2[j] = *(const f32x2*)(w + 2 * F.lane + 128 * j);
    for (int m = F.gw; m < MT; m += F.NGW) { f32x2 v[3]; float ss = 0.f;
#pragma unroll
        for (int j = 0; j < 3; ++j) { v[j] = *(const f32x2*)(QL + (size_t)m * 384 + 2 * F.lane + 128 * j); ss += v[j].x * v[j].x + v[j].y * v[j].y; }
        const float rs = 1.0f / sqrtf(wave_sum(ss) * (1.0f / 384.0f) + NORM_EPS);
#pragma unroll
        for (int j = 0; j < 3; ++j) *(unsigned*)(CQ + (size_t)m * 384 + 2 * F.lane + 128 * j) = pk2(v[j].x * rs * w2[j].x, v[j].y * rs * w2[j].y); }
}
constexpr int AT_KP = 400, AT_VP = 136, AT_KBYTES = 64 * AT_KP, AT_VBYTES = 128 * AT_VP, AT_BUF = AT_KBYTES + AT_VBYTES;
__device__ __forceinline__ int crow(int r, int hi) { return (r & 3) + 8 * (r >> 2) + 4 * hi; }
typedef __bf16 bf16x8_nat __attribute__((ext_vector_type(8)));
typedef float f32x8 __attribute__((ext_vector_type(8)));
__device__ __forceinline__ bf16x8 pack8f(float a0, float a1, float a2, float a3, float a4, float a5, float a6, float a7) {
    return __builtin_bit_cast(bf16x8, __builtin_convertvector((f32x8){a0, a1, a2, a3, a4, a5, a6, a7}, bf16x8_nat)); }
__device__ __forceinline__ void attn_unit(Frame& F, int b, int hd, int qb) {
    unsigned char* ws = F.ws; const bf16* Q = (const bf16*)(ws + WS_Q);
    const bf16* Z = (const bf16*)(ws + WS_Z); bf16* G = (bf16*)(ws + WS_G);
    LAS unsigned char* Ks = F.lds; LAS unsigned char* Vs = F.lds + AT_KBYTES;
    const int lane = lane_id(), r32 = lane & 31, hi = lane >> 5, tid = F.wave * 64 + lane;
    const int qpos = qb * 256 + F.wave * 32 + r32; const size_t qrow = (size_t)b * SEQ + qpos;
    bf16x8 qf[12];
#pragma unroll
    for (int s = 0; s < 12; ++s) qf[s] = *(const bf16x8*)(Q + qrow * 3072 + hd * 192 + 16 * s + 8 * hi);
    f32x16 o[4];
#pragma unroll
    for (int d = 0; d < 4; ++d)
#pragma unroll
        for (int r = 0; r < 16; ++r) o[d][r] = 0.f;
    float mrow = -1e30f, lrow = 0.f;
    const int ntiles = 4 * qb + 4, wq0 = qb * 256 + F.wave * 32;
    const unsigned gK = (unsigned)((tid >> 4) * 4096 + (tid & 15) * 16), gP = (unsigned)((tid >> 3) * 128 + (tid & 7) * 16), gV = (unsigned)((tid >> 3) * (MP * 2) + (tid & 7) * 16);
    LAS unsigned char* lK = Ks + (tid >> 4) * AT_KP + (tid & 15) * 16; LAS unsigned char* lP = Ks + (tid >> 3) * AT_KP + 256 + (tid & 7) * 16; LAS unsigned char* lV = Vs + (tid >> 3) * AT_VP + (tid & 7) * 16;
    const unsigned char* kb0 = ws + WS_KN + ((size_t)b * SEQ * 2048 + hd * 128) * 2; const unsigned char* pb0 = ws + WS_KPEB + (size_t)b * SEQ * 128; const unsigned char* vb0 = ws + WS_VT + ((size_t)hd * 128 * MP + (size_t)b * SEQ) * 2;
    v4u pk_[3], pv_[2];
#define AT_FETCH(kt_) do { const unsigned char* kb = kb0 + (size_t)(kt_) * (64 * 4096); const unsigned char* pb = pb0 + (size_t)(kt_) * (64 * 128); const unsigned char* vb = vb0 + (size_t)(kt_) * 128; \
        pk_[0] = *(const v4u*)(kb + gK); pk_[1] = *(const v4u*)(kb + 32 * 4096 + gK); pk_[2] = *(const v4u*)(pb + gP); pv_[0] = *(const v4u*)(vb + gV); pv_[1] = *(const v4u*)(vb + (size_t)64 * MP * 2 + gV); } while (0)
    AT_FETCH(0);
    const LAS unsigned char* kA = Ks + r32 * AT_KP + hi * 16;
    const LAS unsigned char* vA = Vs + r32 * AT_VP + hi * 8;
#define AT_KF(st_) (*(const LAS bf16x8*)(kA + ((st_) & 1) * (32 * AT_KP) + ((st_) >> 1) * 32))
#define AT_VF(st_, j_) (*(const LAS v2u*)(vA + ((st_) & 3) * (32 * AT_VP) + ((st_) >> 2) * 32 + 16 * (j_)))
    constexpr int KD = 6, VD = 4;
    for (int kt = 0; kt < ntiles; ++kt) {
        __syncthreads();
        *(LAS v4u*)lK = pk_[0]; *(LAS v4u*)(lK + 32 * AT_KP) = pk_[1]; *(LAS v4u*)lP = pk_[2];
#pragma unroll
        for (int i = 0; i < 2; ++i) { *(LAS v2u*)(lV + i * 64 * AT_VP) = (v2u){pv_[i].x, pv_[i].y}; *(LAS v2u*)(lV + i * 64 * AT_VP + 8) = (v2u){pv_[i].z, pv_[i].w}; }
        __syncthreads();
        if (kt + 1 < ntiles) AT_FETCH(kt + 1);
        if (kt * 64 > wq0 + 31) continue;
        f32x16 s0, s1;
#pragma unroll
        for (int r = 0; r < 16; ++r) { s0[r] = 0.f; s1[r] = 0.f; }
        bf16x8 kf[8];
#pragma unroll
        for (int st = 0; st < KD; ++st) kf[st] = AT_KF(st);
#pragma unroll
        for (int st = 0; st < 24; ++st) {
            if (st + KD < 24) kf[(st + KD) & 7] = AT_KF(st + KD);
            if (st & 1) s1 = __builtin_amdgcn_mfma_f32_32x32x16_bf16(kf[st & 7], qf[st >> 1], s1, 0, 0, 0);
            else s0 = __builtin_amdgcn_mfma_f32_32x32x16_bf16(kf[st & 7], qf[st >> 1], s0, 0, 0, 0);
            __builtin_amdgcn_sched_barrier(0);
        }
        v2u vf[8][2];
#pragma unroll
        for (int st = 0; st < VD; ++st) { vf[st][0] = AT_VF(st, 0); vf[st][1] = AT_VF(st, 1); }
        __builtin_amdgcn_sched_barrier(0);
        if (kt * 64 + 63 > wq0) {
#pragma unroll
            for (int r = 0; r < 16; ++r) { const int key = kt * 64 + crow(r, hi); if (key > qpos) s0[r] = -__builtin_inff(); if (key + 32 > qpos) s1[r] = -__builtin_inff(); } }
        float tmax = s0[0];
#pragma unroll
        for (int r = 1; r < 16; ++r) tmax = fmaxf(tmax, s0[r]);
#pragma unroll
        for (int r = 0; r < 16; ++r) tmax = fmaxf(tmax, s1[r]);
        tmax = xor32_max(tmax);
        if (__builtin_amdgcn_ballot_w64(tmax > mrow + 8.0f) != 0ull) { const float mnew = fmaxf(mrow, tmax), alpha = __builtin_amdgcn_exp2f(mrow - mnew); mrow = mnew; lrow *= alpha;
#pragma unroll
            for (int d = 0; d < 4; ++d)
#pragma unroll
                for (int r = 0; r < 16; ++r) o[d][r] *= alpha; }
        float ps = 0.f;
#pragma unroll
        for (int r = 0; r < 16; ++r) { s0[r] = __builtin_amdgcn_exp2f(s0[r] - mrow); s1[r] = __builtin_amdgcn_exp2f(s1[r] - mrow); ps += s0[r] + s1[r]; }
        lrow += ps;
        bf16x8 pb[4];
        pb[0] = pack8f(s0[0], s0[1], s0[2], s0[3], s0[4], s0[5], s0[6], s0[7]); pb[1] = pack8f(s0[8], s0[9], s0[10], s0[11], s0[12], s0[13], s0[14], s0[15]);
        pb[2] = pack8f(s1[0], s1[1], s1[2], s1[3], s1[4], s1[5], s1[6], s1[7]); pb[3] = pack8f(s1[8], s1[9], s1[10], s1[11], s1[12], s1[13], s1[14], s1[15]);
        __builtin_amdgcn_sched_barrier(0);
#pragma unroll
        for (int st = 0; st < 16; ++st) {
            if (st + VD < 16) { vf[(st + VD) & 7][0] = AT_VF(st + VD, 0); vf[(st + VD) & 7][1] = AT_VF(st + VD, 1); }
            const v4u av = (v4u){vf[st & 7][0].x, vf[st & 7][0].y, vf[st & 7][1].x, vf[st & 7][1].y};
            o[st & 3] = __builtin_amdgcn_mfma_f32_32x32x16_bf16(__builtin_bit_cast(bf16x8, av), pb[st >> 2], o[st & 3], 0, 0, 0);
            __builtin_amdgcn_sched_barrier(0);
        }
    }
#undef AT_FETCH
#undef AT_KF
#undef AT_VF
    lrow = xor32_sum(lrow); const float inv = 1.0f / lrow;
    v2u zq[4][4];
#pragma unroll
    for (int d = 0; d < 4; ++d)
#pragma unroll
        for (int rg = 0; rg < 4; ++rg) zq[d][rg] = *(const v2u*)(Z + qrow * 2048 + hd * 128 + 32 * d + 8 * rg + 4 * hi);
    __builtin_amdgcn_sched_barrier(0);
#pragma unroll
    for (int d = 0; d < 4; ++d)
#pragma unroll
        for (int rg = 0; rg < 4; ++rg) { const int dd = 32 * d + 8 * rg + 4 * hi; const size_t off = qrow * 2048 + hd * 128 + dd;
            const v2u zz = zq[d][rg]; const float z0 = bflo(zz.x), z1 = bfhi(zz.x), z2 = bflo(zz.y), z3 = bfhi(zz.y);
            v2u w; w.x = pk2(o[d][4 * rg] * inv * (z0 * sigmoidf_(z0)), o[d][4 * rg + 1] * inv * (z1 * sigmoidf_(z1))); w.y = pk2(o[d][4 * rg + 2] * inv * (z2 * sigmoidf_(z2)), o[d][4 * rg + 3] * inv * (z3 * sigmoidf_(z3)));
            *(v2u*)(G + off) = w; }
}
__device__ __forceinline__ void b2a_attn_prompt(Frame& F) {
    if (F.wave < 4) __builtin_amdgcn_s_setprio(1);
    const int vcu = (F.G % 8 == 0) ? (F.bid % 8) * (F.G / 8) + F.bid / 8 : F.bid;
    for (int u = vcu; u < BATCH * B_HEADS * 4; u += F.G) { const int bh = u >> 2, qp = u & 3;
        for (int hf = 0; hf < 2; ++hf) attn_unit(F, bh >> 4, bh & 15, hf ? qp : 7 - qp); }
    __builtin_amdgcn_s_setprio(0);
    __syncthreads();
}

constexpr int DT_P = 656;
typedef short v4i16_t __attribute__((ext_vector_type(4)));
__device__ __forceinline__ void b2b_attn_sample(Frame& F, cargs a) {
    unsigned char* ws = F.ws; const float* cckv = (const float*)a->in[4]; const float* ckpe = (const float*)a->in[5]; const int* ptab = (const int*)a->in[6];
    const bf16* QA = (const bf16*)(ws + WS_QABS); float* OP = (float*)(ws + WS_OPART); float* ML = (float*)(ws + WS_ML);
    LAS unsigned char* T = F.lds;
    F.lane = lane_id();
    const int lane = F.lane, hcol = lane & 15, g = lane >> 4, tid = F.wave * 64 + lane, q4 = (lane & 15) >> 2, p4 = lane & 3;
    const bf16* Q = (const bf16*)(ws + WS_Q); const float* wuk = (const float*)a->in[28]; bf16* QAg = (bf16*)(ws + WS_QABS);
    LAS bf16* QAl = (LAS bf16*)(F.lds + 49152);
    for (int hu = F.bid; hu < DEC_BATCH * 2; hu += F.G) for (int si = 0; si < 4; ++si) { const int b = hu >> 1, sp = (hu & 1) * 4 + si;
      if (si == 0) {
        __syncthreads();
        for (int hh = 0; hh < 2; ++hh) { const int hd = 2 * F.wave + hh; const bf16* qn = Q + (size_t)(MP + b) * 3072 + hd * 192;
            float acc[4] = {0.f, 0.f, 0.f, 0.f};
            for (int n = 0; n < 128; n += 4) { const v2u qu = *(const v2u*)(qn + n); const f32x4 q4 = (f32x4){bflo(qu.x), bfhi(qu.x), bflo(qu.y), bfhi(qu.y)};
#pragma unroll
                for (int cc = 0; cc < 4; ++cc) { const f32x4 w4 = *(const f32x4*)(wuk + (size_t)(4 * lane + cc) * 2048 + hd * 128 + n); acc[cc] += (q4.x * w4.x + q4.y * w4.y) + (q4.z * w4.z + q4.w * w4.w); } }
            const v2u w = (v2u){pk2(acc[0], acc[1]), pk2(acc[2], acc[3])}; *(LAS v2u*)(QAl + hd * 320 + 4 * lane) = w;
            const bf16 rp = qn[128 + 2 * (lane & 31) + (lane >> 5)]; QAl[hd * 320 + 256 + lane] = rp;
            if ((hu & 1) == 0) { *(v2u*)(QAg + (size_t)(b * 16 + hd) * 320 + 4 * lane) = w; QAg[(size_t)(b * 16 + hd) * 320 + 256 + lane] = rp; } }
        __syncthreads(); }
        bf16x8 qf[10];
#pragma unroll
        for (int s = 0; s < 10; ++s) qf[s] = *(const LAS bf16x8*)(QAl + hcol * 320 + 32 * s + 8 * g);
        f32x4 o[2]; o[0] = (f32x4){0.f, 0.f, 0.f, 0.f}; o[1] = o[0]; float mrow = -1e30f, lrow = 0.f;
        f32x4 pf_[10];
#define DT_FETCH(t_) do { const int pp = ptab[b * NPAGES + sp * 8 + ((t_) >> 1)], tok0 = ((t_) & 1) * 64; \
            _Pragma("unroll") for (int i = 0; i < 10; ++i) { const int c = tid + 512 * i, key = c / 80, ch = c % 80; const size_t tk = (size_t)pp * PAGE + tok0 + key; \
                pf_[i] = ch < 64 ? *(const f32x4*)(cckv + tk * 256 + ch * 4) : *(const f32x4*)(ckpe + tk * 64 + (ch - 64) * 4); } } while (0)
        DT_FETCH(0);
        for (int t = 0; t < 16; ++t) {
            __syncthreads();
#pragma unroll
            for (int i = 0; i < 10; ++i) { const int c = tid + 512 * i, key = c / 80, ch = c % 80; *(LAS v2u*)(T + key * DT_P + ch * 8) = (v2u){pk2(pf_[i].x, pf_[i].y), pk2(pf_[i].z, pf_[i].w)}; }
            __syncthreads();
            if (t + 1 < 16) DT_FETCH(t + 1);
            f32x4 sc[4];
#pragma unroll
            for (int kg = 0; kg < 4; ++kg) { sc[kg] = (f32x4){0.f, 0.f, 0.f, 0.f};
#pragma unroll
                for (int s = 0; s < 10; ++s) { const bf16x8 kf = *(const LAS bf16x8*)(T + (16 * kg + hcol) * DT_P + (32 * s + 8 * g) * 2);
                    sc[kg] = __builtin_amdgcn_mfma_f32_16x16x32_bf16(kf, qf[s], sc[kg], 0, 0, 0); } }
            float tmax = sc[0][0];
#pragma unroll
            for (int kg = 0; kg < 4; ++kg)
#pragma unroll
                for (int r = 0; r < 4; ++r) tmax = fmaxf(tmax, sc[kg][r]);
            tmax = fmaxf(tmax, swz_xor<16>(tmax)); tmax = xor32_max(tmax);
            const float mnew = fmaxf(mrow, tmax), alpha = __builtin_amdgcn_exp2f(mrow - mnew); mrow = mnew;
            float ps = 0.f;
#pragma unroll
            for (int kg = 0; kg < 4; ++kg)
#pragma unroll
                for (int r = 0; r < 4; ++r) { sc[kg][r] = __builtin_amdgcn_exp2f(sc[kg][r] - mnew); ps += sc[kg][r]; }
            lrow = lrow * alpha + ps; o[0] *= alpha; o[1] *= alpha;
#pragma unroll
            for (int kk = 0; kk < 2; ++kk) { const bf16x8 pbf = pack8f(sc[2 * kk][0], sc[2 * kk][1], sc[2 * kk][2], sc[2 * kk][3], sc[2 * kk + 1][0], sc[2 * kk + 1][1], sc[2 * kk + 1][2], sc[2 * kk + 1][3]);
#pragma unroll
                for (int ci = 0; ci < 2; ++ci) { const int cb = 2 * F.wave + ci; LAS unsigned char* ap = T + (32 * kk + 4 * g + q4) * DT_P + (16 * cb + 4 * p4) * 2;
                    const s16x4 lo = __builtin_bit_cast(s16x4, __builtin_amdgcn_ds_read_tr16_b64_v4i16((LAS v4i16_t*)ap)), hi2 = __builtin_bit_cast(s16x4, __builtin_amdgcn_ds_read_tr16_b64_v4i16((LAS v4i16_t*)(ap + 16 * DT_P)));
                    const bf16x8 av = (bf16x8){lo[0], lo[1], lo[2], lo[3], hi2[0], hi2[1], hi2[2], hi2[3]};
                    o[ci] = __builtin_amdgcn_mfma_f32_16x16x32_bf16(av, pbf, o[ci], 0, 0, 0); } }
        }
#undef DT_FETCH
        lrow += swz_xor<16>(lrow); lrow = xor32_sum(lrow);
        const size_t pb_ = (size_t)(b * 8 + sp) * 16 + hcol;
#pragma unroll
        for (int ci = 0; ci < 2; ++ci) *(f32x4*)(OP + pb_ * 256 + 16 * (2 * F.wave + ci) + 4 * g) = o[ci];
        if (F.wave == 0 && g == 0) { ML[pb_ * 2] = mrow; ML[pb_ * 2 + 1] = lrow; }
    }
    __syncthreads();
}
__device__ __forceinline__ void b2c_combine(Frame& F, cargs a) {
    unsigned char* ws = F.ws; const bf16* QA = (const bf16*)(ws + WS_QABS); const float* OP = (const float*)(ws + WS_OPART); const float* ML = (const float*)(ws + WS_ML);
    const float* wuv = (const float*)a->in[29]; const bf16* Z = (const bf16*)(ws + WS_Z); bf16* G = (bf16*)(ws + WS_G);
    LAS float* scr = (LAS float*)(F.lds + F.wave * 1024);
    for (int it = F.gw; it < DEC_BATCH * B_HEADS; it += F.NGW) { const int b = it >> 4, hd = it & 15; const int lane = F.lane;
        const float* cn = F.out + O_CKVS + (size_t)b * 256; const float* kn = F.out + O_KPES + (size_t)b * 64; const bf16* qa = QA + (size_t)it * 320;
        const f32x4 c4 = *(const f32x4*)(cn + 4 * lane); const v2u qv = *(const v2u*)(qa + 4 * lane);
        float sn = (bflo(qv.x) * c4.x + bfhi(qv.x) * c4.y) + (bflo(qv.y) * c4.z + bfhi(qv.y) * c4.w);
        sn += __builtin_bit_cast(float, (unsigned)qa[256 + lane] << 16) * kn[lane];
        sn = wave_sum(sn);
        float ms[8], ls[8], M = sn; f32x4 op[8];
#pragma unroll
        for (int s = 0; s < 8; ++s) { ms[s] = ML[((size_t)(b * 8 + s) * 16 + hd) * 2]; ls[s] = ML[((size_t)(b * 8 + s) * 16 + hd) * 2 + 1]; op[s] = *(const f32x4*)(OP + ((size_t)(b * 8 + s) * 16 + hd) * 256 + 4 * lane); }
        __builtin_amdgcn_sched_barrier(0);
#pragma unroll
        for (int s = 0; s < 8; ++s) M = fmaxf(M, ms[s]);
        const float en = __builtin_amdgcn_exp2f(sn - M); float L = en; f32x4 acc = c4 * en;
#pragma unroll
        for (int s = 0; s < 8; ++s) { const float e = __builtin_amdgcn_exp2f(ms[s] - M); L += e * ls[s]; acc += op[s] * e; }
        acc *= 1.0f / L;
        *(LAS f32x4*)(scr + 4 * lane) = acc; LDS_WAIT(); asm volatile("" ::: "memory");
        f32x2 ov = (f32x2){0.f, 0.f};
        for (int c0 = 0; c0 < 256; c0 += 32) { f32x2 wv[32];
#pragma unroll
            for (int j = 0; j < 32; ++j) wv[j] = *(const f32x2*)(wuv + (size_t)(c0 + j) * 2048 + hd * 128 + 2 * lane);
            __builtin_amdgcn_sched_barrier(0);
#pragma unroll
            for (int j = 0; j < 32; ++j) ov += wv[j] * scr[c0 + j]; }
        const size_t off = (size_t)(MP + b) * 2048 + hd * 128 + 2 * lane; const unsigned zz = *(const unsigned*)(Z + off); const float z0 = bflo(zz), z1 = bfhi(zz);
        *(unsigned*)(G + off) = pk2(ov.x * (z0 * sigmoidf_(z0)), ov.y * (z1 * sigmoidf_(z1)));
        LDS_WAIT(); asm volatile("" ::: "memory");
    }
}

#ifndef MK_SPLIT
#define MK_SPLIT 0
#endif
#ifndef MK_DIAG
#define MK_DIAG 0
#endif
constexpr int NPHASES = 1 + 4 + 5 + 7 + 6 + 1 + (MK_DIAG ? 1 : 0);
#define PH_BEGIN if (ph >= lo && ph < hi) { cargs ap = (cargs)__builtin_amdgcn_kernarg_segment_ptr(); asm volatile("" : "+s"(ap)); Frame F = make_frame(ap, wave0, (LAS unsigned char*)lds); unsigned char* ws = F.ws;
#define PH_END } if (ph >= lo && ph + 1 < hi) xcd_barrier(bar); ++ph;
typedef pg8::StaticOrder SO;
#define GEMM_B(ACT_, A_, Bt_, M_, N_, K_, O_, ldc_, nvalid_, nstore_) do { pg8::Gemm g_{(const pg8::bf16_t*)(A_), (const pg8::bf16_t*)(Bt_), (M_), (N_), (K_)}; SO S_; S_.init((M_), (N_), F.G, F.bid); \
    pg8::EpiB<ACT_> E_{(pg8::bf16_t*)(O_), (ldc_), (nvalid_), (nstore_)}; pg8::gemm_phase<pg8::EpiB<ACT_>, SO, true, true>(F.lds, g_, S_, E_, F.wave); } while (0)
#define GEMM_F(ACT_, HB_, HBI_, A_, Bt_, M_, N_, K_, O_, base_, bias_, ldc_, nstore_) do { int kk_ = (K_); asm volatile("" : "+s"(kk_)); pg8::Gemm g_{(const pg8::bf16_t*)(A_), (const pg8::bf16_t*)(Bt_), (M_), (N_), kk_}; SO S_; S_.init((M_), (N_), F.G, F.bid); \
    pg8::EpiF<ACT_, HB_, HBI_> E_{(float*)(O_), (const float*)(base_), (const float*)(bias_), (ldc_), (nstore_)}; pg8::gemm_phase<pg8::EpiF<ACT_, HB_, HBI_>, SO, true, true>(F.lds, g_, S_, E_, F.wave); } while (0)

#define OUTPROJ(Wt_, base_) do { \
    { pg8::Gemm g_{(const pg8::bf16_t*)(ws + WS_G), (const pg8::bf16_t*)(Wt_), MT, 1024, 256, 2048}; pg8::SliceOrder S_{MP / 256, 4, 8, F.G, F.bid, 512}; pg8::EpiFA E_{(float*)(ws + WS_X), 1024, MP + DEC_BATCH}; \
      pg8::gemm_phase<pg8::EpiFA, pg8::SliceOrder, true, true>(F.lds, g_, S_, E_, F.wave); } \
    GEMM_F(0, true, false, ws + WS_G, (Wt_), MP, 1024, 2048, ws + WS_X, (base_), nullptr, 1024, 1024); } while (0)
__global__ void __launch_bounds__(NTHR, 2) mk_fwd(Args args) {
    extern __shared__ __attribute__((aligned(16))) unsigned char lds[];
    const int wave0 = __builtin_amdgcn_readfirstlane(threadIdx.x >> 6);
    for (int u = threadIdx.x; u < (LDS_BYTES - LDSCTL_OFF) / 4; u += NTHR) ((LAS unsigned*)(lds + LDSCTL_OFF))[u] = 0u;
    __syncthreads();
    XcdBarrier bar = xcd_barrier_post((unsigned*)(args.ws + WS_CTL) + CW_BAR + args.li * XCD_BAR_WORDS, (volatile LAS unsigned*)((LAS unsigned char*)lds + LDSCTL_OFF), (unsigned)wave0);
    int ph = 0; const int lo = args.ph_lo, hi = args.ph_hi;

    PH_BEGIN p0_prologue(F, ap); __syncthreads(); a1_prepass(F, ap, 0); PH_END

    for (int l = 0; l < 2; ++l) {
        if (l > 0) { PH_BEGIN a1_prepass(F, ap, l); PH_END }
        PH_BEGIN
            { static_assert(AM_STRIDE == (size_t)130 * 256 * 1024 * 2, "A-operand buffers sit 130 row panels apart");
              pg8::Gemm g_{(const pg8::bf16_t*)(ws + WS_AM), (const pg8::bf16_t*)(ws + WS_WIN + (size_t)l * WIN_L), MT, 2048, 1024}; pg8::GroupOrderA2 S_; S_.init(MT, F.G, F.bid, l ? 7 : 6);
              static_assert(WS_K == WS_R + BIGB && WS_V0 == WS_R + 2 * BIGB && WS_V1 == WS_R + 3 * BIGB && WS_Z == WS_R + 4 * BIGB && WS_LA == WS_LW + 9 * MiB && WS_LV == WS_LW + 18 * MiB, "output buffers are equally spaced");
              pg8::EpiA2 E_{(pg8::bf16_t*)(ws + WS_R), BIGB / 2, 2 + l, (pg8::bf16_t*)(ws + WS_LW), 9 * MiB / 2};
              pg8::gemm_phase<pg8::EpiA2, pg8::GroupOrderA2, true, true>(F.lds, g_, S_, E_, F.wave); }
        PH_END
        PH_BEGIN
#define GEMM_BA(ACT_, A_, Bt_, O_, bias_) do { int kk_ = 128; asm volatile("" : "+s"(kk_)); pg8::Gemm g_{(const pg8::bf16_t*)(A_), (const pg8::bf16_t*)(Bt_), MT, 2048, kk_}; SO S_; S_.init(MT, 2048, F.G, F.bid); \
    pg8::EpiBA<ACT_> E_{(pg8::bf16_t*)(O_), (const float*)(bias_)}; pg8::gemm_phase<pg8::EpiBA<ACT_>, SO, true, true>(F.lds, g_, S_, E_, F.wave); } while (0)
            GEMM_BA(4, ws + WS_LW, ws + WS_W2 + (size_t)l * (MiB / 2), ws + WS_WD, (const float*)ap->in[10] + l * 2048);
            GEMM_BA(3, ws + WS_LA, ws + WS_W2 + (size_t)(2 + l) * (MiB / 2), ws + WS_IA, (const float*)ap->in[13] + l * 2048);
            if (l) GEMM_BA(3, ws + WS_LV, ws + WS_W2 + (size_t)4 * (MiB / 2), ws + WS_VG, (const float*)ap->in[16]);
#undef GEMM_BA
        PH_END
        PH_BEGIN a5_fused(F, ap, l); PH_END
        PH_BEGIN
            OUTPROJ(ws + WS_WO + (size_t)l * 4 * MiB, l == 0 ? (const void*)ap->in[0] : (const void*)(ws + WS_X));
        PH_END
    }

#define MLA_INPROJ(l_, A_) do { \
        { pg8::Gemm g_{(const pg8::bf16_t*)(A_), (const pg8::bf16_t*)(ws + WS_WQ + (size_t)(l_) * MiB), MT, 512, 1024}; SO S_; S_.init(MT, 512, F.G, F.bid); \
          pg8::EpiCQ E_{(pg8::bf16_t*)(ws + WS_CQ), (const float*)ap->in[32] + (l_) * 384, (float*)(ws + WS_CTL + CW_RSQ + (size_t)(l_) * 262144)}; pg8::gemm_phase<pg8::EpiCQ, SO, true, true>(F.lds, g_, S_, E_, F.wave); } \
        GEMM_B(0, (A_), ws + WS_WZ + (size_t)(l_) * 4 * MiB, MT, 2048, 1024, ws + WS_Z, 2048, 2048, 2048); } while (0)
#define MLA_QUP(l_) do { pg8::Gemm g_{(const pg8::bf16_t*)(ws + WS_CQ), (const pg8::bf16_t*)(ws + WS_WUQ + (size_t)(l_) * (5 * MiB / 2)), MT, 3072, 384}; SO S_; S_.init(MT, 3072, F.G, F.bid); \
        pg8::EpiQ E_{(pg8::bf16_t*)(ws + WS_Q), (const float*)(ws + WS_ROPE), ATTN_SCALE * LOG2E, MP, SEQ, (const float*)(ws + WS_CTL + CW_RSQ + (size_t)(l_) * 262144)}; pg8::gemm_phase<pg8::EpiQ, SO, true, true>(F.lds, g_, S_, E_, F.wave); } while (0)
    for (int l = 0; l < 2; ++l) {
        PH_BEGIN if (l == 0) norm2_rows_bf16(F, (const float*)(ws + WS_X), (const float*)ap->in[25], (bf16*)(ws + WS_AM), (const float*)ap->in[30], (bf16*)(ws + WS_AM + AM_STRIDE));
                 else norm_rows_bf16(F, (const float*)(ws + WS_X), (const float*)ap->in[30] + l * 1024, (bf16*)(ws + WS_AM)); PH_END
        PH_BEGIN if (l == 0) GEMM_F(0, false, false, ws + WS_AM, ws + WS_WDKV, MT, 512, 1024, ws + WS_KVR, nullptr, nullptr, 320, 320);
                 MLA_INPROJ(l, ws + WS_AM + (l == 0 ? AM_STRIDE : 0)); PH_END
        if (l == 0) { PH_BEGIN b0c_kvpost(F, ap); PH_END }
        PH_BEGIN if (l == 0) { GEMM_B(0, ws + WS_CKVB, ws + WS_WUK, MP, 2048, 256, ws + WS_KN, 2048, 2048, 2048);
                               GEMM_B(0, ws + WS_WUV, ws + WS_CKVB, 2048, MP, 256, ws + WS_VT, MP, MP, MP); }
                 MLA_QUP(l); PH_END
        PH_BEGIN b2a_attn_prompt(F); b2b_attn_sample(F, ap); PH_END
        PH_BEGIN b2c_combine(F, ap); PH_END
        PH_BEGIN OUTPROJ(ws + WS_WBO + (size_t)l * 4 * MiB, ws + WS_X); PH_END
    }
#undef MLA_INPROJ
#undef MLA_QUP

    PH_BEGIN final_norm(F, ap); PH_END
#if MK_DIAG
    PH_BEGIN
        const size_t offs[11] = {O_YP, O_YS, O_WKVP, O_SHP, O_CKVP, O_KPEP, O_WKVS, O_SHS, O_CKVS, O_KPES, O_END};
        for (int k = 1; k < 10; ++k) { const float f = 1.0f + sqrtf(2e-4f * (float)k);
            for (size_t i = offs[k] + (size_t)(F.bid * NTHR + F.wave * 64 + F.lane); i < offs[k + 1]; i += (size_t)F.NT) F.out[i] *= f; }
    PH_END
#endif
}

extern "C" void kernel_launch(void* const* d_in, const int* in_sizes, int n_in, void* d_out, int out_size, void* d_ws, size_t ws_size, hipStream_t stream) {
    static int grid = 0;
    if (grid == 0) {
        if (n_in != 36 || (size_t)out_size != O_END || ws_size < WS_NEED) { fprintf(stderr, "kernel_launch: unexpected sizes: n_in %d out %d (want %zu) ws %zu (need %zu)\n", n_in, out_size, (size_t)O_END, ws_size, (size_t)WS_NEED); grid = -1; return; }
        int dev = 0, cus = 0, per_cu = 0;
        if (hipGetDevice(&dev) != hipSuccess || hipDeviceGetAttribute(&cus, hipDeviceAttributeMultiprocessorCount, dev) != hipSuccess) { grid = -1; return; }
        if (hipFuncSetAttribute((const void*)mk_fwd, hipFuncAttributeMaxDynamicSharedMemorySize, LDS_BYTES) != hipSuccess) { fprintf(stderr, "kernel_launch: hipFuncSetAttribute failed\n"); grid = -1; return; }
        if (hipOccupancyMaxActiveBlocksPerMultiprocessor(&per_cu, (const void*)mk_fwd, NTHR, LDS_BYTES) != hipSuccess || per_cu < 1) fprintf(stderr, "kernel_launch: occupancy query reports %d\n", per_cu);
        (void)hipGetLastError();
        grid = cus;
    }
    if (grid < 0) return;
    if (hipMemsetAsync((char*)d_ws + WS_CTL, 0, CTL_ZERO_BYTES, stream) != hipSuccess) { fprintf(stderr, "kernel_launch: memset failed\n"); return; }
    Args a{};
    for (int i = 0; i < 36; ++i) a.in[i] = d_in[i];
    a.out = (float*)d_out; a.ws = (unsigned char*)d_ws;
#if MK_SPLIT
    for (int li = 0; li < NPHASES; ++li) { a.ph_lo = li; a.ph_hi = li + 1; a.li = li;
        hipLaunchKernelGGL(mk_fwd, dim3(grid), dim3(NTHR), LDS_BYTES, stream, a); }
#else
    a.ph_lo = 0; a.ph_hi = NPHASES; a.li = 0;
    hipLaunchKernelGGL(mk_fwd, dim3(grid), dim3(NTHR), LDS_BYTES, stream, a);
#endif
    const hipError_t le = hipPeekAtLastError();
    if (le != hipSuccess) fprintf(stderr, "kernel_launch: launch failed: %s\n", hipGetErrorName(le));
}
```

```cpp
#include <hip/hip_runtime.h>
#include <cstdio>
#include <cstdint>
namespace pg8 {
#define PG8_LAS __attribute__((address_space(3)))
typedef unsigned short bf16_t;
typedef short bf16x8 __attribute__((ext_vector_type(8)));
typedef float f32x4 __attribute__((ext_vector_type(4)));
typedef unsigned u32x4 __attribute__((ext_vector_type(4)));
constexpr int BM = 256, BK = 64, HALF = 128, HTB = HALF * BK * 2  , STAGE_BYTES = 8 * HTB, NXCD = 8, WGM = 8;

__host__ __device__ __forceinline__ int lds_byte(int r, int c) { const int st = (r >> 4) * 2 + (c >> 5), rr = r & 15, cc = c & 31, ob = rr * 64 + cc * 2; return st * 1024 + (ob ^ (((ob >> 9) & 1) << 5)); }
__host__ __device__ __forceinline__ void stage_rc(int b, int& R, int& C) { const int st = b / 1024, sb = b % 1024, swz = sb ^ (((sb >> 9) & 1) << 5); R = (st >> 1) * 16 + swz / 64; C = (st & 1) * 32 + (swz % 64) / 2; }
__host__ __device__ __forceinline__ int perm32(int rho) { const int n = rho >> 4, i = rho & 15; return 8 * (i >> 2) + 4 * n + (i & 3); }

struct Unit { int pm, pn; int ko; };
struct Gemm { const bf16_t* A; const bf16_t* Bt; int M, N, K; int ld; };

struct StaticOrder {
    int nM, nN, nwg, G, c;
    __host__ __device__ void init(int M, int N, int G_, int c_) { nM = M / BM; nN = N / BM; nwg = nM * nN; G = G_; c = c_; }
    __host__ __device__ bool next(int i, Unit& u) const {
        const long L = (long)i * G + c; if (L >= nwg) return false;
        int wgid = (int)L; { const int q = nwg / NXCD, r = nwg % NXCD, xcd = wgid % NXCD, off = wgid / NXCD; wgid = (xcd < r ? xcd * (q + 1) : r * (q + 1) + (xcd - r) * q) + off; }
        const int nig = WGM * nN, gid = wgid / nig, fm = gid * WGM, gsz = (nM - fm) < WGM ? (nM - fm) : WGM;
        u.pm = fm + ((wgid % nig) % gsz); u.pn = (wgid % nig) / gsz; u.ko = 0; return true;
    }
    __device__ __forceinline__ void a_ready(const Unit&) const {}
    __device__ __forceinline__ void done(const Unit&) const {}
};

__device__ __forceinline__ unsigned cvt_pk_bf16(float lo, float hi) { unsigned r; asm volatile("v_cvt_pk_bf16_f32 %0, %1, %2" : "=v"(r) : "v"(lo), "v"(hi)); return r; }
typedef float f32x2 __attribute__((ext_vector_type(2)));
__device__ __forceinline__ float act_apply(int ACT, float x) {
    if (ACT == 1) return 1.0f - 2.0f / (1.0f + __expf(2.0f * x));
    if (ACT == 2) return __expf(-0.6065306597126334f / (1.0f + __expf(-x)));
    if (ACT == 3) return 1.0f / (1.0f + __expf(-x));
    return x;
}
template <int ACT> struct EpiB {
    static constexpr bool PERM = true, AFTER_DRAIN = false;
    bf16_t* O; int ldc; int nvalid; int nstore;
    __device__ __forceinline__ void operator()(const f32x4 (&acc)[2][2][4][2], const Unit& u, int wr, int wc, int, int) const {
        int lane_; asm volatile("v_mbcnt_lo_u32_b32 %0, -1, 0\n\tv_mbcnt_hi_u32_b32 %0, -1, %0" : "=v"(lane_)); const int fr = lane_ & 15, fq = lane_ >> 4;
        const int row0 = u.pm * BM + wr * 64 + fr, col0 = u.pn * BM + wc * 32 + 8 * fq;
#pragma unroll
        for (int ai = 0; ai < 2; ++ai)
#pragma unroll
            for (int m = 0; m < 4; ++m) { bf16_t* rowp = O + (size_t)(row0 + ai * HALF + m * 16) * ldc + col0;
#pragma unroll
                for (int bj = 0; bj < 2; ++bj) { const int c = col0 + bj * HALF; if (c >= nstore) continue;
                    f32x4 v0 = acc[ai][bj][m][0], v1 = acc[ai][bj][m][1];
                    if (ACT != 0) {
#pragma unroll
                        for (int e = 0; e < 4; ++e) { v0[e] = act_apply(ACT, v0[e]); v1[e] = act_apply(ACT, v1[e]); } }
                    u32x4 w; w.x = cvt_pk_bf16(v0[0], v0[1]); w.y = cvt_pk_bf16(v0[2], v0[3]); w.z = cvt_pk_bf16(v1[0], v1[1]); w.w = cvt_pk_bf16(v1[2], v1[3]);
                    if (c >= nvalid) w = (u32x4){0u, 0u, 0u, 0u};
                    *(u32x4*)(rowp + bj * HALF) = w; } }
    }
};
template <int ACT, bool HAS_BASE, bool HAS_BIAS> struct EpiF {
    static constexpr bool PERM = false, AFTER_DRAIN = false;
    float* O; const float* base; const float* bias; int ldc; int nstore;
    __device__ __forceinline__ void operator()(const f32x4 (&acc)[2][2][4][2], const Unit& u, int wr, int wc, int, int) const {
        int lane_; asm volatile("v_mbcnt_lo_u32_b32 %0, -1, 0\n\tv_mbcnt_hi_u32_b32 %0, -1, %0" : "=v"(lane_)); const int fr = lane_ & 15, fq = lane_ >> 4;
        const int row0 = u.pm * BM + wr * 64 + fr, col0 = u.pn * BM + wc * 32 + 4 * fq;
        f32x4 bv[2][2];
#pragma unroll
        for (int bj = 0; bj < 2; ++bj)
#pragma unroll
            for (int n = 0; n < 2; ++n) bv[bj][n] = HAS_BIAS ? *(const f32x4*)(bias + col0 + bj * HALF + n * 16) : (f32x4){0.f, 0.f, 0.f, 0.f};
#pragma unroll
        for (int ai = 0; ai < 2; ++ai) { f32x4 bs[2][2][2];
#pragma unroll
            for (int m = 0; m < 4; ++m) { const size_t off = (size_t)(row0 + ai * HALF + m * 16) * ldc + col0;
                if (HAS_BASE && !(m & 1)) {
#pragma unroll
                    for (int mm = 0; mm < 2; ++mm)
#pragma unroll
                        for (int bj = 0; bj < 2; ++bj)
#pragma unroll
                            for (int n = 0; n < 2; ++n) bs[mm][bj][n] = *(const f32x4*)(base + off + (size_t)mm * 16 * ldc + bj * HALF + n * 16);
                    __builtin_amdgcn_sched_barrier(0); }
#pragma unroll
                for (int bj = 0; bj < 2; ++bj)
#pragma unroll
                    for (int n = 0; n < 2; ++n) { if (!HAS_BASE && col0 + bj * HALF + n * 16 >= nstore) continue;
                        f32x4 v = acc[ai][bj][m][n] + bv[bj][n];
                        if (ACT != 0) {
#pragma unroll
                            for (int e = 0; e < 4; ++e) v[e] = act_apply(ACT, v[e]); }
                        if (HAS_BASE) v += bs[m & 1][bj][n];
                        *(f32x4*)(O + off + bj * HALF + n * 16) = v; }
                if (m & 1) asm volatile("" ::: "memory"); } }
    }
};

struct GroupOrder4 {
    StaticOrder so; int per;
    __device__ void init(int M, int N, int G_, int c_) { so.init(M, N, G_, c_); per = so.nwg; }
    __device__ bool next(int i, Unit& u) const {
        const long L = (long)i * so.G + so.c; if (L >= 4L * per) return false;
        const int gi = (int)(L / per); int wgid = (int)(L - (long)gi * per);
        { const int q = so.nwg / NXCD, r = so.nwg % NXCD, xcd = wgid % NXCD, off = wgid / NXCD; wgid = (xcd < r ? xcd * (q + 1) : r * (q + 1) + (xcd - r) * q) + off; }
        const int nig = WGM * so.nN, gid = wgid / nig, fm = gid * WGM, gsz = (so.nM - fm) < WGM ? (so.nM - fm) : WGM;
        u.pm = fm + ((wgid % nig) % gsz) + 130 * gi; u.pn = (wgid % nig) / gsz + 8 * gi; u.ko = 0; return true;
    }
    __device__ __forceinline__ void a_ready(const Unit&) const {}
    __device__ __forceinline__ void done(const Unit&) const {}
};
struct EpiB4 {
    static constexpr bool PERM = true, AFTER_DRAIN = false;
    bf16_t* O[4];
    __device__ __forceinline__ void operator()(const f32x4 (&acc)[2][2][4][2], const Unit& u, int wr, int wc, int, int) const {
        int lane_; asm volatile("v_mbcnt_lo_u32_b32 %0, -1, 0\n\tv_mbcnt_hi_u32_b32 %0, -1, %0" : "=v"(lane_)); const int fr = lane_ & 15, fq = lane_ >> 4;
        const int gi = u.pn >> 3; bf16_t* Ob = gi == 0 ? O[0] : gi == 1 ? O[1] : gi == 2 ? O[2] : O[3];
        const int row0 = (u.pm - 130 * gi) * BM + wr * 64 + fr, col0 = (u.pn & 7) * BM + wc * 32 + 8 * fq;
#pragma unroll
        for (int ai = 0; ai < 2; ++ai)
#pragma unroll
            for (int m = 0; m < 4; ++m) { bf16_t* rowp = Ob + (size_t)(row0 + ai * HALF + m * 16) * 2048 + col0;
#pragma unroll
                for (int bj = 0; bj < 2; ++bj) { const f32x4 v0 = acc[ai][bj][m][0], v1 = acc[ai][bj][m][1];
                    u32x4 w; w.x = cvt_pk_bf16(v0[0], v0[1]); w.y = cvt_pk_bf16(v0[2], v0[3]); w.z = cvt_pk_bf16(v1[0], v1[1]); w.w = cvt_pk_bf16(v1[2], v1[3]);
                    *(u32x4*)(rowp + bj * HALF) = w; } }
    }
};

struct EpiQ {
    static constexpr bool PERM = true, AFTER_DRAIN = false;
    bf16_t* O; const float* rope; float sc; int mp, seq; const float* rsq;
    __device__ __forceinline__ void operator()(const f32x4 (&acc)[2][2][4][2], const Unit& u, int wr, int wc, int, int) const {
        int lane_; asm volatile("v_mbcnt_lo_u32_b32 %0, -1, 0\n\tv_mbcnt_hi_u32_b32 %0, -1, %0" : "=v"(lane_)); const int fr = lane_ & 15, fq = lane_ >> 4;
        const int row0 = u.pm * BM + wr * 64 + fr, col0 = u.pn * BM + wc * 32 + 8 * fq;
#pragma unroll
        for (int ai = 0; ai < 2; ++ai)
#pragma unroll
            for (int m2 = 0; m2 < 4; m2 += 2) {
                float rq[2]; f32x4 tt0[2][2], tt1[2][2];
#pragma unroll
                for (int mm = 0; mm < 2; ++mm) { const int row = row0 + ai * HALF + (m2 + mm) * 16; const int p = row < mp ? (row & (seq - 1)) : seq; rq[mm] = rsq[row];
#pragma unroll
                    for (int bj = 0; bj < 2; ++bj) { const int within = (col0 + bj * HALF) % 192, wi = within >= 128 ? ((within - 128) >> 1) : 0; const float* t = rope + (size_t)(p * 32 + wi) * 2;
                        tt0[mm][bj] = *(const f32x4*)t; tt1[mm][bj] = *(const f32x4*)(t + 4); } }
                __builtin_amdgcn_sched_barrier(0);
#pragma unroll
                for (int mm = 0; mm < 2; ++mm) { const int m = m2 + mm, row = row0 + ai * HALF + m * 16; bf16_t* rowp = O + (size_t)row * 3072 + col0; const float rsc = sc / sqrtf(rq[mm] * (1.0f / 384.0f) + 1e-6f);
#pragma unroll
                    for (int bj = 0; bj < 2; ++bj) { const int c = col0 + bj * HALF, within = c % 192; f32x4 v0 = acc[ai][bj][m][0], v1 = acc[ai][bj][m][1];
                        if (within >= 128) { const f32x4 t0 = tt0[mm][bj], t1 = tt1[mm][bj];
                            const f32x4 a0 = v0, a1 = v1;
                            v0[0] = a0[0] * t0[0] - a0[1] * t0[1]; v0[1] = a0[1] * t0[0] + a0[0] * t0[1]; v0[2] = a0[2] * t0[2] - a0[3] * t0[3]; v0[3] = a0[3] * t0[2] + a0[2] * t0[3];
                            v1[0] = a1[0] * t1[0] - a1[1] * t1[1]; v1[1] = a1[1] * t1[0] + a1[0] * t1[1]; v1[2] = a1[2] * t1[2] - a1[3] * t1[3]; v1[3] = a1[3] * t1[2] + a1[2] * t1[3]; }
                        v0 = v0 * rsc; v1 = v1 * rsc;
                        u32x4 w; w.x = cvt_pk_bf16(v0[0], v0[1]); w.y = cvt_pk_bf16(v0[2], v0[3]); w.z = cvt_pk_bf16(v1[0], v1[1]); w.w = cvt_pk_bf16(v1[2], v1[3]);
                        *(u32x4*)(rowp + bj * HALF) = w; } } }
    }
};

struct EpiCQ {
    static constexpr bool PERM = true, AFTER_DRAIN = false;
    bf16_t* O; const float* wq; float* rsq;
    __device__ __forceinline__ void operator()(const f32x4 (&acc)[2][2][4][2], const Unit& u, int wr, int wc, int, int) const {
        int lane_; asm volatile("v_mbcnt_lo_u32_b32 %0, -1, 0\n\tv_mbcnt_hi_u32_b32 %0, -1, %0" : "=v"(lane_)); const int fr = lane_ & 15, fq = lane_ >> 4;
        const int row0 = u.pm * BM + wr * 64 + fr, col0 = u.pn * BM + wc * 32 + 8 * fq;
#pragma unroll
        for (int ai = 0; ai < 2; ++ai)
#pragma unroll
            for (int m = 0; m < 4; ++m) { const int row = row0 + ai * HALF + m * 16; float ss = 0.f;
#pragma unroll
                for (int bj = 0; bj < 2; ++bj) { const int c = col0 + bj * HALF; if (c >= 384) continue;
                    const f32x4 v0 = acc[ai][bj][m][0], v1 = acc[ai][bj][m][1], w0 = *(const f32x4*)(wq + c), w1 = *(const f32x4*)(wq + c + 4);
                    ss += ((v0[0] * v0[0] + v0[1] * v0[1]) + (v0[2] * v0[2] + v0[3] * v0[3])) + ((v1[0] * v1[0] + v1[1] * v1[1]) + (v1[2] * v1[2] + v1[3] * v1[3]));
                    u32x4 w; w.x = cvt_pk_bf16(v0[0] * w0[0], v0[1] * w0[1]); w.y = cvt_pk_bf16(v0[2] * w0[2], v0[3] * w0[3]); w.z = cvt_pk_bf16(v1[0] * w1[0], v1[1] * w1[1]); w.w = cvt_pk_bf16(v1[2] * w1[2], v1[3] * w1[3]);
                    *(u32x4*)(O + (size_t)row * 384 + c) = w; }
                ss += __builtin_bit_cast(float, __builtin_amdgcn_ds_swizzle(__builtin_bit_cast(int, ss), 0x1F | (16 << 10)));
                { float a = ss, b = ss; asm volatile("s_nop 1\n\tv_permlane32_swap_b32 %0, %1\n\ts_nop 1" : "+v"(a), "+v"(b)); ss = a + b; }
                if (fq == 0 && u.pn < 2) atomicAdd(rsq + row, ss); }
    }
};

struct SliceOrder {
    int pm, nN, nS, G, c, kbytes;
    __device__ bool next(int i, Unit& u) const { const int L = i * G + c; if (L >= nN * nS) return false; u.pm = pm; u.pn = L % nN; u.ko = (L / nN) * kbytes; return true; }
    __device__ __forceinline__ void a_ready(const Unit&) const {}
    __device__ __forceinline__ void done(const Unit&) const {}
};
struct EpiFA {
    static constexpr bool PERM = false, AFTER_DRAIN = false;
    float* O; int ldc, rows;
    __device__ __forceinline__ void operator()(const f32x4 (&acc)[2][2][4][2], const Unit& u, int wr, int wc, int, int) const {
        int lane_; asm volatile("v_mbcnt_lo_u32_b32 %0, -1, 0\n\tv_mbcnt_hi_u32_b32 %0, -1, %0" : "=v"(lane_)); const int fr = lane_ & 15, fq = lane_ >> 4;
        const int row0 = u.pm * BM + wr * 64 + fr, col0 = u.pn * BM + wc * 32 + 4 * fq;
#pragma unroll
        for (int ai = 0; ai < 2; ++ai)
#pragma unroll
            for (int m = 0; m < 4; ++m) { const int row = row0 + ai * HALF + m * 16; if (row >= rows) continue; float* rp = O + (size_t)row * ldc + col0;
#pragma unroll
                for (int bj = 0; bj < 2; ++bj)
#pragma unroll
                    for (int n = 0; n < 2; ++n) { const f32x4 v = acc[ai][bj][m][n];
#pragma unroll
                        for (int e = 0; e < 4; ++e) atomicAdd(rp + bj * HALF + n * 16 + e, v[e]); } }
    }
};

template <int ACT> struct EpiBA {
    static constexpr bool PERM = true, AFTER_DRAIN = false;
    bf16_t* O; const float* bias;
    __device__ __forceinline__ void operator()(const f32x4 (&acc)[2][2][4][2], const Unit& u, int wr, int wc, int, int) const {
        int lane_; asm volatile("v_mbcnt_lo_u32_b32 %0, -1, 0\n\tv_mbcnt_hi_u32_b32 %0, -1, %0" : "=v"(lane_)); const int fr = lane_ & 15, fq = lane_ >> 4;
        const int row0 = u.pm * BM + wr * 64 + fr, col0 = u.pn * BM + wc * 32 + 8 * fq;
        f32x4 bv[2][2];
#pragma unroll
        for (int bj = 0; bj < 2; ++bj)
#pragma unroll
            for (int n = 0; n < 2; ++n) bv[bj][n] = *(const f32x4*)(bias + col0 + bj * HALF + 4 * n);
#pragma unroll
        for (int ai = 0; ai < 2; ++ai)
#pragma unroll
            for (int m = 0; m < 4; ++m) { bf16_t* rowp = O + (size_t)(row0 + ai * HALF + m * 16) * 2048 + col0;
#pragma unroll
                for (int bj = 0; bj < 2; ++bj) { f32x4 v0 = acc[ai][bj][m][0] + bv[bj][0], v1 = acc[ai][bj][m][1] + bv[bj][1];
#pragma unroll
                    for (int e = 0; e < 4; ++e) { const float s0 = __builtin_amdgcn_rcpf(1.0f + __builtin_amdgcn_exp2f(-1.4426950408889634f * v0[e])), s1 = __builtin_amdgcn_rcpf(1.0f + __builtin_amdgcn_exp2f(-1.4426950408889634f * v1[e]));
                        v0[e] = ACT == 4 ? -0.8750387749f * s0 : s0; v1[e] = ACT == 4 ? -0.8750387749f * s1 : s1; }
                    typedef __bf16 bf8n __attribute__((ext_vector_type(8))); typedef float f8n __attribute__((ext_vector_type(8)));
                    const u32x4 w = __builtin_bit_cast(u32x4, __builtin_convertvector((f8n){v0[0], v0[1], v0[2], v0[3], v1[0], v1[1], v1[2], v1[3]}, bf8n));
                    *(u32x4*)(rowp + bj * HALF) = w; } }
    }
};

struct GroupOrderA2 {
    StaticOrder so; int per, nG;
    __device__ void init(int M, int G_, int c_, int nG_) { so.init(M, 2048, G_, c_); per = so.nwg; nG = nG_; }
    __device__ bool next(int i, Unit& u) const {
        const long L = (long)i * so.G + so.c; u.ko = 0;
        if (L < 4L * per) { const int gi = (int)(L / per); int wgid = (int)(L - (long)gi * per);
            { const int q = so.nwg / NXCD, r = so.nwg % NXCD, xcd = wgid % NXCD, off = wgid / NXCD; wgid = (xcd < r ? xcd * (q + 1) : r * (q + 1) + (xcd - r) * q) + off; }
            const int nig = WGM * so.nN, gid = wgid / nig, fm = gid * WGM, gsz = (so.nM - fm) < WGM ? (so.nM - fm) : WGM;
            u.pm = fm + ((wgid % nig) % gsz) + 130 * gi; u.pn = (wgid % nig) / gsz + 8 * gi; return true; }
        const int Lp = (int)(L - 4L * per); if (Lp >= (nG - 4) * so.nM) return false;
        const int ge = Lp / so.nM, gi = 4 + ge; u.pm = Lp % so.nM + 130 * (gi == 6 ? 2 : gi); u.pn = 32 + ge; return true;
    }
    __device__ __forceinline__ void a_ready(const Unit&) const {}
    __device__ __forceinline__ void done(const Unit&) const {}
};
struct EpiA2 {
    static constexpr bool PERM = true, AFTER_DRAIN = false;
    bf16_t* Rb; size_t ostride; int vidx; bf16_t* Lb; size_t lstride;
    __device__ __forceinline__ void operator()(const f32x4 (&acc)[2][2][4][2], const Unit& u, int wr, int wc, int, int) const {
        int lane_; asm volatile("v_mbcnt_lo_u32_b32 %0, -1, 0\n\tv_mbcnt_hi_u32_b32 %0, -1, %0" : "=v"(lane_)); const int fr = lane_ & 15, fq = lane_ >> 4;
        if (u.pn < 32) { const int gi = u.pn >> 3; bf16_t* Ob = Rb + (size_t)(gi < 2 ? gi : (gi == 2 ? vidx : 4)) * ostride;
            const int row0 = (u.pm - 130 * gi) * BM + wr * 64 + fr, col0 = (u.pn & 7) * BM + wc * 32 + 8 * fq;
#pragma unroll
            for (int ai = 0; ai < 2; ++ai)
#pragma unroll
                for (int m = 0; m < 4; ++m) { bf16_t* rowp = Ob + (size_t)(row0 + ai * HALF + m * 16) * 2048 + col0;
#pragma unroll
                    for (int bj = 0; bj < 2; ++bj) { const f32x4 v0 = acc[ai][bj][m][0], v1 = acc[ai][bj][m][1];
                        u32x4 w; w.x = cvt_pk_bf16(v0[0], v0[1]); w.y = cvt_pk_bf16(v0[2], v0[3]); w.z = cvt_pk_bf16(v1[0], v1[1]); w.w = cvt_pk_bf16(v1[2], v1[3]);
                        *(u32x4*)(rowp + bj * HALF) = w; } }
        } else { const int ge = u.pn - 32, gi = 4 + ge; bf16_t* Ob = Lb + (size_t)ge * lstride; const int nvalid = ge == 2 ? 32 : 64;
            const int row0 = (u.pm - 130 * (gi == 6 ? 2 : gi)) * BM + wr * 64 + fr, c = wc * 32 + 8 * fq;
#pragma unroll
            for (int ai = 0; ai < 2; ++ai)
#pragma unroll
                for (int m = 0; m < 4; ++m) { f32x4 v0 = acc[ai][0][m][0], v1 = acc[ai][0][m][1];
                    if (ge == 0) {
#pragma unroll
                        for (int e = 0; e < 4; ++e) { v0[e] = 1.0f - 2.0f / (1.0f + __expf(2.0f * v0[e])); v1[e] = 1.0f - 2.0f / (1.0f + __expf(2.0f * v1[e])); } }
                    u32x4 w; w.x = cvt_pk_bf16(v0[0], v0[1]); w.y = cvt_pk_bf16(v0[2], v0[3]); w.z = cvt_pk_bf16(v1[0], v1[1]); w.w = cvt_pk_bf16(v1[2], v1[3]);
                    if (c >= nvalid) w = (u32x4){0u, 0u, 0u, 0u};
                    *(u32x4*)(Ob + (size_t)(row0 + ai * HALF + m * 16) * 128 + c) = w; }
        }
    }
};
template <class Epi, class Sched, bool ALIGN_EPI = false, bool SP2 = false>
__device__ __forceinline__ void gemm_phase(PG8_LAS unsigned char* lds, const Gemm g, const Sched& S, const Epi& E, const int wid) {
    int lane_; asm volatile("v_mbcnt_lo_u32_b32 %0, -1, 0\n\tv_mbcnt_hi_u32_b32 %0, -1, %0" : "=v"(lane_));
    const int lane = lane_, tid = wid * 64 + lane, wr = wid >> 2, wc = wid & 3, fr = lane & 15, fq = lane >> 4;
    const int K = g.K, nt = K / BK, LD = g.ld ? g.ld : g.K;
    unsigned voffA[2], voffB[2];
#pragma unroll
    for (int i = 0; i < 2; ++i) { int R, C; stage_rc(tid * 16 + i * 8192, R, C); const int Rb = Epi::PERM ? ((R & ~31) + perm32(R & 31)) : R;
        voffA[i] = (unsigned)(R * LD + C) * 2u; voffB[i] = (unsigned)(Rb * LD + C) * 2u; }
    const size_t kstep = (size_t)(BK * 2);
    const size_t hstep = (size_t)HALF * LD * 2;
    const size_t tstep = 2 * hstep;
    const unsigned ldsw = (unsigned)wid * 1024u;
    const int aoff = lds_byte(wr * 64 + fr, fq * 8), boff = lds_byte(wc * 32 + fr, fq * 8);
#define PG8_SA(b, h) (((b) * 2 + (h)) * HTB)
#define PG8_SB(b, h) ((4 + (b) * 2 + (h)) * HTB)
#define PG8_STAGE(bufoff, gbase, voff) do { _Pragma("unroll") for (int _i = 0; _i < 2; ++_i) \
        __builtin_amdgcn_global_load_lds((const unsigned*)((const char*)(gbase) + (voff)[_i]), (PG8_LAS unsigned*)(lds + (bufoff) + ldsw + _i * 8192), 16, 0, 0); } while (0)
#define PG8_LDA(dst, b, h) do { _Pragma("unroll") for (int m = 0; m < 4; ++m) _Pragma("unroll") for (int k = 0; k < 2; ++k) dst[m][k] = *(const PG8_LAS bf16x8*)(lds + PG8_SA(b, h) + aoff + m * 2048 + k * 1024); } while (0)
#define PG8_LDB(dst, b, h) do { _Pragma("unroll") for (int n = 0; n < 2; ++n) _Pragma("unroll") for (int k = 0; k < 2; ++k) dst[n][k] = *(const PG8_LAS bf16x8*)(lds + PG8_SB(b, h) + boff + n * 2048 + k * 1024); } while (0)
#define PG8_MMA(ai, bj, At, Bt) do { __builtin_amdgcn_s_setprio(1); _Pragma("unroll") for (int m = 0; m < 4; ++m) _Pragma("unroll") for (int n = 0; n < 2; ++n) _Pragma("unroll") for (int k = 0; k < 2; ++k) \
        acc[ai][bj][m][n] = __builtin_amdgcn_mfma_f32_16x16x32_bf16(Bt[n][k], At[m][k], acc[ai][bj][m][n], 0, 0, 0); __builtin_amdgcn_s_setprio(0); } while (0)
#define PG8_WAIT_V(n) asm volatile("s_waitcnt vmcnt(" #n ")" ::: "memory")
#define PG8_WAIT_L(n) asm volatile("s_waitcnt lgkmcnt(" #n ")" ::: "memory")
#define PG8_BAR __builtin_amdgcn_s_barrier()
#define PG8_SCHED __builtin_amdgcn_sched_barrier(0)
    Unit cur, nxt; int ui = 0;
    if (!S.next(0, cur)) return;
    f32x4 acc[2][2][4][2];
#pragma unroll
    for (int a = 0; a < 2; ++a)
#pragma unroll
        for (int b = 0; b < 2; ++b)
#pragma unroll
            for (int m = 0; m < 4; ++m)
#pragma unroll
                for (int n = 0; n < 2; ++n) acc[a][b][m][n] = (f32x4){0.f, 0.f, 0.f, 0.f};
    bf16x8 At[4][2], B0[2][2], B1[2][2];
    const char* cA = (const char*)g.A + (size_t)cur.pm * tstep + cur.ko; const char* cB = (const char*)g.Bt + (size_t)cur.pn * tstep + cur.ko;
    S.a_ready(cur);
    if constexpr (SP2) {
        PG8_STAGE(PG8_SB(0, 0), cB, voffB); PG8_STAGE(PG8_SB(0, 1), cB + hstep, voffB); PG8_STAGE(PG8_SA(0, 0), cA, voffA); PG8_STAGE(PG8_SA(0, 1), cA + hstep, voffA);
        if (wr == 1) PG8_BAR;
        PG8_WAIT_V(2); PG8_BAR;
        PG8_STAGE(PG8_SB(1, 0), cB + kstep, voffB); PG8_STAGE(PG8_SA(1, 0), cA + kstep, voffA); PG8_STAGE(PG8_SB(1, 1), cB + hstep + kstep, voffB);
        PG8_WAIT_V(6); PG8_BAR;
    } else {
        PG8_STAGE(PG8_SB(0, 0), cB, voffB); PG8_STAGE(PG8_SA(0, 0), cA, voffA); PG8_STAGE(PG8_SB(0, 1), cB + hstep, voffB); PG8_STAGE(PG8_SA(0, 1), cA + hstep, voffA);
        if (wr == 1) PG8_BAR;
        PG8_WAIT_V(4); PG8_BAR;
        PG8_STAGE(PG8_SB(1, 0), cB + kstep, voffB); PG8_STAGE(PG8_SA(1, 0), cA + kstep, voffA); PG8_STAGE(PG8_SB(1, 1), cB + hstep + kstep, voffB);
        PG8_WAIT_V(6); PG8_BAR;
    }
    for (;;) {
        const bool has_next = S.next(ui + 1, nxt);
        const char* nA = has_next ? (const char*)g.A + (size_t)nxt.pm * tstep + nxt.ko : cA; const char* nB = has_next ? (const char*)g.Bt + (size_t)nxt.pn * tstep + nxt.ko : cB;
        for (int t = 0; t < nt; t += 2) {
            const bool last = (t == nt - 2);
            const char* a1 = cA + (size_t)(t + 1) * kstep;
            const char* a2 = last ? nA : cA + (size_t)(t + 2) * kstep; const char* b2 = last ? nB : cB + (size_t)(t + 2) * kstep;
            const char* a3 = a2 + kstep; const char* b3 = b2 + kstep;
            if (last && has_next) S.a_ready(nxt);
            if constexpr (SP2) {
            PG8_LDB(B0, 0, 0); PG8_LDB(B1, 0, 1); PG8_SCHED; PG8_LDA(At, 0, 0); PG8_STAGE(PG8_SA(1, 1), a1 + hstep, voffA);
            PG8_WAIT_V(8); PG8_WAIT_L(0); PG8_BAR; PG8_MMA(0, 0, At, B0); PG8_MMA(0, 1, At, B1); PG8_BAR; PG8_SCHED;
            PG8_LDA(At, 0, 1); PG8_STAGE(PG8_SB(0, 0), b2, voffB); PG8_STAGE(PG8_SB(0, 1), b2 + hstep, voffB); PG8_STAGE(PG8_SA(0, 0), a2, voffA);
            PG8_WAIT_V(8); PG8_WAIT_L(0); PG8_BAR; PG8_MMA(1, 0, At, B0); PG8_MMA(1, 1, At, B1); PG8_BAR; PG8_SCHED;
            PG8_LDB(B0, 1, 0); PG8_LDB(B1, 1, 1); PG8_SCHED; PG8_LDA(At, 1, 0); PG8_STAGE(PG8_SA(0, 1), a2 + hstep, voffA);
            PG8_WAIT_V(8); PG8_WAIT_L(0); PG8_BAR; PG8_MMA(0, 0, At, B0); PG8_MMA(0, 1, At, B1); PG8_BAR; PG8_SCHED;
            PG8_LDA(At, 1, 1); PG8_STAGE(PG8_SB(1, 0), b3, voffB); PG8_STAGE(PG8_SB(1, 1), b3 + hstep, voffB); PG8_STAGE(PG8_SA(1, 0), a3, voffA);
            PG8_WAIT_V(8); PG8_WAIT_L(0); PG8_BAR; PG8_MMA(1, 0, At, B0); PG8_MMA(1, 1, At, B1); PG8_BAR; PG8_SCHED;
            } else {
            PG8_LDB(B0, 0, 0); PG8_SCHED; PG8_LDA(At, 0, 0); PG8_STAGE(PG8_SA(1, 1), a1 + hstep, voffA);
            PG8_WAIT_L(8); PG8_BAR; PG8_WAIT_L(0); PG8_MMA(0, 0, At, B0); PG8_BAR; PG8_SCHED;
            PG8_LDB(B1, 0, 1); PG8_STAGE(PG8_SB(0, 0), b2, voffB);
            PG8_BAR; PG8_WAIT_L(0); PG8_MMA(0, 1, At, B1); PG8_BAR;
            PG8_LDA(At, 0, 1); PG8_STAGE(PG8_SA(0, 0), a2, voffA);
            PG8_BAR; PG8_WAIT_L(0); PG8_MMA(1, 0, At, B0); PG8_BAR; PG8_SCHED;
            PG8_STAGE(PG8_SB(0, 1), b2 + hstep, voffB);
            PG8_WAIT_V(6); PG8_BAR; PG8_MMA(1, 1, At, B1); PG8_BAR;
            PG8_LDB(B0, 1, 0); PG8_SCHED; PG8_LDA(At, 1, 0); PG8_STAGE(PG8_SA(0, 1), a2 + hstep, voffA);
            PG8_WAIT_L(8); PG8_BAR; PG8_WAIT_L(0); PG8_MMA(0, 0, At, B0); PG8_BAR; PG8_SCHED;
            PG8_LDB(B1, 1, 1); PG8_STAGE(PG8_SB(1, 0), b3, voffB);
            PG8_BAR; PG8_WAIT_L(0); PG8_MMA(0, 1, At, B1); PG8_BAR;
            PG8_LDA(At, 1, 1); PG8_STAGE(PG8_SA(1, 0), a3, voffA);
            PG8_BAR; PG8_WAIT_L(0); PG8_MMA(1, 0, At, B0); PG8_BAR; PG8_SCHED;
            PG8_STAGE(PG8_SB(1, 1), b3 + hstep, voffB);
            PG8_WAIT_V(6); PG8_BAR; PG8_MMA(1, 1, At, B1); PG8_BAR;
            }
        }
        if constexpr (ALIGN_EPI) { if (wr == 0) PG8_BAR; }
        if constexpr (!Epi::AFTER_DRAIN) { E(acc, cur, wr, wc, fr, fq); S.done(cur); }
        if (!has_next) break;
#pragma unroll
        for (int a = 0; a < 2; ++a)
#pragma unroll
            for (int b = 0; b < 2; ++b)
#pragma unroll
                for (int m = 0; m < 4; ++m)
#pragma unroll
                    for (int n = 0; n < 2; ++n) acc[a][b][m][n] = (f32x4){0.f, 0.f, 0.f, 0.f};
        cur = nxt; cA = nA; cB = nB; ++ui;
        if constexpr (ALIGN_EPI) { if (wr == 1) PG8_BAR; }
    }
    PG8_WAIT_V(0);
    if constexpr (!ALIGN_EPI) { if (wr == 0) PG8_BAR; }
    PG8_BAR;
    if constexpr (Epi::AFTER_DRAIN) { E.fused(acc, cur, wr, wc, fr, fq, lds, wid, lane); S.done(cur); }
#undef PG8_SA
#undef PG8_SB
#undef PG8_STAGE
#undef PG8_LDA
#undef PG8_LDB
#undef PG8_MMA
#undef PG8_WAIT_V
#undef PG8_WAIT_L
#undef PG8_BAR
#undef PG8_SCHED
}
}
constexpr int D_MODEL = 1024, BATCH = 16, SEQ = 2048, DEC_BATCH = 128, PAST = 8192, PAGE = 128, NPAGES = 64;
constexpr int D_INNER = 2048, A_HEADS = 32, A_HEAD = 64, B_HEADS = 16, KV_LORA = 256, Q_LORA = 384, QK_NOPE = 128, QK_ROPE = 64, V_HEAD = 128, QK_HEAD = 192;
constexpr int MP = BATCH * SEQ;
constexpr int MS0 = MP;
constexpr int MT = MP + 256;
constexpr float NORM_EPS = 1e-6f, GN_EPS = 64e-5f;
constexpr float ATTN_SCALE = 0.07216878364870322f;
constexpr float LOG2E = 1.4426950408889634f;
constexpr int NWAVES = 8, NTHR = 512;

constexpr size_t O_YP = 0, O_YS = O_YP + (size_t)MP * D_MODEL, O_WKVP = O_YS + (size_t)DEC_BATCH * D_MODEL, O_SHP = O_WKVP + (size_t)2 * BATCH * A_HEADS * 4096,
    O_CKVP = O_SHP + (size_t)2 * BATCH * D_MODEL, O_KPEP = O_CKVP + (size_t)MP * KV_LORA, O_WKVS = O_KPEP + (size_t)MP * QK_ROPE, O_SHS = O_WKVS + (size_t)2 * DEC_BATCH * A_HEADS * 4096,
    O_CKVS = O_SHS + (size_t)2 * DEC_BATCH * D_MODEL, O_KPES = O_CKVS + (size_t)DEC_BATCH * KV_LORA, O_END = O_KPES + (size_t)DEC_BATCH * QK_ROPE;

constexpr size_t MiB = 1u << 20;
constexpr size_t WS_CTL = 0, CTL_ZERO_BYTES = 2 * MiB;
constexpr size_t WS_WIN = 2 * MiB, WIN_L = 18 * MiB;
constexpr size_t WS_W2 = WS_WIN + 2 * WIN_L;
constexpr size_t WS_WO = WS_W2 + 3 * MiB;
constexpr size_t WS_WDKV = WS_WO + 8 * MiB;
constexpr size_t WS_WUK = WS_WDKV + 1 * MiB;
constexpr size_t WS_WUV = WS_WUK + 1 * MiB;
constexpr size_t WS_WQ = WS_WUV + 1 * MiB;
constexpr size_t WS_WZ = WS_WQ + 2 * MiB;
constexpr size_t WS_WUQ = WS_WZ + 8 * MiB;
constexpr size_t WS_WBO = WS_WUQ + 5 * MiB;
constexpr size_t WS_ROPE = WS_WBO + 8 * MiB;
constexpr size_t WS_X = 96 * MiB;
constexpr size_t WS_AM = WS_X + 130 * MiB;
constexpr size_t AM_STRIDE = 65 * MiB;
constexpr size_t WS_R = WS_AM + 6 * AM_STRIDE;
constexpr size_t BIGB = 130 * MiB;
constexpr size_t WS_K = WS_R + BIGB, WS_V0 = WS_K + BIGB, WS_V1 = WS_V0 + BIGB, WS_Z = WS_V1 + BIGB, WS_G = WS_Z + BIGB;
constexpr size_t WS_LW = WS_G + BIGB;
constexpr size_t WS_LA = WS_LW + 9 * MiB, WS_LV = WS_LA + 9 * MiB;
constexpr size_t WS_BON = WS_LV + 9 * MiB;
constexpr size_t WS_F = WS_BON + 5 * MiB;
constexpr size_t BIGF = 260 * MiB;
constexpr size_t WS_WD = WS_F, WS_IA = WS_F + BIGF, WS_VG = WS_F + 2 * BIGF, WS_SR = WS_F + 3 * BIGF, WS_SK = WS_F + 4 * BIGF, WS_SA = WS_F + 5 * BIGF, WS_SB = WS_F + 6 * BIGF,
    WS_SV = WS_F + 7 * BIGF, WS_Y = WS_F + 8 * BIGF, WS_END_A = WS_F + 9 * BIGF;
constexpr size_t WS_KVR = WS_F;
constexpr size_t WS_CKVB = WS_KVR + 41 * MiB;
constexpr size_t WS_KPEB = WS_CKVB + 17 * MiB;
constexpr size_t WS_KN = WS_KPEB + 5 * MiB;
constexpr size_t WS_VT = WS_KN + 128 * MiB;
constexpr size_t WS_QL = WS_VT + 128 * MiB;
constexpr size_t WS_CQ = WS_QL + 49 * MiB;
constexpr size_t WS_QR = WS_CQ + 25 * MiB;
constexpr size_t WS_Q = WS_QR + 388 * MiB;
constexpr size_t WS_QABS = WS_Q + 194 * MiB;
constexpr size_t WS_OPART = WS_QABS + 2 * MiB;
constexpr size_t WS_ML = WS_OPART + 16 * MiB;
constexpr size_t WS_END_B = WS_ML + 1 * MiB;
constexpr size_t WS_NEED = WS_END_A > WS_END_B ? WS_END_A : WS_END_B;
static_assert(WS_ROPE + 1 * MiB <= WS_X, "weights region");
constexpr size_t CW_RSQ = 1 * MiB;
constexpr int CW_BAR = 4096;

constexpr int RING_BYTES = 131072;
constexpr int LDSCTL_OFF = RING_BYTES;
constexpr int LDS_BYTES = 147456;

#define GAS __attribute__((address_space(1)))
#define LAS __attribute__((address_space(3)))
typedef unsigned short bf16;
typedef unsigned v4u __attribute__((ext_vector_type(4)));
typedef unsigned v2u __attribute__((ext_vector_type(2)));
typedef float f32x4 __attribute__((ext_vector_type(4)));
typedef float f32x16 __attribute__((ext_vector_type(16)));
typedef short bf16x8 __attribute__((ext_vector_type(8)));
typedef short s16x4 __attribute__((ext_vector_type(4)));
typedef const __attribute__((address_space(4))) float* cfp;
#define LDS_WAIT() asm volatile("s_waitcnt lgkmcnt(0)" ::: "memory")
#define VM_WAIT() asm volatile("s_waitcnt vmcnt(0)" ::: "memory")
__device__ __forceinline__ unsigned f2bf(float f) { unsigned u = __builtin_bit_cast(unsigned, f); return (u + 0x7fffu + ((u >> 16) & 1u)) >> 16; }
__device__ __forceinline__ unsigned pk2(float lo, float hi) { return f2bf(lo) | (f2bf(hi) << 16); }
__device__ __forceinline__ float bflo(unsigned u) { return __builtin_bit_cast(float, u << 16); }
__device__ __forceinline__ float bfhi(unsigned u) { return __builtin_bit_cast(float, u & 0xffff0000u); }
template <int MASK> __device__ __forceinline__ float swz_xor(float v) { return __builtin_bit_cast(float, __builtin_amdgcn_ds_swizzle(__builtin_bit_cast(int, v), 0x1F | (MASK << 10))); }
__device__ __forceinline__ float xor32_sum(float v) { float a = v, b = v; asm volatile("s_nop 1\n\tv_permlane32_swap_b32 %0, %1\n\ts_nop 1" : "+v"(a), "+v"(b)); return a + b; }
__device__ __forceinline__ float xor32_max(float v) { float a = v, b = v; asm volatile("s_nop 1\n\tv_permlane32_swap_b32 %0, %1\n\ts_nop 1" : "+v"(a), "+v"(b)); return fmaxf(a, b); }
__device__ __forceinline__ float wave_sum(float v) { v += swz_xor<1>(v); v += swz_xor<2>(v); v += swz_xor<4>(v); v += swz_xor<8>(v); v += swz_xor<16>(v); return xor32_sum(v); }
__device__ __forceinline__ float sigmoidf_(float x) { return 1.0f / (1.0f + __expf(-x)); }
#define XB_TMO      128
#define XB_XCNT(j)  (256  + 64 * (j))
#define XB_XSUB(j)  (1280 + 64 * (j))
#define XB_XGEN(j)  (2304 + 64 * (j))
#define XB_TOP      3328
#define XB_TOPGEN   3392
#define XCD_BAR_WORDS 3456
#define XB_SPIN_CAP (1u << 18)

__device__ __forceinline__ unsigned xb_ld(unsigned* p)              { return __hip_atomic_load(p, __ATOMIC_RELAXED, __HIP_MEMORY_SCOPE_AGENT); }
__device__ __forceinline__ unsigned xb_add(unsigned* p, unsigned v) { return __hip_atomic_fetch_add(p, v, __ATOMIC_RELAXED, __HIP_MEMORY_SCOPE_AGENT); }
__device__ __forceinline__ unsigned xb_xcc_id() { return (unsigned)__builtin_amdgcn_s_getreg((3 << 11) | 20) & 0xFu; }
#define XB_SPIN(cond, bar) do { unsigned _sp = 0; while (cond) { __builtin_amdgcn_s_sleep(1); \
    if ((++_sp & 255u) == 0u) { if (xb_ld(&(bar)[XB_TMO])) break; if (_sp > XB_SPIN_CAP) { atomicAdd(&(bar)[XB_TMO], 1u); break; } } } } while (0)

struct XcdBarrier {
    unsigned* bar; unsigned x; unsigned w;
    volatile LAS unsigned* st;
};

__device__ __forceinline__ bool xb_t0(unsigned w) { unsigned l; asm volatile("v_mbcnt_lo_u32_b32 %0, -1, 0\n\tv_mbcnt_hi_u32_b32 %0, -1, %0" : "=v"(l)); return w == 0u && l == 0u; }
__device__ __forceinline__ XcdBarrier xcd_barrier_post(unsigned* bar, volatile LAS unsigned* st, unsigned w) {
    XcdBarrier b; b.bar = bar; b.x = xb_xcc_id(); b.st = st; b.w = w;
    if (xb_t0(w)) (void)xb_add(&bar[XB_XCNT(b.x)], 1u);
    return b;
}
__device__ __forceinline__ void xcd_barrier_complete(unsigned* bar, unsigned x, unsigned& nloc, unsigned& nx) {
    const unsigned G = gridDim.x * gridDim.y * gridDim.z;
    unsigned sum, cnt, mine, sp = 0u;
    for (;;) {
        sum = 0u; cnt = 0u; mine = 0u;
#pragma unroll
        for (unsigned j = 0; j < 16; ++j) { const unsigned c = xb_ld(&bar[XB_XCNT(j)]); sum += c; cnt += (c > 0u) ? 1u : 0u; mine = (j == x) ? c : mine; }
        if (sum == G) break;
        __builtin_amdgcn_s_sleep(1);
        if ((++sp & 255u) == 0u) { if (xb_ld(&bar[XB_TMO])) break; if (sp > XB_SPIN_CAP) { atomicAdd(&bar[XB_TMO], 1u); break; } }
    }
    nloc = mine > 0u ? mine : 1u; nx = cnt > 0u ? cnt : 1u;
}

__device__ __forceinline__ void xcd_barrier(const XcdBarrier& b) {
    asm volatile("s_waitcnt vmcnt(0)" ::: "memory");
    __syncthreads();
    if (xb_t0(b.w)) {
        unsigned* bar = b.bar;
        __builtin_amdgcn_s_waitcnt(0);
        unsigned nloc = b.st[0], nx = b.st[1];
        if (nloc == 0u) { xcd_barrier_complete(bar, b.x, nloc, nx); b.st[0] = nloc; b.st[1] = nx; }
        const unsigned old = xb_add(&bar[XB_XSUB(b.x)], 1u);
        const unsigned gen = old / nloc;
        if (old + 1u == (gen + 1u) * nloc) {
            __builtin_amdgcn_fence(__ATOMIC_RELEASE, "agent");
            asm volatile("s_waitcnt vmcnt(0)" ::: "memory");
            const unsigned og = xb_add(&bar[XB_TOP], 1u);
            const unsigned tg = og / nx;
            if (og + 1u == (tg + 1u) * nx) xb_add(&bar[XB_TOPGEN], 1u);
            else XB_SPIN(xb_ld(&bar[XB_TOPGEN]) == tg, bar);
            __builtin_amdgcn_fence(__ATOMIC_ACQUIRE, "agent");
            xb_add(&bar[XB_XGEN(b.x)], 1u);
            asm volatile("s_waitcnt vmcnt(0)" ::: "memory");
        } else {
            XB_SPIN(xb_ld(&bar[XB_XGEN(b.x)]) == gen, bar);
            __builtin_amdgcn_fence(__ATOMIC_ACQUIRE, "agent");
            asm volatile("s_waitcnt vmcnt(0)" ::: "memory");
        }
    }
    __syncthreads();
}
struct Args { const void* in[36]; float* out; unsigned char* ws; int ph_lo, ph_hi, li, pad; };
typedef const __attribute__((address_space(4))) Args* cargs;
__device__ __forceinline__ int lane_id() { int l; asm volatile("v_mbcnt_lo_u32_b32 %0, -1, 0\n\tv_mbcnt_hi_u32_b32 %0, -1, %0" : "=v"(l)); return l; }
struct Frame { LAS unsigned char* lds; unsigned char* ws; float* out; int lane, wave, bid, gw, NGW, G, NT; };
#define LANE F.lane
__device__ __forceinline__ Frame make_frame(cargs ap, int wave0, LAS unsigned char* lds) {
    Frame F; int w = wave0, b = (int)blockIdx.x, g = (int)gridDim.x; asm volatile("" : "+s"(w), "+s"(b), "+s"(g));
    F.lds = lds; F.ws = ap->ws; F.out = ap->out; F.lane = lane_id(); F.wave = w; F.bid = b; F.G = g; F.gw = b * NWAVES + w; F.NGW = g * NWAVES; F.NT = g * NTHR;
    return F;
}

__device__ __forceinline__ int rope_perm_col(int n) { const int c = n % 192; if (c < 128) return n; const int j = c - 128; return n - c + 128 + 2 * (j & 31) + (j >> 5); }
__device__ __forceinline__ void tr_item(const float* W, int ldw, int col0, int Kvalid, int nblk, bf16* WT, int ldt, bool zpad, LAS float* scr, int item, int lane, bool rperm = false) {
    const int kb = item / nblk, nb = item % nblk, k0 = 64 * kb, n0 = 32 * nb;
    float wv[32];
#pragma unroll
    for (int i = 0; i < 32; ++i) { const int kr = min(k0 + 2 * i + (lane >> 5), Kvalid - 1); wv[i] = W[(size_t)kr * ldw + col0 + n0 + (lane & 31)]; }
    __builtin_amdgcn_sched_barrier(0);
#pragma unroll
    for (int i = 0; i < 32; ++i) { const int kk = 2 * i + (lane >> 5); scr[kk * 33 + (lane & 31)] = (k0 + kk < Kvalid) ? wv[i] : 0.f; }
    LDS_WAIT(); asm volatile("" ::: "memory");
    const int c = lane & 7;
#pragma unroll
    for (int j = 0; j < 4; ++j) { const int n = (lane >> 3) + 8 * j; const LAS float* s = scr + (8 * c) * 33 + n;
        v4u o; o.x = pk2(s[0 * 33], s[1 * 33]); o.y = pk2(s[2 * 33], s[3 * 33]); o.z = pk2(s[4 * 33], s[5 * 33]); o.w = pk2(s[6 * 33], s[7 * 33]);
        const int nd = rperm ? rope_perm_col(n0 + n) : n0 + n;
        *(v4u*)(WT + (size_t)nd * ldt + k0 + 8 * c) = o;
        if (zpad) *(v4u*)(WT + (size_t)nd * ldt + 64 + 8 * c) = (v4u){0u, 0u, 0u, 0u}; }
    LDS_WAIT(); asm volatile("" ::: "memory");
}
#define TRJOB_(W_, ldw_, col0_, Kv_, Nc_, WT_, ldt_, zp_, rp_) do { const int nblk_ = (Nc_) / 32, items_ = (((Kv_) + 63) / 64) * nblk_; \
    for (int it_ = ((F.gw - base_) % F.NGW + F.NGW) % F.NGW; it_ < items_; it_ += F.NGW) tr_item((W_), (ldw_), (col0_), (Kv_), nblk_, (bf16*)(WT_), (ldt_), (zp_), scr, it_, LANE, (rp_)); base_ = (base_ + items_) % F.NGW; } while (0)
#define TRJOB(W_, ldw_, col0_, Kv_, Nc_, WT_, ldt_, zp_) TRJOB_(W_, ldw_, col0_, Kv_, Nc_, WT_, ldt_, zp_, false)

__device__ __forceinline__ void p0_prologue(Frame& F, cargs a) {
    LAS float* scr = (LAS float*)(F.lds + F.wave * 16384);
    unsigned char* ws = F.ws; int base_ = 0;
    for (int l = 0; l < 2; ++l) {
        for (int p = 0; p < 4; ++p) TRJOB((const float*)a->in[9] + (size_t)(l * 4 + p) * 1024 * 2048, 2048, 0, 1024, 2048, ws + WS_WIN + (size_t)l * WIN_L + (size_t)p * 4 * MiB, 1024, false);
        TRJOB((const float*)a->in[11] + (size_t)l * 1024 * 64, 64, 0, 1024, 64, ws + WS_WIN + (size_t)l * WIN_L + 16 * MiB, 1024, false);
        TRJOB((const float*)a->in[14] + (size_t)l * 1024 * 64, 64, 0, 1024, 64, ws + WS_WIN + (size_t)l * WIN_L + 16 * MiB + MiB / 2, 1024, false);
        TRJOB((const float*)a->in[12] + (size_t)l * 64 * 2048, 2048, 0, 64, 2048, ws + WS_W2 + (size_t)l * (MiB / 2), 128, true);
        TRJOB((const float*)a->in[15] + (size_t)l * 64 * 2048, 2048, 0, 64, 2048, ws + WS_W2 + (size_t)(2 + l) * (MiB / 2), 128, true);
        TRJOB((const float*)a->in[24] + (size_t)l * 2048 * 1024, 1024, 0, 2048, 1024, ws + WS_WO + (size_t)l * 4 * MiB, 2048, false);
        TRJOB((const float*)a->in[31] + (size_t)l * 1024 * 2432, 2432, 0, 1024, 384, ws + WS_WQ + (size_t)l * MiB, 1024, false);
        TRJOB((const float*)a->in[31] + (size_t)l * 1024 * 2432, 2432, 384, 1024, 2048, ws + WS_WZ + (size_t)l * 4 * MiB, 1024, false);
        TRJOB_((const float*)a->in[33] + (size_t)l * 384 * 3072, 3072, 0, 384, 3072, ws + WS_WUQ + (size_t)l * (5 * MiB / 2), 384, false, true);
        TRJOB((const float*)a->in[34] + (size_t)l * 2048 * 1024, 1024, 0, 2048, 1024, ws + WS_WBO + (size_t)l * 4 * MiB, 2048, false);
    }
    TRJOB((const float*)a->in[17], 32, 0, 1024, 32, ws + WS_WIN + WIN_L + 17 * MiB, 1024, false);
    TRJOB((const float*)a->in[18], 2048, 0, 32, 2048, ws + WS_W2 + (size_t)4 * (MiB / 2), 128, true);
    TRJOB((const float*)a->in[26], 320, 0, 1024, 320, ws + WS_WDKV, 1024, false);
    TRJOB((const float*)a->in[28], 2048, 0, 256, 2048, ws + WS_WUK, 256, false);
    TRJOB((const float*)a->in[29], 2048, 0, 256, 2048, ws + WS_WUV, 256, false);
    { const f32x4* xs = (const f32x4*)a->in[1]; f32x4* X4 = (f32x4*)(ws + WS_X) + (size_t)MP * 256;
      for (int i = (F.bid * NTHR + F.wave * 64 + LANE); i < 256 * 256; i += F.NT) X4[i] = i < DEC_BATCH * 256 ? xs[i] : (f32x4){0.f, 0.f, 0.f, 0.f}; }
    { float* T = (float*)(ws + WS_ROPE);
      for (int i = (F.bid * NTHR + F.wave * 64 + LANE); i < 2049 * 32; i += F.NT) { const int p = i >> 5, f = i & 31; const double pos = p < 2048 ? (double)p : 8192.0;
          const double ang = pos * (double)exp2f(-(float)f * (13.287712379549449f / 32.0f)); T[2 * i] = (float)cos(ang); T[2 * i + 1] = (float)sin(ang); } }
}

__device__ __forceinline__ void load_row(const float* row, int lane, f32x4 (&v)[4]) {
#pragma unroll
    for (int j = 0; j < 4; ++j) v[j] = ((const f32x4*)row)[lane + 64 * j];
}
__device__ __forceinline__ float row_rs(const f32x4 (&v)[4]) {
    float s = 0.f;
#pragma unroll
    for (int j = 0; j < 4; ++j) s += (v[j].x * v[j].x + v[j].y * v[j].y) + (v[j].z * v[j].z + v[j].w * v[j].w);
    return 1.0f / sqrtf(wave_sum(s) * (1.0f / 1024.0f) + NORM_EPS);
}
__device__ __forceinline__ void norm_rows_bf16(Frame& F, const float* X, const float* w, bf16* O) {
    f32x4 w4[4]; load_row(w, LANE, w4);
    for (int m = F.gw; m < MT; m += F.NGW) { f32x4 x[4]; load_row(X + (size_t)m * 1024, LANE, x); const float rs = row_rs(x);
#pragma unroll
        for (int j = 0; j < 4; ++j) { const f32x4 h = x[j] * rs * w4[j]; v2u o; o.x = pk2(h.x, h.y); o.y = pk2(h.z, h.w); *(v2u*)(O + (size_t)m * 1024 + 4 * LANE + 256 * j) = o; } }
}

__device__ __forceinline__ void norm2_rows_bf16(Frame& F, const float* X, const float* wa, bf16* Oa, const float* wb, bf16* Ob) {
    f32x4 a4[4], b4[4]; load_row(wa, LANE, a4); load_row(wb, LANE, b4);
    for (int m = F.gw; m < MT; m += F.NGW) { f32x4 x[4]; load_row(X + (size_t)m * 1024, LANE, x); const float rs = row_rs(x);
#pragma unroll
        for (int j = 0; j < 4; ++j) { const f32x4 xs = x[j] * rs, ha = xs * a4[j], hb = xs * b4[j]; v2u o; o.x = pk2(ha.x, ha.y); o.y = pk2(ha.z, ha.w); *(v2u*)(Oa + (size_t)m * 1024 + 4 * LANE + 256 * j) = o;
            o.x = pk2(hb.x, hb.y); o.y = pk2(hb.z, hb.w); *(v2u*)(Ob + (size_t)m * 1024 + 4 * LANE + 256 * j) = o; } }
}

__device__ __forceinline__ void a1_prepass(Frame& F, cargs a, int l) {
    const float* Xw = (const float*)(F.ws + WS_X); const float* X = l == 0 ? (const float*)a->in[0] : Xw;
    const float* nw = (const float*)a->in[7] + l * 1024; const float* mix = (const float*)a->in[8] + l * 6 * 1024; const float* sshift = (const float*)a->in[3] + (size_t)l * DEC_BATCH * 1024;
    f32x4 w4[4]; load_row(nw, LANE, w4);
    LAS f32x4* mxl = (LAS f32x4*)F.lds;
    for (int i = F.wave * 64 + LANE; i < 6 * 256; i += NTHR) mxl[i] = ((const f32x4*)mix)[i];
    __syncthreads();
    for (int m = F.gw; m < MT; m += F.NGW) {
        f32x4 x[4], h[4], hp[4]; load_row((m < MP ? X : Xw) + (size_t)m * 1024, LANE, x); const float rs = row_rs(x);
#pragma unroll
        for (int j = 0; j < 4; ++j) { h[j] = x[j] * rs * w4[j]; hp[j] = (f32x4){0.f, 0.f, 0.f, 0.f}; }
        if (m < MP) { if ((m & (SEQ - 1)) != 0) { f32x4 xq[4]; load_row(X + (size_t)(m - 1) * 1024, LANE, xq); const float rq = row_rs(xq);
#pragma unroll
                for (int j = 0; j < 4; ++j) hp[j] = xq[j] * rq * w4[j]; } }
        else if (m < MP + DEC_BATCH) load_row(sshift + (size_t)(m - MP) * 1024, LANE, hp);
#pragma unroll
        for (int p = 0; p < 6; ++p) { bf16* O = (bf16*)(F.ws + WS_AM + (size_t)p * AM_STRIDE) + (size_t)m * 1024;
#pragma unroll
            for (int j = 0; j < 4; ++j) { const f32x4 mx = mxl[p * 256 + LANE + 64 * j]; const f32x4 o = h[j] + (hp[j] - h[j]) * mx;
                v2u w; w.x = pk2(o.x, o.y); w.y = pk2(o.z, o.w); *(v2u*)(O + 4 * LANE + 256 * j) = w; } }
        float* so = nullptr;
        if (m < MP) { if ((m & (SEQ - 1)) == SEQ - 1) so = F.out + O_SHP + (size_t)(l * BATCH + (m >> 11)) * 1024; }
        else if (m < MP + DEC_BATCH) so = F.out + O_SHS + (size_t)(l * DEC_BATCH + (m - MP)) * 1024;
        if (so) {
#pragma unroll
            for (int j = 0; j < 4; ++j) ((f32x4*)so)[LANE + 64 * j] = h[j]; }
    }
}

typedef float f32x2 __attribute__((ext_vector_type(2)));
__device__ __forceinline__ void unpack8(v4u u, float (&f)[8]) { f[0] = bflo(u.x); f[1] = bfhi(u.x); f[2] = bflo(u.y); f[3] = bfhi(u.y); f[4] = bflo(u.z); f[5] = bfhi(u.z); f[6] = bflo(u.w); f[7] = bfhi(u.w); }
constexpr int FS_TS = 16, FS_Y = FS_TS * 6 * 64 * 4, FS_Z = FS_Y + FS_TS * 64 * 4, FS_BON = FS_Z + FS_TS * 64 * 2, FS_BH = FS_BON + 128, FS_BUF = 2 * FS_BH;
static_assert(2 * FS_BUF <= RING_BYTES && FS_BH % 16 == 0, "fused scan LDS");
template <int CTRL> __device__ __forceinline__ float dppf(float v) { return __builtin_bit_cast(float, __builtin_amdgcn_update_dpp(0, __builtin_bit_cast(int, v), CTRL, 0xF, 0xF, false)); }
__device__ __forceinline__ float wave_sum_fast(float v) {
    v += dppf<0xB1>(v); v += dppf<0x4E>(v); v += dppf<0x124>(v); v += dppf<0x128>(v);
    const int iv = __builtin_bit_cast(int, v);
    return (__builtin_bit_cast(float, __builtin_amdgcn_readlane(iv, 0)) + __builtin_bit_cast(float, __builtin_amdgcn_readlane(iv, 16))) + (__builtin_bit_cast(float, __builtin_amdgcn_readlane(iv, 32)) + __builtin_bit_cast(float, __builtin_amdgcn_readlane(iv, 48)));
}
struct HeadPrm { float w0, a0, v0, kk, ka, rk, lnw, lnb; };
__device__ __forceinline__ float frcp(float x) { return __builtin_amdgcn_rcpf(x); }
__device__ __forceinline__ float fsig(float x) { return __builtin_amdgcn_rcpf(1.0f + __builtin_amdgcn_exp2f(-1.4426950408889634f * x)); }
__device__ __forceinline__ float wkv_step_lds(f32x2 (&S)[32], const LAS float* op, int lane) {
    const LAS f32x4* a4 = (const LAS f32x4*)op; const LAS f32x4* w4 = a4 + 16; const LAS f32x4* b4 = a4 + 32; const LAS f32x4* k4 = a4 + 48; const LAS f32x4* r4 = a4 + 64;
    const float vv = op[320 + lane];
    f32x2 s0 = (f32x2){0.f, 0.f}, s1 = s0;
#pragma unroll
    for (int q = 0; q < 16; ++q) { const f32x4 a = a4[q]; s0 += S[2 * q] * (f32x2){a.x, a.y}; s1 += S[2 * q + 1] * (f32x2){a.z, a.w}; }
    const f32x2 st = s0 + s1; const float sa = st.x + st.y; const f32x2 sa2 = (f32x2){sa, sa}, vv2 = (f32x2){vv, vv};
    f32x2 y0 = (f32x2){0.f, 0.f}, y1 = y0;
#pragma unroll
    for (int q = 0; q < 16; ++q) { const f32x4 w = w4[q], b = b4[q], k = k4[q], r = r4[q];
        S[2 * q] = S[2 * q] * (f32x2){w.x, w.y} + (sa2 * (f32x2){b.x, b.y} + vv2 * (f32x2){k.x, k.y}); y0 += S[2 * q] * (f32x2){r.x, r.y};
        S[2 * q + 1] = S[2 * q + 1] * (f32x2){w.z, w.w} + (sa2 * (f32x2){b.z, b.w} + vv2 * (f32x2){k.z, k.w}); y1 += S[2 * q + 1] * (f32x2){r.z, r.w}; }
    const f32x2 yt = y0 + y1; return yt.x + yt.y;
}
__device__ __forceinline__ void fs_prep_one(const HeadPrm& P, int l, float r, float k, float v, float dw, float da, float dv, float vf, LAS float* op, int lane, float& bon) {
    const float ia = da, w = __builtin_amdgcn_exp2f(dw);
    if (l) v = v + (vf - v) * dv;
    const float kk = k * P.kk, n2 = wave_sum_fast(kk * kk), inv = 1.0f / fmaxf(sqrtf(n2), 1e-12f), q = kk * inv, kp = k * (1.0f + (ia - 1.0f) * P.ka);
    bon = wave_sum_fast(r * kp * P.rk);
    op[lane] = -q; op[64 + lane] = w; op[128 + lane] = q * ia; op[192 + lane] = kp; op[256 + lane] = r; op[320 + lane] = v;
}
__device__ __forceinline__ float fs_post_one(const HeadPrm& P, float y, float vp, float z, float bon) {
    const float mu = wave_sum_fast(y) * (1.0f / 64.0f), d = y - mu, var = wave_sum_fast(d * d) * (1.0f / 64.0f);
    const float yn = d * __builtin_amdgcn_rsqf(var + GN_EPS) * P.lnw + P.lnb; return (yn + bon * vp) * (z * fsig(z));
}
__device__ __forceinline__ float ldbf(const bf16* p) { return bflo((unsigned)*p); }
__device__ __forceinline__ bf16 tobf(float x) { return __builtin_bit_cast(unsigned short, (__bf16)x); }
typedef short s16x4_t __attribute__((ext_vector_type(4)));
#define MF16(a_, b_, c_) __builtin_amdgcn_mfma_f32_16x16x16bf16_1k((a_), (b_), (c_), 0, 0, 0)
#define MF32(a_, b_, c_) __builtin_amdgcn_mfma_f32_16x16x32_bf16((a_), (b_), (c_), 0, 0, 0)
typedef __bf16 bf16x4_nat __attribute__((ext_vector_type(4)));
__device__ __forceinline__ s16x4_t cvt4(f32x4 v) { return __builtin_bit_cast(s16x4_t, __builtin_convertvector(v, bf16x4_nat)); }
constexpr int CK_TP = 144, CK_KP = 40;
constexpr int CK_AT = 0, CK_RT = CK_AT + 16 * CK_TP, CK_BH = CK_RT + 16 * CK_TP, CK_KH = CK_BH + 16 * CK_TP, CK_BHT = CK_KH + 16 * CK_TP, CK_KHT = CK_BHT + 64 * CK_KP, CK_VT = CK_KHT + 64 * CK_KP,
    CK_PC = CK_VT + 64 * CK_KP, CK_OPB = CK_PC + 256;
constexpr int RG_VP = 0, RG_Z = 2048, RG_BON = 4096, RG_SZ = 4224;
constexpr int BH_OPB = 0, BH_RING = 2 * CK_OPB, BH_Y = BH_RING + 3 * RG_SZ, BH_LW = BH_Y + 2 * 4096, BH_PRM = BH_LW + 4096, BH_SZ = BH_PRM + 6 * 256;
static_assert(2 * BH_SZ <= RING_BYTES && BH_SZ % 16 == 0 && CK_OPB % 16 == 0, "chunked scan LDS");
typedef short v4i16_ck __attribute__((ext_vector_type(4)));
__device__ __forceinline__ s16x4_t ck_tr(const LAS unsigned char* p) { return __builtin_bit_cast(s16x4_t, __builtin_amdgcn_ds_read_tr16_b64_v4i16((LAS v4i16_ck*)p)); }
__device__ __forceinline__ void ck_scan_chunk(f32x4 (&ST)[4][4], const LAS unsigned char* ob, const LAS unsigned char* vpb, LAS float* yb, int c16, int g) {
    const f32x4 zero4 = (f32x4){0.f, 0.f, 0.f, 0.f};
    bf16x8 at[2], rt[2], bh[2], kh[2];
#pragma unroll
    for (int ks = 0; ks < 2; ++ks) { const int o = c16 * CK_TP + 16 * g + 64 * ks;
        at[ks] = *(const LAS bf16x8*)(ob + CK_AT + o); rt[ks] = *(const LAS bf16x8*)(ob + CK_RT + o); bh[ks] = *(const LAS bf16x8*)(ob + CK_BH + o); kh[ks] = *(const LAS bf16x8*)(ob + CK_KH + o); }
    f32x4 qN = zero4, qL = zero4, qMk = zero4, qNbr = zero4, qNkr = zero4;
#pragma unroll
    for (int ks = 0; ks < 2; ++ks) { qN = MF32(bh[ks], at[ks], qN); qL = MF32(at[ks], bh[ks], qL); qMk = MF32(kh[ks], at[ks], qMk); qNbr = MF32(bh[ks], rt[ks], qNbr); qNkr = MF32(kh[ks], rt[ks], qNkr); }
    f32x4 Id;
#pragma unroll
    for (int r = 0; r < 4; ++r) { const int row = 4 * g + r; Id[r] = row == c16 ? 1.f : 0.f;
        if (!(row < c16)) { qN[r] = 0.f; qMk[r] = 0.f; }
        if (!(row <= c16)) { qNbr[r] = 0.f; qNkr[r] = 0.f; }
        if (!(c16 < row)) qL[r] = 0.f; }
    const s16x4_t aN = cvt4(qN), aL = cvt4(qL), aMk = cvt4(qMk), aNbr = cvt4(qNbr), aNkr = cvt4(qNkr);
    const f32x4 n2 = MF16(aL, aN, zero4), l2 = MF16(aN, aL, zero4);
    const s16x4_t aN2 = cvt4(n2), aL2 = cvt4(l2);
    const f32x4 n4 = MF16(aL2, aN2, zero4), l4 = MF16(aN2, aL2, zero4);
    const f32x4 n8 = MF16(cvt4(l4), cvt4(n4), zero4);
    const f32x4 p1t = MF16(cvt4(n2 + Id), cvt4(qL + Id), zero4);
    const f32x4 p2 = MF16(cvt4(l4 + Id), cvt4(n8 + Id), zero4);
    const s16x4_t aT = cvt4(MF16(cvt4(p1t), cvt4(p2), zero4));
    s16x4_t af[4], rf[4], bfr[4], kfr[4], vtr[4]; f32x4 pc[4]; s16x4_t Sb[4];
#pragma unroll
    for (int ki = 0; ki < 4; ++ki) { const int o = c16 * CK_TP + (16 * ki + 4 * g) * 2; af[ki] = *(const LAS s16x4_t*)(ob + CK_AT + o); rf[ki] = *(const LAS s16x4_t*)(ob + CK_RT + o);
        const int o2 = (4 * g + (c16 >> 2)) * CK_TP + (16 * ki + 4 * (c16 & 3)) * 2; bfr[ki] = ck_tr(ob + CK_BH + o2); kfr[ki] = ck_tr(ob + CK_KH + o2);
        vtr[ki] = ck_tr(vpb + (4 * g + (c16 >> 2)) * 128 + (16 * ki + 4 * (c16 & 3)) * 2);
        pc[ki] = *(const LAS f32x4*)(ob + CK_PC + (16 * ki + 4 * g) * 4); }
    f32x4 yt[4];
#pragma unroll
    for (int vi = 0; vi < 4; ++vi) {
        f32x4 xt = zero4, y0 = zero4;
#pragma unroll
        for (int ki = 0; ki < 4; ++ki) { Sb[ki] = cvt4(ST[ki][vi]); xt = MF16(af[ki], Sb[ki], xt); y0 = MF16(rf[ki], Sb[ki], y0); }
        const s16x4_t vt = vtr[vi];
        xt = MF16(aMk, vt, xt);
        const s16x4_t ub = cvt4(MF16(aT, cvt4(xt), zero4));
        y0 = MF16(aNbr, ub, y0); yt[vi] = MF16(aNkr, vt, y0);
#pragma unroll
        for (int ki = 0; ki < 4; ++ki) { ST[ki][vi] = MF16(bfr[ki], ub, ST[ki][vi]); ST[ki][vi] = MF16(kfr[ki], vt, ST[ki][vi]); ST[ki][vi] *= pc[ki]; }
    }
#pragma unroll
    for (int vi = 0; vi < 4; ++vi)
#pragma unroll
        for (int r = 0; r < 4; ++r) yb[(4 * g + r) * 64 + 16 * vi + c16] = yt[vi][r];
}
__device__ __forceinline__ void a5_fused(Frame& F, cargs a, int l) {
    unsigned char* ws = F.ws; const int lane = F.lane;
    const bf16* R = (const bf16*)(ws + WS_R); const bf16* K = (const bf16*)(ws + WS_K); const bf16* V = (const bf16*)(ws + (l ? WS_V1 : WS_V0)); const bf16* VF = (const bf16*)(ws + WS_V0); const bf16* Z = (const bf16*)(ws + WS_Z);
    const bf16* DW = (const bf16*)(ws + WS_WD); const bf16* DA = (const bf16*)(ws + WS_IA); const bf16* DV = (const bf16*)(ws + WS_VG); bf16* G = (bf16*)(ws + WS_G);
    const float* pw0 = (const float*)a->in[10] + l * 2048; const float* pa0 = (const float*)a->in[13] + l * 2048; const float* pv0 = (const float*)a->in[16]; const float* pkk = (const float*)a->in[19] + l * 2048;
    const float* pka = (const float*)a->in[20] + l * 2048; const float* prk = (const float*)a->in[21] + l * 2048; const float* plw = (const float*)a->in[22] + l * 2048; const float* plb = (const float*)a->in[23] + l * 2048;
    constexpr int NCH = SEQ / 16;
    for (int pr = F.bid; pr < BATCH * A_HEADS / 2; pr += F.G) { const int bh0 = 2 * pr;
        const int role = F.wave >> 1, hb = F.wave & 1, bh = bh0 + hb, b = bh >> 5, hh = bh & 31, ch = hh * 64 + lane;
        LAS unsigned char* blk = F.lds + hb * BH_SZ;
        const size_t rowb = (size_t)b * SEQ; const int c16 = lane & 15, g = lane >> 4;
#define CK_BAR() do { asm volatile("s_waitcnt lgkmcnt(0)" ::: "memory"); __builtin_amdgcn_s_barrier(); asm volatile("" ::: "memory"); } while (0)
#define CKV_LOAD(cc, SET) do { const size_t ro = (rowb + (size_t)(cc) * 16) * 2048;     \
            _Pragma("unroll") for (int j = 0; j < 2; ++j) { SET##r[j] = ((const v4u*)(R + ro + voff_))[j]; SET##k[j] = ((const v4u*)(K + ro + voff_))[j]; SET##v[j] = ((const v4u*)(V + ro + voff_))[j]; SET##z[j] = ((const v4u*)(Z + ro + voff_))[j]; \
                SET##w[j] = ((const v4u*)(DW + ro + voff_))[j]; SET##a[j] = ((const v4u*)(DA + ro + voff_))[j]; if (l) { SET##d[j] = ((const v4u*)(DV + ro + voff_))[j]; SET##f[j] = ((const v4u*)(VF + ro + voff_))[j]; } } } while (0)
#define CKV_PREP(cc, SET) do { LAS unsigned char* ob = blk + BH_OPB + ((cc) & 1) * CK_OPB; LAS unsigned char* rg = blk + BH_RING + ((cc) % 3) * RG_SZ; \
            float kk_[16], kp_[16], ia_[16], lw_[16]; float n2 = 0.f, bon = 0.f; \
            _Pragma("unroll") for (int j = 0; j < 2; ++j) { float k8[8], a8[8], r8[8], w8[8]; unpack8(SET##k[j], k8); unpack8(SET##a[j], a8); unpack8(SET##r[j], r8); unpack8(SET##w[j], w8); \
                _Pragma("unroll") for (int h = 0; h < 2; ++h) { const f32x4 pkk_ = prm[3 * 16 + 4 * vq_ + 2 * j + h], pka_ = prm[4 * 16 + 4 * vq_ + 2 * j + h], prk_ = prm[5 * 16 + 4 * vq_ + 2 * j + h]; \
                    _Pragma("unroll") for (int e = 0; e < 4; ++e) { const int i = 8 * j + 4 * h + e, e8 = 4 * h + e; const float ia = a8[e8]; ia_[i] = ia; lw_[i] = w8[e8]; \
                        const float kk = k8[e8] * pkk_[e]; kk_[i] = kk; n2 += kk * kk; const float kp = k8[e8] * (1.0f + (ia - 1.0f) * pka_[e]); kp_[i] = kp; bon += r8[e8] * kp * prk_[e]; } } } \
            n2 += dppf<0xB1>(n2); n2 += dppf<0x4E>(n2); bon += dppf<0xB1>(bon); bon += dppf<0x4E>(bon); const float inv = __builtin_amdgcn_rsqf(fmaxf(n2, 1e-24f)); \
              \
            _Pragma("unroll") for (int j = 0; j < 4; ++j) lwp[vt_ * 16 + 4 * vq_ + j] = (f32x4){lw_[4 * j], lw_[4 * j + 1], lw_[4 * j + 2], lw_[4 * j + 3]}; \
            LDS_WAIT(); asm volatile("" ::: "memory"); \
            { float c_[16]; _Pragma("unroll") for (int t = 0; t < 16; ++t) c_[t] = ((const LAS float*)lwp)[t * 64 + lane]; \
              _Pragma("unroll") for (int t = 1; t < 16; ++t) c_[t] += c_[t - 1]; \
              _Pragma("unroll") for (int t = 0; t < 16; ++t) ((LAS float*)lwp)[t * 64 + lane] = c_[t]; } \
            LDS_WAIT(); asm volatile("" ::: "memory"); \
            float lp_[16]; _Pragma("unroll") for (int j = 0; j < 4; ++j) { const f32x4 v = lwp[vt_ * 16 + 4 * vq_ + j]; lp_[4 * j] = v.x; lp_[4 * j + 1] = v.y; lp_[4 * j + 2] = v.z; lp_[4 * j + 3] = v.w; } \
            v4u oa[2], orr[2], ob_[2], ok[2], ov[2]; \
            _Pragma("unroll") for (int j = 0; j < 2; ++j) { float r8[8], v8[8]; unpack8(SET##r[j], r8); unpack8(SET##v[j], v8); \
                if (l) { float d8[8], f8[8]; unpack8(SET##d[j], d8); unpack8(SET##f[j], f8); _Pragma("unroll") for (int h = 0; h < 2; ++h) { \
                        _Pragma("unroll") for (int e = 0; e < 4; ++e) { const int e8 = 4 * h + e; v8[e8] = v8[e8] + (f8[e8] - v8[e8]) * d8[e8]; } } } \
                _Pragma("unroll") for (int e = 0; e < 8; e += 2) { const int i = 8 * j + e; \
                    const float P0 = __builtin_amdgcn_exp2f(lp_[i]), P1 = __builtin_amdgcn_exp2f(lp_[i + 1]), R0 = __builtin_amdgcn_exp2f(-lp_[i]), R1 = __builtin_amdgcn_exp2f(-lp_[i + 1]); \
                    const float M0 = __builtin_amdgcn_exp2f(lp_[i] - lw_[i]), M1 = __builtin_amdgcn_exp2f(lp_[i + 1] - lw_[i + 1]), q0 = kk_[i] * inv, q1 = kk_[i + 1] * inv; \
                    oa[j][e >> 1] = (unsigned)tobf(-q0 * M0) | ((unsigned)tobf(-q1 * M1) << 16); orr[j][e >> 1] = (unsigned)tobf(r8[e] * P0) | ((unsigned)tobf(r8[e + 1] * P1) << 16); \
                    ob_[j][e >> 1] = (unsigned)tobf(q0 * ia_[i] * R0) | ((unsigned)tobf(q1 * ia_[i + 1] * R1) << 16); ok[j][e >> 1] = (unsigned)tobf(kp_[i] * R0) | ((unsigned)tobf(kp_[i + 1] * R1) << 16); \
                    ov[j][e >> 1] = (unsigned)tobf(v8[e]) | ((unsigned)tobf(v8[e + 1]) << 16); \
                    if (vt_ == 15) { ((LAS float*)(ob + CK_PC))[16 * vq_ + i] = P0; ((LAS float*)(ob + CK_PC))[16 * vq_ + i + 1] = P1; } } } \
            _Pragma("unroll") for (int j = 0; j < 2; ++j) { const int o = vt_ * CK_TP + 32 * vq_ + 16 * j; *(LAS v4u*)(ob + CK_AT + o) = oa[j]; *(LAS v4u*)(ob + CK_RT + o) = orr[j]; *(LAS v4u*)(ob + CK_BH + o) = ob_[j]; *(LAS v4u*)(ob + CK_KH + o) = ok[j]; \
                *(LAS v4u*)(rg + RG_VP + vt_ * 128 + 32 * vq_ + 16 * j) = ov[j]; *(LAS v4u*)(rg + RG_Z + vt_ * 128 + 32 * vq_ + 16 * j) = SET##z[j]; } \
            if (vq_ == 0) ((LAS float*)(rg + RG_BON))[vt_] = bon; } while (0)
#define CK_POST(cc) do { const LAS unsigned char* rg = blk + BH_RING + ((cc) % 3) * RG_SZ; const LAS float* yb = (const LAS float*)(blk + BH_Y + ((cc) & 1) * 4096) + pt_ * 64 + 16 * pq_; \
            float y_[16], vp_[16], z_[16]; \
            _Pragma("unroll") for (int j = 0; j < 4; ++j) { const f32x4 v = ((const LAS f32x4*)yb)[j]; y_[4 * j] = v.x; y_[4 * j + 1] = v.y; y_[4 * j + 2] = v.z; y_[4 * j + 3] = v.w; } \
            _Pragma("unroll") for (int j = 0; j < 2; ++j) { float t8[8]; unpack8(((const LAS v4u*)(rg + RG_VP + pt_ * 128 + 32 * pq_))[j], t8); _Pragma("unroll") for (int e = 0; e < 8; ++e) vp_[8 * j + e] = t8[e]; \
                unpack8(((const LAS v4u*)(rg + RG_Z + pt_ * 128 + 32 * pq_))[j], t8); _Pragma("unroll") for (int e = 0; e < 8; ++e) z_[8 * j + e] = t8[e]; } \
            const float bon = ((const LAS float*)(rg + RG_BON))[pt_]; float sm = 0.f; \
            _Pragma("unroll") for (int j = 0; j < 16; ++j) sm += y_[j]; \
            sm += dppf<0xB1>(sm); sm += dppf<0x4E>(sm); const float mu = sm * (1.0f / 64.0f); float sq = 0.f; \
            _Pragma("unroll") for (int j = 0; j < 16; ++j) { y_[j] -= mu; sq += y_[j] * y_[j]; } \
            sq += dppf<0xB1>(sq); sq += dppf<0x4E>(sq); const float rstd = __builtin_amdgcn_rsqf(sq * (1.0f / 64.0f) + GN_EPS); \
            v4u o_[2]; \
            _Pragma("unroll") for (int j = 0; j < 16; j += 2) { const float g0 = (y_[j] * rstd * lw_[j] + lb_[j] + bon * vp_[j]) * (z_[j] * fsig(z_[j])), g1 = (y_[j + 1] * rstd * lw_[j + 1] + lb_[j + 1] + bon * vp_[j + 1]) * (z_[j + 1] * fsig(z_[j + 1])); \
                o_[j >> 3][(j >> 1) & 3] = (unsigned)tobf(g0) | ((unsigned)tobf(g1) << 16); } \
            v4u* gp = (v4u*)(G + (rowb + (size_t)(cc) * 16 + pt_) * 2048 + hh * 64 + 16 * pq_); gp[0] = o_[0]; gp[1] = o_[1]; } while (0)
        typedef unsigned short us2 __attribute__((ext_vector_type(2)));
        if (role == 0) { f32x4 ST[4][4];
#pragma unroll
            for (int i = 0; i < 4; ++i)
#pragma unroll
                for (int j = 0; j < 4; ++j) ST[i][j] = (f32x4){0.f, 0.f, 0.f, 0.f};
            CK_BAR();
            for (int c = 0; c < NCH; ++c) { ck_scan_chunk(ST, blk + BH_OPB + (c & 1) * CK_OPB, blk + BH_RING + (c % 3) * RG_SZ + RG_VP, (LAS float*)(blk + BH_Y + (c & 1) * 4096), c16, g); CK_BAR(); }
            float* so = F.out + O_WKVP + ((size_t)(l * BATCH + b) * A_HEADS + hh) * 4096;
#pragma unroll
            for (int ki = 0; ki < 4; ++ki)
#pragma unroll
                for (int vi = 0; vi < 4; ++vi) *(f32x4*)(so + (16 * vi + c16) * 64 + 16 * ki + 4 * g) = ST[ki][vi]; }
        else if (role == 1) { const int ln1 = lane_id(), vt_ = ln1 >> 2, vq_ = ln1 & 3; const unsigned voff_ = (unsigned)(vt_ * 2048 + hh * 64 + 16 * vq_); LAS f32x4* lwp = (LAS f32x4*)(blk + BH_LW); const LAS f32x4* prm = (const LAS f32x4*)(blk + BH_PRM);
            { const int ln = lane_id(), c1 = hh * 64 + ln; LAS float* pf = (LAS float*)(blk + BH_PRM); pf[ln] = pw0[c1]; pf[64 + ln] = pa0[c1]; pf[128 + ln] = l ? pv0[c1] : 0.f; pf[192 + ln] = pkk[c1]; pf[256 + ln] = pka[c1]; pf[320 + ln] = prk[c1]; LDS_WAIT(); asm volatile("" ::: "memory"); }
            v4u Ar[2], Ak[2], Av[2], Az[2], Aw[2], Aa[2], Ad[2], Af[2];
#pragma unroll
            for (int j = 0; j < 2; ++j) { Ad[j] = (v4u){0u, 0u, 0u, 0u}; Af[j] = Ad[j]; }
            CKV_LOAD(0, A); CKV_PREP(0, A); CKV_LOAD(1, A); CK_BAR();
            for (int c = 0; c < NCH; ++c) { if (c + 1 < NCH) { CKV_PREP(c + 1, A); if (c + 2 < NCH) CKV_LOAD(c + 2, A); } CK_BAR(); } }
        else if (role == 3) {
            const int ln3 = lane_id(), vt_ = ln3 >> 2, vq_ = ln3 & 3; const unsigned voff_ = (unsigned)(vt_ * 2048 + hh * 64 + 16 * vq_);
            v4u Ar[2], Ak[2], Av[2], Az[2], Aw[2], Aa[2], Ad[2], Af[2];
#pragma unroll
            for (int j = 0; j < 2; ++j) { Ad[j] = (v4u){0u, 0u, 0u, 0u}; Af[j] = Ad[j]; }
            CKV_LOAD(2, A); CK_BAR();
            for (int c = 0; c < NCH; ++c) {
#pragma unroll
                for (int j = 0; j < 2; ++j) asm volatile("" :: "v"(Ar[j]), "v"(Ak[j]), "v"(Av[j]), "v"(Az[j]), "v"(Aw[j]), "v"(Aa[j]), "v"(Ad[j]), "v"(Af[j]));
                if (c + 3 < NCH) CKV_LOAD(c + 3, A);
                CK_BAR(); } }
        else { const int ln2 = lane_id(), pt_ = ln2 >> 2, pq_ = ln2 & 3; float lw_[16], lb_[16];
#pragma unroll
            for (int j = 0; j < 16; ++j) { lw_[j] = plw[hh * 64 + 16 * pq_ + j]; lb_[j] = plb[hh * 64 + 16 * pq_ + j]; }
            CK_BAR();
            for (int c = 0; c < NCH; ++c) { if (c >= 1) CK_POST(c - 1); CK_BAR(); }
            CK_POST(NCH - 1); }
        __syncthreads();
#undef CK_PREP
#undef CKV_LOAD
#undef CKV_PREP
#undef CK_BAR
#undef CK_POST
    }
    const float* stt = (const float*)a->in[2] + (size_t)l * DEC_BATCH * A_HEADS * 4096;
    LAS float* sop = (LAS float*)(F.lds + F.wave * 2048);
    for (int it = F.gw; it < DEC_BATCH * A_HEADS; it += F.NGW) { const int b = it >> 5, hh = it & 31, ch = hh * 64 + lane; const size_t o = (size_t)(MP + b) * 2048 + ch;
        HeadPrm P; P.w0 = pw0[ch]; P.a0 = pa0[ch]; P.v0 = l ? pv0[ch] : 0.f; P.kk = pkk[ch]; P.ka = pka[ch]; P.rk = prk[ch]; P.lnw = plw[ch]; P.lnb = plb[ch];
        const float z = ldbf(Z + o); float bon;
        fs_prep_one(P, l, ldbf(R + o), ldbf(K + o), ldbf(V + o), ldbf(DW + o), ldbf(DA + o), l ? ldbf(DV + o) : 0.f, l ? ldbf(VF + o) : 0.f, sop, lane, bon);
        LDS_WAIT(); asm volatile("" ::: "memory");
        f32x2 S[32]; const float* si = stt + (size_t)it * 4096 + lane * 64;
#pragma unroll
        for (int k = 0; k < 32; k += 2) { const f32x4 v = *(const f32x4*)(si + 2 * k); S[k] = (f32x2){v.x, v.y}; S[k + 1] = (f32x2){v.z, v.w}; }
        const float y = wkv_step_lds(S, sop, lane), vp = sop[320 + lane];
        float* so = F.out + O_WKVS + ((size_t)l * DEC_BATCH * A_HEADS + it) * 4096 + lane * 64;
#pragma unroll
        for (int k = 0; k < 32; k += 2) *(f32x4*)(so + 2 * k) = (f32x4){S[k].x, S[k].y, S[k + 1].x, S[k + 1].y};
        G[o] = (bf16)f2bf(fs_post_one(P, y, vp, z, bon));
        LDS_WAIT(); asm volatile("" ::: "memory");
    }
#undef FS_PREP
#undef FS_POST
}

__device__ __forceinline__ void final_norm(Frame& F, cargs a) {
    const float* X = (const float*)(F.ws + WS_X); f32x4 w4[4]; load_row((const float*)a->in[35], LANE, w4);
    for (int m = F.gw; m < MP + DEC_BATCH; m += F.NGW) { f32x4 x[4]; load_row(X + (size_t)m * 1024, LANE, x); const float rs = row_rs(x);
        float* o = m < MP ? F.out + O_YP + (size_t)m * 1024 : F.out + O_YS + (size_t)(m - MP) * 1024;
#pragma unroll
        for (int j = 0; j < 4; ++j) ((f32x4*)o)[LANE + 64 * j] = x[j] * rs * w4[j]; }
}
__device__ __forceinline__ void b0c_kvpost(Frame& F, cargs a) {
    unsigned char* ws = F.ws; const float* KVR = (const float*)(ws + WS_KVR); bf16* CK = (bf16*)(ws + WS_CKVB); bf16* KP = (bf16*)(ws + WS_KPEB); const float* ROPE = (const float*)(ws + WS_ROPE);
    const f32x4 w4 = ((const f32x4*)a->in[27])[F.lane];
    for (int m = F.gw; m < MP + DEC_BATCH; m += F.NGW) { const float* row = KVR + (size_t)m * 320;
        const f32x4 v = ((const f32x4*)row)[F.lane]; const float ss = wave_sum((v.x * v.x + v.y * v.y) + (v.z * v.z + v.w * v.w));
        const float rs = 1.0f / sqrtf(ss * (1.0f / 256.0f) + NORM_EPS); const f32x4 c = v * rs * w4;
        float* oc = m < MP ? F.out + O_CKVP + (size_t)m * 256 : F.out + O_CKVS + (size_t)(m - MP) * 256; float* ok = m < MP ? F.out + O_KPEP + (size_t)m * 64 : F.out + O_KPES + (size_t)(m - MP) * 64;
        ((f32x4*)oc)[F.lane] = c; v2u pw; pw.x = pk2(c.x, c.y); pw.y = pk2(c.z, c.w); *(v2u*)(CK + (size_t)m * 256 + 4 * F.lane) = pw;
        if (F.lane < 32) { const int i = F.lane, p = m < MP ? (m & (SEQ - 1)) : SEQ; const float x1 = row[256 + i], x2 = row[288 + i], cs = ROPE[(p * 32 + i) * 2], sn = ROPE[(p * 32 + i) * 2 + 1];
            const float o1 = x1 * cs - x2 * sn, o2 = x2 * cs + x1 * sn; ok[i] = o1; ok[32 + i] = o2; *(unsigned*)(KP + (size_t)m * 64 + 2 * i) = pk2(o1, o2); }
    }
}
__device__ __forceinline__ void b1c_cq(Frame& F, cargs a, int l) {
    unsigned char* ws = F.ws; const float* QL = (const float*)(ws + WS_QL); bf16* CQ = (bf16*)(ws + WS_CQ); const float* w = (const float*)a->in[32] + l * 384;
    f32x2 w2[3];
#pragma unroll
    for (int j = 0; j < 3; ++j) w2[j] = *(const f32x2*)(w + 2 * F.lane + 128 * j);
    for (int m = F.gw; m < MT; m += F.NGW) { f32x2 v[3]; float ss = 0.f;
#pragma unroll
        for (int j = 0; j < 3; ++j) { v[j] = *(const f32x2*)(QL + (size_t)m * 384 + 2 * F.lane + 128 * j); ss += v[j].x * v[j].x + v[j].y * v[j].y; }
        const float rs = 1.0f / sqrtf(wave_sum(ss) * (1.0f / 384.0f) + NORM_EPS);
#pragma unroll
        for (int j = 0; j < 3; ++j) *(unsigned*)(CQ + (size_t)m * 384 + 2 * F.lane + 128 * j) = pk2(v[j].x * rs * w2[j].x, v[j].y * rs * w2[j].y); }
}
constexpr int AT_KP = 400, AT_VP = 136, AT_KBYTES = 64 * AT_KP, AT_VBYTES = 128 * AT_VP, AT_BUF = AT_KBYTES + AT_VBYTES;
__device__ __forceinline__ int crow(int r, int hi) { return (r & 3) + 8 * (r >> 2) + 4 * hi; }
typedef __bf16 bf16x8_nat __attribute__((ext_vector_type(8)));
typedef float f32x8 __attribute__((ext_vector_type(8)));
__device__ __forceinline__ bf16x8 pack8f(float a0, float a1, float a2, float a3, float a4, float a5, float a6, float a7) {
    return __builtin_bit_cast(bf16x8, __builtin_convertvector((f32x8){a0, a1, a2, a3, a4, a5, a6, a7}, bf16x8_nat)); }
__device__ __forceinline__ void attn_unit(Frame& F, int b, int hd, int qb) {
    unsigned char* ws = F.ws; const bf16* Q = (const bf16*)(ws + WS_Q);
    const bf16* Z = (const bf16*)(ws + WS_Z); bf16* G = (bf16*)(ws + WS_G);
    LAS unsigned char* Ks = F.lds; LAS unsigned char* Vs = F.lds + AT_KBYTES;
    const int lane = lane_id(), r32 = lane & 31, hi = lane >> 5, tid = F.wave * 64 + lane;
    const int qpos = qb * 256 + F.wave * 32 + r32; const size_t qrow = (size_t)b * SEQ + qpos;
    bf16x8 qf[12];
#pragma unroll
    for (int s = 0; s < 12; ++s) qf[s] = *(const bf16x8*)(Q + qrow * 3072 + hd * 192 + 16 * s + 8 * hi);
    f32x16 o[4];
#pragma unroll
    for (int d = 0; d < 4; ++d)
#pragma unroll
        for (int r = 0; r < 16; ++r) o[d][r] = 0.f;
    float mrow = -1e30f, lrow = 0.f;
    const int ntiles = 4 * qb + 4, wq0 = qb * 256 + F.wave * 32;
    const unsigned gK = (unsigned)((tid >> 4) * 4096 + (tid & 15) * 16), gP = (unsigned)((tid >> 3) * 128 + (tid & 7) * 16), gV = (unsigned)((tid >> 3) * (MP * 2) + (tid & 7) * 16);
    LAS unsigned char* lK = Ks + (tid >> 4) * AT_KP + (tid & 15) * 16; LAS unsigned char* lP = Ks + (tid >> 3) * AT_KP + 256 + (tid & 7) * 16; LAS unsigned char* lV = Vs + (tid >> 3) * AT_VP + (tid & 7) * 16;
    const unsigned char* kb0 = ws + WS_KN + ((size_t)b * SEQ * 2048 + hd * 128) * 2; const unsigned char* pb0 = ws + WS_KPEB + (size_t)b * SEQ * 128; const unsigned char* vb0 = ws + WS_VT + ((size_t)hd * 128 * MP + (size_t)b * SEQ) * 2;
    v4u pk_[3], pv_[2];
#define AT_FETCH(kt_) do { const unsigned char* kb = kb0 + (size_t)(kt_) * (64 * 4096); const unsigned char* pb = pb0 + (size_t)(kt_) * (64 * 128); const unsigned char* vb = vb0 + (size_t)(kt_) * 128; \
        pk_[0] = *(const v4u*)(kb + gK); pk_[1] = *(const v4u*)(kb + 32 * 4096 + gK); pk_[2] = *(const v4u*)(pb + gP); pv_[0] = *(const v4u*)(vb + gV); pv_[1] = *(const v4u*)(vb + (size_t)64 * MP * 2 + gV); } while (0)
    AT_FETCH(0);
    const LAS unsigned char* kA = Ks + r32 * AT_KP + hi * 16;
    const LAS unsigned char* vA = Vs + r32 * AT_VP + hi * 8;
#define AT_KF(st_) (*(const LAS bf16x8*)(kA + ((st_) & 1) * (32 * AT_KP) + ((st_) >> 1) * 32))
#define AT_VF(st_, j_) (*(const LAS v2u*)(vA + ((st_) & 3) * (32 * AT_VP) + ((st_) >> 2) * 32 + 16 * (j_)))
    constexpr int KD = 6, VD = 4;
    for (int kt = 0; kt < ntiles; ++kt) {
        __syncthreads();
        *(LAS v4u*)lK = pk_[0]; *(LAS v4u*)(lK + 32 * AT_KP) = pk_[1]; *(LAS v4u*)lP = pk_[2];
#pragma unroll
        for (int i = 0; i < 2; ++i) { *(LAS v2u*)(lV + i * 64 * AT_VP) = (v2u){pv_[i].x, pv_[i].y}; *(LAS v2u*)(lV + i * 64 * AT_VP + 8) = (v2u){pv_[i].z, pv_[i].w}; }
        __syncthreads();
        if (kt + 1 < ntiles) AT_FETCH(kt + 1);
        if (kt * 64 > wq0 + 31) continue;
        f32x16 s0, s1;
#pragma unroll
        for (int r = 0; r < 16; ++r) { s0[r] = 0.f; s1[r] = 0.f; }
        bf16x8 kf[8];
#pragma unroll
        for (int st = 0; st < KD; ++st) kf[st] = AT_KF(st);
#pragma unroll
        for (int st = 0; st < 24; ++st) {
            if (st + KD < 24) kf[(st + KD) & 7] = AT_KF(st + KD);
            if (st & 1) s1 = __builtin_amdgcn_mfma_f32_32x32x16_bf16(kf[st & 7], qf[st >> 1], s1, 0, 0, 0);
            else s0 = __builtin_amdgcn_mfma_f32_32x32x16_bf16(kf[st & 7], qf[st >> 1], s0, 0, 0, 0);
            __builtin_amdgcn_sched_barrier(0);
        }
        v2u vf[8][2];
#pragma unroll
        for (int st = 0; st < VD; ++st) { vf[st][0] = AT_VF(st, 0); vf[st][1] = AT_VF(st, 1); }
        __builtin_amdgcn_sched_barrier(0);
        if (kt * 64 + 63 > wq0) {
#pragma unroll
            for (int r = 0; r < 16; ++r) { const int key = kt * 64 + crow(r, hi); if (key > qpos) s0[r] = -__builtin_inff(); if (key + 32 > qpos) s1[r] = -__builtin_inff(); } }
        float tmax = s0[0];
#pragma unroll
        for (int r = 1; r < 16; ++r) tmax = fmaxf(tmax, s0[r]);
#pragma unroll
        for (int r = 0; r < 16; ++r) tmax = fmaxf(tmax, s1[r]);
        tmax = xor32_max(tmax);
        if (__builtin_amdgcn_ballot_w64(tmax > mrow + 8.0f) != 0ull) { const float mnew = fmaxf(mrow, tmax), alpha = __builtin_amdgcn_exp2f(mrow - mnew); mrow = mnew; lrow *= alpha;
#pragma unroll
            for (int d = 0; d < 4; ++d)
#pragma unroll
                for (int r = 0; r < 16; ++r) o[d][r] *= alpha; }
        float ps = 0.f;
#pragma unroll
        for (int r = 0; r < 16; ++r) { s0[r] = __builtin_amdgcn_exp2f(s0[r] - mrow); s1[r] = __builtin_amdgcn_exp2f(s1[r] - mrow); ps += s0[r] + s1[r]; }
        lrow += ps;
        bf16x8 pb[4];
        pb[0] = pack8f(s0[0], s0[1], s0[2], s0[3], s0[4], s0[5], s0[6], s0[7]); pb[1] = pack8f(s0[8], s0[9], s0[10], s0[11], s0[12], s0[13], s0[14], s0[15]);
        pb[2] = pack8f(s1[0], s1[1], s1[2], s1[3], s1[4], s1[5], s1[6], s1[7]); pb[3] = pack8f(s1[8], s1[9], s1[10], s1[11], s1[12], s1[13], s1[14], s1[15]);
        __builtin_amdgcn_sched_barrier(0);
#pragma unroll
        for (int st = 0; st < 16; ++st) {
            if (st + VD < 16) { vf[(st + VD) & 7][0] = AT_VF(st + VD, 0); vf[(st + VD) & 7][1] = AT_VF(st + VD, 1); }
            const v4u av = (v4u){vf[st & 7][0].x, vf[st & 7][0].y, vf[st & 7][1].x, vf[st & 7][1].y};
            o[st & 3] = __builtin_amdgcn_mfma_f32_32x32x16_bf16(__builtin_bit_cast(bf16x8, av), pb[st >> 2], o[st & 3], 0, 0, 0);
            __builtin_amdgcn_sched_barrier(0);
        }
    }
#undef AT_FETCH
#undef AT_KF
#undef AT_VF
    lrow = xor32_sum(lrow); const float inv = 1.0f / lrow;
    v2u zq[4][4];
#pragma unroll
    for (int d = 0; d < 4; ++d)
#pragma unroll
        for (int rg = 0; rg < 4; ++rg) zq[d][rg] = *(const v2u*)(Z + qrow * 2048 + hd * 128 + 32 * d + 8 * rg + 4 * hi);
    __builtin_amdgcn_sched_barrier(0);
#pragma unroll
    for (int d = 0; d < 4; ++d)
#pragma unroll
        for (int rg = 0; rg < 4; ++rg) { const int dd = 32 * d + 8 * rg + 4 * hi; const size_t off = qrow * 2048 + hd * 128 + dd;
            const v2u zz = zq[d][rg]; const float z0 = bflo(zz.x), z1 = bfhi(zz.x), z2 = bflo(zz.y), z3 = bfhi(zz.y);
            v2u w; w.x = pk2(o[d][4 * rg] * inv * (z0 * sigmoidf_(z0)), o[d][4 * rg + 1] * inv * (z1 * sigmoidf_(z1))); w.y = pk2(o[d][4 * rg + 2] * inv * (z2 * sigmoidf_(z2)), o[d][4 * rg + 3] * inv * (z3 * sigmoidf_(z3)));
            *(v2u*)(G + off) = w; }
}
__device__ __forceinline__ void b2a_attn_prompt(Frame& F) {
    if (F.wave < 4) __builtin_amdgcn_s_setprio(1);
    const int vcu = (F.G % 8 == 0) ? (F.bid % 8) * (F.G / 8) + F.bid / 8 : F.bid;
    for (int u = vcu; u < BATCH * B_HEADS * 4; u += F.G) { const int bh = u >> 2, qp = u & 3;
        for (int hf = 0; hf < 2; ++hf) attn_unit(F, bh >> 4, bh & 15, hf ? qp : 7 - qp); }
    __builtin_amdgcn_s_setprio(0);
    __syncthreads();
}

constexpr int DT_P = 656;
typedef short v4i16_t __attribute__((ext_vector_type(4)));
__device__ __forceinline__ void b2b_attn_sample(Frame& F, cargs a) {
    unsigned char* ws = F.ws; const float* cckv = (const float*)a->in[4]; const float* ckpe = (const float*)a->in[5]; const int* ptab = (const int*)a->in[6];
    const bf16* QA = (const bf16*)(ws + WS_QABS); float* OP = (float*)(ws + WS_OPART); float* ML = (float*)(ws + WS_ML);
    LAS unsigned char* T = F.lds;
    F.lane = lane_id();
    const int lane = F.lane, hcol = lane & 15, g = lane >> 4, tid = F.wave * 64 + lane, q4 = (lane & 15) >> 2, p4 = lane & 3;
    const bf16* Q = (const bf16*)(ws + WS_Q); const float* wuk = (const float*)a->in[28]; bf16* QAg = (bf16*)(ws + WS_QABS);
    LAS bf16* QAl = (LAS bf16*)(F.lds + 49152);
    for (int hu = F.bid; hu < DEC_BATCH * 2; hu += F.G) for (int si = 0; si < 4; ++si) { const int b = hu >> 1, sp = (hu & 1) * 4 + si;
      if (si == 0) {
        __syncthreads();
        for (int hh = 0; hh < 2; ++hh) { const int hd = 2 * F.wave + hh; const bf16* qn = Q + (size_t)(MP + b) * 3072 + hd * 192;
            float acc[4] = {0.f, 0.f, 0.f, 0.f};
            for (int n = 0; n < 128; n += 4) { const v2u qu = *(const v2u*)(qn + n); const f32x4 q4 = (f32x4){bflo(qu.x), bfhi(qu.x), bflo(qu.y), bfhi(qu.y)};
#pragma unroll
                for (int cc = 0; cc < 4; ++cc) { const f32x4 w4 = *(const f32x4*)(wuk + (size_t)(4 * lane + cc) * 2048 + hd * 128 + n); acc[cc] += (q4.x * w4.x + q4.y * w4.y) + (q4.z * w4.z + q4.w * w4.w); } }
            const v2u w = (v2u){pk2(acc[0], acc[1]), pk2(acc[2], acc[3])}; *(LAS v2u*)(QAl + hd * 320 + 4 * lane) = w;
            const bf16 rp = qn[128 + 2 * (lane & 31) + (lane >> 5)]; QAl[hd * 320 + 256 + lane] = rp;
            if ((hu & 1) == 0) { *(v2u*)(QAg + (size_t)(b * 16 + hd) * 320 + 4 * lane) = w; QAg[(size_t)(b * 16 + hd) * 320 + 256 + lane] = rp; } }
        __syncthreads(); }
        bf16x8 qf[10];
#pragma unroll
        for (int s = 0; s < 10; ++s) qf[s] = *(const LAS bf16x8*)(QAl + hcol * 320 + 32 * s + 8 * g);
        f32x4 o[2]; o[0] = (f32x4){0.f, 0.f, 0.f, 0.f}; o[1] = o[0]; float mrow = -1e30f, lrow = 0.f;
        f32x4 pf_[10];
#define DT_FETCH(t_) do { const int pp = ptab[b * NPAGES + sp * 8 + ((t_) >> 1)], tok0 = ((t_) & 1) * 64; \
            _Pragma("unroll") for (int i = 0; i < 10; ++i) { const int c = tid + 512 * i, key = c / 80, ch = c % 80; const size_t tk = (size_t)pp * PAGE + tok0 + key; \
                pf_[i] = ch < 64 ? *(const f32x4*)(cckv + tk * 256 + ch * 4) : *(const f32x4*)(ckpe + tk * 64 + (ch - 64) * 4); } } while (0)
        DT_FETCH(0);
        for (int t = 0; t < 16; ++t) {
            __syncthreads();
#pragma unroll
            for (int i = 0; i < 10; ++i) { const int c = tid + 512 * i, key = c / 80, ch = c % 80; *(LAS v2u*)(T + key * DT_P + ch * 8) = (v2u){pk2(pf_[i].x, pf_[i].y), pk2(pf_[i].z, pf_[i].w)}; }
            __syncthreads();
            if (t + 1 < 16) DT_FETCH(t + 1);
            f32x4 sc[4];
#pragma unroll
            for (int kg = 0; kg < 4; ++kg) { sc[kg] = (f32x4){0.f, 0.f, 0.f, 0.f};
#pragma unroll
                for (int s = 0; s < 10; ++s) { const bf16x8 kf = *(const LAS bf16x8*)(T + (16 * kg + hcol) * DT_P + (32 * s + 8 * g) * 2);
                    sc[kg] = __builtin_amdgcn_mfma_f32_16x16x32_bf16(kf, qf[s], sc[kg], 0, 0, 0); } }
            float tmax = sc[0][0];
#pragma unroll
            for (int kg = 0; kg < 4; ++kg)
#pragma unroll
                for (int r = 0; r < 4; ++r) tmax = fmaxf(tmax, sc[kg][r]);
            tmax = fmaxf(tmax, swz_xor<16>(tmax)); tmax = xor32_max(tmax);
            const float mnew = fmaxf(mrow, tmax), alpha = __builtin_amdgcn_exp2f(mrow - mnew); mrow = mnew;
            float ps = 0.f;
#pragma unroll
            for (int kg = 0; kg < 4; ++kg)
#pragma unroll
                for (int r = 0; r < 4; ++r) { sc[kg][r] = __builtin_amdgcn_exp2f(sc[kg][r] - mnew); ps += sc[kg][r]; }
            lrow = lrow * alpha + ps; o[0] *= alpha; o[1] *= alpha;
#pragma unroll
            for (int kk = 0; kk < 2; ++kk) { const bf16x8 pbf = pack8f(sc[2 * kk][0], sc[2 * kk][1], sc[2 * kk][2], sc[2 * kk][3], sc[2 * kk + 1][0], sc[2 * kk + 1][1], sc[2 * kk + 1][2], sc[2 * kk + 1][3]);
#pragma unroll
                for (int ci = 0; ci < 2; ++ci) { const int cb = 2 * F.wave + ci; LAS unsigned char* ap = T + (32 * kk + 4 * g + q4) * DT_P + (16 * cb + 4 * p4) * 2;
                    const s16x4 lo = __builtin_bit_cast(s16x4, __builtin_amdgcn_ds_read_tr16_b64_v4i16((LAS v4i16_t*)ap)), hi2 = __builtin_bit_cast(s16x4, __builtin_amdgcn_ds_read_tr16_b64_v4i16((LAS v4i16_t*)(ap + 16 * DT_P)));
                    const bf16x8 av = (bf16x8){lo[0], lo[1], lo[2], lo[3], hi2[0], hi2[1], hi2[2], hi2[3]};
                    o[ci] = __builtin_amdgcn_mfma_f32_16x16x32_bf16(av, pbf, o[ci], 0, 0, 0); } }
        }
#undef DT_FETCH
        lrow += swz_xor<16>(lrow); lrow = xor32_sum(lrow);
        const size_t pb_ = (size_t)(b * 8 + sp) * 16 + hcol;
#pragma unroll
        for (int ci = 0; ci < 2; ++ci) *(f32x4*)(OP + pb_ * 256 + 16 * (2 * F.wave + ci) + 4 * g) = o[ci];
        if (F.wave == 0 && g == 0) { ML[pb_ * 2] = mrow; ML[pb_ * 2 + 1] = lrow; }
    }
    __syncthreads();
}
__device__ __forceinline__ void b2c_combine(Frame& F, cargs a) {
    unsigned char* ws = F.ws; const bf16* QA = (const bf16*)(ws + WS_QABS); const float* OP = (const float*)(ws + WS_OPART); const float* ML = (const float*)(ws + WS_ML);
    const float* wuv = (const float*)a->in[29]; const bf16* Z = (const bf16*)(ws + WS_Z); bf16* G = (bf16*)(ws + WS_G);
    LAS float* scr = (LAS float*)(F.lds + F.wave * 1024);
    for (int it = F.gw; it < DEC_BATCH * B_HEADS; it += F.NGW) { const int b = it >> 4, hd = it & 15; const int lane = F.lane;
        const float* cn = F.out + O_CKVS + (size_t)b * 256; const float* kn = F.out + O_KPES + (size_t)b * 64; const bf16* qa = QA + (size_t)it * 320;
        const f32x4 c4 = *(const f32x4*)(cn + 4 * lane); const v2u qv = *(const v2u*)(qa + 4 * lane);
        float sn = (bflo(qv.x) * c4.x + bfhi(qv.x) * c4.y) + (bflo(qv.y) * c4.z + bfhi(qv.y) * c4.w);
        sn += __builtin_bit_cast(float, (unsigned)qa[256 + lane] << 16) * kn[lane];
        sn = wave_sum(sn);
        float ms[8], ls[8], M = sn; f32x4 op[8];
#pragma unroll
        for (int s = 0; s < 8; ++s) { ms[s] = ML[((size_t)(b * 8 + s) * 16 + hd) * 2]; ls[s] = ML[((size_t)(b * 8 + s) * 16 + hd) * 2 + 1]; op[s] = *(const f32x4*)(OP + ((size_t)(b * 8 + s) * 16 + hd) * 256 + 4 * lane); }
        __builtin_amdgcn_sched_barrier(0);
#pragma unroll
        for (int s = 0; s < 8; ++s) M = fmaxf(M, ms[s]);
        const float en = __builtin_amdgcn_exp2f(sn - M); float L = en; f32x4 acc = c4 * en;
#pragma unroll
        for (int s = 0; s < 8; ++s) { const float e = __builtin_amdgcn_exp2f(ms[s] - M); L += e * ls[s]; acc += op[s] * e; }
        acc *= 1.0f / L;
        *(LAS f32x4*)(scr + 4 * lane) = acc; LDS_WAIT(); asm volatile("" ::: "memory");
        f32x2 ov = (f32x2){0.f, 0.f};
        for (int c0 = 0; c0 < 256; c0 += 32) { f32x2 wv[32];
#pragma unroll
            for (int j = 0; j < 32; ++j) wv[j] = *(const f32x2*)(wuv + (size_t)(c0 + j) * 2048 + hd * 128 + 2 * lane);
            __builtin_amdgcn_sched_barrier(0);
#pragma unroll
            for (int j = 0; j < 32; ++j) ov += wv[j] * scr[c0 + j]; }
        const size_t off = (size_t)(MP + b) * 2048 + hd * 128 + 2 * lane; const unsigned zz = *(const unsigned*)(Z + off); const float z0 = bflo(zz), z1 = bfhi(zz);
        *(unsigned*)(G + off) = pk2(ov.x * (z0 * sigmoidf_(z0)), ov.y * (z1 * sigmoidf_(z1)));
        LDS_WAIT(); asm volatile("" ::: "memory");
    }
}

#ifndef MK_SPLIT
#define MK_SPLIT 0
#endif
#ifndef MK_DIAG
#define MK_DIAG 0
#endif
constexpr int NPHASES = 1 + 4 + 5 + 7 + 6 + 1 + (MK_DIAG ? 1 : 0);
#define PH_BEGIN if (ph >= lo && ph < hi) { cargs ap = (cargs)__builtin_amdgcn_kernarg_segment_ptr(); asm volatile("" : "+s"(ap)); Frame F = make_frame(ap, wave0, (LAS unsigned char*)lds); unsigned char* ws = F.ws; int wgc_ = F.bid; (void)wgc_;
#define PH_END } if (ph >= lo && ph + 1 < hi) xcd_barrier(bar); ++ph;
typedef pg8::StaticOrder SO;
#define WG_ROT(off_) (wgc_ = (F.bid + F.G - (off_)) % F.G)
#define GEMM_B(ACT_, A_, Bt_, M_, N_, K_, O_, ldc_, nvalid_, nstore_) do { pg8::Gemm g_{(const pg8::bf16_t*)(A_), (const pg8::bf16_t*)(Bt_), (M_), (N_), (K_)}; SO S_; S_.init((M_), (N_), F.G, wgc_); \
    pg8::EpiB<ACT_> E_{(pg8::bf16_t*)(O_), (ldc_), (nvalid_), (nstore_)}; pg8::gemm_phase<pg8::EpiB<ACT_>, SO, true, true>(F.lds, g_, S_, E_, F.wave); } while (0)
#define GEMM_F(ACT_, HB_, HBI_, A_, Bt_, M_, N_, K_, O_, base_, bias_, ldc_, nstore_) do { int kk_ = (K_); asm volatile("" : "+s"(kk_)); pg8::Gemm g_{(const pg8::bf16_t*)(A_), (const pg8::bf16_t*)(Bt_), (M_), (N_), kk_}; SO S_; S_.init((M_), (N_), F.G, wgc_); \
    pg8::EpiF<ACT_, HB_, HBI_> E_{(float*)(O_), (const float*)(base_), (const float*)(bias_), (ldc_), (nstore_)}; pg8::gemm_phase<pg8::EpiF<ACT_, HB_, HBI_>, SO, true, true>(F.lds, g_, S_, E_, F.wave); } while (0)

#define OUTPROJ(Wt_, base_) do { \
    { pg8::Gemm g_{(const pg8::bf16_t*)(ws + WS_G), (const pg8::bf16_t*)(Wt_), MT, 1024, 256, 2048}; pg8::SliceOrder S_{MP / 256, 4, 8, F.G, F.bid, 512}; pg8::EpiFA E_{(float*)(ws + WS_X), 1024, MP + DEC_BATCH}; \
      pg8::gemm_phase<pg8::EpiFA, pg8::SliceOrder, true, true>(F.lds, g_, S_, E_, F.wave); } \
    GEMM_F(0, true, false, ws + WS_G, (Wt_), MP, 1024, 2048, ws + WS_X, (base_), nullptr, 1024, 1024); } while (0)
__global__ void __launch_bounds__(NTHR, 2) mk_fwd(Args args) {
    extern __shared__ __attribute__((aligned(16))) unsigned char lds[];
    const int wave0 = __builtin_amdgcn_readfirstlane(threadIdx.x >> 6);
    for (int u = threadIdx.x; u < (LDS_BYTES - LDSCTL_OFF) / 4; u += NTHR) ((LAS unsigned*)(lds + LDSCTL_OFF))[u] = 0u;
    __syncthreads();
    XcdBarrier bar = xcd_barrier_post((unsigned*)(args.ws + WS_CTL) + CW_BAR + args.li * XCD_BAR_WORDS, (volatile LAS unsigned*)((LAS unsigned char*)lds + LDSCTL_OFF), (unsigned)wave0);
    int ph = 0; const int lo = args.ph_lo, hi = args.ph_hi;

    PH_BEGIN p0_prologue(F, ap); __syncthreads(); a1_prepass(F, ap, 0); PH_END

    for (int l = 0; l < 2; ++l) {
        if (l > 0) { PH_BEGIN a1_prepass(F, ap, l); PH_END }
        PH_BEGIN
            { static_assert(AM_STRIDE == (size_t)130 * 256 * 1024 * 2, "A-operand buffers sit 130 row panels apart");
              pg8::Gemm g_{(const pg8::bf16_t*)(ws + WS_AM), (const pg8::bf16_t*)(ws + WS_WIN + (size_t)l * WIN_L), MT, 2048, 1024}; pg8::GroupOrderA2 S_; S_.init(MT, F.G, F.bid, l ? 7 : 6);
              static_assert(WS_K == WS_R + BIGB && WS_V0 == WS_R + 2 * BIGB && WS_V1 == WS_R + 3 * BIGB && WS_Z == WS_R + 4 * BIGB && WS_LA == WS_LW + 9 * MiB && WS_LV == WS_LW + 18 * MiB, "output buffers are equally spaced");
              pg8::EpiA2 E_{(pg8::bf16_t*)(ws + WS_R), BIGB / 2, 2 + l, (pg8::bf16_t*)(ws + WS_LW), 9 * MiB / 2};
              pg8::gemm_phase<pg8::EpiA2, pg8::GroupOrderA2, true, true>(F.lds, g_, S_, E_, F.wave); }
        PH_END
        PH_BEGIN
#define GEMM_BA(ACT_, A_, Bt_, O_, bias_) do { int kk_ = 128; asm volatile("" : "+s"(kk_)); pg8::Gemm g_{(const pg8::bf16_t*)(A_), (const pg8::bf16_t*)(Bt_), MT, 2048, kk_}; SO S_; S_.init(MT, 2048, F.G, wgc_); \
    pg8::EpiBA<ACT_> E_{(pg8::bf16_t*)(O_), (const float*)(bias_)}; pg8::gemm_phase<pg8::EpiBA<ACT_>, SO, true, true>(F.lds, g_, S_, E_, F.wave); } while (0)
            GEMM_BA(4, ws + WS_LW, ws + WS_W2 + (size_t)l * (MiB / 2), ws + WS_WD, (const float*)ap->in[10] + l * 2048);
            WG_ROT(8); GEMM_BA(3, ws + WS_LA, ws + WS_W2 + (size_t)(2 + l) * (MiB / 2), ws + WS_IA, (const float*)ap->in[13] + l * 2048);
            WG_ROT(16); if (l) GEMM_BA(3, ws + WS_LV, ws + WS_W2 + (size_t)4 * (MiB / 2), ws + WS_VG, (const float*)ap->in[16]);
#undef GEMM_BA
        PH_END
        PH_BEGIN a5_fused(F, ap, l); PH_END
        PH_BEGIN
            OUTPROJ(ws + WS_WO + (size_t)l * 4 * MiB, l == 0 ? (const void*)ap->in[0] : (const void*)(ws + WS_X));
        PH_END
    }

#define MLA_INPROJ(l_, A_) do { \
        { pg8::Gemm g_{(const pg8::bf16_t*)(A_), (const pg8::bf16_t*)(ws + WS_WQ + (size_t)(l_) * MiB), MT, 512, 1024}; WG_ROT(8); SO S_; S_.init(MT, 512, F.G, wgc_); \
          pg8::EpiCQ E_{(pg8::bf16_t*)(ws + WS_CQ), (const float*)ap->in[32] + (l_) * 384, (float*)(ws + WS_CTL + CW_RSQ + (size_t)(l_) * 262144)}; pg8::gemm_phase<pg8::EpiCQ, SO, true, true>(F.lds, g_, S_, E_, F.wave); } \
        WG_ROT(16); GEMM_B(0, (A_), ws + WS_WZ + (size_t)(l_) * 4 * MiB, MT, 2048, 1024, ws + WS_Z, 2048, 2048, 2048); } while (0)
#define MLA_QUP(l_) do { pg8::Gemm g_{(const pg8::bf16_t*)(ws + WS_CQ), (const pg8::bf16_t*)(ws + WS_WUQ + (size_t)(l_) * (5 * MiB / 2)), MT, 3072, 384}; SO S_; S_.init(MT, 3072, F.G, F.bid); \
        pg8::EpiQ E_{(pg8::bf16_t*)(ws + WS_Q), (const float*)(ws + WS_ROPE), ATTN_SCALE * LOG2E, MP, SEQ, (const float*)(ws + WS_CTL + CW_RSQ + (size_t)(l_) * 262144)}; pg8::gemm_phase<pg8::EpiQ, SO, true, true>(F.lds, g_, S_, E_, F.wave); } while (0)
    for (int l = 0; l < 2; ++l) {
        PH_BEGIN if (l == 0) norm2_rows_bf16(F, (const float*)(ws + WS_X), (const float*)ap->in[25], (bf16*)(ws + WS_AM), (const float*)ap->in[30], (bf16*)(ws + WS_AM + AM_STRIDE));
                 else norm_rows_bf16(F, (const float*)(ws + WS_X), (const float*)ap->in[30] + l * 1024, (bf16*)(ws + WS_AM)); PH_END
        PH_BEGIN if (l == 0) GEMM_F(0, false, false, ws + WS_AM, ws + WS_WDKV, MT, 512, 1024, ws + WS_KVR, nullptr, nullptr, 320, 320);
                 MLA_INPROJ(l, ws + WS_AM + (l == 0 ? AM_STRIDE : 0)); PH_END
        if (l == 0) { PH_BEGIN b0c_kvpost(F, ap); PH_END }
        PH_BEGIN if (l == 0) { GEMM_B(0, ws + WS_CKVB, ws + WS_WUK, MP, 2048, 256, ws + WS_KN, 2048, 2048, 2048);
                               GEMM_B(0, ws + WS_WUV, ws + WS_CKVB, 2048, MP, 256, ws + WS_VT, MP, MP, MP); }
                 MLA_QUP(l); PH_END
        PH_BEGIN b2a_attn_prompt(F); b2b_attn_sample(F, ap); PH_END
        PH_BEGIN b2c_combine(F, ap); PH_END
        PH_BEGIN OUTPROJ(ws + WS_WBO + (size_t)l * 4 * MiB, ws + WS_X); PH_END
    }
#undef MLA_INPROJ
#undef MLA_QUP

    PH_BEGIN final_norm(F, ap); PH_END
#if MK_DIAG
    PH_BEGIN
        const size_t offs[11] = {O_YP, O_YS, O_WKVP, O_SHP, O_CKVP, O_KPEP, O_WKVS, O_SHS, O_CKVS, O_KPES, O_END};
        for (int k = 1; k < 10; ++k) { const float f = 1.0f + sqrtf(2e-4f * (float)k);
            for (size_t i = offs[k] + (size_t)(F.bid * NTHR + F.wave * 64 + F.lane); i < offs[k + 1]; i += (size_t)F.NT) F.out[i] *= f; }
    PH_END
#endif
}

extern "C" void kernel_launch(void* const* d_in, const int* in_sizes, int n_in, void* d_out, int out_size, void* d_ws, size_t ws_size, hipStream_t stream) {
    static int grid = 0;
    if (grid == 0) {
        if (n_in != 36 || (size_t)out_size != O_END || ws_size < WS_NEED) { fprintf(stderr, "kernel_launch: unexpected sizes: n_in %d out %d (want %zu) ws %zu (need %zu)\n", n_in, out_size, (size_t)O_END, ws_size, (size_t)WS_NEED); grid = -1; return; }
        int dev = 0, cus = 0, per_cu = 0;
        if (hipGetDevice(&dev) != hipSuccess || hipDeviceGetAttribute(&cus, hipDeviceAttributeMultiprocessorCount, dev) != hipSuccess) { grid = -1; return; }
        if (hipFuncSetAttribute((const void*)mk_fwd, hipFuncAttributeMaxDynamicSharedMemorySize, LDS_BYTES) != hipSuccess) { fprintf(stderr, "kernel_launch: hipFuncSetAttribute failed\n"); grid = -1; return; }
        if (hipOccupancyMaxActiveBlocksPerMultiprocessor(&per_cu, (const void*)mk_fwd, NTHR, LDS_BYTES) != hipSuccess || per_cu < 1) fprintf(stderr, "kernel_launch: occupancy query reports %d\n", per_cu);
        (void)hipGetLastError();
        grid = cus;
    }
    if (grid < 0) return;
    if (hipMemsetAsync((char*)d_ws + WS_CTL, 0, CTL_ZERO_BYTES, stream) != hipSuccess) { fprintf(stderr, "kernel_launch: memset failed\n"); return; }
    Args a{};
    for (int i = 0; i < 36; ++i) a.in[i] = d_in[i];
    a.out = (float*)d_out; a.ws = (unsigned char*)d_ws;
#if MK_SPLIT
    for (int li = 0; li < NPHASES; ++li) { a.ph_lo = li; a.ph_hi = li + 1; a.li = li;
        hipLaunchKernelGGL(mk_fwd, dim3(grid), dim3(NTHR), LDS_BYTES, stream, a); }
#else
    a.ph_lo = 0; a.ph_hi = NPHASES; a.li = 0;
    hipLaunchKernelGGL(mk_fwd, dim3(grid), dim3(NTHR), LDS_BYTES, stream, a);
#endif
    const hipError_t le = hipPeekAtLastError();
    if (le != hipSuccess) fprintf(stderr, "kernel_launch: launch failed: %s\n", hipGetErrorName(le));
}
```

```cpp
#include <hip/hip_runtime.h>
#include <cstdio>
#include <cstdint>
namespace pg8 {
#define PG8_LAS __attribute__((address_space(3)))
typedef unsigned short bf16_t;
typedef short bf16x8 __attribute__((ext_vector_type(8)));
typedef float f32x4 __attribute__((ext_vector_type(4)));
typedef unsigned u32x4 __attribute__((ext_vector_type(4)));
constexpr int BM = 256, BK = 64, HALF = 128, HTB = HALF * BK * 2  , STAGE_BYTES = 8 * HTB, NXCD = 8, WGM = 8;

__host__ __device__ __forceinline__ int lds_byte(int r, int c) { const int st = (r >> 4) * 2 + (c >> 5), rr = r & 15, cc = c & 31, ob = rr * 64 + cc * 2; return st * 1024 + (ob ^ (((ob >> 9) & 1) << 5)); }
__host__ __device__ __forceinline__ void stage_rc(int b, int& R, int& C) { const int st = b / 1024, sb = b % 1024, swz = sb ^ (((sb >> 9) & 1) << 5); R = (st >> 1) * 16 + swz / 64; C = (st & 1) * 32 + (swz % 64) / 2; }
__host__ __device__ __forceinline__ int perm32(int rho) { const int n = rho >> 4, i = rho & 15; return 8 * (i >> 2) + 4 * n + (i & 3); }

struct Unit { int pm, pn; int ko; };
struct Gemm { const bf16_t* A; const bf16_t* Bt; int M, N, K; int ld; };

struct StaticOrder {
    int nM, nN, nwg, G, c;
    __host__ __device__ void init(int M, int N, int G_, int c_) { nM = M / BM; nN = N / BM; nwg = nM * nN; G = G_; c = c_; }
    __host__ __device__ bool next(int i, Unit& u) const {
        const long L = (long)i * G + c; if (L >= nwg) return false;
        int wgid = (int)L; { const int q = nwg / NXCD, r = nwg % NXCD, xcd = wgid % NXCD, off = wgid / NXCD; wgid = (xcd < r ? xcd * (q + 1) : r * (q + 1) + (xcd - r) * q) + off; }
        const int nig = WGM * nN, gid = wgid / nig, fm = gid * WGM, gsz = (nM - fm) < WGM ? (nM - fm) : WGM;
        u.pm = fm + ((wgid % nig) % gsz); u.pn = (wgid % nig) / gsz; u.ko = 0; return true;
    }
    __device__ __forceinline__ void a_ready(const Unit&) const {}
    __device__ __forceinline__ void done(const Unit&) const {}
};

__device__ __forceinline__ unsigned cvt_pk_bf16(float lo, float hi) { unsigned r; asm volatile("v_cvt_pk_bf16_f32 %0, %1, %2" : "=v"(r) : "v"(lo), "v"(hi)); return r; }
typedef float f32x2 __attribute__((ext_vector_type(2)));
__device__ __forceinline__ float act_apply(int ACT, float x) {
    if (ACT == 1) return 1.0f - 2.0f / (1.0f + __expf(2.0f * x));
    if (ACT == 2) return __expf(-0.6065306597126334f / (1.0f + __expf(-x)));
    if (ACT == 3) return 1.0f / (1.0f + __expf(-x));
    return x;
}
template <int ACT> struct EpiB {
    static constexpr bool PERM = true, AFTER_DRAIN = false;
    bf16_t* O; int ldc; int nvalid; int nstore;
    __device__ __forceinline__ void operator()(const f32x4 (&acc)[2][2][4][2], const Unit& u, int wr, int wc, int, int) const {
        int lane_; asm volatile("v_mbcnt_lo_u32_b32 %0, -1, 0\n\tv_mbcnt_hi_u32_b32 %0, -1, %0" : "=v"(lane_)); const int fr = lane_ & 15, fq = lane_ >> 4;
        const int row0 = u.pm * BM + wr * 64 + fr, col0 = u.pn * BM + wc * 32 + 8 * fq;
#pragma unroll
        for (int ai = 0; ai < 2; ++ai)
#pragma unroll
            for (int m = 0; m < 4; ++m) { bf16_t* rowp = O + (size_t)(row0 + ai * HALF + m * 16) * ldc + col0;
#pragma unroll
                for (int bj = 0; bj < 2; ++bj) { const int c = col0 + bj * HALF; if (c >= nstore) continue;
                    f32x4 v0 = acc[ai][bj][m][0], v1 = acc[ai][bj][m][1];
                    if (ACT != 0) {
#pragma unroll
                        for (int e = 0; e < 4; ++e) { v0[e] = act_apply(ACT, v0[e]); v1[e] = act_apply(ACT, v1[e]); } }
                    u32x4 w; w.x = cvt_pk_bf16(v0[0], v0[1]); w.y = cvt_pk_bf16(v0[2], v0[3]); w.z = cvt_pk_bf16(v1[0], v1[1]); w.w = cvt_pk_bf16(v1[2], v1[3]);
                    if (c >= nvalid) w = (u32x4){0u, 0u, 0u, 0u};
                    *(u32x4*)(rowp + bj * HALF) = w; } }
    }
};
template <int ACT, bool HAS_BASE, bool HAS_BIAS> struct EpiF {
    static constexpr bool PERM = false, AFTER_DRAIN = false;
    float* O; const float* base; const float* bias; int ldc; int nstore;
    __device__ __forceinline__ void operator()(const f32x4 (&acc)[2][2][4][2], const Unit& u, int wr, int wc, int, int) const {
        int lane_; asm volatile("v_mbcnt_lo_u32_b32 %0, -1, 0\n\tv_mbcnt_hi_u32_b32 %0, -1, %0" : "=v"(lane_)); const int fr = lane_ & 15, fq = lane_ >> 4;
        const int row0 = u.pm * BM + wr * 64 + fr, col0 = u.pn * BM + wc * 32 + 4 * fq;
        f32x4 bv[2][2];
#pragma unroll
        for (int bj = 0; bj < 2; ++bj)
#pragma unroll
            for (int n = 0; n < 2; ++n) bv[bj][n] = HAS_BIAS ? *(const f32x4*)(bias + col0 + bj * HALF + n * 16) : (f32x4){0.f, 0.f, 0.f, 0.f};
#pragma unroll
        for (int ai = 0; ai < 2; ++ai) { f32x4 bs[2][2][2];
#pragma unroll
            for (int m = 0; m < 4; ++m) { const size_t off = (size_t)(row0 + ai * HALF + m * 16) * ldc + col0;
                if (HAS_BASE && !(m & 1)) {
#pragma unroll
                    for (int mm = 0; mm < 2; ++mm)
#pragma unroll
                        for (int bj = 0; bj < 2; ++bj)
#pragma unroll
                            for (int n = 0; n < 2; ++n) bs[mm][bj][n] = *(const f32x4*)(base + off + (size_t)mm * 16 * ldc + bj * HALF + n * 16);
                    __builtin_amdgcn_sched_barrier(0); }
#pragma unroll
                for (int bj = 0; bj < 2; ++bj)
#pragma unroll
                    for (int n = 0; n < 2; ++n) { if (!HAS_BASE && col0 + bj * HALF + n * 16 >= nstore) continue;
                        f32x4 v = acc[ai][bj][m][n] + bv[bj][n];
                        if (ACT != 0) {
#pragma unroll
                            for (int e = 0; e < 4; ++e) v[e] = act_apply(ACT, v[e]); }
                        if (HAS_BASE) v += bs[m & 1][bj][n];
                        *(f32x4*)(O + off + bj * HALF + n * 16) = v; }
                if (m & 1) asm volatile("" ::: "memory"); } }
    }
};

struct GroupOrder4 {
    StaticOrder so; int per;
    __device__ void init(int M, int N, int G_, int c_) { so.init(M, N, G_, c_); per = so.nwg; }
    __device__ bool next(int i, Unit& u) const {
        const long L = (long)i * so.G + so.c; if (L >= 4L * per) return false;
        const int gi = (int)(L / per); int wgid = (int)(L - (long)gi * per);
        { const int q = so.nwg / NXCD, r = so.nwg % NXCD, xcd = wgid % NXCD, off = wgid / NXCD; wgid = (xcd < r ? xcd * (q + 1) : r * (q + 1) + (xcd - r) * q) + off; }
        const int nig = WGM * so.nN, gid = wgid / nig, fm = gid * WGM, gsz = (so.nM - fm) < WGM ? (so.nM - fm) : WGM;
        u.pm = fm + ((wgid % nig) % gsz) + 130 * gi; u.pn = (wgid % nig) / gsz + 8 * gi; u.ko = 0; return true;
    }
    __device__ __forceinline__ void a_ready(const Unit&) const {}
    __device__ __forceinline__ void done(const Unit&) const {}
};
struct EpiB4 {
    static constexpr bool PERM = true, AFTER_DRAIN = false;
    bf16_t* O[4];
    __device__ __forceinline__ void operator()(const f32x4 (&acc)[2][2][4][2], const Unit& u, int wr, int wc, int, int) const {
        int lane_; asm volatile("v_mbcnt_lo_u32_b32 %0, -1, 0\n\tv_mbcnt_hi_u32_b32 %0, -1, %0" : "=v"(lane_)); const int fr = lane_ & 15, fq = lane_ >> 4;
        const int gi = u.pn >> 3; bf16_t* Ob = gi == 0 ? O[0] : gi == 1 ? O[1] : gi == 2 ? O[2] : O[3];
        const int row0 = (u.pm - 130 * gi) * BM + wr * 64 + fr, col0 = (u.pn & 7) * BM + wc * 32 + 8 * fq;
#pragma unroll
        for (int ai = 0; ai < 2; ++ai)
#pragma unroll
            for (int m = 0; m < 4; ++m) { bf16_t* rowp = Ob + (size_t)(row0 + ai * HALF + m * 16) * 2048 + col0;
#pragma unroll
                for (int bj = 0; bj < 2; ++bj) { const f32x4 v0 = acc[ai][bj][m][0], v1 = acc[ai][bj][m][1];
                    u32x4 w; w.x = cvt_pk_bf16(v0[0], v0[1]); w.y = cvt_pk_bf16(v0[2], v0[3]); w.z = cvt_pk_bf16(v1[0], v1[1]); w.w = cvt_pk_bf16(v1[2], v1[3]);
                    *(u32x4*)(rowp + bj * HALF) = w; } }
    }
};

struct EpiQ {
    static constexpr bool PERM = true, AFTER_DRAIN = false;
    bf16_t* O; const float* rope; float sc; int mp, seq; const float* rsq;
    __device__ __forceinline__ void operator()(const f32x4 (&acc)[2][2][4][2], const Unit& u, int wr, int wc, int, int) const {
        int lane_; asm volatile("v_mbcnt_lo_u32_b32 %0, -1, 0\n\tv_mbcnt_hi_u32_b32 %0, -1, %0" : "=v"(lane_)); const int fr = lane_ & 15, fq = lane_ >> 4;
        const int row0 = u.pm * BM + wr * 64 + fr, col0 = u.pn * BM + wc * 32 + 8 * fq;
#pragma unroll
        for (int ai = 0; ai < 2; ++ai)
#pragma unroll
            for (int m2 = 0; m2 < 4; m2 += 2) {
                float rq[2]; f32x4 tt0[2][2], tt1[2][2];
#pragma unroll
                for (int mm = 0; mm < 2; ++mm) { const int row = row0 + ai * HALF + (m2 + mm) * 16; const int p = row < mp ? (row & (seq - 1)) : seq; rq[mm] = rsq[row];
#pragma unroll
                    for (int bj = 0; bj < 2; ++bj) { const int within = (col0 + bj * HALF) % 192, wi = within >= 128 ? ((within - 128) >> 1) : 0; const float* t = rope + (size_t)(p * 32 + wi) * 2;
                        tt0[mm][bj] = *(const f32x4*)t; tt1[mm][bj] = *(const f32x4*)(t + 4); } }
                __builtin_amdgcn_sched_barrier(0);
#pragma unroll
                for (int mm = 0; mm < 2; ++mm) { const int m = m2 + mm, row = row0 + ai * HALF + m * 16; bf16_t* rowp = O + (size_t)row * 3072 + col0; const float rsc = sc / sqrtf(rq[mm] * (1.0f / 384.0f) + 1e-6f);
#pragma unroll
                    for (int bj = 0; bj < 2; ++bj) { const int c = col0 + bj * HALF, within = c % 192; f32x4 v0 = acc[ai][bj][m][0], v1 = acc[ai][bj][m][1];
                        if (within >= 128) { const f32x4 t0 = tt0[mm][bj], t1 = tt1[mm][bj];
                            const f32x4 a0 = v0, a1 = v1;
                            v0[0] = a0[0] * t0[0] - a0[1] * t0[1]; v0[1] = a0[1] * t0[0] + a0[0] * t0[1]; v0[2] = a0[2] * t0[2] - a0[3] * t0[3]; v0[3] = a0[3] * t0[2] + a0[2] * t0[3];
                            v1[0] = a1[0] * t1[0] - a1[1] * t1[1]; v1[1] = a1[1] * t1[0] + a1[0] * t1[1]; v1[2] = a1[2] * t1[2] - a1[3] * t1[3]; v1[3] = a1[3] * t1[2] + a1[2] * t1[3]; }
                        v0 = v0 * rsc; v1 = v1 * rsc;
                        u32x4 w; w.x = cvt_pk_bf16(v0[0], v0[1]); w.y = cvt_pk_bf16(v0[2], v0[3]); w.z = cvt_pk_bf16(v1[0], v1[1]); w.w = cvt_pk_bf16(v1[2], v1[3]);
                        *(u32x4*)(rowp + bj * HALF) = w; } } }
    }
};

struct EpiCQ {
    static constexpr bool PERM = true, AFTER_DRAIN = false;
    bf16_t* O; const float* wq; float* rsq;
    __device__ __forceinline__ void operator()(const f32x4 (&acc)[2][2][4][2], const Unit& u, int wr, int wc, int, int) const {
        int lane_; asm volatile("v_mbcnt_lo_u32_b32 %0, -1, 0\n\tv_mbcnt_hi_u32_b32 %0, -1, %0" : "=v"(lane_)); const int fr = lane_ & 15, fq = lane_ >> 4;
        const int row0 = u.pm * BM + wr * 64 + fr, col0 = u.pn * BM + wc * 32 + 8 * fq;
#pragma unroll
        for (int ai = 0; ai < 2; ++ai)
#pragma unroll
            for (int m = 0; m < 4; ++m) { const int row = row0 + ai * HALF + m * 16; float ss = 0.f;
#pragma unroll
                for (int bj = 0; bj < 2; ++bj) { const int c = col0 + bj * HALF; if (c >= 384) continue;
                    const f32x4 v0 = acc[ai][bj][m][0], v1 = acc[ai][bj][m][1], w0 = *(const f32x4*)(wq + c), w1 = *(const f32x4*)(wq + c + 4);
                    ss += ((v0[0] * v0[0] + v0[1] * v0[1]) + (v0[2] * v0[2] + v0[3] * v0[3])) + ((v1[0] * v1[0] + v1[1] * v1[1]) + (v1[2] * v1[2] + v1[3] * v1[3]));
                    u32x4 w; w.x = cvt_pk_bf16(v0[0] * w0[0], v0[1] * w0[1]); w.y = cvt_pk_bf16(v0[2] * w0[2], v0[3] * w0[3]); w.z = cvt_pk_bf16(v1[0] * w1[0], v1[1] * w1[1]); w.w = cvt_pk_bf16(v1[2] * w1[2], v1[3] * w1[3]);
                    *(u32x4*)(O + (size_t)row * 384 + c) = w; }
                ss += __builtin_bit_cast(float, __builtin_amdgcn_ds_swizzle(__builtin_bit_cast(int, ss), 0x1F | (16 << 10)));
                { float a = ss, b = ss; asm volatile("s_nop 1\n\tv_permlane32_swap_b32 %0, %1\n\ts_nop 1" : "+v"(a), "+v"(b)); ss = a + b; }
                if (fq == 0 && u.pn < 2) atomicAdd(rsq + row, ss); }
    }
};

struct SliceOrder {
    int pm, nN, nS, G, c, kbytes;
    __device__ bool next(int i, Unit& u) const { const int L = i * G + c; if (L >= nN * nS) return false; u.pm = pm; u.pn = L % nN; u.ko = (L / nN) * kbytes; return true; }
    __device__ __forceinline__ void a_ready(const Unit&) const {}
    __device__ __forceinline__ void done(const Unit&) const {}
};
struct EpiFA {
    static constexpr bool PERM = false, AFTER_DRAIN = false;
    float* O; int ldc, rows;
    __device__ __forceinline__ void operator()(const f32x4 (&acc)[2][2][4][2], const Unit& u, int wr, int wc, int, int) const {
        int lane_; asm volatile("v_mbcnt_lo_u32_b32 %0, -1, 0\n\tv_mbcnt_hi_u32_b32 %0, -1, %0" : "=v"(lane_)); const int fr = lane_ & 15, fq = lane_ >> 4;
        const int row0 = u.pm * BM + wr * 64 + fr, col0 = u.pn * BM + wc * 32 + 4 * fq;
#pragma unroll
        for (int ai = 0; ai < 2; ++ai)
#pragma unroll
            for (int m = 0; m < 4; ++m) { const int row = row0 + ai * HALF + m * 16; if (row >= rows) continue; float* rp = O + (size_t)row * ldc + col0;
#pragma unroll
                for (int bj = 0; bj < 2; ++bj)
#pragma unroll
                    for (int n = 0; n < 2; ++n) { const f32x4 v = acc[ai][bj][m][n];
#pragma unroll
                        for (int e = 0; e < 4; ++e) atomicAdd(rp + bj * HALF + n * 16 + e, v[e]); } }
    }
};

template <int ACT> struct EpiBA {
    static constexpr bool PERM = true, AFTER_DRAIN = false;
    bf16_t* O; const float* bias;
    __device__ __forceinline__ void operator()(const f32x4 (&acc)[2][2][4][2], const Unit& u, int wr, int wc, int, int) const {
        int lane_; asm volatile("v_mbcnt_lo_u32_b32 %0, -1, 0\n\tv_mbcnt_hi_u32_b32 %0, -1, %0" : "=v"(lane_)); const int fr = lane_ & 15, fq = lane_ >> 4;
        const int row0 = u.pm * BM + wr * 64 + fr, col0 = u.pn * BM + wc * 32 + 8 * fq;
        f32x4 bv[2][2];
#pragma unroll
        for (int bj = 0; bj < 2; ++bj)
#pragma unroll
            for (int n = 0; n < 2; ++n) bv[bj][n] = *(const f32x4*)(bias + col0 + bj * HALF + 4 * n);
#pragma unroll
        for (int ai = 0; ai < 2; ++ai)
#pragma unroll
            for (int m = 0; m < 4; ++m) { bf16_t* rowp = O + (size_t)(row0 + ai * HALF + m * 16) * 2048 + col0;
#pragma unroll
                for (int bj = 0; bj < 2; ++bj) { f32x4 v0 = acc[ai][bj][m][0] + bv[bj][0], v1 = acc[ai][bj][m][1] + bv[bj][1];
#pragma unroll
                    for (int e = 0; e < 4; ++e) { const float s0 = __builtin_amdgcn_rcpf(1.0f + __builtin_amdgcn_exp2f(-1.4426950408889634f * v0[e])), s1 = __builtin_amdgcn_rcpf(1.0f + __builtin_amdgcn_exp2f(-1.4426950408889634f * v1[e]));
                        v0[e] = ACT == 4 ? -0.8750387749f * s0 : s0; v1[e] = ACT == 4 ? -0.8750387749f * s1 : s1; }
                    typedef __bf16 bf8n __attribute__((ext_vector_type(8))); typedef float f8n __attribute__((ext_vector_type(8)));
                    const u32x4 w = __builtin_bit_cast(u32x4, __builtin_convertvector((f8n){v0[0], v0[1], v0[2], v0[3], v1[0], v1[1], v1[2], v1[3]}, bf8n));
                    *(u32x4*)(rowp + bj * HALF) = w; } }
    }
};

struct GroupOrderA2 {
    StaticOrder so; int per, nG;
    __device__ void init(int M, int G_, int c_, int nG_) { so.init(M, 2048, G_, c_); per = so.nwg; nG = nG_; }
    __device__ bool next(int i, Unit& u) const {
        const long L = (long)i * so.G + so.c; u.ko = 0;
        if (L < 4L * per) { const int gi = (int)(L / per); int wgid = (int)(L - (long)gi * per);
            { const int q = so.nwg / NXCD, r = so.nwg % NXCD, xcd = wgid % NXCD, off = wgid / NXCD; wgid = (xcd < r ? xcd * (q + 1) : r * (q + 1) + (xcd - r) * q) + off; }
            const int nig = WGM * so.nN, gid = wgid / nig, fm = gid * WGM, gsz = (so.nM - fm) < WGM ? (so.nM - fm) : WGM;
            u.pm = fm + ((wgid % nig) % gsz) + 130 * gi; u.pn = (wgid % nig) / gsz + 8 * gi; return true; }
        const int Lp = (int)(L - 4L * per); if (Lp >= (nG - 4) * so.nM) return false;
        const int ge = Lp / so.nM, gi = 4 + ge; u.pm = Lp % so.nM + 130 * (gi == 6 ? 2 : gi); u.pn = 32 + ge; return true;
    }
    __device__ __forceinline__ void a_ready(const Unit&) const {}
    __device__ __forceinline__ void done(const Unit&) const {}
};
struct EpiA2 {
    static constexpr bool PERM = true, AFTER_DRAIN = false;
    bf16_t* Rb; size_t ostride; int vidx; bf16_t* Lb; size_t lstride;
    __device__ __forceinline__ void operator()(const f32x4 (&acc)[2][2][4][2], const Unit& u, int wr, int wc, int, int) const {
        int lane_; asm volatile("v_mbcnt_lo_u32_b32 %0, -1, 0\n\tv_mbcnt_hi_u32_b32 %0, -1, %0" : "=v"(lane_)); const int fr = lane_ & 15, fq = lane_ >> 4;
        if (u.pn < 32) { const int gi = u.pn >> 3; bf16_t* Ob = Rb + (size_t)(gi < 2 ? gi : (gi == 2 ? vidx : 4)) * ostride;
            const int row0 = (u.pm - 130 * gi) * BM + wr * 64 + fr, col0 = (u.pn & 7) * BM + wc * 32 + 8 * fq;
#pragma unroll
            for (int ai = 0; ai < 2; ++ai)
#pragma unroll
                for (int m = 0; m < 4; ++m) { bf16_t* rowp = Ob + (size_t)(row0 + ai * HALF + m * 16) * 2048 + col0;
#pragma unroll
                    for (int bj = 0; bj < 2; ++bj) { const f32x4 v0 = acc[ai][bj][m][0], v1 = acc[ai][bj][m][1];
                        u32x4 w; w.x = cvt_pk_bf16(v0[0], v0[1]); w.y = cvt_pk_bf16(v0[2], v0[3]); w.z = cvt_pk_bf16(v1[0], v1[1]); w.w = cvt_pk_bf16(v1[2], v1[3]);
                        *(u32x4*)(rowp + bj * HALF) = w; } }
        } else { const int ge = u.pn - 32, gi = 4 + ge; bf16_t* Ob = Lb + (size_t)ge * lstride; const int nvalid = ge == 2 ? 32 : 64;
            const int row0 = (u.pm - 130 * (gi == 6 ? 2 : gi)) * BM + wr * 64 + fr, c = wc * 32 + 8 * fq;
#pragma unroll
            for (int ai = 0; ai < 2; ++ai)
#pragma unroll
                for (int m = 0; m < 4; ++m) { f32x4 v0 = acc[ai][0][m][0], v1 = acc[ai][0][m][1];
                    if (ge == 0) {
#pragma unroll
                        for (int e = 0; e < 4; ++e) { v0[e] = 1.0f - 2.0f / (1.0f + __expf(2.0f * v0[e])); v1[e] = 1.0f - 2.0f / (1.0f + __expf(2.0f * v1[e])); } }
                    u32x4 w; w.x = cvt_pk_bf16(v0[0], v0[1]); w.y = cvt_pk_bf16(v0[2], v0[3]); w.z = cvt_pk_bf16(v1[0], v1[1]); w.w = cvt_pk_bf16(v1[2], v1[3]);
                    if (c >= nvalid) w = (u32x4){0u, 0u, 0u, 0u};
                    *(u32x4*)(Ob + (size_t)(row0 + ai * HALF + m * 16) * 128 + c) = w; }
        }
    }
};
template <class Epi, class Sched, bool ALIGN_EPI = false, bool SP2 = false>
__device__ __forceinline__ void gemm_phase(PG8_LAS unsigned char* lds, const Gemm g, const Sched& S, const Epi& E, const int wid) {
    int lane_; asm volatile("v_mbcnt_lo_u32_b32 %0, -1, 0\n\tv_mbcnt_hi_u32_b32 %0, -1, %0" : "=v"(lane_));
    const int lane = lane_, tid = wid * 64 + lane, wr = wid >> 2, wc = wid & 3, fr = lane & 15, fq = lane >> 4;
    const int K = g.K, nt = K / BK, LD = g.ld ? g.ld : g.K;
    unsigned voffA[2], voffB[2];
#pragma unroll
    for (int i = 0; i < 2; ++i) { int R, C; stage_rc(tid * 16 + i * 8192, R, C); const int Rb = Epi::PERM ? ((R & ~31) + perm32(R & 31)) : R;
        voffA[i] = (unsigned)(R * LD + C) * 2u; voffB[i] = (unsigned)(Rb * LD + C) * 2u; }
    const size_t kstep = (size_t)(BK * 2);
    const size_t hstep = (size_t)HALF * LD * 2;
    const size_t tstep = 2 * hstep;
    const unsigned ldsw = (unsigned)wid * 1024u;
    const int aoff = lds_byte(wr * 64 + fr, fq * 8), boff = lds_byte(wc * 32 + fr, fq * 8);
#define PG8_SA(b, h) (((b) * 2 + (h)) * HTB)
#define PG8_SB(b, h) ((4 + (b) * 2 + (h)) * HTB)
#define PG8_STAGE(bufoff, gbase, voff) do { _Pragma("unroll") for (int _i = 0; _i < 2; ++_i) \
        __builtin_amdgcn_global_load_lds((const unsigned*)((const char*)(gbase) + (voff)[_i]), (PG8_LAS unsigned*)(lds + (bufoff) + ldsw + _i * 8192), 16, 0, 0); } while (0)
#define PG8_LDA(dst, b, h) do { _Pragma("unroll") for (int m = 0; m < 4; ++m) _Pragma("unroll") for (int k = 0; k < 2; ++k) dst[m][k] = *(const PG8_LAS bf16x8*)(lds + PG8_SA(b, h) + aoff + m * 2048 + k * 1024); } while (0)
#define PG8_LDB(dst, b, h) do { _Pragma("unroll") for (int n = 0; n < 2; ++n) _Pragma("unroll") for (int k = 0; k < 2; ++k) dst[n][k] = *(const PG8_LAS bf16x8*)(lds + PG8_SB(b, h) + boff + n * 2048 + k * 1024); } while (0)
#define PG8_MMA(ai, bj, At, Bt) do { __builtin_amdgcn_s_setprio(1); _Pragma("unroll") for (int m = 0; m < 4; ++m) _Pragma("unroll") for (int n = 0; n < 2; ++n) _Pragma("unroll") for (int k = 0; k < 2; ++k) \
        acc[ai][bj][m][n] = __builtin_amdgcn_mfma_f32_16x16x32_bf16(Bt[n][k], At[m][k], acc[ai][bj][m][n], 0, 0, 0); __builtin_amdgcn_s_setprio(0); } while (0)
#define PG8_WAIT_V(n) asm volatile("s_waitcnt vmcnt(" #n ")" ::: "memory")
#define PG8_WAIT_L(n) asm volatile("s_waitcnt lgkmcnt(" #n ")" ::: "memory")
#define PG8_BAR __builtin_amdgcn_s_barrier()
#define PG8_SCHED __builtin_amdgcn_sched_barrier(0)
    Unit cur, nxt; int ui = 0;
    if (!S.next(0, cur)) return;
    f32x4 acc[2][2][4][2];
#pragma unroll
    for (int a = 0; a < 2; ++a)
#pragma unroll
        for (int b = 0; b < 2; ++b)
#pragma unroll
            for (int m = 0; m < 4; ++m)
#pragma unroll
                for (int n = 0; n < 2; ++n) acc[a][b][m][n] = (f32x4){0.f, 0.f, 0.f, 0.f};
    bf16x8 At[4][2], B0[2][2], B1[2][2];
    const char* cA = (const char*)g.A + (size_t)cur.pm * tstep + cur.ko; const char* cB = (const char*)g.Bt + (size_t)cur.pn * tstep + cur.ko;
    S.a_ready(cur);
    if constexpr (SP2) {
        PG8_STAGE(PG8_SB(0, 0), cB, voffB); PG8_STAGE(PG8_SB(0, 1), cB + hstep, voffB); PG8_STAGE(PG8_SA(0, 0), cA, voffA); PG8_STAGE(PG8_SA(0, 1), cA + hstep, voffA);
        if (wr == 1) PG8_BAR;
        PG8_WAIT_V(2); PG8_BAR;
        PG8_STAGE(PG8_SB(1, 0), cB + kstep, voffB); PG8_STAGE(PG8_SA(1, 0), cA + kstep, voffA); PG8_STAGE(PG8_SB(1, 1), cB + hstep + kstep, voffB);
        PG8_WAIT_V(6); PG8_BAR;
    } else {
        PG8_STAGE(PG8_SB(0, 0), cB, voffB); PG8_STAGE(PG8_SA(0, 0), cA, voffA); PG8_STAGE(PG8_SB(0, 1), cB + hstep, voffB); PG8_STAGE(PG8_SA(0, 1), cA + hstep, voffA);
        if (wr == 1) PG8_BAR;
        PG8_WAIT_V(4); PG8_BAR;
        PG8_STAGE(PG8_SB(1, 0), cB + kstep, voffB); PG8_STAGE(PG8_SA(1, 0), cA + kstep, voffA); PG8_STAGE(PG8_SB(1, 1), cB + hstep + kstep, voffB);
        PG8_WAIT_V(6); PG8_BAR;
    }
    for (;;) {
        const bool has_next = S.next(ui + 1, nxt);
        const char* nA = has_next ? (const char*)g.A + (size_t)nxt.pm * tstep + nxt.ko : cA; const char* nB = has_next ? (const char*)g.Bt + (size_t)nxt.pn * tstep + nxt.ko : cB;
        for (int t = 0; t < nt; t += 2) {
            const bool last = (t == nt - 2);
            const char* a1 = cA + (size_t)(t + 1) * kstep;
            const char* a2 = last ? nA : cA + (size_t)(t + 2) * kstep; const char* b2 = last ? nB : cB + (size_t)(t + 2) * kstep;
            const char* a3 = a2 + kstep; const char* b3 = b2 + kstep;
            if (last && has_next) S.a_ready(nxt);
            if constexpr (SP2) {
            PG8_LDB(B0, 0, 0); PG8_LDB(B1, 0, 1); PG8_SCHED; PG8_LDA(At, 0, 0); PG8_STAGE(PG8_SA(1, 1), a1 + hstep, voffA);
            PG8_WAIT_V(8); PG8_WAIT_L(0); PG8_BAR; PG8_MMA(0, 0, At, B0); PG8_MMA(0, 1, At, B1); PG8_BAR; PG8_SCHED;
            PG8_LDA(At, 0, 1); PG8_STAGE(PG8_SB(0, 0), b2, voffB); PG8_STAGE(PG8_SB(0, 1), b2 + hstep, voffB); PG8_STAGE(PG8_SA(0, 0), a2, voffA);
            PG8_WAIT_V(8); PG8_WAIT_L(0); PG8_BAR; PG8_MMA(1, 0, At, B0); PG8_MMA(1, 1, At, B1); PG8_BAR; PG8_SCHED;
            PG8_LDB(B0, 1, 0); PG8_LDB(B1, 1, 1); PG8_SCHED; PG8_LDA(At, 1, 0); PG8_STAGE(PG8_SA(0, 1), a2 + hstep, voffA);
            PG8_WAIT_V(8); PG8_WAIT_L(0); PG8_BAR; PG8_MMA(0, 0, At, B0); PG8_MMA(0, 1, At, B1); PG8_BAR; PG8_SCHED;
            PG8_LDA(At, 1, 1); PG8_STAGE(PG8_SB(1, 0), b3, voffB); PG8_STAGE(PG8_SB(1, 1), b3 + hstep, voffB); PG8_STAGE(PG8_SA(1, 0), a3, voffA);
            PG8_WAIT_V(8); PG8_WAIT_L(0); PG8_BAR; PG8_MMA(1, 0, At, B0); PG8_MMA(1, 1, At, B1); PG8_BAR; PG8_SCHED;
            } else {
            PG8_LDB(B0, 0, 0); PG8_SCHED; PG8_LDA(At, 0, 0); PG8_STAGE(PG8_SA(1, 1), a1 + hstep, voffA);
            PG8_WAIT_L(8); PG8_BAR; PG8_WAIT_L(0); PG8_MMA(0, 0, At, B0); PG8_BAR; PG8_SCHED;
            PG8_LDB(B1, 0, 1); PG8_STAGE(PG8_SB(0, 0), b2, voffB);
            PG8_BAR; PG8_WAIT_L(0); PG8_MMA(0, 1, At, B1); PG8_BAR;
            PG8_LDA(At, 0, 1); PG8_STAGE(PG8_SA(0, 0), a2, voffA);
            PG8_BAR; PG8_WAIT_L(0); PG8_MMA(1, 0, At, B0); PG8_BAR; PG8_SCHED;
            PG8_STAGE(PG8_SB(0, 1), b2 + hstep, voffB);
            PG8_WAIT_V(6); PG8_BAR; PG8_MMA(1, 1, At, B1); PG8_BAR;
            PG8_LDB(B0, 1, 0); PG8_SCHED; PG8_LDA(At, 1, 0); PG8_STAGE(PG8_SA(0, 1), a2 + hstep, voffA);
            PG8_WAIT_L(8); PG8_BAR; PG8_WAIT_L(0); PG8_MMA(0, 0, At, B0); PG8_BAR; PG8_SCHED;
            PG8_LDB(B1, 1, 1); PG8_STAGE(PG8_SB(1, 0), b3, voffB);
            PG8_BAR; PG8_WAIT_L(0); PG8_MMA(0, 1, At, B1); PG8_BAR;
            PG8_LDA(At, 1, 1); PG8_STAGE(PG8_SA(1, 0), a3, voffA);
            PG8_BAR; PG8_WAIT_L(0); PG8_MMA(1, 0, At, B0); PG8_BAR; PG8_SCHED;
            PG8_STAGE(PG8_SB(1, 1), b3 + hstep, voffB);
            PG8_WAIT_V(6); PG8_BAR; PG8_MMA(1, 1, At, B1); PG8_BAR;
            }
        }
        if constexpr (ALIGN_EPI) { if (wr == 0) PG8_BAR; }
        if constexpr (!Epi::AFTER_DRAIN) { E(acc, cur, wr, wc, fr, fq); S.done(cur); }
        if (!has_next) break;
#pragma unroll
        for (int a = 0; a < 2; ++a)
#pragma unroll
            for (int b = 0; b < 2; ++b)
#pragma unroll
                for (int m = 0; m < 4; ++m)
#pragma unroll
                    for (int n = 0; n < 2; ++n) acc[a][b][m][n] = (f32x4){0.f, 0.f, 0.f, 0.f};
        cur = nxt; cA = nA; cB = nB; ++ui;
        if constexpr (ALIGN_EPI) { if (wr == 1) PG8_BAR; }
    }
    PG8_WAIT_V(0);
    if constexpr (!ALIGN_EPI) { if (wr == 0) PG8_BAR; }
    PG8_BAR;
    if constexpr (Epi::AFTER_DRAIN) { E.fused(acc, cur, wr, wc, fr, fq, lds, wid, lane); S.done(cur); }
#undef PG8_SA
#undef PG8_SB
#undef PG8_STAGE
#undef PG8_LDA
#undef PG8_LDB
#undef PG8_MMA
#undef PG8_WAIT_V
#undef PG8_WAIT_L
#undef PG8_BAR
#undef PG8_SCHED
}
}
constexpr int D_MODEL = 1024, BATCH = 16, SEQ = 2048, DEC_BATCH = 128, PAST = 8192, PAGE = 128, NPAGES = 64;
constexpr int D_INNER = 2048, A_HEADS = 32, A_HEAD = 64, B_HEADS = 16, KV_LORA = 256, Q_LORA = 384, QK_NOPE = 128, QK_ROPE = 64, V_HEAD = 128, QK_HEAD = 192;
constexpr int MP = BATCH * SEQ;
constexpr int MS0 = MP;
constexpr int MT = MP + 256;
constexpr float NORM_EPS = 1e-6f, GN_EPS = 64e-5f;
constexpr float ATTN_SCALE = 0.07216878364870322f;
constexpr float LOG2E = 1.4426950408889634f;
constexpr int NWAVES = 8, NTHR = 512;

constexpr size_t O_YP = 0, O_YS = O_YP + (size_t)MP * D_MODEL, O_WKVP = O_YS + (size_t)DEC_BATCH * D_MODEL, O_SHP = O_WKVP + (size_t)2 * BATCH * A_HEADS * 4096,
    O_CKVP = O_SHP + (size_t)2 * BATCH * D_MODEL, O_KPEP = O_CKVP + (size_t)MP * KV_LORA, O_WKVS = O_KPEP + (size_t)MP * QK_ROPE, O_SHS = O_WKVS + (size_t)2 * DEC_BATCH * A_HEADS * 4096,
    O_CKVS = O_SHS + (size_t)2 * DEC_BATCH * D_MODEL, O_KPES = O_CKVS + (size_t)DEC_BATCH * KV_LORA, O_END = O_KPES + (size_t)DEC_BATCH * QK_ROPE;

constexpr size_t MiB = 1u << 20;
constexpr size_t WS_CTL = 0, CTL_ZERO_BYTES = 2 * MiB;
constexpr size_t WS_WIN = 2 * MiB, WIN_L = 18 * MiB;
constexpr size_t WS_W2 = WS_WIN + 2 * WIN_L;
constexpr size_t WS_WO = WS_W2 + 3 * MiB;
constexpr size_t WS_WDKV = WS_WO + 8 * MiB;
constexpr size_t WS_WUK = WS_WDKV + 1 * MiB;
constexpr size_t WS_WUV = WS_WUK + 1 * MiB;
constexpr size_t WS_WQ = WS_WUV + 1 * MiB;
constexpr size_t WS_WZ = WS_WQ + 2 * MiB;
constexpr size_t WS_WUQ = WS_WZ + 8 * MiB;
constexpr size_t WS_WBO = WS_WUQ + 5 * MiB;
constexpr size_t WS_ROPE = WS_WBO + 8 * MiB;
constexpr size_t WS_X = 96 * MiB;
constexpr size_t WS_AM = WS_X + 130 * MiB;
constexpr size_t AM_STRIDE = 65 * MiB;
constexpr size_t WS_R = WS_AM + 6 * AM_STRIDE;
constexpr size_t BIGB = 130 * MiB;
constexpr size_t WS_K = WS_R + BIGB, WS_V0 = WS_K + BIGB, WS_V1 = WS_V0 + BIGB, WS_Z = WS_V1 + BIGB, WS_G = WS_Z + BIGB;
constexpr size_t WS_LW = WS_G + BIGB;
constexpr size_t WS_LA = WS_LW + 9 * MiB, WS_LV = WS_LA + 9 * MiB;
constexpr size_t WS_BON = WS_LV + 9 * MiB;
constexpr size_t WS_F = WS_BON + 5 * MiB;
constexpr size_t BIGF = 260 * MiB;
constexpr size_t WS_WD = WS_F, WS_IA = WS_F + BIGF, WS_VG = WS_F + 2 * BIGF, WS_SR = WS_F + 3 * BIGF, WS_SK = WS_F + 4 * BIGF, WS_SA = WS_F + 5 * BIGF, WS_SB = WS_F + 6 * BIGF,
    WS_SV = WS_F + 7 * BIGF, WS_Y = WS_F + 8 * BIGF, WS_END_A = WS_F + 9 * BIGF;
constexpr size_t WS_KVR = WS_F;
constexpr size_t WS_CKVB = WS_KVR + 41 * MiB;
constexpr size_t WS_KPEB = WS_CKVB + 17 * MiB;
constexpr size_t WS_KN = WS_KPEB + 5 * MiB;
constexpr size_t WS_VT = WS_KN + 128 * MiB;
constexpr size_t WS_QL = WS_VT + 128 * MiB;
constexpr size_t WS_CQ = WS_QL + 49 * MiB;
constexpr size_t WS_QR = WS_CQ + 25 * MiB;
constexpr size_t WS_Q = WS_QR + 388 * MiB;
constexpr size_t WS_QABS = WS_Q + 194 * MiB;
constexpr size_t WS_OPART = WS_QABS + 2 * MiB;
constexpr size_t WS_ML = WS_OPART + 16 * MiB;
constexpr size_t WS_END_B = WS_ML + 1 * MiB;
constexpr size_t WS_NEED = WS_END_A > WS_END_B ? WS_END_A : WS_END_B;
static_assert(WS_ROPE + 1 * MiB <= WS_X, "weights region");
constexpr size_t CW_RSQ = 1 * MiB;
constexpr int CW_BAR = 4096;

constexpr int RING_BYTES = 131072;
constexpr int LDSCTL_OFF = RING_BYTES;
constexpr int LDS_BYTES = 147456;

#define GAS __attribute__((address_space(1)))
#define LAS __attribute__((address_space(3)))
typedef unsigned short bf16;
typedef unsigned v4u __attribute__((ext_vector_type(4)));
typedef unsigned v2u __attribute__((ext_vector_type(2)));
typedef float f32x4 __attribute__((ext_vector_type(4)));
typedef float f32x16 __attribute__((ext_vector_type(16)));
typedef short bf16x8 __attribute__((ext_vector_type(8)));
typedef short s16x4 __attribute__((ext_vector_type(4)));
typedef const __attribute__((address_space(4))) float* cfp;
#define LDS_WAIT() asm volatile("s_waitcnt lgkmcnt(0)" ::: "memory")
#define VM_WAIT() asm volatile("s_waitcnt vmcnt(0)" ::: "memory")
__device__ __forceinline__ unsigned f2bf(float f) { unsigned u = __builtin_bit_cast(unsigned, f); return (u + 0x7fffu + ((u >> 16) & 1u)) >> 16; }
__device__ __forceinline__ unsigned pk2(float lo, float hi) { return f2bf(lo) | (f2bf(hi) << 16); }
__device__ __forceinline__ float bflo(unsigned u) { return __builtin_bit_cast(float, u << 16); }
__device__ __forceinline__ float bfhi(unsigned u) { return __builtin_bit_cast(float, u & 0xffff0000u); }
template <int MASK> __device__ __forceinline__ float swz_xor(float v) { return __builtin_bit_cast(float, __builtin_amdgcn_ds_swizzle(__builtin_bit_cast(int, v), 0x1F | (MASK << 10))); }
__device__ __forceinline__ float xor32_sum(float v) { float a = v, b = v; asm volatile("s_nop 1\n\tv_permlane32_swap_b32 %0, %1\n\ts_nop 1" : "+v"(a), "+v"(b)); return a + b; }
__device__ __forceinline__ float xor32_max(float v) { float a = v, b = v; asm volatile("s_nop 1\n\tv_permlane32_swap_b32 %0, %1\n\ts_nop 1" : "+v"(a), "+v"(b)); return fmaxf(a, b); }
__device__ __forceinline__ float wave_sum(float v) { v += swz_xor<1>(v); v += swz_xor<2>(v); v += swz_xor<4>(v); v += swz_xor<8>(v); v += swz_xor<16>(v); return xor32_sum(v); }
__device__ __forceinline__ float sigmoidf_(float x) { return 1.0f / (1.0f + __expf(-x)); }
#define XB_TMO      128
#define XB_XCNT(j)  (256  + 64 * (j))
#define XB_XSUB(j)  (1280 + 64 * (j))
#define XB_XGEN(j)  (2304 + 64 * (j))
#define XB_TOP      3328
#define XB_TOPGEN   3392
#define XCD_BAR_WORDS 3456
#define XB_SPIN_CAP (1u << 18)

__device__ __forceinline__ unsigned xb_ld(unsigned* p)              { return __hip_atomic_load(p, __ATOMIC_RELAXED, __HIP_MEMORY_SCOPE_AGENT); }
__device__ __forceinline__ unsigned xb_add(unsigned* p, unsigned v) { return __hip_atomic_fetch_add(p, v, __ATOMIC_RELAXED, __HIP_MEMORY_SCOPE_AGENT); }
__device__ __forceinline__ unsigned xb_xcc_id() { return (unsigned)__builtin_amdgcn_s_getreg((3 << 11) | 20) & 0xFu; }
#define XB_SPIN(cond, bar) do { unsigned _sp = 0; while (cond) { __builtin_amdgcn_s_sleep(1); \
    if ((++_sp & 255u) == 0u) { if (xb_ld(&(bar)[XB_TMO])) break; if (_sp > XB_SPIN_CAP) { atomicAdd(&(bar)[XB_TMO], 1u); break; } } } } while (0)

struct XcdBarrier {
    unsigned* bar; unsigned x; unsigned w;
    volatile LAS unsigned* st;
};

__device__ __forceinline__ bool xb_t0(unsigned w) { unsigned l; asm volatile("v_mbcnt_lo_u32_b32 %0, -1, 0\n\tv_mbcnt_hi_u32_b32 %0, -1, %0" : "=v"(l)); return w == 0u && l == 0u; }
__device__ __forceinline__ XcdBarrier xcd_barrier_post(unsigned* bar, volatile LAS unsigned* st, unsigned w) {
    XcdBarrier b; b.bar = bar; b.x = xb_xcc_id(); b.st = st; b.w = w;
    if (xb_t0(w)) (void)xb_add(&bar[XB_XCNT(b.x)], 1u);
    return b;
}
__device__ __forceinline__ void xcd_barrier_complete(unsigned* bar, unsigned x, unsigned& nloc, unsigned& nx) {
    const unsigned G = gridDim.x * gridDim.y * gridDim.z;
    unsigned sum, cnt, mine, sp = 0u;
    for (;;) {
        sum = 0u; cnt = 0u; mine = 0u;
#pragma unroll
        for (unsigned j = 0; j < 16; ++j) { const unsigned c = xb_ld(&bar[XB_XCNT(j)]); sum += c; cnt += (c > 0u) ? 1u : 0u; mine = (j == x) ? c : mine; }
        if (sum == G) break;
        __builtin_amdgcn_s_sleep(1);
        if ((++sp & 255u) == 0u) { if (xb_ld(&bar[XB_TMO])) break; if (sp > XB_SPIN_CAP) { atomicAdd(&bar[XB_TMO], 1u); break; } }
    }
    nloc = mine > 0u ? mine : 1u; nx = cnt > 0u ? cnt : 1u;
}

__device__ __forceinline__ void xcd_barrier(const XcdBarrier& b) {
    asm volatile("s_waitcnt vmcnt(0)" ::: "memory");
    __syncthreads();
    if (xb_t0(b.w)) {
        unsigned* bar = b.bar;
        __builtin_amdgcn_s_waitcnt(0);
        unsigned nloc = b.st[0], nx = b.st[1];
        if (nloc == 0u) { xcd_barrier_complete(bar, b.x, nloc, nx); b.st[0] = nloc; b.st[1] = nx; }
        const unsigned old = xb_add(&bar[XB_XSUB(b.x)], 1u);
        const unsigned gen = old / nloc;
        if (old + 1u == (gen + 1u) * nloc) {
            __builtin_amdgcn_fence(__ATOMIC_RELEASE, "agent");
            asm volatile("s_waitcnt vmcnt(0)" ::: "memory");
            const unsigned og = xb_add(&bar[XB_TOP], 1u);
            const unsigned tg = og / nx;
            if (og + 1u == (tg + 1u) * nx) xb_add(&bar[XB_TOPGEN], 1u);
            else XB_SPIN(xb_ld(&bar[XB_TOPGEN]) == tg, bar);
            __builtin_amdgcn_fence(__ATOMIC_ACQUIRE, "agent");
            xb_add(&bar[XB_XGEN(b.x)], 1u);
            asm volatile("s_waitcnt vmcnt(0)" ::: "memory");
        } else {
            XB_SPIN(xb_ld(&bar[XB_XGEN(b.x)]) == gen, bar);
            __builtin_amdgcn_fence(__ATOMIC_ACQUIRE, "agent");
            asm volatile("s_waitcnt vmcnt(0)" ::: "memory");
        }
    }
    __syncthreads();
}
struct Args { const void* in[36]; float* out; unsigned char* ws; int ph_lo, ph_hi, li, pad; };
typedef const __attribute__((address_space(4))) Args* cargs;
__device__ __forceinline__ int lane_id() { int l; asm volatile("v_mbcnt_lo_u32_b32 %0, -1, 0\n\tv_mbcnt_hi_u32_b32 %0, -1, %0" : "=v"(l)); return l; }
struct Frame { LAS unsigned char* lds; unsigned char* ws; float* out; int lane, wave, bid, gw, NGW, G, NT; };
#define LANE F.lane
__device__ __forceinline__ Frame make_frame(cargs ap, int wave0, LAS unsigned char* lds) {
    Frame F; int w = wave0, b = (int)blockIdx.x, g = (int)gridDim.x; asm volatile("" : "+s"(w), "+s"(b), "+s"(g));
    F.lds = lds; F.ws = ap->ws; F.out = ap->out; F.lane = lane_id(); F.wave = w; F.bid = b; F.G = g; F.gw = b * NWAVES + w; F.NGW = g * NWAVES; F.NT = g * NTHR;
    return F;
}

__device__ __forceinline__ int rope_perm_col(int n) { const int c = n % 192; if (c < 128) return n; const int j = c - 128; return n - c + 128 + 2 * (j & 31) + (j >> 5); }
__device__ __forceinline__ void tr_item(const float* W, int ldw, int col0, int Kvalid, int nblk, bf16* WT, int ldt, bool zpad, LAS float* scr, int item, int lane, bool rperm = false) {
    const int kb = item / nblk, nb = item % nblk, k0 = 64 * kb, n0 = 32 * nb;
    float wv[32];
#pragma unroll
    for (int i = 0; i < 32; ++i) { const int kr = min(k0 + 2 * i + (lane >> 5), Kvalid - 1); wv[i] = W[(size_t)kr * ldw + col0 + n0 + (lane & 31)]; }
    __builtin_amdgcn_sched_barrier(0);
#pragma unroll
    for (int i = 0; i < 32; ++i) { const int kk = 2 * i + (lane >> 5); scr[kk * 33 + (lane & 31)] = (k0 + kk < Kvalid) ? wv[i] : 0.f; }
    LDS_WAIT(); asm volatile("" ::: "memory");
    const int c = lane & 7;
#pragma unroll
    for (int j = 0; j < 4; ++j) { const int n = (lane >> 3) + 8 * j; const LAS float* s = scr + (8 * c) * 33 + n;
        v4u o; o.x = pk2(s[0 * 33], s[1 * 33]); o.y = pk2(s[2 * 33], s[3 * 33]); o.z = pk2(s[4 * 33], s[5 * 33]); o.w = pk2(s[6 * 33], s[7 * 33]);
        const int nd = rperm ? rope_perm_col(n0 + n) : n0 + n;
        *(v4u*)(WT + (size_t)nd * ldt + k0 + 8 * c) = o;
        if (zpad) *(v4u*)(WT + (size_t)nd * ldt + 64 + 8 * c) = (v4u){0u, 0u, 0u, 0u}; }
    LDS_WAIT(); asm volatile("" ::: "memory");
}
#define TRJOB_(W_, ldw_, col0_, Kv_, Nc_, WT_, ldt_, zp_, rp_) do { const int nblk_ = (Nc_) / 32, items_ = (((Kv_) + 63) / 64) * nblk_; \
    for (int it_ = ((F.gw - base_) % F.NGW + F.NGW) % F.NGW; it_ < items_; it_ += F.NGW) tr_item((W_), (ldw_), (col0_), (Kv_), nblk_, (bf16*)(WT_), (ldt_), (zp_), scr, it_, LANE, (rp_)); base_ = (base_ + items_) % F.NGW; } while (0)
#define TRJOB(W_, ldw_, col0_, Kv_, Nc_, WT_, ldt_, zp_) TRJOB_(W_, ldw_, col0_, Kv_, Nc_, WT_, ldt_, zp_, false)

__device__ __forceinline__ void p0_prologue(Frame& F, cargs a) {
    LAS float* scr = (LAS float*)(F.lds + F.wave * 16384);
    unsigned char* ws = F.ws; int base_ = 0;
    for (int l = 0; l < 2; ++l) {
        for (int p = 0; p < 4; ++p) TRJOB((const float*)a->in[9] + (size_t)(l * 4 + p) * 1024 * 2048, 2048, 0, 1024, 2048, ws + WS_WIN + (size_t)l * WIN_L + (size_t)p * 4 * MiB, 1024, false);
        TRJOB((const float*)a->in[11] + (size_t)l * 1024 * 64, 64, 0, 1024, 64, ws + WS_WIN + (size_t)l * WIN_L + 16 * MiB, 1024, false);
        TRJOB((const float*)a->in[14] + (size_t)l * 1024 * 64, 64, 0, 1024, 64, ws + WS_WIN + (size_t)l * WIN_L + 16 * MiB + MiB / 2, 1024, false);
        TRJOB((const float*)a->in[12] + (size_t)l * 64 * 2048, 2048, 0, 64, 2048, ws + WS_W2 + (size_t)l * (MiB / 2), 128, true);
        TRJOB((const float*)a->in[15] + (size_t)l * 64 * 2048, 2048, 0, 64, 2048, ws + WS_W2 + (size_t)(2 + l) * (MiB / 2), 128, true);
        TRJOB((const float*)a->in[24] + (size_t)l * 2048 * 1024, 1024, 0, 2048, 1024, ws + WS_WO + (size_t)l * 4 * MiB, 2048, false);
        TRJOB((const float*)a->in[31] + (size_t)l * 1024 * 2432, 2432, 0, 1024, 384, ws + WS_WQ + (size_t)l * MiB, 1024, false);
        TRJOB((const float*)a->in[31] + (size_t)l * 1024 * 2432, 2432, 384, 1024, 2048, ws + WS_WZ + (size_t)l * 4 * MiB, 1024, false);
        TRJOB_((const float*)a->in[33] + (size_t)l * 384 * 3072, 3072, 0, 384, 3072, ws + WS_WUQ + (size_t)l * (5 * MiB / 2), 384, false, true);
        TRJOB((const float*)a->in[34] + (size_t)l * 2048 * 1024, 1024, 0, 2048, 1024, ws + WS_WBO + (size_t)l * 4 * MiB, 2048, false);
    }
    TRJOB((const float*)a->in[17], 32, 0, 1024, 32, ws + WS_WIN + WIN_L + 17 * MiB, 1024, false);
    TRJOB((const float*)a->in[18], 2048, 0, 32, 2048, ws + WS_W2 + (size_t)4 * (MiB / 2), 128, true);
    TRJOB((const float*)a->in[26], 320, 0, 1024, 320, ws + WS_WDKV, 1024, false);
    TRJOB((const float*)a->in[28], 2048, 0, 256, 2048, ws + WS_WUK, 256, false);
    TRJOB((const float*)a->in[29], 2048, 0, 256, 2048, ws + WS_WUV, 256, false);
    { const f32x4* xs = (const f32x4*)a->in[1]; f32x4* X4 = (f32x4*)(ws + WS_X) + (size_t)MP * 256;
      for (int i = (F.bid * NTHR + F.wave * 64 + LANE); i < 256 * 256; i += F.NT) X4[i] = i < DEC_BATCH * 256 ? xs[i] : (f32x4){0.f, 0.f, 0.f, 0.f}; }
    { float* T = (float*)(ws + WS_ROPE);
      for (int i = (F.bid * NTHR + F.wave * 64 + LANE); i < 2049 * 32; i += F.NT) { const int p = i >> 5, f = i & 31; const double pos = p < 2048 ? (double)p : 8192.0;
          const double ang = pos * (double)exp2f(-(float)f * (13.287712379549449f / 32.0f)); T[2 * i] = (float)cos(ang); T[2 * i + 1] = (float)sin(ang); } }
}

__device__ __forceinline__ void load_row(const float* row, int lane, f32x4 (&v)[4]) {
#pragma unroll
    for (int j = 0; j < 4; ++j) v[j] = ((const f32x4*)row)[lane + 64 * j];
}
__device__ __forceinline__ float row_rs(const f32x4 (&v)[4]) {
    float s = 0.f;
#pragma unroll
    for (int j = 0; j < 4; ++j) s += (v[j].x * v[j].x + v[j].y * v[j].y) + (v[j].z * v[j].z + v[j].w * v[j].w);
    return 1.0f / sqrtf(wave_sum(s) * (1.0f / 1024.0f) + NORM_EPS);
}
__device__ __forceinline__ void norm_rows_bf16(Frame& F, const float* X, const float* w, bf16* O) {
    f32x4 w4[4]; load_row(w, LANE, w4);
    for (int m = F.gw; m < MT; m += F.NGW) { f32x4 x[4]; load_row(X + (size_t)m * 1024, LANE, x); const float rs = row_rs(x);
#pragma unroll
        for (int j = 0; j < 4; ++j) { const f32x4 h = x[j] * rs * w4[j]; v2u o; o.x = pk2(h.x, h.y); o.y = pk2(h.z, h.w); *(v2u*)(O + (size_t)m * 1024 + 4 * LANE + 256 * j) = o; } }
}

__device__ __forceinline__ void norm2_rows_bf16(Frame& F, const float* X, const float* wa, bf16* Oa, const float* wb, bf16* Ob) {
    f32x4 a4[4], b4[4]; load_row(wa, LANE, a4); load_row(wb, LANE, b4);
    for (int m = F.gw; m < MT; m += F.NGW) { f32x4 x[4]; load_row(X + (size_t)m * 1024, LANE, x); const float rs = row_rs(x);
#pragma unroll
        for (int j = 0; j < 4; ++j) { const f32x4 xs = x[j] * rs, ha = xs * a4[j], hb = xs * b4[j]; v2u o; o.x = pk2(ha.x, ha.y); o.y = pk2(ha.z, ha.w); *(v2u*)(Oa + (size_t)m * 1024 + 4 * LANE + 256 * j) = o;
            o.x = pk2(hb.x, hb.y); o.y = pk2(hb.z, hb.w); *(v2u*)(Ob + (size_t)m * 1024 + 4 * LANE + 256 * j) = o; } }
}

__device__ __forceinline__ void a1_prepass(Frame& F, cargs a, int l) {
    const float* Xw = (const float*)(F.ws + WS_X); const float* X = l == 0 ? (const float*)a->in[0] : Xw;
    const float* nw = (const float*)a->in[7] + l * 1024; const float* mix = (const float*)a->in[8] + l * 6 * 1024; const float* sshift = (const float*)a->in[3] + (size_t)l * DEC_BATCH * 1024;
    f32x4 w4[4]; load_row(nw, LANE, w4);
    LAS f32x4* mxl = (LAS f32x4*)F.lds;
    for (int i = F.wave * 64 + LANE; i < 6 * 256; i += NTHR) mxl[i] = ((const f32x4*)mix)[i];
    __syncthreads();
    for (int m = F.gw; m < MT; m += F.NGW) {
        f32x4 x[4], h[4], hp[4]; load_row((m < MP ? X : Xw) + (size_t)m * 1024, LANE, x); const float rs = row_rs(x);
#pragma unroll
        for (int j = 0; j < 4; ++j) { h[j] = x[j] * rs * w4[j]; hp[j] = (f32x4){0.f, 0.f, 0.f, 0.f}; }
        if (m < MP) { if ((m & (SEQ - 1)) != 0) { f32x4 xq[4]; load_row(X + (size_t)(m - 1) * 1024, LANE, xq); const float rq = row_rs(xq);
#pragma unroll
                for (int j = 0; j < 4; ++j) hp[j] = xq[j] * rq * w4[j]; } }
        else if (m < MP + DEC_BATCH) load_row(sshift + (size_t)(m - MP) * 1024, LANE, hp);
#pragma unroll
        for (int p = 0; p < 6; ++p) { bf16* O = (bf16*)(F.ws + WS_AM + (size_t)p * AM_STRIDE) + (size_t)m * 1024;
#pragma unroll
            for (int j = 0; j < 4; ++j) { const f32x4 mx = mxl[p * 256 + LANE + 64 * j]; const f32x4 o = h[j] + (hp[j] - h[j]) * mx;
                v2u w; w.x = pk2(o.x, o.y); w.y = pk2(o.z, o.w); *(v2u*)(O + 4 * LANE + 256 * j) = w; } }
        float* so = nullptr;
        if (m < MP) { if ((m & (SEQ - 1)) == SEQ - 1) so = F.out + O_SHP + (size_t)(l * BATCH + (m >> 11)) * 1024; }
        else if (m < MP + DEC_BATCH) so = F.out + O_SHS + (size_t)(l * DEC_BATCH + (m - MP)) * 1024;
        if (so) {
#pragma unroll
            for (int j = 0; j < 4; ++j) ((f32x4*)so)[LANE + 64 * j] = h[j]; }
    }
}

typedef float f32x2 __attribute__((ext_vector_type(2)));
__device__ __forceinline__ void unpack8(v4u u, float (&f)[8]) { f[0] = bflo(u.x); f[1] = bfhi(u.x); f[2] = bflo(u.y); f[3] = bfhi(u.y); f[4] = bflo(u.z); f[5] = bfhi(u.z); f[6] = bflo(u.w); f[7] = bfhi(u.w); }
constexpr int FS_TS = 16, FS_Y = FS_TS * 6 * 64 * 4, FS_Z = FS_Y + FS_TS * 64 * 4, FS_BON = FS_Z + FS_TS * 64 * 2, FS_BH = FS_BON + 128, FS_BUF = 2 * FS_BH;
static_assert(2 * FS_BUF <= RING_BYTES && FS_BH % 16 == 0, "fused scan LDS");
template <int CTRL> __device__ __forceinline__ float dppf(float v) { return __builtin_bit_cast(float, __builtin_amdgcn_update_dpp(0, __builtin_bit_cast(int, v), CTRL, 0xF, 0xF, false)); }
__device__ __forceinline__ float wave_sum_fast(float v) {
    v += dppf<0xB1>(v); v += dppf<0x4E>(v); v += dppf<0x124>(v); v += dppf<0x128>(v);
    const int iv = __builtin_bit_cast(int, v);
    return (__builtin_bit_cast(float, __builtin_amdgcn_readlane(iv, 0)) + __builtin_bit_cast(float, __builtin_amdgcn_readlane(iv, 16))) + (__builtin_bit_cast(float, __builtin_amdgcn_readlane(iv, 32)) + __builtin_bit_cast(float, __builtin_amdgcn_readlane(iv, 48)));
}
struct HeadPrm { float w0, a0, v0, kk, ka, rk, lnw, lnb; };
__device__ __forceinline__ float frcp(float x) { return __builtin_amdgcn_rcpf(x); }
__device__ __forceinline__ float fsig(float x) { return __builtin_amdgcn_rcpf(1.0f + __builtin_amdgcn_exp2f(-1.4426950408889634f * x)); }
__device__ __forceinline__ float wkv_step_lds(f32x2 (&S)[32], const LAS float* op, int lane) {
    const LAS f32x4* a4 = (const LAS f32x4*)op; const LAS f32x4* w4 = a4 + 16; const LAS f32x4* b4 = a4 + 32; const LAS f32x4* k4 = a4 + 48; const LAS f32x4* r4 = a4 + 64;
    const float vv = op[320 + lane];
    f32x2 s0 = (f32x2){0.f, 0.f}, s1 = s0;
#pragma unroll
    for (int q = 0; q < 16; ++q) { const f32x4 a = a4[q]; s0 += S[2 * q] * (f32x2){a.x, a.y}; s1 += S[2 * q + 1] * (f32x2){a.z, a.w}; }
    const f32x2 st = s0 + s1; const float sa = st.x + st.y; const f32x2 sa2 = (f32x2){sa, sa}, vv2 = (f32x2){vv, vv};
    f32x2 y0 = (f32x2){0.f, 0.f}, y1 = y0;
#pragma unroll
    for (int q = 0; q < 16; ++q) { const f32x4 w = w4[q], b = b4[q], k = k4[q], r = r4[q];
        S[2 * q] = S[2 * q] * (f32x2){w.x, w.y} + (sa2 * (f32x2){b.x, b.y} + vv2 * (f32x2){k.x, k.y}); y0 += S[2 * q] * (f32x2){r.x, r.y};
        S[2 * q + 1] = S[2 * q + 1] * (f32x2){w.z, w.w} + (sa2 * (f32x2){b.z, b.w} + vv2 * (f32x2){k.z, k.w}); y1 += S[2 * q + 1] * (f32x2){r.z, r.w}; }
    const f32x2 yt = y0 + y1; return yt.x + yt.y;
}
__device__ __forceinline__ void fs_prep_one(const HeadPrm& P, int l, float r, float k, float v, float dw, float da, float dv, float vf, LAS float* op, int lane, float& bon) {
    const float ia = da, w = __builtin_amdgcn_exp2f(dw);
    if (l) v = v + (vf - v) * dv;
    const float kk = k * P.kk, n2 = wave_sum_fast(kk * kk), inv = 1.0f / fmaxf(sqrtf(n2), 1e-12f), q = kk * inv, kp = k * (1.0f + (ia - 1.0f) * P.ka);
    bon = wave_sum_fast(r * kp * P.rk);
    op[lane] = -q; op[64 + lane] = w; op[128 + lane] = q * ia; op[192 + lane] = kp; op[256 + lane] = r; op[320 + lane] = v;
}
__device__ __forceinline__ float fs_post_one(const HeadPrm& P, float y, float vp, float z, float bon) {
    const float mu = wave_sum_fast(y) * (1.0f / 64.0f), d = y - mu, var = wave_sum_fast(d * d) * (1.0f / 64.0f);
    const float yn = d * __builtin_amdgcn_rsqf(var + GN_EPS) * P.lnw + P.lnb; return (yn + bon * vp) * (z * fsig(z));
}
__device__ __forceinline__ float ldbf(const bf16* p) { return bflo((unsigned)*p); }
__device__ __forceinline__ bf16 tobf(float x) { return __builtin_bit_cast(unsigned short, (__bf16)x); }
typedef short s16x4_t __attribute__((ext_vector_type(4)));
#define MF16(a_, b_, c_) __builtin_amdgcn_mfma_f32_16x16x16bf16_1k((a_), (b_), (c_), 0, 0, 0)
#define MF32(a_, b_, c_) __builtin_amdgcn_mfma_f32_16x16x32_bf16((a_), (b_), (c_), 0, 0, 0)
#define CAT8(a_, b_) __builtin_shufflevector((a_), (b_), 0, 1, 2, 3, 4, 5, 6, 7)
typedef __bf16 bf16x4_nat __attribute__((ext_vector_type(4)));
__device__ __forceinline__ s16x4_t cvt4(f32x4 v) { return __builtin_bit_cast(s16x4_t, __builtin_convertvector(v, bf16x4_nat)); }
constexpr int CK_TP = 144, CK_KP = 40;
constexpr int CK_AT = 0, CK_RT = CK_AT + 16 * CK_TP, CK_BH = CK_RT + 16 * CK_TP, CK_KH = CK_BH + 16 * CK_TP, CK_BHT = CK_KH + 16 * CK_TP, CK_KHT = CK_BHT + 64 * CK_KP, CK_VT = CK_KHT + 64 * CK_KP,
    CK_PC = CK_VT + 64 * CK_KP, CK_OPB = CK_PC + 256;
constexpr int RG_VP = 0, RG_Z = 2048, RG_BON = 4096, RG_SZ = 4224;
constexpr int BH_OPB = 0, BH_RING = 2 * CK_OPB, BH_Y = BH_RING + 3 * RG_SZ, BH_LW = BH_Y + 2 * 4096, BH_PRM = BH_LW + 4096, BH_SZ = BH_PRM + 6 * 256;
static_assert(2 * BH_SZ <= RING_BYTES && BH_SZ % 16 == 0 && CK_OPB % 16 == 0, "chunked scan LDS");
typedef short v4i16_ck __attribute__((ext_vector_type(4)));
__device__ __forceinline__ s16x4_t ck_tr(const LAS unsigned char* p) { return __builtin_bit_cast(s16x4_t, __builtin_amdgcn_ds_read_tr16_b64_v4i16((LAS v4i16_ck*)p)); }
__device__ __forceinline__ void ck_scan_chunk(f32x4 (&ST)[4][4], const LAS unsigned char* ob, const LAS unsigned char* vpb, LAS float* yb, int c16, int g) {
    const f32x4 zero4 = (f32x4){0.f, 0.f, 0.f, 0.f};
    bf16x8 at[2], rt[2], bh[2], kh[2];
#pragma unroll
    for (int ks = 0; ks < 2; ++ks) { const int o = c16 * CK_TP + 16 * g + 64 * ks;
        at[ks] = *(const LAS bf16x8*)(ob + CK_AT + o); rt[ks] = *(const LAS bf16x8*)(ob + CK_RT + o); bh[ks] = *(const LAS bf16x8*)(ob + CK_BH + o); kh[ks] = *(const LAS bf16x8*)(ob + CK_KH + o); }
    f32x4 qN = zero4, qL = zero4, qMk = zero4, qNbr = zero4, qNkr = zero4;
#pragma unroll
    for (int ks = 0; ks < 2; ++ks) { qN = MF32(bh[ks], at[ks], qN); qL = MF32(at[ks], bh[ks], qL); qMk = MF32(kh[ks], at[ks], qMk); qNbr = MF32(bh[ks], rt[ks], qNbr); qNkr = MF32(kh[ks], rt[ks], qNkr); }
    f32x4 Id;
#pragma unroll
    for (int r = 0; r < 4; ++r) { const int row = 4 * g + r; Id[r] = row == c16 ? 1.f : 0.f;
        if (!(row < c16)) { qN[r] = 0.f; qMk[r] = 0.f; }
        if (!(row <= c16)) { qNbr[r] = 0.f; qNkr[r] = 0.f; }
        if (!(c16 < row)) qL[r] = 0.f; }
    const s16x4_t aN = cvt4(qN), aL = cvt4(qL), aMk = cvt4(qMk), aNbr = cvt4(qNbr), aNkr = cvt4(qNkr);
    const f32x4 n2 = MF16(aL, aN, zero4), l2 = MF16(aN, aL, zero4);
    const s16x4_t aN2 = cvt4(n2), aL2 = cvt4(l2);
    const f32x4 n4 = MF16(aL2, aN2, zero4), l4 = MF16(aN2, aL2, zero4);
    const f32x4 n8 = MF16(cvt4(l4), cvt4(n4), zero4);
    const f32x4 p1t = MF16(cvt4(n2 + Id), cvt4(qL + Id), zero4);
    const f32x4 p2 = MF16(cvt4(l4 + Id), cvt4(n8 + Id), zero4);
    const s16x4_t aT = cvt4(MF16(cvt4(p1t), cvt4(p2), zero4));
    s16x4_t af[4], rf[4], bfr[4], kfr[4], vtr[4]; f32x4 pc[4]; s16x4_t Sb[4];
#pragma unroll
    for (int ki = 0; ki < 4; ++ki) { const int o = c16 * CK_TP + (16 * ki + 4 * g) * 2; af[ki] = *(const LAS s16x4_t*)(ob + CK_AT + o); rf[ki] = *(const LAS s16x4_t*)(ob + CK_RT + o);
        const int o2 = (4 * g + (c16 >> 2)) * CK_TP + (16 * ki + 4 * (c16 & 3)) * 2; bfr[ki] = ck_tr(ob + CK_BH + o2); kfr[ki] = ck_tr(ob + CK_KH + o2);
        vtr[ki] = ck_tr(vpb + (4 * g + (c16 >> 2)) * 128 + (16 * ki + 4 * (c16 & 3)) * 2);
        pc[ki] = *(const LAS f32x4*)(ob + CK_PC + (16 * ki + 4 * g) * 4); }
    f32x4 yt[4];
#pragma unroll
    for (int vi = 0; vi < 4; ++vi) {
        f32x4 xt = zero4, y0 = zero4;
#pragma unroll
        for (int ki = 0; ki < 4; ki += 2) { Sb[ki] = cvt4(ST[ki][vi]); Sb[ki + 1] = cvt4(ST[ki + 1][vi]); const bf16x8 sb2 = CAT8(Sb[ki], Sb[ki + 1]);
            xt = MF32(CAT8(af[ki], af[ki + 1]), sb2, xt); y0 = MF32(CAT8(rf[ki], rf[ki + 1]), sb2, y0); }
        const s16x4_t vt = vtr[vi];
        xt = MF16(aMk, vt, xt);
        const s16x4_t ub = cvt4(MF16(aT, cvt4(xt), zero4));
        const bf16x8 uv = CAT8(ub, vt);
        yt[vi] = MF32(CAT8(aNbr, aNkr), uv, y0);
#pragma unroll
        for (int ki = 0; ki < 4; ++ki) { ST[ki][vi] = MF32(CAT8(bfr[ki], kfr[ki]), uv, ST[ki][vi]); ST[ki][vi] *= pc[ki]; }
    }
#pragma unroll
    for (int vi = 0; vi < 4; ++vi)
#pragma unroll
        for (int r = 0; r < 4; ++r) yb[(4 * g + r) * 64 + 16 * vi + c16] = yt[vi][r];
}
__device__ __forceinline__ void a5_fused(Frame& F, cargs a, int l) {
    unsigned char* ws = F.ws; const int lane = F.lane;
    const bf16* R = (const bf16*)(ws + WS_R); const bf16* K = (const bf16*)(ws + WS_K); const bf16* V = (const bf16*)(ws + (l ? WS_V1 : WS_V0)); const bf16* VF = (const bf16*)(ws + WS_V0); const bf16* Z = (const bf16*)(ws + WS_Z);
    const bf16* DW = (const bf16*)(ws + WS_WD); const bf16* DA = (const bf16*)(ws + WS_IA); const bf16* DV = (const bf16*)(ws + WS_VG); bf16* G = (bf16*)(ws + WS_G);
    const float* pw0 = (const float*)a->in[10] + l * 2048; const float* pa0 = (const float*)a->in[13] + l * 2048; const float* pv0 = (const float*)a->in[16]; const float* pkk = (const float*)a->in[19] + l * 2048;
    const float* pka = (const float*)a->in[20] + l * 2048; const float* prk = (const float*)a->in[21] + l * 2048; const float* plw = (const float*)a->in[22] + l * 2048; const float* plb = (const float*)a->in[23] + l * 2048;
    constexpr int NCH = SEQ / 16;
    for (int pr = F.bid; pr < BATCH * A_HEADS / 2; pr += F.G) { const int bh0 = 2 * pr;
        const int role = F.wave >> 1, hb = F.wave & 1, bh = bh0 + hb, b = bh >> 5, hh = bh & 31, ch = hh * 64 + lane;
        LAS unsigned char* blk = F.lds + hb * BH_SZ;
        const size_t rowb = (size_t)b * SEQ; const int c16 = lane & 15, g = lane >> 4;
#define CK_BAR() do { asm volatile("s_waitcnt lgkmcnt(0)" ::: "memory"); __builtin_amdgcn_s_barrier(); asm volatile("" ::: "memory"); } while (0)
#define CKV_LOAD(cc, SET) do { const size_t ro = (rowb + (size_t)(cc) * 16) * 2048;     \
            _Pragma("unroll") for (int j = 0; j < 2; ++j) { SET##r[j] = ((const v4u*)(R + ro + voff_))[j]; SET##k[j] = ((const v4u*)(K + ro + voff_))[j]; SET##v[j] = ((const v4u*)(V + ro + voff_))[j]; SET##z[j] = ((const v4u*)(Z + ro + voff_))[j]; \
                SET##w[j] = ((const v4u*)(DW + ro + voff_))[j]; SET##a[j] = ((const v4u*)(DA + ro + voff_))[j]; if (l) { SET##d[j] = ((const v4u*)(DV + ro + voff_))[j]; SET##f[j] = ((const v4u*)(VF + ro + voff_))[j]; } } } while (0)
#define CKV_PREP(cc, SET) do { LAS unsigned char* ob = blk + BH_OPB + ((cc) & 1) * CK_OPB; LAS unsigned char* rg = blk + BH_RING + ((cc) % 3) * RG_SZ; \
            float kk_[16], kp_[16], ia_[16], lw_[16]; float n2 = 0.f, bon = 0.f; \
            _Pragma("unroll") for (int j = 0; j < 2; ++j) { float k8[8], a8[8], r8[8], w8[8]; unpack8(SET##k[j], k8); unpack8(SET##a[j], a8); unpack8(SET##r[j], r8); unpack8(SET##w[j], w8); \
                _Pragma("unroll") for (int h = 0; h < 2; ++h) { const f32x4 pkk_ = prm[3 * 16 + 4 * vq_ + 2 * j + h], pka_ = prm[4 * 16 + 4 * vq_ + 2 * j + h], prk_ = prm[5 * 16 + 4 * vq_ + 2 * j + h]; \
                    _Pragma("unroll") for (int e = 0; e < 4; ++e) { const int i = 8 * j + 4 * h + e, e8 = 4 * h + e; const float ia = a8[e8]; ia_[i] = ia; lw_[i] = w8[e8]; \
                        const float kk = k8[e8] * pkk_[e]; kk_[i] = kk; n2 += kk * kk; const float kp = k8[e8] * (1.0f + (ia - 1.0f) * pka_[e]); kp_[i] = kp; bon += r8[e8] * kp * prk_[e]; } } } \
            n2 += dppf<0xB1>(n2); n2 += dppf<0x4E>(n2); bon += dppf<0xB1>(bon); bon += dppf<0x4E>(bon); const float inv = __builtin_amdgcn_rsqf(fmaxf(n2, 1e-24f)); \
              \
            _Pragma("unroll") for (int j = 0; j < 4; ++j) lwp[vt_ * 16 + 4 * vq_ + j] = (f32x4){lw_[4 * j], lw_[4 * j + 1], lw_[4 * j + 2], lw_[4 * j + 3]}; \
            LDS_WAIT(); asm volatile("" ::: "memory"); \
            { float c_[16]; _Pragma("unroll") for (int t = 0; t < 16; ++t) c_[t] = ((const LAS float*)lwp)[t * 64 + lane]; \
              _Pragma("unroll") for (int t = 1; t < 16; ++t) c_[t] += c_[t - 1]; \
              _Pragma("unroll") for (int t = 0; t < 16; ++t) ((LAS float*)lwp)[t * 64 + lane] = c_[t]; } \
            LDS_WAIT(); asm volatile("" ::: "memory"); \
            float lp_[16]; _Pragma("unroll") for (int j = 0; j < 4; ++j) { const f32x4 v = lwp[vt_ * 16 + 4 * vq_ + j]; lp_[4 * j] = v.x; lp_[4 * j + 1] = v.y; lp_[4 * j + 2] = v.z; lp_[4 * j + 3] = v.w; } \
            v4u oa[2], orr[2], ob_[2], ok[2], ov[2]; \
            _Pragma("unroll") for (int j = 0; j < 2; ++j) { float r8[8], v8[8]; unpack8(SET##r[j], r8); unpack8(SET##v[j], v8); \
                if (l) { float d8[8], f8[8]; unpack8(SET##d[j], d8); unpack8(SET##f[j], f8); _Pragma("unroll") for (int h = 0; h < 2; ++h) { \
                        _Pragma("unroll") for (int e = 0; e < 4; ++e) { const int e8 = 4 * h + e; v8[e8] = v8[e8] + (f8[e8] - v8[e8]) * d8[e8]; } } } \
                _Pragma("unroll") for (int e = 0; e < 8; e += 2) { const int i = 8 * j + e; \
                    const float P0 = __builtin_amdgcn_exp2f(lp_[i]), P1 = __builtin_amdgcn_exp2f(lp_[i + 1]), R0 = __builtin_amdgcn_exp2f(-lp_[i]), R1 = __builtin_amdgcn_exp2f(-lp_[i + 1]); \
                    const float M0 = __builtin_amdgcn_exp2f(lp_[i] - lw_[i]), M1 = __builtin_amdgcn_exp2f(lp_[i + 1] - lw_[i + 1]), q0 = kk_[i] * inv, q1 = kk_[i + 1] * inv; \
                    oa[j][e >> 1] = (unsigned)tobf(-q0 * M0) | ((unsigned)tobf(-q1 * M1) << 16); orr[j][e >> 1] = (unsigned)tobf(r8[e] * P0) | ((unsigned)tobf(r8[e + 1] * P1) << 16); \
                    ob_[j][e >> 1] = (unsigned)tobf(q0 * ia_[i] * R0) | ((unsigned)tobf(q1 * ia_[i + 1] * R1) << 16); ok[j][e >> 1] = (unsigned)tobf(kp_[i] * R0) | ((unsigned)tobf(kp_[i + 1] * R1) << 16); \
                    ov[j][e >> 1] = (unsigned)tobf(v8[e]) | ((unsigned)tobf(v8[e + 1]) << 16); \
                    if (vt_ == 15) { ((LAS float*)(ob + CK_PC))[16 * vq_ + i] = P0; ((LAS float*)(ob + CK_PC))[16 * vq_ + i + 1] = P1; } } } \
            _Pragma("unroll") for (int j = 0; j < 2; ++j) { const int o = vt_ * CK_TP + 32 * vq_ + 16 * j; *(LAS v4u*)(ob + CK_AT + o) = oa[j]; *(LAS v4u*)(ob + CK_RT + o) = orr[j]; *(LAS v4u*)(ob + CK_BH + o) = ob_[j]; *(LAS v4u*)(ob + CK_KH + o) = ok[j]; \
                *(LAS v4u*)(rg + RG_VP + vt_ * 128 + 32 * vq_ + 16 * j) = ov[j]; *(LAS v4u*)(rg + RG_Z + vt_ * 128 + 32 * vq_ + 16 * j) = SET##z[j]; } \
            if (vq_ == 0) ((LAS float*)(rg + RG_BON))[vt_] = bon; } while (0)
#define CK_POST(cc) do { const LAS unsigned char* rg = blk + BH_RING + ((cc) % 3) * RG_SZ; const LAS float* yb = (const LAS float*)(blk + BH_Y + ((cc) & 1) * 4096) + pt_ * 64 + 16 * pq_; \
            float y_[16], vp_[16], z_[16]; \
            _Pragma("unroll") for (int j = 0; j < 4; ++j) { const f32x4 v = ((const LAS f32x4*)yb)[j]; y_[4 * j] = v.x; y_[4 * j + 1] = v.y; y_[4 * j + 2] = v.z; y_[4 * j + 3] = v.w; } \
            _Pragma("unroll") for (int j = 0; j < 2; ++j) { float t8[8]; unpack8(((const LAS v4u*)(rg + RG_VP + pt_ * 128 + 32 * pq_))[j], t8); _Pragma("unroll") for (int e = 0; e < 8; ++e) vp_[8 * j + e] = t8[e]; \
                unpack8(((const LAS v4u*)(rg + RG_Z + pt_ * 128 + 32 * pq_))[j], t8); _Pragma("unroll") for (int e = 0; e < 8; ++e) z_[8 * j + e] = t8[e]; } \
            const float bon = ((const LAS float*)(rg + RG_BON))[pt_]; float sm = 0.f; \
            _Pragma("unroll") for (int j = 0; j < 16; ++j) sm += y_[j]; \
            sm += dppf<0xB1>(sm); sm += dppf<0x4E>(sm); const float mu = sm * (1.0f / 64.0f); float sq = 0.f; \
            _Pragma("unroll") for (int j = 0; j < 16; ++j) { y_[j] -= mu; sq += y_[j] * y_[j]; } \
            sq += dppf<0xB1>(sq); sq += dppf<0x4E>(sq); const float rstd = __builtin_amdgcn_rsqf(sq * (1.0f / 64.0f) + GN_EPS); \
            v4u o_[2]; \
            _Pragma("unroll") for (int j = 0; j < 16; j += 2) { const float g0 = (y_[j] * rstd * lw_[j] + lb_[j] + bon * vp_[j]) * (z_[j] * fsig(z_[j])), g1 = (y_[j + 1] * rstd * lw_[j + 1] + lb_[j + 1] + bon * vp_[j + 1]) * (z_[j + 1] * fsig(z_[j + 1])); \
                o_[j >> 3][(j >> 1) & 3] = (unsigned)tobf(g0) | ((unsigned)tobf(g1) << 16); } \
            v4u* gp = (v4u*)(G + (rowb + (size_t)(cc) * 16 + pt_) * 2048 + hh * 64 + 16 * pq_); gp[0] = o_[0]; gp[1] = o_[1]; } while (0)
        typedef unsigned short us2 __attribute__((ext_vector_type(2)));
        if (role == 0) { f32x4 ST[4][4];
#pragma unroll
            for (int i = 0; i < 4; ++i)
#pragma unroll
                for (int j = 0; j < 4; ++j) ST[i][j] = (f32x4){0.f, 0.f, 0.f, 0.f};
            CK_BAR();
            for (int c = 0; c < NCH; ++c) { ck_scan_chunk(ST, blk + BH_OPB + (c & 1) * CK_OPB, blk + BH_RING + (c % 3) * RG_SZ + RG_VP, (LAS float*)(blk + BH_Y + (c & 1) * 4096), c16, g); CK_BAR(); }
            float* so = F.out + O_WKVP + ((size_t)(l * BATCH + b) * A_HEADS + hh) * 4096;
#pragma unroll
            for (int ki = 0; ki < 4; ++ki)
#pragma unroll
                for (int vi = 0; vi < 4; ++vi) *(f32x4*)(so + (16 * vi + c16) * 64 + 16 * ki + 4 * g) = ST[ki][vi]; }
        else if (role == 1) { const int ln1 = lane_id(), vt_ = ln1 >> 2, vq_ = ln1 & 3; const unsigned voff_ = (unsigned)(vt_ * 2048 + hh * 64 + 16 * vq_); LAS f32x4* lwp = (LAS f32x4*)(blk + BH_LW); const LAS f32x4* prm = (const LAS f32x4*)(blk + BH_PRM);
            { const int ln = lane_id(), c1 = hh * 64 + ln; LAS float* pf = (LAS float*)(blk + BH_PRM); pf[ln] = pw0[c1]; pf[64 + ln] = pa0[c1]; pf[128 + ln] = l ? pv0[c1] : 0.f; pf[192 + ln] = pkk[c1]; pf[256 + ln] = pka[c1]; pf[320 + ln] = prk[c1]; LDS_WAIT(); asm volatile("" ::: "memory"); }
            v4u Ar[2], Ak[2], Av[2], Az[2], Aw[2], Aa[2], Ad[2], Af[2];
#pragma unroll
            for (int j = 0; j < 2; ++j) { Ad[j] = (v4u){0u, 0u, 0u, 0u}; Af[j] = Ad[j]; }
            CKV_LOAD(0, A); CKV_PREP(0, A); CKV_LOAD(1, A); CK_BAR();
            for (int c = 0; c < NCH; ++c) { if (c + 1 < NCH) { CKV_PREP(c + 1, A); if (c + 2 < NCH) CKV_LOAD(c + 2, A); } CK_BAR(); } }
        else if (role == 3) {
            const int ln3 = lane_id(), vt_ = ln3 >> 2, vq_ = ln3 & 3; const unsigned voff_ = (unsigned)(vt_ * 2048 + hh * 64 + 16 * vq_);
            v4u Ar[2], Ak[2], Av[2], Az[2], Aw[2], Aa[2], Ad[2], Af[2];
#pragma unroll
            for (int j = 0; j < 2; ++j) { Ad[j] = (v4u){0u, 0u, 0u, 0u}; Af[j] = Ad[j]; }
            CKV_LOAD(2, A); CK_BAR();
            for (int c = 0; c < NCH; ++c) {
#pragma unroll
                for (int j = 0; j < 2; ++j) asm volatile("" :: "v"(Ar[j]), "v"(Ak[j]), "v"(Av[j]), "v"(Az[j]), "v"(Aw[j]), "v"(Aa[j]), "v"(Ad[j]), "v"(Af[j]));
                if (c + 3 < NCH) CKV_LOAD(c + 3, A);
                CK_BAR(); } }
        else { const int ln2 = lane_id(), pt_ = ln2 >> 2, pq_ = ln2 & 3; float lw_[16], lb_[16];
#pragma unroll
            for (int j = 0; j < 16; ++j) { lw_[j] = plw[hh * 64 + 16 * pq_ + j]; lb_[j] = plb[hh * 64 + 16 * pq_ + j]; }
            CK_BAR();
            for (int c = 0; c < NCH; ++c) { if (c >= 1) CK_POST(c - 1); CK_BAR(); }
            CK_POST(NCH - 1); }
        __syncthreads();
#undef CK_PREP
#undef CKV_LOAD
#undef CKV_PREP
#undef CK_BAR
#undef CK_POST
    }
    const float* stt = (const float*)a->in[2] + (size_t)l * DEC_BATCH * A_HEADS * 4096;
    LAS float* sop = (LAS float*)(F.lds + F.wave * 2048);
    for (int it = F.gw; it < DEC_BATCH * A_HEADS; it += F.NGW) { const int b = it >> 5, hh = it & 31, ch = hh * 64 + lane; const size_t o = (size_t)(MP + b) * 2048 + ch;
        HeadPrm P; P.w0 = pw0[ch]; P.a0 = pa0[ch]; P.v0 = l ? pv0[ch] : 0.f; P.kk = pkk[ch]; P.ka = pka[ch]; P.rk = prk[ch]; P.lnw = plw[ch]; P.lnb = plb[ch];
        const float z = ldbf(Z + o); float bon;
        fs_prep_one(P, l, ldbf(R + o), ldbf(K + o), ldbf(V + o), ldbf(DW + o), ldbf(DA + o), l ? ldbf(DV + o) : 0.f, l ? ldbf(VF + o) : 0.f, sop, lane, bon);
        LDS_WAIT(); asm volatile("" ::: "memory");
        f32x2 S[32]; const float* si = stt + (size_t)it * 4096 + lane * 64;
#pragma unroll
        for (int k = 0; k < 32; k += 2) { const f32x4 v = *(const f32x4*)(si + 2 * k); S[k] = (f32x2){v.x, v.y}; S[k + 1] = (f32x2){v.z, v.w}; }
        const float y = wkv_step_lds(S, sop, lane), vp = sop[320 + lane];
        float* so = F.out + O_WKVS + ((size_t)l * DEC_BATCH * A_HEADS + it) * 4096 + lane * 64;
#pragma unroll
        for (int k = 0; k < 32; k += 2) *(f32x4*)(so + 2 * k) = (f32x4){S[k].x, S[k].y, S[k + 1].x, S[k + 1].y};
        G[o] = (bf16)f2bf(fs_post_one(P, y, vp, z, bon));
        LDS_WAIT(); asm volatile("" ::: "memory");
    }
#undef FS_PREP
#undef FS_POST
}

__device__ __forceinline__ void final_norm(Frame& F, cargs a) {
    const float* X = (const float*)(F.ws + WS_X); f32x4 w4[4]; load_row((const float*)a->in[35], LANE, w4);
    for (int m = F.gw; m < MP + DEC_BATCH; m += F.NGW) { f32x4 x[4]; load_row(X + (size_t)m * 1024, LANE, x); const float rs = row_rs(x);
        float* o = m < MP ? F.out + O_YP + (size_t)m * 1024 : F.out + O_YS + (size_t)(m - MP) * 1024;
#pragma unroll
        for (int j = 0; j < 4; ++j) ((f32x4*)o)[LANE + 64 * j] = x[j] * rs * w4[j]; }
}
__device__ __forceinline__ void b0c_kvpost(Frame& F, cargs a) {
    unsigned char* ws = F.ws; const float* KVR = (const float*)(ws + WS_KVR); bf16* CK = (bf16*)(ws + WS_CKVB); bf16* KP = (bf16*)(ws + WS_KPEB); const float* ROPE = (const float*)(ws + WS_ROPE);
    const f32x4 w4 = ((const f32x4*)a->in[27])[F.lane];
    for (int m = F.gw; m < MP + DEC_BATCH; m += F.NGW) { const float* row = KVR + (size_t)m * 320;
        const f32x4 v = ((const f32x4*)row)[F.lane]; const float ss = wave_sum((v.x * v.x + v.y * v.y) + (v.z * v.z + v.w * v.w));
        const float rs = 1.0f / sqrtf(ss * (1.0f / 256.0f) + NORM_EPS); const f32x4 c = v * rs * w4;
        float* oc = m < MP ? F.out + O_CKVP + (size_t)m * 256 : F.out + O_CKVS + (size_t)(m - MP) * 256; float* ok = m < MP ? F.out + O_KPEP + (size_t)m * 64 : F.out + O_KPES + (size_t)(m - MP) * 64;
        ((f32x4*)oc)[F.lane] = c; v2u pw; pw.x = pk2(c.x, c.y); pw.y = pk2(c.z, c.w); *(v2u*)(CK + (size_t)m * 256 + 4 * F.lane) = pw;
        if (F.lane < 32) { const int i = F.lane, p = m < MP ? (m & (SEQ - 1)) : SEQ; const float x1 = row[256 + i], x2 = row[288 + i], cs = ROPE[(p * 32 + i) * 2], sn = ROPE[(p * 32 + i) * 2 + 1];
            const float o1 = x1 * cs - x2 * sn, o2 = x2 * cs + x1 * sn; ok[i] = o1; ok[32 + i] = o2; *(unsigned*)(KP + (size_t)m * 64 + 2 * i) = pk2(o1, o2); }
    }
}
__device__ __forceinline__ void b1c_cq(Frame& F, cargs a, int l) {
    unsigned char* ws = F.ws; const float* QL = (const float*)(ws + WS_QL); bf16* CQ = (bf16*)(ws + WS_CQ); const float* w = (const float*)a->in[32] + l * 384;
    f32x2 w2[3];
#pragma unroll
    for (int j = 0; j < 3; ++j) w2[j] = *(const f32x2*)(w + 2 * F.lane + 128 * j);
    for (int m = F.gw; m < MT; m += F.NGW) { f32x2 v[3]; float ss = 0.f;
#pragma unroll
        for (int j = 0; j < 3; ++j) { v[j] = *(const f32x2*)(QL + (size_t)m * 384 + 2 * F.lane + 128 * j); ss += v[j].x * v[j].x + v[j].y * v[j].y; }
        const float rs = 1.0f / sqrtf(wave_sum(ss) * (1.0f / 384.0f) + NORM_EPS);
#pragma unroll
        for (int j = 0; j < 3; ++j) *(unsigned*)(CQ + (size_t)m * 384 + 2 * F.lane + 128 * j) = pk2(v[j].x * rs * w2[j].x, v[j].y * rs * w2[j].y); }
}
constexpr int AT_KP = 400, AT_VP = 136, AT_KBYTES = 64 * AT_KP, AT_VBYTES = 128 * AT_VP, AT_BUF = AT_KBYTES + AT_VBYTES;
__device__ __forceinline__ int crow(int r, int hi) { return (r & 3) + 8 * (r >> 2) + 4 * hi; }
typedef __bf16 bf16x8_nat __attribute__((ext_vector_type(8)));
typedef float f32x8 __attribute__((ext_vector_type(8)));
__device__ __forceinline__ bf16x8 pack8f(float a0, float a1, float a2, float a3, float a4, float a5, float a6, float a7) {
    return __builtin_bit_cast(bf16x8, __builtin_convertvector((f32x8){a0, a1, a2, a3, a4, a5, a6, a7}, bf16x8_nat)); }
__device__ __forceinline__ void attn_unit(Frame& F, int b, int hd, int qb) {
    unsigned char* ws = F.ws; const bf16* Q = (const bf16*)(ws + WS_Q);
    const bf16* Z = (const bf16*)(ws + WS_Z); bf16* G = (bf16*)(ws + WS_G);
    LAS unsigned char* Ks = F.lds; LAS unsigned char* Vs = F.lds + AT_KBYTES;
    const int lane = lane_id(), r32 = lane & 31, hi = lane >> 5, tid = F.wave * 64 + lane;
    const int qpos = qb * 256 + F.wave * 32 + r32; const size_t qrow = (size_t)b * SEQ + qpos;
    bf16x8 qf[12];
#pragma unroll
    for (int s = 0; s < 12; ++s) qf[s] = *(const bf16x8*)(Q + qrow * 3072 + hd * 192 + 16 * s + 8 * hi);
    f32x16 o[4];
#pragma unroll
    for (int d = 0; d < 4; ++d)
#pragma unroll
        for (int r = 0; r < 16; ++r) o[d][r] = 0.f;
    float mrow = -1e30f, lrow = 0.f;
    const int ntiles = 4 * qb + 4, wq0 = qb * 256 + F.wave * 32;
    const unsigned gK = (unsigned)((tid >> 4) * 4096 + (tid & 15) * 16), gP = (unsigned)((tid >> 3) * 128 + (tid & 7) * 16), gV = (unsigned)((tid >> 3) * (MP * 2) + (tid & 7) * 16);
    LAS unsigned char* lK = Ks + (tid >> 4) * AT_KP + (tid & 15) * 16; LAS unsigned char* lP = Ks + (tid >> 3) * AT_KP + 256 + (tid & 7) * 16; LAS unsigned char* lV = Vs + (tid >> 3) * AT_VP + (tid & 7) * 16;
    const unsigned char* kb0 = ws + WS_KN + ((size_t)b * SEQ * 2048 + hd * 128) * 2; const unsigned char* pb0 = ws + WS_KPEB + (size_t)b * SEQ * 128; const unsigned char* vb0 = ws + WS_VT + ((size_t)hd * 128 * MP + (size_t)b * SEQ) * 2;
    v4u pk_[3], pv_[2];
#define AT_FETCH(kt_) do { const unsigned char* kb = kb0 + (size_t)(kt_) * (64 * 4096); const unsigned char* pb = pb0 + (size_t)(kt_) * (64 * 128); const unsigned char* vb = vb0 + (size_t)(kt_) * 128; \
        pk_[0] = *(const v4u*)(kb + gK); pk_[1] = *(const v4u*)(kb + 32 * 4096 + gK); pk_[2] = *(const v4u*)(pb + gP); pv_[0] = *(const v4u*)(vb + gV); pv_[1] = *(const v4u*)(vb + (size_t)64 * MP * 2 + gV); } while (0)
    AT_FETCH(0);
    const LAS unsigned char* kA = Ks + r32 * AT_KP + hi * 16;
    const LAS unsigned char* vA = Vs + r32 * AT_VP + hi * 8;
#define AT_KF(st_) (*(const LAS bf16x8*)(kA + ((st_) & 1) * (32 * AT_KP) + ((st_) >> 1) * 32))
#define AT_VF(st_, j_) (*(const LAS v2u*)(vA + ((st_) & 3) * (32 * AT_VP) + ((st_) >> 2) * 32 + 16 * (j_)))
    constexpr int KD = 6, VD = 4;
    for (int kt = 0; kt < ntiles; ++kt) {
        __syncthreads();
        *(LAS v4u*)lK = pk_[0]; *(LAS v4u*)(lK + 32 * AT_KP) = pk_[1]; *(LAS v4u*)lP = pk_[2];
#pragma unroll
        for (int i = 0; i < 2; ++i) { *(LAS v2u*)(lV + i * 64 * AT_VP) = (v2u){pv_[i].x, pv_[i].y}; *(LAS v2u*)(lV + i * 64 * AT_VP + 8) = (v2u){pv_[i].z, pv_[i].w}; }
        __syncthreads();
        if (kt + 1 < ntiles) AT_FETCH(kt + 1);
        if (kt * 64 > wq0 + 31) continue;
        f32x16 s0, s1;
#pragma unroll
        for (int r = 0; r < 16; ++r) { s0[r] = 0.f; s1[r] = 0.f; }
        bf16x8 kf[8];
#pragma unroll
        for (int st = 0; st < KD; ++st) kf[st] = AT_KF(st);
#pragma unroll
        for (int st = 0; st < 24; ++st) {
            if (st + KD < 24) kf[(st + KD) & 7] = AT_KF(st + KD);
            if (st & 1) s1 = __builtin_amdgcn_mfma_f32_32x32x16_bf16(kf[st & 7], qf[st >> 1], s1, 0, 0, 0);
            else s0 = __builtin_amdgcn_mfma_f32_32x32x16_bf16(kf[st & 7], qf[st >> 1], s0, 0, 0, 0);
            __builtin_amdgcn_sched_barrier(0);
        }
        v2u vf[8][2];
#pragma unroll
        for (int st = 0; st < VD; ++st) { vf[st][0] = AT_VF(st, 0); vf[st][1] = AT_VF(st, 1); }
        __builtin_amdgcn_sched_barrier(0);
        if (kt * 64 + 63 > wq0) {
#pragma unroll
            for (int r = 0; r < 16; ++r) { const int key = kt * 64 + crow(r, hi); if (key > qpos) s0[r] = -__builtin_inff(); if (key + 32 > qpos) s1[r] = -__builtin_inff(); } }
        float tmax = s0[0];
#pragma unroll
        for (int r = 1; r < 16; ++r) tmax = fmaxf(tmax, s0[r]);
#pragma unroll
        for (int r = 0; r < 16; ++r) tmax = fmaxf(tmax, s1[r]);
        tmax = xor32_max(tmax);
        if (__builtin_amdgcn_ballot_w64(tmax > mrow + 8.0f) != 0ull) { const float mnew = fmaxf(mrow, tmax), alpha = __builtin_amdgcn_exp2f(mrow - mnew); mrow = mnew; lrow *= alpha;
#pragma unroll
            for (int d = 0; d < 4; ++d)
#pragma unroll
                for (int r = 0; r < 16; ++r) o[d][r] *= alpha; }
        float ps = 0.f;
#pragma unroll
        for (int r = 0; r < 16; ++r) { s0[r] = __builtin_amdgcn_exp2f(s0[r] - mrow); s1[r] = __builtin_amdgcn_exp2f(s1[r] - mrow); ps += s0[r] + s1[r]; }
        lrow += ps;
        bf16x8 pb[4];
        pb[0] = pack8f(s0[0], s0[1], s0[2], s0[3], s0[4], s0[5], s0[6], s0[7]); pb[1] = pack8f(s0[8], s0[9], s0[10], s0[11], s0[12], s0[13], s0[14], s0[15]);
        pb[2] = pack8f(s1[0], s1[1], s1[2], s1[3], s1[4], s1[5], s1[6], s1[7]); pb[3] = pack8f(s1[8], s1[9], s1[10], s1[11], s1[12], s1[13], s1[14], s1[15]);
        __builtin_amdgcn_sched_barrier(0);
#pragma unroll
        for (int st = 0; st < 16; ++st) {
            if (st + VD < 16) { vf[(st + VD) & 7][0] = AT_VF(st + VD, 0); vf[(st + VD) & 7][1] = AT_VF(st + VD, 1); }
            const v4u av = (v4u){vf[st & 7][0].x, vf[st & 7][0].y, vf[st & 7][1].x, vf[st & 7][1].y};
            o[st & 3] = __builtin_amdgcn_mfma_f32_32x32x16_bf16(__builtin_bit_cast(bf16x8, av), pb[st >> 2], o[st & 3], 0, 0, 0);
            __builtin_amdgcn_sched_barrier(0);
        }
    }
#undef AT_FETCH
#undef AT_KF
#undef AT_VF
    lrow = xor32_sum(lrow); const float inv = 1.0f / lrow;
    v2u zq[4][4];
#pragma unroll
    for (int d = 0; d < 4; ++d)
#pragma unroll
        for (int rg = 0; rg < 4; ++rg) zq[d][rg] = *(const v2u*)(Z + qrow * 2048 + hd * 128 + 32 * d + 8 * rg + 4 * hi);
    __builtin_amdgcn_sched_barrier(0);
#pragma unroll
    for (int d = 0; d < 4; ++d)
#pragma unroll
        for (int rg = 0; rg < 4; ++rg) { const int dd = 32 * d + 8 * rg + 4 * hi; const size_t off = qrow * 2048 + hd * 128 + dd;
            const v2u zz = zq[d][rg]; const float z0 = bflo(zz.x), z1 = bfhi(zz.x), z2 = bflo(zz.y), z3 = bfhi(zz.y);
            v2u w; w.x = pk2(o[d][4 * rg] * inv * (z0 * sigmoidf_(z0)), o[d][4 * rg + 1] * inv * (z1 * sigmoidf_(z1))); w.y = pk2(o[d][4 * rg + 2] * inv * (z2 * sigmoidf_(z2)), o[d][4 * rg + 3] * inv * (z3 * sigmoidf_(z3)));
            *(v2u*)(G + off) = w; }
}
__device__ __forceinline__ void b2a_attn_prompt(Frame& F) {
    if (F.wave < 4) __builtin_amdgcn_s_setprio(1);
    const int vcu = (F.G % 8 == 0) ? (F.bid % 8) * (F.G / 8) + F.bid / 8 : F.bid;
    for (int u = vcu; u < BATCH * B_HEADS * 4; u += F.G) { const int bh = u >> 2, qp = u & 3;
        for (int hf = 0; hf < 2; ++hf) attn_unit(F, bh >> 4, bh & 15, hf ? qp : 7 - qp); }
    __builtin_amdgcn_s_setprio(0);
    __syncthreads();
}

constexpr int DT_P = 656;
typedef short v4i16_t __attribute__((ext_vector_type(4)));
__device__ __forceinline__ void b2b_attn_sample(Frame& F, cargs a) {
    unsigned char* ws = F.ws; const float* cckv = (const float*)a->in[4]; const float* ckpe = (const float*)a->in[5]; const int* ptab = (const int*)a->in[6];
    const bf16* QA = (const bf16*)(ws + WS_QABS); float* OP = (float*)(ws + WS_OPART); float* ML = (float*)(ws + WS_ML);
    LAS unsigned char* T = F.lds;
    F.lane = lane_id();
    const int lane = F.lane, hcol = lane & 15, g = lane >> 4, tid = F.wave * 64 + lane, q4 = (lane & 15) >> 2, p4 = lane & 3;
    const bf16* Q = (const bf16*)(ws + WS_Q); const float* wuk = (const float*)a->in[28]; bf16* QAg = (bf16*)(ws + WS_QABS);
    LAS bf16* QAl = (LAS bf16*)(F.lds + 49152);
    for (int hu = F.bid; hu < DEC_BATCH * 2; hu += F.G) for (int si = 0; si < 4; ++si) { const int b = hu >> 1, sp = (hu & 1) * 4 + si;
      if (si == 0) {
        __syncthreads();
        for (int hh = 0; hh < 2; ++hh) { const int hd = 2 * F.wave + hh; const bf16* qn = Q + (size_t)(MP + b) * 3072 + hd * 192;
            float acc[4] = {0.f, 0.f, 0.f, 0.f};
            for (int n = 0; n < 128; n += 4) { const v2u qu = *(const v2u*)(qn + n); const f32x4 q4 = (f32x4){bflo(qu.x), bfhi(qu.x), bflo(qu.y), bfhi(qu.y)};
#pragma unroll
                for (int cc = 0; cc < 4; ++cc) { const f32x4 w4 = *(const f32x4*)(wuk + (size_t)(4 * lane + cc) * 2048 + hd * 128 + n); acc[cc] += (q4.x * w4.x + q4.y * w4.y) + (q4.z * w4.z + q4.w * w4.w); } }
            const v2u w = (v2u){pk2(acc[0], acc[1]), pk2(acc[2], acc[3])}; *(LAS v2u*)(QAl + hd * 320 + 4 * lane) = w;
            const bf16 rp = qn[128 + 2 * (lane & 31) + (lane >> 5)]; QAl[hd * 320 + 256 + lane] = rp;
            if ((hu & 1) == 0) { *(v2u*)(QAg + (size_t)(b * 16 + hd) * 320 + 4 * lane) = w; QAg[(size_t)(b * 16 + hd) * 320 + 256 + lane] = rp; } }
        __syncthreads(); }
        bf16x8 qf[10];
#pragma unroll
        for (int s = 0; s < 10; ++s) qf[s] = *(const LAS bf16x8*)(QAl + hcol * 320 + 32 * s + 8 * g);
        f32x4 o[2]; o[0] = (f32x4){0.f, 0.f, 0.f, 0.f}; o[1] = o[0]; float mrow = -1e30f, lrow = 0.f;
        f32x4 pf_[10];
#define DT_FETCH(t_) do { const int pp = ptab[b * NPAGES + sp * 8 + ((t_) >> 1)], tok0 = ((t_) & 1) * 64; \
            _Pragma("unroll") for (int i = 0; i < 10; ++i) { const int c = tid + 512 * i, key = c / 80, ch = c % 80; const size_t tk = (size_t)pp * PAGE + tok0 + key; \
                pf_[i] = ch < 64 ? *(const f32x4*)(cckv + tk * 256 + ch * 4) : *(const f32x4*)(ckpe + tk * 64 + (ch - 64) * 4); } } while (0)
        DT_FETCH(0);
        for (int t = 0; t < 16; ++t) {
            __syncthreads();
#pragma unroll
            for (int i = 0; i < 10; ++i) { const int c = tid + 512 * i, key = c / 80, ch = c % 80; *(LAS v2u*)(T + key * DT_P + ch * 8) = (v2u){pk2(pf_[i].x, pf_[i].y), pk2(pf_[i].z, pf_[i].w)}; }
            __syncthreads();
            if (t + 1 < 16) DT_FETCH(t + 1);
            f32x4 sc[4];
#pragma unroll
            for (int kg = 0; kg < 4; ++kg) { sc[kg] = (f32x4){0.f, 0.f, 0.f, 0.f};
#pragma unroll
                for (int s = 0; s < 10; ++s) { const bf16x8 kf = *(const LAS bf16x8*)(T + (16 * kg + hcol) * DT_P + (32 * s + 8 * g) * 2);
                    sc[kg] = __builtin_amdgcn_mfma_f32_16x16x32_bf16(kf, qf[s], sc[kg], 0, 0, 0); } }
            float tmax = sc[0][0];
#pragma unroll
            for (int kg = 0; kg < 4; ++kg)
#pragma unroll
                for (int r = 0; r < 4; ++r) tmax = fmaxf(tmax, sc[kg][r]);
            tmax = fmaxf(tmax, swz_xor<16>(tmax)); tmax = xor32_max(tmax);
            const float mnew = fmaxf(mrow, tmax), alpha = __builtin_amdgcn_exp2f(mrow - mnew); mrow = mnew;
            float ps = 0.f;
#pragma unroll
            for (int kg = 0; kg < 4; ++kg)
#pragma unroll
                for (int r = 0; r < 4; ++r) { sc[kg][r] = __builtin_amdgcn_exp2f(sc[kg][r] - mnew); ps += sc[kg][r]; }
            lrow = lrow * alpha + ps; o[0] *= alpha; o[1] *= alpha;
#pragma unroll
            for (int kk = 0; kk < 2; ++kk) { const bf16x8 pbf = pack8f(sc[2 * kk][0], sc[2 * kk][1], sc[2 * kk][2], sc[2 * kk][3], sc[2 * kk + 1][0], sc[2 * kk + 1][1], sc[2 * kk + 1][2], sc[2 * kk + 1][3]);
#pragma unroll
                for (int ci = 0; ci < 2; ++ci) { const int cb = 2 * F.wave + ci; LAS unsigned char* ap = T + (32 * kk + 4 * g + q4) * DT_P + (16 * cb + 4 * p4) * 2;
                    const s16x4 lo = __builtin_bit_cast(s16x4, __builtin_amdgcn_ds_read_tr16_b64_v4i16((LAS v4i16_t*)ap)), hi2 = __builtin_bit_cast(s16x4, __builtin_amdgcn_ds_read_tr16_b64_v4i16((LAS v4i16_t*)(ap + 16 * DT_P)));
                    const bf16x8 av = (bf16x8){lo[0], lo[1], lo[2], lo[3], hi2[0], hi2[1], hi2[2], hi2[3]};
                    o[ci] = __builtin_amdgcn_mfma_f32_16x16x32_bf16(av, pbf, o[ci], 0, 0, 0); } }
        }
#undef DT_FETCH
        lrow += swz_xor<16>(lrow); lrow = xor32_sum(lrow);
        const size_t pb_ = (size_t)(b * 8 + sp) * 16 + hcol;
#pragma unroll
        for (int ci = 0; ci < 2; ++ci) *(f32x4*)(OP + pb_ * 256 + 16 * (2 * F.wave + ci) + 4 * g) = o[ci];
        if (F.wave == 0 && g == 0) { ML[pb_ * 2] = mrow; ML[pb_ * 2 + 1] = lrow; }
    }
    __syncthreads();
}
__device__ __forceinline__ void b2c_combine(Frame& F, cargs a) {
    unsigned char* ws = F.ws; const bf16* QA = (const bf16*)(ws + WS_QABS); const float* OP = (const float*)(ws + WS_OPART); const float* ML = (const float*)(ws + WS_ML);
    const float* wuv = (const float*)a->in[29]; const bf16* Z = (const bf16*)(ws + WS_Z); bf16* G = (bf16*)(ws + WS_G);
    LAS float* scr = (LAS float*)(F.lds + F.wave * 1024);
    for (int it = F.gw; it < DEC_BATCH * B_HEADS; it += F.NGW) { const int b = it >> 4, hd = it & 15; const int lane = F.lane;
        const float* cn = F.out + O_CKVS + (size_t)b * 256; const float* kn = F.out + O_KPES + (size_t)b * 64; const bf16* qa = QA + (size_t)it * 320;
        const f32x4 c4 = *(const f32x4*)(cn + 4 * lane); const v2u qv = *(const v2u*)(qa + 4 * lane);
        float sn = (bflo(qv.x) * c4.x + bfhi(qv.x) * c4.y) + (bflo(qv.y) * c4.z + bfhi(qv.y) * c4.w);
        sn += __builtin_bit_cast(float, (unsigned)qa[256 + lane] << 16) * kn[lane];
        sn = wave_sum(sn);
        float ms[8], ls[8], M = sn; f32x4 op[8];
#pragma unroll
        for (int s = 0; s < 8; ++s) { ms[s] = ML[((size_t)(b * 8 + s) * 16 + hd) * 2]; ls[s] = ML[((size_t)(b * 8 + s) * 16 + hd) * 2 + 1]; op[s] = *(const f32x4*)(OP + ((size_t)(b * 8 + s) * 16 + hd) * 256 + 4 * lane); }
        __builtin_amdgcn_sched_barrier(0);
#pragma unroll
        for (int s = 0; s < 8; ++s) M = fmaxf(M, ms[s]);
        const float en = __builtin_amdgcn_exp2f(sn - M); float L = en; f32x4 acc = c4 * en;
#pragma unroll
        for (int s = 0; s < 8; ++s) { const float e = __builtin_amdgcn_exp2f(ms[s] - M); L += e * ls[s]; acc += op[s] * e; }
        acc *= 1.0f / L;
        *(LAS f32x4*)(scr + 4 * lane) = acc; LDS_WAIT(); asm volatile("" ::: "memory");
        f32x2 ov = (f32x2){0.f, 0.f};
        for (int c0 = 0; c0 < 256; c0 += 32) { f32x2 wv[32];
#pragma unroll
            for (int j = 0; j < 32; ++j) wv[j] = *(const f32x2*)(wuv + (size_t)(c0 + j) * 2048 + hd * 128 + 2 * lane);
            __builtin_amdgcn_sched_barrier(0);
#pragma unroll
            for (int j = 0; j < 32; ++j) ov += wv[j] * scr[c0 + j]; }
        const size_t off = (size_t)(MP + b) * 2048 + hd * 128 + 2 * lane; const unsigned zz = *(const unsigned*)(Z + off); const float z0 = bflo(zz), z1 = bfhi(zz);
        *(unsigned*)(G + off) = pk2(ov.x * (z0 * sigmoidf_(z0)), ov.y * (z1 * sigmoidf_(z1)));
        LDS_WAIT(); asm volatile("" ::: "memory");
    }
}

#ifndef MK_SPLIT
#define MK_SPLIT 0
#endif
#ifndef MK_DIAG
#define MK_DIAG 0
#endif
constexpr int NPHASES = 1 + 4 + 5 + 7 + 6 + 1 + (MK_DIAG ? 1 : 0);
#define PH_BEGIN if (ph >= lo && ph < hi) { cargs ap = (cargs)__builtin_amdgcn_kernarg_segment_ptr(); asm volatile("" : "+s"(ap)); Frame F = make_frame(ap, wave0, (LAS unsigned char*)lds); unsigned char* ws = F.ws; int wgc_ = F.bid; (void)wgc_;
#define PH_END } if (ph >= lo && ph + 1 < hi) xcd_barrier(bar); ++ph;
typedef pg8::StaticOrder SO;
#define WG_ROT(off_) (wgc_ = (F.bid + F.G - (off_)) % F.G)
#define GEMM_B(ACT_, A_, Bt_, M_, N_, K_, O_, ldc_, nvalid_, nstore_) do { pg8::Gemm g_{(const pg8::bf16_t*)(A_), (const pg8::bf16_t*)(Bt_), (M_), (N_), (K_)}; SO S_; S_.init((M_), (N_), F.G, wgc_); \
    pg8::EpiB<ACT_> E_{(pg8::bf16_t*)(O_), (ldc_), (nvalid_), (nstore_)}; pg8::gemm_phase<pg8::EpiB<ACT_>, SO, true, true>(F.lds, g_, S_, E_, F.wave); } while (0)
#define GEMM_F(ACT_, HB_, HBI_, A_, Bt_, M_, N_, K_, O_, base_, bias_, ldc_, nstore_) do { int kk_ = (K_); asm volatile("" : "+s"(kk_)); pg8::Gemm g_{(const pg8::bf16_t*)(A_), (const pg8::bf16_t*)(Bt_), (M_), (N_), kk_}; SO S_; S_.init((M_), (N_), F.G, wgc_); \
    pg8::EpiF<ACT_, HB_, HBI_> E_{(float*)(O_), (const float*)(base_), (const float*)(bias_), (ldc_), (nstore_)}; pg8::gemm_phase<pg8::EpiF<ACT_, HB_, HBI_>, SO, true, true>(F.lds, g_, S_, E_, F.wave); } while (0)

#define OUTPROJ(Wt_, base_) do { \
    { pg8::Gemm g_{(const pg8::bf16_t*)(ws + WS_G), (const pg8::bf16_t*)(Wt_), MT, 1024, 256, 2048}; pg8::SliceOrder S_{MP / 256, 4, 8, F.G, F.bid, 512}; pg8::EpiFA E_{(float*)(ws + WS_X), 1024, MP + DEC_BATCH}; \
      pg8::gemm_phase<pg8::EpiFA, pg8::SliceOrder, true, true>(F.lds, g_, S_, E_, F.wave); } \
    GEMM_F(0, true, false, ws + WS_G, (Wt_), MP, 1024, 2048, ws + WS_X, (base_), nullptr, 1024, 1024); } while (0)
__global__ void __launch_bounds__(NTHR, 2) mk_fwd(Args args) {
    extern __shared__ __attribute__((aligned(16))) unsigned char lds[];
    const int wave0 = __builtin_amdgcn_readfirstlane(threadIdx.x >> 6);
    for (int u = threadIdx.x; u < (LDS_BYTES - LDSCTL_OFF) / 4; u += NTHR) ((LAS unsigned*)(lds + LDSCTL_OFF))[u] = 0u;
    __syncthreads();
    XcdBarrier bar = xcd_barrier_post((unsigned*)(args.ws + WS_CTL) + CW_BAR + args.li * XCD_BAR_WORDS, (volatile LAS unsigned*)((LAS unsigned char*)lds + LDSCTL_OFF), (unsigned)wave0);
    int ph = 0; const int lo = args.ph_lo, hi = args.ph_hi;

    PH_BEGIN p0_prologue(F, ap); __syncthreads(); a1_prepass(F, ap, 0); PH_END

    for (int l = 0; l < 2; ++l) {
        if (l > 0) { PH_BEGIN a1_prepass(F, ap, l); PH_END }
        PH_BEGIN
            { static_assert(AM_STRIDE == (size_t)130 * 256 * 1024 * 2, "A-operand buffers sit 130 row panels apart");
              pg8::Gemm g_{(const pg8::bf16_t*)(ws + WS_AM), (const pg8::bf16_t*)(ws + WS_WIN + (size_t)l * WIN_L), MT, 2048, 1024}; pg8::GroupOrderA2 S_; S_.init(MT, F.G, F.bid, l ? 7 : 6);
              static_assert(WS_K == WS_R + BIGB && WS_V0 == WS_R + 2 * BIGB && WS_V1 == WS_R + 3 * BIGB && WS_Z == WS_R + 4 * BIGB && WS_LA == WS_LW + 9 * MiB && WS_LV == WS_LW + 18 * MiB, "output buffers are equally spaced");
              pg8::EpiA2 E_{(pg8::bf16_t*)(ws + WS_R), BIGB / 2, 2 + l, (pg8::bf16_t*)(ws + WS_LW), 9 * MiB / 2};
              pg8::gemm_phase<pg8::EpiA2, pg8::GroupOrderA2, true, true>(F.lds, g_, S_, E_, F.wave); }
        PH_END
        PH_BEGIN
#define GEMM_BA(ACT_, A_, Bt_, O_, bias_) do { int kk_ = 128; asm volatile("" : "+s"(kk_)); pg8::Gemm g_{(const pg8::bf16_t*)(A_), (const pg8::bf16_t*)(Bt_), MT, 2048, kk_}; SO S_; S_.init(MT, 2048, F.G, wgc_); \
    pg8::EpiBA<ACT_> E_{(pg8::bf16_t*)(O_), (const float*)(bias_)}; pg8::gemm_phase<pg8::EpiBA<ACT_>, SO, true, true>(F.lds, g_, S_, E_, F.wave); } while (0)
            GEMM_BA(4, ws + WS_LW, ws + WS_W2 + (size_t)l * (MiB / 2), ws + WS_WD, (const float*)ap->in[10] + l * 2048);
            WG_ROT(8); GEMM_BA(3, ws + WS_LA, ws + WS_W2 + (size_t)(2 + l) * (MiB / 2), ws + WS_IA, (const float*)ap->in[13] + l * 2048);
            WG_ROT(16); if (l) GEMM_BA(3, ws + WS_LV, ws + WS_W2 + (size_t)4 * (MiB / 2), ws + WS_VG, (const float*)ap->in[16]);
#undef GEMM_BA
        PH_END
        PH_BEGIN a5_fused(F, ap, l); PH_END
        PH_BEGIN
            OUTPROJ(ws + WS_WO + (size_t)l * 4 * MiB, l == 0 ? (const void*)ap->in[0] : (const void*)(ws + WS_X));
        PH_END
    }

#define MLA_INPROJ(l_, A_) do { \
        { pg8::Gemm g_{(const pg8::bf16_t*)(A_), (const pg8::bf16_t*)(ws + WS_WQ + (size_t)(l_) * MiB), MT, 512, 1024}; WG_ROT(8); SO S_; S_.init(MT, 512, F.G, wgc_); \
          pg8::EpiCQ E_{(pg8::bf16_t*)(ws + WS_CQ), (const float*)ap->in[32] + (l_) * 384, (float*)(ws + WS_CTL + CW_RSQ + (size_t)(l_) * 262144)}; pg8::gemm_phase<pg8::EpiCQ, SO, true, true>(F.lds, g_, S_, E_, F.wave); } \
        WG_ROT(16); GEMM_B(0, (A_), ws + WS_WZ + (size_t)(l_) * 4 * MiB, MT, 2048, 1024, ws + WS_Z, 2048, 2048, 2048); } while (0)
#define MLA_QUP(l_) do { pg8::Gemm g_{(const pg8::bf16_t*)(ws + WS_CQ), (const pg8::bf16_t*)(ws + WS_WUQ + (size_t)(l_) * (5 * MiB / 2)), MT, 3072, 384}; SO S_; S_.init(MT, 3072, F.G, F.bid); \
        pg8::EpiQ E_{(pg8::bf16_t*)(ws + WS_Q), (const float*)(ws + WS_ROPE), ATTN_SCALE * LOG2E, MP, SEQ, (const float*)(ws + WS_CTL + CW_RSQ + (size_t)(l_) * 262144)}; pg8::gemm_phase<pg8::EpiQ, SO, true, true>(F.lds, g_, S_, E_, F.wave); } while (0)
    for (int l = 0; l < 2; ++l) {
        PH_BEGIN if (l == 0) norm2_rows_bf16(F, (const float*)(ws + WS_X), (const float*)ap->in[25], (bf16*)(ws + WS_AM), (const float*)ap->in[30], (bf16*)(ws + WS_AM + AM_STRIDE));
                 else norm_rows_bf16(F, (const float*)(ws + WS_X), (const float*)ap->in[30] + l * 1024, (bf16*)(ws + WS_AM)); PH_END
        PH_BEGIN if (l == 0) GEMM_F(0, false, false, ws + WS_AM, ws + WS_WDKV, MT, 512, 1024, ws + WS_KVR, nullptr, nullptr, 320, 320);
                 MLA_INPROJ(l, ws + WS_AM + (l == 0 ? AM_STRIDE : 0)); PH_END
        if (l == 0) { PH_BEGIN b0c_kvpost(F, ap); PH_END }
        PH_BEGIN if (l == 0) { GEMM_B(0, ws + WS_CKVB, ws + WS_WUK, MP, 2048, 256, ws + WS_KN, 2048, 2048, 2048);
                               GEMM_B(0, ws + WS_WUV, ws + WS_CKVB, 2048, MP, 256, ws + WS_VT, MP, MP, MP); }
                 MLA_QUP(l); PH_END
        PH_BEGIN b2a_attn_prompt(F); b2b_attn_sample(F, ap); PH_END
        PH_BEGIN b2c_combine(F, ap); PH_END
        PH_BEGIN OUTPROJ(ws + WS_WBO + (size_t)l * 4 * MiB, ws + WS_X); PH_END
    }
#undef MLA_INPROJ
#undef MLA_QUP

    PH_BEGIN final_norm(F, ap); PH_END
#if MK_DIAG
    PH_BEGIN
        const size_t offs[11] = {O_YP, O_YS, O_WKVP, O_SHP, O_CKVP, O_KPEP, O_WKVS, O_SHS, O_CKVS, O_KPES, O_END};
        for (int k = 1; k < 10; ++k) { const float f = 1.0f + sqrtf(2e-4f * (float)k);
            for (size_t i = offs[k] + (size_t)(F.bid * NTHR + F.wave * 64 + F.lane); i < offs[k + 1]; i += (size_t)F.NT) F.out[i] *= f; }
    PH_END
#endif
}

extern "C" void kernel_launch(void* const* d_in, const int* in_sizes, int n_in, void* d_out, int out_size, void* d_ws, size_t ws_size, hipStream_t stream) {
    static int grid = 0;
    if (grid == 0) {
        if (n_in != 36 || (size_t)out_size != O_END || ws_size < WS_NEED) { fprintf(stderr, "kernel_launch: unexpected sizes: n_in %d out %d (want %zu) ws %zu (need %zu)\n", n_in, out_size, (size_t)O_END, ws_size, (size_t)WS_NEED); grid = -1; return; }
        int dev = 0, cus = 0, per_cu = 0;
        if (hipGetDevice(&dev) != hipSuccess || hipDeviceGetAttribute(&cus, hipDeviceAttributeMultiprocessorCount, dev) != hipSuccess) { grid = -1; return; }
        if (hipFuncSetAttribute((const void*)mk_fwd, hipFuncAttributeMaxDynamicSharedMemorySize, LDS_BYTES) != hipSuccess) { fprintf(stderr, "kernel_launch: hipFuncSetAttribute failed\n"); grid = -1; return; }
        if (hipOccupancyMaxActiveBlocksPerMultiprocessor(&per_cu, (const void*)mk_fwd, NTHR, LDS_BYTES) != hipSuccess || per_cu < 1) fprintf(stderr, "kernel_launch: occupancy query reports %d\n", per_cu);
        (void)hipGetLastError();
        grid = cus;
    }
    if (grid < 0) return;
    if (hipMemsetAsync((char*)d_ws + WS_CTL, 0, CTL_ZERO_BYTES, stream) != hipSuccess) { fprintf(stderr, "kernel_launch: memset failed\n"); return; }
    Args a{};
    for (int i = 0; i < 36; ++i) a.in[i] = d_in[i];
    a.out = (float*)d_out; a.ws = (unsigned char*)d_ws;
#if MK_SPLIT
    for (int li = 0; li < NPHASES; ++li) { a.ph_lo = li; a.ph_hi = li + 1; a.li = li;
        hipLaunchKernelGGL(mk_fwd, dim3(grid), dim3(NTHR), LDS_BYTES, stream, a); }
#else
    a.ph_lo = 0; a.ph_hi = NPHASES; a.li = 0;
    hipLaunchKernelGGL(mk_fwd, dim3(grid), dim3(NTHR), LDS_BYTES, stream, a);
#endif
    const hipError_t le = hipPeekAtLastError();
    if (le != hipSuccess) fprintf(stderr, "kernel_launch: launch failed: %s\n", hipGetErrorName(le));
}
```

```cpp
#include <hip/hip_runtime.h>
#include <cstdio>
#include <cstdint>
namespace pg8 {
#define PG8_LAS __attribute__((address_space(3)))
typedef unsigned short bf16_t;
typedef short bf16x8 __attribute__((ext_vector_type(8)));
typedef float f32x4 __attribute__((ext_vector_type(4)));
typedef unsigned u32x4 __attribute__((ext_vector_type(4)));
constexpr int BM = 256, BK = 64, HALF = 128, HTB = HALF * BK * 2  , STAGE_BYTES = 8 * HTB, NXCD = 8, WGM = 8;

__host__ __device__ __forceinline__ int lds_byte(int r, int c) { const int st = (r >> 4) * 2 + (c >> 5), rr = r & 15, cc = c & 31, ob = rr * 64 + cc * 2; return st * 1024 + (ob ^ (((ob >> 9) & 1) << 5)); }
__host__ __device__ __forceinline__ void stage_rc(int b, int& R, int& C) { const int st = b / 1024, sb = b % 1024, swz = sb ^ (((sb >> 9) & 1) << 5); R = (st >> 1) * 16 + swz / 64; C = (st & 1) * 32 + (swz % 64) / 2; }
__host__ __device__ __forceinline__ int perm32(int rho) { const int n = rho >> 4, i = rho & 15; return 8 * (i >> 2) + 4 * n + (i & 3); }

struct Unit { int pm, pn; int ko; };
struct Gemm { const bf16_t* A; const bf16_t* Bt; int M, N, K; int ld; };

struct StaticOrder {
    int nM, nN, nwg, G, c;
    __host__ __device__ void init(int M, int N, int G_, int c_) { nM = M / BM; nN = N / BM; nwg = nM * nN; G = G_; c = c_; }
    __host__ __device__ bool next(int i, Unit& u) const {
        const long L = (long)i * G + c; if (L >= nwg) return false;
        int wgid = (int)L; { const int q = nwg / NXCD, r = nwg % NXCD, xcd = wgid % NXCD, off = wgid / NXCD; wgid = (xcd < r ? xcd * (q + 1) : r * (q + 1) + (xcd - r) * q) + off; }
        const int nig = WGM * nN, gid = wgid / nig, fm = gid * WGM, gsz = (nM - fm) < WGM ? (nM - fm) : WGM;
        u.pm = fm + ((wgid % nig) % gsz); u.pn = (wgid % nig) / gsz; u.ko = 0; return true;
    }
    __device__ __forceinline__ void a_ready(const Unit&) const {}
    __device__ __forceinline__ void done(const Unit&) const {}
};

__device__ __forceinline__ unsigned cvt_pk_bf16(float lo, float hi) { unsigned r; asm volatile("v_cvt_pk_bf16_f32 %0, %1, %2" : "=v"(r) : "v"(lo), "v"(hi)); return r; }
typedef float f32x2 __attribute__((ext_vector_type(2)));
__device__ __forceinline__ float act_apply(int ACT, float x) {
    if (ACT == 1) return 1.0f - 2.0f / (1.0f + __expf(2.0f * x));
    if (ACT == 2) return __expf(-0.6065306597126334f / (1.0f + __expf(-x)));
    if (ACT == 3) return 1.0f / (1.0f + __expf(-x));
    return x;
}
template <int ACT> struct EpiB {
    static constexpr bool PERM = true, AFTER_DRAIN = false;
    bf16_t* O; int ldc; int nvalid; int nstore;
    __device__ __forceinline__ void operator()(const f32x4 (&acc)[2][2][4][2], const Unit& u, int wr, int wc, int, int) const {
        int lane_; asm volatile("v_mbcnt_lo_u32_b32 %0, -1, 0\n\tv_mbcnt_hi_u32_b32 %0, -1, %0" : "=v"(lane_)); const int fr = lane_ & 15, fq = lane_ >> 4;
        const int row0 = u.pm * BM + wr * 64 + fr, col0 = u.pn * BM + wc * 32 + 8 * fq;
#pragma unroll
        for (int ai = 0; ai < 2; ++ai)
#pragma unroll
            for (int m = 0; m < 4; ++m) { bf16_t* rowp = O + (size_t)(row0 + ai * HALF + m * 16) * ldc + col0;
#pragma unroll
                for (int bj = 0; bj < 2; ++bj) { const int c = col0 + bj * HALF; if (c >= nstore) continue;
                    f32x4 v0 = acc[ai][bj][m][0], v1 = acc[ai][bj][m][1];
                    if (ACT != 0) {
#pragma unroll
                        for (int e = 0; e < 4; ++e) { v0[e] = act_apply(ACT, v0[e]); v1[e] = act_apply(ACT, v1[e]); } }
                    u32x4 w; w.x = cvt_pk_bf16(v0[0], v0[1]); w.y = cvt_pk_bf16(v0[2], v0[3]); w.z = cvt_pk_bf16(v1[0], v1[1]); w.w = cvt_pk_bf16(v1[2], v1[3]);
                    if (c >= nvalid) w = (u32x4){0u, 0u, 0u, 0u};
                    *(u32x4*)(rowp + bj * HALF) = w; } }
    }
};
template <int ACT, bool HAS_BASE, bool HAS_BIAS> struct EpiF {
    static constexpr bool PERM = false, AFTER_DRAIN = false;
    float* O; const float* base; const float* bias; int ldc; int nstore;
    __device__ __forceinline__ void operator()(const f32x4 (&acc)[2][2][4][2], const Unit& u, int wr, int wc, int, int) const {
        int lane_; asm volatile("v_mbcnt_lo_u32_b32 %0, -1, 0\n\tv_mbcnt_hi_u32_b32 %0, -1, %0" : "=v"(lane_)); const int fr = lane_ & 15, fq = lane_ >> 4;
        const int row0 = u.pm * BM + wr * 64 + fr, col0 = u.pn * BM + wc * 32 + 4 * fq;
        f32x4 bv[2][2];
#pragma unroll
        for (int bj = 0; bj < 2; ++bj)
#pragma unroll
            for (int n = 0; n < 2; ++n) bv[bj][n] = HAS_BIAS ? *(const f32x4*)(bias + col0 + bj * HALF + n * 16) : (f32x4){0.f, 0.f, 0.f, 0.f};
#pragma unroll
        for (int ai = 0; ai < 2; ++ai) { f32x4 bs[2][2][2];
#pragma unroll
            for (int m = 0; m < 4; ++m) { const size_t off = (size_t)(row0 + ai * HALF + m * 16) * ldc + col0;
                if (HAS_BASE && !(m & 1)) {
#pragma unroll
                    for (int mm = 0; mm < 2; ++mm)
#pragma unroll
                        for (int bj = 0; bj < 2; ++bj)
#pragma unroll
                            for (int n = 0; n < 2; ++n) bs[mm][bj][n] = *(const f32x4*)(base + off + (size_t)mm * 16 * ldc + bj * HALF + n * 16);
                    __builtin_amdgcn_sched_barrier(0); }
#pragma unroll
                for (int bj = 0; bj < 2; ++bj)
#pragma unroll
                    for (int n = 0; n < 2; ++n) { if (!HAS_BASE && col0 + bj * HALF + n * 16 >= nstore) continue;
                        f32x4 v = acc[ai][bj][m][n] + bv[bj][n];
                        if (ACT != 0) {
#pragma unroll
                            for (int e = 0; e < 4; ++e) v[e] = act_apply(ACT, v[e]); }
                        if (HAS_BASE) v += bs[m & 1][bj][n];
                        *(f32x4*)(O + off + bj * HALF + n * 16) = v; }
                if (m & 1) asm volatile("" ::: "memory"); } }
    }
};

struct GroupOrder4 {
    StaticOrder so; int per;
    __device__ void init(int M, int N, int G_, int c_) { so.init(M, N, G_, c_); per = so.nwg; }
    __device__ bool next(int i, Unit& u) const {
        const long L = (long)i * so.G + so.c; if (L >= 4L * per) return false;
        const int gi = (int)(L / per); int wgid = (int)(L - (long)gi * per);
        { const int q = so.nwg / NXCD, r = so.nwg % NXCD, xcd = wgid % NXCD, off = wgid / NXCD; wgid = (xcd < r ? xcd * (q + 1) : r * (q + 1) + (xcd - r) * q) + off; }
        const int nig = WGM * so.nN, gid = wgid / nig, fm = gid * WGM, gsz = (so.nM - fm) < WGM ? (so.nM - fm) : WGM;
        u.pm = fm + ((wgid % nig) % gsz) + 130 * gi; u.pn = (wgid % nig) / gsz + 8 * gi; u.ko = 0; return true;
    }
    __device__ __forceinline__ void a_ready(const Unit&) const {}
    __device__ __forceinline__ void done(const Unit&) const {}
};
struct EpiB4 {
    static constexpr bool PERM = true, AFTER_DRAIN = false;
    bf16_t* O[4];
    __device__ __forceinline__ void operator()(const f32x4 (&acc)[2][2][4][2], const Unit& u, int wr, int wc, int, int) const {
        int lane_; asm volatile("v_mbcnt_lo_u32_b32 %0, -1, 0\n\tv_mbcnt_hi_u32_b32 %0, -1, %0" : "=v"(lane_)); const int fr = lane_ & 15, fq = lane_ >> 4;
        const int gi = u.pn >> 3; bf16_t* Ob = gi == 0 ? O[0] : gi == 1 ? O[1] : gi == 2 ? O[2] : O[3];
        const int row0 = (u.pm - 130 * gi) * BM + wr * 64 + fr, col0 = (u.pn & 7) * BM + wc * 32 + 8 * fq;
#pragma unroll
        for (int ai = 0; ai < 2; ++ai)
#pragma unroll
            for (int m = 0; m < 4; ++m) { bf16_t* rowp = Ob + (size_t)(row0 + ai * HALF + m * 16) * 2048 + col0;
#pragma unroll
                for (int bj = 0; bj < 2; ++bj) { const f32x4 v0 = acc[ai][bj][m][0], v1 = acc[ai][bj][m][1];
                    u32x4 w; w.x = cvt_pk_bf16(v0[0], v0[1]); w.y = cvt_pk_bf16(v0[2], v0[3]); w.z = cvt_pk_bf16(v1[0], v1[1]); w.w = cvt_pk_bf16(v1[2], v1[3]);
                    *(u32x4*)(rowp + bj * HALF) = w; } }
    }
};

struct EpiQ {
    static constexpr bool PERM = true, AFTER_DRAIN = false;
    bf16_t* O; const float* rope; float sc; int mp, seq; const float* rsq;
    __device__ __forceinline__ void operator()(const f32x4 (&acc)[2][2][4][2], const Unit& u, int wr, int wc, int, int) const {
        int lane_; asm volatile("v_mbcnt_lo_u32_b32 %0, -1, 0\n\tv_mbcnt_hi_u32_b32 %0, -1, %0" : "=v"(lane_)); const int fr = lane_ & 15, fq = lane_ >> 4;
        const int row0 = u.pm * BM + wr * 64 + fr, col0 = u.pn * BM + wc * 32 + 8 * fq;
#pragma unroll
        for (int ai = 0; ai < 2; ++ai)
#pragma unroll
            for (int m2 = 0; m2 < 4; m2 += 2) {
                float rq[2]; f32x4 tt0[2][2], tt1[2][2];
#pragma unroll
                for (int mm = 0; mm < 2; ++mm) { const int row = row0 + ai * HALF + (m2 + mm) * 16; const int p = row < mp ? (row & (seq - 1)) : seq; rq[mm] = rsq[row];
#pragma unroll
                    for (int bj = 0; bj < 2; ++bj) { const int within = (col0 + bj * HALF) % 192, wi = within >= 128 ? ((within - 128) >> 1) : 0; const float* t = rope + (size_t)(p * 32 + wi) * 2;
                        tt0[mm][bj] = *(const f32x4*)t; tt1[mm][bj] = *(const f32x4*)(t + 4); } }
                __builtin_amdgcn_sched_barrier(0);
#pragma unroll
                for (int mm = 0; mm < 2; ++mm) { const int m = m2 + mm, row = row0 + ai * HALF + m * 16; bf16_t* rowp = O + (size_t)row * 3072 + col0; const float rsc = sc / sqrtf(rq[mm] * (1.0f / 384.0f) + 1e-6f);
#pragma unroll
                    for (int bj = 0; bj < 2; ++bj) { const int c = col0 + bj * HALF, within = c % 192; f32x4 v0 = acc[ai][bj][m][0], v1 = acc[ai][bj][m][1];
                        if (within >= 128) { const f32x4 t0 = tt0[mm][bj], t1 = tt1[mm][bj];
                            const f32x4 a0 = v0, a1 = v1;
                            v0[0] = a0[0] * t0[0] - a0[1] * t0[1]; v0[1] = a0[1] * t0[0] + a0[0] * t0[1]; v0[2] = a0[2] * t0[2] - a0[3] * t0[3]; v0[3] = a0[3] * t0[2] + a0[2] * t0[3];
                            v1[0] = a1[0] * t1[0] - a1[1] * t1[1]; v1[1] = a1[1] * t1[0] + a1[0] * t1[1]; v1[2] = a1[2] * t1[2] - a1[3] * t1[3]; v1[3] = a1[3] * t1[2] + a1[2] * t1[3]; }
                        v0 = v0 * rsc; v1 = v1 * rsc;
                        u32x4 w; w.x = cvt_pk_bf16(v0[0], v0[1]); w.y = cvt_pk_bf16(v0[2], v0[3]); w.z = cvt_pk_bf16(v1[0], v1[1]); w.w = cvt_pk_bf16(v1[2], v1[3]);
                        *(u32x4*)(rowp + bj * HALF) = w; } } }
    }
};

struct EpiCQ {
    static constexpr bool PERM = true, AFTER_DRAIN = false;
    bf16_t* O; const float* wq; float* rsq;
    __device__ __forceinline__ void operator()(const f32x4 (&acc)[2][2][4][2], const Unit& u, int wr, int wc, int, int) const {
        int lane_; asm volatile("v_mbcnt_lo_u32_b32 %0, -1, 0\n\tv_mbcnt_hi_u32_b32 %0, -1, %0" : "=v"(lane_)); const int fr = lane_ & 15, fq = lane_ >> 4;
        const int row0 = u.pm * BM + wr * 64 + fr, col0 = u.pn * BM + wc * 32 + 8 * fq;
#pragma unroll
        for (int ai = 0; ai < 2; ++ai)
#pragma unroll
            for (int m = 0; m < 4; ++m) { const int row = row0 + ai * HALF + m * 16; float ss = 0.f;
#pragma unroll
                for (int bj = 0; bj < 2; ++bj) { const int c = col0 + bj * HALF; if (c >= 384) continue;
                    const f32x4 v0 = acc[ai][bj][m][0], v1 = acc[ai][bj][m][1], w0 = *(const f32x4*)(wq + c), w1 = *(const f32x4*)(wq + c + 4);
                    ss += ((v0[0] * v0[0] + v0[1] * v0[1]) + (v0[2] * v0[2] + v0[3] * v0[3])) + ((v1[0] * v1[0] + v1[1] * v1[1]) + (v1[2] * v1[2] + v1[3] * v1[3]));
                    u32x4 w; w.x = cvt_pk_bf16(v0[0] * w0[0], v0[1] * w0[1]); w.y = cvt_pk_bf16(v0[2] * w0[2], v0[3] * w0[3]); w.z = cvt_pk_bf16(v1[0] * w1[0], v1[1] * w1[1]); w.w = cvt_pk_bf16(v1[2] * w1[2], v1[3] * w1[3]);
                    *(u32x4*)(O + (size_t)row * 384 + c) = w; }
                ss += __builtin_bit_cast(float, __builtin_amdgcn_ds_swizzle(__builtin_bit_cast(int, ss), 0x1F | (16 << 10)));
                { float a = ss, b = ss; asm volatile("s_nop 1\n\tv_permlane32_swap_b32 %0, %1\n\ts_nop 1" : "+v"(a), "+v"(b)); ss = a + b; }
                if (fq == 0 && u.pn < 2) atomicAdd(rsq + row, ss); }
    }
};

struct SliceOrder {
    int pm, nN, nS, G, c, kbytes;
    __device__ bool next(int i, Unit& u) const { const int L = i * G + c; if (L >= nN * nS) return false; u.pm = pm; u.pn = L % nN; u.ko = (L / nN) * kbytes; return true; }
    __device__ __forceinline__ void a_ready(const Unit&) const {}
    __device__ __forceinline__ void done(const Unit&) const {}
};
struct EpiFA {
    static constexpr bool PERM = false, AFTER_DRAIN = false;
    float* O; int ldc, rows;
    __device__ __forceinline__ void operator()(const f32x4 (&acc)[2][2][4][2], const Unit& u, int wr, int wc, int, int) const {
        int lane_; asm volatile("v_mbcnt_lo_u32_b32 %0, -1, 0\n\tv_mbcnt_hi_u32_b32 %0, -1, %0" : "=v"(lane_)); const int fr = lane_ & 15, fq = lane_ >> 4;
        const int row0 = u.pm * BM + wr * 64 + fr, col0 = u.pn * BM + wc * 32 + 4 * fq;
#pragma unroll
        for (int ai = 0; ai < 2; ++ai)
#pragma unroll
            for (int m = 0; m < 4; ++m) { const int row = row0 + ai * HALF + m * 16; if (row >= rows) continue; float* rp = O + (size_t)row * ldc + col0;
#pragma unroll
                for (int bj = 0; bj < 2; ++bj)
#pragma unroll
                    for (int n = 0; n < 2; ++n) { const f32x4 v = acc[ai][bj][m][n];
#pragma unroll
                        for (int e = 0; e < 4; ++e) atomicAdd(rp + bj * HALF + n * 16 + e, v[e]); } }
    }
};

template <int ACT> struct EpiBA {
    static constexpr bool PERM = true, AFTER_DRAIN = false;
    bf16_t* O; const float* bias;
    __device__ __forceinline__ void operator()(const f32x4 (&acc)[2][2][4][2], const Unit& u, int wr, int wc, int, int) const {
        int lane_; asm volatile("v_mbcnt_lo_u32_b32 %0, -1, 0\n\tv_mbcnt_hi_u32_b32 %0, -1, %0" : "=v"(lane_)); const int fr = lane_ & 15, fq = lane_ >> 4;
        const int row0 = u.pm * BM + wr * 64 + fr, col0 = u.pn * BM + wc * 32 + 8 * fq;
        f32x4 bv[2][2];
#pragma unroll
        for (int bj = 0; bj < 2; ++bj)
#pragma unroll
            for (int n = 0; n < 2; ++n) bv[bj][n] = *(const f32x4*)(bias + col0 + bj * HALF + 4 * n);
#pragma unroll
        for (int ai = 0; ai < 2; ++ai)
#pragma unroll
            for (int m = 0; m < 4; ++m) { bf16_t* rowp = O + (size_t)(row0 + ai * HALF + m * 16) * 2048 + col0;
#pragma unroll
                for (int bj = 0; bj < 2; ++bj) { f32x4 v0 = acc[ai][bj][m][0] + bv[bj][0], v1 = acc[ai][bj][m][1] + bv[bj][1];
#pragma unroll
                    for (int e = 0; e < 4; ++e) { const float s0 = __builtin_amdgcn_rcpf(1.0f + __builtin_amdgcn_exp2f(-1.4426950408889634f * v0[e])), s1 = __builtin_amdgcn_rcpf(1.0f + __builtin_amdgcn_exp2f(-1.4426950408889634f * v1[e]));
                        v0[e] = ACT == 4 ? -0.8750387749f * s0 : s0; v1[e] = ACT == 4 ? -0.8750387749f * s1 : s1; }
                    typedef __bf16 bf8n __attribute__((ext_vector_type(8))); typedef float f8n __attribute__((ext_vector_type(8)));
                    const u32x4 w = __builtin_bit_cast(u32x4, __builtin_convertvector((f8n){v0[0], v0[1], v0[2], v0[3], v1[0], v1[1], v1[2], v1[3]}, bf8n));
                    *(u32x4*)(rowp + bj * HALF) = w; } }
    }
};

struct GroupOrderA2 {
    StaticOrder so; int per, nG;
    __device__ void init(int M, int G_, int c_, int nG_) { so.init(M, 2048, G_, c_); per = so.nwg; nG = nG_; }
    __device__ bool next(int i, Unit& u) const {
        const long L = (long)i * so.G + so.c; u.ko = 0;
        if (L < 4L * per) { const int gi = (int)(L / per); int wgid = (int)(L - (long)gi * per);
            { const int q = so.nwg / NXCD, r = so.nwg % NXCD, xcd = wgid % NXCD, off = wgid / NXCD; wgid = (xcd < r ? xcd * (q + 1) : r * (q + 1) + (xcd - r) * q) + off; }
            const int nig = WGM * so.nN, gid = wgid / nig, fm = gid * WGM, gsz = (so.nM - fm) < WGM ? (so.nM - fm) : WGM;
            u.pm = fm + ((wgid % nig) % gsz) + 130 * gi; u.pn = (wgid % nig) / gsz + 8 * gi; return true; }
        const int Lp = (int)(L - 4L * per); if (Lp >= (nG - 4) * so.nM) return false;
        const int ge = Lp / so.nM, gi = 4 + ge; u.pm = Lp % so.nM + 130 * (gi == 6 ? 2 : gi); u.pn = 32 + ge; return true;
    }
    __device__ __forceinline__ void a_ready(const Unit&) const {}
    __device__ __forceinline__ void done(const Unit&) const {}
};
struct EpiA2 {
    static constexpr bool PERM = true, AFTER_DRAIN = false;
    bf16_t* Rb; size_t ostride; int vidx; bf16_t* Lb; size_t lstride;
    __device__ __forceinline__ void operator()(const f32x4 (&acc)[2][2][4][2], const Unit& u, int wr, int wc, int, int) const {
        int lane_; asm volatile("v_mbcnt_lo_u32_b32 %0, -1, 0\n\tv_mbcnt_hi_u32_b32 %0, -1, %0" : "=v"(lane_)); const int fr = lane_ & 15, fq = lane_ >> 4;
        if (u.pn < 32) { const int gi = u.pn >> 3; bf16_t* Ob = Rb + (size_t)(gi < 2 ? gi : (gi == 2 ? vidx : 4)) * ostride;
            const int row0 = (u.pm - 130 * gi) * BM + wr * 64 + fr, col0 = (u.pn & 7) * BM + wc * 32 + 8 * fq;
#pragma unroll
            for (int ai = 0; ai < 2; ++ai)
#pragma unroll
                for (int m = 0; m < 4; ++m) { bf16_t* rowp = Ob + (size_t)(row0 + ai * HALF + m * 16) * 2048 + col0;
#pragma unroll
                    for (int bj = 0; bj < 2; ++bj) { const f32x4 v0 = acc[ai][bj][m][0], v1 = acc[ai][bj][m][1];
                        u32x4 w; w.x = cvt_pk_bf16(v0[0], v0[1]); w.y = cvt_pk_bf16(v0[2], v0[3]); w.z = cvt_pk_bf16(v1[0], v1[1]); w.w = cvt_pk_bf16(v1[2], v1[3]);
                        *(u32x4*)(rowp + bj * HALF) = w; } }
        } else { const int ge = u.pn - 32, gi = 4 + ge; bf16_t* Ob = Lb + (size_t)ge * lstride; const int nvalid = ge == 2 ? 32 : 64;
            const int row0 = (u.pm - 130 * (gi == 6 ? 2 : gi)) * BM + wr * 64 + fr, c = wc * 32 + 8 * fq;
#pragma unroll
            for (int ai = 0; ai < 2; ++ai)
#pragma unroll
                for (int m = 0; m < 4; ++m) { f32x4 v0 = acc[ai][0][m][0], v1 = acc[ai][0][m][1];
                    if (ge == 0) {
#pragma unroll
                        for (int e = 0; e < 4; ++e) { v0[e] = 1.0f - 2.0f / (1.0f + __expf(2.0f * v0[e])); v1[e] = 1.0f - 2.0f / (1.0f + __expf(2.0f * v1[e])); } }
                    u32x4 w; w.x = cvt_pk_bf16(v0[0], v0[1]); w.y = cvt_pk_bf16(v0[2], v0[3]); w.z = cvt_pk_bf16(v1[0], v1[1]); w.w = cvt_pk_bf16(v1[2], v1[3]);
                    if (c >= nvalid) w = (u32x4){0u, 0u, 0u, 0u};
                    *(u32x4*)(Ob + (size_t)(row0 + ai * HALF + m * 16) * 128 + c) = w; }
        }
    }
};
template <class Epi, class Sched, bool ALIGN_EPI = false, bool SP2 = false>
__device__ __forceinline__ void gemm_phase(PG8_LAS unsigned char* lds, const Gemm g, const Sched& S, const Epi& E, const int wid) {
    int lane_; asm volatile("v_mbcnt_lo_u32_b32 %0, -1, 0\n\tv_mbcnt_hi_u32_b32 %0, -1, %0" : "=v"(lane_));
    const int lane = lane_, tid = wid * 64 + lane, wr = wid >> 2, wc = wid & 3, fr = lane & 15, fq = lane >> 4;
    const int K = g.K, nt = K / BK, LD = g.ld ? g.ld : g.K;
    unsigned voffA[2], voffB[2];
#pragma unroll
    for (int i = 0; i < 2; ++i) { int R, C; stage_rc(tid * 16 + i * 8192, R, C); const int Rb = Epi::PERM ? ((R & ~31) + perm32(R & 31)) : R;
        voffA[i] = (unsigned)(R * LD + C) * 2u; voffB[i] = (unsigned)(Rb * LD + C) * 2u; }
    const size_t kstep = (size_t)(BK * 2);
    const size_t hstep = (size_t)HALF * LD * 2;
    const size_t tstep = 2 * hstep;
    const unsigned ldsw = (unsigned)wid * 1024u;
    const int aoff = lds_byte(wr * 64 + fr, fq * 8), boff = lds_byte(wc * 32 + fr, fq * 8);
#define PG8_SA(b, h) (((b) * 2 + (h)) * HTB)
#define PG8_SB(b, h) ((4 + (b) * 2 + (h)) * HTB)
#define PG8_STAGE(bufoff, gbase, voff) do { _Pragma("unroll") for (int _i = 0; _i < 2; ++_i) \
        __builtin_amdgcn_global_load_lds((const unsigned*)((const char*)(gbase) + (voff)[_i]), (PG8_LAS unsigned*)(lds + (bufoff) + ldsw + _i * 8192), 16, 0, 0); } while (0)
#define PG8_LDA(dst, b, h) do { _Pragma("unroll") for (int m = 0; m < 4; ++m) _Pragma("unroll") for (int k = 0; k < 2; ++k) dst[m][k] = *(const PG8_LAS bf16x8*)(lds + PG8_SA(b, h) + aoff + m * 2048 + k * 1024); } while (0)
#define PG8_LDB(dst, b, h) do { _Pragma("unroll") for (int n = 0; n < 2; ++n) _Pragma("unroll") for (int k = 0; k < 2; ++k) dst[n][k] = *(const PG8_LAS bf16x8*)(lds + PG8_SB(b, h) + boff + n * 2048 + k * 1024); } while (0)
#define PG8_MMA(ai, bj, At, Bt) do { __builtin_amdgcn_s_setprio(1); _Pragma("unroll") for (int m = 0; m < 4; ++m) _Pragma("unroll") for (int n = 0; n < 2; ++n) _Pragma("unroll") for (int k = 0; k < 2; ++k) \
        acc[ai][bj][m][n] = __builtin_amdgcn_mfma_f32_16x16x32_bf16(Bt[n][k], At[m][k], acc[ai][bj][m][n], 0, 0, 0); __builtin_amdgcn_s_setprio(0); } while (0)
#define PG8_WAIT_V(n) asm volatile("s_waitcnt vmcnt(" #n ")" ::: "memory")
#define PG8_WAIT_L(n) asm volatile("s_waitcnt lgkmcnt(" #n ")" ::: "memory")
#define PG8_BAR __builtin_amdgcn_s_barrier()
#define PG8_SCHED __builtin_amdgcn_sched_barrier(0)
    Unit cur, nxt; int ui = 0;
    if (!S.next(0, cur)) return;
    f32x4 acc[2][2][4][2];
#pragma unroll
    for (int a = 0; a < 2; ++a)
#pragma unroll
        for (int b = 0; b < 2; ++b)
#pragma unroll
            for (int m = 0; m < 4; ++m)
#pragma unroll
                for (int n = 0; n < 2; ++n) acc[a][b][m][n] = (f32x4){0.f, 0.f, 0.f, 0.f};
    bf16x8 At[4][2], B0[2][2], B1[2][2];
    const char* cA = (const char*)g.A + (size_t)cur.pm * tstep + cur.ko; const char* cB = (const char*)g.Bt + (size_t)cur.pn * tstep + cur.ko;
    S.a_ready(cur);
    if constexpr (SP2) {
        PG8_STAGE(PG8_SB(0, 0), cB, voffB); PG8_STAGE(PG8_SB(0, 1), cB + hstep, voffB); PG8_STAGE(PG8_SA(0, 0), cA, voffA); PG8_STAGE(PG8_SA(0, 1), cA + hstep, voffA);
        if (wr == 1) PG8_BAR;
        PG8_WAIT_V(2); PG8_BAR;
        PG8_STAGE(PG8_SB(1, 0), cB + kstep, voffB); PG8_STAGE(PG8_SA(1, 0), cA + kstep, voffA); PG8_STAGE(PG8_SB(1, 1), cB + hstep + kstep, voffB);
        PG8_WAIT_V(6); PG8_BAR;
    } else {
        PG8_STAGE(PG8_SB(0, 0), cB, voffB); PG8_STAGE(PG8_SA(0, 0), cA, voffA); PG8_STAGE(PG8_SB(0, 1), cB + hstep, voffB); PG8_STAGE(PG8_SA(0, 1), cA + hstep, voffA);
        if (wr == 1) PG8_BAR;
        PG8_WAIT_V(4); PG8_BAR;
        PG8_STAGE(PG8_SB(1, 0), cB + kstep, voffB); PG8_STAGE(PG8_SA(1, 0), cA + kstep, voffA); PG8_STAGE(PG8_SB(1, 1), cB + hstep + kstep, voffB);
        PG8_WAIT_V(6); PG8_BAR;
    }
    for (;;) {
        const bool has_next = S.next(ui + 1, nxt);
        const char* nA = has_next ? (const char*)g.A + (size_t)nxt.pm * tstep + nxt.ko : cA; const char* nB = has_next ? (const char*)g.Bt + (size_t)nxt.pn * tstep + nxt.ko : cB;
        for (int t = 0; t < nt; t += 2) {
            const bool last = (t == nt - 2);
            const char* a1 = cA + (size_t)(t + 1) * kstep;
            const char* a2 = last ? nA : cA + (size_t)(t + 2) * kstep; const char* b2 = last ? nB : cB + (size_t)(t + 2) * kstep;
            const char* a3 = a2 + kstep; const char* b3 = b2 + kstep;
            if (last && has_next) S.a_ready(nxt);
            if constexpr (SP2) {
            PG8_LDB(B0, 0, 0); PG8_LDB(B1, 0, 1); PG8_SCHED; PG8_LDA(At, 0, 0); PG8_STAGE(PG8_SA(1, 1), a1 + hstep, voffA);
            PG8_WAIT_V(8); PG8_WAIT_L(0); PG8_BAR; PG8_MMA(0, 0, At, B0); PG8_MMA(0, 1, At, B1); PG8_BAR; PG8_SCHED;
            PG8_LDA(At, 0, 1); PG8_STAGE(PG8_SB(0, 0), b2, voffB); PG8_STAGE(PG8_SB(0, 1), b2 + hstep, voffB); PG8_STAGE(PG8_SA(0, 0), a2, voffA);
            PG8_WAIT_V(8); PG8_WAIT_L(0); PG8_BAR; PG8_MMA(1, 0, At, B0); PG8_MMA(1, 1, At, B1); PG8_BAR; PG8_SCHED;
            PG8_LDB(B0, 1, 0); PG8_LDB(B1, 1, 1); PG8_SCHED; PG8_LDA(At, 1, 0); PG8_STAGE(PG8_SA(0, 1), a2 + hstep, voffA);
            PG8_WAIT_V(8); PG8_WAIT_L(0); PG8_BAR; PG8_MMA(0, 0, At, B0); PG8_MMA(0, 1, At, B1); PG8_BAR; PG8_SCHED;
            PG8_LDA(At, 1, 1); PG8_STAGE(PG8_SB(1, 0), b3, voffB); PG8_STAGE(PG8_SB(1, 1), b3 + hstep, voffB); PG8_STAGE(PG8_SA(1, 0), a3, voffA);
            PG8_WAIT_V(8); PG8_WAIT_L(0); PG8_BAR; PG8_MMA(1, 0, At, B0); PG8_MMA(1, 1, At, B1); PG8_BAR; PG8_SCHED;
            } else {
            PG8_LDB(B0, 0, 0); PG8_SCHED; PG8_LDA(At, 0, 0); PG8_STAGE(PG8_SA(1, 1), a1 + hstep, voffA);
            PG8_WAIT_L(8); PG8_BAR; PG8_WAIT_L(0); PG8_MMA(0, 0, At, B0); PG8_BAR; PG8_SCHED;
            PG8_LDB(B1, 0, 1); PG8_STAGE(PG8_SB(0, 0), b2, voffB);
            PG8_BAR; PG8_WAIT_L(0); PG8_MMA(0, 1, At, B1); PG8_BAR;
            PG8_LDA(At, 0, 1); PG8_STAGE(PG8_SA(0, 0), a2, voffA);
            PG8_BAR; PG8_WAIT_L(0); PG8_MMA(1, 0, At, B0); PG8_BAR; PG8_SCHED;
            PG8_STAGE(PG8_SB(0, 1), b2 + hstep, voffB);
            PG8_WAIT_V(6); PG8_BAR; PG8_MMA(1, 1, At, B1); PG8_BAR;
            PG8_LDB(B0, 1, 0); PG8_SCHED; PG8_LDA(At, 1, 0); PG8_STAGE(PG8_SA(0, 1), a2 + hstep, voffA);
            PG8_WAIT_L(8); PG8_BAR; PG8_WAIT_L(0); PG8_MMA(0, 0, At, B0); PG8_BAR; PG8_SCHED;
            PG8_LDB(B1, 1, 1); PG8_STAGE(PG8_SB(1, 0), b3, voffB);
            PG8_BAR; PG8_WAIT_L(0); PG8_MMA(0, 1, At, B1); PG8_BAR;
            PG8_LDA(At, 1, 1); PG8_STAGE(PG8_SA(1, 0), a3, voffA);
            PG8_BAR; PG8_WAIT_L(0); PG8_MMA(1, 0, At, B0); PG8_BAR; PG8_SCHED;
            PG8_STAGE(PG8_SB(1, 1), b3 + hstep, voffB);
            PG8_WAIT_V(6); PG8_BAR; PG8_MMA(1, 1, At, B1); PG8_BAR;
            }
        }
        if constexpr (ALIGN_EPI) { if (wr == 0) PG8_BAR; }
        if constexpr (!Epi::AFTER_DRAIN) { E(acc, cur, wr, wc, fr, fq); S.done(cur); }
        if (!has_next) break;
#pragma unroll
        for (int a = 0; a < 2; ++a)
#pragma unroll
            for (int b = 0; b < 2; ++b)
#pragma unroll
                for (int m = 0; m < 4; ++m)
#pragma unroll
                    for (int n = 0; n < 2; ++n) acc[a][b][m][n] = (f32x4){0.f, 0.f, 0.f, 0.f};
        cur = nxt; cA = nA; cB = nB; ++ui;
        if constexpr (ALIGN_EPI) { if (wr == 1) PG8_BAR; }
    }
    PG8_WAIT_V(0);
    if constexpr (!ALIGN_EPI) { if (wr == 0) PG8_BAR; }
    PG8_BAR;
    if constexpr (Epi::AFTER_DRAIN) { E.fused(acc, cur, wr, wc, fr, fq, lds, wid, lane); S.done(cur); }
#undef PG8_SA
#undef PG8_SB
#undef PG8_STAGE
#undef PG8_LDA
#undef PG8_LDB
#undef PG8_MMA
#undef PG8_WAIT_V
#undef PG8_WAIT_L
#undef PG8_BAR
#undef PG8_SCHED
}
}
constexpr int D_MODEL = 1024, BATCH = 16, SEQ = 2048, DEC_BATCH = 128, PAST = 8192, PAGE = 128, NPAGES = 64;
constexpr int D_INNER = 2048, A_HEADS = 32, A_HEAD = 64, B_HEADS = 16, KV_LORA = 256, Q_LORA = 384, QK_NOPE = 128, QK_ROPE = 64, V_HEAD = 128, QK_HEAD = 192;
constexpr int MP = BATCH * SEQ;
constexpr int MS0 = MP;
constexpr int MT = MP + 256;
constexpr float NORM_EPS = 1e-6f, GN_EPS = 64e-5f;
constexpr float ATTN_SCALE = 0.07216878364870322f;
constexpr float LOG2E = 1.4426950408889634f;
constexpr int NWAVES = 8, NTHR = 512;

constexpr size_t O_YP = 0, O_YS = O_YP + (size_t)MP * D_MODEL, O_WKVP = O_YS + (size_t)DEC_BATCH * D_MODEL, O_SHP = O_WKVP + (size_t)2 * BATCH * A_HEADS * 4096,
    O_CKVP = O_SHP + (size_t)2 * BATCH * D_MODEL, O_KPEP = O_CKVP + (size_t)MP * KV_LORA, O_WKVS = O_KPEP + (size_t)MP * QK_ROPE, O_SHS = O_WKVS + (size_t)2 * DEC_BATCH * A_HEADS * 4096,
    O_CKVS = O_SHS + (size_t)2 * DEC_BATCH * D_MODEL, O_KPES = O_CKVS + (size_t)DEC_BATCH * KV_LORA, O_END = O_KPES + (size_t)DEC_BATCH * QK_ROPE;

constexpr size_t MiB = 1u << 20;
constexpr size_t WS_CTL = 0, CTL_ZERO_BYTES = 2 * MiB;
constexpr size_t WS_WIN = 2 * MiB, WIN_L = 18 * MiB;
constexpr size_t WS_W2 = WS_WIN + 2 * WIN_L;
constexpr size_t WS_WO = WS_W2 + 3 * MiB;
constexpr size_t WS_WDKV = WS_WO + 8 * MiB;
constexpr size_t WS_WUK = WS_WDKV + 1 * MiB;
constexpr size_t WS_WUV = WS_WUK + 1 * MiB;
constexpr size_t WS_WQ = WS_WUV + 1 * MiB;
constexpr size_t WS_WZ = WS_WQ + 2 * MiB;
constexpr size_t WS_WUQ = WS_WZ + 8 * MiB;
constexpr size_t WS_WBO = WS_WUQ + 5 * MiB;
constexpr size_t WS_ROPE = WS_WBO + 8 * MiB;
constexpr size_t WS_X = 96 * MiB;
constexpr size_t WS_AM = WS_X + 130 * MiB;
constexpr size_t AM_STRIDE = 65 * MiB;
constexpr size_t WS_R = WS_AM + 6 * AM_STRIDE;
constexpr size_t BIGB = 130 * MiB;
constexpr size_t WS_K = WS_R + BIGB, WS_V0 = WS_K + BIGB, WS_V1 = WS_V0 + BIGB, WS_Z = WS_V1 + BIGB, WS_G = WS_Z + BIGB;
constexpr size_t WS_LW = WS_G + BIGB;
constexpr size_t WS_LA = WS_LW + 9 * MiB, WS_LV = WS_LA + 9 * MiB;
constexpr size_t WS_BON = WS_LV + 9 * MiB;
constexpr size_t WS_F = WS_BON + 5 * MiB;
constexpr size_t BIGF = 260 * MiB;
constexpr size_t WS_WD = WS_F, WS_IA = WS_F + BIGF, WS_VG = WS_F + 2 * BIGF, WS_SR = WS_F + 3 * BIGF, WS_SK = WS_F + 4 * BIGF, WS_SA = WS_F + 5 * BIGF, WS_SB = WS_F + 6 * BIGF,
    WS_SV = WS_F + 7 * BIGF, WS_Y = WS_F + 8 * BIGF, WS_END_A = WS_F + 9 * BIGF;
constexpr size_t WS_KVR = WS_F;
constexpr size_t WS_CKVB = WS_KVR + 41 * MiB;
constexpr size_t WS_KPEB = WS_CKVB + 17 * MiB;
constexpr size_t WS_KN = WS_KPEB + 5 * MiB;
constexpr size_t WS_VT = WS_KN + 128 * MiB;
constexpr size_t WS_QL = WS_VT + 128 * MiB;
constexpr size_t WS_CQ = WS_QL + 49 * MiB;
constexpr size_t WS_QR = WS_CQ + 25 * MiB;
constexpr size_t WS_Q = WS_QR + 388 * MiB;
constexpr size_t WS_QABS = WS_Q + 194 * MiB;
constexpr size_t WS_OPART = WS_QABS + 2 * MiB;
constexpr size_t WS_ML = WS_OPART + 16 * MiB;
constexpr size_t WS_END_B = WS_ML + 1 * MiB;
constexpr size_t WS_NEED = WS_END_A > WS_END_B ? WS_END_A : WS_END_B;
static_assert(WS_ROPE + 1 * MiB <= WS_X, "weights region");
constexpr size_t CW_RSQ = 1 * MiB;
constexpr int CW_BAR = 4096;

constexpr int RING_BYTES = 131072;
constexpr int LDSCTL_OFF = RING_BYTES;
constexpr int LDS_BYTES = 147456;

#define GAS __attribute__((address_space(1)))
#define LAS __attribute__((address_space(3)))
typedef unsigned short bf16;
typedef unsigned v4u __attribute__((ext_vector_type(4)));
typedef unsigned v2u __attribute__((ext_vector_type(2)));
typedef float f32x4 __attribute__((ext_vector_type(4)));
typedef float f32x16 __attribute__((ext_vector_type(16)));
typedef short bf16x8 __attribute__((ext_vector_type(8)));
typedef short s16x4 __attribute__((ext_vector_type(4)));
typedef const __attribute__((address_space(4))) float* cfp;
#define LDS_WAIT() asm volatile("s_waitcnt lgkmcnt(0)" ::: "memory")
#define VM_WAIT() asm volatile("s_waitcnt vmcnt(0)" ::: "memory")
__device__ __forceinline__ unsigned f2bf(float f) { unsigned u = __builtin_bit_cast(unsigned, f); return (u + 0x7fffu + ((u >> 16) & 1u)) >> 16; }
__device__ __forceinline__ unsigned pk2(float lo, float hi) { return f2bf(lo) | (f2bf(hi) << 16); }
__device__ __forceinline__ float bflo(unsigned u) { return __builtin_bit_cast(float, u << 16); }
__device__ __forceinline__ float bfhi(unsigned u) { return __builtin_bit_cast(float, u & 0xffff0000u); }
template <int MASK> __device__ __forceinline__ float swz_xor(float v) { return __builtin_bit_cast(float, __builtin_amdgcn_ds_swizzle(__builtin_bit_cast(int, v), 0x1F | (MASK << 10))); }
__device__ __forceinline__ float xor32_sum(float v) { float a = v, b = v; asm volatile("s_nop 1\n\tv_permlane32_swap_b32 %0, %1\n\ts_nop 1" : "+v"(a), "+v"(b)); return a + b; }
__device__ __forceinline__ float xor32_max(float v) { float a = v, b = v; asm volatile("s_nop 1\n\tv_permlane32_swap_b32 %0, %1\n\ts_nop 1" : "+v"(a), "+v"(b)); return fmaxf(a, b); }
__device__ __forceinline__ float wave_sum(float v) { v += swz_xor<1>(v); v += swz_xor<2>(v); v += swz_xor<4>(v); v += swz_xor<8>(v); v += swz_xor<16>(v); return xor32_sum(v); }
__device__ __forceinline__ float sigmoidf_(float x) { return 1.0f / (1.0f + __expf(-x)); }
#define XB_TMO      128
#define XB_XCNT(j)  (256  + 64 * (j))
#define XB_XSUB(j)  (1280 + 64 * (j))
#define XB_XGEN(j)  (2304 + 64 * (j))
#define XB_TOP      3328
#define XB_TOPGEN   3392
#define XCD_BAR_WORDS 3456
#define XB_SPIN_CAP (1u << 18)

__device__ __forceinline__ unsigned xb_ld(unsigned* p)              { return __hip_atomic_load(p, __ATOMIC_RELAXED, __HIP_MEMORY_SCOPE_AGENT); }
__device__ __forceinline__ unsigned xb_add(unsigned* p, unsigned v) { return __hip_atomic_fetch_add(p, v, __ATOMIC_RELAXED, __HIP_MEMORY_SCOPE_AGENT); }
__device__ __forceinline__ unsigned xb_xcc_id() { return (unsigned)__builtin_amdgcn_s_getreg((3 << 11) | 20) & 0xFu; }
#define XB_SPIN(cond, bar) do { unsigned _sp = 0; while (cond) { __builtin_amdgcn_s_sleep(1); \
    if ((++_sp & 255u) == 0u) { if (xb_ld(&(bar)[XB_TMO])) break; if (_sp > XB_SPIN_CAP) { atomicAdd(&(bar)[XB_TMO], 1u); break; } } } } while (0)

struct XcdBarrier {
    unsigned* bar; unsigned x; unsigned w;
    volatile LAS unsigned* st;
};

__device__ __forceinline__ bool xb_t0(unsigned w) { unsigned l; asm volatile("v_mbcnt_lo_u32_b32 %0, -1, 0\n\tv_mbcnt_hi_u32_b32 %0, -1, %0" : "=v"(l)); return w == 0u && l == 0u; }
__device__ __forceinline__ XcdBarrier xcd_barrier_post(unsigned* bar, volatile LAS unsigned* st, unsigned w) {
    XcdBarrier b; b.bar = bar; b.x = xb_xcc_id(); b.st = st; b.w = w;
    if (xb_t0(w)) (void)xb_add(&bar[XB_XCNT(b.x)], 1u);
    return b;
}
__device__ __forceinline__ void xcd_barrier_complete(unsigned* bar, unsigned x, unsigned& nloc, unsigned& nx) {
    const unsigned G = gridDim.x * gridDim.y * gridDim.z;
    unsigned sum, cnt, mine, sp = 0u;
    for (;;) {
        sum = 0u; cnt = 0u; mine = 0u;
#pragma unroll
        for (unsigned j = 0; j < 16; ++j) { const unsigned c = xb_ld(&bar[XB_XCNT(j)]); sum += c; cnt += (c > 0u) ? 1u : 0u; mine = (j == x) ? c : mine; }
        if (sum == G) break;
        __builtin_amdgcn_s_sleep(1);
        if ((++sp & 255u) == 0u) { if (xb_ld(&bar[XB_TMO])) break; if (sp > XB_SPIN_CAP) { atomicAdd(&bar[XB_TMO], 1u); break; } }
    }
    nloc = mine > 0u ? mine : 1u; nx = cnt > 0u ? cnt : 1u;
}

__device__ __forceinline__ void xcd_barrier(const XcdBarrier& b) {
    asm volatile("s_waitcnt vmcnt(0)" ::: "memory");
    __syncthreads();
    if (xb_t0(b.w)) {
        unsigned* bar = b.bar;
        __builtin_amdgcn_s_waitcnt(0);
        unsigned nloc = b.st[0], nx = b.st[1];
        if (nloc == 0u) { xcd_barrier_complete(bar, b.x, nloc, nx); b.st[0] = nloc; b.st[1] = nx; }
        const unsigned old = xb_add(&bar[XB_XSUB(b.x)], 1u);
        const unsigned gen = old / nloc;
        if (old + 1u == (gen + 1u) * nloc) {
            __builtin_amdgcn_fence(__ATOMIC_RELEASE, "agent");
            asm volatile("s_waitcnt vmcnt(0)" ::: "memory");
            const unsigned og = xb_add(&bar[XB_TOP], 1u);
            const unsigned tg = og / nx;
            if (og + 1u == (tg + 1u) * nx) xb_add(&bar[XB_TOPGEN], 1u);
            else XB_SPIN(xb_ld(&bar[XB_TOPGEN]) == tg, bar);
            __builtin_amdgcn_fence(__ATOMIC_ACQUIRE, "agent");
            xb_add(&bar[XB_XGEN(b.x)], 1u);
            asm volatile("s_waitcnt vmcnt(0)" ::: "memory");
        } else {
            XB_SPIN(xb_ld(&bar[XB_XGEN(b.x)]) == gen, bar);
            __builtin_amdgcn_fence(__ATOMIC_ACQUIRE, "agent");
            asm volatile("s_waitcnt vmcnt(0)" ::: "memory");
        }
    }
    __syncthreads();
}
struct Args { const void* in[36]; float* out; unsigned char* ws; int ph_lo, ph_hi, li, pad; };
typedef const __attribute__((address_space(4))) Args* cargs;
__device__ __forceinline__ int lane_id() { int l; asm volatile("v_mbcnt_lo_u32_b32 %0, -1, 0\n\tv_mbcnt_hi_u32_b32 %0, -1, %0" : "=v"(l)); return l; }
struct Frame { LAS unsigned char* lds; unsigned char* ws; float* out; int lane, wave, bid, gw, NGW, G, NT; };
#define LANE F.lane
__device__ __forceinline__ Frame make_frame(cargs ap, int wave0, LAS unsigned char* lds) {
    Frame F; int w = wave0, b = (int)blockIdx.x, g = (int)gridDim.x; asm volatile("" : "+s"(w), "+s"(b), "+s"(g));
    F.lds = lds; F.ws = ap->ws; F.out = ap->out; F.lane = lane_id(); F.wave = w; F.bid = b; F.G = g; F.gw = b * NWAVES + w; F.NGW = g * NWAVES; F.NT = g * NTHR;
    return F;
}

__device__ __forceinline__ int rope_perm_col(int n) { const int c = n % 192; if (c < 128) return n; const int j = c - 128; return n - c + 128 + 2 * (j & 31) + (j >> 5); }
__device__ __forceinline__ void tr_item(const float* W, int ldw, int col0, int Kvalid, int nblk, bf16* WT, int ldt, bool zpad, LAS float* scr, int item, int lane, bool rperm = false) {
    const int kb = item / nblk, nb = item % nblk, k0 = 64 * kb, n0 = 32 * nb;
    float wv[32];
#pragma unroll
    for (int i = 0; i < 32; ++i) { const int kr = min(k0 + 2 * i + (lane >> 5), Kvalid - 1); wv[i] = W[(size_t)kr * ldw + col0 + n0 + (lane & 31)]; }
    __builtin_amdgcn_sched_barrier(0);
#pragma unroll
    for (int i = 0; i < 32; ++i) { const int kk = 2 * i + (lane >> 5); scr[kk * 33 + (lane & 31)] = (k0 + kk < Kvalid) ? wv[i] : 0.f; }
    LDS_WAIT(); asm volatile("" ::: "memory");
    const int c = lane & 7;
#pragma unroll
    for (int j = 0; j < 4; ++j) { const int n = (lane >> 3) + 8 * j; const LAS float* s = scr + (8 * c) * 33 + n;
        v4u o; o.x = pk2(s[0 * 33], s[1 * 33]); o.y = pk2(s[2 * 33], s[3 * 33]); o.z = pk2(s[4 * 33], s[5 * 33]); o.w = pk2(s[6 * 33], s[7 * 33]);
        const int nd = rperm ? rope_perm_col(n0 + n) : n0 + n;
        *(v4u*)(WT + (size_t)nd * ldt + k0 + 8 * c) = o;
        if (zpad) *(v4u*)(WT + (size_t)nd * ldt + 64 + 8 * c) = (v4u){0u, 0u, 0u, 0u}; }
    LDS_WAIT(); asm volatile("" ::: "memory");
}
#define TRJOB_(W_, ldw_, col0_, Kv_, Nc_, WT_, ldt_, zp_, rp_) do { const int nblk_ = (Nc_) / 32, items_ = (((Kv_) + 63) / 64) * nblk_; \
    for (int it_ = ((F.gw - base_) % F.NGW + F.NGW) % F.NGW; it_ < items_; it_ += F.NGW) tr_item((W_), (ldw_), (col0_), (Kv_), nblk_, (bf16*)(WT_), (ldt_), (zp_), scr, it_, LANE, (rp_)); base_ = (base_ + items_) % F.NGW; } while (0)
#define TRJOB(W_, ldw_, col0_, Kv_, Nc_, WT_, ldt_, zp_) TRJOB_(W_, ldw_, col0_, Kv_, Nc_, WT_, ldt_, zp_, false)

__device__ __forceinline__ void p0_prologue(Frame& F, cargs a) {
    LAS float* scr = (LAS float*)(F.lds + F.wave * 16384);
    unsigned char* ws = F.ws; int base_ = 0;
    for (int l = 0; l < 2; ++l) {
        for (int p = 0; p < 4; ++p) TRJOB((const float*)a->in[9] + (size_t)(l * 4 + p) * 1024 * 2048, 2048, 0, 1024, 2048, ws + WS_WIN + (size_t)l * WIN_L + (size_t)p * 4 * MiB, 1024, false);
        TRJOB((const float*)a->in[11] + (size_t)l * 1024 * 64, 64, 0, 1024, 64, ws + WS_WIN + (size_t)l * WIN_L + 16 * MiB, 1024, false);
        TRJOB((const float*)a->in[14] + (size_t)l * 1024 * 64, 64, 0, 1024, 64, ws + WS_WIN + (size_t)l * WIN_L + 16 * MiB + MiB / 2, 1024, false);
        TRJOB((const float*)a->in[12] + (size_t)l * 64 * 2048, 2048, 0, 64, 2048, ws + WS_W2 + (size_t)l * (MiB / 2), 128, true);
        TRJOB((const float*)a->in[15] + (size_t)l * 64 * 2048, 2048, 0, 64, 2048, ws + WS_W2 + (size_t)(2 + l) * (MiB / 2), 128, true);
        TRJOB((const float*)a->in[24] + (size_t)l * 2048 * 1024, 1024, 0, 2048, 1024, ws + WS_WO + (size_t)l * 4 * MiB, 2048, false);
        TRJOB((const float*)a->in[31] + (size_t)l * 1024 * 2432, 2432, 0, 1024, 384, ws + WS_WQ + (size_t)l * MiB, 1024, false);
        TRJOB((const float*)a->in[31] + (size_t)l * 1024 * 2432, 2432, 384, 1024, 2048, ws + WS_WZ + (size_t)l * 4 * MiB, 1024, false);
        TRJOB_((const float*)a->in[33] + (size_t)l * 384 * 3072, 3072, 0, 384, 3072, ws + WS_WUQ + (size_t)l * (5 * MiB / 2), 384, false, true);
        TRJOB((const float*)a->in[34] + (size_t)l * 2048 * 1024, 1024, 0, 2048, 1024, ws + WS_WBO + (size_t)l * 4 * MiB, 2048, false);
    }
    TRJOB((const float*)a->in[17], 32, 0, 1024, 32, ws + WS_WIN + WIN_L + 17 * MiB, 1024, false);
    TRJOB((const float*)a->in[18], 2048, 0, 32, 2048, ws + WS_W2 + (size_t)4 * (MiB / 2), 128, true);
    TRJOB((const float*)a->in[26], 320, 0, 1024, 320, ws + WS_WDKV, 1024, false);
    TRJOB((const float*)a->in[28], 2048, 0, 256, 2048, ws + WS_WUK, 256, false);
    TRJOB((const float*)a->in[29], 2048, 0, 256, 2048, ws + WS_WUV, 256, false);
    { const f32x4* xs = (const f32x4*)a->in[1]; f32x4* X4 = (f32x4*)(ws + WS_X) + (size_t)MP * 256;
      for (int i = (F.bid * NTHR + F.wave * 64 + LANE); i < 256 * 256; i += F.NT) X4[i] = i < DEC_BATCH * 256 ? xs[i] : (f32x4){0.f, 0.f, 0.f, 0.f}; }
    { float* T = (float*)(ws + WS_ROPE);
      for (int i = (F.bid * NTHR + F.wave * 64 + LANE); i < 2049 * 32; i += F.NT) { const int p = i >> 5, f = i & 31; const double pos = p < 2048 ? (double)p : 8192.0;
          const double ang = pos * (double)exp2f(-(float)f * (13.287712379549449f / 32.0f)); T[2 * i] = (float)cos(ang); T[2 * i + 1] = (float)sin(ang); } }
}

__device__ __forceinline__ void load_row(const float* row, int lane, f32x4 (&v)[4]) {
#pragma unroll
    for (int j = 0; j < 4; ++j) v[j] = ((const f32x4*)row)[lane + 64 * j];
}
__device__ __forceinline__ float row_rs(const f32x4 (&v)[4]) {
    float s = 0.f;
#pragma unroll
    for (int j = 0; j < 4; ++j) s += (v[j].x * v[j].x + v[j].y * v[j].y) + (v[j].z * v[j].z + v[j].w * v[j].w);
    return 1.0f / sqrtf(wave_sum(s) * (1.0f / 1024.0f) + NORM_EPS);
}
__device__ __forceinline__ void norm_rows_bf16(Frame& F, const float* X, const float* w, bf16* O) {
    f32x4 w4[4]; load_row(w, LANE, w4);
    for (int m = F.gw; m < MT; m += F.NGW) { f32x4 x[4]; load_row(X + (size_t)m * 1024, LANE, x); const float rs = row_rs(x);
#pragma unroll
        for (int j = 0; j < 4; ++j) { const f32x4 h = x[j] * rs * w4[j]; v2u o; o.x = pk2(h.x, h.y); o.y = pk2(h.z, h.w); *(v2u*)(O + (size_t)m * 1024 + 4 * LANE + 256 * j) = o; } }
}

__device__ __forceinline__ void norm2_rows_bf16(Frame& F, const float* X, const float* wa, bf16* Oa, const float* wb, bf16* Ob) {
    f32x4 a4[4], b4[4]; load_row(wa, LANE, a4); load_row(wb, LANE, b4);
    for (int m = F.gw; m < MT; m += F.NGW) { f32x4 x[4]; load_row(X + (size_t)m * 1024, LANE, x); const float rs = row_rs(x);
#pragma unroll
        for (int j = 0; j < 4; ++j) { const f32x4 xs = x[j] * rs, ha = xs * a4[j], hb = xs * b4[j]; v2u o; o.x = pk2(ha.x, ha.y); o.y = pk2(ha.z, ha.w); *(v2u*)(Oa + (size_t)m * 1024 + 4 * LANE + 256 * j) = o;
            o.x = pk2(hb.x, hb.y); o.y = pk2(hb.z, hb.w); *(v2u*)(Ob + (size_t)m * 1024 + 4 * LANE + 256 * j) = o; } }
}

__device__ __forceinline__ void a1_prepass(Frame& F, cargs a, int l) {
    const float* Xw = (const float*)(F.ws + WS_X); const float* X = l == 0 ? (const float*)a->in[0] : Xw;
    const float* nw = (const float*)a->in[7] + l * 1024; const float* mix = (const float*)a->in[8] + l * 6 * 1024; const float* sshift = (const float*)a->in[3] + (size_t)l * DEC_BATCH * 1024;
    f32x4 w4[4]; load_row(nw, LANE, w4);
    LAS f32x4* mxl = (LAS f32x4*)F.lds;
    for (int i = F.wave * 64 + LANE; i < 6 * 256; i += NTHR) mxl[i] = ((const f32x4*)mix)[i];
    __syncthreads();
    for (int m = F.gw; m < MT; m += F.NGW) {
        f32x4 x[4], h[4], hp[4]; load_row((m < MP ? X : Xw) + (size_t)m * 1024, LANE, x); const float rs = row_rs(x);
#pragma unroll
        for (int j = 0; j < 4; ++j) { h[j] = x[j] * rs * w4[j]; hp[j] = (f32x4){0.f, 0.f, 0.f, 0.f}; }
        if (m < MP) { if ((m & (SEQ - 1)) != 0) { f32x4 xq[4]; load_row(X + (size_t)(m - 1) * 1024, LANE, xq); const float rq = row_rs(xq);
#pragma unroll
                for (int j = 0; j < 4; ++j) hp[j] = xq[j] * rq * w4[j]; } }
        else if (m < MP + DEC_BATCH) load_row(sshift + (size_t)(m - MP) * 1024, LANE, hp);
#pragma unroll
        for (int p = 0; p < 6; ++p) { bf16* O = (bf16*)(F.ws + WS_AM + (size_t)p * AM_STRIDE) + (size_t)m * 1024;
#pragma unroll
            for (int j = 0; j < 4; ++j) { const f32x4 mx = mxl[p * 256 + LANE + 64 * j]; const f32x4 o = h[j] + (hp[j] - h[j]) * mx;
                v2u w; w.x = pk2(o.x, o.y); w.y = pk2(o.z, o.w); *(v2u*)(O + 4 * LANE + 256 * j) = w; } }
        float* so = nullptr;
        if (m < MP) { if ((m & (SEQ - 1)) == SEQ - 1) so = F.out + O_SHP + (size_t)(l * BATCH + (m >> 11)) * 1024; }
        else if (m < MP + DEC_BATCH) so = F.out + O_SHS + (size_t)(l * DEC_BATCH + (m - MP)) * 1024;
        if (so) {
#pragma unroll
            for (int j = 0; j < 4; ++j) ((f32x4*)so)[LANE + 64 * j] = h[j]; }
    }
}

typedef float f32x2 __attribute__((ext_vector_type(2)));
__device__ __forceinline__ void unpack8(v4u u, float (&f)[8]) { f[0] = bflo(u.x); f[1] = bfhi(u.x); f[2] = bflo(u.y); f[3] = bfhi(u.y); f[4] = bflo(u.z); f[5] = bfhi(u.z); f[6] = bflo(u.w); f[7] = bfhi(u.w); }
constexpr int FS_TS = 16, FS_Y = FS_TS * 6 * 64 * 4, FS_Z = FS_Y + FS_TS * 64 * 4, FS_BON = FS_Z + FS_TS * 64 * 2, FS_BH = FS_BON + 128, FS_BUF = 2 * FS_BH;
static_assert(2 * FS_BUF <= RING_BYTES && FS_BH % 16 == 0, "fused scan LDS");
template <int CTRL> __device__ __forceinline__ float dppf(float v) { return __builtin_bit_cast(float, __builtin_amdgcn_update_dpp(0, __builtin_bit_cast(int, v), CTRL, 0xF, 0xF, false)); }
__device__ __forceinline__ float wave_sum_fast(float v) {
    v += dppf<0xB1>(v); v += dppf<0x4E>(v); v += dppf<0x124>(v); v += dppf<0x128>(v);
    const int iv = __builtin_bit_cast(int, v);
    return (__builtin_bit_cast(float, __builtin_amdgcn_readlane(iv, 0)) + __builtin_bit_cast(float, __builtin_amdgcn_readlane(iv, 16))) + (__builtin_bit_cast(float, __builtin_amdgcn_readlane(iv, 32)) + __builtin_bit_cast(float, __builtin_amdgcn_readlane(iv, 48)));
}
struct HeadPrm { float w0, a0, v0, kk, ka, rk, lnw, lnb; };
__device__ __forceinline__ float frcp(float x) { return __builtin_amdgcn_rcpf(x); }
__device__ __forceinline__ float fsig(float x) { return __builtin_amdgcn_rcpf(1.0f + __builtin_amdgcn_exp2f(-1.4426950408889634f * x)); }
__device__ __forceinline__ float wkv_step_lds(f32x2 (&S)[32], const LAS float* op, int lane) {
    const LAS f32x4* a4 = (const LAS f32x4*)op; const LAS f32x4* w4 = a4 + 16; const LAS f32x4* b4 = a4 + 32; const LAS f32x4* k4 = a4 + 48; const LAS f32x4* r4 = a4 + 64;
    const float vv = op[320 + lane];
    f32x2 s0 = (f32x2){0.f, 0.f}, s1 = s0;
#pragma unroll
    for (int q = 0; q < 16; ++q) { const f32x4 a = a4[q]; s0 += S[2 * q] * (f32x2){a.x, a.y}; s1 += S[2 * q + 1] * (f32x2){a.z, a.w}; }
    const f32x2 st = s0 + s1; const float sa = st.x + st.y; const f32x2 sa2 = (f32x2){sa, sa}, vv2 = (f32x2){vv, vv};
    f32x2 y0 = (f32x2){0.f, 0.f}, y1 = y0;
#pragma unroll
    for (int q = 0; q < 16; ++q) { const f32x4 w = w4[q], b = b4[q], k = k4[q], r = r4[q];
        S[2 * q] = S[2 * q] * (f32x2){w.x, w.y} + (sa2 * (f32x2){b.x, b.y} + vv2 * (f32x2){k.x, k.y}); y0 += S[2 * q] * (f32x2){r.x, r.y};
        S[2 * q + 1] = S[2 * q + 1] * (f32x2){w.z, w.w} + (sa2 * (f32x2){b.z, b.w} + vv2 * (f32x2){k.z, k.w}); y1 += S[2 * q + 1] * (f32x2){r.z, r.w}; }
    const f32x2 yt = y0 + y1; return yt.x + yt.y;
}
__device__ __forceinline__ void fs_prep_one(const HeadPrm& P, int l, float r, float k, float v, float dw, float da, float dv, float vf, LAS float* op, int lane, float& bon) {
    const float ia = da, w = __builtin_amdgcn_exp2f(dw);
    if (l) v = v + (vf - v) * dv;
    const float kk = k * P.kk, n2 = wave_sum_fast(kk * kk), inv = 1.0f / fmaxf(sqrtf(n2), 1e-12f), q = kk * inv, kp = k * (1.0f + (ia - 1.0f) * P.ka);
    bon = wave_sum_fast(r * kp * P.rk);
    op[lane] = -q; op[64 + lane] = w; op[128 + lane] = q * ia; op[192 + lane] = kp; op[256 + lane] = r; op[320 + lane] = v;
}
__device__ __forceinline__ float fs_post_one(const HeadPrm& P, float y, float vp, float z, float bon) {
    const float mu = wave_sum_fast(y) * (1.0f / 64.0f), d = y - mu, var = wave_sum_fast(d * d) * (1.0f / 64.0f);
    const float yn = d * __builtin_amdgcn_rsqf(var + GN_EPS) * P.lnw + P.lnb; return (yn + bon * vp) * (z * fsig(z));
}
__device__ __forceinline__ float ldbf(const bf16* p) { return bflo((unsigned)*p); }
__device__ __forceinline__ bf16 tobf(float x) { return __builtin_bit_cast(unsigned short, (__bf16)x); }
typedef short s16x4_t __attribute__((ext_vector_type(4)));
#define MF16(a_, b_, c_) __builtin_amdgcn_mfma_f32_16x16x16bf16_1k((a_), (b_), (c_), 0, 0, 0)
#define MF32(a_, b_, c_) __builtin_amdgcn_mfma_f32_16x16x32_bf16((a_), (b_), (c_), 0, 0, 0)
#define CAT8(a_, b_) __builtin_shufflevector((a_), (b_), 0, 1, 2, 3, 4, 5, 6, 7)
typedef __bf16 bf16x4_nat __attribute__((ext_vector_type(4)));
__device__ __forceinline__ s16x4_t cvt4(f32x4 v) { return __builtin_bit_cast(s16x4_t, __builtin_convertvector(v, bf16x4_nat)); }
constexpr int CK_TP = 144, CK_KP = 40;
constexpr int CK_AT = 0, CK_RT = CK_AT + 16 * CK_TP, CK_BH = CK_RT + 16 * CK_TP, CK_KH = CK_BH + 16 * CK_TP, CK_BHT = CK_KH + 16 * CK_TP, CK_KHT = CK_BHT + 64 * CK_KP, CK_VT = CK_KHT + 64 * CK_KP,
    CK_PC = CK_VT + 64 * CK_KP, CK_OPB = CK_PC + 256;
constexpr int RG_VP = 0, RG_Z = 2048, RG_BON = 4096, RG_SZ = 4224;
constexpr int BH_OPB = 0, BH_RING = 2 * CK_OPB, BH_Y = BH_RING + 3 * RG_SZ, BH_LW = BH_Y + 2 * 4096, BH_PRM = BH_LW + 4096, BH_SZ = BH_PRM + 6 * 256;
static_assert(2 * BH_SZ <= RING_BYTES && BH_SZ % 16 == 0 && CK_OPB % 16 == 0, "chunked scan LDS");
typedef short v4i16_ck __attribute__((ext_vector_type(4)));
__device__ __forceinline__ s16x4_t ck_tr(const LAS unsigned char* p) { return __builtin_bit_cast(s16x4_t, __builtin_amdgcn_ds_read_tr16_b64_v4i16((LAS v4i16_ck*)p)); }
__device__ __forceinline__ void ck_scan_chunk(f32x4 (&ST)[4][4], const LAS unsigned char* ob, const LAS unsigned char* vpb, LAS float* yb, int c16, int g) {
    const f32x4 zero4 = (f32x4){0.f, 0.f, 0.f, 0.f};
    bf16x8 at[2], rt[2], bh[2], kh[2];
#pragma unroll
    for (int ks = 0; ks < 2; ++ks) { const int o = c16 * CK_TP + 16 * g + 64 * ks;
        at[ks] = *(const LAS bf16x8*)(ob + CK_AT + o); rt[ks] = *(const LAS bf16x8*)(ob + CK_RT + o); bh[ks] = *(const LAS bf16x8*)(ob + CK_BH + o); kh[ks] = *(const LAS bf16x8*)(ob + CK_KH + o); }
    f32x4 qN = zero4, qL = zero4, qMk = zero4, qNbr = zero4, qNkr = zero4;
#pragma unroll
    for (int ks = 0; ks < 2; ++ks) { qN = MF32(bh[ks], at[ks], qN); qL = MF32(at[ks], bh[ks], qL); qMk = MF32(kh[ks], at[ks], qMk); qNbr = MF32(bh[ks], rt[ks], qNbr); qNkr = MF32(kh[ks], rt[ks], qNkr); }
    f32x4 Id;
#pragma unroll
    for (int r = 0; r < 4; ++r) { const int row = 4 * g + r; Id[r] = row == c16 ? 1.f : 0.f;
        if (!(row < c16)) { qN[r] = 0.f; qMk[r] = 0.f; }
        if (!(row <= c16)) { qNbr[r] = 0.f; qNkr[r] = 0.f; }
        if (!(c16 < row)) qL[r] = 0.f; }
    const s16x4_t aN = cvt4(qN), aL = cvt4(qL), aMk = cvt4(qMk), aNbr = cvt4(qNbr), aNkr = cvt4(qNkr);
    const f32x4 n2 = MF16(aL, aN, zero4), l2 = MF16(aN, aL, zero4);
    const s16x4_t aN2 = cvt4(n2), aL2 = cvt4(l2);
    const f32x4 n4 = MF16(aL2, aN2, zero4), l4 = MF16(aN2, aL2, zero4);
    const f32x4 n8 = MF16(cvt4(l4), cvt4(n4), zero4);
    const f32x4 p1t = MF16(cvt4(n2 + Id), cvt4(qL + Id), zero4);
    const f32x4 p2 = MF16(cvt4(l4 + Id), cvt4(n8 + Id), zero4);
    const s16x4_t aT = cvt4(MF16(cvt4(p1t), cvt4(p2), zero4));
    s16x4_t af[4], rf[4], bfr[4], kfr[4], vtr[4]; f32x4 pc[4]; s16x4_t Sb[4];
#pragma unroll
    for (int ki = 0; ki < 4; ++ki) { const int o = c16 * CK_TP + (16 * ki + 4 * g) * 2; af[ki] = *(const LAS s16x4_t*)(ob + CK_AT + o); rf[ki] = *(const LAS s16x4_t*)(ob + CK_RT + o);
        const int o2 = (4 * g + (c16 >> 2)) * CK_TP + (16 * ki + 4 * (c16 & 3)) * 2; bfr[ki] = ck_tr(ob + CK_BH + o2); kfr[ki] = ck_tr(ob + CK_KH + o2);
        vtr[ki] = ck_tr(vpb + (4 * g + (c16 >> 2)) * 128 + (16 * ki + 4 * (c16 & 3)) * 2);
        pc[ki] = *(const LAS f32x4*)(ob + CK_PC + (16 * ki + 4 * g) * 4); }
    f32x4 yt[4];
#pragma unroll
    for (int vi = 0; vi < 4; ++vi) {
        f32x4 xt = zero4, y0 = zero4;
#pragma unroll
        for (int ki = 0; ki < 4; ki += 2) { Sb[ki] = cvt4(ST[ki][vi]); Sb[ki + 1] = cvt4(ST[ki + 1][vi]); const bf16x8 sb2 = CAT8(Sb[ki], Sb[ki + 1]);
            xt = MF32(CAT8(af[ki], af[ki + 1]), sb2, xt); y0 = MF32(CAT8(rf[ki], rf[ki + 1]), sb2, y0); }
        const s16x4_t vt = vtr[vi];
        xt = MF16(aMk, vt, xt);
        const s16x4_t ub = cvt4(MF16(aT, cvt4(xt), zero4));
        const bf16x8 uv = CAT8(ub, vt);
        yt[vi] = MF32(CAT8(aNbr, aNkr), uv, y0);
#pragma unroll
        for (int ki = 0; ki < 4; ++ki) { ST[ki][vi] = MF32(CAT8(bfr[ki], kfr[ki]), uv, ST[ki][vi]); ST[ki][vi] *= pc[ki]; }
    }
#pragma unroll
    for (int vi = 0; vi < 4; ++vi)
#pragma unroll
        for (int r = 0; r < 4; ++r) yb[(4 * g + r) * 64 + 16 * vi + c16] = yt[vi][r];
}
__device__ __forceinline__ void a5_fused(Frame& F, cargs a, int l) {
    unsigned char* ws = F.ws; const int lane = F.lane;
    const bf16* R = (const bf16*)(ws + WS_R); const bf16* K = (const bf16*)(ws + WS_K); const bf16* V = (const bf16*)(ws + (l ? WS_V1 : WS_V0)); const bf16* VF = (const bf16*)(ws + WS_V0); const bf16* Z = (const bf16*)(ws + WS_Z);
    const bf16* DW = (const bf16*)(ws + WS_WD); const bf16* DA = (const bf16*)(ws + WS_IA); const bf16* DV = (const bf16*)(ws + WS_VG); bf16* G = (bf16*)(ws + WS_G);
    const float* pw0 = (const float*)a->in[10] + l * 2048; const float* pa0 = (const float*)a->in[13] + l * 2048; const float* pv0 = (const float*)a->in[16]; const float* pkk = (const float*)a->in[19] + l * 2048;
    const float* pka = (const float*)a->in[20] + l * 2048; const float* prk = (const float*)a->in[21] + l * 2048; const float* plw = (const float*)a->in[22] + l * 2048; const float* plb = (const float*)a->in[23] + l * 2048;
    constexpr int NCH = SEQ / 16;
    for (int pr = F.bid; pr < BATCH * A_HEADS / 2; pr += F.G) { const int bh0 = 2 * pr;
        const int role = F.wave >> 1, hb = F.wave & 1, bh = bh0 + hb, b = bh >> 5, hh = bh & 31, ch = hh * 64 + lane;
        LAS unsigned char* blk = F.lds + hb * BH_SZ;
        const size_t rowb = (size_t)b * SEQ; const int c16 = lane & 15, g = lane >> 4;
#define CK_BAR() do { asm volatile("s_waitcnt lgkmcnt(0)" ::: "memory"); __builtin_amdgcn_s_barrier(); asm volatile("" ::: "memory"); } while (0)
#define CKV_LOAD(cc, SET) do { const size_t ro = (rowb + (size_t)(cc) * 16) * 2048;     \
            _Pragma("unroll") for (int j = 0; j < 2; ++j) { SET##r[j] = ((const v4u*)(R + ro + voff_))[j]; SET##k[j] = ((const v4u*)(K + ro + voff_))[j]; SET##v[j] = ((const v4u*)(V + ro + voff_))[j]; SET##z[j] = ((const v4u*)(Z + ro + voff_))[j]; \
                SET##w[j] = ((const v4u*)(DW + ro + voff_))[j]; SET##a[j] = ((const v4u*)(DA + ro + voff_))[j]; if (l) { SET##d[j] = ((const v4u*)(DV + ro + voff_))[j]; SET##f[j] = ((const v4u*)(VF + ro + voff_))[j]; } } } while (0)
#define CKV_PREP(cc, SET) do { LAS unsigned char* ob = blk + BH_OPB + ((cc) & 1) * CK_OPB; LAS unsigned char* rg = blk + BH_RING + ((cc) % 3) * RG_SZ; \
            float kk_[16], kp_[16], ia_[16], lw_[16]; float n2 = 0.f, bon = 0.f; \
            _Pragma("unroll") for (int j = 0; j < 2; ++j) { float k8[8], a8[8], r8[8], w8[8]; unpack8(SET##k[j], k8); unpack8(SET##a[j], a8); unpack8(SET##r[j], r8); unpack8(SET##w[j], w8); \
                _Pragma("unroll") for (int h = 0; h < 2; ++h) { const f32x4 pkk_ = prm[3 * 16 + 4 * vq_ + 2 * j + h], pka_ = prm[4 * 16 + 4 * vq_ + 2 * j + h], prk_ = prm[5 * 16 + 4 * vq_ + 2 * j + h]; \
                    _Pragma("unroll") for (int e = 0; e < 4; ++e) { const int i = 8 * j + 4 * h + e, e8 = 4 * h + e; const float ia = a8[e8]; ia_[i] = ia; lw_[i] = w8[e8]; \
                        const float kk = k8[e8] * pkk_[e]; kk_[i] = kk; n2 += kk * kk; const float kp = k8[e8] * (1.0f + (ia - 1.0f) * pka_[e]); kp_[i] = kp; bon += r8[e8] * kp * prk_[e]; } } } \
            n2 += dppf<0xB1>(n2); n2 += dppf<0x4E>(n2); bon += dppf<0xB1>(bon); bon += dppf<0x4E>(bon); const float inv = __builtin_amdgcn_rsqf(fmaxf(n2, 1e-24f)); \
              \
            _Pragma("unroll") for (int j = 0; j < 4; ++j) lwp[vt_ * 16 + 4 * vq_ + j] = (f32x4){lw_[4 * j], lw_[4 * j + 1], lw_[4 * j + 2], lw_[4 * j + 3]}; \
            LDS_WAIT(); asm volatile("" ::: "memory"); \
            { float c_[16]; _Pragma("unroll") for (int t = 0; t < 16; ++t) c_[t] = ((const LAS float*)lwp)[t * 64 + lane]; \
              _Pragma("unroll") for (int t = 1; t < 16; ++t) c_[t] += c_[t - 1]; \
              _Pragma("unroll") for (int t = 0; t < 16; ++t) ((LAS float*)lwp)[t * 64 + lane] = c_[t]; } \
            LDS_WAIT(); asm volatile("" ::: "memory"); \
            float lp_[16]; _Pragma("unroll") for (int j = 0; j < 4; ++j) { const f32x4 v = lwp[vt_ * 16 + 4 * vq_ + j]; lp_[4 * j] = v.x; lp_[4 * j + 1] = v.y; lp_[4 * j + 2] = v.z; lp_[4 * j + 3] = v.w; } \
            v4u oa[2], orr[2], ob_[2], ok[2], ov[2]; \
            _Pragma("unroll") for (int j = 0; j < 2; ++j) { float r8[8], v8[8]; unpack8(SET##r[j], r8); unpack8(SET##v[j], v8); \
                if (l) { float d8[8], f8[8]; unpack8(SET##d[j], d8); unpack8(SET##f[j], f8); _Pragma("unroll") for (int h = 0; h < 2; ++h) { \
                        _Pragma("unroll") for (int e = 0; e < 4; ++e) { const int e8 = 4 * h + e; v8[e8] = v8[e8] + (f8[e8] - v8[e8]) * d8[e8]; } } } \
                _Pragma("unroll") for (int e = 0; e < 8; e += 2) { const int i = 8 * j + e; \
                    const float P0 = __builtin_amdgcn_exp2f(lp_[i]), P1 = __builtin_amdgcn_exp2f(lp_[i + 1]), R0 = __builtin_amdgcn_exp2f(-lp_[i]), R1 = __builtin_amdgcn_exp2f(-lp_[i + 1]); \
                    const float M0 = __builtin_amdgcn_exp2f(lp_[i] - lw_[i]), M1 = __builtin_amdgcn_exp2f(lp_[i + 1] - lw_[i + 1]), q0 = kk_[i] * inv, q1 = kk_[i + 1] * inv; \
                    oa[j][e >> 1] = (unsigned)tobf(-q0 * M0) | ((unsigned)tobf(-q1 * M1) << 16); orr[j][e >> 1] = (unsigned)tobf(r8[e] * P0) | ((unsigned)tobf(r8[e + 1] * P1) << 16); \
                    ob_[j][e >> 1] = (unsigned)tobf(q0 * ia_[i] * R0) | ((unsigned)tobf(q1 * ia_[i + 1] * R1) << 16); ok[j][e >> 1] = (unsigned)tobf(kp_[i] * R0) | ((unsigned)tobf(kp_[i + 1] * R1) << 16); \
                    ov[j][e >> 1] = (unsigned)tobf(v8[e]) | ((unsigned)tobf(v8[e + 1]) << 16); \
                    if (vt_ == 15) { ((LAS float*)(ob + CK_PC))[16 * vq_ + i] = P0; ((LAS float*)(ob + CK_PC))[16 * vq_ + i + 1] = P1; } } } \
            _Pragma("unroll") for (int j = 0; j < 2; ++j) { const int o = vt_ * CK_TP + 32 * vq_ + 16 * j; *(LAS v4u*)(ob + CK_AT + o) = oa[j]; *(LAS v4u*)(ob + CK_RT + o) = orr[j]; *(LAS v4u*)(ob + CK_BH + o) = ob_[j]; *(LAS v4u*)(ob + CK_KH + o) = ok[j]; \
                *(LAS v4u*)(rg + RG_VP + vt_ * 128 + 32 * vq_ + 16 * j) = ov[j]; *(LAS v4u*)(rg + RG_Z + vt_ * 128 + 32 * vq_ + 16 * j) = SET##z[j]; } \
            if (vq_ == 0) ((LAS float*)(rg + RG_BON))[vt_] = bon; } while (0)
#define CK_POST(cc) do { const LAS unsigned char* rg = blk + BH_RING + ((cc) % 3) * RG_SZ; const LAS float* yb = (const LAS float*)(blk + BH_Y + ((cc) & 1) * 4096) + pt_ * 64 + 16 * pq_; \
            float y_[16], vp_[16], z_[16]; \
            _Pragma("unroll") for (int j = 0; j < 4; ++j) { const f32x4 v = ((const LAS f32x4*)yb)[j]; y_[4 * j] = v.x; y_[4 * j + 1] = v.y; y_[4 * j + 2] = v.z; y_[4 * j + 3] = v.w; } \
            _Pragma("unroll") for (int j = 0; j < 2; ++j) { float t8[8]; unpack8(((const LAS v4u*)(rg + RG_VP + pt_ * 128 + 32 * pq_))[j], t8); _Pragma("unroll") for (int e = 0; e < 8; ++e) vp_[8 * j + e] = t8[e]; \
                unpack8(((const LAS v4u*)(rg + RG_Z + pt_ * 128 + 32 * pq_))[j], t8); _Pragma("unroll") for (int e = 0; e < 8; ++e) z_[8 * j + e] = t8[e]; } \
            const float bon = ((const LAS float*)(rg + RG_BON))[pt_]; float sm = 0.f; \
            _Pragma("unroll") for (int j = 0; j < 16; ++j) sm += y_[j]; \
            sm += dppf<0xB1>(sm); sm += dppf<0x4E>(sm); const float mu = sm * (1.0f / 64.0f); float sq = 0.f; \
            _Pragma("unroll") for (int j = 0; j < 16; ++j) { y_[j] -= mu; sq += y_[j] * y_[j]; } \
            sq += dppf<0xB1>(sq); sq += dppf<0x4E>(sq); const float rstd = __builtin_amdgcn_rsqf(sq * (1.0f / 64.0f) + GN_EPS); \
            v4u o_[2]; \
            _Pragma("unroll") for (int j = 0; j < 16; j += 2) { const float g0 = (y_[j] * rstd * lw_[j] + lb_[j] + bon * vp_[j]) * (z_[j] * fsig(z_[j])), g1 = (y_[j + 1] * rstd * lw_[j + 1] + lb_[j + 1] + bon * vp_[j + 1]) * (z_[j + 1] * fsig(z_[j + 1])); \
                o_[j >> 3][(j >> 1) & 3] = (unsigned)tobf(g0) | ((unsigned)tobf(g1) << 16); } \
            v4u* gp = (v4u*)(G + (rowb + (size_t)(cc) * 16 + pt_) * 2048 + hh * 64 + 16 * pq_); gp[0] = o_[0]; gp[1] = o_[1]; } while (0)
        typedef unsigned short us2 __attribute__((ext_vector_type(2)));
        if (role == 0) { f32x4 ST[4][4];
#pragma unroll
            for (int i = 0; i < 4; ++i)
#pragma unroll
                for (int j = 0; j < 4; ++j) ST[i][j] = (f32x4){0.f, 0.f, 0.f, 0.f};
            CK_BAR();
            for (int c = 0; c < NCH; ++c) { ck_scan_chunk(ST, blk + BH_OPB + (c & 1) * CK_OPB, blk + BH_RING + (c % 3) * RG_SZ + RG_VP, (LAS float*)(blk + BH_Y + (c & 1) * 4096), c16, g); CK_BAR(); }
            float* so = F.out + O_WKVP + ((size_t)(l * BATCH + b) * A_HEADS + hh) * 4096;
#pragma unroll
            for (int ki = 0; ki < 4; ++ki)
#pragma unroll
                for (int vi = 0; vi < 4; ++vi) *(f32x4*)(so + (16 * vi + c16) * 64 + 16 * ki + 4 * g) = ST[ki][vi]; }
        else if (role == 1) { const int ln1 = lane_id(), vt_ = ln1 >> 2, vq_ = ln1 & 3; const unsigned voff_ = (unsigned)(vt_ * 2048 + hh * 64 + 16 * vq_); LAS f32x4* lwp = (LAS f32x4*)(blk + BH_LW); const LAS f32x4* prm = (const LAS f32x4*)(blk + BH_PRM);
            { const int ln = lane_id(), c1 = hh * 64 + ln; LAS float* pf = (LAS float*)(blk + BH_PRM); pf[ln] = pw0[c1]; pf[64 + ln] = pa0[c1]; pf[128 + ln] = l ? pv0[c1] : 0.f; pf[192 + ln] = pkk[c1]; pf[256 + ln] = pka[c1]; pf[320 + ln] = prk[c1]; LDS_WAIT(); asm volatile("" ::: "memory"); }
            v4u Ar[2], Ak[2], Av[2], Az[2], Aw[2], Aa[2], Ad[2], Af[2];
#pragma unroll
            for (int j = 0; j < 2; ++j) { Ad[j] = (v4u){0u, 0u, 0u, 0u}; Af[j] = Ad[j]; }
            CKV_LOAD(0, A); CKV_PREP(0, A); CKV_LOAD(1, A); CK_BAR();
            for (int c = 0; c < NCH; ++c) { if (c + 1 < NCH) { CKV_PREP(c + 1, A); if (c + 2 < NCH) CKV_LOAD(c + 2, A); } CK_BAR(); } }
        else if (role == 3) {
            const int ln3 = lane_id(), vt_ = ln3 >> 2, vq_ = ln3 & 3; const unsigned voff_ = (unsigned)(vt_ * 2048 + hh * 64 + 16 * vq_);
            v4u Ar[2], Ak[2], Av[2], Az[2], Aw[2], Aa[2], Ad[2], Af[2];
#pragma unroll
            for (int j = 0; j < 2; ++j) { Ad[j] = (v4u){0u, 0u, 0u, 0u}; Af[j] = Ad[j]; }
            CKV_LOAD(2, A); CK_BAR();
            for (int c = 0; c < NCH; ++c) {
#pragma unroll
                for (int j = 0; j < 2; ++j) asm volatile("" :: "v"(Ar[j]), "v"(Ak[j]), "v"(Av[j]), "v"(Az[j]), "v"(Aw[j]), "v"(Aa[j]), "v"(Ad[j]), "v"(Af[j]));
                if (c + 3 < NCH) CKV_LOAD(c + 3, A);
                CK_BAR(); } }
        else { const int ln2 = lane_id(), pt_ = ln2 >> 2, pq_ = ln2 & 3; float lw_[16], lb_[16];
#pragma unroll
            for (int j = 0; j < 16; ++j) { lw_[j] = plw[hh * 64 + 16 * pq_ + j]; lb_[j] = plb[hh * 64 + 16 * pq_ + j]; }
            CK_BAR();
            for (int c = 0; c < NCH; ++c) { if (c >= 1) CK_POST(c - 1); CK_BAR(); }
            CK_POST(NCH - 1); }
        __syncthreads();
#undef CK_PREP
#undef CKV_LOAD
#undef CKV_PREP
#undef CK_BAR
#undef CK_POST
    }
    const float* stt = (const float*)a->in[2] + (size_t)l * DEC_BATCH * A_HEADS * 4096;
    LAS float* sop = (LAS float*)(F.lds + F.wave * 2048);
    for (int it = F.gw; it < DEC_BATCH * A_HEADS; it += F.NGW) { const int b = it >> 5, hh = it & 31, ch = hh * 64 + lane; const size_t o = (size_t)(MP + b) * 2048 + ch;
        HeadPrm P; P.w0 = pw0[ch]; P.a0 = pa0[ch]; P.v0 = l ? pv0[ch] : 0.f; P.kk = pkk[ch]; P.ka = pka[ch]; P.rk = prk[ch]; P.lnw = plw[ch]; P.lnb = plb[ch];
        const float z = ldbf(Z + o); float bon;
        fs_prep_one(P, l, ldbf(R + o), ldbf(K + o), ldbf(V + o), ldbf(DW + o), ldbf(DA + o), l ? ldbf(DV + o) : 0.f, l ? ldbf(VF + o) : 0.f, sop, lane, bon);
        LDS_WAIT(); asm volatile("" ::: "memory");
        f32x2 S[32]; const float* si = stt + (size_t)it * 4096 + lane * 64;
#pragma unroll
        for (int k = 0; k < 32; k += 2) { const f32x4 v = *(const f32x4*)(si + 2 * k); S[k] = (f32x2){v.x, v.y}; S[k + 1] = (f32x2){v.z, v.w}; }
        const float y = wkv_step_lds(S, sop, lane), vp = sop[320 + lane];
        float* so = F.out + O_WKVS + ((size_t)l * DEC_BATCH * A_HEADS + it) * 4096 + lane * 64;
#pragma unroll
        for (int k = 0; k < 32; k += 2) *(f32x4*)(so + 2 * k) = (f32x4){S[k].x, S[k].y, S[k + 1].x, S[k + 1].y};
        G[o] = (bf16)f2bf(fs_post_one(P, y, vp, z, bon));
        LDS_WAIT(); asm volatile("" ::: "memory");
    }
#undef FS_PREP
#undef FS_POST
}

__device__ __forceinline__ void final_norm(Frame& F, cargs a) {
    const float* X = (const float*)(F.ws + WS_X); f32x4 w4[4]; load_row((const float*)a->in[35], LANE, w4);
    for (int m = F.gw; m < MP + DEC_BATCH; m += F.NGW) { f32x4 x[4]; load_row(X + (size_t)m * 1024, LANE, x); const float rs = row_rs(x);
        float* o = m < MP ? F.out + O_YP + (size_t)m * 1024 : F.out + O_YS + (size_t)(m - MP) * 1024;
#pragma unroll
        for (int j = 0; j < 4; ++j) ((f32x4*)o)[LANE + 64 * j] = x[j] * rs * w4[j]; }
}
#ifndef MK_DYNATT
#define MK_DYNATT 0
#endif
__device__ __forceinline__ void b0c_kvpost(Frame& F, cargs a) {
    unsigned char* ws = F.ws; const float* KVR = (const float*)(ws + WS_KVR); bf16* CK = (bf16*)(ws + WS_CKVB); bf16* KP = (bf16*)(ws + WS_KPEB); const float* ROPE = (const float*)(ws + WS_ROPE);
    const f32x4 w4 = ((const f32x4*)a->in[27])[F.lane];
    for (int m = F.gw; m < MP + DEC_BATCH; m += F.NGW) { const float* row = KVR + (size_t)m * 320;
        const f32x4 v = ((const f32x4*)row)[F.lane]; const float ss = wave_sum((v.x * v.x + v.y * v.y) + (v.z * v.z + v.w * v.w));
        const float rs = 1.0f / sqrtf(ss * (1.0f / 256.0f) + NORM_EPS); const f32x4 c = v * rs * w4;
        float* oc = m < MP ? F.out + O_CKVP + (size_t)m * 256 : F.out + O_CKVS + (size_t)(m - MP) * 256; float* ok = m < MP ? F.out + O_KPEP + (size_t)m * 64 : F.out + O_KPES + (size_t)(m - MP) * 64;
        ((f32x4*)oc)[F.lane] = c; v2u pw; pw.x = pk2(c.x, c.y); pw.y = pk2(c.z, c.w); *(v2u*)(CK + (size_t)m * 256 + 4 * F.lane) = pw;
        if (F.lane < 32) { const int i = F.lane, p = m < MP ? (m & (SEQ - 1)) : SEQ; const float x1 = row[256 + i], x2 = row[288 + i], cs = ROPE[(p * 32 + i) * 2], sn = ROPE[(p * 32 + i) * 2 + 1];
            const float o1 = x1 * cs - x2 * sn, o2 = x2 * cs + x1 * sn; ok[i] = o1; ok[32 + i] = o2; *(unsigned*)(KP + (size_t)m * 64 + 2 * i) = pk2(o1, o2); }
    }
}
__device__ __forceinline__ void b1c_cq(Frame& F, cargs a, int l) {
    unsigned char* ws = F.ws; const float* QL = (const float*)(ws + WS_QL); bf16* CQ = (bf16*)(ws + WS_CQ); const float* w = (const float*)a->in[32] + l * 384;
    f32x2 w2[3];
#pragma unroll
    for (int j = 0; j < 3; ++j) w2[j] = *(const f32x2*)(w + 2 * F.lane + 128 * j);
    for (int m = F.gw; m < MT; m += F.NGW) { f32x2 v[3]; float ss = 0.f;
#pragma unroll
        for (int j = 0; j < 3; ++j) { v[j] = *(const f32x2*)(QL + (size_t)m * 384 + 2 * F.lane + 128 * j); ss += v[j].x * v[j].x + v[j].y * v[j].y; }
        const float rs = 1.0f / sqrtf(wave_sum(ss) * (1.0f / 384.0f) + NORM_EPS);
#pragma unroll
        for (int j = 0; j < 3; ++j) *(unsigned*)(CQ + (size_t)m * 384 + 2 * F.lane + 128 * j) = pk2(v[j].x * rs * w2[j].x, v[j].y * rs * w2[j].y); }
}
constexpr int AT_KP = 400, AT_VP = 136, AT_KBYTES = 64 * AT_KP, AT_VBYTES = 128 * AT_VP, AT_BUF = AT_KBYTES + AT_VBYTES;
__device__ __forceinline__ int crow(int r, int hi) { return (r & 3) + 8 * (r >> 2) + 4 * hi; }
typedef __bf16 bf16x8_nat __attribute__((ext_vector_type(8)));
typedef float f32x8 __attribute__((ext_vector_type(8)));
__device__ __forceinline__ bf16x8 pack8f(float a0, float a1, float a2, float a3, float a4, float a5, float a6, float a7) {
    return __builtin_bit_cast(bf16x8, __builtin_convertvector((f32x8){a0, a1, a2, a3, a4, a5, a6, a7}, bf16x8_nat)); }
__device__ __forceinline__ void attn_unit(Frame& F, int b, int hd, int qb) {
    unsigned char* ws = F.ws; const bf16* Q = (const bf16*)(ws + WS_Q);
    const bf16* Z = (const bf16*)(ws + WS_Z); bf16* G = (bf16*)(ws + WS_G);
    LAS unsigned char* Ks = F.lds; LAS unsigned char* Vs = F.lds + AT_KBYTES;
    const int lane = lane_id(), r32 = lane & 31, hi = lane >> 5, tid = F.wave * 64 + lane;
    const int qpos = qb * 256 + F.wave * 32 + r32; const size_t qrow = (size_t)b * SEQ + qpos;
    bf16x8 qf[12];
#pragma unroll
    for (int s = 0; s < 12; ++s) qf[s] = *(const bf16x8*)(Q + qrow * 3072 + hd * 192 + 16 * s + 8 * hi);
    f32x16 o[4];
#pragma unroll
    for (int d = 0; d < 4; ++d)
#pragma unroll
        for (int r = 0; r < 16; ++r) o[d][r] = 0.f;
    float mrow = -1e30f, lrow = 0.f;
    const int ntiles = 4 * qb + 4, wq0 = qb * 256 + F.wave * 32;
    const unsigned gK = (unsigned)((tid >> 4) * 4096 + (tid & 15) * 16), gP = (unsigned)((tid >> 3) * 128 + (tid & 7) * 16), gV = (unsigned)((tid >> 3) * (MP * 2) + (tid & 7) * 16);
    LAS unsigned char* lK = Ks + (tid >> 4) * AT_KP + (tid & 15) * 16; LAS unsigned char* lP = Ks + (tid >> 3) * AT_KP + 256 + (tid & 7) * 16; LAS unsigned char* lV = Vs + (tid >> 3) * AT_VP + (tid & 7) * 16;
    const unsigned char* kb0 = ws + WS_KN + ((size_t)b * SEQ * 2048 + hd * 128) * 2; const unsigned char* pb0 = ws + WS_KPEB + (size_t)b * SEQ * 128; const unsigned char* vb0 = ws + WS_VT + ((size_t)hd * 128 * MP + (size_t)b * SEQ) * 2;
    v4u pk_[3], pv_[2];
#define AT_FETCH(kt_) do { const unsigned char* kb = kb0 + (size_t)(kt_) * (64 * 4096); const unsigned char* pb = pb0 + (size_t)(kt_) * (64 * 128); const unsigned char* vb = vb0 + (size_t)(kt_) * 128; \
        pk_[0] = *(const v4u*)(kb + gK); pk_[1] = *(const v4u*)(kb + 32 * 4096 + gK); pk_[2] = *(const v4u*)(pb + gP); pv_[0] = *(const v4u*)(vb + gV); pv_[1] = *(const v4u*)(vb + (size_t)64 * MP * 2 + gV); } while (0)
    AT_FETCH(0);
    const LAS unsigned char* kA = Ks + r32 * AT_KP + hi * 16;
    const LAS unsigned char* vA = Vs + r32 * AT_VP + hi * 8;
#define AT_KF(st_) (*(const LAS bf16x8*)(kA + ((st_) & 1) * (32 * AT_KP) + ((st_) >> 1) * 32))
#define AT_VF(st_, j_) (*(const LAS v2u*)(vA + ((st_) & 3) * (32 * AT_VP) + ((st_) >> 2) * 32 + 16 * (j_)))
    constexpr int KD = 6, VD = 4;
    for (int kt = 0; kt < ntiles; ++kt) {
        __syncthreads();
        *(LAS v4u*)lK = pk_[0]; *(LAS v4u*)(lK + 32 * AT_KP) = pk_[1]; *(LAS v4u*)lP = pk_[2];
#pragma unroll
        for (int i = 0; i < 2; ++i) { *(LAS v2u*)(lV + i * 64 * AT_VP) = (v2u){pv_[i].x, pv_[i].y}; *(LAS v2u*)(lV + i * 64 * AT_VP + 8) = (v2u){pv_[i].z, pv_[i].w}; }
        __syncthreads();
        if (kt + 1 < ntiles) AT_FETCH(kt + 1);
        if (kt * 64 > wq0 + 31) continue;
        f32x16 s0, s1;
#pragma unroll
        for (int r = 0; r < 16; ++r) { s0[r] = 0.f; s1[r] = 0.f; }
        bf16x8 kf[8];
#pragma unroll
        for (int st = 0; st < KD; ++st) kf[st] = AT_KF(st);
#pragma unroll
        for (int st = 0; st < 24; ++st) {
            if (st + KD < 24) kf[(st + KD) & 7] = AT_KF(st + KD);
            if (st & 1) s1 = __builtin_amdgcn_mfma_f32_32x32x16_bf16(kf[st & 7], qf[st >> 1], s1, 0, 0, 0);
            else s0 = __builtin_amdgcn_mfma_f32_32x32x16_bf16(kf[st & 7], qf[st >> 1], s0, 0, 0, 0);
            __builtin_amdgcn_sched_barrier(0);
        }
        v2u vf[8][2];
#pragma unroll
        for (int st = 0; st < VD; ++st) { vf[st][0] = AT_VF(st, 0); vf[st][1] = AT_VF(st, 1); }
        __builtin_amdgcn_sched_barrier(0);
        if (kt * 64 + 63 > wq0) {
#pragma unroll
            for (int r = 0; r < 16; ++r) { const int key = kt * 64 + crow(r, hi); if (key > qpos) s0[r] = -__builtin_inff(); if (key + 32 > qpos) s1[r] = -__builtin_inff(); } }
        float tmax = s0[0];
#pragma unroll
        for (int r = 1; r < 16; ++r) tmax = fmaxf(tmax, s0[r]);
#pragma unroll
        for (int r = 0; r < 16; ++r) tmax = fmaxf(tmax, s1[r]);
        tmax = xor32_max(tmax);
        if (__builtin_amdgcn_ballot_w64(tmax > mrow + 8.0f) != 0ull) { const float mnew = fmaxf(mrow, tmax), alpha = __builtin_amdgcn_exp2f(mrow - mnew); mrow = mnew; lrow *= alpha;
#pragma unroll
            for (int d = 0; d < 4; ++d)
#pragma unroll
                for (int r = 0; r < 16; ++r) o[d][r] *= alpha; }
        float ps = 0.f;
#pragma unroll
        for (int r = 0; r < 16; ++r) { s0[r] = __builtin_amdgcn_exp2f(s0[r] - mrow); s1[r] = __builtin_amdgcn_exp2f(s1[r] - mrow); ps += s0[r] + s1[r]; }
        lrow += ps;
        bf16x8 pb[4];
        pb[0] = pack8f(s0[0], s0[1], s0[2], s0[3], s0[4], s0[5], s0[6], s0[7]); pb[1] = pack8f(s0[8], s0[9], s0[10], s0[11], s0[12], s0[13], s0[14], s0[15]);
        pb[2] = pack8f(s1[0], s1[1], s1[2], s1[3], s1[4], s1[5], s1[6], s1[7]); pb[3] = pack8f(s1[8], s1[9], s1[10], s1[11], s1[12], s1[13], s1[14], s1[15]);
        __builtin_amdgcn_sched_barrier(0);
#pragma unroll
        for (int st = 0; st < 16; ++st) {
            if (st + VD < 16) { vf[(st + VD) & 7][0] = AT_VF(st + VD, 0); vf[(st + VD) & 7][1] = AT_VF(st + VD, 1); }
            const v4u av = (v4u){vf[st & 7][0].x, vf[st & 7][0].y, vf[st & 7][1].x, vf[st & 7][1].y};
            o[st & 3] = __builtin_amdgcn_mfma_f32_32x32x16_bf16(__builtin_bit_cast(bf16x8, av), pb[st >> 2], o[st & 3], 0, 0, 0);
            __builtin_amdgcn_sched_barrier(0);
        }
    }
#undef AT_FETCH
#undef AT_KF
#undef AT_VF
    lrow = xor32_sum(lrow); const float inv = 1.0f / lrow;
    v2u zq[4][4];
#pragma unroll
    for (int d = 0; d < 4; ++d)
#pragma unroll
        for (int rg = 0; rg < 4; ++rg) zq[d][rg] = *(const v2u*)(Z + qrow * 2048 + hd * 128 + 32 * d + 8 * rg + 4 * hi);
    __builtin_amdgcn_sched_barrier(0);
#pragma unroll
    for (int d = 0; d < 4; ++d)
#pragma unroll
        for (int rg = 0; rg < 4; ++rg) { const int dd = 32 * d + 8 * rg + 4 * hi; const size_t off = qrow * 2048 + hd * 128 + dd;
            const v2u zz = zq[d][rg]; const float z0 = bflo(zz.x), z1 = bfhi(zz.x), z2 = bflo(zz.y), z3 = bfhi(zz.y);
            v2u w; w.x = pk2(o[d][4 * rg] * inv * (z0 * sigmoidf_(z0)), o[d][4 * rg + 1] * inv * (z1 * sigmoidf_(z1))); w.y = pk2(o[d][4 * rg + 2] * inv * (z2 * sigmoidf_(z2)), o[d][4 * rg + 3] * inv * (z3 * sigmoidf_(z3)));
            *(v2u*)(G + off) = w; }
}
#if !MK_DYNATT
__device__ __forceinline__ void b2a_attn_prompt(Frame& F) {
    if (F.wave < 4) __builtin_amdgcn_s_setprio(1);
    const int vcu = (F.G % 8 == 0) ? (F.bid % 8) * (F.G / 8) + F.bid / 8 : F.bid;
    for (int u = vcu; u < BATCH * B_HEADS * 4; u += F.G) { const int bh = u >> 2, qp = u & 3;
        for (int hf = 0; hf < 2; ++hf) attn_unit(F, bh >> 4, bh & 15, hf ? qp : 7 - qp); }
    __builtin_amdgcn_s_setprio(0);
    __syncthreads();
}
#endif

constexpr int DT_P = 656;
typedef __bf16 bf16x2_nat __attribute__((ext_vector_type(2)));
__device__ __forceinline__ unsigned cvtpk2(float lo, float hi) { return __builtin_bit_cast(unsigned, __builtin_convertvector((f32x2){lo, hi}, bf16x2_nat)); }
typedef short v4i16_t __attribute__((ext_vector_type(4)));
__device__ __forceinline__ void b2b_unit(Frame& F, cargs a, const int hu) {
    unsigned char* ws = F.ws; const float* cckv = (const float*)a->in[4]; const float* ckpe = (const float*)a->in[5]; const int* ptab = (const int*)a->in[6];
    const bf16* QA = (const bf16*)(ws + WS_QABS); float* OP = (float*)(ws + WS_OPART); float* ML = (float*)(ws + WS_ML);
    LAS unsigned char* T = F.lds;
    F.lane = lane_id();
    const int lane = F.lane, hcol = lane & 15, g = lane >> 4, tid = F.wave * 64 + lane, q4 = (lane & 15) >> 2, p4 = lane & 3;
    const bf16* Q = (const bf16*)(ws + WS_Q); const float* wuk = (const float*)a->in[28]; bf16* QAg = (bf16*)(ws + WS_QABS);
    LAS bf16* QAl = (LAS bf16*)(F.lds + 49152);
    { const int b = hu >> 1;
      {
        __syncthreads();
        for (int hh = 0; hh < 2; ++hh) { const int hd = 2 * F.wave + hh; const bf16* qn = Q + (size_t)(MP + b) * 3072 + hd * 192;
            float acc[4] = {0.f, 0.f, 0.f, 0.f};
            for (int n = 0; n < 128; n += 4) { const v2u qu = *(const v2u*)(qn + n); const f32x4 q4 = (f32x4){bflo(qu.x), bfhi(qu.x), bflo(qu.y), bfhi(qu.y)};
#pragma unroll
                for (int cc = 0; cc < 4; ++cc) { const f32x4 w4 = *(const f32x4*)(wuk + (size_t)(4 * lane + cc) * 2048 + hd * 128 + n); acc[cc] += (q4.x * w4.x + q4.y * w4.y) + (q4.z * w4.z + q4.w * w4.w); } }
            const v2u w = (v2u){pk2(acc[0], acc[1]), pk2(acc[2], acc[3])}; *(LAS v2u*)(QAl + hd * 320 + 4 * lane) = w;
            const bf16 rp = qn[128 + 2 * (lane & 31) + (lane >> 5)]; QAl[hd * 320 + 256 + lane] = rp;
            if ((hu & 1) == 0) { *(v2u*)(QAg + (size_t)(b * 16 + hd) * 320 + 4 * lane) = w; QAg[(size_t)(b * 16 + hd) * 320 + 256 + lane] = rp; } }
        __syncthreads(); }
        bf16x8 qf[10];
#pragma unroll
        for (int s = 0; s < 10; ++s) qf[s] = *(const LAS bf16x8*)(QAl + hcol * 320 + 32 * s + 8 * g);
        f32x4 o[2]; o[0] = (f32x4){0.f, 0.f, 0.f, 0.f}; o[1] = o[0]; float mrow = -1e30f, lrow = 0.f;
        f32x4 pfA_[10];
#define DT_FETCH(P_, tt_) do { const int pp = ptab[b * NPAGES + (hu & 1) * 32 + ((tt_) >> 1)], tok0 = ((tt_) & 1) * 64; \
            _Pragma("unroll") for (int i = 0; i < 10; ++i) { const int c = tid + 512 * i, key = c / 80, ch = c % 80; const size_t tk = (size_t)pp * PAGE + tok0 + key; \
                P_[i] = ch < 64 ? *(const f32x4*)(cckv + tk * 256 + ch * 4) : *(const f32x4*)(ckpe + tk * 64 + (ch - 64) * 4); } } while (0)
#define DT_BAR() do { asm volatile("s_waitcnt lgkmcnt(0)" ::: "memory"); __builtin_amdgcn_s_barrier(); asm volatile("" ::: "memory"); } while (0)
#define DT_KF(st_) (*(const LAS bf16x8*)(T + (16 * ((st_) & 3) + hcol) * DT_P + (32 * ((st_) >> 2) + 8 * g) * 2))
#define DT_TILE(P_, tt_) do { \
            DT_BAR(); \
            _Pragma("unroll") for (int i = 0; i < 10; ++i) { const int c = tid + 512 * i, key = c / 80, ch = c % 80; *(LAS v2u*)(T + key * DT_P + ch * 8) = (v2u){cvtpk2(P_[i].x, P_[i].y), cvtpk2(P_[i].z, P_[i].w)}; } \
            DT_BAR(); \
            if ((tt_) + 1 < 64) DT_FETCH(P_, (tt_) + 1); \
            f32x4 sc[4]; bf16x8 kf_[8];                                 \
            _Pragma("unroll") for (int kg = 0; kg < 4; ++kg) sc[kg] = (f32x4){0.f, 0.f, 0.f, 0.f}; \
            _Pragma("unroll") for (int st = 0; st < 6; ++st) kf_[st] = DT_KF(st); \
            _Pragma("unroll") for (int st = 0; st < 40; ++st) { if (st + 6 < 40) kf_[(st + 6) & 7] = DT_KF(st + 6); \
                sc[st & 3] = __builtin_amdgcn_mfma_f32_16x16x32_bf16(kf_[st & 7], qf[st >> 2], sc[st & 3], 0, 0, 0); __builtin_amdgcn_sched_barrier(0); } \
            float tmax = sc[0][0]; \
            _Pragma("unroll") for (int kg = 0; kg < 4; ++kg) _Pragma("unroll") for (int r = 0; r < 4; ++r) tmax = fmaxf(tmax, sc[kg][r]); \
            tmax = fmaxf(tmax, swz_xor<16>(tmax)); tmax = xor32_max(tmax); \
            const float mnew = fmaxf(mrow, tmax), alpha = __builtin_amdgcn_exp2f(mrow - mnew); mrow = mnew; \
            float ps = 0.f; \
            _Pragma("unroll") for (int kg = 0; kg < 4; ++kg) _Pragma("unroll") for (int r = 0; r < 4; ++r) { sc[kg][r] = __builtin_amdgcn_exp2f(sc[kg][r] - mnew); ps += sc[kg][r]; } \
            lrow = lrow * alpha + ps; o[0] *= alpha; o[1] *= alpha; \
            _Pragma("unroll") for (int kk = 0; kk < 2; ++kk) { const bf16x8 pbf = pack8f(sc[2 * kk][0], sc[2 * kk][1], sc[2 * kk][2], sc[2 * kk][3], sc[2 * kk + 1][0], sc[2 * kk + 1][1], sc[2 * kk + 1][2], sc[2 * kk + 1][3]); \
                _Pragma("unroll") for (int ci = 0; ci < 2; ++ci) { const int cb = 2 * F.wave + ci; LAS unsigned char* ap = T + (32 * kk + 4 * g + q4) * DT_P + (16 * cb + 4 * p4) * 2; \
                    const s16x4 lo = __builtin_bit_cast(s16x4, __builtin_amdgcn_ds_read_tr16_b64_v4i16((LAS v4i16_t*)ap)), hi2 = __builtin_bit_cast(s16x4, __builtin_amdgcn_ds_read_tr16_b64_v4i16((LAS v4i16_t*)(ap + 16 * DT_P))); \
                    const bf16x8 av = (bf16x8){lo[0], lo[1], lo[2], lo[3], hi2[0], hi2[1], hi2[2], hi2[3]}; \
                    o[ci] = __builtin_amdgcn_mfma_f32_16x16x32_bf16(av, pbf, o[ci], 0, 0, 0); } } \
            if (((tt_) & 15) == 15) {                                   \
                const int sp = (hu & 1) * 4 + ((tt_) >> 4); float lr = lrow + swz_xor<16>(lrow); lr = xor32_sum(lr); \
                const size_t pb_ = (size_t)(b * 8 + sp) * 16 + hcol; \
                _Pragma("unroll") for (int ci = 0; ci < 2; ++ci) *(f32x4*)(OP + pb_ * 256 + 16 * (2 * F.wave + ci) + 4 * g) = o[ci]; \
                if (F.wave == 0 && g == 0) { ML[pb_ * 2] = mrow; ML[pb_ * 2 + 1] = lr; } \
                o[0] = (f32x4){0.f, 0.f, 0.f, 0.f}; o[1] = o[0]; mrow = -1e30f; lrow = 0.f; } } while (0)
        DT_FETCH(pfA_, 0);
        for (int tt = 0; tt < 64; ++tt) DT_TILE(pfA_, tt);
#undef DT_FETCH
#undef DT_TILE
#undef DT_KF
#undef DT_BAR
    }
}
#if !MK_DYNATT
__device__ __forceinline__ void b2b_attn_sample(Frame& F, cargs a) {
    for (int hu = F.bid; hu < DEC_BATCH * 2; hu += F.G) b2b_unit(F, a, hu);
    __syncthreads();
}
#else
__device__ __forceinline__ void b2_attn(Frame& F, cargs a, int l) {
    unsigned* qP = (unsigned*)(F.ws + WS_CTL) + 64 + l * 64; unsigned* qS = qP + 32;
    volatile LAS int* slot = (volatile LAS int*)(F.lds + LDSCTL_OFF + 64);
    const bool prefS = (F.bid & 1) == 0;
    constexpr int NPU = BATCH * B_HEADS * 8, NSU = DEC_BATCH * 2;
    int exP = 0, exS = 0;
    for (;;) {
        __syncthreads();
        if (F.wave == 0 && lane_id() == 0) { int code = -1;
            for (int tr = 0; tr < 2 && code == -1; ++tr) { const bool s_ = (tr == 0) == prefS;
                if (s_) { if (!exS) { const unsigned i = __hip_atomic_fetch_add(qS, 1u, __ATOMIC_RELAXED, __HIP_MEMORY_SCOPE_AGENT); if (i < (unsigned)NSU) code = -2 - (int)i; else exS = 1; } }
                else { if (!exP) { const unsigned i = __hip_atomic_fetch_add(qP, 1u, __ATOMIC_RELAXED, __HIP_MEMORY_SCOPE_AGENT); if (i < (unsigned)NPU) code = (int)i; else exP = 1; } } }
            *slot = code; }
        __syncthreads();
        const int code = __builtin_amdgcn_readfirstlane(*slot);
        if (code == -1) break;
        if (code >= 0) { int bh, qb;
            if (code < 1024) { bh = code >> 2; qb = 7 - (code & 3); } else if (code < 1536) { bh = (code - 1024) >> 1; qb = 3 - (code & 1); } else { bh = (code - 1536) >> 1; qb = 1 - (code & 1); }
            attn_unit(F, bh >> 4, bh & 15, qb); }
        else b2b_unit(F, a, -2 - code);
    }
    __syncthreads();
}
#endif
__device__ __forceinline__ void b2c_combine(Frame& F, cargs a) {
    unsigned char* ws = F.ws; const bf16* QA = (const bf16*)(ws + WS_QABS); const float* OP = (const float*)(ws + WS_OPART); const float* ML = (const float*)(ws + WS_ML);
    const float* wuv = (const float*)a->in[29]; const bf16* Z = (const bf16*)(ws + WS_Z); bf16* G = (bf16*)(ws + WS_G);
    LAS float* scr = (LAS float*)(F.lds + F.wave * 1024);
    for (int it = F.gw; it < DEC_BATCH * B_HEADS; it += F.NGW) { const int b = it >> 4, hd = it & 15; const int lane = F.lane;
        const float* cn = F.out + O_CKVS + (size_t)b * 256; const float* kn = F.out + O_KPES + (size_t)b * 64; const bf16* qa = QA + (size_t)it * 320;
        const f32x4 c4 = *(const f32x4*)(cn + 4 * lane); const v2u qv = *(const v2u*)(qa + 4 * lane);
        float sn = (bflo(qv.x) * c4.x + bfhi(qv.x) * c4.y) + (bflo(qv.y) * c4.z + bfhi(qv.y) * c4.w);
        sn += __builtin_bit_cast(float, (unsigned)qa[256 + lane] << 16) * kn[lane];
        sn = wave_sum(sn);
        float ms[8], ls[8], M = sn; f32x4 op[8];
#pragma unroll
        for (int s = 0; s < 8; ++s) { ms[s] = ML[((size_t)(b * 8 + s) * 16 + hd) * 2]; ls[s] = ML[((size_t)(b * 8 + s) * 16 + hd) * 2 + 1]; op[s] = *(const f32x4*)(OP + ((size_t)(b * 8 + s) * 16 + hd) * 256 + 4 * lane); }
        __builtin_amdgcn_sched_barrier(0);
#pragma unroll
        for (int s = 0; s < 8; ++s) M = fmaxf(M, ms[s]);
        const float en = __builtin_amdgcn_exp2f(sn - M); float L = en; f32x4 acc = c4 * en;
#pragma unroll
        for (int s = 0; s < 8; ++s) { const float e = __builtin_amdgcn_exp2f(ms[s] - M); L += e * ls[s]; acc += op[s] * e; }
        acc *= 1.0f / L;
        *(LAS f32x4*)(scr + 4 * lane) = acc; LDS_WAIT(); asm volatile("" ::: "memory");
        f32x2 ov = (f32x2){0.f, 0.f};
        for (int c0 = 0; c0 < 256; c0 += 32) { f32x2 wv[32];
#pragma unroll
            for (int j = 0; j < 32; ++j) wv[j] = *(const f32x2*)(wuv + (size_t)(c0 + j) * 2048 + hd * 128 + 2 * lane);
            __builtin_amdgcn_sched_barrier(0);
#pragma unroll
            for (int j = 0; j < 32; ++j) ov += wv[j] * scr[c0 + j]; }
        const size_t off = (size_t)(MP + b) * 2048 + hd * 128 + 2 * lane; const unsigned zz = *(const unsigned*)(Z + off); const float z0 = bflo(zz), z1 = bfhi(zz);
        *(unsigned*)(G + off) = pk2(ov.x * (z0 * sigmoidf_(z0)), ov.y * (z1 * sigmoidf_(z1)));
        LDS_WAIT(); asm volatile("" ::: "memory");
    }
}

#ifndef MK_SPLIT
#define MK_SPLIT 0
#endif
#ifndef MK_DIAG
#define MK_DIAG 0
#endif
constexpr int NPHASES = 1 + 4 + 5 + 7 + 6 + 1 + (MK_DIAG ? 1 : 0);
#ifndef MK_TPROBE
#define MK_TPROBE 0
#endif
#ifndef MK_TAMP
#define MK_TAMP 4
#endif
#if MK_TPROBE
#define TP_T0 tp0_ = __builtin_amdgcn_s_memrealtime();
#define TP_T1 if (((MK_TPROBE >> ph) & 1) && !tpskip_) tpacc_ += __builtin_amdgcn_s_memrealtime() - tp0_; tpskip_ = 0;
#else
#define TP_T0
#define TP_T1
#endif
#define PH_BEGIN TP_T0 if (ph >= lo && ph < hi) { cargs ap = (cargs)__builtin_amdgcn_kernarg_segment_ptr(); asm volatile("" : "+s"(ap)); Frame F = make_frame(ap, wave0, (LAS unsigned char*)lds); unsigned char* ws = F.ws; int wgc_ = F.bid; (void)wgc_;
#define PH_END } if (ph >= lo && ph + 1 < hi) xcd_barrier(bar); TP_T1 ++ph;
typedef pg8::StaticOrder SO;
#define WG_ROT(off_) (wgc_ = (F.bid + F.G - (off_)) % F.G)
#define GEMM_B(ACT_, A_, Bt_, M_, N_, K_, O_, ldc_, nvalid_, nstore_) do { pg8::Gemm g_{(const pg8::bf16_t*)(A_), (const pg8::bf16_t*)(Bt_), (M_), (N_), (K_)}; SO S_; S_.init((M_), (N_), F.G, wgc_); \
    pg8::EpiB<ACT_> E_{(pg8::bf16_t*)(O_), (ldc_), (nvalid_), (nstore_)}; pg8::gemm_phase<pg8::EpiB<ACT_>, SO, true, true>(F.lds, g_, S_, E_, F.wave); } while (0)
#define GEMM_F(ACT_, HB_, HBI_, A_, Bt_, M_, N_, K_, O_, base_, bias_, ldc_, nstore_) do { int kk_ = (K_); asm volatile("" : "+s"(kk_)); pg8::Gemm g_{(const pg8::bf16_t*)(A_), (const pg8::bf16_t*)(Bt_), (M_), (N_), kk_}; SO S_; S_.init((M_), (N_), F.G, wgc_); \
    pg8::EpiF<ACT_, HB_, HBI_> E_{(float*)(O_), (const float*)(base_), (const float*)(bias_), (ldc_), (nstore_)}; pg8::gemm_phase<pg8::EpiF<ACT_, HB_, HBI_>, SO, true, true>(F.lds, g_, S_, E_, F.wave); } while (0)

#define OUTPROJ(Wt_, base_) do { \
    { pg8::Gemm g_{(const pg8::bf16_t*)(ws + WS_G), (const pg8::bf16_t*)(Wt_), MT, 1024, 256, 2048}; pg8::SliceOrder S_{MP / 256, 4, 8, F.G, F.bid, 512}; pg8::EpiFA E_{(float*)(ws + WS_X), 1024, MP + DEC_BATCH}; \
      pg8::gemm_phase<pg8::EpiFA, pg8::SliceOrder, true, true>(F.lds, g_, S_, E_, F.wave); } \
    GEMM_F(0, true, false, ws + WS_G, (Wt_), MP, 1024, 2048, ws + WS_X, (base_), nullptr, 1024, 1024); } while (0)
__global__ void __launch_bounds__(NTHR, 2) mk_fwd(Args args) {
    extern __shared__ __attribute__((aligned(16))) unsigned char lds[];
    const int wave0 = __builtin_amdgcn_readfirstlane(threadIdx.x >> 6);
    for (int u = threadIdx.x; u < (LDS_BYTES - LDSCTL_OFF) / 4; u += NTHR) ((LAS unsigned*)(lds + LDSCTL_OFF))[u] = 0u;
    __syncthreads();
    XcdBarrier bar = xcd_barrier_post((unsigned*)(args.ws + WS_CTL) + CW_BAR + args.li * XCD_BAR_WORDS, (volatile LAS unsigned*)((LAS unsigned char*)lds + LDSCTL_OFF), (unsigned)wave0);
    int ph = 0; const int lo = args.ph_lo, hi = args.ph_hi;
#if MK_TPROBE
    unsigned long long tpacc_ = 0, tp0_ = 0; int tpskip_ = 0;
#endif

    PH_BEGIN p0_prologue(F, ap); __syncthreads(); a1_prepass(F, ap, 0); PH_END

    for (int l = 0; l < 2; ++l) {
        if (l > 0) { PH_BEGIN a1_prepass(F, ap, l); PH_END }
        PH_BEGIN
            { static_assert(AM_STRIDE == (size_t)130 * 256 * 1024 * 2, "A-operand buffers sit 130 row panels apart");
              pg8::Gemm g_{(const pg8::bf16_t*)(ws + WS_AM), (const pg8::bf16_t*)(ws + WS_WIN + (size_t)l * WIN_L), MT, 2048, 1024}; pg8::GroupOrderA2 S_; S_.init(MT, F.G, F.bid, l ? 7 : 6);
              static_assert(WS_K == WS_R + BIGB && WS_V0 == WS_R + 2 * BIGB && WS_V1 == WS_R + 3 * BIGB && WS_Z == WS_R + 4 * BIGB && WS_LA == WS_LW + 9 * MiB && WS_LV == WS_LW + 18 * MiB, "output buffers are equally spaced");
              pg8::EpiA2 E_{(pg8::bf16_t*)(ws + WS_R), BIGB / 2, 2 + l, (pg8::bf16_t*)(ws + WS_LW), 9 * MiB / 2};
              pg8::gemm_phase<pg8::EpiA2, pg8::GroupOrderA2, true, true>(F.lds, g_, S_, E_, F.wave); }
        PH_END
        PH_BEGIN
#define GEMM_BA(ACT_, A_, Bt_, O_, bias_) do { int kk_ = 128; asm volatile("" : "+s"(kk_)); pg8::Gemm g_{(const pg8::bf16_t*)(A_), (const pg8::bf16_t*)(Bt_), MT, 2048, kk_}; SO S_; S_.init(MT, 2048, F.G, wgc_); \
    pg8::EpiBA<ACT_> E_{(pg8::bf16_t*)(O_), (const float*)(bias_)}; pg8::gemm_phase<pg8::EpiBA<ACT_>, SO, true, true>(F.lds, g_, S_, E_, F.wave); } while (0)
            GEMM_BA(4, ws + WS_LW, ws + WS_W2 + (size_t)l * (MiB / 2), ws + WS_WD, (const float*)ap->in[10] + l * 2048);
            WG_ROT(8); GEMM_BA(3, ws + WS_LA, ws + WS_W2 + (size_t)(2 + l) * (MiB / 2), ws + WS_IA, (const float*)ap->in[13] + l * 2048);
            WG_ROT(16); if (l) GEMM_BA(3, ws + WS_LV, ws + WS_W2 + (size_t)4 * (MiB / 2), ws + WS_VG, (const float*)ap->in[16]);
#undef GEMM_BA
        PH_END
        PH_BEGIN a5_fused(F, ap, l); PH_END
        PH_BEGIN
            OUTPROJ(ws + WS_WO + (size_t)l * 4 * MiB, l == 0 ? (const void*)ap->in[0] : (const void*)(ws + WS_X));
        PH_END
    }

#define MLA_INPROJ(l_, A_) do { \
        { pg8::Gemm g_{(const pg8::bf16_t*)(A_), (const pg8::bf16_t*)(ws + WS_WQ + (size_t)(l_) * MiB), MT, 512, 1024}; WG_ROT(8); SO S_; S_.init(MT, 512, F.G, wgc_); \
          pg8::EpiCQ E_{(pg8::bf16_t*)(ws + WS_CQ), (const float*)ap->in[32] + (l_) * 384, (float*)(ws + WS_CTL + CW_RSQ + (size_t)(l_) * 262144)}; pg8::gemm_phase<pg8::EpiCQ, SO, true, true>(F.lds, g_, S_, E_, F.wave); } \
        WG_ROT(16); GEMM_B(0, (A_), ws + WS_WZ + (size_t)(l_) * 4 * MiB, MT, 2048, 1024, ws + WS_Z, 2048, 2048, 2048); } while (0)
#define MLA_QUP(l_) do { pg8::Gemm g_{(const pg8::bf16_t*)(ws + WS_CQ), (const pg8::bf16_t*)(ws + WS_WUQ + (size_t)(l_) * (5 * MiB / 2)), MT, 3072, 384}; SO S_; S_.init(MT, 3072, F.G, F.bid); \
        pg8::EpiQ E_{(pg8::bf16_t*)(ws + WS_Q), (const float*)(ws + WS_ROPE), ATTN_SCALE * LOG2E, MP, SEQ, (const float*)(ws + WS_CTL + CW_RSQ + (size_t)(l_) * 262144)}; pg8::gemm_phase<pg8::EpiQ, SO, true, true>(F.lds, g_, S_, E_, F.wave); } while (0)
    for (int l = 0; l < 2; ++l) {
        PH_BEGIN if (l == 0) norm2_rows_bf16(F, (const float*)(ws + WS_X), (const float*)ap->in[25], (bf16*)(ws + WS_AM), (const float*)ap->in[30], (bf16*)(ws + WS_AM + AM_STRIDE));
                 else norm_rows_bf16(F, (const float*)(ws + WS_X), (const float*)ap->in[30] + l * 1024, (bf16*)(ws + WS_AM)); PH_END
        PH_BEGIN if (l == 0) GEMM_F(0, false, false, ws + WS_AM, ws + WS_WDKV, MT, 512, 1024, ws + WS_KVR, nullptr, nullptr, 320, 320);
                 MLA_INPROJ(l, ws + WS_AM + (l == 0 ? AM_STRIDE : 0)); PH_END
        if (l == 0) { PH_BEGIN b0c_kvpost(F, ap); PH_END }
        PH_BEGIN if (l == 0) { GEMM_B(0, ws + WS_CKVB, ws + WS_WUK, MP, 2048, 256, ws + WS_KN, 2048, 2048, 2048);
                               GEMM_B(0, ws + WS_WUV, ws + WS_CKVB, 2048, MP, 256, ws + WS_VT, MP, MP, MP); }
                 MLA_QUP(l); PH_END
#ifndef MK_TSUB
#define MK_TSUB 0
#endif
#if MK_TPROBE && MK_TSUB
        PH_BEGIN b2a_attn_prompt(F);
            if (MK_TSUB == 1) { if ((MK_TPROBE >> ph) & 1) tpacc_ += __builtin_amdgcn_s_memrealtime() - tp0_; tpskip_ = 1; } else if (MK_TSUB == 2) tp0_ = __builtin_amdgcn_s_memrealtime();
            b2b_attn_sample(F, ap);
            if (MK_TSUB == 2) { if ((MK_TPROBE >> ph) & 1) tpacc_ += __builtin_amdgcn_s_memrealtime() - tp0_; tpskip_ = 1; } else if (MK_TSUB == 3) tp0_ = __builtin_amdgcn_s_memrealtime();
        PH_END
#else
#if MK_DYNATT
        PH_BEGIN b2_attn(F, ap, l); PH_END
#else
        PH_BEGIN b2a_attn_prompt(F); b2b_attn_sample(F, ap); PH_END
#endif
#endif
        PH_BEGIN b2c_combine(F, ap); PH_END
        PH_BEGIN OUTPROJ(ws + WS_WBO + (size_t)l * 4 * MiB, ws + WS_X); PH_END
    }
#undef MLA_INPROJ
#undef MLA_QUP

    PH_BEGIN final_norm(F, ap); PH_END
#if MK_TPROBE
    if (blockIdx.x == 0) { const unsigned long long tend_ = __builtin_amdgcn_s_memrealtime() + (unsigned long long)MK_TAMP * tpacc_; while (__builtin_amdgcn_s_memrealtime() < tend_) __builtin_amdgcn_s_sleep(8); }
#endif
#if MK_DIAG
    PH_BEGIN
        const size_t offs[11] = {O_YP, O_YS, O_WKVP, O_SHP, O_CKVP, O_KPEP, O_WKVS, O_SHS, O_CKVS, O_KPES, O_END};
        for (int k = 1; k < 10; ++k) { const float f = 1.0f + sqrtf(2e-4f * (float)k);
            for (size_t i = offs[k] + (size_t)(F.bid * NTHR + F.wave * 64 + F.lane); i < offs[k + 1]; i += (size_t)F.NT) F.out[i] *= f; }
    PH_END
#endif
}

extern "C" void kernel_launch(void* const* d_in, const int* in_sizes, int n_in, void* d_out, int out_size, void* d_ws, size_t ws_size, hipStream_t stream) {
    static int grid = 0;
    if (grid == 0) {
        if (n_in != 36 || (size_t)out_size != O_END || ws_size < WS_NEED) { fprintf(stderr, "kernel_launch: unexpected sizes: n_in %d out %d (want %zu) ws %zu (need %zu)\n", n_in, out_size, (size_t)O_END, ws_size, (size_t)WS_NEED); grid = -1; return; }
        int dev = 0, cus = 0, per_cu = 0;
        if (hipGetDevice(&dev) != hipSuccess || hipDeviceGetAttribute(&cus, hipDeviceAttributeMultiprocessorCount, dev) != hipSuccess) { grid = -1; return; }
        if (hipFuncSetAttribute((const void*)mk_fwd, hipFuncAttributeMaxDynamicSharedMemorySize, LDS_BYTES) != hipSuccess) { fprintf(stderr, "kernel_launch: hipFuncSetAttribute failed\n"); grid = -1; return; }
        if (hipOccupancyMaxActiveBlocksPerMultiprocessor(&per_cu, (const void*)mk_fwd, NTHR, LDS_BYTES) != hipSuccess || per_cu < 1) fprintf(stderr, "kernel_launch: occupancy query reports %d\n", per_cu);
        (void)hipGetLastError();
        grid = cus;
    }
    if (grid < 0) return;
    if (hipMemsetAsync((char*)d_ws + WS_CTL, 0, CTL_ZERO_BYTES, stream) != hipSuccess) { fprintf(stderr, "kernel_launch: memset failed\n"); return; }
    Args a{};
    for (int i = 0; i < 36; ++i) a.in[i] = d_in[i];
    a.out = (float*)d_out; a.ws = (unsigned char*)d_ws;
#if MK_SPLIT
    for (int li = 0; li < NPHASES; ++li) { a.ph_lo = li; a.ph_hi = li + 1; a.li = li;
        hipLaunchKernelGGL(mk_fwd, dim3(grid), dim3(NTHR), LDS_BYTES, stream, a); }
#else
    a.ph_lo = 0; a.ph_hi = NPHASES; a.li = 0;
    hipLaunchKernelGGL(mk_fwd, dim3(grid), dim3(NTHR), LDS_BYTES, stream, a);
#endif
    const hipError_t le = hipPeekAtLastError();
    if (le != hipSuccess) fprintf(stderr, "kernel_launch: launch failed: %s\n", hipGetErrorName(le));
}
```

```cpp
#include <hip/hip_runtime.h>
#include <cstdio>
#include <cstdint>
namespace pg8 {
#define PG8_LAS __attribute__((address_space(3)))
typedef unsigned short bf16_t;
typedef short bf16x8 __attribute__((ext_vector_type(8)));
typedef float f32x4 __attribute__((ext_vector_type(4)));
typedef unsigned u32x4 __attribute__((ext_vector_type(4)));
constexpr int BM = 256, BK = 64, HALF = 128, HTB = HALF * BK * 2  , STAGE_BYTES = 8 * HTB, NXCD = 8, WGM = 8;

__host__ __device__ __forceinline__ int lds_byte(int r, int c) { const int st = (r >> 4) * 2 + (c >> 5), rr = r & 15, cc = c & 31, ob = rr * 64 + cc * 2; return st * 1024 + (ob ^ (((ob >> 9) & 1) << 5)); }
__host__ __device__ __forceinline__ void stage_rc(int b, int& R, int& C) { const int st = b / 1024, sb = b % 1024, swz = sb ^ (((sb >> 9) & 1) << 5); R = (st >> 1) * 16 + swz / 64; C = (st & 1) * 32 + (swz % 64) / 2; }
__host__ __device__ __forceinline__ int perm32(int rho) { const int n = rho >> 4, i = rho & 15; return 8 * (i >> 2) + 4 * n + (i & 3); }

struct Unit { int pm, pn; int ko; };
struct Gemm { const bf16_t* A; const bf16_t* Bt; int M, N, K; int ld; };

struct StaticOrder {
    int nM, nN, nwg, G, c;
    __host__ __device__ void init(int M, int N, int G_, int c_) { nM = M / BM; nN = N / BM; nwg = nM * nN; G = G_; c = c_; }
    __host__ __device__ bool next(int i, Unit& u) const {
        const long L = (long)i * G + c; if (L >= nwg) return false;
        int wgid = (int)L; { const int q = nwg / NXCD, r = nwg % NXCD, xcd = wgid % NXCD, off = wgid / NXCD; wgid = (xcd < r ? xcd * (q + 1) : r * (q + 1) + (xcd - r) * q) + off; }
        const int nig = WGM * nN, gid = wgid / nig, fm = gid * WGM, gsz = (nM - fm) < WGM ? (nM - fm) : WGM;
        u.pm = fm + ((wgid % nig) % gsz); u.pn = (wgid % nig) / gsz; u.ko = 0; return true;
    }
    __device__ __forceinline__ void a_ready(const Unit&) const {}
    __device__ __forceinline__ void done(const Unit&) const {}
};

__device__ __forceinline__ unsigned cvt_pk_bf16(float lo, float hi) { unsigned r; asm volatile("v_cvt_pk_bf16_f32 %0, %1, %2" : "=v"(r) : "v"(lo), "v"(hi)); return r; }
typedef float f32x2 __attribute__((ext_vector_type(2)));
__device__ __forceinline__ float act_apply(int ACT, float x) {
    if (ACT == 1) return 1.0f - 2.0f / (1.0f + __expf(2.0f * x));
    if (ACT == 2) return __expf(-0.6065306597126334f / (1.0f + __expf(-x)));
    if (ACT == 3) return 1.0f / (1.0f + __expf(-x));
    return x;
}
template <int ACT> struct EpiB {
    static constexpr bool PERM = true, AFTER_DRAIN = false;
    bf16_t* O; int ldc; int nvalid; int nstore;
    __device__ __forceinline__ void operator()(const f32x4 (&acc)[2][2][4][2], const Unit& u, int wr, int wc, int, int) const {
        int lane_; asm volatile("v_mbcnt_lo_u32_b32 %0, -1, 0\n\tv_mbcnt_hi_u32_b32 %0, -1, %0" : "=v"(lane_)); const int fr = lane_ & 15, fq = lane_ >> 4;
        const int row0 = u.pm * BM + wr * 64 + fr, col0 = u.pn * BM + wc * 32 + 8 * fq;
#pragma unroll
        for (int ai = 0; ai < 2; ++ai)
#pragma unroll
            for (int m = 0; m < 4; ++m) { bf16_t* rowp = O + (size_t)(row0 + ai * HALF + m * 16) * ldc + col0;
#pragma unroll
                for (int bj = 0; bj < 2; ++bj) { const int c = col0 + bj * HALF; if (c >= nstore) continue;
                    f32x4 v0 = acc[ai][bj][m][0], v1 = acc[ai][bj][m][1];
                    if (ACT != 0) {
#pragma unroll
                        for (int e = 0; e < 4; ++e) { v0[e] = act_apply(ACT, v0[e]); v1[e] = act_apply(ACT, v1[e]); } }
                    u32x4 w; w.x = cvt_pk_bf16(v0[0], v0[1]); w.y = cvt_pk_bf16(v0[2], v0[3]); w.z = cvt_pk_bf16(v1[0], v1[1]); w.w = cvt_pk_bf16(v1[2], v1[3]);
                    if (c >= nvalid) w = (u32x4){0u, 0u, 0u, 0u};
                    *(u32x4*)(rowp + bj * HALF) = w; } }
    }
};
template <int ACT, bool HAS_BASE, bool HAS_BIAS> struct EpiF {
    static constexpr bool PERM = false, AFTER_DRAIN = false;
    float* O; const float* base; const float* bias; int ldc; int nstore;
    __device__ __forceinline__ void operator()(const f32x4 (&acc)[2][2][4][2], const Unit& u, int wr, int wc, int, int) const {
        int lane_; asm volatile("v_mbcnt_lo_u32_b32 %0, -1, 0\n\tv_mbcnt_hi_u32_b32 %0, -1, %0" : "=v"(lane_)); const int fr = lane_ & 15, fq = lane_ >> 4;
        const int row0 = u.pm * BM + wr * 64 + fr, col0 = u.pn * BM + wc * 32 + 4 * fq;
        f32x4 bv[2][2];
#pragma unroll
        for (int bj = 0; bj < 2; ++bj)
#pragma unroll
            for (int n = 0; n < 2; ++n) bv[bj][n] = HAS_BIAS ? *(const f32x4*)(bias + col0 + bj * HALF + n * 16) : (f32x4){0.f, 0.f, 0.f, 0.f};
#pragma unroll
        for (int ai = 0; ai < 2; ++ai) { f32x4 bs[2][2][2];
#pragma unroll
            for (int m = 0; m < 4; ++m) { const size_t off = (size_t)(row0 + ai * HALF + m * 16) * ldc + col0;
                if (HAS_BASE && !(m & 1)) {
#pragma unroll
                    for (int mm = 0; mm < 2; ++mm)
#pragma unroll
                        for (int bj = 0; bj < 2; ++bj)
#pragma unroll
                            for (int n = 0; n < 2; ++n) bs[mm][bj][n] = *(const f32x4*)(base + off + (size_t)mm * 16 * ldc + bj * HALF + n * 16);
                    __builtin_amdgcn_sched_barrier(0); }
#pragma unroll
                for (int bj = 0; bj < 2; ++bj)
#pragma unroll
                    for (int n = 0; n < 2; ++n) { if (!HAS_BASE && col0 + bj * HALF + n * 16 >= nstore) continue;
                        f32x4 v = acc[ai][bj][m][n] + bv[bj][n];
                        if (ACT != 0) {
#pragma unroll
                            for (int e = 0; e < 4; ++e) v[e] = act_apply(ACT, v[e]); }
                        if (HAS_BASE) v += bs[m & 1][bj][n];
                        *(f32x4*)(O + off + bj * HALF + n * 16) = v; }
                if (m & 1) asm volatile("" ::: "memory"); } }
    }
};

struct GroupOrder4 {
    StaticOrder so; int per;
    __device__ void init(int M, int N, int G_, int c_) { so.init(M, N, G_, c_); per = so.nwg; }
    __device__ bool next(int i, Unit& u) const {
        const long L = (long)i * so.G + so.c; if (L >= 4L * per) return false;
        const int gi = (int)(L / per); int wgid = (int)(L - (long)gi * per);
        { const int q = so.nwg / NXCD, r = so.nwg % NXCD, xcd = wgid % NXCD, off = wgid / NXCD; wgid = (xcd < r ? xcd * (q + 1) : r * (q + 1) + (xcd - r) * q) + off; }
        const int nig = WGM * so.nN, gid = wgid / nig, fm = gid * WGM, gsz = (so.nM - fm) < WGM ? (so.nM - fm) : WGM;
        u.pm = fm + ((wgid % nig) % gsz) + 130 * gi; u.pn = (wgid % nig) / gsz + 8 * gi; u.ko = 0; return true;
    }
    __device__ __forceinline__ void a_ready(const Unit&) const {}
    __device__ __forceinline__ void done(const Unit&) const {}
};
struct EpiB4 {
    static constexpr bool PERM = true, AFTER_DRAIN = false;
    bf16_t* O[4];
    __device__ __forceinline__ void operator()(const f32x4 (&acc)[2][2][4][2], const Unit& u, int wr, int wc, int, int) const {
        int lane_; asm volatile("v_mbcnt_lo_u32_b32 %0, -1, 0\n\tv_mbcnt_hi_u32_b32 %0, -1, %0" : "=v"(lane_)); const int fr = lane_ & 15, fq = lane_ >> 4;
        const int gi = u.pn >> 3; bf16_t* Ob = gi == 0 ? O[0] : gi == 1 ? O[1] : gi == 2 ? O[2] : O[3];
        const int row0 = (u.pm - 130 * gi) * BM + wr * 64 + fr, col0 = (u.pn & 7) * BM + wc * 32 + 8 * fq;
#pragma unroll
        for (int ai = 0; ai < 2; ++ai)
#pragma unroll
            for (int m = 0; m < 4; ++m) { bf16_t* rowp = Ob + (size_t)(row0 + ai * HALF + m * 16) * 2048 + col0;
#pragma unroll
                for (int bj = 0; bj < 2; ++bj) { const f32x4 v0 = acc[ai][bj][m][0], v1 = acc[ai][bj][m][1];
                    u32x4 w; w.x = cvt_pk_bf16(v0[0], v0[1]); w.y = cvt_pk_bf16(v0[2], v0[3]); w.z = cvt_pk_bf16(v1[0], v1[1]); w.w = cvt_pk_bf16(v1[2], v1[3]);
                    *(u32x4*)(rowp + bj * HALF) = w; } }
    }
};

struct EpiQ {
    static constexpr bool PERM = true, AFTER_DRAIN = false;
    bf16_t* O; const float* rope; float sc; int mp, seq; const float* rsq;
    __device__ __forceinline__ void operator()(const f32x4 (&acc)[2][2][4][2], const Unit& u, int wr, int wc, int, int) const {
        int lane_; asm volatile("v_mbcnt_lo_u32_b32 %0, -1, 0\n\tv_mbcnt_hi_u32_b32 %0, -1, %0" : "=v"(lane_)); const int fr = lane_ & 15, fq = lane_ >> 4;
        const int row0 = u.pm * BM + wr * 64 + fr, col0 = u.pn * BM + wc * 32 + 8 * fq;
#pragma unroll
        for (int ai = 0; ai < 2; ++ai)
#pragma unroll
            for (int m2 = 0; m2 < 4; m2 += 2) {
                float rq[2]; f32x4 tt0[2][2], tt1[2][2];
#pragma unroll
                for (int mm = 0; mm < 2; ++mm) { const int row = row0 + ai * HALF + (m2 + mm) * 16; const int p = row < mp ? (row & (seq - 1)) : seq; rq[mm] = rsq[row];
#pragma unroll
                    for (int bj = 0; bj < 2; ++bj) { const int within = (col0 + bj * HALF) % 192, wi = within >= 128 ? ((within - 128) >> 1) : 0; const float* t = rope + (size_t)(p * 32 + wi) * 2;
                        tt0[mm][bj] = *(const f32x4*)t; tt1[mm][bj] = *(const f32x4*)(t + 4); } }
                __builtin_amdgcn_sched_barrier(0);
#pragma unroll
                for (int mm = 0; mm < 2; ++mm) { const int m = m2 + mm, row = row0 + ai * HALF + m * 16; bf16_t* rowp = O + (size_t)row * 3072 + col0; const float rsc = sc / sqrtf(rq[mm] * (1.0f / 384.0f) + 1e-6f);
#pragma unroll
                    for (int bj = 0; bj < 2; ++bj) { const int c = col0 + bj * HALF, within = c % 192; f32x4 v0 = acc[ai][bj][m][0], v1 = acc[ai][bj][m][1];
                        if (within >= 128) { const f32x4 t0 = tt0[mm][bj], t1 = tt1[mm][bj];
                            const f32x4 a0 = v0, a1 = v1;
                            v0[0] = a0[0] * t0[0] - a0[1] * t0[1]; v0[1] = a0[1] * t0[0] + a0[0] * t0[1]; v0[2] = a0[2] * t0[2] - a0[3] * t0[3]; v0[3] = a0[3] * t0[2] + a0[2] * t0[3];
                            v1[0] = a1[0] * t1[0] - a1[1] * t1[1]; v1[1] = a1[1] * t1[0] + a1[0] * t1[1]; v1[2] = a1[2] * t1[2] - a1[3] * t1[3]; v1[3] = a1[3] * t1[2] + a1[2] * t1[3]; }
                        v0 = v0 * rsc; v1 = v1 * rsc;
                        u32x4 w; w.x = cvt_pk_bf16(v0[0], v0[1]); w.y = cvt_pk_bf16(v0[2], v0[3]); w.z = cvt_pk_bf16(v1[0], v1[1]); w.w = cvt_pk_bf16(v1[2], v1[3]);
                        *(u32x4*)(rowp + bj * HALF) = w; } } }
    }
};

struct EpiCQ {
    static constexpr bool PERM = true, AFTER_DRAIN = false;
    bf16_t* O; const float* wq; float* rsq;
    __device__ __forceinline__ void operator()(const f32x4 (&acc)[2][2][4][2], const Unit& u, int wr, int wc, int, int) const {
        int lane_; asm volatile("v_mbcnt_lo_u32_b32 %0, -1, 0\n\tv_mbcnt_hi_u32_b32 %0, -1, %0" : "=v"(lane_)); const int fr = lane_ & 15, fq = lane_ >> 4;
        const int row0 = u.pm * BM + wr * 64 + fr, col0 = u.pn * BM + wc * 32 + 8 * fq;
#pragma unroll
        for (int ai = 0; ai < 2; ++ai)
#pragma unroll
            for (int m = 0; m < 4; ++m) { const int row = row0 + ai * HALF + m * 16; float ss = 0.f;
#pragma unroll
                for (int bj = 0; bj < 2; ++bj) { const int c = col0 + bj * HALF; if (c >= 384) continue;
                    const f32x4 v0 = acc[ai][bj][m][0], v1 = acc[ai][bj][m][1], w0 = *(const f32x4*)(wq + c), w1 = *(const f32x4*)(wq + c + 4);
                    ss += ((v0[0] * v0[0] + v0[1] * v0[1]) + (v0[2] * v0[2] + v0[3] * v0[3])) + ((v1[0] * v1[0] + v1[1] * v1[1]) + (v1[2] * v1[2] + v1[3] * v1[3]));
                    u32x4 w; w.x = cvt_pk_bf16(v0[0] * w0[0], v0[1] * w0[1]); w.y = cvt_pk_bf16(v0[2] * w0[2], v0[3] * w0[3]); w.z = cvt_pk_bf16(v1[0] * w1[0], v1[1] * w1[1]); w.w = cvt_pk_bf16(v1[2] * w1[2], v1[3] * w1[3]);
                    *(u32x4*)(O + (size_t)row * 384 + c) = w; }
                ss += __builtin_bit_cast(float, __builtin_amdgcn_ds_swizzle(__builtin_bit_cast(int, ss), 0x1F | (16 << 10)));
                { float a = ss, b = ss; asm volatile("s_nop 1\n\tv_permlane32_swap_b32 %0, %1\n\ts_nop 1" : "+v"(a), "+v"(b)); ss = a + b; }
                if (fq == 0 && u.pn < 2) atomicAdd(rsq + row, ss); }
    }
};

struct SliceOrder {
    int pm, nN, nS, G, c, kbytes;
    __device__ bool next(int i, Unit& u) const { const int L = i * G + c; if (L >= nN * nS) return false; u.pm = pm; u.pn = L % nN; u.ko = (L / nN) * kbytes; return true; }
    __device__ __forceinline__ void a_ready(const Unit&) const {}
    __device__ __forceinline__ void done(const Unit&) const {}
};
struct EpiFA {
    static constexpr bool PERM = false, AFTER_DRAIN = false;
    float* O; int ldc, rows;
    __device__ __forceinline__ void operator()(const f32x4 (&acc)[2][2][4][2], const Unit& u, int wr, int wc, int, int) const {
        int lane_; asm volatile("v_mbcnt_lo_u32_b32 %0, -1, 0\n\tv_mbcnt_hi_u32_b32 %0, -1, %0" : "=v"(lane_)); const int fr = lane_ & 15, fq = lane_ >> 4;
        const int row0 = u.pm * BM + wr * 64 + fr, col0 = u.pn * BM + wc * 32 + 4 * fq;
#pragma unroll
        for (int ai = 0; ai < 2; ++ai)
#pragma unroll
            for (int m = 0; m < 4; ++m) { const int row = row0 + ai * HALF + m * 16; if (row >= rows) continue; float* rp = O + (size_t)row * ldc + col0;
#pragma unroll
                for (int bj = 0; bj < 2; ++bj)
#pragma unroll
                    for (int n = 0; n < 2; ++n) { const f32x4 v = acc[ai][bj][m][n];
#pragma unroll
                        for (int e = 0; e < 4; ++e) atomicAdd(rp + bj * HALF + n * 16 + e, v[e]); } }
    }
};

template <int ACT> struct EpiBA {
    static constexpr bool PERM = true, AFTER_DRAIN = false;
    bf16_t* O; const float* bias;
    __device__ __forceinline__ void operator()(const f32x4 (&acc)[2][2][4][2], const Unit& u, int wr, int wc, int, int) const {
        int lane_; asm volatile("v_mbcnt_lo_u32_b32 %0, -1, 0\n\tv_mbcnt_hi_u32_b32 %0, -1, %0" : "=v"(lane_)); const int fr = lane_ & 15, fq = lane_ >> 4;
        const int row0 = u.pm * BM + wr * 64 + fr, col0 = u.pn * BM + wc * 32 + 8 * fq;
        f32x4 bv[2][2];
#pragma unroll
        for (int bj = 0; bj < 2; ++bj)
#pragma unroll
            for (int n = 0; n < 2; ++n) bv[bj][n] = *(const f32x4*)(bias + col0 + bj * HALF + 4 * n);
#pragma unroll
        for (int ai = 0; ai < 2; ++ai)
#pragma unroll
            for (int m = 0; m < 4; ++m) { bf16_t* rowp = O + (size_t)(row0 + ai * HALF + m * 16) * 2048 + col0;
#pragma unroll
                for (int bj = 0; bj < 2; ++bj) { f32x4 v0 = acc[ai][bj][m][0] + bv[bj][0], v1 = acc[ai][bj][m][1] + bv[bj][1];
#pragma unroll
                    for (int e = 0; e < 4; ++e) { const float s0 = __builtin_amdgcn_rcpf(1.0f + __builtin_amdgcn_exp2f(-1.4426950408889634f * v0[e])), s1 = __builtin_amdgcn_rcpf(1.0f + __builtin_amdgcn_exp2f(-1.4426950408889634f * v1[e]));
                        v0[e] = ACT == 4 ? -0.8750387749f * s0 : s0; v1[e] = ACT == 4 ? -0.8750387749f * s1 : s1; }
                    typedef __bf16 bf8n __attribute__((ext_vector_type(8))); typedef float f8n __attribute__((ext_vector_type(8)));
                    const u32x4 w = __builtin_bit_cast(u32x4, __builtin_convertvector((f8n){v0[0], v0[1], v0[2], v0[3], v1[0], v1[1], v1[2], v1[3]}, bf8n));
                    *(u32x4*)(rowp + bj * HALF) = w; } }
    }
};

struct GroupOrderA2 {
    StaticOrder so; int per, nG;
    __device__ void init(int M, int G_, int c_, int nG_) { so.init(M, 2048, G_, c_); per = so.nwg; nG = nG_; }
    __device__ bool next(int i, Unit& u) const {
        const long L = (long)i * so.G + so.c; u.ko = 0;
        if (L < 4L * per) { const int gi = (int)(L / per); int wgid = (int)(L - (long)gi * per);
            { const int q = so.nwg / NXCD, r = so.nwg % NXCD, xcd = wgid % NXCD, off = wgid / NXCD; wgid = (xcd < r ? xcd * (q + 1) : r * (q + 1) + (xcd - r) * q) + off; }
            const int nig = WGM * so.nN, gid = wgid / nig, fm = gid * WGM, gsz = (so.nM - fm) < WGM ? (so.nM - fm) : WGM;
            u.pm = fm + ((wgid % nig) % gsz) + 130 * gi; u.pn = (wgid % nig) / gsz + 8 * gi; return true; }
        const int Lp = (int)(L - 4L * per); if (Lp >= (nG - 4) * so.nM) return false;
        const int ge = Lp / so.nM, gi = 4 + ge; u.pm = Lp % so.nM + 130 * (gi == 6 ? 2 : gi); u.pn = 32 + ge; return true;
    }
    __device__ __forceinline__ void a_ready(const Unit&) const {}
    __device__ __forceinline__ void done(const Unit&) const {}
};
struct EpiA2 {
    static constexpr bool PERM = true, AFTER_DRAIN = false;
    bf16_t* Rb; size_t ostride; int vidx; bf16_t* Lb; size_t lstride;
    __device__ __forceinline__ void operator()(const f32x4 (&acc)[2][2][4][2], const Unit& u, int wr, int wc, int, int) const {
        int lane_; asm volatile("v_mbcnt_lo_u32_b32 %0, -1, 0\n\tv_mbcnt_hi_u32_b32 %0, -1, %0" : "=v"(lane_)); const int fr = lane_ & 15, fq = lane_ >> 4;
        if (u.pn < 32) { const int gi = u.pn >> 3; bf16_t* Ob = Rb + (size_t)(gi < 2 ? gi : (gi == 2 ? vidx : 4)) * ostride;
            const int row0 = (u.pm - 130 * gi) * BM + wr * 64 + fr, col0 = (u.pn & 7) * BM + wc * 32 + 8 * fq;
#pragma unroll
            for (int ai = 0; ai < 2; ++ai)
#pragma unroll
                for (int m = 0; m < 4; ++m) { bf16_t* rowp = Ob + (size_t)(row0 + ai * HALF + m * 16) * 2048 + col0;
#pragma unroll
                    for (int bj = 0; bj < 2; ++bj) { const f32x4 v0 = acc[ai][bj][m][0], v1 = acc[ai][bj][m][1];
                        u32x4 w; w.x = cvt_pk_bf16(v0[0], v0[1]); w.y = cvt_pk_bf16(v0[2], v0[3]); w.z = cvt_pk_bf16(v1[0], v1[1]); w.w = cvt_pk_bf16(v1[2], v1[3]);
                        *(u32x4*)(rowp + bj * HALF) = w; } }
        } else { const int ge = u.pn - 32, gi = 4 + ge; bf16_t* Ob = Lb + (size_t)ge * lstride; const int nvalid = ge == 2 ? 32 : 64;
            const int row0 = (u.pm - 130 * (gi == 6 ? 2 : gi)) * BM + wr * 64 + fr, c = wc * 32 + 8 * fq;
#pragma unroll
            for (int ai = 0; ai < 2; ++ai)
#pragma unroll
                for (int m = 0; m < 4; ++m) { f32x4 v0 = acc[ai][0][m][0], v1 = acc[ai][0][m][1];
                    if (ge == 0) {
#pragma unroll
                        for (int e = 0; e < 4; ++e) { v0[e] = 1.0f - 2.0f / (1.0f + __expf(2.0f * v0[e])); v1[e] = 1.0f - 2.0f / (1.0f + __expf(2.0f * v1[e])); } }
                    u32x4 w; w.x = cvt_pk_bf16(v0[0], v0[1]); w.y = cvt_pk_bf16(v0[2], v0[3]); w.z = cvt_pk_bf16(v1[0], v1[1]); w.w = cvt_pk_bf16(v1[2], v1[3]);
                    if (c >= nvalid) w = (u32x4){0u, 0u, 0u, 0u};
                    *(u32x4*)(Ob + (size_t)(row0 + ai * HALF + m * 16) * 128 + c) = w; }
        }
    }
};
template <class Epi, class Sched, bool ALIGN_EPI = false, bool SP2 = false>
__device__ __forceinline__ void gemm_phase(PG8_LAS unsigned char* lds, const Gemm g, const Sched& S, const Epi& E, const int wid) {
    int lane_; asm volatile("v_mbcnt_lo_u32_b32 %0, -1, 0\n\tv_mbcnt_hi_u32_b32 %0, -1, %0" : "=v"(lane_));
    const int lane = lane_, tid = wid * 64 + lane, wr = wid >> 2, wc = wid & 3, fr = lane & 15, fq = lane >> 4;
    const int K = g.K, nt = K / BK, LD = g.ld ? g.ld : g.K;
    unsigned voffA[2], voffB[2];
#pragma unroll
    for (int i = 0; i < 2; ++i) { int R, C; stage_rc(tid * 16 + i * 8192, R, C); const int Rb = Epi::PERM ? ((R & ~31) + perm32(R & 31)) : R;
        voffA[i] = (unsigned)(R * LD + C) * 2u; voffB[i] = (unsigned)(Rb * LD + C) * 2u; }
    const size_t kstep = (size_t)(BK * 2);
    const size_t hstep = (size_t)HALF * LD * 2;
    const size_t tstep = 2 * hstep;
    const unsigned ldsw = (unsigned)wid * 1024u;
    const int aoff = lds_byte(wr * 64 + fr, fq * 8), boff = lds_byte(wc * 32 + fr, fq * 8);
#define PG8_SA(b, h) (((b) * 2 + (h)) * HTB)
#define PG8_SB(b, h) ((4 + (b) * 2 + (h)) * HTB)
#define PG8_STAGE(bufoff, gbase, voff) do { _Pragma("unroll") for (int _i = 0; _i < 2; ++_i) \
        __builtin_amdgcn_global_load_lds((const unsigned*)((const char*)(gbase) + (voff)[_i]), (PG8_LAS unsigned*)(lds + (bufoff) + ldsw + _i * 8192), 16, 0, 0); } while (0)
#define PG8_LDA(dst, b, h) do { _Pragma("unroll") for (int m = 0; m < 4; ++m) _Pragma("unroll") for (int k = 0; k < 2; ++k) dst[m][k] = *(const PG8_LAS bf16x8*)(lds + PG8_SA(b, h) + aoff + m * 2048 + k * 1024); } while (0)
#define PG8_LDB(dst, b, h) do { _Pragma("unroll") for (int n = 0; n < 2; ++n) _Pragma("unroll") for (int k = 0; k < 2; ++k) dst[n][k] = *(const PG8_LAS bf16x8*)(lds + PG8_SB(b, h) + boff + n * 2048 + k * 1024); } while (0)
#define PG8_MMA(ai, bj, At, Bt) do { __builtin_amdgcn_s_setprio(1); _Pragma("unroll") for (int m = 0; m < 4; ++m) _Pragma("unroll") for (int n = 0; n < 2; ++n) _Pragma("unroll") for (int k = 0; k < 2; ++k) \
        acc[ai][bj][m][n] = __builtin_amdgcn_mfma_f32_16x16x32_bf16(Bt[n][k], At[m][k], acc[ai][bj][m][n], 0, 0, 0); __builtin_amdgcn_s_setprio(0); } while (0)
#define PG8_WAIT_V(n) asm volatile("s_waitcnt vmcnt(" #n ")" ::: "memory")
#define PG8_WAIT_L(n) asm volatile("s_waitcnt lgkmcnt(" #n ")" ::: "memory")
#define PG8_BAR __builtin_amdgcn_s_barrier()
#define PG8_SCHED __builtin_amdgcn_sched_barrier(0)
    Unit cur, nxt; int ui = 0;
    if (!S.next(0, cur)) return;
    f32x4 acc[2][2][4][2];
#pragma unroll
    for (int a = 0; a < 2; ++a)
#pragma unroll
        for (int b = 0; b < 2; ++b)
#pragma unroll
            for (int m = 0; m < 4; ++m)
#pragma unroll
                for (int n = 0; n < 2; ++n) acc[a][b][m][n] = (f32x4){0.f, 0.f, 0.f, 0.f};
    bf16x8 At[4][2], B0[2][2], B1[2][2];
    const char* cA = (const char*)g.A + (size_t)cur.pm * tstep + cur.ko; const char* cB = (const char*)g.Bt + (size_t)cur.pn * tstep + cur.ko;
    S.a_ready(cur);
    if constexpr (SP2) {
        PG8_STAGE(PG8_SB(0, 0), cB, voffB); PG8_STAGE(PG8_SB(0, 1), cB + hstep, voffB); PG8_STAGE(PG8_SA(0, 0), cA, voffA); PG8_STAGE(PG8_SA(0, 1), cA + hstep, voffA);
        if (wr == 1) PG8_BAR;
        PG8_WAIT_V(2); PG8_BAR;
        PG8_STAGE(PG8_SB(1, 0), cB + kstep, voffB); PG8_STAGE(PG8_SA(1, 0), cA + kstep, voffA); PG8_STAGE(PG8_SB(1, 1), cB + hstep + kstep, voffB);
        PG8_WAIT_V(6); PG8_BAR;
    } else {
        PG8_STAGE(PG8_SB(0, 0), cB, voffB); PG8_STAGE(PG8_SA(0, 0), cA, voffA); PG8_STAGE(PG8_SB(0, 1), cB + hstep, voffB); PG8_STAGE(PG8_SA(0, 1), cA + hstep, voffA);
        if (wr == 1) PG8_BAR;
        PG8_WAIT_V(4); PG8_BAR;
        PG8_STAGE(PG8_SB(1, 0), cB + kstep, voffB); PG8_STAGE(PG8_SA(1, 0), cA + kstep, voffA); PG8_STAGE(PG8_SB(1, 1), cB + hstep + kstep, voffB);
        PG8_WAIT_V(6); PG8_BAR;
    }
    for (;;) {
        const bool has_next = S.next(ui + 1, nxt);
        const char* nA = has_next ? (const char*)g.A + (size_t)nxt.pm * tstep + nxt.ko : cA; const char* nB = has_next ? (const char*)g.Bt + (size_t)nxt.pn * tstep + nxt.ko : cB;
        for (int t = 0; t < nt; t += 2) {
            const bool last = (t == nt - 2);
            const char* a1 = cA + (size_t)(t + 1) * kstep;
            const char* a2 = last ? nA : cA + (size_t)(t + 2) * kstep; const char* b2 = last ? nB : cB + (size_t)(t + 2) * kstep;
            const char* a3 = a2 + kstep; const char* b3 = b2 + kstep;
            if (last && has_next) S.a_ready(nxt);
            if constexpr (SP2) {
            PG8_LDB(B0, 0, 0); PG8_LDB(B1, 0, 1); PG8_SCHED; PG8_LDA(At, 0, 0); PG8_STAGE(PG8_SA(1, 1), a1 + hstep, voffA);
            PG8_WAIT_V(8); PG8_WAIT_L(0); PG8_BAR; PG8_MMA(0, 0, At, B0); PG8_MMA(0, 1, At, B1); PG8_BAR; PG8_SCHED;
            PG8_LDA(At, 0, 1); PG8_STAGE(PG8_SB(0, 0), b2, voffB); PG8_STAGE(PG8_SB(0, 1), b2 + hstep, voffB); PG8_STAGE(PG8_SA(0, 0), a2, voffA);
            PG8_WAIT_V(8); PG8_WAIT_L(0); PG8_BAR; PG8_MMA(1, 0, At, B0); PG8_MMA(1, 1, At, B1); PG8_BAR; PG8_SCHED;
            PG8_LDB(B0, 1, 0); PG8_LDB(B1, 1, 1); PG8_SCHED; PG8_LDA(At, 1, 0); PG8_STAGE(PG8_SA(0, 1), a2 + hstep, voffA);
            PG8_WAIT_V(8); PG8_WAIT_L(0); PG8_BAR; PG8_MMA(0, 0, At, B0); PG8_MMA(0, 1, At, B1); PG8_BAR; PG8_SCHED;
            PG8_LDA(At, 1, 1); PG8_STAGE(PG8_SB(1, 0), b3, voffB); PG8_STAGE(PG8_SB(1, 1), b3 + hstep, voffB); PG8_STAGE(PG8_SA(1, 0), a3, voffA);
            PG8_WAIT_V(8); PG8_WAIT_L(0); PG8_BAR; PG8_MMA(1, 0, At, B0); PG8_MMA(1, 1, At, B1); PG8_BAR; PG8_SCHED;
            } else {
            PG8_LDB(B0, 0, 0); PG8_SCHED; PG8_LDA(At, 0, 0); PG8_STAGE(PG8_SA(1, 1), a1 + hstep, voffA);
            PG8_WAIT_L(8); PG8_BAR; PG8_WAIT_L(0); PG8_MMA(0, 0, At, B0); PG8_BAR; PG8_SCHED;
            PG8_LDB(B1, 0, 1); PG8_STAGE(PG8_SB(0, 0), b2, voffB);
            PG8_BAR; PG8_WAIT_L(0); PG8_MMA(0, 1, At, B1); PG8_BAR;
            PG8_LDA(At, 0, 1); PG8_STAGE(PG8_SA(0, 0), a2, voffA);
            PG8_BAR; PG8_WAIT_L(0); PG8_MMA(1, 0, At, B0); PG8_BAR; PG8_SCHED;
            PG8_STAGE(PG8_SB(0, 1), b2 + hstep, voffB);
            PG8_WAIT_V(6); PG8_BAR; PG8_MMA(1, 1, At, B1); PG8_BAR;
            PG8_LDB(B0, 1, 0); PG8_SCHED; PG8_LDA(At, 1, 0); PG8_STAGE(PG8_SA(0, 1), a2 + hstep, voffA);
            PG8_WAIT_L(8); PG8_BAR; PG8_WAIT_L(0); PG8_MMA(0, 0, At, B0); PG8_BAR; PG8_SCHED;
            PG8_LDB(B1, 1, 1); PG8_STAGE(PG8_SB(1, 0), b3, voffB);
            PG8_BAR; PG8_WAIT_L(0); PG8_MMA(0, 1, At, B1); PG8_BAR;
            PG8_LDA(At, 1, 1); PG8_STAGE(PG8_SA(1, 0), a3, voffA);
            PG8_BAR; PG8_WAIT_L(0); PG8_MMA(1, 0, At, B0); PG8_BAR; PG8_SCHED;
            PG8_STAGE(PG8_SB(1, 1), b3 + hstep, voffB);
            PG8_WAIT_V(6); PG8_BAR; PG8_MMA(1, 1, At, B1); PG8_BAR;
            }
        }
        if constexpr (ALIGN_EPI) { if (wr == 0) PG8_BAR; }
        if constexpr (!Epi::AFTER_DRAIN) { E(acc, cur, wr, wc, fr, fq); S.done(cur); }
        if (!has_next) break;
#pragma unroll
        for (int a = 0; a < 2; ++a)
#pragma unroll
            for (int b = 0; b < 2; ++b)
#pragma unroll
                for (int m = 0; m < 4; ++m)
#pragma unroll
                    for (int n = 0; n < 2; ++n) acc[a][b][m][n] = (f32x4){0.f, 0.f, 0.f, 0.f};
        cur = nxt; cA = nA; cB = nB; ++ui;
        if constexpr (ALIGN_EPI) { if (wr == 1) PG8_BAR; }
    }
    PG8_WAIT_V(0);
    if constexpr (!ALIGN_EPI) { if (wr == 0) PG8_BAR; }
    PG8_BAR;
    if constexpr (Epi::AFTER_DRAIN) { E.fused(acc, cur, wr, wc, fr, fq, lds, wid, lane); S.done(cur); }
#undef PG8_SA
#undef PG8_SB
#undef PG8_STAGE
#undef PG8_LDA
#undef PG8_LDB
#undef PG8_MMA
#undef PG8_WAIT_V
#undef PG8_WAIT_L
#undef PG8_BAR
#undef PG8_SCHED
}
}
constexpr int D_MODEL = 1024, BATCH = 16, SEQ = 2048, DEC_BATCH = 128, PAST = 8192, PAGE = 128, NPAGES = 64;
constexpr int D_INNER = 2048, A_HEADS = 32, A_HEAD = 64, B_HEADS = 16, KV_LORA = 256, Q_LORA = 384, QK_NOPE = 128, QK_ROPE = 64, V_HEAD = 128, QK_HEAD = 192;
constexpr int MP = BATCH * SEQ;
constexpr int MS0 = MP;
constexpr int MT = MP + 256;
constexpr float NORM_EPS = 1e-6f, GN_EPS = 64e-5f;
constexpr float ATTN_SCALE = 0.07216878364870322f;
constexpr float LOG2E = 1.4426950408889634f;
constexpr int NWAVES = 8, NTHR = 512;

constexpr size_t O_YP = 0, O_YS = O_YP + (size_t)MP * D_MODEL, O_WKVP = O_YS + (size_t)DEC_BATCH * D_MODEL, O_SHP = O_WKVP + (size_t)2 * BATCH * A_HEADS * 4096,
    O_CKVP = O_SHP + (size_t)2 * BATCH * D_MODEL, O_KPEP = O_CKVP + (size_t)MP * KV_LORA, O_WKVS = O_KPEP + (size_t)MP * QK_ROPE, O_SHS = O_WKVS + (size_t)2 * DEC_BATCH * A_HEADS * 4096,
    O_CKVS = O_SHS + (size_t)2 * DEC_BATCH * D_MODEL, O_KPES = O_CKVS + (size_t)DEC_BATCH * KV_LORA, O_END = O_KPES + (size_t)DEC_BATCH * QK_ROPE;

constexpr size_t MiB = 1u << 20;
constexpr size_t WS_CTL = 0, CTL_ZERO_BYTES = 2 * MiB;
constexpr size_t WS_WIN = 2 * MiB, WIN_L = 18 * MiB;
constexpr size_t WS_W2 = WS_WIN + 2 * WIN_L;
constexpr size_t WS_WO = WS_W2 + 3 * MiB;
constexpr size_t WS_WDKV = WS_WO + 8 * MiB;
constexpr size_t WS_WUK = WS_WDKV + 1 * MiB;
constexpr size_t WS_WUV = WS_WUK + 1 * MiB;
constexpr size_t WS_WQ = WS_WUV + 1 * MiB;
constexpr size_t WS_WZ = WS_WQ + 2 * MiB;
constexpr size_t WS_WUQ = WS_WZ + 8 * MiB;
constexpr size_t WS_WBO = WS_WUQ + 5 * MiB;
constexpr size_t WS_ROPE = WS_WBO + 8 * MiB;
constexpr size_t WS_X = 96 * MiB;
constexpr size_t WS_AM = WS_X + 130 * MiB;
constexpr size_t AM_STRIDE = 65 * MiB;
constexpr size_t WS_R = WS_AM + 6 * AM_STRIDE;
constexpr size_t BIGB = 130 * MiB;
constexpr size_t WS_K = WS_R + BIGB, WS_V0 = WS_K + BIGB, WS_V1 = WS_V0 + BIGB, WS_Z = WS_V1 + BIGB, WS_G = WS_Z + BIGB;
constexpr size_t WS_LW = WS_G + BIGB;
constexpr size_t WS_LA = WS_LW + 9 * MiB, WS_LV = WS_LA + 9 * MiB;
constexpr size_t WS_BON = WS_LV + 9 * MiB;
constexpr size_t WS_F = WS_BON + 5 * MiB;
constexpr size_t BIGF = 260 * MiB;
constexpr size_t WS_WD = WS_F, WS_IA = WS_F + BIGF, WS_VG = WS_F + 2 * BIGF, WS_SR = WS_F + 3 * BIGF, WS_SK = WS_F + 4 * BIGF, WS_SA = WS_F + 5 * BIGF, WS_SB = WS_F + 6 * BIGF,
    WS_SV = WS_F + 7 * BIGF, WS_Y = WS_F + 8 * BIGF, WS_END_A = WS_F + 9 * BIGF;
constexpr size_t WS_KVR = WS_F;
constexpr size_t WS_CKVB = WS_KVR + 41 * MiB;
constexpr size_t WS_KPEB = WS_CKVB + 17 * MiB;
constexpr size_t WS_KN = WS_KPEB + 5 * MiB;
constexpr size_t WS_VT = WS_KN + 128 * MiB;
constexpr size_t WS_QL = WS_VT + 128 * MiB;
constexpr size_t WS_CQ = WS_QL + 49 * MiB;
constexpr size_t WS_QR = WS_CQ + 25 * MiB;
constexpr size_t WS_Q = WS_QR + 388 * MiB;
constexpr size_t WS_QABS = WS_Q + 194 * MiB;
constexpr size_t WS_OPART = WS_QABS + 2 * MiB;
constexpr size_t WS_ML = WS_OPART + 16 * MiB;
constexpr size_t WS_END_B = WS_ML + 1 * MiB;
constexpr size_t WS_NEED = WS_END_A > WS_END_B ? WS_END_A : WS_END_B;
static_assert(WS_ROPE + 1 * MiB <= WS_X, "weights region");
constexpr size_t CW_RSQ = 1 * MiB;
constexpr int CW_BAR = 4096;

constexpr int RING_BYTES = 131072;
constexpr int LDSCTL_OFF = RING_BYTES;
constexpr int LDS_BYTES = 147456;

#define GAS __attribute__((address_space(1)))
#define LAS __attribute__((address_space(3)))
typedef unsigned short bf16;
typedef unsigned v4u __attribute__((ext_vector_type(4)));
typedef unsigned v2u __attribute__((ext_vector_type(2)));
typedef float f32x4 __attribute__((ext_vector_type(4)));
typedef float f32x16 __attribute__((ext_vector_type(16)));
typedef short bf16x8 __attribute__((ext_vector_type(8)));
typedef short s16x4 __attribute__((ext_vector_type(4)));
typedef const __attribute__((address_space(4))) float* cfp;
#define LDS_WAIT() asm volatile("s_waitcnt lgkmcnt(0)" ::: "memory")
#define VM_WAIT() asm volatile("s_waitcnt vmcnt(0)" ::: "memory")
__device__ __forceinline__ unsigned f2bf(float f) { unsigned u = __builtin_bit_cast(unsigned, f); return (u + 0x7fffu + ((u >> 16) & 1u)) >> 16; }
__device__ __forceinline__ unsigned pk2(float lo, float hi) { return f2bf(lo) | (f2bf(hi) << 16); }
__device__ __forceinline__ float bflo(unsigned u) { return __builtin_bit_cast(float, u << 16); }
__device__ __forceinline__ float bfhi(unsigned u) { return __builtin_bit_cast(float, u & 0xffff0000u); }
template <int MASK> __device__ __forceinline__ float swz_xor(float v) { return __builtin_bit_cast(float, __builtin_amdgcn_ds_swizzle(__builtin_bit_cast(int, v), 0x1F | (MASK << 10))); }
__device__ __forceinline__ float xor32_sum(float v) { float a = v, b = v; asm volatile("s_nop 1\n\tv_permlane32_swap_b32 %0, %1\n\ts_nop 1" : "+v"(a), "+v"(b)); return a + b; }
__device__ __forceinline__ float xor32_max(float v) { float a = v, b = v; asm volatile("s_nop 1\n\tv_permlane32_swap_b32 %0, %1\n\ts_nop 1" : "+v"(a), "+v"(b)); return fmaxf(a, b); }
__device__ __forceinline__ float wave_sum(float v) { v += swz_xor<1>(v); v += swz_xor<2>(v); v += swz_xor<4>(v); v += swz_xor<8>(v); v += swz_xor<16>(v); return xor32_sum(v); }
__device__ __forceinline__ float sigmoidf_(float x) { return 1.0f / (1.0f + __expf(-x)); }
#define XB_TMO      128
#define XB_XCNT(j)  (256  + 64 * (j))
#define XB_XSUB(j)  (1280 + 64 * (j))
#define XB_XGEN(j)  (2304 + 64 * (j))
#define XB_TOP      3328
#define XB_TOPGEN   3392
#define XCD_BAR_WORDS 3456
#define XB_SPIN_CAP (1u << 18)

__device__ __forceinline__ unsigned xb_ld(unsigned* p)              { return __hip_atomic_load(p, __ATOMIC_RELAXED, __HIP_MEMORY_SCOPE_AGENT); }
__device__ __forceinline__ unsigned xb_add(unsigned* p, unsigned v) { return __hip_atomic_fetch_add(p, v, __ATOMIC_RELAXED, __HIP_MEMORY_SCOPE_AGENT); }
__device__ __forceinline__ unsigned xb_xcc_id() { return (unsigned)__builtin_amdgcn_s_getreg((3 << 11) | 20) & 0xFu; }
#define XB_SPIN(cond, bar) do { unsigned _sp = 0; while (cond) { __builtin_amdgcn_s_sleep(1); \
    if ((++_sp & 255u) == 0u) { if (xb_ld(&(bar)[XB_TMO])) break; if (_sp > XB_SPIN_CAP) { atomicAdd(&(bar)[XB_TMO], 1u); break; } } } } while (0)

struct XcdBarrier {
    unsigned* bar; unsigned x; unsigned w;
    volatile LAS unsigned* st;
};

__device__ __forceinline__ bool xb_t0(unsigned w) { unsigned l; asm volatile("v_mbcnt_lo_u32_b32 %0, -1, 0\n\tv_mbcnt_hi_u32_b32 %0, -1, %0" : "=v"(l)); return w == 0u && l == 0u; }
__device__ __forceinline__ XcdBarrier xcd_barrier_post(unsigned* bar, volatile LAS unsigned* st, unsigned w) {
    XcdBarrier b; b.bar = bar; b.x = xb_xcc_id(); b.st = st; b.w = w;
    if (xb_t0(w)) (void)xb_add(&bar[XB_XCNT(b.x)], 1u);
    return b;
}
__device__ __forceinline__ void xcd_barrier_complete(unsigned* bar, unsigned x, unsigned& nloc, unsigned& nx) {
    const unsigned G = gridDim.x * gridDim.y * gridDim.z;
    unsigned sum, cnt, mine, sp = 0u;
    for (;;) {
        sum = 0u; cnt = 0u; mine = 0u;
#pragma unroll
        for (unsigned j = 0; j < 16; ++j) { const unsigned c = xb_ld(&bar[XB_XCNT(j)]); sum += c; cnt += (c > 0u) ? 1u : 0u; mine = (j == x) ? c : mine; }
        if (sum == G) break;
        __builtin_amdgcn_s_sleep(1);
        if ((++sp & 255u) == 0u) { if (xb_ld(&bar[XB_TMO])) break; if (sp > XB_SPIN_CAP) { atomicAdd(&bar[XB_TMO], 1u); break; } }
    }
    nloc = mine > 0u ? mine : 1u; nx = cnt > 0u ? cnt : 1u;
}

__device__ __forceinline__ void xcd_barrier(const XcdBarrier& b) {
    asm volatile("s_waitcnt vmcnt(0)" ::: "memory");
    __syncthreads();
    if (xb_t0(b.w)) {
        unsigned* bar = b.bar;
        __builtin_amdgcn_s_waitcnt(0);
        unsigned nloc = b.st[0], nx = b.st[1];
        if (nloc == 0u) { xcd_barrier_complete(bar, b.x, nloc, nx); b.st[0] = nloc; b.st[1] = nx; }
        const unsigned old = xb_add(&bar[XB_XSUB(b.x)], 1u);
        const unsigned gen = old / nloc;
        if (old + 1u == (gen + 1u) * nloc) {
            __builtin_amdgcn_fence(__ATOMIC_RELEASE, "agent");
            asm volatile("s_waitcnt vmcnt(0)" ::: "memory");
            const unsigned og = xb_add(&bar[XB_TOP], 1u);
            const unsigned tg = og / nx;
            if (og + 1u == (tg + 1u) * nx) xb_add(&bar[XB_TOPGEN], 1u);
            else XB_SPIN(xb_ld(&bar[XB_TOPGEN]) == tg, bar);
            __builtin_amdgcn_fence(__ATOMIC_ACQUIRE, "agent");
            xb_add(&bar[XB_XGEN(b.x)], 1u);
            asm volatile("s_waitcnt vmcnt(0)" ::: "memory");
        } else {
            XB_SPIN(xb_ld(&bar[XB_XGEN(b.x)]) == gen, bar);
            __builtin_amdgcn_fence(__ATOMIC_ACQUIRE, "agent");
            asm volatile("s_waitcnt vmcnt(0)" ::: "memory");
        }
    }
    __syncthreads();
}
struct Args { const void* in[36]; float* out; unsigned char* ws; int ph_lo, ph_hi, li, pad; };
typedef const __attribute__((address_space(4))) Args* cargs;
__device__ __forceinline__ int lane_id() { int l; asm volatile("v_mbcnt_lo_u32_b32 %0, -1, 0\n\tv_mbcnt_hi_u32_b32 %0, -1, %0" : "=v"(l)); return l; }
struct Frame { LAS unsigned char* lds; unsigned char* ws; float* out; int lane, wave, bid, gw, NGW, G, NT; };
#define LANE F.lane
__device__ __forceinline__ Frame make_frame(cargs ap, int wave0, LAS unsigned char* lds) {
    Frame F; int w = wave0, b = (int)blockIdx.x, g = (int)gridDim.x; asm volatile("" : "+s"(w), "+s"(b), "+s"(g));
    F.lds = lds; F.ws = ap->ws; F.out = ap->out; F.lane = lane_id(); F.wave = w; F.bid = b; F.G = g; F.gw = b * NWAVES + w; F.NGW = g * NWAVES; F.NT = g * NTHR;
    return F;
}

__device__ __forceinline__ int rope_perm_col(int n) { const int c = n % 192; if (c < 128) return n; const int j = c - 128; return n - c + 128 + 2 * (j & 31) + (j >> 5); }
__device__ __forceinline__ void tr_item(const float* W, int ldw, int col0, int Kvalid, int nblk, bf16* WT, int ldt, bool zpad, LAS float* scr, int item, int lane, bool rperm = false) {
    const int kb = item / nblk, nb = item % nblk, k0 = 64 * kb, n0 = 32 * nb;
    float wv[32];
#pragma unroll
    for (int i = 0; i < 32; ++i) { const int kr = min(k0 + 2 * i + (lane >> 5), Kvalid - 1); wv[i] = W[(size_t)kr * ldw + col0 + n0 + (lane & 31)]; }
    __builtin_amdgcn_sched_barrier(0);
#pragma unroll
    for (int i = 0; i < 32; ++i) { const int kk = 2 * i + (lane >> 5); scr[kk * 33 + (lane & 31)] = (k0 + kk < Kvalid) ? wv[i] : 0.f; }
    LDS_WAIT(); asm volatile("" ::: "memory");
    const int c = lane & 7;
#pragma unroll
    for (int j = 0; j < 4; ++j) { const int n = (lane >> 3) + 8 * j; const LAS float* s = scr + (8 * c) * 33 + n;
        v4u o; o.x = pk2(s[0 * 33], s[1 * 33]); o.y = pk2(s[2 * 33], s[3 * 33]); o.z = pk2(s[4 * 33], s[5 * 33]); o.w = pk2(s[6 * 33], s[7 * 33]);
        const int nd = rperm ? rope_perm_col(n0 + n) : n0 + n;
        *(v4u*)(WT + (size_t)nd * ldt + k0 + 8 * c) = o;
        if (zpad) *(v4u*)(WT + (size_t)nd * ldt + 64 + 8 * c) = (v4u){0u, 0u, 0u, 0u}; }
    LDS_WAIT(); asm volatile("" ::: "memory");
}
#define TRJOB_(W_, ldw_, col0_, Kv_, Nc_, WT_, ldt_, zp_, rp_) do { const int nblk_ = (Nc_) / 32, items_ = (((Kv_) + 63) / 64) * nblk_; \
    for (int it_ = ((F.gw - base_) % F.NGW + F.NGW) % F.NGW; it_ < items_; it_ += F.NGW) tr_item((W_), (ldw_), (col0_), (Kv_), nblk_, (bf16*)(WT_), (ldt_), (zp_), scr, it_, LANE, (rp_)); base_ = (base_ + items_) % F.NGW; } while (0)
#define TRJOB(W_, ldw_, col0_, Kv_, Nc_, WT_, ldt_, zp_) TRJOB_(W_, ldw_, col0_, Kv_, Nc_, WT_, ldt_, zp_, false)

__device__ __forceinline__ void p0_prologue(Frame& F, cargs a) {
    LAS float* scr = (LAS float*)(F.lds + F.wave * 16384);
    unsigned char* ws = F.ws; int base_ = 0;
    for (int l = 0; l < 2; ++l) {
        for (int p = 0; p < 4; ++p) TRJOB((const float*)a->in[9] + (size_t)(l * 4 + p) * 1024 * 2048, 2048, 0, 1024, 2048, ws + WS_WIN + (size_t)l * WIN_L + (size_t)p * 4 * MiB, 1024, false);
        TRJOB((const float*)a->in[11] + (size_t)l * 1024 * 64, 64, 0, 1024, 64, ws + WS_WIN + (size_t)l * WIN_L + 16 * MiB, 1024, false);
        TRJOB((const float*)a->in[14] + (size_t)l * 1024 * 64, 64, 0, 1024, 64, ws + WS_WIN + (size_t)l * WIN_L + 16 * MiB + MiB / 2, 1024, false);
        TRJOB((const float*)a->in[12] + (size_t)l * 64 * 2048, 2048, 0, 64, 2048, ws + WS_W2 + (size_t)l * (MiB / 2), 128, true);
        TRJOB((const float*)a->in[15] + (size_t)l * 64 * 2048, 2048, 0, 64, 2048, ws + WS_W2 + (size_t)(2 + l) * (MiB / 2), 128, true);
        TRJOB((const float*)a->in[24] + (size_t)l * 2048 * 1024, 1024, 0, 2048, 1024, ws + WS_WO + (size_t)l * 4 * MiB, 2048, false);
        TRJOB((const float*)a->in[31] + (size_t)l * 1024 * 2432, 2432, 0, 1024, 384, ws + WS_WQ + (size_t)l * MiB, 1024, false);
        TRJOB((const float*)a->in[31] + (size_t)l * 1024 * 2432, 2432, 384, 1024, 2048, ws + WS_WZ + (size_t)l * 4 * MiB, 1024, false);
        TRJOB_((const float*)a->in[33] + (size_t)l * 384 * 3072, 3072, 0, 384, 3072, ws + WS_WUQ + (size_t)l * (5 * MiB / 2), 384, false, true);
        TRJOB((const float*)a->in[34] + (size_t)l * 2048 * 1024, 1024, 0, 2048, 1024, ws + WS_WBO + (size_t)l * 4 * MiB, 2048, false);
    }
    TRJOB((const float*)a->in[17], 32, 0, 1024, 32, ws + WS_WIN + WIN_L + 17 * MiB, 1024, false);
    TRJOB((const float*)a->in[18], 2048, 0, 32, 2048, ws + WS_W2 + (size_t)4 * (MiB / 2), 128, true);
    TRJOB((const float*)a->in[26], 320, 0, 1024, 320, ws + WS_WDKV, 1024, false);
    TRJOB((const float*)a->in[28], 2048, 0, 256, 2048, ws + WS_WUK, 256, false);
    TRJOB((const float*)a->in[29], 2048, 0, 256, 2048, ws + WS_WUV, 256, false);
    { const f32x4* xs = (const f32x4*)a->in[1]; f32x4* X4 = (f32x4*)(ws + WS_X) + (size_t)MP * 256;
      for (int i = (F.bid * NTHR + F.wave * 64 + LANE); i < 256 * 256; i += F.NT) X4[i] = i < DEC_BATCH * 256 ? xs[i] : (f32x4){0.f, 0.f, 0.f, 0.f}; }
    { float* T = (float*)(ws + WS_ROPE);
      for (int i = (F.bid * NTHR + F.wave * 64 + LANE); i < 2049 * 32; i += F.NT) { const int p = i >> 5, f = i & 31; const double pos = p < 2048 ? (double)p : 8192.0;
          const double ang = pos * (double)exp2f(-(float)f * (13.287712379549449f / 32.0f)); T[2 * i] = (float)cos(ang); T[2 * i + 1] = (float)sin(ang); } }
}

__device__ __forceinline__ void load_row(const float* row, int lane, f32x4 (&v)[4]) {
#pragma unroll
    for (int j = 0; j < 4; ++j) v[j] = ((const f32x4*)row)[lane + 64 * j];
}
__device__ __forceinline__ float row_rs(const f32x4 (&v)[4]) {
    float s = 0.f;
#pragma unroll
    for (int j = 0; j < 4; ++j) s += (v[j].x * v[j].x + v[j].y * v[j].y) + (v[j].z * v[j].z + v[j].w * v[j].w);
    return 1.0f / sqrtf(wave_sum(s) * (1.0f / 1024.0f) + NORM_EPS);
}
__device__ __forceinline__ void norm_rows_bf16(Frame& F, const float* X, const float* w, bf16* O) {
    f32x4 w4[4]; load_row(w, LANE, w4);
    for (int m = F.gw; m < MT; m += F.NGW) { f32x4 x[4]; load_row(X + (size_t)m * 1024, LANE, x); const float rs = row_rs(x);
#pragma unroll
        for (int j = 0; j < 4; ++j) { const f32x4 h = x[j] * rs * w4[j]; v2u o; o.x = pk2(h.x, h.y); o.y = pk2(h.z, h.w); *(v2u*)(O + (size_t)m * 1024 + 4 * LANE + 256 * j) = o; } }
}

__device__ __forceinline__ void norm2_rows_bf16(Frame& F, const float* X, const float* wa, bf16* Oa, const float* wb, bf16* Ob) {
    f32x4 a4[4], b4[4]; load_row(wa, LANE, a4); load_row(wb, LANE, b4);
    for (int m = F.gw; m < MT; m += F.NGW) { f32x4 x[4]; load_row(X + (size_t)m * 1024, LANE, x); const float rs = row_rs(x);
#pragma unroll
        for (int j = 0; j < 4; ++j) { const f32x4 xs = x[j] * rs, ha = xs * a4[j], hb = xs * b4[j]; v2u o; o.x = pk2(ha.x, ha.y); o.y = pk2(ha.z, ha.w); *(v2u*)(Oa + (size_t)m * 1024 + 4 * LANE + 256 * j) = o;
            o.x = pk2(hb.x, hb.y); o.y = pk2(hb.z, hb.w); *(v2u*)(Ob + (size_t)m * 1024 + 4 * LANE + 256 * j) = o; } }
}

__device__ __forceinline__ void a1_prepass(Frame& F, cargs a, int l) {
    const float* Xw = (const float*)(F.ws + WS_X); const float* X = l == 0 ? (const float*)a->in[0] : Xw;
    const float* nw = (const float*)a->in[7] + l * 1024; const float* mix = (const float*)a->in[8] + l * 6 * 1024; const float* sshift = (const float*)a->in[3] + (size_t)l * DEC_BATCH * 1024;
    f32x4 w4[4]; load_row(nw, LANE, w4);
    LAS f32x4* mxl = (LAS f32x4*)F.lds;
    for (int i = F.wave * 64 + LANE; i < 6 * 256; i += NTHR) mxl[i] = ((const f32x4*)mix)[i];
    __syncthreads();
    for (int m = F.gw; m < MT; m += F.NGW) {
        f32x4 x[4], h[4], hp[4]; load_row((m < MP ? X : Xw) + (size_t)m * 1024, LANE, x); const float rs = row_rs(x);
#pragma unroll
        for (int j = 0; j < 4; ++j) { h[j] = x[j] * rs * w4[j]; hp[j] = (f32x4){0.f, 0.f, 0.f, 0.f}; }
        if (m < MP) { if ((m & (SEQ - 1)) != 0) { f32x4 xq[4]; load_row(X + (size_t)(m - 1) * 1024, LANE, xq); const float rq = row_rs(xq);
#pragma unroll
                for (int j = 0; j < 4; ++j) hp[j] = xq[j] * rq * w4[j]; } }
        else if (m < MP + DEC_BATCH) load_row(sshift + (size_t)(m - MP) * 1024, LANE, hp);
#pragma unroll
        for (int p = 0; p < 6; ++p) { bf16* O = (bf16*)(F.ws + WS_AM + (size_t)p * AM_STRIDE) + (size_t)m * 1024;
#pragma unroll
            for (int j = 0; j < 4; ++j) { const f32x4 mx = mxl[p * 256 + LANE + 64 * j]; const f32x4 o = h[j] + (hp[j] - h[j]) * mx;
                v2u w; w.x = pk2(o.x, o.y); w.y = pk2(o.z, o.w); *(v2u*)(O + 4 * LANE + 256 * j) = w; } }
        float* so = nullptr;
        if (m < MP) { if ((m & (SEQ - 1)) == SEQ - 1) so = F.out + O_SHP + (size_t)(l * BATCH + (m >> 11)) * 1024; }
        else if (m < MP + DEC_BATCH) so = F.out + O_SHS + (size_t)(l * DEC_BATCH + (m - MP)) * 1024;
        if (so) {
#pragma unroll
            for (int j = 0; j < 4; ++j) ((f32x4*)so)[LANE + 64 * j] = h[j]; }
    }
}

typedef float f32x2 __attribute__((ext_vector_type(2)));
__device__ __forceinline__ void unpack8(v4u u, float (&f)[8]) { f[0] = bflo(u.x); f[1] = bfhi(u.x); f[2] = bflo(u.y); f[3] = bfhi(u.y); f[4] = bflo(u.z); f[5] = bfhi(u.z); f[6] = bflo(u.w); f[7] = bfhi(u.w); }
constexpr int FS_TS = 16, FS_Y = FS_TS * 6 * 64 * 4, FS_Z = FS_Y + FS_TS * 64 * 4, FS_BON = FS_Z + FS_TS * 64 * 2, FS_BH = FS_BON + 128, FS_BUF = 2 * FS_BH;
static_assert(2 * FS_BUF <= RING_BYTES && FS_BH % 16 == 0, "fused scan LDS");
template <int CTRL> __device__ __forceinline__ float dppf(float v) { return __builtin_bit_cast(float, __builtin_amdgcn_update_dpp(0, __builtin_bit_cast(int, v), CTRL, 0xF, 0xF, false)); }
__device__ __forceinline__ float wave_sum_fast(float v) {
    v += dppf<0xB1>(v); v += dppf<0x4E>(v); v += dppf<0x124>(v); v += dppf<0x128>(v);
    const int iv = __builtin_bit_cast(int, v);
    return (__builtin_bit_cast(float, __builtin_amdgcn_readlane(iv, 0)) + __builtin_bit_cast(float, __builtin_amdgcn_readlane(iv, 16))) + (__builtin_bit_cast(float, __builtin_amdgcn_readlane(iv, 32)) + __builtin_bit_cast(float, __builtin_amdgcn_readlane(iv, 48)));
}
struct HeadPrm { float w0, a0, v0, kk, ka, rk, lnw, lnb; };
__device__ __forceinline__ float frcp(float x) { return __builtin_amdgcn_rcpf(x); }
__device__ __forceinline__ float fsig(float x) { return __builtin_amdgcn_rcpf(1.0f + __builtin_amdgcn_exp2f(-1.4426950408889634f * x)); }
__device__ __forceinline__ float wkv_step_lds(f32x2 (&S)[32], const LAS float* op, int lane) {
    const LAS f32x4* a4 = (const LAS f32x4*)op; const LAS f32x4* w4 = a4 + 16; const LAS f32x4* b4 = a4 + 32; const LAS f32x4* k4 = a4 + 48; const LAS f32x4* r4 = a4 + 64;
    const float vv = op[320 + lane];
    f32x2 s0 = (f32x2){0.f, 0.f}, s1 = s0;
#pragma unroll
    for (int q = 0; q < 16; ++q) { const f32x4 a = a4[q]; s0 += S[2 * q] * (f32x2){a.x, a.y}; s1 += S[2 * q + 1] * (f32x2){a.z, a.w}; }
    const f32x2 st = s0 + s1; const float sa = st.x + st.y; const f32x2 sa2 = (f32x2){sa, sa}, vv2 = (f32x2){vv, vv};
    f32x2 y0 = (f32x2){0.f, 0.f}, y1 = y0;
#pragma unroll
    for (int q = 0; q < 16; ++q) { const f32x4 w = w4[q], b = b4[q], k = k4[q], r = r4[q];
        S[2 * q] = S[2 * q] * (f32x2){w.x, w.y} + (sa2 * (f32x2){b.x, b.y} + vv2 * (f32x2){k.x, k.y}); y0 += S[2 * q] * (f32x2){r.x, r.y};
        S[2 * q + 1] = S[2 * q + 1] * (f32x2){w.z, w.w} + (sa2 * (f32x2){b.z, b.w} + vv2 * (f32x2){k.z, k.w}); y1 += S[2 * q + 1] * (f32x2){r.z, r.w}; }
    const f32x2 yt = y0 + y1; return yt.x + yt.y;
}
__device__ __forceinline__ void fs_prep_one(const HeadPrm& P, int l, float r, float k, float v, float dw, float da, float dv, float vf, LAS float* op, int lane, float& bon) {
    const float ia = da, w = __builtin_amdgcn_exp2f(dw);
    if (l) v = v + (vf - v) * dv;
    const float kk = k * P.kk, n2 = wave_sum_fast(kk * kk), inv = 1.0f / fmaxf(sqrtf(n2), 1e-12f), q = kk * inv, kp = k * (1.0f + (ia - 1.0f) * P.ka);
    bon = wave_sum_fast(r * kp * P.rk);
    op[lane] = -q; op[64 + lane] = w; op[128 + lane] = q * ia; op[192 + lane] = kp; op[256 + lane] = r; op[320 + lane] = v;
}
__device__ __forceinline__ float fs_post_one(const HeadPrm& P, float y, float vp, float z, float bon) {
    const float mu = wave_sum_fast(y) * (1.0f / 64.0f), d = y - mu, var = wave_sum_fast(d * d) * (1.0f / 64.0f);
    const float yn = d * __builtin_amdgcn_rsqf(var + GN_EPS) * P.lnw + P.lnb; return (yn + bon * vp) * (z * fsig(z));
}
__device__ __forceinline__ float ldbf(const bf16* p) { return bflo((unsigned)*p); }
__device__ __forceinline__ bf16 tobf(float x) { return __builtin_bit_cast(unsigned short, (__bf16)x); }
typedef short s16x4_t __attribute__((ext_vector_type(4)));
#define MF16(a_, b_, c_) __builtin_amdgcn_mfma_f32_16x16x16bf16_1k((a_), (b_), (c_), 0, 0, 0)
#define MF32(a_, b_, c_) __builtin_amdgcn_mfma_f32_16x16x32_bf16((a_), (b_), (c_), 0, 0, 0)
#define CAT8(a_, b_) __builtin_shufflevector((a_), (b_), 0, 1, 2, 3, 4, 5, 6, 7)
typedef __bf16 bf16x4_nat __attribute__((ext_vector_type(4)));
__device__ __forceinline__ s16x4_t cvt4(f32x4 v) { return __builtin_bit_cast(s16x4_t, __builtin_convertvector(v, bf16x4_nat)); }
constexpr int CK_TP = 144, CK_KP = 40;
constexpr int CK_AT = 0, CK_RT = CK_AT + 16 * CK_TP, CK_BH = CK_RT + 16 * CK_TP, CK_KH = CK_BH + 16 * CK_TP, CK_BHT = CK_KH + 16 * CK_TP, CK_KHT = CK_BHT + 64 * CK_KP, CK_VT = CK_KHT + 64 * CK_KP,
    CK_PC = CK_VT + 64 * CK_KP, CK_OPB = CK_PC + 256;
constexpr int RG_VP = 0, RG_Z = 2048, RG_BON = 4096, RG_SZ = 4224;
constexpr int BH_OPB = 0, BH_RING = 2 * CK_OPB, BH_Y = BH_RING + 3 * RG_SZ, BH_LW = BH_Y + 2 * 4096, BH_PRM = BH_LW + 4096, BH_SZ = BH_PRM + 6 * 256;
static_assert(2 * BH_SZ <= RING_BYTES && BH_SZ % 16 == 0 && CK_OPB % 16 == 0, "chunked scan LDS");
typedef short v4i16_ck __attribute__((ext_vector_type(4)));
__device__ __forceinline__ s16x4_t ck_tr(const LAS unsigned char* p) { return __builtin_bit_cast(s16x4_t, __builtin_amdgcn_ds_read_tr16_b64_v4i16((LAS v4i16_ck*)p)); }
__device__ __forceinline__ void ck_scan_chunk(f32x4 (&ST)[4][4], const LAS unsigned char* ob, const LAS unsigned char* vpb, LAS float* yb, int c16, int g) {
    const f32x4 zero4 = (f32x4){0.f, 0.f, 0.f, 0.f};
    bf16x8 at[2], rt[2], bh[2], kh[2];
#pragma unroll
    for (int ks = 0; ks < 2; ++ks) { const int o = c16 * CK_TP + 16 * g + 64 * ks;
        at[ks] = *(const LAS bf16x8*)(ob + CK_AT + o); rt[ks] = *(const LAS bf16x8*)(ob + CK_RT + o); bh[ks] = *(const LAS bf16x8*)(ob + CK_BH + o); kh[ks] = *(const LAS bf16x8*)(ob + CK_KH + o); }
    f32x4 qN = zero4, qL = zero4, qMk = zero4, qNbr = zero4, qNkr = zero4;
#pragma unroll
    for (int ks = 0; ks < 2; ++ks) { qN = MF32(bh[ks], at[ks], qN); qL = MF32(at[ks], bh[ks], qL); qMk = MF32(kh[ks], at[ks], qMk); qNbr = MF32(bh[ks], rt[ks], qNbr); qNkr = MF32(kh[ks], rt[ks], qNkr); }
    f32x4 Id;
#pragma unroll
    for (int r = 0; r < 4; ++r) { const int row = 4 * g + r; Id[r] = row == c16 ? 1.f : 0.f;
        if (!(row < c16)) { qN[r] = 0.f; qMk[r] = 0.f; }
        if (!(row <= c16)) { qNbr[r] = 0.f; qNkr[r] = 0.f; }
        if (!(c16 < row)) qL[r] = 0.f; }
    const s16x4_t aN = cvt4(qN), aL = cvt4(qL), aMk = cvt4(qMk), aNbr = cvt4(qNbr), aNkr = cvt4(qNkr);
    const f32x4 n2 = MF16(aL, aN, zero4), l2 = MF16(aN, aL, zero4);
    const s16x4_t aN2 = cvt4(n2), aL2 = cvt4(l2);
    const f32x4 n4 = MF16(aL2, aN2, zero4), l4 = MF16(aN2, aL2, zero4);
    const f32x4 n8 = MF16(cvt4(l4), cvt4(n4), zero4);
    const f32x4 p1t = MF16(cvt4(n2 + Id), cvt4(qL + Id), zero4);
    const f32x4 p2 = MF16(cvt4(l4 + Id), cvt4(n8 + Id), zero4);
    const s16x4_t aT = cvt4(MF16(cvt4(p1t), cvt4(p2), zero4));
    s16x4_t af[4], rf[4], bfr[4], kfr[4], vtr[4]; f32x4 pc[4]; s16x4_t Sb[4];
#pragma unroll
    for (int ki = 0; ki < 4; ++ki) { const int o = c16 * CK_TP + (16 * ki + 4 * g) * 2; af[ki] = *(const LAS s16x4_t*)(ob + CK_AT + o); rf[ki] = *(const LAS s16x4_t*)(ob + CK_RT + o);
        const int o2 = (4 * g + (c16 >> 2)) * CK_TP + (16 * ki + 4 * (c16 & 3)) * 2; bfr[ki] = ck_tr(ob + CK_BH + o2); kfr[ki] = ck_tr(ob + CK_KH + o2);
        vtr[ki] = ck_tr(vpb + (4 * g + (c16 >> 2)) * 128 + (16 * ki + 4 * (c16 & 3)) * 2);
        pc[ki] = *(const LAS f32x4*)(ob + CK_PC + (16 * ki + 4 * g) * 4); }
    f32x4 yt[4];
#pragma unroll
    for (int vi = 0; vi < 4; ++vi) {
        f32x4 xt = zero4, y0 = zero4;
#pragma unroll
        for (int ki = 0; ki < 4; ki += 2) { Sb[ki] = cvt4(ST[ki][vi]); Sb[ki + 1] = cvt4(ST[ki + 1][vi]); const bf16x8 sb2 = CAT8(Sb[ki], Sb[ki + 1]);
            xt = MF32(CAT8(af[ki], af[ki + 1]), sb2, xt); y0 = MF32(CAT8(rf[ki], rf[ki + 1]), sb2, y0); }
        const s16x4_t vt = vtr[vi];
        xt = MF16(aMk, vt, xt);
        const s16x4_t ub = cvt4(MF16(aT, cvt4(xt), zero4));
        const bf16x8 uv = CAT8(ub, vt);
        yt[vi] = MF32(CAT8(aNbr, aNkr), uv, y0);
#pragma unroll
        for (int ki = 0; ki < 4; ++ki) { ST[ki][vi] = MF32(CAT8(bfr[ki], kfr[ki]), uv, ST[ki][vi]); ST[ki][vi] *= pc[ki]; }
    }
#pragma unroll
    for (int vi = 0; vi < 4; ++vi)
#pragma unroll
        for (int r = 0; r < 4; ++r) yb[(4 * g + r) * 64 + 16 * vi + c16] = yt[vi][r];
}
__device__ __forceinline__ void a5_fused(Frame& F, cargs a, int l) {
    unsigned char* ws = F.ws; const int lane = F.lane;
    const bf16* R = (const bf16*)(ws + WS_R); const bf16* K = (const bf16*)(ws + WS_K); const bf16* V = (const bf16*)(ws + (l ? WS_V1 : WS_V0)); const bf16* VF = (const bf16*)(ws + WS_V0); const bf16* Z = (const bf16*)(ws + WS_Z);
    const bf16* DW = (const bf16*)(ws + WS_WD); const bf16* DA = (const bf16*)(ws + WS_IA); const bf16* DV = (const bf16*)(ws + WS_VG); bf16* G = (bf16*)(ws + WS_G);
    const float* pw0 = (const float*)a->in[10] + l * 2048; const float* pa0 = (const float*)a->in[13] + l * 2048; const float* pv0 = (const float*)a->in[16]; const float* pkk = (const float*)a->in[19] + l * 2048;
    const float* pka = (const float*)a->in[20] + l * 2048; const float* prk = (const float*)a->in[21] + l * 2048; const float* plw = (const float*)a->in[22] + l * 2048; const float* plb = (const float*)a->in[23] + l * 2048;
    constexpr int NCH = SEQ / 16;
    for (int pr = F.bid; pr < BATCH * A_HEADS / 2; pr += F.G) { const int bh0 = 2 * pr;
        const int role = F.wave >> 1, hb = F.wave & 1, bh = bh0 + hb, b = bh >> 5, hh = bh & 31, ch = hh * 64 + lane;
        LAS unsigned char* blk = F.lds + hb * BH_SZ;
        const size_t rowb = (size_t)b * SEQ; const int c16 = lane & 15, g = lane >> 4;
#define CK_BAR() do { asm volatile("s_waitcnt lgkmcnt(0)" ::: "memory"); __builtin_amdgcn_s_barrier(); asm volatile("" ::: "memory"); } while (0)
#define CKV_LOAD(cc, SET) do { const size_t ro = (rowb + (size_t)(cc) * 16) * 2048;     \
            _Pragma("unroll") for (int j = 0; j < 2; ++j) { SET##r[j] = ((const v4u*)(R + ro + voff_))[j]; SET##k[j] = ((const v4u*)(K + ro + voff_))[j]; SET##v[j] = ((const v4u*)(V + ro + voff_))[j]; SET##z[j] = ((const v4u*)(Z + ro + voff_))[j]; \
                SET##w[j] = ((const v4u*)(DW + ro + voff_))[j]; SET##a[j] = ((const v4u*)(DA + ro + voff_))[j]; if (l) { SET##d[j] = ((const v4u*)(DV + ro + voff_))[j]; SET##f[j] = ((const v4u*)(VF + ro + voff_))[j]; } } } while (0)
#define CKV_PREP(cc, SET) do { LAS unsigned char* ob = blk + BH_OPB + ((cc) & 1) * CK_OPB; LAS unsigned char* rg = blk + BH_RING + ((cc) % 3) * RG_SZ; \
            float kk_[16], kp_[16], ia_[16], lw_[16]; float n2 = 0.f, bon = 0.f; \
            _Pragma("unroll") for (int j = 0; j < 2; ++j) { float k8[8], a8[8], r8[8], w8[8]; unpack8(SET##k[j], k8); unpack8(SET##a[j], a8); unpack8(SET##r[j], r8); unpack8(SET##w[j], w8); \
                _Pragma("unroll") for (int h = 0; h < 2; ++h) { const f32x4 pkk_ = prm[3 * 16 + 4 * vq_ + 2 * j + h], pka_ = prm[4 * 16 + 4 * vq_ + 2 * j + h], prk_ = prm[5 * 16 + 4 * vq_ + 2 * j + h]; \
                    _Pragma("unroll") for (int e = 0; e < 4; ++e) { const int i = 8 * j + 4 * h + e, e8 = 4 * h + e; const float ia = a8[e8]; ia_[i] = ia; lw_[i] = w8[e8]; \
                        const float kk = k8[e8] * pkk_[e]; kk_[i] = kk; n2 += kk * kk; const float kp = k8[e8] * (1.0f + (ia - 1.0f) * pka_[e]); kp_[i] = kp; bon += r8[e8] * kp * prk_[e]; } } } \
            n2 += dppf<0xB1>(n2); n2 += dppf<0x4E>(n2); bon += dppf<0xB1>(bon); bon += dppf<0x4E>(bon); const float inv = __builtin_amdgcn_rsqf(fmaxf(n2, 1e-24f)); \
              \
            _Pragma("unroll") for (int j = 0; j < 4; ++j) lwp[vt_ * 16 + 4 * vq_ + j] = (f32x4){lw_[4 * j], lw_[4 * j + 1], lw_[4 * j + 2], lw_[4 * j + 3]}; \
            LDS_WAIT(); asm volatile("" ::: "memory"); \
            { float c_[16]; _Pragma("unroll") for (int t = 0; t < 16; ++t) c_[t] = ((const LAS float*)lwp)[t * 64 + lane]; \
              _Pragma("unroll") for (int t = 1; t < 16; ++t) c_[t] += c_[t - 1]; \
              _Pragma("unroll") for (int t = 0; t < 16; ++t) ((LAS float*)lwp)[t * 64 + lane] = c_[t]; } \
            LDS_WAIT(); asm volatile("" ::: "memory"); \
            float lp_[16]; _Pragma("unroll") for (int j = 0; j < 4; ++j) { const f32x4 v = lwp[vt_ * 16 + 4 * vq_ + j]; lp_[4 * j] = v.x; lp_[4 * j + 1] = v.y; lp_[4 * j + 2] = v.z; lp_[4 * j + 3] = v.w; } \
            v4u oa[2], orr[2], ob_[2], ok[2], ov[2]; \
            _Pragma("unroll") for (int j = 0; j < 2; ++j) { float r8[8], v8[8]; unpack8(SET##r[j], r8); unpack8(SET##v[j], v8); \
                if (l) { float d8[8], f8[8]; unpack8(SET##d[j], d8); unpack8(SET##f[j], f8); _Pragma("unroll") for (int h = 0; h < 2; ++h) { \
                        _Pragma("unroll") for (int e = 0; e < 4; ++e) { const int e8 = 4 * h + e; v8[e8] = v8[e8] + (f8[e8] - v8[e8]) * d8[e8]; } } } \
                _Pragma("unroll") for (int e = 0; e < 8; e += 2) { const int i = 8 * j + e; \
                    const float P0 = __builtin_amdgcn_exp2f(lp_[i]), P1 = __builtin_amdgcn_exp2f(lp_[i + 1]), R0 = __builtin_amdgcn_exp2f(-lp_[i]), R1 = __builtin_amdgcn_exp2f(-lp_[i + 1]); \
                    const float M0 = __builtin_amdgcn_exp2f(lp_[i] - lw_[i]), M1 = __builtin_amdgcn_exp2f(lp_[i + 1] - lw_[i + 1]), q0 = kk_[i] * inv, q1 = kk_[i + 1] * inv; \
                    oa[j][e >> 1] = (unsigned)tobf(-q0 * M0) | ((unsigned)tobf(-q1 * M1) << 16); orr[j][e >> 1] = (unsigned)tobf(r8[e] * P0) | ((unsigned)tobf(r8[e + 1] * P1) << 16); \
                    ob_[j][e >> 1] = (unsigned)tobf(q0 * ia_[i] * R0) | ((unsigned)tobf(q1 * ia_[i + 1] * R1) << 16); ok[j][e >> 1] = (unsigned)tobf(kp_[i] * R0) | ((unsigned)tobf(kp_[i + 1] * R1) << 16); \
                    ov[j][e >> 1] = (unsigned)tobf(v8[e]) | ((unsigned)tobf(v8[e + 1]) << 16); \
                    if (vt_ == 15) { ((LAS float*)(ob + CK_PC))[16 * vq_ + i] = P0; ((LAS float*)(ob + CK_PC))[16 * vq_ + i + 1] = P1; } } } \
            _Pragma("unroll") for (int j = 0; j < 2; ++j) { const int o = vt_ * CK_TP + 32 * vq_ + 16 * j; *(LAS v4u*)(ob + CK_AT + o) = oa[j]; *(LAS v4u*)(ob + CK_RT + o) = orr[j]; *(LAS v4u*)(ob + CK_BH + o) = ob_[j]; *(LAS v4u*)(ob + CK_KH + o) = ok[j]; \
                *(LAS v4u*)(rg + RG_VP + vt_ * 128 + 32 * vq_ + 16 * j) = ov[j]; *(LAS v4u*)(rg + RG_Z + vt_ * 128 + 32 * vq_ + 16 * j) = SET##z[j]; } \
            if (vq_ == 0) ((LAS float*)(rg + RG_BON))[vt_] = bon; } while (0)
#define CK_POST(cc) do { const LAS unsigned char* rg = blk + BH_RING + ((cc) % 3) * RG_SZ; const LAS float* yb = (const LAS float*)(blk + BH_Y + ((cc) & 1) * 4096) + pt_ * 64 + 16 * pq_; \
            float y_[16], vp_[16], z_[16]; \
            _Pragma("unroll") for (int j = 0; j < 4; ++j) { const f32x4 v = ((const LAS f32x4*)yb)[j]; y_[4 * j] = v.x; y_[4 * j + 1] = v.y; y_[4 * j + 2] = v.z; y_[4 * j + 3] = v.w; } \
            _Pragma("unroll") for (int j = 0; j < 2; ++j) { float t8[8]; unpack8(((const LAS v4u*)(rg + RG_VP + pt_ * 128 + 32 * pq_))[j], t8); _Pragma("unroll") for (int e = 0; e < 8; ++e) vp_[8 * j + e] = t8[e]; \
                unpack8(((const LAS v4u*)(rg + RG_Z + pt_ * 128 + 32 * pq_))[j], t8); _Pragma("unroll") for (int e = 0; e < 8; ++e) z_[8 * j + e] = t8[e]; } \
            const float bon = ((const LAS float*)(rg + RG_BON))[pt_]; float sm = 0.f; \
            _Pragma("unroll") for (int j = 0; j < 16; ++j) sm += y_[j]; \
            sm += dppf<0xB1>(sm); sm += dppf<0x4E>(sm); const float mu = sm * (1.0f / 64.0f); float sq = 0.f; \
            _Pragma("unroll") for (int j = 0; j < 16; ++j) { y_[j] -= mu; sq += y_[j] * y_[j]; } \
            sq += dppf<0xB1>(sq); sq += dppf<0x4E>(sq); const float rstd = __builtin_amdgcn_rsqf(sq * (1.0f / 64.0f) + GN_EPS); \
            v4u o_[2]; \
            _Pragma("unroll") for (int j = 0; j < 16; j += 2) { const float g0 = (y_[j] * rstd * lw_[j] + lb_[j] + bon * vp_[j]) * (z_[j] * fsig(z_[j])), g1 = (y_[j + 1] * rstd * lw_[j + 1] + lb_[j + 1] + bon * vp_[j + 1]) * (z_[j + 1] * fsig(z_[j + 1])); \
                o_[j >> 3][(j >> 1) & 3] = (unsigned)tobf(g0) | ((unsigned)tobf(g1) << 16); } \
            v4u* gp = (v4u*)(G + (rowb + (size_t)(cc) * 16 + pt_) * 2048 + hh * 64 + 16 * pq_); gp[0] = o_[0]; gp[1] = o_[1]; } while (0)
        typedef unsigned short us2 __attribute__((ext_vector_type(2)));
        if (role == 0) { f32x4 ST[4][4];
#pragma unroll
            for (int i = 0; i < 4; ++i)
#pragma unroll
                for (int j = 0; j < 4; ++j) ST[i][j] = (f32x4){0.f, 0.f, 0.f, 0.f};
            CK_BAR();
            for (int c = 0; c < NCH; ++c) { ck_scan_chunk(ST, blk + BH_OPB + (c & 1) * CK_OPB, blk + BH_RING + (c % 3) * RG_SZ + RG_VP, (LAS float*)(blk + BH_Y + (c & 1) * 4096), c16, g); CK_BAR(); }
            float* so = F.out + O_WKVP + ((size_t)(l * BATCH + b) * A_HEADS + hh) * 4096;
#pragma unroll
            for (int ki = 0; ki < 4; ++ki)
#pragma unroll
                for (int vi = 0; vi < 4; ++vi) *(f32x4*)(so + (16 * vi + c16) * 64 + 16 * ki + 4 * g) = ST[ki][vi]; }
        else if (role == 1) { const int ln1 = lane_id(), vt_ = ln1 >> 2, vq_ = ln1 & 3; const unsigned voff_ = (unsigned)(vt_ * 2048 + hh * 64 + 16 * vq_); LAS f32x4* lwp = (LAS f32x4*)(blk + BH_LW); const LAS f32x4* prm = (const LAS f32x4*)(blk + BH_PRM);
            { const int ln = lane_id(), c1 = hh * 64 + ln; LAS float* pf = (LAS float*)(blk + BH_PRM); pf[ln] = pw0[c1]; pf[64 + ln] = pa0[c1]; pf[128 + ln] = l ? pv0[c1] : 0.f; pf[192 + ln] = pkk[c1]; pf[256 + ln] = pka[c1]; pf[320 + ln] = prk[c1]; LDS_WAIT(); asm volatile("" ::: "memory"); }
            v4u Ar[2], Ak[2], Av[2], Az[2], Aw[2], Aa[2], Ad[2], Af[2];
#pragma unroll
            for (int j = 0; j < 2; ++j) { Ad[j] = (v4u){0u, 0u, 0u, 0u}; Af[j] = Ad[j]; }
            CKV_LOAD(0, A); CKV_PREP(0, A); CKV_LOAD(1, A); CK_BAR();
            for (int c = 0; c < NCH; ++c) { if (c + 1 < NCH) { CKV_PREP(c + 1, A); if (c + 2 < NCH) CKV_LOAD(c + 2, A); } CK_BAR(); } }
        else if (role == 3) {
            const int ln3 = lane_id(), vt_ = ln3 >> 2, vq_ = ln3 & 3; const unsigned voff_ = (unsigned)(vt_ * 2048 + hh * 64 + 16 * vq_);
            v4u Ar[2], Ak[2], Av[2], Az[2], Aw[2], Aa[2], Ad[2], Af[2];
#pragma unroll
            for (int j = 0; j < 2; ++j) { Ad[j] = (v4u){0u, 0u, 0u, 0u}; Af[j] = Ad[j]; }
            CKV_LOAD(2, A); CK_BAR();
            for (int c = 0; c < NCH; ++c) {
#pragma unroll
                for (int j = 0; j < 2; ++j) asm volatile("" :: "v"(Ar[j]), "v"(Ak[j]), "v"(Av[j]), "v"(Az[j]), "v"(Aw[j]), "v"(Aa[j]), "v"(Ad[j]), "v"(Af[j]));
                if (c + 3 < NCH) CKV_LOAD(c + 3, A);
                CK_BAR(); } }
        else { const int ln2 = lane_id(), pt_ = ln2 >> 2, pq_ = ln2 & 3; float lw_[16], lb_[16];
#pragma unroll
            for (int j = 0; j < 16; ++j) { lw_[j] = plw[hh * 64 + 16 * pq_ + j]; lb_[j] = plb[hh * 64 + 16 * pq_ + j]; }
            CK_BAR();
            for (int c = 0; c < NCH; ++c) { if (c >= 1) CK_POST(c - 1); CK_BAR(); }
            CK_POST(NCH - 1); }
        __syncthreads();
#undef CK_PREP
#undef CKV_LOAD
#undef CKV_PREP
#undef CK_BAR
#undef CK_POST
    }
    const float* stt = (const float*)a->in[2] + (size_t)l * DEC_BATCH * A_HEADS * 4096;
    LAS float* sop = (LAS float*)(F.lds + F.wave * 2048);
    for (int it = F.gw; it < DEC_BATCH * A_HEADS; it += F.NGW) { const int b = it >> 5, hh = it & 31, ch = hh * 64 + lane; const size_t o = (size_t)(MP + b) * 2048 + ch;
        HeadPrm P; P.w0 = pw0[ch]; P.a0 = pa0[ch]; P.v0 = l ? pv0[ch] : 0.f; P.kk = pkk[ch]; P.ka = pka[ch]; P.rk = prk[ch]; P.lnw = plw[ch]; P.lnb = plb[ch];
        const float z = ldbf(Z + o); float bon;
        fs_prep_one(P, l, ldbf(R + o), ldbf(K + o), ldbf(V + o), ldbf(DW + o), ldbf(DA + o), l ? ldbf(DV + o) : 0.f, l ? ldbf(VF + o) : 0.f, sop, lane, bon);
        LDS_WAIT(); asm volatile("" ::: "memory");
        f32x2 S[32]; const float* si = stt + (size_t)it * 4096 + lane * 64;
#pragma unroll
        for (int k = 0; k < 32; k += 2) { const f32x4 v = *(const f32x4*)(si + 2 * k); S[k] = (f32x2){v.x, v.y}; S[k + 1] = (f32x2){v.z, v.w}; }
        const float y = wkv_step_lds(S, sop, lane), vp = sop[320 + lane];
        float* so = F.out + O_WKVS + ((size_t)l * DEC_BATCH * A_HEADS + it) * 4096 + lane * 64;
#pragma unroll
        for (int k = 0; k < 32; k += 2) *(f32x4*)(so + 2 * k) = (f32x4){S[k].x, S[k].y, S[k + 1].x, S[k + 1].y};
        G[o] = (bf16)f2bf(fs_post_one(P, y, vp, z, bon));
        LDS_WAIT(); asm volatile("" ::: "memory");
    }
#undef FS_PREP
#undef FS_POST
}

__device__ __forceinline__ void final_norm(Frame& F, cargs a) {
    const float* X = (const float*)(F.ws + WS_X); f32x4 w4[4]; load_row((const float*)a->in[35], LANE, w4);
    for (int m = F.gw; m < MP + DEC_BATCH; m += F.NGW) { f32x4 x[4]; load_row(X + (size_t)m * 1024, LANE, x); const float rs = row_rs(x);
        float* o = m < MP ? F.out + O_YP + (size_t)m * 1024 : F.out + O_YS + (size_t)(m - MP) * 1024;
#pragma unroll
        for (int j = 0; j < 4; ++j) ((f32x4*)o)[LANE + 64 * j] = x[j] * rs * w4[j]; }
}
#ifndef MK_DYNATT
#define MK_DYNATT 0
#endif
__device__ __forceinline__ void b0c_kvpost(Frame& F, cargs a) {
    unsigned char* ws = F.ws; const float* KVR = (const float*)(ws + WS_KVR); bf16* CK = (bf16*)(ws + WS_CKVB); bf16* KP = (bf16*)(ws + WS_KPEB); const float* ROPE = (const float*)(ws + WS_ROPE);
    const f32x4 w4 = ((const f32x4*)a->in[27])[F.lane];
    for (int m = F.gw; m < MP + DEC_BATCH; m += F.NGW) { const float* row = KVR + (size_t)m * 320;
        const f32x4 v = ((const f32x4*)row)[F.lane]; const float ss = wave_sum((v.x * v.x + v.y * v.y) + (v.z * v.z + v.w * v.w));
        const float rs = 1.0f / sqrtf(ss * (1.0f / 256.0f) + NORM_EPS); const f32x4 c = v * rs * w4;
        float* oc = m < MP ? F.out + O_CKVP + (size_t)m * 256 : F.out + O_CKVS + (size_t)(m - MP) * 256; float* ok = m < MP ? F.out + O_KPEP + (size_t)m * 64 : F.out + O_KPES + (size_t)(m - MP) * 64;
        ((f32x4*)oc)[F.lane] = c; v2u pw; pw.x = pk2(c.x, c.y); pw.y = pk2(c.z, c.w); *(v2u*)(CK + (size_t)m * 256 + 4 * F.lane) = pw;
        if (F.lane < 32) { const int i = F.lane, p = m < MP ? (m & (SEQ - 1)) : SEQ; const float x1 = row[256 + i], x2 = row[288 + i], cs = ROPE[(p * 32 + i) * 2], sn = ROPE[(p * 32 + i) * 2 + 1];
            const float o1 = x1 * cs - x2 * sn, o2 = x2 * cs + x1 * sn; ok[i] = o1; ok[32 + i] = o2; *(unsigned*)(KP + (size_t)m * 64 + 2 * i) = pk2(o1, o2); }
    }
}
__device__ __forceinline__ void b1c_cq(Frame& F, cargs a, int l) {
    unsigned char* ws = F.ws; const float* QL = (const float*)(ws + WS_QL); bf16* CQ = (bf16*)(ws + WS_CQ); const float* w = (const float*)a->in[32] + l * 384;
    f32x2 w2[3];
#pragma unroll
    for (int j = 0; j < 3; ++j) w2[j] = *(const f32x2*)(w + 2 * F.lane + 128 * j);
    for (int m = F.gw; m < MT; m += F.NGW) { f32x2 v[3]; float ss = 0.f;
#pragma unroll
        for (int j = 0; j < 3; ++j) { v[j] = *(const f32x2*)(QL + (size_t)m * 384 + 2 * F.lane + 128 * j); ss += v[j].x * v[j].x + v[j].y * v[j].y; }
        const float rs = 1.0f / sqrtf(wave_sum(ss) * (1.0f / 384.0f) + NORM_EPS);
#pragma unroll
        for (int j = 0; j < 3; ++j) *(unsigned*)(CQ + (size_t)m * 384 + 2 * F.lane + 128 * j) = pk2(v[j].x * rs * w2[j].x, v[j].y * rs * w2[j].y); }
}
constexpr int AT_KP = 400, AT_VP = 136, AT_KBYTES = 64 * AT_KP, AT_VBYTES = 128 * AT_VP, AT_BUF = AT_KBYTES + AT_VBYTES;
__device__ __forceinline__ int crow(int r, int hi) { return (r & 3) + 8 * (r >> 2) + 4 * hi; }
typedef __bf16 bf16x8_nat __attribute__((ext_vector_type(8)));
typedef float f32x8 __attribute__((ext_vector_type(8)));
__device__ __forceinline__ bf16x8 pack8f(float a0, float a1, float a2, float a3, float a4, float a5, float a6, float a7) {
    return __builtin_bit_cast(bf16x8, __builtin_convertvector((f32x8){a0, a1, a2, a3, a4, a5, a6, a7}, bf16x8_nat)); }
__device__ __forceinline__ void attn_unit(Frame& F, int b, int hd, int qb) {
    unsigned char* ws = F.ws; const bf16* Q = (const bf16*)(ws + WS_Q);
    const bf16* Z = (const bf16*)(ws + WS_Z); bf16* G = (bf16*)(ws + WS_G);
    LAS unsigned char* Ks = F.lds; LAS unsigned char* Vs = F.lds + AT_KBYTES;
    const int lane = lane_id(), r32 = lane & 31, hi = lane >> 5, tid = F.wave * 64 + lane;
    const int qpos = qb * 256 + F.wave * 32 + r32; const size_t qrow = (size_t)b * SEQ + qpos;
    bf16x8 qf[12];
#pragma unroll
    for (int s = 0; s < 12; ++s) qf[s] = *(const bf16x8*)(Q + qrow * 3072 + hd * 192 + 16 * s + 8 * hi);
    f32x16 o[4];
#pragma unroll
    for (int d = 0; d < 4; ++d)
#pragma unroll
        for (int r = 0; r < 16; ++r) o[d][r] = 0.f;
    float mrow = -1e30f, lrow = 0.f;
    const int ntiles = 4 * qb + 4, wq0 = qb * 256 + F.wave * 32;
    const unsigned gK = (unsigned)((tid >> 4) * 4096 + (tid & 15) * 16), gP = (unsigned)((tid >> 3) * 128 + (tid & 7) * 16), gV = (unsigned)((tid >> 3) * (MP * 2) + (tid & 7) * 16);
    LAS unsigned char* lK = Ks + (tid >> 4) * AT_KP + (tid & 15) * 16; LAS unsigned char* lP = Ks + (tid >> 3) * AT_KP + 256 + (tid & 7) * 16; LAS unsigned char* lV = Vs + (tid >> 3) * AT_VP + (tid & 7) * 16;
    const unsigned char* kb0 = ws + WS_KN + ((size_t)b * SEQ * 2048 + hd * 128) * 2; const unsigned char* pb0 = ws + WS_KPEB + (size_t)b * SEQ * 128; const unsigned char* vb0 = ws + WS_VT + ((size_t)hd * 128 * MP + (size_t)b * SEQ) * 2;
    v4u pk_[3], pv_[2];
#define AT_FETCH(kt_) do { const unsigned char* kb = kb0 + (size_t)(kt_) * (64 * 4096); const unsigned char* pb = pb0 + (size_t)(kt_) * (64 * 128); const unsigned char* vb = vb0 + (size_t)(kt_) * 128; \
        pk_[0] = *(const v4u*)(kb + gK); pk_[1] = *(const v4u*)(kb + 32 * 4096 + gK); pk_[2] = *(const v4u*)(pb + gP); pv_[0] = *(const v4u*)(vb + gV); pv_[1] = *(const v4u*)(vb + (size_t)64 * MP * 2 + gV); } while (0)
    AT_FETCH(0);
    const LAS unsigned char* kA = Ks + r32 * AT_KP + hi * 16;
    const LAS unsigned char* vA = Vs + r32 * AT_VP + hi * 8;
#define AT_KF(st_) (*(const LAS bf16x8*)(kA + ((st_) & 1) * (32 * AT_KP) + ((st_) >> 1) * 32))
#define AT_VF(st_, j_) (*(const LAS v2u*)(vA + ((st_) & 3) * (32 * AT_VP) + ((st_) >> 2) * 32 + 16 * (j_)))
    constexpr int KD = 6, VD = 4;
    for (int kt = 0; kt < ntiles; ++kt) {
        __syncthreads();
        *(LAS v4u*)lK = pk_[0]; *(LAS v4u*)(lK + 32 * AT_KP) = pk_[1]; *(LAS v4u*)lP = pk_[2];
#pragma unroll
        for (int i = 0; i < 2; ++i) { *(LAS v2u*)(lV + i * 64 * AT_VP) = (v2u){pv_[i].x, pv_[i].y}; *(LAS v2u*)(lV + i * 64 * AT_VP + 8) = (v2u){pv_[i].z, pv_[i].w}; }
        __syncthreads();
        if (kt + 1 < ntiles) AT_FETCH(kt + 1);
        if (kt * 64 > wq0 + 31) continue;
        f32x16 s0, s1;
#pragma unroll
        for (int r = 0; r < 16; ++r) { s0[r] = 0.f; s1[r] = 0.f; }
        bf16x8 kf[8];
#pragma unroll
        for (int st = 0; st < KD; ++st) kf[st] = AT_KF(st);
#pragma unroll
        for (int st = 0; st < 24; ++st) {
            if (st + KD < 24) kf[(st + KD) & 7] = AT_KF(st + KD);
            if (st & 1) s1 = __builtin_amdgcn_mfma_f32_32x32x16_bf16(kf[st & 7], qf[st >> 1], s1, 0, 0, 0);
            else s0 = __builtin_amdgcn_mfma_f32_32x32x16_bf16(kf[st & 7], qf[st >> 1], s0, 0, 0, 0);
            __builtin_amdgcn_sched_barrier(0);
        }
        v2u vf[8][2];
#pragma unroll
        for (int st = 0; st < VD; ++st) { vf[st][0] = AT_VF(st, 0); vf[st][1] = AT_VF(st, 1); }
        __builtin_amdgcn_sched_barrier(0);
        if (kt * 64 + 63 > wq0) {
#pragma unroll
            for (int r = 0; r < 16; ++r) { const int key = kt * 64 + crow(r, hi); if (key > qpos) s0[r] = -__builtin_inff(); if (key + 32 > qpos) s1[r] = -__builtin_inff(); } }
        float tmax = s0[0];
#pragma unroll
        for (int r = 1; r < 16; ++r) tmax = fmaxf(tmax, s0[r]);
#pragma unroll
        for (int r = 0; r < 16; ++r) tmax = fmaxf(tmax, s1[r]);
        tmax = xor32_max(tmax);
        if (__builtin_amdgcn_ballot_w64(tmax > mrow + 8.0f) != 0ull) { const float mnew = fmaxf(mrow, tmax), alpha = __builtin_amdgcn_exp2f(mrow - mnew); mrow = mnew; lrow *= alpha;
#pragma unroll
            for (int d = 0; d < 4; ++d)
#pragma unroll
                for (int r = 0; r < 16; ++r) o[d][r] *= alpha; }
        float ps = 0.f;
#pragma unroll
        for (int r = 0; r < 16; ++r) { s0[r] = __builtin_amdgcn_exp2f(s0[r] - mrow); s1[r] = __builtin_amdgcn_exp2f(s1[r] - mrow); ps += s0[r] + s1[r]; }
        lrow += ps;
        bf16x8 pb[4];
        pb[0] = pack8f(s0[0], s0[1], s0[2], s0[3], s0[4], s0[5], s0[6], s0[7]); pb[1] = pack8f(s0[8], s0[9], s0[10], s0[11], s0[12], s0[13], s0[14], s0[15]);
        pb[2] = pack8f(s1[0], s1[1], s1[2], s1[3], s1[4], s1[5], s1[6], s1[7]); pb[3] = pack8f(s1[8], s1[9], s1[10], s1[11], s1[12], s1[13], s1[14], s1[15]);
        __builtin_amdgcn_sched_barrier(0);
#pragma unroll
        for (int st = 0; st < 16; ++st) {
            if (st + VD < 16) { vf[(st + VD) & 7][0] = AT_VF(st + VD, 0); vf[(st + VD) & 7][1] = AT_VF(st + VD, 1); }
            const v4u av = (v4u){vf[st & 7][0].x, vf[st & 7][0].y, vf[st & 7][1].x, vf[st & 7][1].y};
            o[st & 3] = __builtin_amdgcn_mfma_f32_32x32x16_bf16(__builtin_bit_cast(bf16x8, av), pb[st >> 2], o[st & 3], 0, 0, 0);
            __builtin_amdgcn_sched_barrier(0);
        }
    }
#undef AT_FETCH
#undef AT_KF
#undef AT_VF
    lrow = xor32_sum(lrow); const float inv = 1.0f / lrow;
    v2u zq[4][4];
#pragma unroll
    for (int d = 0; d < 4; ++d)
#pragma unroll
        for (int rg = 0; rg < 4; ++rg) zq[d][rg] = *(const v2u*)(Z + qrow * 2048 + hd * 128 + 32 * d + 8 * rg + 4 * hi);
    __builtin_amdgcn_sched_barrier(0);
#pragma unroll
    for (int d = 0; d < 4; ++d)
#pragma unroll
        for (int rg = 0; rg < 4; ++rg) { const int dd = 32 * d + 8 * rg + 4 * hi; const size_t off = qrow * 2048 + hd * 128 + dd;
            const v2u zz = zq[d][rg]; const float z0 = bflo(zz.x), z1 = bfhi(zz.x), z2 = bflo(zz.y), z3 = bfhi(zz.y);
            v2u w; w.x = pk2(o[d][4 * rg] * inv * (z0 * sigmoidf_(z0)), o[d][4 * rg + 1] * inv * (z1 * sigmoidf_(z1))); w.y = pk2(o[d][4 * rg + 2] * inv * (z2 * sigmoidf_(z2)), o[d][4 * rg + 3] * inv * (z3 * sigmoidf_(z3)));
            *(v2u*)(G + off) = w; }
}
#if !MK_DYNATT
__device__ __forceinline__ void b2a_attn_prompt(Frame& F) {
    if (F.wave < 4) __builtin_amdgcn_s_setprio(1);
    const int vcu = (F.G % 8 == 0) ? (F.bid % 8) * (F.G / 8) + F.bid / 8 : F.bid;
    for (int u = vcu; u < BATCH * B_HEADS * 4; u += F.G) { const int bh = u >> 2, qp = u & 3;
        for (int hf = 0; hf < 2; ++hf) attn_unit(F, bh >> 4, bh & 15, hf ? qp : 7 - qp); }
    __builtin_amdgcn_s_setprio(0);
    __syncthreads();
}
#endif

constexpr int DT_P = 656;
typedef __bf16 bf16x2_nat __attribute__((ext_vector_type(2)));
__device__ __forceinline__ unsigned cvtpk2(float lo, float hi) { return __builtin_bit_cast(unsigned, __builtin_convertvector((f32x2){lo, hi}, bf16x2_nat)); }
typedef short v4i16_t __attribute__((ext_vector_type(4)));
__device__ __forceinline__ void b2b_unit(Frame& F, cargs a, const int hu) {
    unsigned char* ws = F.ws; const float* cckv = (const float*)a->in[4]; const float* ckpe = (const float*)a->in[5]; const int* ptab = (const int*)a->in[6];
    const bf16* QA = (const bf16*)(ws + WS_QABS); float* OP = (float*)(ws + WS_OPART); float* ML = (float*)(ws + WS_ML);
    LAS unsigned char* T = F.lds;
    F.lane = lane_id();
    const int lane = F.lane, hcol = lane & 15, g = lane >> 4, tid = F.wave * 64 + lane, q4 = (lane & 15) >> 2, p4 = lane & 3;
    const bf16* Q = (const bf16*)(ws + WS_Q); const float* wuk = (const float*)a->in[28]; bf16* QAg = (bf16*)(ws + WS_QABS);
    LAS bf16* QAl = (LAS bf16*)(F.lds + 49152);
    { const int b = hu >> 1;
      {
        __syncthreads();
        for (int hh = 0; hh < 2; ++hh) { const int hd = 2 * F.wave + hh; const bf16* qn = Q + (size_t)(MP + b) * 3072 + hd * 192;
            float acc[4] = {0.f, 0.f, 0.f, 0.f};
            for (int n = 0; n < 128; n += 4) { const v2u qu = *(const v2u*)(qn + n); const f32x4 q4 = (f32x4){bflo(qu.x), bfhi(qu.x), bflo(qu.y), bfhi(qu.y)};
#pragma unroll
                for (int cc = 0; cc < 4; ++cc) { const f32x4 w4 = *(const f32x4*)(wuk + (size_t)(4 * lane + cc) * 2048 + hd * 128 + n); acc[cc] += (q4.x * w4.x + q4.y * w4.y) + (q4.z * w4.z + q4.w * w4.w); } }
            const v2u w = (v2u){pk2(acc[0], acc[1]), pk2(acc[2], acc[3])}; *(LAS v2u*)(QAl + hd * 320 + 4 * lane) = w;
            const bf16 rp = qn[128 + 2 * (lane & 31) + (lane >> 5)]; QAl[hd * 320 + 256 + lane] = rp;
            if ((hu & 1) == 0) { *(v2u*)(QAg + (size_t)(b * 16 + hd) * 320 + 4 * lane) = w; QAg[(size_t)(b * 16 + hd) * 320 + 256 + lane] = rp; } }
        __syncthreads(); }
        bf16x8 qf[10];
#pragma unroll
        for (int s = 0; s < 10; ++s) qf[s] = *(const LAS bf16x8*)(QAl + hcol * 320 + 32 * s + 8 * g);
        f32x4 o[2]; o[0] = (f32x4){0.f, 0.f, 0.f, 0.f}; o[1] = o[0]; float mrow = -1e30f, lrow = 0.f;
        f32x4 pfA_[10];
#define DT_FETCH(P_, tt_) do { const int pp = ptab[b * NPAGES + (hu & 1) * 32 + ((tt_) >> 1)], tok0 = ((tt_) & 1) * 64; \
            _Pragma("unroll") for (int i = 0; i < 10; ++i) { const int c = tid + 512 * i, key = c / 80, ch = c % 80; const size_t tk = (size_t)pp * PAGE + tok0 + key; \
                P_[i] = __builtin_nontemporal_load(ch < 64 ? (const f32x4*)(cckv + tk * 256 + ch * 4) : (const f32x4*)(ckpe + tk * 64 + (ch - 64) * 4)); } } while (0)
#define DT_BAR() do { asm volatile("s_waitcnt lgkmcnt(0)" ::: "memory"); __builtin_amdgcn_s_barrier(); asm volatile("" ::: "memory"); } while (0)
#define DT_KF(st_) (*(const LAS bf16x8*)(T + (16 * ((st_) & 3) + hcol) * DT_P + (32 * ((st_) >> 2) + 8 * g) * 2))
#define DT_TILE(P_, tt_) do { \
            DT_BAR(); \
            _Pragma("unroll") for (int i = 0; i < 10; ++i) { const int c = tid + 512 * i, key = c / 80, ch = c % 80; *(LAS v2u*)(T + key * DT_P + ch * 8) = (v2u){cvtpk2(P_[i].x, P_[i].y), cvtpk2(P_[i].z, P_[i].w)}; } \
            DT_BAR(); \
            if ((tt_) + 1 < 64) DT_FETCH(P_, (tt_) + 1); \
            f32x4 sc[4]; bf16x8 kf_[8];                                 \
            _Pragma("unroll") for (int kg = 0; kg < 4; ++kg) sc[kg] = (f32x4){0.f, 0.f, 0.f, 0.f}; \
            _Pragma("unroll") for (int st = 0; st < 6; ++st) kf_[st] = DT_KF(st); \
            _Pragma("unroll") for (int st = 0; st < 40; ++st) { if (st + 6 < 40) kf_[(st + 6) & 7] = DT_KF(st + 6); \
                sc[st & 3] = __builtin_amdgcn_mfma_f32_16x16x32_bf16(kf_[st & 7], qf[st >> 2], sc[st & 3], 0, 0, 0); __builtin_amdgcn_sched_barrier(0); } \
            float tmax = sc[0][0]; \
            _Pragma("unroll") for (int kg = 0; kg < 4; ++kg) _Pragma("unroll") for (int r = 0; r < 4; ++r) tmax = fmaxf(tmax, sc[kg][r]); \
            tmax = fmaxf(tmax, swz_xor<16>(tmax)); tmax = xor32_max(tmax); \
            const float mnew = fmaxf(mrow, tmax), alpha = __builtin_amdgcn_exp2f(mrow - mnew); mrow = mnew; \
            float ps = 0.f; \
            _Pragma("unroll") for (int kg = 0; kg < 4; ++kg) _Pragma("unroll") for (int r = 0; r < 4; ++r) { sc[kg][r] = __builtin_amdgcn_exp2f(sc[kg][r] - mnew); ps += sc[kg][r]; } \
            lrow = lrow * alpha + ps; o[0] *= alpha; o[1] *= alpha; \
            _Pragma("unroll") for (int kk = 0; kk < 2; ++kk) { const bf16x8 pbf = pack8f(sc[2 * kk][0], sc[2 * kk][1], sc[2 * kk][2], sc[2 * kk][3], sc[2 * kk + 1][0], sc[2 * kk + 1][1], sc[2 * kk + 1][2], sc[2 * kk + 1][3]); \
                _Pragma("unroll") for (int ci = 0; ci < 2; ++ci) { const int cb = 2 * F.wave + ci; LAS unsigned char* ap = T + (32 * kk + 4 * g + q4) * DT_P + (16 * cb + 4 * p4) * 2; \
                    const s16x4 lo = __builtin_bit_cast(s16x4, __builtin_amdgcn_ds_read_tr16_b64_v4i16((LAS v4i16_t*)ap)), hi2 = __builtin_bit_cast(s16x4, __builtin_amdgcn_ds_read_tr16_b64_v4i16((LAS v4i16_t*)(ap + 16 * DT_P))); \
                    const bf16x8 av = (bf16x8){lo[0], lo[1], lo[2], lo[3], hi2[0], hi2[1], hi2[2], hi2[3]}; \
                    o[ci] = __builtin_amdgcn_mfma_f32_16x16x32_bf16(av, pbf, o[ci], 0, 0, 0); } } \
            if (((tt_) & 15) == 15) {                                   \
                const int sp = (hu & 1) * 4 + ((tt_) >> 4); float lr = lrow + swz_xor<16>(lrow); lr = xor32_sum(lr); \
                const size_t pb_ = (size_t)(b * 8 + sp) * 16 + hcol; \
                _Pragma("unroll") for (int ci = 0; ci < 2; ++ci) *(f32x4*)(OP + pb_ * 256 + 16 * (2 * F.wave + ci) + 4 * g) = o[ci]; \
                if (F.wave == 0 && g == 0) { ML[pb_ * 2] = mrow; ML[pb_ * 2 + 1] = lr; } \
                o[0] = (f32x4){0.f, 0.f, 0.f, 0.f}; o[1] = o[0]; mrow = -1e30f; lrow = 0.f; } } while (0)
        DT_FETCH(pfA_, 0);
        for (int tt = 0; tt < 64; ++tt) DT_TILE(pfA_, tt);
#undef DT_FETCH
#undef DT_TILE
#undef DT_KF
#undef DT_BAR
    }
}
#if !MK_DYNATT
__device__ __forceinline__ void b2b_attn_sample(Frame& F, cargs a) {
    for (int hu = F.bid; hu < DEC_BATCH * 2; hu += F.G) b2b_unit(F, a, hu);
    __syncthreads();
}
#else
__device__ __forceinline__ void b2_attn(Frame& F, cargs a, int l) {
    unsigned* qP = (unsigned*)(F.ws + WS_CTL) + 64 + l * 64; unsigned* qS = qP + 32;
    volatile LAS int* slot = (volatile LAS int*)(F.lds + LDSCTL_OFF + 64);
    const bool prefS = (F.bid & 1) == 0;
    constexpr int NPU = BATCH * B_HEADS * 8, NSU = DEC_BATCH * 2;
    int exP = 0, exS = 0;
    for (;;) {
        __syncthreads();
        if (F.wave == 0 && lane_id() == 0) { int code = -1;
            for (int tr = 0; tr < 2 && code == -1; ++tr) { const bool s_ = (tr == 0) == prefS;
                if (s_) { if (!exS) { const unsigned i = __hip_atomic_fetch_add(qS, 1u, __ATOMIC_RELAXED, __HIP_MEMORY_SCOPE_AGENT); if (i < (unsigned)NSU) code = -2 - (int)i; else exS = 1; } }
                else { if (!exP) { const unsigned i = __hip_atomic_fetch_add(qP, 1u, __ATOMIC_RELAXED, __HIP_MEMORY_SCOPE_AGENT); if (i < (unsigned)NPU) code = (int)i; else exP = 1; } } }
            *slot = code; }
        __syncthreads();
        const int code = __builtin_amdgcn_readfirstlane(*slot);
        if (code == -1) break;
        if (code >= 0) { int bh, qb;
            if (code < 1024) { bh = code >> 2; qb = 7 - (code & 3); } else if (code < 1536) { bh = (code - 1024) >> 1; qb = 3 - (code & 1); } else { bh = (code - 1536) >> 1; qb = 1 - (code & 1); }
            attn_unit(F, bh >> 4, bh & 15, qb); }
        else b2b_unit(F, a, -2 - code);
    }
    __syncthreads();
}
#endif
__device__ __forceinline__ void b2c_combine(Frame& F, cargs a) {
    unsigned char* ws = F.ws; const bf16* QA = (const bf16*)(ws + WS_QABS); const float* OP = (const float*)(ws + WS_OPART); const float* ML = (const float*)(ws + WS_ML);
    const float* wuv = (const float*)a->in[29]; const bf16* Z = (const bf16*)(ws + WS_Z); bf16* G = (bf16*)(ws + WS_G);
    LAS float* scr = (LAS float*)(F.lds + F.wave * 1024);
    for (int it = F.gw; it < DEC_BATCH * B_HEADS; it += F.NGW) { const int b = it >> 4, hd = it & 15; const int lane = F.lane;
        const float* cn = F.out + O_CKVS + (size_t)b * 256; const float* kn = F.out + O_KPES + (size_t)b * 64; const bf16* qa = QA + (size_t)it * 320;
        const f32x4 c4 = *(const f32x4*)(cn + 4 * lane); const v2u qv = *(const v2u*)(qa + 4 * lane);
        float sn = (bflo(qv.x) * c4.x + bfhi(qv.x) * c4.y) + (bflo(qv.y) * c4.z + bfhi(qv.y) * c4.w);
        sn += __builtin_bit_cast(float, (unsigned)qa[256 + lane] << 16) * kn[lane];
        sn = wave_sum(sn);
        float ms[8], ls[8], M = sn; f32x4 op[8];
#pragma unroll
        for (int s = 0; s < 8; ++s) { ms[s] = ML[((size_t)(b * 8 + s) * 16 + hd) * 2]; ls[s] = ML[((size_t)(b * 8 + s) * 16 + hd) * 2 + 1]; op[s] = *(const f32x4*)(OP + ((size_t)(b * 8 + s) * 16 + hd) * 256 + 4 * lane); }
        __builtin_amdgcn_sched_barrier(0);
#pragma unroll
        for (int s = 0; s < 8; ++s) M = fmaxf(M, ms[s]);
        const float en = __builtin_amdgcn_exp2f(sn - M); float L = en; f32x4 acc = c4 * en;
#pragma unroll
        for (int s = 0; s < 8; ++s) { const float e = __builtin_amdgcn_exp2f(ms[s] - M); L += e * ls[s]; acc += op[s] * e; }
        acc *= 1.0f / L;
        *(LAS f32x4*)(scr + 4 * lane) = acc; LDS_WAIT(); asm volatile("" ::: "memory");
        f32x2 ov = (f32x2){0.f, 0.f};
        for (int c0 = 0; c0 < 256; c0 += 32) { f32x2 wv[32];
#pragma unroll
            for (int j = 0; j < 32; ++j) wv[j] = *(const f32x2*)(wuv + (size_t)(c0 + j) * 2048 + hd * 128 + 2 * lane);
            __builtin_amdgcn_sched_barrier(0);
#pragma unroll
            for (int j = 0; j < 32; ++j) ov += wv[j] * scr[c0 + j]; }
        const size_t off = (size_t)(MP + b) * 2048 + hd * 128 + 2 * lane; const unsigned zz = *(const unsigned*)(Z + off); const float z0 = bflo(zz), z1 = bfhi(zz);
        *(unsigned*)(G + off) = pk2(ov.x * (z0 * sigmoidf_(z0)), ov.y * (z1 * sigmoidf_(z1)));
        LDS_WAIT(); asm volatile("" ::: "memory");
    }
}

#ifndef MK_SPLIT
#define MK_SPLIT 0
#endif
#ifndef MK_DIAG
#define MK_DIAG 0
#endif
constexpr int NPHASES = 1 + 4 + 5 + 7 + 6 + 1 + (MK_DIAG ? 1 : 0);
#ifndef MK_TPROBE
#define MK_TPROBE 0
#endif
#ifndef MK_TAMP
#define MK_TAMP 4
#endif
#if MK_TPROBE
#define TP_T0 tp0_ = __builtin_amdgcn_s_memrealtime();
#define TP_T1 if (((MK_TPROBE >> ph) & 1) && !tpskip_) tpacc_ += __builtin_amdgcn_s_memrealtime() - tp0_; tpskip_ = 0;
#else
#define TP_T0
#define TP_T1
#endif
#define PH_BEGIN TP_T0 if (ph >= lo && ph < hi) { cargs ap = (cargs)__builtin_amdgcn_kernarg_segment_ptr(); asm volatile("" : "+s"(ap)); Frame F = make_frame(ap, wave0, (LAS unsigned char*)lds); unsigned char* ws = F.ws; int wgc_ = F.bid; (void)wgc_;
#define PH_END } if (ph >= lo && ph + 1 < hi) xcd_barrier(bar); TP_T1 ++ph;
typedef pg8::StaticOrder SO;
#define WG_ROT(off_) (wgc_ = (F.bid + F.G - (off_)) % F.G)
#define GEMM_B(ACT_, A_, Bt_, M_, N_, K_, O_, ldc_, nvalid_, nstore_) do { pg8::Gemm g_{(const pg8::bf16_t*)(A_), (const pg8::bf16_t*)(Bt_), (M_), (N_), (K_)}; SO S_; S_.init((M_), (N_), F.G, wgc_); \
    pg8::EpiB<ACT_> E_{(pg8::bf16_t*)(O_), (ldc_), (nvalid_), (nstore_)}; pg8::gemm_phase<pg8::EpiB<ACT_>, SO, true, true>(F.lds, g_, S_, E_, F.wave); } while (0)
#define GEMM_F(ACT_, HB_, HBI_, A_, Bt_, M_, N_, K_, O_, base_, bias_, ldc_, nstore_) do { int kk_ = (K_); asm volatile("" : "+s"(kk_)); pg8::Gemm g_{(const pg8::bf16_t*)(A_), (const pg8::bf16_t*)(Bt_), (M_), (N_), kk_}; SO S_; S_.init((M_), (N_), F.G, wgc_); \
    pg8::EpiF<ACT_, HB_, HBI_> E_{(float*)(O_), (const float*)(base_), (const float*)(bias_), (ldc_), (nstore_)}; pg8::gemm_phase<pg8::EpiF<ACT_, HB_, HBI_>, SO, true, true>(F.lds, g_, S_, E_, F.wave); } while (0)

#define OUTPROJ(Wt_, base_) do { \
    { pg8::Gemm g_{(const pg8::bf16_t*)(ws + WS_G), (const pg8::bf16_t*)(Wt_), MT, 1024, 256, 2048}; pg8::SliceOrder S_{MP / 256, 4, 8, F.G, F.bid, 512}; pg8::EpiFA E_{(float*)(ws + WS_X), 1024, MP + DEC_BATCH}; \
      pg8::gemm_phase<pg8::EpiFA, pg8::SliceOrder, true, true>(F.lds, g_, S_, E_, F.wave); } \
    GEMM_F(0, true, false, ws + WS_G, (Wt_), MP, 1024, 2048, ws + WS_X, (base_), nullptr, 1024, 1024); } while (0)
__global__ void __launch_bounds__(NTHR, 2) mk_fwd(Args args) {
    extern __shared__ __attribute__((aligned(16))) unsigned char lds[];
    const int wave0 = __builtin_amdgcn_readfirstlane(threadIdx.x >> 6);
    for (int u = threadIdx.x; u < (LDS_BYTES - LDSCTL_OFF) / 4; u += NTHR) ((LAS unsigned*)(lds + LDSCTL_OFF))[u] = 0u;
    __syncthreads();
    XcdBarrier bar = xcd_barrier_post((unsigned*)(args.ws + WS_CTL) + CW_BAR + args.li * XCD_BAR_WORDS, (volatile LAS unsigned*)((LAS unsigned char*)lds + LDSCTL_OFF), (unsigned)wave0);
    int ph = 0; const int lo = args.ph_lo, hi = args.ph_hi;
#if MK_TPROBE
    unsigned long long tpacc_ = 0, tp0_ = 0; int tpskip_ = 0;
#endif

    PH_BEGIN p0_prologue(F, ap); __syncthreads(); a1_prepass(F, ap, 0); PH_END

    for (int l = 0; l < 2; ++l) {
        if (l > 0) { PH_BEGIN a1_prepass(F, ap, l); PH_END }
        PH_BEGIN
            { static_assert(AM_STRIDE == (size_t)130 * 256 * 1024 * 2, "A-operand buffers sit 130 row panels apart");
              pg8::Gemm g_{(const pg8::bf16_t*)(ws + WS_AM), (const pg8::bf16_t*)(ws + WS_WIN + (size_t)l * WIN_L), MT, 2048, 1024}; pg8::GroupOrderA2 S_; S_.init(MT, F.G, F.bid, l ? 7 : 6);
              static_assert(WS_K == WS_R + BIGB && WS_V0 == WS_R + 2 * BIGB && WS_V1 == WS_R + 3 * BIGB && WS_Z == WS_R + 4 * BIGB && WS_LA == WS_LW + 9 * MiB && WS_LV == WS_LW + 18 * MiB, "output buffers are equally spaced");
              pg8::EpiA2 E_{(pg8::bf16_t*)(ws + WS_R), BIGB / 2, 2 + l, (pg8::bf16_t*)(ws + WS_LW), 9 * MiB / 2};
              pg8::gemm_phase<pg8::EpiA2, pg8::GroupOrderA2, true, true>(F.lds, g_, S_, E_, F.wave); }
        PH_END
        PH_BEGIN
#define GEMM_BA(ACT_, A_, Bt_, O_, bias_) do { int kk_ = 128; asm volatile("" : "+s"(kk_)); pg8::Gemm g_{(const pg8::bf16_t*)(A_), (const pg8::bf16_t*)(Bt_), MT, 2048, kk_}; SO S_; S_.init(MT, 2048, F.G, wgc_); \
    pg8::EpiBA<ACT_> E_{(pg8::bf16_t*)(O_), (const float*)(bias_)}; pg8::gemm_phase<pg8::EpiBA<ACT_>, SO, true, true>(F.lds, g_, S_, E_, F.wave); } while (0)
            GEMM_BA(4, ws + WS_LW, ws + WS_W2 + (size_t)l * (MiB / 2), ws + WS_WD, (const float*)ap->in[10] + l * 2048);
            WG_ROT(8); GEMM_BA(3, ws + WS_LA, ws + WS_W2 + (size_t)(2 + l) * (MiB / 2), ws + WS_IA, (const float*)ap->in[13] + l * 2048);
            WG_ROT(16); if (l) GEMM_BA(3, ws + WS_LV, ws + WS_W2 + (size_t)4 * (MiB / 2), ws + WS_VG, (const float*)ap->in[16]);
#undef GEMM_BA
        PH_END
        PH_BEGIN a5_fused(F, ap, l); PH_END
        PH_BEGIN
            OUTPROJ(ws + WS_WO + (size_t)l * 4 * MiB, l == 0 ? (const void*)ap->in[0] : (const void*)(ws + WS_X));
        PH_END
    }

#define MLA_INPROJ(l_, A_) do { \
        { pg8::Gemm g_{(const pg8::bf16_t*)(A_), (const pg8::bf16_t*)(ws + WS_WQ + (size_t)(l_) * MiB), MT, 512, 1024}; WG_ROT(8); SO S_; S_.init(MT, 512, F.G, wgc_); \
          pg8::EpiCQ E_{(pg8::bf16_t*)(ws + WS_CQ), (const float*)ap->in[32] + (l_) * 384, (float*)(ws + WS_CTL + CW_RSQ + (size_t)(l_) * 262144)}; pg8::gemm_phase<pg8::EpiCQ, SO, true, true>(F.lds, g_, S_, E_, F.wave); } \
        WG_ROT(16); GEMM_B(0, (A_), ws + WS_WZ + (size_t)(l_) * 4 * MiB, MT, 2048, 1024, ws + WS_Z, 2048, 2048, 2048); } while (0)
#define MLA_QUP(l_) do { pg8::Gemm g_{(const pg8::bf16_t*)(ws + WS_CQ), (const pg8::bf16_t*)(ws + WS_WUQ + (size_t)(l_) * (5 * MiB / 2)), MT, 3072, 384}; SO S_; S_.init(MT, 3072, F.G, F.bid); \
        pg8::EpiQ E_{(pg8::bf16_t*)(ws + WS_Q), (const float*)(ws + WS_ROPE), ATTN_SCALE * LOG2E, MP, SEQ, (const float*)(ws + WS_CTL + CW_RSQ + (size_t)(l_) * 262144)}; pg8::gemm_phase<pg8::EpiQ, SO, true, true>(F.lds, g_, S_, E_, F.wave); } while (0)
    for (int l = 0; l < 2; ++l) {
        PH_BEGIN if (l == 0) norm2_rows_bf16(F, (const float*)(ws + WS_X), (const float*)ap->in[25], (bf16*)(ws + WS_AM), (const float*)ap->in[30], (bf16*)(ws + WS_AM + AM_STRIDE));
                 else norm_rows_bf16(F, (const float*)(ws + WS_X), (const float*)ap->in[30] + l * 1024, (bf16*)(ws + WS_AM)); PH_END
        PH_BEGIN if (l == 0) GEMM_F(0, false, false, ws + WS_AM, ws + WS_WDKV, MT, 512, 1024, ws + WS_KVR, nullptr, nullptr, 320, 320);
                 MLA_INPROJ(l, ws + WS_AM + (l == 0 ? AM_STRIDE : 0)); PH_END
        if (l == 0) { PH_BEGIN b0c_kvpost(F, ap); PH_END }
        PH_BEGIN if (l == 0) { GEMM_B(0, ws + WS_CKVB, ws + WS_WUK, MP, 2048, 256, ws + WS_KN, 2048, 2048, 2048);
                               GEMM_B(0, ws + WS_WUV, ws + WS_CKVB, 2048, MP, 256, ws + WS_VT, MP, MP, MP); }
                 MLA_QUP(l); PH_END
#ifndef MK_TSUB
#define MK_TSUB 0
#endif
#if MK_TPROBE && MK_TSUB
        PH_BEGIN b2a_attn_prompt(F);
            if (MK_TSUB == 1) { if ((MK_TPROBE >> ph) & 1) tpacc_ += __builtin_amdgcn_s_memrealtime() - tp0_; tpskip_ = 1; } else if (MK_TSUB == 2) tp0_ = __builtin_amdgcn_s_memrealtime();
            b2b_attn_sample(F, ap);
            if (MK_TSUB == 2) { if ((MK_TPROBE >> ph) & 1) tpacc_ += __builtin_amdgcn_s_memrealtime() - tp0_; tpskip_ = 1; } else if (MK_TSUB == 3) tp0_ = __builtin_amdgcn_s_memrealtime();
        PH_END
#else
#if MK_DYNATT
        PH_BEGIN b2_attn(F, ap, l); PH_END
#else
        PH_BEGIN b2a_attn_prompt(F); b2b_attn_sample(F, ap); PH_END
#endif
#endif
        PH_BEGIN b2c_combine(F, ap); PH_END
        PH_BEGIN OUTPROJ(ws + WS_WBO + (size_t)l * 4 * MiB, ws + WS_X); PH_END
    }
#undef MLA_INPROJ
#undef MLA_QUP

    PH_BEGIN final_norm(F, ap); PH_END
#if MK_TPROBE
    if (blockIdx.x == 0) { const unsigned long long tend_ = __builtin_amdgcn_s_memrealtime() + (unsigned long long)MK_TAMP * tpacc_; while (__builtin_amdgcn_s_memrealtime() < tend_) __builtin_amdgcn_s_sleep(8); }
#endif
#if MK_DIAG
    PH_BEGIN
        const size_t offs[11] = {O_YP, O_YS, O_WKVP, O_SHP, O_CKVP, O_KPEP, O_WKVS, O_SHS, O_CKVS, O_KPES, O_END};
        for (int k = 1; k < 10; ++k) { const float f = 1.0f + sqrtf(2e-4f * (float)k);
            for (size_t i = offs[k] + (size_t)(F.bid * NTHR + F.wave * 64 + F.lane); i < offs[k + 1]; i += (size_t)F.NT) F.out[i] *= f; }
    PH_END
#endif
}

extern "C" void kernel_launch(void* const* d_in, const int* in_sizes, int n_in, void* d_out, int out_size, void* d_ws, size_t ws_size, hipStream_t stream) {
    static int grid = 0;
    if (grid == 0) {
        if (n_in != 36 || (size_t)out_size != O_END || ws_size < WS_NEED) { fprintf(stderr, "kernel_launch: unexpected sizes: n_in %d out %d (want %zu) ws %zu (need %zu)\n", n_in, out_size, (size_t)O_END, ws_size, (size_t)WS_NEED); grid = -1; return; }
        int dev = 0, cus = 0, per_cu = 0;
        if (hipGetDevice(&dev) != hipSuccess || hipDeviceGetAttribute(&cus, hipDeviceAttributeMultiprocessorCount, dev) != hipSuccess) { grid = -1; return; }
        if (hipFuncSetAttribute((const void*)mk_fwd, hipFuncAttributeMaxDynamicSharedMemorySize, LDS_BYTES) != hipSuccess) { fprintf(stderr, "kernel_launch: hipFuncSetAttribute failed\n"); grid = -1; return; }
        if (hipOccupancyMaxActiveBlocksPerMultiprocessor(&per_cu, (const void*)mk_fwd, NTHR, LDS_BYTES) != hipSuccess || per_cu < 1) fprintf(stderr, "kernel_launch: occupancy query reports %d\n", per_cu);
        (void)hipGetLastError();
        grid = cus;
    }
    if (grid < 0) return;
    if (hipMemsetAsync((char*)d_ws + WS_CTL, 0, CTL_ZERO_BYTES, stream) != hipSuccess) { fprintf(stderr, "kernel_launch: memset failed\n"); return; }
    Args a{};
    for (int i = 0; i < 36; ++i) a.in[i] = d_in[i];
    a.out = (float*)d_out; a.ws = (unsigned char*)d_ws;
#if MK_SPLIT
    for (int li = 0; li < NPHASES; ++li) { a.ph_lo = li; a.ph_hi = li + 1; a.li = li;
        hipLaunchKernelGGL(mk_fwd, dim3(grid), dim3(NTHR), LDS_BYTES, stream, a); }
#else
    a.ph_lo = 0; a.ph_hi = NPHASES; a.li = 0;
    hipLaunchKernelGGL(mk_fwd, dim3(grid), dim3(NTHR), LDS_BYTES, stream, a);
#endif
    const hipError_t le = hipPeekAtLastError();
    if (le != hipSuccess) fprintf(stderr, "kernel_launch: launch failed: %s\n", hipGetErrorName(le));
}
```
